# Optimizing an MI355X kernel written in HIP

```python
import jax, jax.numpy as jnp
from jax import lax
import numpy as np

D_MODEL = 2048
BATCH = 4
SEQ = 2048
DEPTH = 4

GRID_W = 64
CTX_LEN = 256
EPS = 1e-6
ROPE_BASE = 10000.0
NEG_INF = -1e30
F32 = jnp.float32

BRANCH_WIDTH = D_MODEL // 2
N_BRANCH = 3

RET_HEAD_DIM = 128
RET_HEADS = BRANCH_WIDTH // RET_HEAD_DIM
RET_CHUNK = 128
RET_GN_EPS = 1e-5

SWA_HEAD_DIM = 128
SWA_Q_HEADS = BRANCH_WIDTH // SWA_HEAD_DIM
SWA_KV_HEADS = SWA_Q_HEADS // 4
SWA_WINDOW = 128
SWA_BLOCK = 128

RWKV_HEAD_DIM = 64
RWKV_HEADS = BRANCH_WIDTH // RWKV_HEAD_DIM
RWKV_W_RANK = 64
RWKV_A_RANK = 64
RWKV_G_RANK = 128
RWKV_GN_EPS = 64e-5

D_FF = 4 * D_MODEL

RET_IN = 4 * BRANCH_WIDTH
SWA_IN = (SWA_Q_HEADS + 2 * SWA_KV_HEADS) * SWA_HEAD_DIM
RWKV_IN = 3 * BRANCH_WIDTH + 2 * (RWKV_W_RANK + RWKV_A_RANK) + RWKV_G_RANK
GATE_IN = N_BRANCH * D_MODEL
N_IN = RET_IN + SWA_IN + RWKV_IN + GATE_IN
IN_SPLITS = (RET_IN, SWA_IN, RWKV_IN, GATE_IN)
RWKV_SPLITS = (BRANCH_WIDTH, BRANCH_WIDTH, BRANCH_WIDTH, 2 * RWKV_W_RANK, 2 * RWKV_A_RANK, RWKV_G_RANK)

kernel_name = 'hybrid_retention_swa_rwkv7_prefix_dit'


def _split(t, sizes):
    offsets = np.cumsum(np.asarray(sizes))[:-1].tolist()
    return jnp.split(t, offsets, axis=-1)


def _flip(t, rev, axis):
    return jnp.flip(t, axis=axis) if rev else t


def rms_norm(x, g):
    x32 = x.astype(F32)
    y = x32 * lax.rsqrt(jnp.mean(jnp.square(x32), axis=-1, keepdims=True) + EPS)
    return y.astype(x.dtype) * g


def modulate(x, shift, scale):
    return x * (1 + scale) + shift


def sq_relu_mlp(x, w1, w2):
    return jnp.square(jax.nn.relu(x @ w1)) @ w2


def axial_rope_tables(row, col):
    n_freq = SWA_HEAD_DIM // 4
    inv_freq = ROPE_BASE ** (-jnp.arange(n_freq, dtype=F32) / n_freq)
    ang_r = row.astype(F32)[:, None] * inv_freq
    ang_c = col.astype(F32)[:, None] * inv_freq
    return (jnp.cos(ang_r), jnp.sin(ang_r), jnp.cos(ang_c), jnp.sin(ang_c))


def _rotate(x, cos, sin):
    cos = cos[None, :, None, :].astype(x.dtype)
    sin = sin[None, :, None, :].astype(x.dtype)
    x1, x2 = jnp.split(x, 2, axis=-1)
    return jnp.concatenate([x1 * cos - x2 * sin, x2 * cos + x1 * sin], axis=-1)


def apply_axial_rope(x, rope):
    cos_r, sin_r, cos_c, sin_c = rope
    x_row, x_col = jnp.split(x, 2, axis=-1)
    return jnp.concatenate([_rotate(x_row, cos_r, sin_r), _rotate(x_col, cos_c, sin_c)], axis=-1)


def retention_chunkwise(q, k, v, log_gamma, s0):
    b, h, t, _ = q.shape
    dv = v.shape[-1]
    n = t // RET_CHUNK
    q, k, v = (z.astype(F32).reshape(b, h, n, RET_CHUNK, z.shape[-1]) for z in (q, k, v))
    idx = jnp.arange(RET_CHUNK, dtype=F32)
    lg = log_gamma[:, None]
    diff = idx[:, None] - idx[None, :]
    intra = jnp.where(diff >= 0, jnp.exp(lg[:, :, None] * jnp.maximum(diff, 0.0)), 0.0)
    scores = jnp.einsum('bhncd,bhnsd->bhncs', q, k) * intra[None, :, None]
    y_intra = jnp.einsum('bhncs,bhnsv->bhncv', scores, v)
    q_decay = jnp.exp(lg * (idx + 1.0))
    k_decay = jnp.exp(lg * (RET_CHUNK - 1.0 - idx))
    chunk_kv = jnp.einsum('bhncd,hc,bhncv->nbhdv', k, k_decay, v)
    chunk_decay = jnp.exp(log_gamma * RET_CHUNK)[None, :, None, None]

    def step(s, kv):
        return s * chunk_decay + kv, s

    s_final, s_prev = lax.scan(step, s0, chunk_kv)
    y_cross = jnp.einsum('bhncd,hc,nbhdv->bhncv', q, q_decay, s_prev)
    return s_final, (y_intra + y_cross).reshape(b, h, t, dv)


def _ret_output(y, g):
    mean = jnp.mean(y, axis=-1, keepdims=True)
    var = jnp.mean(jnp.square(y - mean), axis=-1, keepdims=True)
    y = (y - mean) * lax.rsqrt(var + RET_GN_EPS)
    b, h, t, dv = y.shape
    y = y.transpose(0, 2, 1, 3).reshape(b, t, h * dv).astype(g.dtype)
    return jax.nn.silu(g) * y


def retention_mixer(p, pc, decay_logit):
    log_gamma = jax.nn.log_sigmoid(decay_logit.astype(F32))

    def heads(t):
        b, t_len, _ = t.shape
        return t.reshape(b, t_len, RET_HEADS, RET_HEAD_DIM).transpose(0, 2, 1, 3)

    def qkvg(t):
        q, k, v, g = jnp.split(t, 4, axis=-1)
        return heads(q), heads(k) * (RET_HEAD_DIM ** -0.5), heads(v), g

    q, k, v, g = qkvg(p)
    qc, kc, vc, gc = qkvg(pc)
    outs, outs_c = [], []
    for direction in range(2):
        rev = direction == 1
        s0 = jnp.zeros(qc.shape[:2] + (RET_HEAD_DIM, RET_HEAD_DIM), F32)
        s_ctx, y_c = retention_chunkwise(_flip(qc, rev, 2), _flip(kc, rev, 2), _flip(vc, rev, 2), log_gamma[direction], s0)
        _, y_l = retention_chunkwise(_flip(q, rev, 2), _flip(k, rev, 2), _flip(v, rev, 2), log_gamma[direction], s_ctx)
        outs.append(_flip(y_l, rev, 2))
        outs_c.append(_flip(y_c, rev, 2))
    return _ret_output(outs[0] + outs[1], g), _ret_output(outs_c[0] + outs_c[1], gc)


def banded_attention_with_ctx(q, k, v, kc, vc, sink):
    b, t, hq, d = q.shape
    g = hq // SWA_KV_HEADS
    nb = t // SWA_BLOCK
    blk = SWA_BLOCK
    tc = kc.shape[1]
    scale = d ** -0.5
    qb = q.reshape(b, nb, blk, SWA_KV_HEADS, g, d)

    def band(z):
        zp = jnp.pad(z, ((0, 0), (blk, blk), (0, 0), (0, 0))).reshape(b, nb + 2, blk, SWA_KV_HEADS, d)
        return jnp.concatenate([zp[:, :-2], zp[:, 1:-1], zp[:, 2:]], axis=2)

    kw, vw = band(k), band(v)
    s_win = jnp.einsum('bnqhgd,bnkhd->bnhgqk', qb, kw).astype(F32) * scale
    blocks = jnp.arange(nb)[:, None, None]
    qpos = blocks * blk + jnp.arange(blk)[None, :, None]
    kpos = (blocks - 1) * blk + jnp.arange(3 * blk)[None, None, :]
    valid = (jnp.abs(qpos - kpos) <= SWA_WINDOW) & (kpos >= 0) & (kpos < t)
    s_win = jnp.where(valid[None, :, None, None], s_win, NEG_INF)
    s_ctx = jnp.einsum('bnqhgd,bchd->bnhgqc', qb, kc).astype(F32) * scale
    sink_col = jnp.broadcast_to(sink.astype(F32).reshape(SWA_KV_HEADS, g)[None, None, :, :, None, None], s_win.shape[:-1] + (1,))
    probs = jax.nn.softmax(jnp.concatenate([s_win, s_ctx, sink_col], axis=-1), axis=-1)
    p_win = probs[..., :3 * blk].astype(v.dtype)
    p_ctx = probs[..., 3 * blk:3 * blk + tc].astype(v.dtype)
    out = jnp.einsum('bnhgqk,bnkhd->bnqhgd', p_win, vw) + jnp.einsum('bnhgqc,bchd->bnqhgd', p_ctx, vc)
    return out.reshape(b, t, hq * d)


def ctx_attention(qc, kc, vc, sink):
    b, tc, hq, d = qc.shape
    g = hq // SWA_KV_HEADS
    qg = qc.reshape(b, tc, SWA_KV_HEADS, g, d)
    s = jnp.einsum('bqhgd,bkhd->bhgqk', qg, kc).astype(F32) * (d ** -0.5)
    sink_col = jnp.broadcast_to(sink.astype(F32).reshape(SWA_KV_HEADS, g)[None, :, :, None, None], s.shape[:-1] + (1,))
    probs = jax.nn.softmax(jnp.concatenate([s, sink_col], axis=-1), axis=-1)
    out = jnp.einsum('bhgqk,bkhd->bqhgd', probs[..., :tc].astype(vc.dtype), vc)
    return out.reshape(b, tc, hq * d)


def swa_mixer(p, pc, sink, rope, with_ctx_out):
    sizes = (SWA_Q_HEADS * SWA_HEAD_DIM, SWA_KV_HEADS * SWA_HEAD_DIM, SWA_KV_HEADS * SWA_HEAD_DIM)

    def split_heads(t):
        b, t_len, _ = t.shape
        q, k, v = _split(t, sizes)
        return (q.reshape(b, t_len, SWA_Q_HEADS, SWA_HEAD_DIM),
                k.reshape(b, t_len, SWA_KV_HEADS, SWA_HEAD_DIM),
                v.reshape(b, t_len, SWA_KV_HEADS, SWA_HEAD_DIM))

    q, k, v = split_heads(p)
    qc, kc, vc = split_heads(pc)
    y = banded_attention_with_ctx(apply_axial_rope(q, rope), apply_axial_rope(k, rope), v, kc, vc, sink)
    y_c = ctx_attention(qc, kc, vc, sink) if with_ctx_out else None
    return y, y_c


def centred_token_shift(p, mu):
    prev = jnp.pad(p, ((0, 0), (1, 0), (0, 0)))[:, :-1]
    nxt = jnp.pad(p, ((0, 0), (0, 1), (0, 0)))[:, 1:]
    return p + mu[0] * (prev - p) + mu[1] * (nxt - p)


def rwkv_features(p, lp):
    p = centred_token_shift(p, lp['rwkv_mu'])
    r, k, v, wd, ad, gd = _split(p, RWKV_SPLITS)
    b, t, _ = p.shape
    wd = wd.reshape(b, t, 2, RWKV_W_RANK)
    ad = ad.reshape(b, t, 2, RWKV_A_RANK)
    w_raw = (lp['rwkv_w0'] + jnp.einsum('btnr,nrw->btnw', jnp.tanh(wd), lp['rwkv_w_up'])).astype(F32)
    log_decay = -jnp.exp(-jax.nn.softplus(-w_raw) - 0.5)
    a = jax.nn.sigmoid((lp['rwkv_a0'] + jnp.einsum('btnr,nrw->btnw', ad, lp['rwkv_a_up'])).astype(F32))
    g = jax.nn.sigmoid(gd) @ lp['rwkv_g_up']
    kk = (k * lp['rwkv_k_k']).astype(F32).reshape(b, t, RWKV_HEADS, RWKV_HEAD_DIM)
    kk = kk / jnp.maximum(jnp.sqrt(jnp.sum(jnp.square(kk), axis=-1, keepdims=True)), 1e-12)
    k_dir = k[:, :, None, :].astype(F32) * (1 + (a - 1) * lp['rwkv_k_a'])

    def hd(z):
        return z.reshape(z.shape[:-1] + (RWKV_HEADS, RWKV_HEAD_DIM))

    return {'r': hd(r.astype(F32)), 'k': hd(k_dir), 'v': hd(v.astype(F32)),
            'log_decay': hd(log_decay), 'a': hd(a), 'kk': kk, 'g': g}


def rwkv_scan(s0, r, w, k, v, a, b):
    def step(s, inp):
        r_t, w_t, k_t, v_t, a_t, b_t = inp
        sa = jnp.einsum('bhvk,bhk->bhv', s, a_t)
        s = s * w_t[:, :, None, :] + sa[..., None] * b_t[:, :, None, :] + v_t[..., None] * k_t[:, :, None, :]
        return s, jnp.einsum('bhvk,bhk->bhv', s, r_t)

    xs = tuple(jnp.moveaxis(z, 1, 0) for z in (r, w, k, v, a, b))
    s, ys = lax.scan(step, s0, xs)
    return s, jnp.moveaxis(ys, 0, 1)


def rwkv_direction_inputs(f, d, rev):
    ins = (f['r'], jnp.exp(f['log_decay'][:, :, d]), f['k'][:, :, d], f['v'], -f['kk'], f['kk'] * f['a'][:, :, d])
    return tuple(_flip(z, rev, 1) for z in ins)


def rwkv_output(y, f, lp):
    b, t = y.shape[:2]
    mean = jnp.mean(y, axis=-1, keepdims=True)
    var = jnp.mean(jnp.square(y - mean), axis=-1, keepdims=True)
    y = ((y - mean) * lax.rsqrt(var + RWKV_GN_EPS)).reshape(b, t, BRANCH_WIDTH) * lp['rwkv_ln_g']
    bonus = jnp.sum(f['r'][:, :, None] * f['k'] * lp['rwkv_r_k'], axis=-1, keepdims=True) * f['v'][:, :, None]
    bonus = jnp.sum(bonus, axis=2).reshape(b, t, BRANCH_WIDTH)
    return ((y + bonus) * f['g']).astype(f['g'].dtype)


def rwkv_mixer(p, pc, lp):
    f = rwkv_features(p, lp)
    fc = rwkv_features(pc, lp)
    bsz = p.shape[0]
    ys, ycs = [], []
    for d in range(2):
        rev = d == 1
        s0 = jnp.zeros((bsz, RWKV_HEADS, RWKV_HEAD_DIM, RWKV_HEAD_DIM), F32)
        s_ctx, y_c = rwkv_scan(s0, *rwkv_direction_inputs(fc, d, rev))
        _, y_l = rwkv_scan(s_ctx, *rwkv_direction_inputs(f, d, rev))
        ys.append(_flip(y_l, rev, 1))
        ycs.append(_flip(y_c, rev, 1))
    return rwkv_output(ys[0] + ys[1], f, lp), rwkv_output(ycs[0] + ycs[1], fc, lp)


def merge_branches(ys, gate_proj, w_branch, w_out):
    gates = jax.nn.sigmoid(gate_proj.reshape(gate_proj.shape[:-1] + (N_BRANCH, D_MODEL)))
    proj = jnp.einsum('btnw,nwd->btnd', jnp.stack(ys, axis=-2), w_branch)
    return jnp.sum(gates * proj, axis=-2) @ w_out


def hybrid_layer(h, hc, mod, mod_c, rope, lp, update_ctx):
    sh1, sc1, g1, sh2, sc2, g2 = jnp.split(mod, 6, axis=-1)
    sh1c, sc1c, g1c, sh2c, sc2c, g2c = jnp.split(mod_c, 6, axis=-1)
    u = modulate(rms_norm(h, lp['norm1_g']), sh1, sc1)
    uc = modulate(rms_norm(hc, lp['norm1_g']), sh1c, sc1c)
    p_ret, p_swa, p_rwkv, p_gate = _split(u @ lp['w_in'], IN_SPLITS)
    pc_ret, pc_swa, pc_rwkv, pc_gate = _split(uc @ lp['w_in'], IN_SPLITS)
    y_ret, yc_ret = retention_mixer(p_ret, pc_ret, lp['ret_decay'])
    y_swa, yc_swa = swa_mixer(p_swa, pc_swa, lp['swa_sink'], rope, update_ctx)
    y_rwkv, yc_rwkv = rwkv_mixer(p_rwkv, pc_rwkv, lp)
    h = h + g1 * merge_branches((y_ret, y_swa, y_rwkv), p_gate, lp['w_branch'], lp['w_out'])
    h = h + g2 * sq_relu_mlp(modulate(rms_norm(h, lp['norm2_g']), sh2, sc2), lp['w_ff1'], lp['w_ff2'])
    if update_ctx:
        hc = hc + g1c * merge_branches((yc_ret, yc_swa, yc_rwkv), pc_gate, lp['w_branch'], lp['w_out'])
        hc = hc + g2c * sq_relu_mlp(modulate(rms_norm(hc, lp['norm2_g']), sh2c, sc2c), lp['w_ff1'], lp['w_ff2'])
    return h, hc


def setup_inputs(seed: int = 0) -> dict:
    key = jax.random.key(seed)
    keys = iter(list(jax.random.split(key, 32)))

    def normal(shape, scale):
        return jax.random.normal(next(keys), shape, F32) * scale

    L, D, W = DEPTH, D_MODEL, BRANCH_WIDTH
    ret_base = jnp.log(2.0 ** (5.0 + jnp.arange(RET_HEADS, dtype=F32)) - 1.0)
    return {
        'x': normal((BATCH, SEQ, D), 1.0),
        'c': normal((BATCH, D), 1.0),
        'ctx': normal((BATCH, CTX_LEN, D), 1.0),
        'c_ctx': normal((D,), 1.0),
        'norm1_g': 1.0 + normal((L, D), 0.02),
        'norm2_g': 1.0 + normal((L, D), 0.02),
        'w_mod': normal((L, D, 6 * D), 0.5 * D ** -0.5),
        'b_mod': normal((L, 6 * D), 0.01),
        'w_in': normal((L, D, N_IN), D ** -0.5),
        'ret_decay': ret_base + normal((L, 2, RET_HEADS), 0.1),
        'swa_sink': normal((L, SWA_Q_HEADS), 0.5),
        'rwkv_mu': jax.random.uniform(next(keys), (L, 2, RWKV_IN), F32, 0.0, 0.5),
        'rwkv_w0': jnp.linspace(-6.5, -1.5, W, dtype=F32) + normal((L, 2, W), 0.1),
        'rwkv_w_up': normal((L, 2, RWKV_W_RANK, W), 0.1 * RWKV_W_RANK ** -0.5),
        'rwkv_a0': normal((L, 2, W), 0.1),
        'rwkv_a_up': normal((L, 2, RWKV_A_RANK, W), 0.1 * RWKV_A_RANK ** -0.5),
        'rwkv_g_up': normal((L, RWKV_G_RANK, W), RWKV_G_RANK ** -0.5),
        'rwkv_k_k': 0.85 + normal((L, W), 0.02),
        'rwkv_k_a': 1.0 + normal((L, W), 0.02),
        'rwkv_r_k': normal((L, RWKV_HEADS, RWKV_HEAD_DIM), 0.1),
        'rwkv_ln_g': 1.0 + normal((L, W), 0.02),
        'w_branch': normal((L, N_BRANCH, W, D), W ** -0.5),
        'w_out': normal((L, D, D), D ** -0.5),
        'w_ff1': normal((L, D, D_FF), D ** -0.5),
        'w_ff2': normal((L, D_FF, D), D_FF ** -0.5),
        'final_g': 1.0 + normal((D,), 0.02),
    }


def reference(x, c, ctx, c_ctx, norm1_g, norm2_g, w_mod, b_mod, w_in, ret_decay, swa_sink, rwkv_mu,
              rwkv_w0, rwkv_w_up, rwkv_a0, rwkv_a_up, rwkv_g_up, rwkv_k_k, rwkv_k_a, rwkv_r_k, rwkv_ln_g,
              w_branch, w_out, w_ff1, w_ff2, final_g):
    seq = x.shape[1]
    rows = seq // GRID_W
    row = jnp.repeat(jnp.arange(rows), GRID_W)
    col = jnp.tile(jnp.arange(GRID_W), rows)
    rope = axial_rope_tables(row, col)
    silu_c = jax.nn.silu(c)
    silu_cc = jax.nn.silu(c_ctx)
    h, hc = x, ctx
    for layer in range(DEPTH):
        mod = (silu_c @ w_mod[layer] + b_mod[layer])[:, None, :]
        mod_c = silu_cc @ w_mod[layer] + b_mod[layer]
        lp = {'norm1_g': norm1_g[layer], 'norm2_g': norm2_g[layer], 'w_in': w_in[layer],
              'ret_decay': ret_decay[layer], 'swa_sink': swa_sink[layer], 'rwkv_mu': rwkv_mu[layer],
              'rwkv_w0': rwkv_w0[layer], 'rwkv_w_up': rwkv_w_up[layer], 'rwkv_a0': rwkv_a0[layer],
              'rwkv_a_up': rwkv_a_up[layer], 'rwkv_g_up': rwkv_g_up[layer], 'rwkv_k_k': rwkv_k_k[layer],
              'rwkv_k_a': rwkv_k_a[layer], 'rwkv_r_k': rwkv_r_k[layer], 'rwkv_ln_g': rwkv_ln_g[layer],
              'w_branch': w_branch[layer], 'w_out': w_out[layer], 'w_ff1': w_ff1[layer], 'w_ff2': w_ff2[layer]}
        h, hc = hybrid_layer(h, hc, mod, mod_c, rope, lp, layer < DEPTH - 1)
    return rms_norm(h, final_g)
```

```cpp
#include <hip/hip_runtime.h>
#include <cstdio>
#include <cstdint>
namespace pg8 {
#define PG8_LAS __attribute__((address_space(3)))
typedef unsigned short bf16_t;
typedef short bf16x8 __attribute__((ext_vector_type(8)));
typedef float f32x4 __attribute__((ext_vector_type(4)));
typedef unsigned u32x4 __attribute__((ext_vector_type(4)));
constexpr int BM = 256, BK = 64, HALF = 128, HTB = HALF * BK * 2  , STAGE_BYTES = 8 * HTB, NXCD = 8, WGM = 8;

__host__ __device__ __forceinline__ int lds_byte(int r, int c) { const int st = (r >> 4) * 2 + (c >> 5), rr = r & 15, cc = c & 31, ob = rr * 64 + cc * 2; return st * 1024 + (ob ^ (((ob >> 9) & 1) << 5)); }
__host__ __device__ __forceinline__ void stage_rc(int b, int& R, int& C) { const int st = b / 1024, sb = b % 1024, swz = sb ^ (((sb >> 9) & 1) << 5); R = (st >> 1) * 16 + swz / 64; C = (st & 1) * 32 + (swz % 64) / 2; }
__host__ __device__ __forceinline__ int perm32(int rho) { const int n = rho >> 4, i = rho & 15; return 8 * (i >> 2) + 4 * n + (i & 3); }

struct Unit { int pm, pn; };
struct Gemm { const bf16_t* A; const bf16_t* Bt; int M, N, K, lda, ldb; };

struct StaticOrder {
    int nM, nN, nwg, G, c;
    __host__ __device__ void init(int M, int N, int G_, int c_) { nM = M / BM; nN = N / BM; nwg = nM * nN; G = G_; c = c_; }
    __host__ __device__ bool next(int i, Unit& u) const {
        const long L = (long)i * G + c; if (L >= nwg) return false;
        int wgid = (int)L; { const int q = nwg / NXCD, r = nwg % NXCD, xcd = wgid % NXCD, off = wgid / NXCD; wgid = (xcd < r ? xcd * (q + 1) : r * (q + 1) + (xcd - r) * q) + off; }
        const int nig = WGM * nN, gid = wgid / nig, fm = gid * WGM, gsz = (nM - fm) < WGM ? (nM - fm) : WGM;
        u.pm = fm + ((wgid % nig) % gsz); u.pn = (wgid % nig) / gsz; return true;
    }
    __device__ __forceinline__ void a_ready(const Unit&) const {}
    __device__ __forceinline__ void done(const Unit&) const {}
};

__device__ __forceinline__ unsigned cvt_pk_bf16(float lo, float hi) { unsigned r; asm volatile("v_cvt_pk_bf16_f32 %0, %1, %2" : "=v"(r) : "v"(lo), "v"(hi)); return r; }
typedef float f32x2 __attribute__((ext_vector_type(2)));
__device__ __forceinline__ float sigmoidf_(float x) { return 1.0f / (1.0f + __expf(-x)); }
__device__ __forceinline__ float bf_lo(unsigned w) { return __uint_as_float(w << 16); }
__device__ __forceinline__ float bf_hi(unsigned w) { return __uint_as_float(w & 0xffff0000u); }

template <int ACT> struct EpiBf16 {
    static constexpr bool PERM = true, AFTER_DRAIN = false;
    bf16_t* O; int ldc;
    __device__ __forceinline__ void operator()(const f32x4 (&acc)[2][2][4][2], const Unit& u, int wr, int wc, int fr, int fq) const {
        const int row0 = u.pm * BM + wr * 64 + fr; const int col0 = u.pn * BM + wc * 32 + 8 * fq;
#pragma unroll
        for (int ai = 0; ai < 2; ++ai)
#pragma unroll
            for (int m = 0; m < 4; ++m) { bf16_t* rowp = O + (size_t)(row0 + ai * HALF + m * 16) * ldc + col0;
#pragma unroll
                for (int bj = 0; bj < 2; ++bj) { f32x4 v0 = acc[ai][bj][m][0], v1 = acc[ai][bj][m][1];
                    if (ACT == 2) {
#pragma unroll
                        for (int e = 0; e < 4; ++e) { const float a = fmaxf(v0[e], 0.f), b = fmaxf(v1[e], 0.f); v0[e] = a * a; v1[e] = b * b; } }
                    u32x4 w; w.x = cvt_pk_bf16(v0[0], v0[1]); w.y = cvt_pk_bf16(v0[2], v0[3]); w.z = cvt_pk_bf16(v1[0], v1[1]); w.w = cvt_pk_bf16(v1[2], v1[3]);
                    *(u32x4*)(rowp + bj * HALF) = w; } }
    }
};
struct EpiF32 {
    static constexpr bool PERM = false, AFTER_DRAIN = false;
    float* C; int ldc;
    __device__ __forceinline__ void operator()(const f32x4 (&acc)[2][2][4][2], const Unit& u, int wr, int wc, int fr, int fq) const {
        const int row0 = u.pm * BM + wr * 64 + fr, col0 = u.pn * BM + wc * 32 + 4 * fq;
#pragma unroll
        for (int ai = 0; ai < 2; ++ai)
#pragma unroll
            for (int m = 0; m < 4; ++m) { float* rowp = C + (size_t)(row0 + ai * HALF + m * 16) * ldc + col0;
#pragma unroll
                for (int bj = 0; bj < 2; ++bj)
#pragma unroll
                    for (int n = 0; n < 2; ++n) *(f32x4*)(rowp + bj * HALF + n * 16) = acc[ai][bj][m][n]; }
    }
};
template <int MODE> struct EpiGate {
    static constexpr bool PERM = true, AFTER_DRAIN = false;
    const bf16_t* G; int ldg;
    float* part; bf16_t* out;
    __device__ __forceinline__ void operator()(const f32x4 (&acc)[2][2][4][2], const Unit& u, int wr, int wc, int fr, int fq) const {
        const int row0 = u.pm * BM + wr * 64 + fr; const int col0 = u.pn * BM + wc * 32 + 8 * fq;
#pragma unroll
        for (int ai = 0; ai < 2; ++ai)
#pragma unroll
            for (int m = 0; m < 4; ++m) { const size_t row = (size_t)(row0 + ai * HALF + m * 16);
#pragma unroll
                for (int bj = 0; bj < 2; ++bj) { const int c = col0 + bj * HALF;
                    const u32x4 gw = *(const u32x4*)(G + row * ldg + c);
                    f32x4 g0, g1; g0[0] = sigmoidf_(bf_lo(gw.x)); g0[1] = sigmoidf_(bf_hi(gw.x)); g0[2] = sigmoidf_(bf_lo(gw.y)); g0[3] = sigmoidf_(bf_hi(gw.y));
                    g1[0] = sigmoidf_(bf_lo(gw.z)); g1[1] = sigmoidf_(bf_hi(gw.z)); g1[2] = sigmoidf_(bf_lo(gw.w)); g1[3] = sigmoidf_(bf_hi(gw.w));
                    f32x4 v0 = acc[ai][bj][m][0] * g0, v1 = acc[ai][bj][m][1] * g1;
                    float* pp = part + row * 2048 + c;
                    if (MODE >= 1) { v0 += *(const f32x4*)pp; v1 += *(const f32x4*)(pp + 4); }
                    if (MODE <= 1) { *(f32x4*)pp = v0; *(f32x4*)(pp + 4) = v1; }
                    else { u32x4 w; w.x = cvt_pk_bf16(v0[0], v0[1]); w.y = cvt_pk_bf16(v0[2], v0[3]); w.z = cvt_pk_bf16(v1[0], v1[1]); w.w = cvt_pk_bf16(v1[2], v1[3]);
                        *(u32x4*)(out + row * 2048 + c) = w; } } }
    }
};
struct EpiResGate {
    static constexpr bool PERM = false, AFTER_DRAIN = false;
    float* H; const float* modl; int goff;
    __device__ __forceinline__ void operator()(const f32x4 (&acc)[2][2][4][2], const Unit& u, int wr, int wc, int fr, int fq) const {
        const int mr = u.pm < 32 ? (u.pm >> 3) : 4;
        const int row0 = u.pm * BM + wr * 64 + fr, col0 = u.pn * BM + wc * 32 + 4 * fq;
        const float* gv = modl + (size_t)mr * 12288 + goff + col0;
        f32x4 gg[2][2];
#pragma unroll
        for (int bj = 0; bj < 2; ++bj)
#pragma unroll
            for (int n = 0; n < 2; ++n) gg[bj][n] = *(const f32x4*)(gv + bj * HALF + n * 16);
#pragma unroll
        for (int ai = 0; ai < 2; ++ai)
#pragma unroll
            for (int m = 0; m < 4; ++m) { float* rowp = H + (size_t)(row0 + ai * HALF + m * 16) * 2048 + col0;
#pragma unroll
                for (int bj = 0; bj < 2; ++bj)
#pragma unroll
                    for (int n = 0; n < 2; ++n) { f32x4* p = (f32x4*)(rowp + bj * HALF + n * 16); *p = *p + gg[bj][n] * acc[ai][bj][m][n]; } }
    }
};

template <class Epi, class Sched, bool ALIGN_EPI = false, bool SP2 = false>
__device__ __forceinline__ void gemm_phase(PG8_LAS unsigned char* lds, const Gemm g, const Sched& S, const Epi& E) {
    int tid_ = threadIdx.x; asm volatile("" : "+v"(tid_));
    const int tid = tid_, wid = __builtin_amdgcn_readfirstlane(tid >> 6), lane = tid & 63, wr = wid >> 2, wc = wid & 3, fr = lane & 15, fq = lane >> 4;
    const int K = g.K, nt = K / BK;
    unsigned voffA[2], voffB[2];
#pragma unroll
    for (int i = 0; i < 2; ++i) { int R, C; stage_rc(tid * 16 + i * 8192, R, C); const int Rb = Epi::PERM ? ((R & ~31) + perm32(R & 31)) : R;
        voffA[i] = (unsigned)(R * g.lda + C) * 2u; voffB[i] = (unsigned)(Rb * g.ldb + C) * 2u; }
    const size_t kstep = (size_t)(BK * 2);
    const size_t hstepA = (size_t)HALF * g.lda * 2, hstepB = (size_t)HALF * g.ldb * 2;
    const size_t tstepA = 2 * hstepA, tstepB = 2 * hstepB;
    const unsigned ldsw = (unsigned)wid * 1024u;
    const int aoff = lds_byte(wr * 64 + fr, fq * 8), boff = lds_byte(wc * 32 + fr, fq * 8);
#define PG8_SA(b, h) (((b) * 2 + (h)) * HTB)
#define PG8_SB(b, h) ((4 + (b) * 2 + (h)) * HTB)
#define PG8_STAGE(bufoff, gbase, voff) do { _Pragma("unroll") for (int _i = 0; _i < 2; ++_i) \
        __builtin_amdgcn_global_load_lds((const unsigned*)((const char*)(gbase) + (voff)[_i]), (PG8_LAS unsigned*)(lds + (bufoff) + ldsw + _i * 8192), 16, 0, 0); } while (0)
#define PG8_LDA(dst, b, h) do { _Pragma("unroll") for (int m = 0; m < 4; ++m) _Pragma("unroll") for (int k = 0; k < 2; ++k) dst[m][k] = *(const PG8_LAS bf16x8*)(lds + PG8_SA(b, h) + aoff + m * 2048 + k * 1024); } while (0)
#define PG8_LDB(dst, b, h) do { _Pragma("unroll") for (int n = 0; n < 2; ++n) _Pragma("unroll") for (int k = 0; k < 2; ++k) dst[n][k] = *(const PG8_LAS bf16x8*)(lds + PG8_SB(b, h) + boff + n * 2048 + k * 1024); } while (0)
#define PG8_MMA(ai, bj, At, Bt) do { __builtin_amdgcn_s_setprio(1); _Pragma("unroll") for (int m = 0; m < 4; ++m) _Pragma("unroll") for (int n = 0; n < 2; ++n) _Pragma("unroll") for (int k = 0; k < 2; ++k) \
        acc[ai][bj][m][n] = __builtin_amdgcn_mfma_f32_16x16x32_bf16(Bt[n][k], At[m][k], acc[ai][bj][m][n], 0, 0, 0); __builtin_amdgcn_s_setprio(0); } while (0)
#define PG8_WAIT_V(n) asm volatile("s_waitcnt vmcnt(" #n ")" ::: "memory")
#define PG8_WAIT_L(n) asm volatile("s_waitcnt lgkmcnt(" #n ")" ::: "memory")
#define PG8_BAR __builtin_amdgcn_s_barrier()
#define PG8_SCHED __builtin_amdgcn_sched_barrier(0)
    Unit cur, nxt; int ui = 0;
    if (!S.next(0, cur)) return;
    f32x4 acc[2][2][4][2];
#pragma unroll
    for (int a = 0; a < 2; ++a)
#pragma unroll
        for (int b = 0; b < 2; ++b)
#pragma unroll
            for (int m = 0; m < 4; ++m)
#pragma unroll
                for (int n = 0; n < 2; ++n) acc[a][b][m][n] = (f32x4){0.f, 0.f, 0.f, 0.f};
    bf16x8 At[4][2], B0[2][2], B1[2][2];
    const char* cA = (const char*)g.A + (size_t)cur.pm * tstepA; const char* cB = (const char*)g.Bt + (size_t)cur.pn * tstepB;
    S.a_ready(cur);
    if constexpr (SP2) {
        PG8_STAGE(PG8_SB(0, 0), cB, voffB); PG8_STAGE(PG8_SB(0, 1), cB + hstepB, voffB); PG8_STAGE(PG8_SA(0, 0), cA, voffA); PG8_STAGE(PG8_SA(0, 1), cA + hstepA, voffA);
        if (wr == 1) PG8_BAR;
        PG8_WAIT_V(2); PG8_BAR;
        PG8_STAGE(PG8_SB(1, 0), cB + kstep, voffB); PG8_STAGE(PG8_SA(1, 0), cA + kstep, voffA); PG8_STAGE(PG8_SB(1, 1), cB + hstepB + kstep, voffB);
        PG8_WAIT_V(6); PG8_BAR;
    } else {
        PG8_STAGE(PG8_SB(0, 0), cB, voffB); PG8_STAGE(PG8_SA(0, 0), cA, voffA); PG8_STAGE(PG8_SB(0, 1), cB + hstepB, voffB); PG8_STAGE(PG8_SA(0, 1), cA + hstepA, voffA);
        if (wr == 1) PG8_BAR;
        PG8_WAIT_V(4); PG8_BAR;
        PG8_STAGE(PG8_SB(1, 0), cB + kstep, voffB); PG8_STAGE(PG8_SA(1, 0), cA + kstep, voffA); PG8_STAGE(PG8_SB(1, 1), cB + hstepB + kstep, voffB);
        PG8_WAIT_V(6); PG8_BAR;
    }
    for (;;) {
        const bool has_next = S.next(ui + 1, nxt);
        const char* nA = has_next ? (const char*)g.A + (size_t)nxt.pm * tstepA : cA; const char* nB = has_next ? (const char*)g.Bt + (size_t)nxt.pn * tstepB : cB;
        for (int t = 0; t < nt; t += 2) {
            const bool last = (t == nt - 2);
            const char* a1 = cA + (size_t)(t + 1) * kstep;
            const char* a2 = last ? nA : cA + (size_t)(t + 2) * kstep; const char* b2 = last ? nB : cB + (size_t)(t + 2) * kstep;
            const char* a3 = a2 + kstep; const char* b3 = b2 + kstep;
            if (last && has_next) S.a_ready(nxt);
            if constexpr (SP2) {
            PG8_LDB(B0, 0, 0); PG8_LDB(B1, 0, 1); PG8_SCHED; PG8_LDA(At, 0, 0); PG8_STAGE(PG8_SA(1, 1), a1 + hstepA, voffA);
            PG8_WAIT_V(8); PG8_WAIT_L(0); PG8_BAR; PG8_MMA(0, 0, At, B0); PG8_MMA(0, 1, At, B1); PG8_BAR; PG8_SCHED;
            PG8_LDA(At, 0, 1); PG8_STAGE(PG8_SB(0, 0), b2, voffB); PG8_STAGE(PG8_SB(0, 1), b2 + hstepB, voffB); PG8_STAGE(PG8_SA(0, 0), a2, voffA);
            PG8_WAIT_V(8); PG8_WAIT_L(0); PG8_BAR; PG8_MMA(1, 0, At, B0); PG8_MMA(1, 1, At, B1); PG8_BAR; PG8_SCHED;
            PG8_LDB(B0, 1, 0); PG8_LDB(B1, 1, 1); PG8_SCHED; PG8_LDA(At, 1, 0); PG8_STAGE(PG8_SA(0, 1), a2 + hstepA, voffA);
            PG8_WAIT_V(8); PG8_WAIT_L(0); PG8_BAR; PG8_MMA(0, 0, At, B0); PG8_MMA(0, 1, At, B1); PG8_BAR; PG8_SCHED;
            PG8_LDA(At, 1, 1); PG8_STAGE(PG8_SB(1, 0), b3, voffB); PG8_STAGE(PG8_SB(1, 1), b3 + hstepB, voffB); PG8_STAGE(PG8_SA(1, 0), a3, voffA);
            PG8_WAIT_V(8); PG8_WAIT_L(0); PG8_BAR; PG8_MMA(1, 0, At, B0); PG8_MMA(1, 1, At, B1); PG8_BAR; PG8_SCHED;
            } else {
            PG8_LDB(B0, 0, 0); PG8_SCHED; PG8_LDA(At, 0, 0); PG8_STAGE(PG8_SA(1, 1), a1 + hstepA, voffA);
            PG8_WAIT_L(8); PG8_BAR; PG8_WAIT_L(0); PG8_MMA(0, 0, At, B0); PG8_BAR; PG8_SCHED;
            PG8_LDB(B1, 0, 1); PG8_STAGE(PG8_SB(0, 0), b2, voffB);
            PG8_BAR; PG8_WAIT_L(0); PG8_MMA(0, 1, At, B1); PG8_BAR;
            PG8_LDA(At, 0, 1); PG8_STAGE(PG8_SA(0, 0), a2, voffA);
            PG8_BAR; PG8_WAIT_L(0); PG8_MMA(1, 0, At, B0); PG8_BAR; PG8_SCHED;
            PG8_STAGE(PG8_SB(0, 1), b2 + hstepB, voffB);
            PG8_WAIT_V(6); PG8_BAR; PG8_MMA(1, 1, At, B1); PG8_BAR;
            PG8_LDB(B0, 1, 0); PG8_SCHED; PG8_LDA(At, 1, 0); PG8_STAGE(PG8_SA(0, 1), a2 + hstepA, voffA);
            PG8_WAIT_L(8); PG8_BAR; PG8_WAIT_L(0); PG8_MMA(0, 0, At, B0); PG8_BAR; PG8_SCHED;
            PG8_LDB(B1, 1, 1); PG8_STAGE(PG8_SB(1, 0), b3, voffB);
            PG8_BAR; PG8_WAIT_L(0); PG8_MMA(0, 1, At, B1); PG8_BAR;
            PG8_LDA(At, 1, 1); PG8_STAGE(PG8_SA(1, 0), a3, voffA);
            PG8_BAR; PG8_WAIT_L(0); PG8_MMA(1, 0, At, B0); PG8_BAR; PG8_SCHED;
            PG8_STAGE(PG8_SB(1, 1), b3 + hstepB, voffB);
            PG8_WAIT_V(6); PG8_BAR; PG8_MMA(1, 1, At, B1); PG8_BAR;
            }
        }
        if constexpr (ALIGN_EPI) { if (wr == 0) PG8_BAR; }
        if constexpr (!Epi::AFTER_DRAIN) { int t2_ = threadIdx.x; asm volatile("" : "+v"(t2_));   E(acc, cur, wr, wc, t2_ & 15, (t2_ >> 4) & 3); S.done(cur); }
        if (!has_next) break;
#pragma unroll
        for (int a = 0; a < 2; ++a)
#pragma unroll
            for (int b = 0; b < 2; ++b)
#pragma unroll
                for (int m = 0; m < 4; ++m)
#pragma unroll
                    for (int n = 0; n < 2; ++n) acc[a][b][m][n] = (f32x4){0.f, 0.f, 0.f, 0.f};
        cur = nxt; cA = nA; cB = nB; ++ui;
        if constexpr (ALIGN_EPI) { if (wr == 1) PG8_BAR; }
    }
    PG8_WAIT_V(0);
    if constexpr (!ALIGN_EPI) { if (wr == 0) PG8_BAR; }
    PG8_BAR;
    if constexpr (Epi::AFTER_DRAIN) { E.fused(acc, cur, wr, wc, fr, fq, lds, wid, lane); S.done(cur); }
#undef PG8_SA
#undef PG8_SB
#undef PG8_STAGE
#undef PG8_LDA
#undef PG8_LDB
#undef PG8_MMA
#undef PG8_WAIT_V
#undef PG8_WAIT_L
#undef PG8_BAR
#undef PG8_SCHED
}
}

constexpr int NB = 4, TL = 2048, TCX = 256, DM = 2048, NL = 4, DFF = 8192, BW = 1024;
constexpr int ML = NB * TL, MC = NB * TCX, MT = ML + MC;
constexpr int NIN = 15232, LDP = 15360;
constexpr int C_RET = 0, C_SWA = 4096, C_RW = 5632, C_GATE = 9088, RWIN = 3456;
constexpr int NLR = 5120, KLR = 384;
constexpr int NQK = 1280;
constexpr int NSTEP = 2304, SCAN_BLK = 32;

constexpr size_t al256(size_t x) { return (x + 255) & ~(size_t)255; }
constexpr size_t WS_CTL = 0, CTL_ZERO_BYTES = 1u << 20;
constexpr size_t SZ_WIN = (size_t)LDP * DM * 2, SZ_WBR = (size_t)3 * DM * BW * 2, SZ_WOUT = (size_t)DM * DM * 2, SZ_WFF = (size_t)DFF * DM * 2, SZ_WLR = (size_t)NLR * KLR * 2;
constexpr size_t WS_WIN = CTL_ZERO_BYTES;
constexpr size_t WS_WBR = WS_WIN + NL * SZ_WIN;
constexpr size_t WS_WOUT = WS_WBR + NL * SZ_WBR;
constexpr size_t WS_WFF1 = WS_WOUT + NL * SZ_WOUT;
constexpr size_t WS_WFF2 = WS_WFF1 + NL * SZ_WFF;
constexpr size_t WS_WLR = WS_WFF2 + NL * SZ_WFF;
constexpr size_t WS_H = WS_WLR + NL * SZ_WLR;
constexpr size_t WS_U = WS_H + (size_t)MT * DM * 4;
constexpr size_t WS_P = WS_U + (size_t)MT * DM * 2;
constexpr size_t WS_Y = WS_P + (size_t)MT * LDP * 2;
constexpr size_t WS_MGF = WS_Y + (size_t)MT * 3072 * 2;
constexpr size_t WS_MG = WS_MGF + (size_t)MT * DM * 4;
constexpr size_t WS_F = WS_MG + (size_t)MT * DM * 2;
constexpr size_t WS_MODP = WS_F + (size_t)MT * DFF * 2;
constexpr size_t WS_MOD = WS_MODP + (size_t)8 * NL * 5 * 12288 * 4;
constexpr size_t WS_ROPE = WS_MOD + (size_t)NL * 5 * 12288 * 4;
constexpr size_t WS_XS = WS_ROPE + 64 * 32 * 2 * 4;
constexpr size_t WS_ALR = WS_XS + (size_t)MT * 3072 * 4;
constexpr size_t WS_LR = WS_ALR + (size_t)MT * KLR * 2;
constexpr size_t WS_QKR = WS_LR + (size_t)MT * NLR * 4;
constexpr size_t WS_YDR = WS_QKR + (size_t)MT * NQK * 4;
constexpr size_t WS_YDW = WS_YDR + (size_t)2 * MT * BW * 4;
constexpr size_t WS_END = WS_YDW + (size_t)2 * MT * BW * 4;
constexpr int CW_BAR = 4096;
constexpr int CW_SWAQ = 16384;

constexpr int RING_BYTES = 131072, LDSCTL_OFF = RING_BYTES, MISC_OFF = LDSCTL_OFF + 320, LDS_BYTES = 147456;
constexpr int NWAVES = 8, NTHR = 512;

#define GAS __attribute__((address_space(1)))
#define LAS __attribute__((address_space(3)))
typedef unsigned short bf16;
typedef float f32x4 __attribute__((ext_vector_type(4)));
typedef float f32x2 __attribute__((ext_vector_type(2)));
typedef unsigned u32x4 __attribute__((ext_vector_type(4)));
typedef unsigned u32x2 __attribute__((ext_vector_type(2)));
#define LDS_WAIT() asm volatile("s_waitcnt lgkmcnt(0)" ::: "memory")
#define VM_WAIT() asm volatile("s_waitcnt vmcnt(0)" ::: "memory")
__device__ __forceinline__ unsigned f2bf(float f) { unsigned u = __builtin_bit_cast(unsigned, f); return (u + 0x7fffu + ((u >> 16) & 1u)) >> 16; }
__device__ __forceinline__ unsigned pk2(float lo, float hi) { return f2bf(lo) | (f2bf(hi) << 16); }
__device__ __forceinline__ float bf2f(bf16 v) { return __uint_as_float((unsigned)v << 16); }
__device__ __forceinline__ float sigm(float x) { return 1.0f / (1.0f + __expf(-x)); }
__device__ __forceinline__ float shx(float v, int m, int lane) { return __int_as_float(__builtin_amdgcn_ds_bpermute((lane ^ m) << 2, __float_as_int(v))); }
__device__ __forceinline__ float wave_sum(float v, int lane) {
#pragma unroll
    for (int o = 1; o < 64; o <<= 1) v += shx(v, o, lane);
    return v;
}
__device__ __forceinline__ float wave_max(float v, int lane) {
#pragma unroll
    for (int o = 1; o < 64; o <<= 1) v = fmaxf(v, shx(v, o, lane));
    return v;
}

#define XB_TMO      128
#define XB_XCNT(j)  (256  + 64 * (j))
#define XB_XSUB(j)  (1280 + 64 * (j))
#define XB_XGEN(j)  (2304 + 64 * (j))
#define XB_TOP      3328
#define XB_TOPGEN   3392
#define XCD_BAR_WORDS 3456
#define XB_SPIN_CAP (1u << 22)
__device__ __forceinline__ unsigned xb_ld(unsigned* p)              { return __hip_atomic_load(p, __ATOMIC_RELAXED, __HIP_MEMORY_SCOPE_AGENT); }
__device__ __forceinline__ unsigned xb_add(unsigned* p, unsigned v) { return __hip_atomic_fetch_add(p, v, __ATOMIC_RELAXED, __HIP_MEMORY_SCOPE_AGENT); }
__device__ __forceinline__ unsigned xb_xcc_id() { return (unsigned)__builtin_amdgcn_s_getreg((3 << 11) | 20) & 0xFu; }
#define XB_SPIN(cond, bar) do { unsigned _sp = 0; while (cond) { __builtin_amdgcn_s_sleep(1); \
    if ((++_sp & 255u) == 0u) { if (xb_ld(&(bar)[XB_TMO])) break; if (_sp > XB_SPIN_CAP) { atomicAdd(&(bar)[XB_TMO], 1u); break; } } } } while (0)
struct XcdBarrier { unsigned* bar; unsigned x; volatile LAS unsigned* st; };
__device__ __forceinline__ XcdBarrier xcd_barrier_post(unsigned* bar, volatile LAS unsigned* st) {
    XcdBarrier b; b.bar = bar; b.x = xb_xcc_id(); b.st = st;
    if (threadIdx.x == 0) (void)xb_add(&bar[XB_XCNT(b.x)], 1u);
    return b;
}
__device__ __forceinline__ void xcd_barrier_complete(unsigned* bar, unsigned x, unsigned& nloc, unsigned& nx) {
    const unsigned G = gridDim.x * gridDim.y * gridDim.z;
    unsigned sum, cnt, mine, sp = 0u;
    for (;;) {
        sum = 0u; cnt = 0u; mine = 0u;
#pragma unroll
        for (unsigned j = 0; j < 16; ++j) { const unsigned c = xb_ld(&bar[XB_XCNT(j)]); sum += c; cnt += (c > 0u) ? 1u : 0u; mine = (j == x) ? c : mine; }
        if (sum == G) break;
        __builtin_amdgcn_s_sleep(1);
        if ((++sp & 255u) == 0u) { if (xb_ld(&bar[XB_TMO])) break; if (sp > XB_SPIN_CAP) { atomicAdd(&bar[XB_TMO], 1u); break; } }
    }
    nloc = mine > 0u ? mine : 1u; nx = cnt > 0u ? cnt : 1u;
}
__device__ __forceinline__ void xcd_barrier(const XcdBarrier& b) {
    asm volatile("s_waitcnt vmcnt(0)" ::: "memory");
    __syncthreads();
    if (threadIdx.x == 0) {
        unsigned* bar = b.bar; unsigned bx = b.x;
        asm volatile("" : "+s"(bar), "+s"(bx));
        __builtin_amdgcn_s_waitcnt(0);
        unsigned nloc = b.st[0], nx = b.st[1];
        if (nloc == 0u) { xcd_barrier_complete(bar, bx, nloc, nx); b.st[0] = nloc; b.st[1] = nx; }
        const unsigned old = xb_add(&bar[XB_XSUB(bx)], 1u);
        const unsigned gen = old / nloc;
        if (old + 1u == (gen + 1u) * nloc) {
            __builtin_amdgcn_fence(__ATOMIC_RELEASE, "agent");
            asm volatile("s_waitcnt vmcnt(0)" ::: "memory");
            const unsigned og = xb_add(&bar[XB_TOP], 1u);
            const unsigned tg = og / nx;
            if (og + 1u == (tg + 1u) * nx) xb_add(&bar[XB_TOPGEN], 1u);
            else XB_SPIN(xb_ld(&bar[XB_TOPGEN]) == tg, bar);
            __builtin_amdgcn_fence(__ATOMIC_ACQUIRE, "agent");
            xb_add(&bar[XB_XGEN(bx)], 1u);
            asm volatile("s_waitcnt vmcnt(0)" ::: "memory");
        } else {
            XB_SPIN(xb_ld(&bar[XB_XGEN(bx)]) == gen, bar);
            __builtin_amdgcn_fence(__ATOMIC_ACQUIRE, "agent");
            asm volatile("s_waitcnt vmcnt(0)" ::: "memory");
        }
    }
    __syncthreads();
}

struct Args { const float* in[26]; float* out; unsigned char* ws; int s_lo, s_hi; };
enum { I_X = 0, I_C, I_CTX, I_CCTX, I_N1G, I_N2G, I_WMOD, I_BMOD, I_WIN, I_RETDEC, I_SINK, I_MU, I_W0, I_WUP, I_A0, I_AUP, I_GUP, I_KK, I_KA, I_RK, I_LNG, I_WBR, I_WOUT, I_WFF1, I_WFF2, I_FING };
struct Frame {
    LAS unsigned char* lds;
    unsigned* ctl;
    int tid, lane, wave, G, wg;
    unsigned char* ws;
};
template <class T> __device__ __forceinline__ T* wsp(const Frame& F, size_t off) { return (T*)(F.ws + off); }
constexpr int PTAB_OFF = LDSCTL_OFF + 64;
__device__ __forceinline__ const float* inp(const Frame& F, int i) {
    const LAS unsigned* t = (const LAS unsigned*)(F.lds + PTAB_OFF) + 2 * i;
    const unsigned lo = __builtin_amdgcn_readfirstlane(t[0]), hi = __builtin_amdgcn_readfirstlane(t[1]);
    return (const float*)(((unsigned long long)hi << 32) | (unsigned long long)lo);
}

__device__ __forceinline__ int scan_row(int b, int dir, int s) {
    if (s < TCX) return ML + b * TCX + (dir ? (TCX - 1 - s) : s);
    const int t = s - TCX; return b * TL + (dir ? (TL - 1 - t) : t);
}

__device__ __forceinline__ void transpose_item(const float* W, int K, int N, bf16* WT, LAS float* scr, int item, int lane) {
    const int nblk = N / 32, kb = item / nblk, nb = item % nblk, k0 = 64 * kb, n0 = 32 * nb;
#pragma unroll 8
    for (int i = 0; i < 32; ++i) { const int kk = 2 * i + (lane >> 5); scr[kk * 33 + (lane & 31)] = W[(size_t)(k0 + kk) * N + n0 + (lane & 31)]; }
    LDS_WAIT(); asm volatile("" ::: "memory");
    const int c = lane & 7;
#pragma unroll
    for (int j = 0; j < 4; ++j) { const int n = (lane >> 3) + 8 * j; const LAS float* s = scr + (8 * c) * 33 + n;
        u32x4 o; o.x = pk2(s[0 * 33], s[1 * 33]); o.y = pk2(s[2 * 33], s[3 * 33]); o.z = pk2(s[4 * 33], s[5 * 33]); o.w = pk2(s[6 * 33], s[7 * 33]);
        *(u32x4*)(WT + (size_t)(n0 + n) * K + k0 + 8 * c) = o; }
    LDS_WAIT(); asm volatile("" ::: "memory");
}
__device__ __forceinline__ void p0_prologue(Frame& F) {
    const int gw = F.wg * NWAVES + F.wave, NGW = F.G * NWAVES;
    const int gt = F.wg * NTHR + F.tid, NGT = F.G * NTHR;
    LAS float* sil = (LAS float*)(F.lds + 81920);
    for (int e = F.tid; e < 5 * DM; e += NTHR) { const int r = e / DM, k = e % DM; const float v = r < 4 ? inp(F, I_C)[r * DM + k] : inp(F, I_CCTX)[k]; sil[e] = v * sigm(v); }
    {
        LAS float* scr = (LAS float*)(F.lds + F.wave * 8704);
        constexpr int IT_IN = (DM / 64) * (NIN / 32), IT_BR = (BW / 64) * (DM / 32), IT_OUT = (DM / 64) * (DM / 32), IT_F1 = (DM / 64) * (DFF / 32), IT_F2 = (DFF / 64) * (DM / 32);
        constexpr int IT_L = IT_IN + 3 * IT_BR + IT_OUT + IT_F1 + IT_F2;
        for (int it = gw; it < NL * IT_L; it += NGW) {
            const int l = it / IT_L; int r = it % IT_L;
            if (r < IT_IN) { transpose_item(inp(F, I_WIN) + (size_t)l * DM * NIN, DM, NIN, wsp<bf16>(F, WS_WIN + l * SZ_WIN), scr, r, F.lane); continue; } r -= IT_IN;
            if (r < 3 * IT_BR) { const int n = r / IT_BR; transpose_item(inp(F, I_WBR) + ((size_t)l * 3 + n) * BW * DM, BW, DM, wsp<bf16>(F, WS_WBR + l * SZ_WBR) + (size_t)n * DM * BW, scr, r % IT_BR, F.lane); continue; } r -= 3 * IT_BR;
            if (r < IT_OUT) { transpose_item(inp(F, I_WOUT) + (size_t)l * DM * DM, DM, DM, wsp<bf16>(F, WS_WOUT + l * SZ_WOUT), scr, r, F.lane); continue; } r -= IT_OUT;
            if (r < IT_F1) { transpose_item(inp(F, I_WFF1) + (size_t)l * DM * DFF, DM, DFF, wsp<bf16>(F, WS_WFF1 + l * SZ_WFF), scr, r, F.lane); continue; } r -= IT_F1;
            transpose_item(inp(F, I_WFF2) + (size_t)l * DFF * DM, DFF, DM, wsp<bf16>(F, WS_WFF2 + l * SZ_WFF), scr, r, F.lane);
        }
    }
    for (int e = gt; e < NL * (LDP - NIN) * DM / 8; e += NGT) { const int l = e / ((LDP - NIN) * DM / 8), r = e % ((LDP - NIN) * DM / 8);
        *(u32x4*)(wsp<bf16>(F, WS_WIN + l * SZ_WIN) + (size_t)NIN * DM + (size_t)r * 8) = (u32x4){0u, 0u, 0u, 0u}; }
    for (int e = gt; e < NL * NLR * KLR; e += NGT) {
        const int l = e / (NLR * KLR), r = e % (NLR * KLR), n = r / KLR, k = r % KLR; float v = 0.f;
        if (n < 2048) { const int d = n >> 10, c = n & 1023; if (k >= 64 * d && k < 64 * d + 64) v = inp(F, I_WUP)[(((size_t)l * 2 + d) * 64 + (k - 64 * d)) * BW + c]; }
        else if (n < 4096) { const int d = (n - 2048) >> 10, c = n & 1023; if (k >= 128 + 64 * d && k < 192 + 64 * d) v = inp(F, I_AUP)[(((size_t)l * 2 + d) * 64 + (k - 128 - 64 * d)) * BW + c]; }
        else { const int c = n - 4096; if (k >= 256) v = inp(F, I_GUP)[((size_t)l * 128 + (k - 256)) * BW + c]; }
        wsp<bf16>(F, WS_WLR + l * SZ_WLR)[r] = (bf16)f2bf(v);
    }
    { const f32x4* x4 = (const f32x4*)inp(F, I_X); const f32x4* c4 = (const f32x4*)inp(F, I_CTX); f32x4* h4 = wsp<f32x4>(F, WS_H);
      for (int e = gt; e < ML * DM / 4; e += NGT) h4[e] = x4[e];
      for (int e = gt; e < MC * DM / 4; e += NGT) h4[ML * DM / 4 + e] = c4[e]; }
    if (gt < 64 * 32) { const int pos = gt >> 5, i = gt & 31; const float inv = powf(10000.0f, -(float)i / 32.0f); const float ang = (float)pos * inv;
        wsp<float>(F, WS_ROPE)[2 * gt] = cosf(ang); wsp<float>(F, WS_ROPE)[2 * gt + 1] = sinf(ang); }
    __syncthreads();
    for (int it = gw; it < NL * 8 * 48; it += NGW) {
        const int l = it / (8 * 48), kc = (it / 48) % 8, cc = it % 48, col = cc * 256 + F.lane * 4, k0 = kc * 256;
        const float* wp = inp(F, I_WMOD) + ((size_t)l * DM + k0) * 12288 + col;
        f32x4 a0 = {0.f, 0.f, 0.f, 0.f}, a1 = a0, a2 = a0, a3 = a0, a4 = a0;
#pragma unroll 8
        for (int k = 0; k < 256; ++k) { const f32x4 w = *(const f32x4*)(wp + (size_t)k * 12288);
            a0 += sil[0 * DM + k0 + k] * w; a1 += sil[1 * DM + k0 + k] * w; a2 += sil[2 * DM + k0 + k] * w; a3 += sil[3 * DM + k0 + k] * w; a4 += sil[4 * DM + k0 + k] * w; }
        float* mp = wsp<float>(F, WS_MODP) + ((size_t)(kc * NL + l) * 5) * 12288 + col;
        *(f32x4*)(mp) = a0; *(f32x4*)(mp + 12288) = a1; *(f32x4*)(mp + 2 * 12288) = a2; *(f32x4*)(mp + 3 * 12288) = a3; *(f32x4*)(mp + 4 * 12288) = a4;
    }
}
__device__ __forceinline__ void p1_modreduce(Frame& F) {
    const int gt = F.wg * NTHR + F.tid, NGT = F.G * NTHR;
    for (int e = gt; e < NL * 5 * 12288; e += NGT) { const int l = e / (5 * 12288), j = e % 12288;
        float s = inp(F, I_BMOD)[l * 12288 + j];
#pragma unroll
        for (int kc = 0; kc < 8; ++kc) s += wsp<float>(F, WS_MODP)[(size_t)kc * NL * 5 * 12288 + e];
        wsp<float>(F, WS_MOD)[e] = s; }
}

__device__ __forceinline__ void norm_phase(Frame& F, int layer, int which, int nrows) {
    const int gw = F.wg * NWAVES + F.wave, NGW = F.G * NWAVES;
    const float* gptr = inp(F, which ? I_N2G : I_N1G) + layer * DM;
    for (int row = gw; row < nrows; row += NGW) {
        const int mr = row < ML ? (row >> 11) : 4;
        const float* mod = wsp<float>(F, WS_MOD) + ((size_t)layer * 5 + mr) * 12288 + (which ? 3 * DM : 0);
        const f32x4* xr = (const f32x4*)(wsp<float>(F, WS_H) + (size_t)row * DM) + F.lane;
        f32x4 v[8]; float ss = 0.f;
#pragma unroll
        for (int j = 0; j < 8; ++j) { v[j] = xr[64 * j]; ss += (v[j].x * v[j].x + v[j].y * v[j].y) + (v[j].z * v[j].z + v[j].w * v[j].w); }
        const float rs = 1.0f / sqrtf(wave_sum(ss, F.lane) * (1.0f / DM) + 1e-6f);
        u32x2* o = (u32x2*)(wsp<bf16>(F, WS_U) + (size_t)row * DM) + F.lane;
#pragma unroll
        for (int j = 0; j < 8; ++j) { const int c = 4 * F.lane + 256 * j;
            const f32x4 g = *(const f32x4*)(gptr + c), sh = *(const f32x4*)(mod + c), sc = *(const f32x4*)(mod + DM + c);
            const f32x4 y = (v[j] * rs) * g * (1.0f + sc) + sh;
            u32x2 w; w.x = pk2(y.x, y.y); w.y = pk2(y.z, y.w); o[64 * j] = w; }
    }
}
__device__ __forceinline__ void final_norm(Frame& F, float* out) {
    const int gw = F.wg * NWAVES + F.wave, NGW = F.G * NWAVES;
    for (int row = gw; row < ML; row += NGW) {
        const f32x4* xr = (const f32x4*)(wsp<float>(F, WS_H) + (size_t)row * DM) + F.lane;
        f32x4 v[8]; float ss = 0.f;
#pragma unroll
        for (int j = 0; j < 8; ++j) { v[j] = xr[64 * j]; ss += (v[j].x * v[j].x + v[j].y * v[j].y) + (v[j].z * v[j].z + v[j].w * v[j].w); }
        const float rs = 1.0f / sqrtf(wave_sum(ss, F.lane) * (1.0f / DM) + 1e-6f);
        f32x4* o = (f32x4*)(out + (size_t)row * DM) + F.lane;
#pragma unroll
        for (int j = 0; j < 8; ++j) { const f32x4 g = *(const f32x4*)(inp(F, I_FING) + 4 * F.lane + 256 * j); o[64 * j] = (v[j] * rs) * g; }
    }
}
__device__ __forceinline__ void prep_phase(Frame& F, int layer) {
    const int gw = F.wg * NWAVES + F.wave, NGW = F.G * NWAVES;
    const bf16* P = wsp<bf16>(F, WS_P);
    const float* mu0 = inp(F, I_MU) + (size_t)layer * 2 * RWIN; const float* mu1 = mu0 + RWIN;
    const float* rope = wsp<float>(F, WS_ROPE);
    for (int row = gw; row < MT; row += NGW) {
        bool first, last; int t = 0;
        if (row < ML) { t = row & (TL - 1); first = t == 0; last = t == TL - 1; } else { const int c = (row - ML) & (TCX - 1); first = c == 0; last = c == TCX - 1; }
        const bf16* pr = P + (size_t)row * LDP + C_RW;
        float* xs = wsp<float>(F, WS_XS) + (size_t)row * 3072; bf16* alr = wsp<bf16>(F, WS_ALR) + (size_t)row * KLR;
        for (int j2 = F.lane; j2 < RWIN / 2; j2 += 64) {
            const int c = 2 * j2;
            const unsigned pw = *(const unsigned*)(pr + c);
            const unsigned vw = first ? 0u : *(const unsigned*)(pr - LDP + c);
            const unsigned nw = last ? 0u : *(const unsigned*)(pr + LDP + c);
            const float p0 = __uint_as_float(pw << 16), p1 = __uint_as_float(pw & 0xffff0000u);
            const float v0 = __uint_as_float(vw << 16), v1 = __uint_as_float(vw & 0xffff0000u);
            const float n0 = __uint_as_float(nw << 16), n1 = __uint_as_float(nw & 0xffff0000u);
            const f32x2 m0 = *(const f32x2*)(mu0 + c), m1 = *(const f32x2*)(mu1 + c);
            const float s0 = p0 + m0.x * (v0 - p0) + m1.x * (n0 - p0), s1 = p1 + m0.y * (v1 - p1) + m1.y * (n1 - p1);
            if (c < 3072) { *(f32x2*)(xs + c) = (f32x2){s0, s1}; }
            else if (c < 3200) { *(unsigned*)(alr + (c - 3072)) = pk2(tanhf(s0), tanhf(s1)); }
            else if (c < 3328) { *(unsigned*)(alr + 128 + (c - 3200)) = pk2(s0, s1); }
            else { *(unsigned*)(alr + 256 + (c - 3328)) = pk2(sigm(s0), sigm(s1)); }
        }
        const bf16* ps = P + (size_t)row * LDP + C_SWA; float* qk = wsp<float>(F, WS_QKR) + (size_t)row * NQK;
        const bool lat = row < ML; const int rr = t >> 6, cc = t & 63;
#pragma unroll
        for (int it = 0; it < 5; ++it) { const int idx = it * 64 + F.lane, hd = idx >> 5, i = idx & 31;
            const float x1r = bf2f(ps[hd * 128 + i]), x2r = bf2f(ps[hd * 128 + 32 + i]), x1c = bf2f(ps[hd * 128 + 64 + i]), x2c = bf2f(ps[hd * 128 + 96 + i]);
            float cr = 1.f, sr = 0.f, ccs = 1.f, scs = 0.f;
            if (lat) { cr = rope[(rr * 32 + i) * 2]; sr = rope[(rr * 32 + i) * 2 + 1]; ccs = rope[(cc * 32 + i) * 2]; scs = rope[(cc * 32 + i) * 2 + 1]; }
            qk[hd * 128 + i] = x1r * cr - x2r * sr; qk[hd * 128 + 32 + i] = x2r * cr + x1r * sr;
            qk[hd * 128 + 64 + i] = x1c * ccs - x2c * scs; qk[hd * 128 + 96 + i] = x2c * ccs + x1c * scs; }
    }
}

__device__ __forceinline__ void ret_scan_unit(Frame& F, int layer, int unit) {
    const int dir = unit & 1, h = (unit >> 1) & 7, b = unit >> 4;
    const float gamma = sigm(inp(F, I_RETDEC)[(layer * 2 + dir) * 8 + h]);
    LAS float* qs = (LAS float*)F.lds; LAS float* ks = qs + 4096; LAS float* vs = ks + 4096; LAS float* yp = vs + 4096;
    const bf16* P = wsp<bf16>(F, WS_P); float* YD = wsp<float>(F, WS_YDR) + (size_t)dir * MT * BW;
    const int dv = F.tid & 127, ks4 = F.tid >> 7;
    float S[32];
#pragma unroll
    for (int i = 0; i < 32; ++i) S[i] = 0.f;
    for (int blk = 0; blk < NSTEP / SCAN_BLK; ++blk) {
        __syncthreads();
        for (int e = F.tid; e < 4096; e += NTHR) { const int tok = e >> 7, d = e & 127; const int row = scan_row(b, dir, blk * SCAN_BLK + tok);
            const bf16* pr = P + (size_t)row * LDP + C_RET + h * 128 + d;
            qs[e] = bf2f(pr[0]); ks[e] = bf2f(pr[1024]) * 0.08838834764831845f; vs[e] = bf2f(pr[2048]); }
        __syncthreads();
        for (int tok = 0; tok < SCAN_BLK; ++tok) {
            const float v = vs[tok * 128 + dv]; float y = 0.f;
            const LAS f32x4* k4 = (const LAS f32x4*)(ks + tok * 128 + 32 * ks4); const LAS f32x4* q4 = (const LAS f32x4*)(qs + tok * 128 + 32 * ks4);
#pragma unroll
            for (int i = 0; i < 8; ++i) { const f32x4 kk = k4[i], qq = q4[i];
                S[4 * i + 0] = fmaf(gamma, S[4 * i + 0], kk.x * v); y = fmaf(qq.x, S[4 * i + 0], y);
                S[4 * i + 1] = fmaf(gamma, S[4 * i + 1], kk.y * v); y = fmaf(qq.y, S[4 * i + 1], y);
                S[4 * i + 2] = fmaf(gamma, S[4 * i + 2], kk.z * v); y = fmaf(qq.z, S[4 * i + 2], y);
                S[4 * i + 3] = fmaf(gamma, S[4 * i + 3], kk.w * v); y = fmaf(qq.w, S[4 * i + 3], y); }
            yp[(tok * 4 + ks4) * 128 + dv] = y;
        }
        __syncthreads();
        for (int e = F.tid; e < 4096; e += NTHR) { const int tok = e >> 7, d = e & 127; const int row = scan_row(b, dir, blk * SCAN_BLK + tok);
            YD[(size_t)row * BW + h * 128 + d] = (yp[(tok * 4 + 0) * 128 + d] + yp[(tok * 4 + 1) * 128 + d]) + (yp[(tok * 4 + 2) * 128 + d] + yp[(tok * 4 + 3) * 128 + d]); }
    }
    __syncthreads();
}
__device__ __forceinline__ void rwkv_scan_unit(Frame& F, int layer, int unit) {
    const int dir = unit & 1, h = (unit >> 1) & 15, b = unit >> 5;
    LAS float* Rl = (LAS float*)F.lds; LAS float* Wl = Rl + 2048; LAS float* Kl = Wl + 2048; LAS float* Vl = Kl + 2048; LAS float* Al = Vl + 2048; LAS float* Bl = Al + 2048; LAS float* Yl = Bl + 2048;
    const float* XS = wsp<float>(F, WS_XS); const float* LR = wsp<float>(F, WS_LR); float* YD = wsp<float>(F, WS_YDW) + (size_t)dir * MT * BW;
    const int vrow = F.tid >> 3, kq = F.tid & 7;
    const int ptok = F.tid >> 4, pj = (F.tid & 15) * 4, pc = h * 64 + pj;
    const f32x4 w0v = *(const f32x4*)(inp(F, I_W0) + ((size_t)layer * 2 + dir) * BW + pc), a0v = *(const f32x4*)(inp(F, I_A0) + ((size_t)layer * 2 + dir) * BW + pc);
    const f32x4 kkv = *(const f32x4*)(inp(F, I_KK) + (size_t)layer * BW + pc), kav = *(const f32x4*)(inp(F, I_KA) + (size_t)layer * BW + pc);
    float S[8];
#pragma unroll
    for (int i = 0; i < 8; ++i) S[i] = 0.f;
    for (int blk = 0; blk < NSTEP / SCAN_BLK; ++blk) {
        __syncthreads();
        {
            const int row = scan_row(b, dir, blk * SCAN_BLK + ptok);
            const f32x4 r4 = *(const f32x4*)(XS + (size_t)row * 3072 + pc), k4 = *(const f32x4*)(XS + (size_t)row * 3072 + 1024 + pc), v4 = *(const f32x4*)(XS + (size_t)row * 3072 + 2048 + pc);
            const f32x4 lw = *(const f32x4*)(LR + (size_t)row * NLR + dir * 1024 + pc), la = *(const f32x4*)(LR + (size_t)row * NLR + 2048 + dir * 1024 + pc);
            f32x4 dec, av, kk, kd; float ssq = 0.f;
#pragma unroll
            for (int e = 0; e < 4; ++e) { dec[e] = __expf(-0.6065306597126334f * sigm(w0v[e] + lw[e])); av[e] = sigm(a0v[e] + la[e]); kk[e] = k4[e] * kkv[e]; ssq += kk[e] * kk[e];
                kd[e] = k4[e] * (1.0f + (av[e] - 1.0f) * kav[e]); }
            ssq += shx(ssq, 1, F.lane); ssq += shx(ssq, 2, F.lane); ssq += shx(ssq, 4, F.lane); ssq += shx(ssq, 8, F.lane);
            const float inv = 1.0f / fmaxf(sqrtf(ssq), 1e-12f);
            f32x4 an, bn;
#pragma unroll
            for (int e = 0; e < 4; ++e) { const float kn = kk[e] * inv; an[e] = -kn; bn[e] = kn * av[e]; }
            const int o = ptok * 64 + pj;
            *(LAS f32x4*)(Rl + o) = r4; *(LAS f32x4*)(Wl + o) = dec; *(LAS f32x4*)(Kl + o) = kd; *(LAS f32x4*)(Vl + o) = v4; *(LAS f32x4*)(Al + o) = an; *(LAS f32x4*)(Bl + o) = bn;
        }
        __syncthreads();
        for (int tok = 0; tok < SCAN_BLK; ++tok) {
            const int o = tok * 64 + 8 * kq;
            const f32x4 a0 = *(const LAS f32x4*)(Al + o), a1 = *(const LAS f32x4*)(Al + o + 4), w0 = *(const LAS f32x4*)(Wl + o), w1 = *(const LAS f32x4*)(Wl + o + 4);
            const f32x4 b0 = *(const LAS f32x4*)(Bl + o), b1 = *(const LAS f32x4*)(Bl + o + 4), k0 = *(const LAS f32x4*)(Kl + o), k1 = *(const LAS f32x4*)(Kl + o + 4);
            const f32x4 r0 = *(const LAS f32x4*)(Rl + o), r1 = *(const LAS f32x4*)(Rl + o + 4); const float vv = Vl[tok * 64 + vrow];
            float sa = (S[0] * a0.x + S[1] * a0.y) + (S[2] * a0.z + S[3] * a0.w) + (S[4] * a1.x + S[5] * a1.y) + (S[6] * a1.z + S[7] * a1.w);
            sa += shx(sa, 1, F.lane); sa += shx(sa, 2, F.lane); sa += shx(sa, 4, F.lane);
            S[0] = fmaf(S[0], w0.x, fmaf(sa, b0.x, vv * k0.x)); S[1] = fmaf(S[1], w0.y, fmaf(sa, b0.y, vv * k0.y)); S[2] = fmaf(S[2], w0.z, fmaf(sa, b0.z, vv * k0.z)); S[3] = fmaf(S[3], w0.w, fmaf(sa, b0.w, vv * k0.w));
            S[4] = fmaf(S[4], w1.x, fmaf(sa, b1.x, vv * k1.x)); S[5] = fmaf(S[5], w1.y, fmaf(sa, b1.y, vv * k1.y)); S[6] = fmaf(S[6], w1.z, fmaf(sa, b1.z, vv * k1.z)); S[7] = fmaf(S[7], w1.w, fmaf(sa, b1.w, vv * k1.w));
            float y = (S[0] * r0.x + S[1] * r0.y) + (S[2] * r0.z + S[3] * r0.w) + (S[4] * r1.x + S[5] * r1.y) + (S[6] * r1.z + S[7] * r1.w);
            y += shx(y, 1, F.lane); y += shx(y, 2, F.lane); y += shx(y, 4, F.lane);
            if (kq == 0) Yl[tok * 64 + vrow] = y;
        }
        __syncthreads();
        { const int e = F.tid * 4, tok = e >> 6, j = e & 63; const int row = scan_row(b, dir, blk * SCAN_BLK + tok);
          *(f32x4*)(YD + (size_t)row * BW + h * 64 + j) = *(const LAS f32x4*)(Yl + e); }
    }
    __syncthreads();
}
__device__ __forceinline__ void swa_wave_unit(Frame& F, int layer, int row, int kvh, LAS float* wl) {
    const float* QKR = wsp<float>(F, WS_QKR); const bf16* P = wsp<bf16>(F, WS_P);
    LAS float* ql = wl;
    LAS float* pl = wl + 512;
    const int lane = F.lane;
    int nwin, wrow0, crow0;
    if (row < ML) { const int b = row >> 11, t = row & (TL - 1); const int lo = t - 128 < 0 ? 0 : t - 128, hi = t + 128 > TL - 1 ? TL - 1 : t + 128; nwin = hi - lo + 1; wrow0 = b * TL + lo; crow0 = ML + b * TCX; }
    else { const int b = (row - ML) >> 8; nwin = 0; wrow0 = 0; crow0 = ML + b * TCX; }
    const int nk = nwin + TCX;
#pragma unroll
    for (int j = 0; j < 2; ++j) *(LAS f32x4*)(ql + (j * 64 + lane) * 4) = *(const f32x4*)(QKR + (size_t)row * NQK + kvh * 512 + (j * 64 + lane) * 4);
    LDS_WAIT(); asm volatile("" ::: "memory");
    float sc[9][4];
#pragma unroll
    for (int s = 0; s < 9; ++s) { sc[s][0] = 0.f; sc[s][1] = 0.f; sc[s][2] = 0.f; sc[s][3] = 0.f; }
    const float* kp[9];
#pragma unroll
    for (int s = 0; s < 9; ++s) { const int kidx = s * 64 + lane; const int kr = kidx < nwin ? wrow0 + kidx : crow0 + (kidx - nwin); kp[s] = QKR + (size_t)(kidx < nk ? kr : crow0) * NQK + 1024 + kvh * 128; }
    for (int dc = 0; dc < 8; ++dc) {
        f32x4 q[4][4];
#pragma unroll
        for (int hh = 0; hh < 4; ++hh)
#pragma unroll
            for (int e = 0; e < 4; ++e) q[hh][e] = *(const LAS f32x4*)(ql + hh * 128 + dc * 16 + e * 4);
#pragma unroll
        for (int s = 0; s < 9; ++s) {
#pragma unroll
            for (int e = 0; e < 4; ++e) { const f32x4 kv = *(const f32x4*)(kp[s] + dc * 16 + e * 4);
#pragma unroll
                for (int hh = 0; hh < 4; ++hh) sc[s][hh] += (kv.x * q[hh][e].x + kv.y * q[hh][e].y) + (kv.z * q[hh][e].z + kv.w * q[hh][e].w); }
        }
    }
    float mx[4], sum[4], sk[4];
#pragma unroll
    for (int hh = 0; hh < 4; ++hh) { sk[hh] = inp(F, I_SINK)[layer * 8 + kvh * 4 + hh]; float m = sk[hh];
#pragma unroll
        for (int s = 0; s < 9; ++s) { sc[s][hh] *= 0.08838834764831845f; if (s * 64 + lane < nk) m = fmaxf(m, sc[s][hh]); }
        mx[hh] = wave_max(m, F.lane); }
#pragma unroll
    for (int hh = 0; hh < 4; ++hh) { float su = 0.f;
#pragma unroll
        for (int s = 0; s < 9; ++s) { const float e = (s * 64 + lane < nk) ? __expf(sc[s][hh] - mx[hh]) : 0.f; sc[s][hh] = e; su += e; }
        sum[hh] = 1.0f / (wave_sum(su, F.lane) + __expf(sk[hh] - mx[hh])); }
#pragma unroll
    for (int s = 0; s < 9; ++s) { const int kidx = s * 64 + lane; if (kidx < nk) *(LAS f32x4*)(pl + kidx * 4) = (f32x4){sc[s][0] * sum[0], sc[s][1] * sum[1], sc[s][2] * sum[2], sc[s][3] * sum[3]}; }
    LDS_WAIT(); asm volatile("" ::: "memory");
    float o0[4] = {0.f, 0.f, 0.f, 0.f}, o1[4] = {0.f, 0.f, 0.f, 0.f};
    const bf16* vbase = P + C_SWA + 1280 + kvh * 128 + 2 * lane;
#pragma unroll 4
    for (int k = 0; k < nwin; ++k) { const unsigned vw = *(const unsigned*)(vbase + (size_t)(wrow0 + k) * LDP); const f32x4 p = *(const LAS f32x4*)(pl + k * 4);
        const float v0 = __uint_as_float(vw << 16), v1 = __uint_as_float(vw & 0xffff0000u);
        o0[0] += p.x * v0; o1[0] += p.x * v1; o0[1] += p.y * v0; o1[1] += p.y * v1; o0[2] += p.z * v0; o1[2] += p.z * v1; o0[3] += p.w * v0; o1[3] += p.w * v1; }
#pragma unroll 4
    for (int k = 0; k < TCX; ++k) { const unsigned vw = *(const unsigned*)(vbase + (size_t)(crow0 + k) * LDP); const f32x4 p = *(const LAS f32x4*)(pl + (nwin + k) * 4);
        const float v0 = __uint_as_float(vw << 16), v1 = __uint_as_float(vw & 0xffff0000u);
        o0[0] += p.x * v0; o1[0] += p.x * v1; o0[1] += p.y * v0; o1[1] += p.y * v1; o0[2] += p.z * v0; o1[2] += p.z * v1; o0[3] += p.w * v0; o1[3] += p.w * v1; }
    bf16* yo = wsp<bf16>(F, WS_Y) + (size_t)row * 3072 + 1024 + kvh * 512 + 2 * lane;
#pragma unroll
    for (int hh = 0; hh < 4; ++hh) *(unsigned*)(yo + hh * 128) = pk2(o0[hh], o1[hh]);
    LDS_WAIT(); asm volatile("" ::: "memory");
}
__device__ __forceinline__ void mix_phase(Frame& F, int layer) {
    if (F.wg < 64) ret_scan_unit(F, layer, F.wg);
    else if (F.wg < 192) rwkv_scan_unit(F, layer, F.wg - 64);
    const int nrow = (layer == NL - 1) ? ML : MT;
    const int nchunk = nrow * 2 / 32;
    volatile LAS int* qslot = (volatile LAS int*)(F.lds + LDSCTL_OFF);
    LAS float* wl = (LAS float*)(F.lds + F.wave * 12288);
    for (;;) {
        __syncthreads();
        if (F.tid == 0) qslot[0] = (int)__hip_atomic_fetch_add(F.ctl + CW_SWAQ + 64 * layer, 1u, __ATOMIC_RELAXED, __HIP_MEMORY_SCOPE_AGENT);
        __syncthreads();
        const int chunk = qslot[0];
        if (chunk >= nchunk) break;
        for (int i = 0; i < 4; ++i) { const int wu = chunk * 32 + F.wave * 4 + i; swa_wave_unit(F, layer, wu >> 1, wu & 1, wl); }
    }
}
__device__ __forceinline__ void mixfin_phase(Frame& F, int layer, int nrows) {
    const int gw = F.wg * NWAVES + F.wave, NGW = F.G * NWAVES; const int lane = F.lane;
    const bf16* P = wsp<bf16>(F, WS_P); const float* XS = wsp<float>(F, WS_XS); const float* LR = wsp<float>(F, WS_LR);
    const float* Y0 = wsp<float>(F, WS_YDR); const float* Y1 = Y0 + (size_t)MT * BW; const float* Z0 = wsp<float>(F, WS_YDW); const float* Z1 = Z0 + (size_t)MT * BW;
    for (int row = gw; row < nrows; row += NGW) {
        bf16* yo = wsp<bf16>(F, WS_Y) + (size_t)row * 3072;
        for (int h = 0; h < 8; ++h) { const size_t o = (size_t)row * BW + h * 128 + 2 * lane;
            const f32x2 a = *(const f32x2*)(Y0 + o), b2 = *(const f32x2*)(Y1 + o); const float y0 = a.x + b2.x, y1 = a.y + b2.y;
            const float mean = wave_sum(y0 + y1, F.lane) * (1.0f / 128.0f); const float d0 = y0 - mean, d1 = y1 - mean;
            const float var = wave_sum(d0 * d0 + d1 * d1, F.lane) * (1.0f / 128.0f); const float rs = 1.0f / sqrtf(var + 1e-5f);
            const unsigned gw2 = *(const unsigned*)(P + (size_t)row * LDP + C_RET + 3072 + h * 128 + 2 * lane);
            const float g0 = __uint_as_float(gw2 << 16), g1 = __uint_as_float(gw2 & 0xffff0000u);
            *(unsigned*)(yo + h * 128 + 2 * lane) = pk2(g0 * sigm(g0) * d0 * rs, g1 * sigm(g1) * d1 * rs); }
        for (int h = 0; h < 16; ++h) { const int c = h * 64 + lane; const size_t o = (size_t)row * BW + c;
            const float y = Z0[o] + Z1[o];
            const float mean = wave_sum(y, F.lane) * (1.0f / 64.0f); const float d = y - mean; const float var = wave_sum(d * d, F.lane) * (1.0f / 64.0f); const float rs = 1.0f / sqrtf(var + 64e-5f);
            const float r = XS[(size_t)row * 3072 + c], k = XS[(size_t)row * 3072 + 1024 + c], v = XS[(size_t)row * 3072 + 2048 + c];
            const float ka = inp(F, I_KA)[layer * BW + c], rk = inp(F, I_RK)[layer * BW + c];
            const float a0 = sigm(inp(F, I_A0)[((size_t)layer * 2 + 0) * BW + c] + LR[(size_t)row * NLR + 2048 + c]);
            const float a1 = sigm(inp(F, I_A0)[((size_t)layer * 2 + 1) * BW + c] + LR[(size_t)row * NLR + 3072 + c]);
            const float kd0 = k * (1.0f + (a0 - 1.0f) * ka), kd1 = k * (1.0f + (a1 - 1.0f) * ka);
            const float dot = wave_sum(r * (kd0 + kd1) * rk, F.lane);
            const float g = LR[(size_t)row * NLR + 4096 + c];
            const float outv = (d * rs * inp(F, I_LNG)[layer * BW + c] + dot * v) * g;
            const float nb = shx(outv, 1, F.lane);
            if (!(lane & 1)) *(unsigned*)(yo + 2048 + c) = pk2(outv, nb); }
    }
}

constexpr int NPH = 11;
constexpr int NSTEPS = 2 + NL * NPH + 1;
__global__ void __launch_bounds__(NTHR, 2) hyb_fwd(Args args) {
    extern __shared__ __attribute__((aligned(16))) unsigned char lds[];
    Frame F;
    F.lds = (LAS unsigned char*)lds;
    F.tid = threadIdx.x; F.lane = F.tid & 63; F.wave = __builtin_amdgcn_readfirstlane(F.tid >> 6);
    F.G = gridDim.x; F.wg = blockIdx.x; F.ws = args.ws; F.ctl = (unsigned*)(args.ws + WS_CTL);
    for (int u = F.tid; u < (LDS_BYTES - LDSCTL_OFF) / 4; u += NTHR) ((LAS unsigned*)(F.lds + LDSCTL_OFF))[u] = 0u;
    __syncthreads();
    if (F.tid < 26) { const __attribute__((address_space(4))) unsigned long long* kp = (const __attribute__((address_space(4))) unsigned long long*)__builtin_amdgcn_kernarg_segment_ptr();
        ((LAS unsigned long long*)(F.lds + PTAB_OFF))[F.tid] = kp[F.tid]; }
    __syncthreads();
    XcdBarrier bar = xcd_barrier_post(F.ctl + CW_BAR, (volatile LAS unsigned*)(F.lds + MISC_OFF) + 8);
    int lo = args.s_lo, hi = args.s_hi;
#define IN(k) (lo <= (k) && (k) < hi)
#define SL() asm volatile("" : "+s"(lo), "+s"(hi), "+s"(F.ws), "+s"(F.wg), "+s"(F.G))
#define LAUNDER() do { int t_ = threadIdx.x; asm volatile("" : "+v"(t_)); F.tid = t_; F.lane = t_ & 63; F.wave = __builtin_amdgcn_readfirstlane(t_ >> 6); } while (0)
#define SEAM(k) do { SL(); if (IN(k) && IN((k) + 1)) xcd_barrier(bar); } while (0)
    SL(); if (IN(0)) { LAUNDER(); p0_prologue(F); }
    SEAM(0);
    SL(); if (IN(1)) { LAUNDER(); p1_modreduce(F); }
    SEAM(1);
    for (int layer_ = 0; layer_ < NL; ++layer_) {
        int layer = layer_; asm volatile("" : "+s"(layer));
        const int s0 = 2 + layer * NPH;
        const int mrows = (layer == NL - 1) ? ML : MT;
        const float* modl = wsp<float>(F, WS_MOD) + (size_t)layer * 5 * 12288;
        SL(); if (IN(s0 + 0)) { LAUNDER(); norm_phase(F, layer, 0, MT); }
        SEAM(s0 + 0);
        SL(); if (IN(s0 + 1)) {
            pg8::Gemm g{wsp<bf16>(F, WS_U), wsp<bf16>(F, WS_WIN + layer * SZ_WIN), MT, LDP, DM, DM, DM}; pg8::StaticOrder S; S.init(MT, LDP, F.G, F.wg);
            pg8::EpiBf16<0> E{wsp<bf16>(F, WS_P), LDP};
            pg8::gemm_phase<pg8::EpiBf16<0>, pg8::StaticOrder, true, true>(F.lds, g, S, E);
        }
        SEAM(s0 + 1);
        SL(); if (IN(s0 + 2)) { LAUNDER(); prep_phase(F, layer); }
        SEAM(s0 + 2);
        SL(); if (IN(s0 + 3)) {
            pg8::Gemm g{wsp<bf16>(F, WS_ALR), wsp<bf16>(F, WS_WLR + layer * SZ_WLR), MT, NLR, KLR, KLR, KLR}; pg8::StaticOrder S; S.init(MT, NLR, F.G, F.wg);
            pg8::EpiF32 E{wsp<float>(F, WS_LR), NLR};
            pg8::gemm_phase<pg8::EpiF32, pg8::StaticOrder, true, true>(F.lds, g, S, E);
        }
        SEAM(s0 + 3);
        SL(); if (IN(s0 + 4)) { LAUNDER(); mix_phase(F, layer); }
        SEAM(s0 + 4);
        SL(); if (IN(s0 + 5)) { LAUNDER(); mixfin_phase(F, layer, mrows); }
        SEAM(s0 + 5);
        SL(); if (IN(s0 + 6)) {
            const bf16* wbr = wsp<bf16>(F, WS_WBR + layer * SZ_WBR);
            pg8::StaticOrder S; S.init(mrows, DM, F.G, F.wg);
            { pg8::Gemm g{wsp<bf16>(F, WS_Y), wbr, mrows, DM, BW, 3072, BW}; pg8::EpiGate<0> E{wsp<bf16>(F, WS_P) + C_GATE, LDP, wsp<float>(F, WS_MGF), wsp<bf16>(F, WS_MG)};
              pg8::gemm_phase<pg8::EpiGate<0>, pg8::StaticOrder, true, true>(F.lds, g, S, E); }
            { pg8::Gemm g{wsp<bf16>(F, WS_Y) + 1024, wbr + (size_t)DM * BW, mrows, DM, BW, 3072, BW}; pg8::EpiGate<1> E{wsp<bf16>(F, WS_P) + C_GATE + 2048, LDP, wsp<float>(F, WS_MGF), wsp<bf16>(F, WS_MG)};
              pg8::gemm_phase<pg8::EpiGate<1>, pg8::StaticOrder, true, true>(F.lds, g, S, E); }
            { pg8::Gemm g{wsp<bf16>(F, WS_Y) + 2048, wbr + (size_t)2 * DM * BW, mrows, DM, BW, 3072, BW}; pg8::EpiGate<2> E{wsp<bf16>(F, WS_P) + C_GATE + 4096, LDP, wsp<float>(F, WS_MGF), wsp<bf16>(F, WS_MG)};
              pg8::gemm_phase<pg8::EpiGate<2>, pg8::StaticOrder, true, true>(F.lds, g, S, E); }
        }
        SEAM(s0 + 6);
        SL(); if (IN(s0 + 7)) {
            pg8::Gemm g{wsp<bf16>(F, WS_MG), wsp<bf16>(F, WS_WOUT + layer * SZ_WOUT), mrows, DM, DM, DM, DM}; pg8::StaticOrder S; S.init(mrows, DM, F.G, F.wg);
            pg8::EpiResGate E{wsp<float>(F, WS_H), modl, 2 * DM};
            pg8::gemm_phase<pg8::EpiResGate, pg8::StaticOrder, true, true>(F.lds, g, S, E);
        }
        SEAM(s0 + 7);
        SL(); if (IN(s0 + 8)) { LAUNDER(); norm_phase(F, layer, 1, mrows); }
        SEAM(s0 + 8);
        SL(); if (IN(s0 + 9)) {
            pg8::Gemm g{wsp<bf16>(F, WS_U), wsp<bf16>(F, WS_WFF1 + layer * SZ_WFF), mrows, DFF, DM, DM, DM}; pg8::StaticOrder S; S.init(mrows, DFF, F.G, F.wg);
            pg8::EpiBf16<2> E{wsp<bf16>(F, WS_F), DFF};
            pg8::gemm_phase<pg8::EpiBf16<2>, pg8::StaticOrder, true, true>(F.lds, g, S, E);
        }
        SEAM(s0 + 9);
        SL(); if (IN(s0 + 10)) {
            pg8::Gemm g{wsp<bf16>(F, WS_F), wsp<bf16>(F, WS_WFF2 + layer * SZ_WFF), mrows, DM, DFF, DFF, DFF}; pg8::StaticOrder S; S.init(mrows, DM, F.G, F.wg);
            pg8::EpiResGate E{wsp<float>(F, WS_H), modl, 5 * DM};
            pg8::gemm_phase<pg8::EpiResGate, pg8::StaticOrder, true, true>(F.lds, g, S, E);
        }
        SEAM(s0 + 10);
    }
    SL(); if (IN(NSTEPS - 1)) { LAUNDER(); final_norm(F, args.out); }
#undef IN
#undef SL
#undef LAUNDER
#undef SEAM
}

#ifndef MK_ONE_LAUNCH
#define MK_ONE_LAUNCH 0
#endif
extern "C" void kernel_launch(void* const* d_in, const int* in_sizes, int n_in, void* d_out, int out_size, void* d_ws, size_t ws_size, hipStream_t stream) {
    static int grid = 0;
    if (grid == 0) {
        if (n_in != 26 || out_size != ML * DM || ws_size < WS_END) { fprintf(stderr, "kernel_launch: unexpected shapes (n_in %d, out %d, ws %zu < %zu)\n", n_in, out_size, ws_size, (size_t)WS_END); grid = -1; return; }
        int dev = 0, cus = 0, per_cu = 0;
        if (hipGetDevice(&dev) != hipSuccess || hipDeviceGetAttribute(&cus, hipDeviceAttributeMultiprocessorCount, dev) != hipSuccess) { grid = -1; return; }
        if (hipFuncSetAttribute((const void*)hyb_fwd, hipFuncAttributeMaxDynamicSharedMemorySize, LDS_BYTES) != hipSuccess) { fprintf(stderr, "kernel_launch: hipFuncSetAttribute failed\n"); grid = -1; return; }
        if (hipOccupancyMaxActiveBlocksPerMultiprocessor(&per_cu, (const void*)hyb_fwd, NTHR, LDS_BYTES) != hipSuccess || per_cu < 1) fprintf(stderr, "kernel_launch: occupancy query reports %d\n", per_cu);
        (void)hipGetLastError();
        grid = cus;
    }
    if (grid < 0) return;
    if (hipMemsetAsync((char*)d_ws + WS_CTL, 0, CTL_ZERO_BYTES, stream) != hipSuccess) return;
    Args a{};
    for (int i = 0; i < 26; ++i) a.in[i] = (const float*)d_in[i];
    a.out = (float*)d_out; a.ws = (unsigned char*)d_ws;
#if MK_ONE_LAUNCH
    a.s_lo = 0; a.s_hi = NSTEPS;
    hipLaunchKernelGGL(hyb_fwd, dim3(grid), dim3(NTHR), LDS_BYTES, stream, a);
#else
    for (int s = 0; s < NSTEPS; ++s) { a.s_lo = s; a.s_hi = s + 1; hipLaunchKernelGGL(hyb_fwd, dim3(grid), dim3(NTHR), LDS_BYTES, stream, a); }
#endif
}
```

```cpp
#include <hip/hip_runtime.h>
#include <cstdio>
#include <cstdint>
namespace pg8 {
#define PG8_LAS __attribute__((address_space(3)))
typedef unsigned short bf16_t;
typedef short bf16x8 __attribute__((ext_vector_type(8)));
typedef float f32x4 __attribute__((ext_vector_type(4)));
typedef unsigned u32x4 __attribute__((ext_vector_type(4)));
constexpr int BM = 256, BK = 64, HALF = 128, HTB = HALF * BK * 2  , STAGE_BYTES = 8 * HTB, NXCD = 8, WGM = 8;

__host__ __device__ __forceinline__ int lds_byte(int r, int c) { const int st = (r >> 4) * 2 + (c >> 5), rr = r & 15, cc = c & 31, ob = rr * 64 + cc * 2; return st * 1024 + (ob ^ (((ob >> 9) & 1) << 5)); }
__host__ __device__ __forceinline__ void stage_rc(int b, int& R, int& C) { const int st = b / 1024, sb = b % 1024, swz = sb ^ (((sb >> 9) & 1) << 5); R = (st >> 1) * 16 + swz / 64; C = (st & 1) * 32 + (swz % 64) / 2; }
__host__ __device__ __forceinline__ int perm32(int rho) { const int n = rho >> 4, i = rho & 15; return 8 * (i >> 2) + 4 * n + (i & 3); }

struct Unit { int pm, pn; };
struct Gemm { const bf16_t* A; const bf16_t* Bt; int M, N, K, lda, ldb; };

struct StaticOrder {
    int nM, nN, nwg, G, c;
    __host__ __device__ void init(int M, int N, int G_, int c_) { nM = M / BM; nN = N / BM; nwg = nM * nN; G = G_; c = c_; }
    __host__ __device__ bool next(int i, Unit& u) const {
        const long L = (long)i * G + c; if (L >= nwg) return false;
        int wgid = (int)L; { const int q = nwg / NXCD, r = nwg % NXCD, xcd = wgid % NXCD, off = wgid / NXCD; wgid = (xcd < r ? xcd * (q + 1) : r * (q + 1) + (xcd - r) * q) + off; }
        const int nig = WGM * nN, gid = wgid / nig, fm = gid * WGM, gsz = (nM - fm) < WGM ? (nM - fm) : WGM;
        u.pm = fm + ((wgid % nig) % gsz); u.pn = (wgid % nig) / gsz; return true;
    }
    __device__ __forceinline__ void a_ready(const Unit&) const {}
    __device__ __forceinline__ void done(const Unit&) const {}
};

__device__ __forceinline__ unsigned cvt_pk_bf16(float lo, float hi) { unsigned r; asm volatile("v_cvt_pk_bf16_f32 %0, %1, %2" : "=v"(r) : "v"(lo), "v"(hi)); return r; }
typedef float f32x2 __attribute__((ext_vector_type(2)));
__device__ __forceinline__ float sigmoidf_(float x) { return 1.0f / (1.0f + __expf(-x)); }
__device__ __forceinline__ float bf_lo(unsigned w) { return __uint_as_float(w << 16); }
__device__ __forceinline__ float bf_hi(unsigned w) { return __uint_as_float(w & 0xffff0000u); }

template <int ACT> struct EpiBf16 {
    static constexpr bool PERM = true, AFTER_DRAIN = false;
    bf16_t* O; int ldc;
    __device__ __forceinline__ void operator()(const f32x4 (&acc)[2][2][4][2], const Unit& u, int wr, int wc, int fr, int fq) const {
        const int row0 = u.pm * BM + wr * 64 + fr; const int col0 = u.pn * BM + wc * 32 + 8 * fq;
#pragma unroll
        for (int ai = 0; ai < 2; ++ai)
#pragma unroll
            for (int m = 0; m < 4; ++m) { bf16_t* rowp = O + (size_t)(row0 + ai * HALF + m * 16) * ldc + col0;
#pragma unroll
                for (int bj = 0; bj < 2; ++bj) { f32x4 v0 = acc[ai][bj][m][0], v1 = acc[ai][bj][m][1];
                    if (ACT == 2) {
#pragma unroll
                        for (int e = 0; e < 4; ++e) { const float a = fmaxf(v0[e], 0.f), b = fmaxf(v1[e], 0.f); v0[e] = a * a; v1[e] = b * b; } }
                    u32x4 w; w.x = cvt_pk_bf16(v0[0], v0[1]); w.y = cvt_pk_bf16(v0[2], v0[3]); w.z = cvt_pk_bf16(v1[0], v1[1]); w.w = cvt_pk_bf16(v1[2], v1[3]);
                    *(u32x4*)(rowp + bj * HALF) = w; } }
    }
};
struct EpiF32 {
    static constexpr bool PERM = false, AFTER_DRAIN = false;
    float* C; int ldc;
    __device__ __forceinline__ void operator()(const f32x4 (&acc)[2][2][4][2], const Unit& u, int wr, int wc, int fr, int fq) const {
        const int row0 = u.pm * BM + wr * 64 + fr, col0 = u.pn * BM + wc * 32 + 4 * fq;
#pragma unroll
        for (int ai = 0; ai < 2; ++ai)
#pragma unroll
            for (int m = 0; m < 4; ++m) { float* rowp = C + (size_t)(row0 + ai * HALF + m * 16) * ldc + col0;
#pragma unroll
                for (int bj = 0; bj < 2; ++bj)
#pragma unroll
                    for (int n = 0; n < 2; ++n) *(f32x4*)(rowp + bj * HALF + n * 16) = acc[ai][bj][m][n]; }
    }
};
template <int MODE> struct EpiGate {
    static constexpr bool PERM = true, AFTER_DRAIN = false;
    const bf16_t* G; int ldg;
    float* part; bf16_t* out;
    __device__ __forceinline__ void operator()(const f32x4 (&acc)[2][2][4][2], const Unit& u, int wr, int wc, int fr, int fq) const {
        const int row0 = u.pm * BM + wr * 64 + fr; const int col0 = u.pn * BM + wc * 32 + 8 * fq;
#pragma unroll
        for (int ai = 0; ai < 2; ++ai)
#pragma unroll
            for (int m = 0; m < 4; ++m) { const size_t row = (size_t)(row0 + ai * HALF + m * 16);
#pragma unroll
                for (int bj = 0; bj < 2; ++bj) { const int c = col0 + bj * HALF;
                    const u32x4 gw = *(const u32x4*)(G + row * ldg + c);
                    f32x4 g0, g1; g0[0] = sigmoidf_(bf_lo(gw.x)); g0[1] = sigmoidf_(bf_hi(gw.x)); g0[2] = sigmoidf_(bf_lo(gw.y)); g0[3] = sigmoidf_(bf_hi(gw.y));
                    g1[0] = sigmoidf_(bf_lo(gw.z)); g1[1] = sigmoidf_(bf_hi(gw.z)); g1[2] = sigmoidf_(bf_lo(gw.w)); g1[3] = sigmoidf_(bf_hi(gw.w));
                    f32x4 v0 = acc[ai][bj][m][0] * g0, v1 = acc[ai][bj][m][1] * g1;
                    float* pp = part + row * 2048 + c;
                    if (MODE >= 1) { v0 += *(const f32x4*)pp; v1 += *(const f32x4*)(pp + 4); }
                    if (MODE <= 1) { *(f32x4*)pp = v0; *(f32x4*)(pp + 4) = v1; }
                    else { u32x4 w; w.x = cvt_pk_bf16(v0[0], v0[1]); w.y = cvt_pk_bf16(v0[2], v0[3]); w.z = cvt_pk_bf16(v1[0], v1[1]); w.w = cvt_pk_bf16(v1[2], v1[3]);
                        *(u32x4*)(out + row * 2048 + c) = w; } } }
    }
};
struct EpiResGate {
    static constexpr bool PERM = false, AFTER_DRAIN = false;
    float* H; const float* modl; int goff;
    __device__ __forceinline__ void operator()(const f32x4 (&acc)[2][2][4][2], const Unit& u, int wr, int wc, int fr, int fq) const {
        const int mr = u.pm < 32 ? (u.pm >> 3) : 4;
        const int row0 = u.pm * BM + wr * 64 + fr, col0 = u.pn * BM + wc * 32 + 4 * fq;
        const float* gv = modl + (size_t)mr * 12288 + goff + col0;
        f32x4 gg[2][2];
#pragma unroll
        for (int bj = 0; bj < 2; ++bj)
#pragma unroll
            for (int n = 0; n < 2; ++n) gg[bj][n] = *(const f32x4*)(gv + bj * HALF + n * 16);
#pragma unroll
        for (int ai = 0; ai < 2; ++ai)
#pragma unroll
            for (int m = 0; m < 4; ++m) { float* rowp = H + (size_t)(row0 + ai * HALF + m * 16) * 2048 + col0;
#pragma unroll
                for (int bj = 0; bj < 2; ++bj)
#pragma unroll
                    for (int n = 0; n < 2; ++n) { f32x4* p = (f32x4*)(rowp + bj * HALF + n * 16); *p = *p + gg[bj][n] * acc[ai][bj][m][n]; } }
    }
};

template <class Epi, class Sched, bool ALIGN_EPI = false, bool SP2 = false>
__device__ __forceinline__ void gemm_phase(PG8_LAS unsigned char* lds, const Gemm g, const Sched& S, const Epi& E) {
    int tid_ = threadIdx.x; asm volatile("" : "+v"(tid_));
    const int tid = tid_, wid = __builtin_amdgcn_readfirstlane(tid >> 6), lane = tid & 63, wr = wid >> 2, wc = wid & 3, fr = lane & 15, fq = lane >> 4;
    const int K = g.K, nt = K / BK;
    unsigned voffA[2], voffB[2];
#pragma unroll
    for (int i = 0; i < 2; ++i) { int R, C; stage_rc(tid * 16 + i * 8192, R, C); const int Rb = Epi::PERM ? ((R & ~31) + perm32(R & 31)) : R;
        voffA[i] = (unsigned)(R * g.lda + C) * 2u; voffB[i] = (unsigned)(Rb * g.ldb + C) * 2u; }
    const size_t kstep = (size_t)(BK * 2);
    const size_t hstepA = (size_t)HALF * g.lda * 2, hstepB = (size_t)HALF * g.ldb * 2;
    const size_t tstepA = 2 * hstepA, tstepB = 2 * hstepB;
    const unsigned ldsw = (unsigned)wid * 1024u;
    const int aoff = lds_byte(wr * 64 + fr, fq * 8), boff = lds_byte(wc * 32 + fr, fq * 8);
#define PG8_SA(b, h) (((b) * 2 + (h)) * HTB)
#define PG8_SB(b, h) ((4 + (b) * 2 + (h)) * HTB)
#define PG8_STAGE(bufoff, gbase, voff) do { _Pragma("unroll") for (int _i = 0; _i < 2; ++_i) \
        __builtin_amdgcn_global_load_lds((const unsigned*)((const char*)(gbase) + (voff)[_i]), (PG8_LAS unsigned*)(lds + (bufoff) + ldsw + _i * 8192), 16, 0, 0); } while (0)
#define PG8_LDA(dst, b, h) do { _Pragma("unroll") for (int m = 0; m < 4; ++m) _Pragma("unroll") for (int k = 0; k < 2; ++k) dst[m][k] = *(const PG8_LAS bf16x8*)(lds + PG8_SA(b, h) + aoff + m * 2048 + k * 1024); } while (0)
#define PG8_LDB(dst, b, h) do { _Pragma("unroll") for (int n = 0; n < 2; ++n) _Pragma("unroll") for (int k = 0; k < 2; ++k) dst[n][k] = *(const PG8_LAS bf16x8*)(lds + PG8_SB(b, h) + boff + n * 2048 + k * 1024); } while (0)
#define PG8_MMA(ai, bj, At, Bt) do { __builtin_amdgcn_s_setprio(1); _Pragma("unroll") for (int m = 0; m < 4; ++m) _Pragma("unroll") for (int n = 0; n < 2; ++n) _Pragma("unroll") for (int k = 0; k < 2; ++k) \
        acc[ai][bj][m][n] = __builtin_amdgcn_mfma_f32_16x16x32_bf16(Bt[n][k], At[m][k], acc[ai][bj][m][n], 0, 0, 0); __builtin_amdgcn_s_setprio(0); } while (0)
#define PG8_WAIT_V(n) asm volatile("s_waitcnt vmcnt(" #n ")" ::: "memory")
#define PG8_WAIT_L(n) asm volatile("s_waitcnt lgkmcnt(" #n ")" ::: "memory")
#define PG8_BAR __builtin_amdgcn_s_barrier()
#define PG8_SCHED __builtin_amdgcn_sched_barrier(0)
    Unit cur, nxt; int ui = 0;
    if (!S.next(0, cur)) return;
    f32x4 acc[2][2][4][2];
#pragma unroll
    for (int a = 0; a < 2; ++a)
#pragma unroll
        for (int b = 0; b < 2; ++b)
#pragma unroll
            for (int m = 0; m < 4; ++m)
#pragma unroll
                for (int n = 0; n < 2; ++n) acc[a][b][m][n] = (f32x4){0.f, 0.f, 0.f, 0.f};
    bf16x8 At[4][2], B0[2][2], B1[2][2];
    const char* cA = (const char*)g.A + (size_t)cur.pm * tstepA; const char* cB = (const char*)g.Bt + (size_t)cur.pn * tstepB;
    S.a_ready(cur);
    if constexpr (SP2) {
        PG8_STAGE(PG8_SB(0, 0), cB, voffB); PG8_STAGE(PG8_SB(0, 1), cB + hstepB, voffB); PG8_STAGE(PG8_SA(0, 0), cA, voffA); PG8_STAGE(PG8_SA(0, 1), cA + hstepA, voffA);
        if (wr == 1) PG8_BAR;
        PG8_WAIT_V(2); PG8_BAR;
        PG8_STAGE(PG8_SB(1, 0), cB + kstep, voffB); PG8_STAGE(PG8_SA(1, 0), cA + kstep, voffA); PG8_STAGE(PG8_SB(1, 1), cB + hstepB + kstep, voffB);
        PG8_WAIT_V(6); PG8_BAR;
    } else {
        PG8_STAGE(PG8_SB(0, 0), cB, voffB); PG8_STAGE(PG8_SA(0, 0), cA, voffA); PG8_STAGE(PG8_SB(0, 1), cB + hstepB, voffB); PG8_STAGE(PG8_SA(0, 1), cA + hstepA, voffA);
        if (wr == 1) PG8_BAR;
        PG8_WAIT_V(4); PG8_BAR;
        PG8_STAGE(PG8_SB(1, 0), cB + kstep, voffB); PG8_STAGE(PG8_SA(1, 0), cA + kstep, voffA); PG8_STAGE(PG8_SB(1, 1), cB + hstepB + kstep, voffB);
        PG8_WAIT_V(6); PG8_BAR;
    }
    for (;;) {
        const bool has_next = S.next(ui + 1, nxt);
        const char* nA = has_next ? (const char*)g.A + (size_t)nxt.pm * tstepA : cA; const char* nB = has_next ? (const char*)g.Bt + (size_t)nxt.pn * tstepB : cB;
        for (int t = 0; t < nt; t += 2) {
            const bool last = (t == nt - 2);
            const char* a1 = cA + (size_t)(t + 1) * kstep;
            const char* a2 = last ? nA : cA + (size_t)(t + 2) * kstep; const char* b2 = last ? nB : cB + (size_t)(t + 2) * kstep;
            const char* a3 = a2 + kstep; const char* b3 = b2 + kstep;
            if (last && has_next) S.a_ready(nxt);
            if constexpr (SP2) {
            PG8_LDB(B0, 0, 0); PG8_LDB(B1, 0, 1); PG8_SCHED; PG8_LDA(At, 0, 0); PG8_STAGE(PG8_SA(1, 1), a1 + hstepA, voffA);
            PG8_WAIT_V(8); PG8_WAIT_L(0); PG8_BAR; PG8_MMA(0, 0, At, B0); PG8_MMA(0, 1, At, B1); PG8_BAR; PG8_SCHED;
            PG8_LDA(At, 0, 1); PG8_STAGE(PG8_SB(0, 0), b2, voffB); PG8_STAGE(PG8_SB(0, 1), b2 + hstepB, voffB); PG8_STAGE(PG8_SA(0, 0), a2, voffA);
            PG8_WAIT_V(8); PG8_WAIT_L(0); PG8_BAR; PG8_MMA(1, 0, At, B0); PG8_MMA(1, 1, At, B1); PG8_BAR; PG8_SCHED;
            PG8_LDB(B0, 1, 0); PG8_LDB(B1, 1, 1); PG8_SCHED; PG8_LDA(At, 1, 0); PG8_STAGE(PG8_SA(0, 1), a2 + hstepA, voffA);
            PG8_WAIT_V(8); PG8_WAIT_L(0); PG8_BAR; PG8_MMA(0, 0, At, B0); PG8_MMA(0, 1, At, B1); PG8_BAR; PG8_SCHED;
            PG8_LDA(At, 1, 1); PG8_STAGE(PG8_SB(1, 0), b3, voffB); PG8_STAGE(PG8_SB(1, 1), b3 + hstepB, voffB); PG8_STAGE(PG8_SA(1, 0), a3, voffA);
            PG8_WAIT_V(8); PG8_WAIT_L(0); PG8_BAR; PG8_MMA(1, 0, At, B0); PG8_MMA(1, 1, At, B1); PG8_BAR; PG8_SCHED;
            } else {
            PG8_LDB(B0, 0, 0); PG8_SCHED; PG8_LDA(At, 0, 0); PG8_STAGE(PG8_SA(1, 1), a1 + hstepA, voffA);
            PG8_WAIT_L(8); PG8_BAR; PG8_WAIT_L(0); PG8_MMA(0, 0, At, B0); PG8_BAR; PG8_SCHED;
            PG8_LDB(B1, 0, 1); PG8_STAGE(PG8_SB(0, 0), b2, voffB);
            PG8_BAR; PG8_WAIT_L(0); PG8_MMA(0, 1, At, B1); PG8_BAR;
            PG8_LDA(At, 0, 1); PG8_STAGE(PG8_SA(0, 0), a2, voffA);
            PG8_BAR; PG8_WAIT_L(0); PG8_MMA(1, 0, At, B0); PG8_BAR; PG8_SCHED;
            PG8_STAGE(PG8_SB(0, 1), b2 + hstepB, voffB);
            PG8_WAIT_V(6); PG8_BAR; PG8_MMA(1, 1, At, B1); PG8_BAR;
            PG8_LDB(B0, 1, 0); PG8_SCHED; PG8_LDA(At, 1, 0); PG8_STAGE(PG8_SA(0, 1), a2 + hstepA, voffA);
            PG8_WAIT_L(8); PG8_BAR; PG8_WAIT_L(0); PG8_MMA(0, 0, At, B0); PG8_BAR; PG8_SCHED;
            PG8_LDB(B1, 1, 1); PG8_STAGE(PG8_SB(1, 0), b3, voffB);
            PG8_BAR; PG8_WAIT_L(0); PG8_MMA(0, 1, At, B1); PG8_BAR;
            PG8_LDA(At, 1, 1); PG8_STAGE(PG8_SA(1, 0), a3, voffA);
            PG8_BAR; PG8_WAIT_L(0); PG8_MMA(1, 0, At, B0); PG8_BAR; PG8_SCHED;
            PG8_STAGE(PG8_SB(1, 1), b3 + hstepB, voffB);
            PG8_WAIT_V(6); PG8_BAR; PG8_MMA(1, 1, At, B1); PG8_BAR;
            }
        }
        if constexpr (ALIGN_EPI) { if (wr == 0) PG8_BAR; }
        if constexpr (!Epi::AFTER_DRAIN) { int t2_ = threadIdx.x; asm volatile("" : "+v"(t2_));   E(acc, cur, wr, wc, t2_ & 15, (t2_ >> 4) & 3); S.done(cur); }
        if (!has_next) break;
#pragma unroll
        for (int a = 0; a < 2; ++a)
#pragma unroll
            for (int b = 0; b < 2; ++b)
#pragma unroll
                for (int m = 0; m < 4; ++m)
#pragma unroll
                    for (int n = 0; n < 2; ++n) acc[a][b][m][n] = (f32x4){0.f, 0.f, 0.f, 0.f};
        cur = nxt; cA = nA; cB = nB; ++ui;
        if constexpr (ALIGN_EPI) { if (wr == 1) PG8_BAR; }
    }
    PG8_WAIT_V(0);
    if constexpr (!ALIGN_EPI) { if (wr == 0) PG8_BAR; }
    PG8_BAR;
    if constexpr (Epi::AFTER_DRAIN) { E.fused(acc, cur, wr, wc, fr, fq, lds, wid, lane); S.done(cur); }
#undef PG8_SA
#undef PG8_SB
#undef PG8_STAGE
#undef PG8_LDA
#undef PG8_LDB
#undef PG8_MMA
#undef PG8_WAIT_V
#undef PG8_WAIT_L
#undef PG8_BAR
#undef PG8_SCHED
}
}

constexpr int NB = 4, TL = 2048, TCX = 256, DM = 2048, NL = 4, DFF = 8192, BW = 1024;
constexpr int ML = NB * TL, MC = NB * TCX, MT = ML + MC;
constexpr int NIN = 15232, LDP = 15360;
constexpr int C_RET = 0, C_SWA = 4096, C_RW = 5632, C_GATE = 9088, RWIN = 3456;
constexpr int NLR = 5120, KLR = 384;
constexpr int NQK = 1280;
constexpr int NSTEP = 2304, SCAN_BLK = 32;

constexpr size_t al256(size_t x) { return (x + 255) & ~(size_t)255; }
constexpr size_t WS_CTL = 0, CTL_ZERO_BYTES = 1u << 20;
constexpr size_t SZ_WIN = (size_t)LDP * DM * 2, SZ_WBR = (size_t)3 * DM * BW * 2, SZ_WOUT = (size_t)DM * DM * 2, SZ_WFF = (size_t)DFF * DM * 2, SZ_WLR = (size_t)NLR * KLR * 2;
constexpr size_t WS_WIN = CTL_ZERO_BYTES;
constexpr size_t WS_WBR = WS_WIN + NL * SZ_WIN;
constexpr size_t WS_WOUT = WS_WBR + NL * SZ_WBR;
constexpr size_t WS_WFF1 = WS_WOUT + NL * SZ_WOUT;
constexpr size_t WS_WFF2 = WS_WFF1 + NL * SZ_WFF;
constexpr size_t WS_WLR = WS_WFF2 + NL * SZ_WFF;
constexpr size_t WS_H = WS_WLR + NL * SZ_WLR;
constexpr size_t WS_U = WS_H + (size_t)MT * DM * 4;
constexpr size_t WS_P = WS_U + (size_t)MT * DM * 2;
constexpr size_t WS_Y = WS_P + (size_t)MT * LDP * 2;
constexpr size_t WS_MGF = WS_Y + (size_t)MT * 3072 * 2;
constexpr size_t WS_MG = WS_MGF + (size_t)MT * DM * 4;
constexpr size_t WS_F = WS_MG + (size_t)MT * DM * 2;
constexpr size_t WS_MODP = WS_F + (size_t)MT * DFF * 2;
constexpr size_t WS_MOD = WS_MODP + (size_t)8 * NL * 5 * 12288 * 4;
constexpr size_t WS_ROPE = WS_MOD + (size_t)NL * 5 * 12288 * 4;
constexpr size_t WS_XS = WS_ROPE + 64 * 32 * 2 * 4;
constexpr size_t WS_ALR = WS_XS + (size_t)MT * 3072 * 4;
constexpr size_t WS_LR = WS_ALR + (size_t)MT * KLR * 2;
constexpr size_t WS_QKR = WS_LR + (size_t)MT * NLR * 4;
constexpr size_t WS_YDR = WS_QKR + (size_t)MT * NQK * 4;
constexpr size_t WS_YDW = WS_YDR + (size_t)2 * MT * BW * 4;
constexpr size_t WS_END = WS_YDW + (size_t)2 * MT * BW * 4;
constexpr int CW_BAR = 4096;
constexpr int CW_SWAQ = 16384;

constexpr int RING_BYTES = 131072, LDSCTL_OFF = RING_BYTES, MISC_OFF = LDSCTL_OFF + 320, LDS_BYTES = 147456;
constexpr int NWAVES = 8, NTHR = 512;

#define GAS __attribute__((address_space(1)))
#define LAS __attribute__((address_space(3)))
typedef unsigned short bf16;
typedef float f32x4 __attribute__((ext_vector_type(4)));
typedef float f32x2 __attribute__((ext_vector_type(2)));
typedef unsigned u32x4 __attribute__((ext_vector_type(4)));
typedef unsigned u32x2 __attribute__((ext_vector_type(2)));
#define LDS_WAIT() asm volatile("s_waitcnt lgkmcnt(0)" ::: "memory")
#define VM_WAIT() asm volatile("s_waitcnt vmcnt(0)" ::: "memory")
__device__ __forceinline__ unsigned f2bf(float f) { unsigned u = __builtin_bit_cast(unsigned, f); return (u + 0x7fffu + ((u >> 16) & 1u)) >> 16; }
__device__ __forceinline__ unsigned pk2(float lo, float hi) { return f2bf(lo) | (f2bf(hi) << 16); }
__device__ __forceinline__ float bf2f(bf16 v) { return __uint_as_float((unsigned)v << 16); }
__device__ __forceinline__ float sigm(float x) { return 1.0f / (1.0f + __expf(-x)); }
__device__ __forceinline__ float shx(float v, int m, int lane) { return __int_as_float(__builtin_amdgcn_ds_bpermute((lane ^ m) << 2, __float_as_int(v))); }
__device__ __forceinline__ float wave_sum(float v, int lane) {
#pragma unroll
    for (int o = 1; o < 64; o <<= 1) v += shx(v, o, lane);
    return v;
}
__device__ __forceinline__ float wave_max(float v, int lane) {
#pragma unroll
    for (int o = 1; o < 64; o <<= 1) v = fmaxf(v, shx(v, o, lane));
    return v;
}

#define XB_TMO      128
#define XB_XCNT(j)  (256  + 64 * (j))
#define XB_XSUB(j)  (1280 + 64 * (j))
#define XB_XGEN(j)  (2304 + 64 * (j))
#define XB_TOP      3328
#define XB_TOPGEN   3392
#define XCD_BAR_WORDS 3456
#define XB_SPIN_CAP (1u << 22)
__device__ __forceinline__ unsigned xb_ld(unsigned* p)              { return __hip_atomic_load(p, __ATOMIC_RELAXED, __HIP_MEMORY_SCOPE_AGENT); }
__device__ __forceinline__ unsigned xb_add(unsigned* p, unsigned v) { return __hip_atomic_fetch_add(p, v, __ATOMIC_RELAXED, __HIP_MEMORY_SCOPE_AGENT); }
__device__ __forceinline__ unsigned xb_xcc_id() { return (unsigned)__builtin_amdgcn_s_getreg((3 << 11) | 20) & 0xFu; }
#define XB_SPIN(cond, bar) do { unsigned _sp = 0; while (cond) { __builtin_amdgcn_s_sleep(1); \
    if ((++_sp & 255u) == 0u) { if (xb_ld(&(bar)[XB_TMO])) break; if (_sp > XB_SPIN_CAP) { atomicAdd(&(bar)[XB_TMO], 1u); break; } } } } while (0)
struct XcdBarrier { unsigned* bar; unsigned x; volatile LAS unsigned* st; };
__device__ __forceinline__ XcdBarrier xcd_barrier_post(unsigned* bar, volatile LAS unsigned* st) {
    XcdBarrier b; b.bar = bar; b.x = xb_xcc_id(); b.st = st;
    if (threadIdx.x == 0) (void)xb_add(&bar[XB_XCNT(b.x)], 1u);
    return b;
}
__device__ __forceinline__ void xcd_barrier_complete(unsigned* bar, unsigned x, unsigned& nloc, unsigned& nx) {
    const unsigned G = gridDim.x * gridDim.y * gridDim.z;
    unsigned sum, cnt, mine, sp = 0u;
    for (;;) {
        sum = 0u; cnt = 0u; mine = 0u;
#pragma unroll
        for (unsigned j = 0; j < 16; ++j) { const unsigned c = xb_ld(&bar[XB_XCNT(j)]); sum += c; cnt += (c > 0u) ? 1u : 0u; mine = (j == x) ? c : mine; }
        if (sum == G) break;
        __builtin_amdgcn_s_sleep(1);
        if ((++sp & 255u) == 0u) { if (xb_ld(&bar[XB_TMO])) break; if (sp > XB_SPIN_CAP) { atomicAdd(&bar[XB_TMO], 1u); break; } }
    }
    nloc = mine > 0u ? mine : 1u; nx = cnt > 0u ? cnt : 1u;
}
__device__ __forceinline__ void xcd_barrier(const XcdBarrier& b) {
    asm volatile("s_waitcnt vmcnt(0)" ::: "memory");
    __syncthreads();
    if (threadIdx.x == 0) {
        unsigned* bar = b.bar; unsigned bx = b.x;
        asm volatile("" : "+s"(bar), "+s"(bx));
        __builtin_amdgcn_s_waitcnt(0);
        unsigned nloc = b.st[0], nx = b.st[1];
        if (nloc == 0u) { xcd_barrier_complete(bar, bx, nloc, nx); b.st[0] = nloc; b.st[1] = nx; }
        const unsigned old = xb_add(&bar[XB_XSUB(bx)], 1u);
        const unsigned gen = old / nloc;
        if (old + 1u == (gen + 1u) * nloc) {
            __builtin_amdgcn_fence(__ATOMIC_RELEASE, "agent");
            asm volatile("s_waitcnt vmcnt(0)" ::: "memory");
            const unsigned og = xb_add(&bar[XB_TOP], 1u);
            const unsigned tg = og / nx;
            if (og + 1u == (tg + 1u) * nx) xb_add(&bar[XB_TOPGEN], 1u);
            else XB_SPIN(xb_ld(&bar[XB_TOPGEN]) == tg, bar);
            __builtin_amdgcn_fence(__ATOMIC_ACQUIRE, "agent");
            xb_add(&bar[XB_XGEN(bx)], 1u);
            asm volatile("s_waitcnt vmcnt(0)" ::: "memory");
        } else {
            XB_SPIN(xb_ld(&bar[XB_XGEN(bx)]) == gen, bar);
            __builtin_amdgcn_fence(__ATOMIC_ACQUIRE, "agent");
            asm volatile("s_waitcnt vmcnt(0)" ::: "memory");
        }
    }
    __syncthreads();
}

struct Args { const float* in[26]; float* out; unsigned char* ws; int s_lo, s_hi; };
enum { I_X = 0, I_C, I_CTX, I_CCTX, I_N1G, I_N2G, I_WMOD, I_BMOD, I_WIN, I_RETDEC, I_SINK, I_MU, I_W0, I_WUP, I_A0, I_AUP, I_GUP, I_KK, I_KA, I_RK, I_LNG, I_WBR, I_WOUT, I_WFF1, I_WFF2, I_FING };
struct Frame {
    LAS unsigned char* lds;
    unsigned* ctl;
    int tid, lane, wave, G, wg;
    unsigned char* ws;
};
template <class T> __device__ __forceinline__ T* wsp(const Frame& F, size_t off) { return (T*)(F.ws + off); }
constexpr int PTAB_OFF = LDSCTL_OFF + 64;
__device__ __forceinline__ const float* inp(const Frame& F, int i) {
    const LAS unsigned* t = (const LAS unsigned*)(F.lds + PTAB_OFF) + 2 * i;
    const unsigned lo = __builtin_amdgcn_readfirstlane(t[0]), hi = __builtin_amdgcn_readfirstlane(t[1]);
    return (const float*)(((unsigned long long)hi << 32) | (unsigned long long)lo);
}

__device__ __forceinline__ int scan_row(int b, int dir, int s) {
    if (s < TCX) return ML + b * TCX + (dir ? (TCX - 1 - s) : s);
    const int t = s - TCX; return b * TL + (dir ? (TL - 1 - t) : t);
}

__device__ __forceinline__ void transpose_item(const float* W, int K, int N, bf16* WT, LAS float* scr, int item, int lane) {
    const int nblk = N / 32, kb = item / nblk, nb = item % nblk, k0 = 64 * kb, n0 = 32 * nb;
#pragma unroll 8
    for (int i = 0; i < 32; ++i) { const int kk = 2 * i + (lane >> 5); scr[kk * 33 + (lane & 31)] = W[(size_t)(k0 + kk) * N + n0 + (lane & 31)]; }
    LDS_WAIT(); asm volatile("" ::: "memory");
    const int c = lane & 7;
#pragma unroll
    for (int j = 0; j < 4; ++j) { const int n = (lane >> 3) + 8 * j; const LAS float* s = scr + (8 * c) * 33 + n;
        u32x4 o; o.x = pk2(s[0 * 33], s[1 * 33]); o.y = pk2(s[2 * 33], s[3 * 33]); o.z = pk2(s[4 * 33], s[5 * 33]); o.w = pk2(s[6 * 33], s[7 * 33]);
        *(u32x4*)(WT + (size_t)(n0 + n) * K + k0 + 8 * c) = o; }
    LDS_WAIT(); asm volatile("" ::: "memory");
}
__device__ __forceinline__ void p0_prologue(Frame& F) {
    const int gw = F.wg * NWAVES + F.wave, NGW = F.G * NWAVES;
    const int gt = F.wg * NTHR + F.tid, NGT = F.G * NTHR;
    LAS float* sil = (LAS float*)(F.lds + 81920);
    for (int e = F.tid; e < 5 * DM; e += NTHR) { const int r = e / DM, k = e % DM; const float v = r < 4 ? inp(F, I_C)[r * DM + k] : inp(F, I_CCTX)[k]; sil[e] = v * sigm(v); }
    {
        LAS float* scr = (LAS float*)(F.lds + F.wave * 8704);
        constexpr int IT_IN = (DM / 64) * (NIN / 32), IT_BR = (BW / 64) * (DM / 32), IT_OUT = (DM / 64) * (DM / 32), IT_F1 = (DM / 64) * (DFF / 32), IT_F2 = (DFF / 64) * (DM / 32);
        constexpr int IT_L = IT_IN + 3 * IT_BR + IT_OUT + IT_F1 + IT_F2;
        for (int it = gw; it < NL * IT_L; it += NGW) {
            const int l = it / IT_L; int r = it % IT_L;
            if (r < IT_IN) { transpose_item(inp(F, I_WIN) + (size_t)l * DM * NIN, DM, NIN, wsp<bf16>(F, WS_WIN + l * SZ_WIN), scr, r, F.lane); continue; } r -= IT_IN;
            if (r < 3 * IT_BR) { const int n = r / IT_BR; transpose_item(inp(F, I_WBR) + ((size_t)l * 3 + n) * BW * DM, BW, DM, wsp<bf16>(F, WS_WBR + l * SZ_WBR) + (size_t)n * DM * BW, scr, r % IT_BR, F.lane); continue; } r -= 3 * IT_BR;
            if (r < IT_OUT) { transpose_item(inp(F, I_WOUT) + (size_t)l * DM * DM, DM, DM, wsp<bf16>(F, WS_WOUT + l * SZ_WOUT), scr, r, F.lane); continue; } r -= IT_OUT;
            if (r < IT_F1) { transpose_item(inp(F, I_WFF1) + (size_t)l * DM * DFF, DM, DFF, wsp<bf16>(F, WS_WFF1 + l * SZ_WFF), scr, r, F.lane); continue; } r -= IT_F1;
            transpose_item(inp(F, I_WFF2) + (size_t)l * DFF * DM, DFF, DM, wsp<bf16>(F, WS_WFF2 + l * SZ_WFF), scr, r, F.lane);
        }
    }
    for (int e = gt; e < NL * (LDP - NIN) * DM / 8; e += NGT) { const int l = e / ((LDP - NIN) * DM / 8), r = e % ((LDP - NIN) * DM / 8);
        *(u32x4*)(wsp<bf16>(F, WS_WIN + l * SZ_WIN) + (size_t)NIN * DM + (size_t)r * 8) = (u32x4){0u, 0u, 0u, 0u}; }
    for (int e = gt; e < NL * NLR * KLR; e += NGT) {
        const int l = e / (NLR * KLR), r = e % (NLR * KLR), n = r / KLR, k = r % KLR; float v = 0.f;
        if (n < 2048) { const int d = n >> 10, c = n & 1023; if (k >= 64 * d && k < 64 * d + 64) v = inp(F, I_WUP)[(((size_t)l * 2 + d) * 64 + (k - 64 * d)) * BW + c]; }
        else if (n < 4096) { const int d = (n - 2048) >> 10, c = n & 1023; if (k >= 128 + 64 * d && k < 192 + 64 * d) v = inp(F, I_AUP)[(((size_t)l * 2 + d) * 64 + (k - 128 - 64 * d)) * BW + c]; }
        else { const int c = n - 4096; if (k >= 256) v = inp(F, I_GUP)[((size_t)l * 128 + (k - 256)) * BW + c]; }
        wsp<bf16>(F, WS_WLR + l * SZ_WLR)[r] = (bf16)f2bf(v);
    }
    { const f32x4* x4 = (const f32x4*)inp(F, I_X); const f32x4* c4 = (const f32x4*)inp(F, I_CTX); f32x4* h4 = wsp<f32x4>(F, WS_H);
      for (int e = gt; e < ML * DM / 4; e += NGT) h4[e] = x4[e];
      for (int e = gt; e < MC * DM / 4; e += NGT) h4[ML * DM / 4 + e] = c4[e]; }
    if (gt < 64 * 32) { const int pos = gt >> 5, i = gt & 31; const float inv = powf(10000.0f, -(float)i / 32.0f); const float ang = (float)pos * inv;
        wsp<float>(F, WS_ROPE)[2 * gt] = cosf(ang); wsp<float>(F, WS_ROPE)[2 * gt + 1] = sinf(ang); }
    __syncthreads();
    for (int it = gw; it < NL * 8 * 48; it += NGW) {
        const int l = it / (8 * 48), kc = (it / 48) % 8, cc = it % 48, col = cc * 256 + F.lane * 4, k0 = kc * 256;
        const float* wp = inp(F, I_WMOD) + ((size_t)l * DM + k0) * 12288 + col;
        f32x4 a0 = {0.f, 0.f, 0.f, 0.f}, a1 = a0, a2 = a0, a3 = a0, a4 = a0;
#pragma unroll 8
        for (int k = 0; k < 256; ++k) { const f32x4 w = *(const f32x4*)(wp + (size_t)k * 12288);
            a0 += sil[0 * DM + k0 + k] * w; a1 += sil[1 * DM + k0 + k] * w; a2 += sil[2 * DM + k0 + k] * w; a3 += sil[3 * DM + k0 + k] * w; a4 += sil[4 * DM + k0 + k] * w; }
        float* mp = wsp<float>(F, WS_MODP) + ((size_t)(kc * NL + l) * 5) * 12288 + col;
        *(f32x4*)(mp) = a0; *(f32x4*)(mp + 12288) = a1; *(f32x4*)(mp + 2 * 12288) = a2; *(f32x4*)(mp + 3 * 12288) = a3; *(f32x4*)(mp + 4 * 12288) = a4;
    }
}
__device__ __forceinline__ void p1_modreduce(Frame& F) {
    const int gt = F.wg * NTHR + F.tid, NGT = F.G * NTHR;
    for (int e = gt; e < NL * 5 * 12288; e += NGT) { const int l = e / (5 * 12288), j = e % 12288;
        float s = inp(F, I_BMOD)[l * 12288 + j];
#pragma unroll
        for (int kc = 0; kc < 8; ++kc) s += wsp<float>(F, WS_MODP)[(size_t)kc * NL * 5 * 12288 + e];
        wsp<float>(F, WS_MOD)[e] = s; }
}

__device__ __forceinline__ void norm_phase(Frame& F, int layer, int which, int nrows) {
    const int gw = F.wg * NWAVES + F.wave, NGW = F.G * NWAVES;
    const float* gptr = inp(F, which ? I_N2G : I_N1G) + layer * DM;
    for (int row = gw; row < nrows; row += NGW) {
        const int mr = row < ML ? (row >> 11) : 4;
        const float* mod = wsp<float>(F, WS_MOD) + ((size_t)layer * 5 + mr) * 12288 + (which ? 3 * DM : 0);
        const f32x4* xr = (const f32x4*)(wsp<float>(F, WS_H) + (size_t)row * DM) + F.lane;
        f32x4 v[8]; float ss = 0.f;
#pragma unroll
        for (int j = 0; j < 8; ++j) { v[j] = xr[64 * j]; ss += (v[j].x * v[j].x + v[j].y * v[j].y) + (v[j].z * v[j].z + v[j].w * v[j].w); }
        const float rs = 1.0f / sqrtf(wave_sum(ss, F.lane) * (1.0f / DM) + 1e-6f);
        u32x2* o = (u32x2*)(wsp<bf16>(F, WS_U) + (size_t)row * DM) + F.lane;
#pragma unroll
        for (int j = 0; j < 8; ++j) { const int c = 4 * F.lane + 256 * j;
            const f32x4 g = *(const f32x4*)(gptr + c), sh = *(const f32x4*)(mod + c), sc = *(const f32x4*)(mod + DM + c);
            const f32x4 y = (v[j] * rs) * g * (1.0f + sc) + sh;
            u32x2 w; w.x = pk2(y.x, y.y); w.y = pk2(y.z, y.w); o[64 * j] = w; }
    }
}
__device__ __forceinline__ void final_norm(Frame& F, float* out) {
    const int gw = F.wg * NWAVES + F.wave, NGW = F.G * NWAVES;
    for (int row = gw; row < ML; row += NGW) {
        const f32x4* xr = (const f32x4*)(wsp<float>(F, WS_H) + (size_t)row * DM) + F.lane;
        f32x4 v[8]; float ss = 0.f;
#pragma unroll
        for (int j = 0; j < 8; ++j) { v[j] = xr[64 * j]; ss += (v[j].x * v[j].x + v[j].y * v[j].y) + (v[j].z * v[j].z + v[j].w * v[j].w); }
        const float rs = 1.0f / sqrtf(wave_sum(ss, F.lane) * (1.0f / DM) + 1e-6f);
        f32x4* o = (f32x4*)(out + (size_t)row * DM) + F.lane;
#pragma unroll
        for (int j = 0; j < 8; ++j) { const f32x4 g = *(const f32x4*)(inp(F, I_FING) + 4 * F.lane + 256 * j); o[64 * j] = (v[j] * rs) * g; }
    }
}
__device__ __forceinline__ void prep_phase(Frame& F, int layer) {
    const int gw = F.wg * NWAVES + F.wave, NGW = F.G * NWAVES;
    const bf16* P = wsp<bf16>(F, WS_P);
    const float* mu0 = inp(F, I_MU) + (size_t)layer * 2 * RWIN; const float* mu1 = mu0 + RWIN;
    const float* rope = wsp<float>(F, WS_ROPE);
    for (int row = gw; row < MT; row += NGW) {
        bool first, last; int t = 0;
        if (row < ML) { t = row & (TL - 1); first = t == 0; last = t == TL - 1; } else { const int c = (row - ML) & (TCX - 1); first = c == 0; last = c == TCX - 1; }
        const bf16* pr = P + (size_t)row * LDP + C_RW;
        float* xs = wsp<float>(F, WS_XS) + (size_t)row * 3072; bf16* alr = wsp<bf16>(F, WS_ALR) + (size_t)row * KLR;
        for (int j2 = F.lane; j2 < RWIN / 2; j2 += 64) {
            const int c = 2 * j2;
            const unsigned pw = *(const unsigned*)(pr + c);
            const unsigned vw = first ? 0u : *(const unsigned*)(pr - LDP + c);
            const unsigned nw = last ? 0u : *(const unsigned*)(pr + LDP + c);
            const float p0 = __uint_as_float(pw << 16), p1 = __uint_as_float(pw & 0xffff0000u);
            const float v0 = __uint_as_float(vw << 16), v1 = __uint_as_float(vw & 0xffff0000u);
            const float n0 = __uint_as_float(nw << 16), n1 = __uint_as_float(nw & 0xffff0000u);
            const f32x2 m0 = *(const f32x2*)(mu0 + c), m1 = *(const f32x2*)(mu1 + c);
            const float s0 = p0 + m0.x * (v0 - p0) + m1.x * (n0 - p0), s1 = p1 + m0.y * (v1 - p1) + m1.y * (n1 - p1);
            if (c < 3072) { *(f32x2*)(xs + c) = (f32x2){s0, s1}; }
            else if (c < 3200) { *(unsigned*)(alr + (c - 3072)) = pk2(tanhf(s0), tanhf(s1)); }
            else if (c < 3328) { *(unsigned*)(alr + 128 + (c - 3200)) = pk2(s0, s1); }
            else { *(unsigned*)(alr + 256 + (c - 3328)) = pk2(sigm(s0), sigm(s1)); }
        }
        const bf16* ps = P + (size_t)row * LDP + C_SWA; float* qk = wsp<float>(F, WS_QKR) + (size_t)row * NQK;
        const bool lat = row < ML; const int rr = t >> 6, cc = t & 63;
#pragma unroll
        for (int it = 0; it < 5; ++it) { const int idx = it * 64 + F.lane, hd = idx >> 5, i = idx & 31;
            const float x1r = bf2f(ps[hd * 128 + i]), x2r = bf2f(ps[hd * 128 + 32 + i]), x1c = bf2f(ps[hd * 128 + 64 + i]), x2c = bf2f(ps[hd * 128 + 96 + i]);
            float cr = 1.f, sr = 0.f, ccs = 1.f, scs = 0.f;
            if (lat) { cr = rope[(rr * 32 + i) * 2]; sr = rope[(rr * 32 + i) * 2 + 1]; ccs = rope[(cc * 32 + i) * 2]; scs = rope[(cc * 32 + i) * 2 + 1]; }
            qk[hd * 128 + i] = x1r * cr - x2r * sr; qk[hd * 128 + 32 + i] = x2r * cr + x1r * sr;
            qk[hd * 128 + 64 + i] = x1c * ccs - x2c * scs; qk[hd * 128 + 96 + i] = x2c * ccs + x1c * scs; }
    }
}

__device__ __forceinline__ void ret_scan_unit(Frame& F, int layer, int unit) {
    const int dir = unit & 1, h = (unit >> 1) & 7, b = unit >> 4;
    const float gamma = sigm(inp(F, I_RETDEC)[(layer * 2 + dir) * 8 + h]);
    LAS float* qs = (LAS float*)F.lds; LAS float* ks = qs + 4096; LAS float* vs = ks + 4096; LAS float* yp = vs + 4096;
    const bf16* P = wsp<bf16>(F, WS_P); float* YD = wsp<float>(F, WS_YDR) + (size_t)dir * MT * BW;
    const int dv = F.tid & 127, ks4 = F.tid >> 7;
    float S[32];
#pragma unroll
    for (int i = 0; i < 32; ++i) S[i] = 0.f;
    for (int blk = 0; blk < NSTEP / SCAN_BLK; ++blk) {
        __syncthreads();
        for (int e = F.tid; e < 4096; e += NTHR) { const int tok = e >> 7, d = e & 127; const int row = scan_row(b, dir, blk * SCAN_BLK + tok);
            const bf16* pr = P + (size_t)row * LDP + C_RET + h * 128 + d;
            qs[e] = bf2f(pr[0]); ks[e] = bf2f(pr[1024]) * 0.08838834764831845f; vs[e] = bf2f(pr[2048]); }
        __syncthreads();
        for (int tok = 0; tok < SCAN_BLK; ++tok) {
            const float v = vs[tok * 128 + dv]; float y = 0.f;
            const LAS f32x4* k4 = (const LAS f32x4*)(ks + tok * 128 + 32 * ks4); const LAS f32x4* q4 = (const LAS f32x4*)(qs + tok * 128 + 32 * ks4);
#pragma unroll
            for (int i = 0; i < 8; ++i) { const f32x4 kk = k4[i], qq = q4[i];
                S[4 * i + 0] = fmaf(gamma, S[4 * i + 0], kk.x * v); y = fmaf(qq.x, S[4 * i + 0], y);
                S[4 * i + 1] = fmaf(gamma, S[4 * i + 1], kk.y * v); y = fmaf(qq.y, S[4 * i + 1], y);
                S[4 * i + 2] = fmaf(gamma, S[4 * i + 2], kk.z * v); y = fmaf(qq.z, S[4 * i + 2], y);
                S[4 * i + 3] = fmaf(gamma, S[4 * i + 3], kk.w * v); y = fmaf(qq.w, S[4 * i + 3], y); }
            yp[(tok * 4 + ks4) * 128 + dv] = y;
        }
        __syncthreads();
        for (int e = F.tid; e < 4096; e += NTHR) { const int tok = e >> 7, d = e & 127; const int row = scan_row(b, dir, blk * SCAN_BLK + tok);
            YD[(size_t)row * BW + h * 128 + d] = (yp[(tok * 4 + 0) * 128 + d] + yp[(tok * 4 + 1) * 128 + d]) + (yp[(tok * 4 + 2) * 128 + d] + yp[(tok * 4 + 3) * 128 + d]); }
    }
    __syncthreads();
}
__device__ __forceinline__ void rwkv_scan_unit(Frame& F, int layer, int unit) {
    const int dir = unit & 1, h = (unit >> 1) & 15, b = unit >> 5;
    LAS float* Rl = (LAS float*)F.lds; LAS float* Wl = Rl + 2048; LAS float* Kl = Wl + 2048; LAS float* Vl = Kl + 2048; LAS float* Al = Vl + 2048; LAS float* Bl = Al + 2048; LAS float* Yl = Bl + 2048;
    const float* XS = wsp<float>(F, WS_XS); const float* LR = wsp<float>(F, WS_LR); float* YD = wsp<float>(F, WS_YDW) + (size_t)dir * MT * BW;
    const int vrow = F.tid >> 3, kq = F.tid & 7;
    const int ptok = F.tid >> 4, pj = (F.tid & 15) * 4, pc = h * 64 + pj;
    const f32x4 w0v = *(const f32x4*)(inp(F, I_W0) + ((size_t)layer * 2 + dir) * BW + pc), a0v = *(const f32x4*)(inp(F, I_A0) + ((size_t)layer * 2 + dir) * BW + pc);
    const f32x4 kkv = *(const f32x4*)(inp(F, I_KK) + (size_t)layer * BW + pc), kav = *(const f32x4*)(inp(F, I_KA) + (size_t)layer * BW + pc);
    float S[8];
#pragma unroll
    for (int i = 0; i < 8; ++i) S[i] = 0.f;
    for (int blk = 0; blk < NSTEP / SCAN_BLK; ++blk) {
        __syncthreads();
        {
            const int row = scan_row(b, dir, blk * SCAN_BLK + ptok);
            const f32x4 r4 = *(const f32x4*)(XS + (size_t)row * 3072 + pc), k4 = *(const f32x4*)(XS + (size_t)row * 3072 + 1024 + pc), v4 = *(const f32x4*)(XS + (size_t)row * 3072 + 2048 + pc);
            const f32x4 lw = *(const f32x4*)(LR + (size_t)row * NLR + dir * 1024 + pc), la = *(const f32x4*)(LR + (size_t)row * NLR + 2048 + dir * 1024 + pc);
            f32x4 dec, av, kk, kd; float ssq = 0.f;
#pragma unroll
            for (int e = 0; e < 4; ++e) { dec[e] = __expf(-0.6065306597126334f * sigm(w0v[e] + lw[e])); av[e] = sigm(a0v[e] + la[e]); kk[e] = k4[e] * kkv[e]; ssq += kk[e] * kk[e];
                kd[e] = k4[e] * (1.0f + (av[e] - 1.0f) * kav[e]); }
            ssq += shx(ssq, 1, F.lane); ssq += shx(ssq, 2, F.lane); ssq += shx(ssq, 4, F.lane); ssq += shx(ssq, 8, F.lane);
            const float inv = 1.0f / fmaxf(sqrtf(ssq), 1e-12f);
            f32x4 an, bn;
#pragma unroll
            for (int e = 0; e < 4; ++e) { const float kn = kk[e] * inv; an[e] = -kn; bn[e] = kn * av[e]; }
            const int o = ptok * 64 + pj;
            *(LAS f32x4*)(Rl + o) = r4; *(LAS f32x4*)(Wl + o) = dec; *(LAS f32x4*)(Kl + o) = kd; *(LAS f32x4*)(Vl + o) = v4; *(LAS f32x4*)(Al + o) = an; *(LAS f32x4*)(Bl + o) = bn;
        }
        __syncthreads();
        for (int tok = 0; tok < SCAN_BLK; ++tok) {
            const int o = tok * 64 + 8 * kq;
            const f32x4 a0 = *(const LAS f32x4*)(Al + o), a1 = *(const LAS f32x4*)(Al + o + 4), w0 = *(const LAS f32x4*)(Wl + o), w1 = *(const LAS f32x4*)(Wl + o + 4);
            const f32x4 b0 = *(const LAS f32x4*)(Bl + o), b1 = *(const LAS f32x4*)(Bl + o + 4), k0 = *(const LAS f32x4*)(Kl + o), k1 = *(const LAS f32x4*)(Kl + o + 4);
            const f32x4 r0 = *(const LAS f32x4*)(Rl + o), r1 = *(const LAS f32x4*)(Rl + o + 4); const float vv = Vl[tok * 64 + vrow];
            float sa = (S[0] * a0.x + S[1] * a0.y) + (S[2] * a0.z + S[3] * a0.w) + (S[4] * a1.x + S[5] * a1.y) + (S[6] * a1.z + S[7] * a1.w);
            sa += shx(sa, 1, F.lane); sa += shx(sa, 2, F.lane); sa += shx(sa, 4, F.lane);
            S[0] = fmaf(S[0], w0.x, fmaf(sa, b0.x, vv * k0.x)); S[1] = fmaf(S[1], w0.y, fmaf(sa, b0.y, vv * k0.y)); S[2] = fmaf(S[2], w0.z, fmaf(sa, b0.z, vv * k0.z)); S[3] = fmaf(S[3], w0.w, fmaf(sa, b0.w, vv * k0.w));
            S[4] = fmaf(S[4], w1.x, fmaf(sa, b1.x, vv * k1.x)); S[5] = fmaf(S[5], w1.y, fmaf(sa, b1.y, vv * k1.y)); S[6] = fmaf(S[6], w1.z, fmaf(sa, b1.z, vv * k1.z)); S[7] = fmaf(S[7], w1.w, fmaf(sa, b1.w, vv * k1.w));
            float y = (S[0] * r0.x + S[1] * r0.y) + (S[2] * r0.z + S[3] * r0.w) + (S[4] * r1.x + S[5] * r1.y) + (S[6] * r1.z + S[7] * r1.w);
            y += shx(y, 1, F.lane); y += shx(y, 2, F.lane); y += shx(y, 4, F.lane);
            if (kq == 0) Yl[tok * 64 + vrow] = y;
        }
        __syncthreads();
        { const int e = F.tid * 4, tok = e >> 6, j = e & 63; const int row = scan_row(b, dir, blk * SCAN_BLK + tok);
          *(f32x4*)(YD + (size_t)row * BW + h * 64 + j) = *(const LAS f32x4*)(Yl + e); }
    }
    __syncthreads();
}
__device__ __forceinline__ void swa_wave_unit(Frame& F, int layer, int row, int kvh, LAS float* wl) {
    const float* QKR = wsp<float>(F, WS_QKR); const bf16* P = wsp<bf16>(F, WS_P);
    LAS float* ql = wl;
    LAS float* pl = wl + 512;
    const int lane = F.lane;
    int nwin, wrow0, crow0;
    if (row < ML) { const int b = row >> 11, t = row & (TL - 1); const int lo = t - 128 < 0 ? 0 : t - 128, hi = t + 128 > TL - 1 ? TL - 1 : t + 128; nwin = hi - lo + 1; wrow0 = b * TL + lo; crow0 = ML + b * TCX; }
    else { const int b = (row - ML) >> 8; nwin = 0; wrow0 = 0; crow0 = ML + b * TCX; }
    const int nk = nwin + TCX;
#pragma unroll
    for (int j = 0; j < 2; ++j) *(LAS f32x4*)(ql + (j * 64 + lane) * 4) = *(const f32x4*)(QKR + (size_t)row * NQK + kvh * 512 + (j * 64 + lane) * 4);
    LDS_WAIT(); asm volatile("" ::: "memory");
    float sc[9][4];
#pragma unroll
    for (int s = 0; s < 9; ++s) { sc[s][0] = 0.f; sc[s][1] = 0.f; sc[s][2] = 0.f; sc[s][3] = 0.f; }
    const float* kp[9];
#pragma unroll
    for (int s = 0; s < 9; ++s) { const int kidx = s * 64 + lane; const int kr = kidx < nwin ? wrow0 + kidx : crow0 + (kidx - nwin); kp[s] = QKR + (size_t)(kidx < nk ? kr : crow0) * NQK + 1024 + kvh * 128; }
    for (int dc = 0; dc < 8; ++dc) {
        f32x4 q[4][4];
#pragma unroll
        for (int hh = 0; hh < 4; ++hh)
#pragma unroll
            for (int e = 0; e < 4; ++e) q[hh][e] = *(const LAS f32x4*)(ql + hh * 128 + dc * 16 + e * 4);
#pragma unroll
        for (int s = 0; s < 9; ++s) {
#pragma unroll
            for (int e = 0; e < 4; ++e) { const f32x4 kv = *(const f32x4*)(kp[s] + dc * 16 + e * 4);
#pragma unroll
                for (int hh = 0; hh < 4; ++hh) sc[s][hh] += (kv.x * q[hh][e].x + kv.y * q[hh][e].y) + (kv.z * q[hh][e].z + kv.w * q[hh][e].w); }
        }
    }
    float mx[4], sum[4], sk[4];
#pragma unroll
    for (int hh = 0; hh < 4; ++hh) { sk[hh] = inp(F, I_SINK)[layer * 8 + kvh * 4 + hh]; float m = sk[hh];
#pragma unroll
        for (int s = 0; s < 9; ++s) { sc[s][hh] *= 0.08838834764831845f; if (s * 64 + lane < nk) m = fmaxf(m, sc[s][hh]); }
        mx[hh] = wave_max(m, F.lane); }
#pragma unroll
    for (int hh = 0; hh < 4; ++hh) { float su = 0.f;
#pragma unroll
        for (int s = 0; s < 9; ++s) { const float e = (s * 64 + lane < nk) ? __expf(sc[s][hh] - mx[hh]) : 0.f; sc[s][hh] = e; su += e; }
        sum[hh] = 1.0f / (wave_sum(su, F.lane) + __expf(sk[hh] - mx[hh])); }
#pragma unroll
    for (int s = 0; s < 9; ++s) { const int kidx = s * 64 + lane; if (kidx < nk) *(LAS f32x4*)(pl + kidx * 4) = (f32x4){sc[s][0] * sum[0], sc[s][1] * sum[1], sc[s][2] * sum[2], sc[s][3] * sum[3]}; }
    LDS_WAIT(); asm volatile("" ::: "memory");
    float o0[4] = {0.f, 0.f, 0.f, 0.f}, o1[4] = {0.f, 0.f, 0.f, 0.f};
    const bf16* vbase = P + C_SWA + 1280 + kvh * 128 + 2 * lane;
#pragma unroll 4
    for (int k = 0; k < nwin; ++k) { const unsigned vw = *(const unsigned*)(vbase + (size_t)(wrow0 + k) * LDP); const f32x4 p = *(const LAS f32x4*)(pl + k * 4);
        const float v0 = __uint_as_float(vw << 16), v1 = __uint_as_float(vw & 0xffff0000u);
        o0[0] += p.x * v0; o1[0] += p.x * v1; o0[1] += p.y * v0; o1[1] += p.y * v1; o0[2] += p.z * v0; o1[2] += p.z * v1; o0[3] += p.w * v0; o1[3] += p.w * v1; }
#pragma unroll 4
    for (int k = 0; k < TCX; ++k) { const unsigned vw = *(const unsigned*)(vbase + (size_t)(crow0 + k) * LDP); const f32x4 p = *(const LAS f32x4*)(pl + (nwin + k) * 4);
        const float v0 = __uint_as_float(vw << 16), v1 = __uint_as_float(vw & 0xffff0000u);
        o0[0] += p.x * v0; o1[0] += p.x * v1; o0[1] += p.y * v0; o1[1] += p.y * v1; o0[2] += p.z * v0; o1[2] += p.z * v1; o0[3] += p.w * v0; o1[3] += p.w * v1; }
    bf16* yo = wsp<bf16>(F, WS_Y) + (size_t)row * 3072 + 1024 + kvh * 512 + 2 * lane;
#pragma unroll
    for (int hh = 0; hh < 4; ++hh) *(unsigned*)(yo + hh * 128) = pk2(o0[hh], o1[hh]);
    LDS_WAIT(); asm volatile("" ::: "memory");
}
__device__ __forceinline__ void mix_phase(Frame& F, int layer) {
    if (F.wg < 64) ret_scan_unit(F, layer, F.wg);
    else if (F.wg < 192) rwkv_scan_unit(F, layer, F.wg - 64);
    const int nrow = (layer == NL - 1) ? ML : MT;
    const int nchunk = nrow * 2 / 32;
    volatile LAS int* qslot = (volatile LAS int*)(F.lds + LDSCTL_OFF);
    LAS float* wl = (LAS float*)(F.lds + F.wave * 12288);
    for (;;) {
        __syncthreads();
        if (F.tid == 0) qslot[0] = (int)__hip_atomic_fetch_add(F.ctl + CW_SWAQ + 64 * layer, 1u, __ATOMIC_RELAXED, __HIP_MEMORY_SCOPE_AGENT);
        __syncthreads();
        const int chunk = qslot[0];
        if (chunk >= nchunk) break;
        for (int i = 0; i < 4; ++i) { const int wu = chunk * 32 + F.wave * 4 + i; swa_wave_unit(F, layer, wu >> 1, wu & 1, wl); }
    }
}
__device__ __forceinline__ void mixfin_phase(Frame& F, int layer, int nrows) {
    const int gw = F.wg * NWAVES + F.wave, NGW = F.G * NWAVES; const int lane = F.lane;
    const bf16* P = wsp<bf16>(F, WS_P); const float* XS = wsp<float>(F, WS_XS); const float* LR = wsp<float>(F, WS_LR);
    const float* Y0 = wsp<float>(F, WS_YDR); const float* Y1 = Y0 + (size_t)MT * BW; const float* Z0 = wsp<float>(F, WS_YDW); const float* Z1 = Z0 + (size_t)MT * BW;
    for (int row = gw; row < nrows; row += NGW) {
        bf16* yo = wsp<bf16>(F, WS_Y) + (size_t)row * 3072;
        for (int h = 0; h < 8; ++h) { const size_t o = (size_t)row * BW + h * 128 + 2 * lane;
            const f32x2 a = *(const f32x2*)(Y0 + o), b2 = *(const f32x2*)(Y1 + o); const float y0 = a.x + b2.x, y1 = a.y + b2.y;
            const float mean = wave_sum(y0 + y1, F.lane) * (1.0f / 128.0f); const float d0 = y0 - mean, d1 = y1 - mean;
            const float var = wave_sum(d0 * d0 + d1 * d1, F.lane) * (1.0f / 128.0f); const float rs = 1.0f / sqrtf(var + 1e-5f);
            const unsigned gw2 = *(const unsigned*)(P + (size_t)row * LDP + C_RET + 3072 + h * 128 + 2 * lane);
            const float g0 = __uint_as_float(gw2 << 16), g1 = __uint_as_float(gw2 & 0xffff0000u);
            *(unsigned*)(yo + h * 128 + 2 * lane) = pk2(g0 * sigm(g0) * d0 * rs, g1 * sigm(g1) * d1 * rs); }
        for (int h = 0; h < 16; ++h) { const int c = h * 64 + lane; const size_t o = (size_t)row * BW + c;
            const float y = Z0[o] + Z1[o];
            const float mean = wave_sum(y, F.lane) * (1.0f / 64.0f); const float d = y - mean; const float var = wave_sum(d * d, F.lane) * (1.0f / 64.0f); const float rs = 1.0f / sqrtf(var + 64e-5f);
            const float r = XS[(size_t)row * 3072 + c], k = XS[(size_t)row * 3072 + 1024 + c], v = XS[(size_t)row * 3072 + 2048 + c];
            const float ka = inp(F, I_KA)[layer * BW + c], rk = inp(F, I_RK)[layer * BW + c];
            const float a0 = sigm(inp(F, I_A0)[((size_t)layer * 2 + 0) * BW + c] + LR[(size_t)row * NLR + 2048 + c]);
            const float a1 = sigm(inp(F, I_A0)[((size_t)layer * 2 + 1) * BW + c] + LR[(size_t)row * NLR + 3072 + c]);
            const float kd0 = k * (1.0f + (a0 - 1.0f) * ka), kd1 = k * (1.0f + (a1 - 1.0f) * ka);
            const float dot = wave_sum(r * (kd0 + kd1) * rk, F.lane);
            const float g = LR[(size_t)row * NLR + 4096 + c];
            const float outv = (d * rs * inp(F, I_LNG)[layer * BW + c] + dot * v) * g;
            const float nb = shx(outv, 1, F.lane);
            if (!(lane & 1)) *(unsigned*)(yo + 2048 + c) = pk2(outv, nb); }
    }
}

constexpr int NPH = 11;
constexpr int NSTEPS = 2 + NL * NPH + 1;
__global__ void __launch_bounds__(NTHR, 2) hyb_fwd(Args args) {
    extern __shared__ __attribute__((aligned(16))) unsigned char lds[];
    Frame F;
    F.lds = (LAS unsigned char*)lds;
    F.tid = threadIdx.x; F.lane = F.tid & 63; F.wave = __builtin_amdgcn_readfirstlane(F.tid >> 6);
    F.G = gridDim.x; F.wg = blockIdx.x; F.ws = args.ws; F.ctl = (unsigned*)(args.ws + WS_CTL);
    for (int u = F.tid; u < (LDS_BYTES - LDSCTL_OFF) / 4; u += NTHR) ((LAS unsigned*)(F.lds + LDSCTL_OFF))[u] = 0u;
    __syncthreads();
    if (F.tid < 26) { const __attribute__((address_space(4))) unsigned long long* kp = (const __attribute__((address_space(4))) unsigned long long*)__builtin_amdgcn_kernarg_segment_ptr();
        ((LAS unsigned long long*)(F.lds + PTAB_OFF))[F.tid] = kp[F.tid]; }
    __syncthreads();
    XcdBarrier bar = xcd_barrier_post(F.ctl + CW_BAR, (volatile LAS unsigned*)(F.lds + MISC_OFF) + 8);
    int lo = args.s_lo, hi = args.s_hi;
#define IN(k) (lo <= (k) && (k) < hi)
#define SL() asm volatile("" : "+s"(lo), "+s"(hi), "+s"(F.ws), "+s"(F.wg), "+s"(F.G))
#define LAUNDER() do { int t_ = threadIdx.x; asm volatile("" : "+v"(t_)); F.tid = t_; F.lane = t_ & 63; F.wave = __builtin_amdgcn_readfirstlane(t_ >> 6); } while (0)
#define SEAM(k) do { SL(); if (IN(k) && IN((k) + 1)) xcd_barrier(bar); } while (0)
    SL(); if (IN(0)) { LAUNDER(); p0_prologue(F); }
    SEAM(0);
    SL(); if (IN(1)) { LAUNDER(); p1_modreduce(F); }
    SEAM(1);
    for (int layer_ = 0; layer_ < NL; ++layer_) {
        int layer = layer_; asm volatile("" : "+s"(layer));
        const int s0 = 2 + layer * NPH;
        const int mrows = (layer == NL - 1) ? ML : MT;
        const float* modl = wsp<float>(F, WS_MOD) + (size_t)layer * 5 * 12288;
        SL(); if (IN(s0 + 0)) { LAUNDER(); norm_phase(F, layer, 0, MT); }
        SEAM(s0 + 0);
        SL(); if (IN(s0 + 1)) {
            pg8::Gemm g{wsp<bf16>(F, WS_U), wsp<bf16>(F, WS_WIN + layer * SZ_WIN), MT, LDP, DM, DM, DM}; pg8::StaticOrder S; S.init(MT, LDP, F.G, F.wg);
            pg8::EpiBf16<0> E{wsp<bf16>(F, WS_P), LDP};
            pg8::gemm_phase<pg8::EpiBf16<0>, pg8::StaticOrder, true, true>(F.lds, g, S, E);
        }
        SEAM(s0 + 1);
        SL(); if (IN(s0 + 2)) { LAUNDER(); prep_phase(F, layer); }
        SEAM(s0 + 2);
        SL(); if (IN(s0 + 3)) {
            pg8::Gemm g{wsp<bf16>(F, WS_ALR), wsp<bf16>(F, WS_WLR + layer * SZ_WLR), MT, NLR, KLR, KLR, KLR}; pg8::StaticOrder S; S.init(MT, NLR, F.G, F.wg);
            pg8::EpiF32 E{wsp<float>(F, WS_LR), NLR};
            pg8::gemm_phase<pg8::EpiF32, pg8::StaticOrder, true, true>(F.lds, g, S, E);
        }
        SEAM(s0 + 3);
        SL(); if (IN(s0 + 4)) { LAUNDER(); mix_phase(F, layer); }
        SEAM(s0 + 4);
        SL(); if (IN(s0 + 5)) { LAUNDER(); mixfin_phase(F, layer, mrows); }
        SEAM(s0 + 5);
        SL(); if (IN(s0 + 6)) {
            const bf16* wbr = wsp<bf16>(F, WS_WBR + layer * SZ_WBR);
            pg8::StaticOrder S; S.init(mrows, DM, F.G, F.wg);
            { pg8::Gemm g{wsp<bf16>(F, WS_Y), wbr, mrows, DM, BW, 3072, BW}; pg8::EpiGate<0> E{wsp<bf16>(F, WS_P) + C_GATE, LDP, wsp<float>(F, WS_MGF), wsp<bf16>(F, WS_MG)};
              pg8::gemm_phase<pg8::EpiGate<0>, pg8::StaticOrder, true, true>(F.lds, g, S, E); }
            { pg8::Gemm g{wsp<bf16>(F, WS_Y) + 1024, wbr + (size_t)DM * BW, mrows, DM, BW, 3072, BW}; pg8::EpiGate<1> E{wsp<bf16>(F, WS_P) + C_GATE + 2048, LDP, wsp<float>(F, WS_MGF), wsp<bf16>(F, WS_MG)};
              pg8::gemm_phase<pg8::EpiGate<1>, pg8::StaticOrder, true, true>(F.lds, g, S, E); }
            { pg8::Gemm g{wsp<bf16>(F, WS_Y) + 2048, wbr + (size_t)2 * DM * BW, mrows, DM, BW, 3072, BW}; pg8::EpiGate<2> E{wsp<bf16>(F, WS_P) + C_GATE + 4096, LDP, wsp<float>(F, WS_MGF), wsp<bf16>(F, WS_MG)};
              pg8::gemm_phase<pg8::EpiGate<2>, pg8::StaticOrder, true, true>(F.lds, g, S, E); }
        }
        SEAM(s0 + 6);
        SL(); if (IN(s0 + 7)) {
            pg8::Gemm g{wsp<bf16>(F, WS_MG), wsp<bf16>(F, WS_WOUT + layer * SZ_WOUT), mrows, DM, DM, DM, DM}; pg8::StaticOrder S; S.init(mrows, DM, F.G, F.wg);
            pg8::EpiResGate E{wsp<float>(F, WS_H), modl, 2 * DM};
            pg8::gemm_phase<pg8::EpiResGate, pg8::StaticOrder, true, true>(F.lds, g, S, E);
        }
        SEAM(s0 + 7);
        SL(); if (IN(s0 + 8)) { LAUNDER(); norm_phase(F, layer, 1, mrows); }
        SEAM(s0 + 8);
        SL(); if (IN(s0 + 9)) {
            pg8::Gemm g{wsp<bf16>(F, WS_U), wsp<bf16>(F, WS_WFF1 + layer * SZ_WFF), mrows, DFF, DM, DM, DM}; pg8::StaticOrder S; S.init(mrows, DFF, F.G, F.wg);
            pg8::EpiBf16<2> E{wsp<bf16>(F, WS_F), DFF};
            pg8::gemm_phase<pg8::EpiBf16<2>, pg8::StaticOrder, true, true>(F.lds, g, S, E);
        }
        SEAM(s0 + 9);
        SL(); if (IN(s0 + 10)) {
            pg8::Gemm g{wsp<bf16>(F, WS_F), wsp<bf16>(F, WS_WFF2 + layer * SZ_WFF), mrows, DM, DFF, DFF, DFF}; pg8::StaticOrder S; S.init(mrows, DM, F.G, F.wg);
            pg8::EpiResGate E{wsp<float>(F, WS_H), modl, 5 * DM};
            pg8::gemm_phase<pg8::EpiResGate, pg8::StaticOrder, true, true>(F.lds, g, S, E);
        }
        SEAM(s0 + 10);
    }
    SL(); if (IN(NSTEPS - 1)) { LAUNDER(); final_norm(F, args.out); }
#undef IN
#undef SL
#undef LAUNDER
#undef SEAM
}

#ifndef MK_ONE_LAUNCH
#define MK_ONE_LAUNCH 1
#endif
extern "C" void kernel_launch(void* const* d_in, const int* in_sizes, int n_in, void* d_out, int out_size, void* d_ws, size_t ws_size, hipStream_t stream) {
    static int grid = 0;
    if (grid == 0) {
        if (n_in != 26 || out_size != ML * DM || ws_size < WS_END) { fprintf(stderr, "kernel_launch: unexpected shapes (n_in %d, out %d, ws %zu < %zu)\n", n_in, out_size, ws_size, (size_t)WS_END); grid = -1; return; }
        int dev = 0, cus = 0, per_cu = 0;
        if (hipGetDevice(&dev) != hipSuccess || hipDeviceGetAttribute(&cus, hipDeviceAttributeMultiprocessorCount, dev) != hipSuccess) { grid = -1; return; }
        if (hipFuncSetAttribute((const void*)hyb_fwd, hipFuncAttributeMaxDynamicSharedMemorySize, LDS_BYTES) != hipSuccess) { fprintf(stderr, "kernel_launch: hipFuncSetAttribute failed\n"); grid = -1; return; }
        if (hipOccupancyMaxActiveBlocksPerMultiprocessor(&per_cu, (const void*)hyb_fwd, NTHR, LDS_BYTES) != hipSuccess || per_cu < 1) fprintf(stderr, "kernel_launch: occupancy query reports %d\n", per_cu);
        (void)hipGetLastError();
        grid = cus;
    }
    if (grid < 0) return;
    if (hipMemsetAsync((char*)d_ws + WS_CTL, 0, CTL_ZERO_BYTES, stream) != hipSuccess) return;
    Args a{};
    for (int i = 0; i < 26; ++i) a.in[i] = (const float*)d_in[i];
    a.out = (float*)d_out; a.ws = (unsigned char*)d_ws;
#if MK_ONE_LAUNCH
    a.s_lo = 0; a.s_hi = NSTEPS;
    hipLaunchKernelGGL(hyb_fwd, dim3(grid), dim3(NTHR), LDS_BYTES, stream, a);
#else
    for (int s = 0; s < NSTEPS; ++s) { a.s_lo = s; a.s_hi = s + 1; hipLaunchKernelGGL(hyb_fwd, dim3(grid), dim3(NTHR), LDS_BYTES, stream, a); }
#endif
}
```

```cpp
#include <hip/hip_runtime.h>
#include <cstdio>
#include <cstdint>
namespace pg8 {
#define PG8_LAS __attribute__((address_space(3)))
typedef unsigned short bf16_t;
typedef short bf16x8 __attribute__((ext_vector_type(8)));
typedef float f32x4 __attribute__((ext_vector_type(4)));
typedef unsigned u32x4 __attribute__((ext_vector_type(4)));
constexpr int BM = 256, BK = 64, HALF = 128, HTB = HALF * BK * 2  , STAGE_BYTES = 8 * HTB, NXCD = 8, WGM = 8;

__host__ __device__ __forceinline__ int lds_byte(int r, int c) { const int st = (r >> 4) * 2 + (c >> 5), rr = r & 15, cc = c & 31, ob = rr * 64 + cc * 2; return st * 1024 + (ob ^ (((ob >> 9) & 1) << 5)); }
__host__ __device__ __forceinline__ void stage_rc(int b, int& R, int& C) { const int st = b / 1024, sb = b % 1024, swz = sb ^ (((sb >> 9) & 1) << 5); R = (st >> 1) * 16 + swz / 64; C = (st & 1) * 32 + (swz % 64) / 2; }
__host__ __device__ __forceinline__ int perm32(int rho) { const int n = rho >> 4, i = rho & 15; return 8 * (i >> 2) + 4 * n + (i & 3); }

struct Unit { int pm, pn; };
struct Gemm { const bf16_t* A; const bf16_t* Bt; int M, N, K, lda, ldb; };

struct StaticOrder {
    int nM, nN, nwg, G, c;
    __host__ __device__ void init(int M, int N, int G_, int c_) { nM = M / BM; nN = N / BM; nwg = nM * nN; G = G_; c = c_; }
    __host__ __device__ bool next(int i, Unit& u) const {
        const long L = (long)i * G + c; if (L >= nwg) return false;
        int wgid = (int)L; { const int q = nwg / NXCD, r = nwg % NXCD, xcd = wgid % NXCD, off = wgid / NXCD; wgid = (xcd < r ? xcd * (q + 1) : r * (q + 1) + (xcd - r) * q) + off; }
        const int nig = WGM * nN, gid = wgid / nig, fm = gid * WGM, gsz = (nM - fm) < WGM ? (nM - fm) : WGM;
        u.pm = fm + ((wgid % nig) % gsz); u.pn = (wgid % nig) / gsz; return true;
    }
    __device__ __forceinline__ void a_ready(const Unit&) const {}
    __device__ __forceinline__ void done(const Unit&) const {}
};

__device__ __forceinline__ unsigned cvt_pk_bf16(float lo, float hi) { unsigned r; asm volatile("v_cvt_pk_bf16_f32 %0, %1, %2" : "=v"(r) : "v"(lo), "v"(hi)); return r; }
typedef float f32x2 __attribute__((ext_vector_type(2)));
__device__ __forceinline__ float sigmoidf_(float x) { return 1.0f / (1.0f + __expf(-x)); }
__device__ __forceinline__ float bf_lo(unsigned w) { return __uint_as_float(w << 16); }
__device__ __forceinline__ float bf_hi(unsigned w) { return __uint_as_float(w & 0xffff0000u); }

template <int ACT> struct EpiBf16 {
    static constexpr bool PERM = true, AFTER_DRAIN = false;
    bf16_t* O; int ldc;
    __device__ __forceinline__ void operator()(const f32x4 (&acc)[2][2][4][2], const Unit& u, int wr, int wc, int fr, int fq) const {
        const int row0 = u.pm * BM + wr * 64 + fr; const int col0 = u.pn * BM + wc * 32 + 8 * fq;
#pragma unroll
        for (int ai = 0; ai < 2; ++ai)
#pragma unroll
            for (int m = 0; m < 4; ++m) { bf16_t* rowp = O + (size_t)(row0 + ai * HALF + m * 16) * ldc + col0;
#pragma unroll
                for (int bj = 0; bj < 2; ++bj) { f32x4 v0 = acc[ai][bj][m][0], v1 = acc[ai][bj][m][1];
                    if (ACT == 2) {
#pragma unroll
                        for (int e = 0; e < 4; ++e) { const float a = fmaxf(v0[e], 0.f), b = fmaxf(v1[e], 0.f); v0[e] = a * a; v1[e] = b * b; } }
                    u32x4 w; w.x = cvt_pk_bf16(v0[0], v0[1]); w.y = cvt_pk_bf16(v0[2], v0[3]); w.z = cvt_pk_bf16(v1[0], v1[1]); w.w = cvt_pk_bf16(v1[2], v1[3]);
                    *(u32x4*)(rowp + bj * HALF) = w; } }
    }
};
struct EpiF32 {
    static constexpr bool PERM = false, AFTER_DRAIN = false;
    float* C; int ldc;
    __device__ __forceinline__ void operator()(const f32x4 (&acc)[2][2][4][2], const Unit& u, int wr, int wc, int fr, int fq) const {
        const int row0 = u.pm * BM + wr * 64 + fr, col0 = u.pn * BM + wc * 32 + 4 * fq;
#pragma unroll
        for (int ai = 0; ai < 2; ++ai)
#pragma unroll
            for (int m = 0; m < 4; ++m) { float* rowp = C + (size_t)(row0 + ai * HALF + m * 16) * ldc + col0;
#pragma unroll
                for (int bj = 0; bj < 2; ++bj)
#pragma unroll
                    for (int n = 0; n < 2; ++n) *(f32x4*)(rowp + bj * HALF + n * 16) = acc[ai][bj][m][n]; }
    }
};
template <int MODE> struct EpiGate {
    static constexpr bool PERM = true, AFTER_DRAIN = false;
    const bf16_t* G; int ldg;
    float* part; bf16_t* out;
    __device__ __forceinline__ void operator()(const f32x4 (&acc)[2][2][4][2], const Unit& u, int wr, int wc, int fr, int fq) const {
        const int row0 = u.pm * BM + wr * 64 + fr; const int col0 = u.pn * BM + wc * 32 + 8 * fq;
#pragma unroll
        for (int ai = 0; ai < 2; ++ai)
#pragma unroll
            for (int m = 0; m < 4; ++m) { const size_t row = (size_t)(row0 + ai * HALF + m * 16);
#pragma unroll
                for (int bj = 0; bj < 2; ++bj) { const int c = col0 + bj * HALF;
                    const u32x4 gw = *(const u32x4*)(G + row * ldg + c);
                    f32x4 g0, g1; g0[0] = sigmoidf_(bf_lo(gw.x)); g0[1] = sigmoidf_(bf_hi(gw.x)); g0[2] = sigmoidf_(bf_lo(gw.y)); g0[3] = sigmoidf_(bf_hi(gw.y));
                    g1[0] = sigmoidf_(bf_lo(gw.z)); g1[1] = sigmoidf_(bf_hi(gw.z)); g1[2] = sigmoidf_(bf_lo(gw.w)); g1[3] = sigmoidf_(bf_hi(gw.w));
                    f32x4 v0 = acc[ai][bj][m][0] * g0, v1 = acc[ai][bj][m][1] * g1;
                    float* pp = part + row * 2048 + c;
                    if (MODE >= 1) { v0 += *(const f32x4*)pp; v1 += *(const f32x4*)(pp + 4); }
                    if (MODE <= 1) { *(f32x4*)pp = v0; *(f32x4*)(pp + 4) = v1; }
                    else { u32x4 w; w.x = cvt_pk_bf16(v0[0], v0[1]); w.y = cvt_pk_bf16(v0[2], v0[3]); w.z = cvt_pk_bf16(v1[0], v1[1]); w.w = cvt_pk_bf16(v1[2], v1[3]);
                        *(u32x4*)(out + row * 2048 + c) = w; } } }
    }
};
struct EpiResGate {
    static constexpr bool PERM = false, AFTER_DRAIN = false;
    float* H; const float* modl; int goff;
    __device__ __forceinline__ void operator()(const f32x4 (&acc)[2][2][4][2], const Unit& u, int wr, int wc, int fr, int fq) const {
        const int mr = u.pm < 32 ? (u.pm >> 3) : 4;
        const int row0 = u.pm * BM + wr * 64 + fr, col0 = u.pn * BM + wc * 32 + 4 * fq;
        const float* gv = modl + (size_t)mr * 12288 + goff + col0;
        f32x4 gg[2][2];
#pragma unroll
        for (int bj = 0; bj < 2; ++bj)
#pragma unroll
            for (int n = 0; n < 2; ++n) gg[bj][n] = *(const f32x4*)(gv + bj * HALF + n * 16);
#pragma unroll
        for (int ai = 0; ai < 2; ++ai)
#pragma unroll
            for (int m = 0; m < 4; ++m) { float* rowp = H + (size_t)(row0 + ai * HALF + m * 16) * 2048 + col0;
#pragma unroll
                for (int bj = 0; bj < 2; ++bj)
#pragma unroll
                    for (int n = 0; n < 2; ++n) { f32x4* p = (f32x4*)(rowp + bj * HALF + n * 16); *p = *p + gg[bj][n] * acc[ai][bj][m][n]; } }
    }
};

template <class Epi, class Sched, bool ALIGN_EPI = false, bool SP2 = false>
__device__ __forceinline__ void gemm_phase(PG8_LAS unsigned char* lds, const Gemm g, const Sched& S, const Epi& E) {
    int tid_ = threadIdx.x; asm volatile("" : "+v"(tid_));
    const int tid = tid_, wid = __builtin_amdgcn_readfirstlane(tid >> 6), lane = tid & 63, wr = wid >> 2, wc = wid & 3, fr = lane & 15, fq = lane >> 4;
    const int K = g.K, nt = K / BK;
    unsigned voffA[2], voffB[2];
#pragma unroll
    for (int i = 0; i < 2; ++i) { int R, C; stage_rc(tid * 16 + i * 8192, R, C); const int Rb = Epi::PERM ? ((R & ~31) + perm32(R & 31)) : R;
        voffA[i] = (unsigned)(R * g.lda + C) * 2u; voffB[i] = (unsigned)(Rb * g.ldb + C) * 2u; }
    const size_t kstep = (size_t)(BK * 2);
    const size_t hstepA = (size_t)HALF * g.lda * 2, hstepB = (size_t)HALF * g.ldb * 2;
    const size_t tstepA = 2 * hstepA, tstepB = 2 * hstepB;
    const unsigned ldsw = (unsigned)wid * 1024u;
    const int aoff = lds_byte(wr * 64 + fr, fq * 8), boff = lds_byte(wc * 32 + fr, fq * 8);
#define PG8_SA(b, h) (((b) * 2 + (h)) * HTB)
#define PG8_SB(b, h) ((4 + (b) * 2 + (h)) * HTB)
#define PG8_STAGE(bufoff, gbase, voff) do { _Pragma("unroll") for (int _i = 0; _i < 2; ++_i) \
        __builtin_amdgcn_global_load_lds((const unsigned*)((const char*)(gbase) + (voff)[_i]), (PG8_LAS unsigned*)(lds + (bufoff) + ldsw + _i * 8192), 16, 0, 0); } while (0)
#define PG8_LDA(dst, b, h) do { _Pragma("unroll") for (int m = 0; m < 4; ++m) _Pragma("unroll") for (int k = 0; k < 2; ++k) dst[m][k] = *(const PG8_LAS bf16x8*)(lds + PG8_SA(b, h) + aoff + m * 2048 + k * 1024); } while (0)
#define PG8_LDB(dst, b, h) do { _Pragma("unroll") for (int n = 0; n < 2; ++n) _Pragma("unroll") for (int k = 0; k < 2; ++k) dst[n][k] = *(const PG8_LAS bf16x8*)(lds + PG8_SB(b, h) + boff + n * 2048 + k * 1024); } while (0)
#define PG8_MMA(ai, bj, At, Bt) do { __builtin_amdgcn_s_setprio(1); _Pragma("unroll") for (int m = 0; m < 4; ++m) _Pragma("unroll") for (int n = 0; n < 2; ++n) _Pragma("unroll") for (int k = 0; k < 2; ++k) \
        acc[ai][bj][m][n] = __builtin_amdgcn_mfma_f32_16x16x32_bf16(Bt[n][k], At[m][k], acc[ai][bj][m][n], 0, 0, 0); __builtin_amdgcn_s_setprio(0); } while (0)
#define PG8_WAIT_V(n) asm volatile("s_waitcnt vmcnt(" #n ")" ::: "memory")
#define PG8_WAIT_L(n) asm volatile("s_waitcnt lgkmcnt(" #n ")" ::: "memory")
#define PG8_BAR __builtin_amdgcn_s_barrier()
#define PG8_SCHED __builtin_amdgcn_sched_barrier(0)
    Unit cur, nxt; int ui = 0;
    if (!S.next(0, cur)) return;
    f32x4 acc[2][2][4][2];
#pragma unroll
    for (int a = 0; a < 2; ++a)
#pragma unroll
        for (int b = 0; b < 2; ++b)
#pragma unroll
            for (int m = 0; m < 4; ++m)
#pragma unroll
                for (int n = 0; n < 2; ++n) acc[a][b][m][n] = (f32x4){0.f, 0.f, 0.f, 0.f};
    bf16x8 At[4][2], B0[2][2], B1[2][2];
    const char* cA = (const char*)g.A + (size_t)cur.pm * tstepA; const char* cB = (const char*)g.Bt + (size_t)cur.pn * tstepB;
    S.a_ready(cur);
    if constexpr (SP2) {
        PG8_STAGE(PG8_SB(0, 0), cB, voffB); PG8_STAGE(PG8_SB(0, 1), cB + hstepB, voffB); PG8_STAGE(PG8_SA(0, 0), cA, voffA); PG8_STAGE(PG8_SA(0, 1), cA + hstepA, voffA);
        if (wr == 1) PG8_BAR;
        PG8_WAIT_V(2); PG8_BAR;
        PG8_STAGE(PG8_SB(1, 0), cB + kstep, voffB); PG8_STAGE(PG8_SA(1, 0), cA + kstep, voffA); PG8_STAGE(PG8_SB(1, 1), cB + hstepB + kstep, voffB);
        PG8_WAIT_V(6); PG8_BAR;
    } else {
        PG8_STAGE(PG8_SB(0, 0), cB, voffB); PG8_STAGE(PG8_SA(0, 0), cA, voffA); PG8_STAGE(PG8_SB(0, 1), cB + hstepB, voffB); PG8_STAGE(PG8_SA(0, 1), cA + hstepA, voffA);
        if (wr == 1) PG8_BAR;
        PG8_WAIT_V(4); PG8_BAR;
        PG8_STAGE(PG8_SB(1, 0), cB + kstep, voffB); PG8_STAGE(PG8_SA(1, 0), cA + kstep, voffA); PG8_STAGE(PG8_SB(1, 1), cB + hstepB + kstep, voffB);
        PG8_WAIT_V(6); PG8_BAR;
    }
    for (;;) {
        const bool has_next = S.next(ui + 1, nxt);
        const char* nA = has_next ? (const char*)g.A + (size_t)nxt.pm * tstepA : cA; const char* nB = has_next ? (const char*)g.Bt + (size_t)nxt.pn * tstepB : cB;
        for (int t = 0; t < nt; t += 2) {
            const bool last = (t == nt - 2);
            const char* a1 = cA + (size_t)(t + 1) * kstep;
            const char* a2 = last ? nA : cA + (size_t)(t + 2) * kstep; const char* b2 = last ? nB : cB + (size_t)(t + 2) * kstep;
            const char* a3 = a2 + kstep; const char* b3 = b2 + kstep;
            if (last && has_next) S.a_ready(nxt);
            if constexpr (SP2) {
            PG8_LDB(B0, 0, 0); PG8_LDB(B1, 0, 1); PG8_SCHED; PG8_LDA(At, 0, 0); PG8_STAGE(PG8_SA(1, 1), a1 + hstepA, voffA);
            PG8_WAIT_V(8); PG8_WAIT_L(0); PG8_BAR; PG8_MMA(0, 0, At, B0); PG8_MMA(0, 1, At, B1); PG8_BAR; PG8_SCHED;
            PG8_LDA(At, 0, 1); PG8_STAGE(PG8_SB(0, 0), b2, voffB); PG8_STAGE(PG8_SB(0, 1), b2 + hstepB, voffB); PG8_STAGE(PG8_SA(0, 0), a2, voffA);
            PG8_WAIT_V(8); PG8_WAIT_L(0); PG8_BAR; PG8_MMA(1, 0, At, B0); PG8_MMA(1, 1, At, B1); PG8_BAR; PG8_SCHED;
            PG8_LDB(B0, 1, 0); PG8_LDB(B1, 1, 1); PG8_SCHED; PG8_LDA(At, 1, 0); PG8_STAGE(PG8_SA(0, 1), a2 + hstepA, voffA);
            PG8_WAIT_V(8); PG8_WAIT_L(0); PG8_BAR; PG8_MMA(0, 0, At, B0); PG8_MMA(0, 1, At, B1); PG8_BAR; PG8_SCHED;
            PG8_LDA(At, 1, 1); PG8_STAGE(PG8_SB(1, 0), b3, voffB); PG8_STAGE(PG8_SB(1, 1), b3 + hstepB, voffB); PG8_STAGE(PG8_SA(1, 0), a3, voffA);
            PG8_WAIT_V(8); PG8_WAIT_L(0); PG8_BAR; PG8_MMA(1, 0, At, B0); PG8_MMA(1, 1, At, B1); PG8_BAR; PG8_SCHED;
            } else {
            PG8_LDB(B0, 0, 0); PG8_SCHED; PG8_LDA(At, 0, 0); PG8_STAGE(PG8_SA(1, 1), a1 + hstepA, voffA);
            PG8_WAIT_L(8); PG8_BAR; PG8_WAIT_L(0); PG8_MMA(0, 0, At, B0); PG8_BAR; PG8_SCHED;
            PG8_LDB(B1, 0, 1); PG8_STAGE(PG8_SB(0, 0), b2, voffB);
            PG8_BAR; PG8_WAIT_L(0); PG8_MMA(0, 1, At, B1); PG8_BAR;
            PG8_LDA(At, 0, 1); PG8_STAGE(PG8_SA(0, 0), a2, voffA);
            PG8_BAR; PG8_WAIT_L(0); PG8_MMA(1, 0, At, B0); PG8_BAR; PG8_SCHED;
            PG8_STAGE(PG8_SB(0, 1), b2 + hstepB, voffB);
            PG8_WAIT_V(6); PG8_BAR; PG8_MMA(1, 1, At, B1); PG8_BAR;
            PG8_LDB(B0, 1, 0); PG8_SCHED; PG8_LDA(At, 1, 0); PG8_STAGE(PG8_SA(0, 1), a2 + hstepA, voffA);
            PG8_WAIT_L(8); PG8_BAR; PG8_WAIT_L(0); PG8_MMA(0, 0, At, B0); PG8_BAR; PG8_SCHED;
            PG8_LDB(B1, 1, 1); PG8_STAGE(PG8_SB(1, 0), b3, voffB);
            PG8_BAR; PG8_WAIT_L(0); PG8_MMA(0, 1, At, B1); PG8_BAR;
            PG8_LDA(At, 1, 1); PG8_STAGE(PG8_SA(1, 0), a3, voffA);
            PG8_BAR; PG8_WAIT_L(0); PG8_MMA(1, 0, At, B0); PG8_BAR; PG8_SCHED;
            PG8_STAGE(PG8_SB(1, 1), b3 + hstepB, voffB);
            PG8_WAIT_V(6); PG8_BAR; PG8_MMA(1, 1, At, B1); PG8_BAR;
            }
        }
        if constexpr (ALIGN_EPI) { if (wr == 0) PG8_BAR; }
        if constexpr (!Epi::AFTER_DRAIN) { int t2_ = threadIdx.x; asm volatile("" : "+v"(t2_));   E(acc, cur, wr, wc, t2_ & 15, (t2_ >> 4) & 3); S.done(cur); }
        if (!has_next) break;
#pragma unroll
        for (int a = 0; a < 2; ++a)
#pragma unroll
            for (int b = 0; b < 2; ++b)
#pragma unroll
                for (int m = 0; m < 4; ++m)
#pragma unroll
                    for (int n = 0; n < 2; ++n) acc[a][b][m][n] = (f32x4){0.f, 0.f, 0.f, 0.f};
        cur = nxt; cA = nA; cB = nB; ++ui;
        if constexpr (ALIGN_EPI) { if (wr == 1) PG8_BAR; }
    }
    PG8_WAIT_V(0);
    if constexpr (!ALIGN_EPI) { if (wr == 0) PG8_BAR; }
    PG8_BAR;
    if constexpr (Epi::AFTER_DRAIN) { E.fused(acc, cur, wr, wc, fr, fq, lds, wid, lane); S.done(cur); }
#undef PG8_SA
#undef PG8_SB
#undef PG8_STAGE
#undef PG8_LDA
#undef PG8_LDB
#undef PG8_MMA
#undef PG8_WAIT_V
#undef PG8_WAIT_L
#undef PG8_BAR
#undef PG8_SCHED
}
}

constexpr int NB = 4, TL = 2048, TCX = 256, DM = 2048, NL = 4, DFF = 8192, BW = 1024;
constexpr int ML = NB * TL, MC = NB * TCX, MT = ML + MC;
constexpr int NIN = 15232, LDP = 15360;
constexpr int C_RET = 0, C_SWA = 4096, C_RW = 5632, C_GATE = 9088, RWIN = 3456;
constexpr int NLR = 5120, KLR = 384;
constexpr int NQK = 1280;
constexpr int NSTEP = 2304, SCAN_BLK = 32;

constexpr size_t al256(size_t x) { return (x + 255) & ~(size_t)255; }
constexpr size_t WS_CTL = 0, CTL_ZERO_BYTES = 1u << 20;
constexpr size_t SZ_WIN = (size_t)LDP * DM * 2, SZ_WBR = (size_t)3 * DM * BW * 2, SZ_WOUT = (size_t)DM * DM * 2, SZ_WFF = (size_t)DFF * DM * 2, SZ_WLR = (size_t)NLR * KLR * 2;
constexpr size_t WS_WIN = CTL_ZERO_BYTES;
constexpr size_t WS_WBR = WS_WIN + NL * SZ_WIN;
constexpr size_t WS_WOUT = WS_WBR + NL * SZ_WBR;
constexpr size_t WS_WFF1 = WS_WOUT + NL * SZ_WOUT;
constexpr size_t WS_WFF2 = WS_WFF1 + NL * SZ_WFF;
constexpr size_t WS_WLR = WS_WFF2 + NL * SZ_WFF;
constexpr size_t WS_H = WS_WLR + NL * SZ_WLR;
constexpr size_t WS_U = WS_H + (size_t)MT * DM * 4;
constexpr size_t WS_P = WS_U + (size_t)MT * DM * 2;
constexpr size_t WS_Y = WS_P + (size_t)MT * LDP * 2;
constexpr size_t WS_MGF = WS_Y + (size_t)MT * 3072 * 2;
constexpr size_t WS_MG = WS_MGF + (size_t)MT * DM * 4;
constexpr size_t WS_F = WS_MG + (size_t)MT * DM * 2;
constexpr size_t WS_MODP = WS_F + (size_t)MT * DFF * 2;
constexpr size_t WS_MOD = WS_MODP + (size_t)8 * NL * 5 * 12288 * 4;
constexpr size_t WS_ROPE = WS_MOD + (size_t)NL * 5 * 12288 * 4;
constexpr size_t WS_XS = WS_ROPE + 64 * 32 * 2 * 4;
constexpr size_t WS_ALR = WS_XS + (size_t)MT * 3072 * 4;
constexpr size_t WS_LR = WS_ALR + (size_t)MT * KLR * 2;
constexpr size_t WS_QKR = WS_LR + (size_t)MT * NLR * 4;
constexpr size_t WS_ST = WS_QKR + (size_t)MT * NQK * 2;
constexpr size_t WS_YDR = WS_ST + (size_t)NB * 8 * 2 * 18 * 128 * 128 * 2;
constexpr size_t WS_YDW = WS_YDR + (size_t)2 * MT * BW * 4;
constexpr size_t WS_END = WS_YDW + (size_t)2 * MT * BW * 4;
constexpr int CW_BAR = 4096;
constexpr int CW_SWAQ = 16384;

constexpr int RING_BYTES = 131072, LDSCTL_OFF = RING_BYTES, MISC_OFF = LDSCTL_OFF + 320, LDS_BYTES = 147456;
constexpr int NWAVES = 8, NTHR = 512;

#define GAS __attribute__((address_space(1)))
#define LAS __attribute__((address_space(3)))
typedef unsigned short bf16;
typedef float f32x4 __attribute__((ext_vector_type(4)));
typedef float f32x2 __attribute__((ext_vector_type(2)));
typedef unsigned u32x4 __attribute__((ext_vector_type(4)));
typedef unsigned u32x2 __attribute__((ext_vector_type(2)));
#define LDS_WAIT() asm volatile("s_waitcnt lgkmcnt(0)" ::: "memory")
#define VM_WAIT() asm volatile("s_waitcnt vmcnt(0)" ::: "memory")
__device__ __forceinline__ unsigned f2bf(float f) { unsigned u = __builtin_bit_cast(unsigned, f); return (u + 0x7fffu + ((u >> 16) & 1u)) >> 16; }
__device__ __forceinline__ unsigned pk2(float lo, float hi) { return f2bf(lo) | (f2bf(hi) << 16); }
__device__ __forceinline__ float bf2f(bf16 v) { return __uint_as_float((unsigned)v << 16); }
__device__ __forceinline__ float sigm(float x) { return 1.0f / (1.0f + __expf(-x)); }
using pg8::bf_lo; using pg8::bf_hi;
__device__ __forceinline__ float shx(float v, int m, int lane) { return __int_as_float(__builtin_amdgcn_ds_bpermute((lane ^ m) << 2, __float_as_int(v))); }
__device__ __forceinline__ float wave_sum(float v, int lane) {
#pragma unroll
    for (int o = 1; o < 64; o <<= 1) v += shx(v, o, lane);
    return v;
}
__device__ __forceinline__ float wave_max(float v, int lane) {
#pragma unroll
    for (int o = 1; o < 64; o <<= 1) v = fmaxf(v, shx(v, o, lane));
    return v;
}

#define XB_TMO      128
#define XB_XCNT(j)  (256  + 64 * (j))
#define XB_XSUB(j)  (1280 + 64 * (j))
#define XB_XGEN(j)  (2304 + 64 * (j))
#define XB_TOP      3328
#define XB_TOPGEN   3392
#define XCD_BAR_WORDS 3456
#define XB_SPIN_CAP (1u << 22)
__device__ __forceinline__ unsigned xb_ld(unsigned* p)              { return __hip_atomic_load(p, __ATOMIC_RELAXED, __HIP_MEMORY_SCOPE_AGENT); }
__device__ __forceinline__ unsigned xb_add(unsigned* p, unsigned v) { return __hip_atomic_fetch_add(p, v, __ATOMIC_RELAXED, __HIP_MEMORY_SCOPE_AGENT); }
__device__ __forceinline__ unsigned xb_xcc_id() { return (unsigned)__builtin_amdgcn_s_getreg((3 << 11) | 20) & 0xFu; }
#define XB_SPIN(cond, bar) do { unsigned _sp = 0; while (cond) { __builtin_amdgcn_s_sleep(1); \
    if ((++_sp & 255u) == 0u) { if (xb_ld(&(bar)[XB_TMO])) break; if (_sp > XB_SPIN_CAP) { atomicAdd(&(bar)[XB_TMO], 1u); break; } } } } while (0)
struct XcdBarrier { unsigned* bar; unsigned x; volatile LAS unsigned* st; };
__device__ __forceinline__ XcdBarrier xcd_barrier_post(unsigned* bar, volatile LAS unsigned* st) {
    XcdBarrier b; b.bar = bar; b.x = xb_xcc_id(); b.st = st;
    if (threadIdx.x == 0) (void)xb_add(&bar[XB_XCNT(b.x)], 1u);
    return b;
}
__device__ __forceinline__ void xcd_barrier_complete(unsigned* bar, unsigned x, unsigned& nloc, unsigned& nx) {
    const unsigned G = gridDim.x * gridDim.y * gridDim.z;
    unsigned sum, cnt, mine, sp = 0u;
    for (;;) {
        sum = 0u; cnt = 0u; mine = 0u;
#pragma unroll
        for (unsigned j = 0; j < 16; ++j) { const unsigned c = xb_ld(&bar[XB_XCNT(j)]); sum += c; cnt += (c > 0u) ? 1u : 0u; mine = (j == x) ? c : mine; }
        if (sum == G) break;
        __builtin_amdgcn_s_sleep(1);
        if ((++sp & 255u) == 0u) { if (xb_ld(&bar[XB_TMO])) break; if (sp > XB_SPIN_CAP) { atomicAdd(&bar[XB_TMO], 1u); break; } }
    }
    nloc = mine > 0u ? mine : 1u; nx = cnt > 0u ? cnt : 1u;
}
__device__ __forceinline__ void xcd_barrier(const XcdBarrier& b) {
    asm volatile("s_waitcnt vmcnt(0)" ::: "memory");
    __syncthreads();
    if (threadIdx.x == 0) {
        unsigned* bar = b.bar; unsigned bx = b.x;
        asm volatile("" : "+s"(bar), "+s"(bx));
        __builtin_amdgcn_s_waitcnt(0);
        unsigned nloc = b.st[0], nx = b.st[1];
        if (nloc == 0u) { xcd_barrier_complete(bar, bx, nloc, nx); b.st[0] = nloc; b.st[1] = nx; }
        const unsigned old = xb_add(&bar[XB_XSUB(bx)], 1u);
        const unsigned gen = old / nloc;
        if (old + 1u == (gen + 1u) * nloc) {
            __builtin_amdgcn_fence(__ATOMIC_RELEASE, "agent");
            asm volatile("s_waitcnt vmcnt(0)" ::: "memory");
            const unsigned og = xb_add(&bar[XB_TOP], 1u);
            const unsigned tg = og / nx;
            if (og + 1u == (tg + 1u) * nx) xb_add(&bar[XB_TOPGEN], 1u);
            else XB_SPIN(xb_ld(&bar[XB_TOPGEN]) == tg, bar);
            __builtin_amdgcn_fence(__ATOMIC_ACQUIRE, "agent");
            xb_add(&bar[XB_XGEN(bx)], 1u);
            asm volatile("s_waitcnt vmcnt(0)" ::: "memory");
        } else {
            XB_SPIN(xb_ld(&bar[XB_XGEN(bx)]) == gen, bar);
            __builtin_amdgcn_fence(__ATOMIC_ACQUIRE, "agent");
            asm volatile("s_waitcnt vmcnt(0)" ::: "memory");
        }
    }
    __syncthreads();
}

struct Args { const float* in[26]; float* out; unsigned char* ws; int s_lo, s_hi; };
enum { I_X = 0, I_C, I_CTX, I_CCTX, I_N1G, I_N2G, I_WMOD, I_BMOD, I_WIN, I_RETDEC, I_SINK, I_MU, I_W0, I_WUP, I_A0, I_AUP, I_GUP, I_KK, I_KA, I_RK, I_LNG, I_WBR, I_WOUT, I_WFF1, I_WFF2, I_FING };
struct Frame {
    LAS unsigned char* lds;
    unsigned* ctl;
    int tid, lane, wave, G, wg;
    unsigned char* ws;
};
template <class T> __device__ __forceinline__ T* wsp(const Frame& F, size_t off) { return (T*)(F.ws + off); }
constexpr int PTAB_OFF = LDSCTL_OFF + 64;
__device__ __forceinline__ const float* inp(const Frame& F, int i) {
    const LAS unsigned* t = (const LAS unsigned*)(F.lds + PTAB_OFF) + 2 * i;
    const unsigned lo = __builtin_amdgcn_readfirstlane(t[0]), hi = __builtin_amdgcn_readfirstlane(t[1]);
    return (const float*)(((unsigned long long)hi << 32) | (unsigned long long)lo);
}

__device__ __forceinline__ int scan_row(int b, int dir, int s) {
    if (s < TCX) return ML + b * TCX + (dir ? (TCX - 1 - s) : s);
    const int t = s - TCX; return b * TL + (dir ? (TL - 1 - t) : t);
}

__device__ __forceinline__ void transpose_item(const float* W, int K, int N, bf16* WT, LAS float* scr, int item, int lane) {
    const int nblk = N / 32, kb = item / nblk, nb = item % nblk, k0 = 64 * kb, n0 = 32 * nb;
#pragma unroll 8
    for (int i = 0; i < 32; ++i) { const int kk = 2 * i + (lane >> 5); scr[kk * 33 + (lane & 31)] = W[(size_t)(k0 + kk) * N + n0 + (lane & 31)]; }
    LDS_WAIT(); asm volatile("" ::: "memory");
    const int c = lane & 7;
#pragma unroll
    for (int j = 0; j < 4; ++j) { const int n = (lane >> 3) + 8 * j; const LAS float* s = scr + (8 * c) * 33 + n;
        u32x4 o; o.x = pk2(s[0 * 33], s[1 * 33]); o.y = pk2(s[2 * 33], s[3 * 33]); o.z = pk2(s[4 * 33], s[5 * 33]); o.w = pk2(s[6 * 33], s[7 * 33]);
        *(u32x4*)(WT + (size_t)(n0 + n) * K + k0 + 8 * c) = o; }
    LDS_WAIT(); asm volatile("" ::: "memory");
}
__device__ __forceinline__ void p0_prologue(Frame& F) {
    const int gw = F.wg * NWAVES + F.wave, NGW = F.G * NWAVES;
    const int gt = F.wg * NTHR + F.tid, NGT = F.G * NTHR;
    LAS float* sil = (LAS float*)(F.lds + 81920);
    for (int e = F.tid; e < 5 * DM; e += NTHR) { const int r = e / DM, k = e % DM; const float v = r < 4 ? inp(F, I_C)[r * DM + k] : inp(F, I_CCTX)[k]; sil[e] = v * sigm(v); }
    {
        LAS float* scr = (LAS float*)(F.lds + F.wave * 8704);
        constexpr int IT_IN = (DM / 64) * (NIN / 32), IT_BR = (BW / 64) * (DM / 32), IT_OUT = (DM / 64) * (DM / 32), IT_F1 = (DM / 64) * (DFF / 32), IT_F2 = (DFF / 64) * (DM / 32);
        constexpr int IT_L = IT_IN + 3 * IT_BR + IT_OUT + IT_F1 + IT_F2;
        for (int it = gw; it < NL * IT_L; it += NGW) {
            const int l = it / IT_L; int r = it % IT_L;
            if (r < IT_IN) { transpose_item(inp(F, I_WIN) + (size_t)l * DM * NIN, DM, NIN, wsp<bf16>(F, WS_WIN + l * SZ_WIN), scr, r, F.lane); continue; } r -= IT_IN;
            if (r < 3 * IT_BR) { const int n = r / IT_BR; transpose_item(inp(F, I_WBR) + ((size_t)l * 3 + n) * BW * DM, BW, DM, wsp<bf16>(F, WS_WBR + l * SZ_WBR) + (size_t)n * DM * BW, scr, r % IT_BR, F.lane); continue; } r -= 3 * IT_BR;
            if (r < IT_OUT) { transpose_item(inp(F, I_WOUT) + (size_t)l * DM * DM, DM, DM, wsp<bf16>(F, WS_WOUT + l * SZ_WOUT), scr, r, F.lane); continue; } r -= IT_OUT;
            if (r < IT_F1) { transpose_item(inp(F, I_WFF1) + (size_t)l * DM * DFF, DM, DFF, wsp<bf16>(F, WS_WFF1 + l * SZ_WFF), scr, r, F.lane); continue; } r -= IT_F1;
            transpose_item(inp(F, I_WFF2) + (size_t)l * DFF * DM, DFF, DM, wsp<bf16>(F, WS_WFF2 + l * SZ_WFF), scr, r, F.lane);
        }
    }
    for (int e = gt; e < NL * (LDP - NIN) * DM / 8; e += NGT) { const int l = e / ((LDP - NIN) * DM / 8), r = e % ((LDP - NIN) * DM / 8);
        *(u32x4*)(wsp<bf16>(F, WS_WIN + l * SZ_WIN) + (size_t)NIN * DM + (size_t)r * 8) = (u32x4){0u, 0u, 0u, 0u}; }
    for (int e = gt; e < NL * NLR * KLR; e += NGT) {
        const int l = e / (NLR * KLR), r = e % (NLR * KLR), n = r / KLR, k = r % KLR; float v = 0.f;
        if (n < 2048) { const int d = n >> 10, c = n & 1023; if (k >= 64 * d && k < 64 * d + 64) v = inp(F, I_WUP)[(((size_t)l * 2 + d) * 64 + (k - 64 * d)) * BW + c]; }
        else if (n < 4096) { const int d = (n - 2048) >> 10, c = n & 1023; if (k >= 128 + 64 * d && k < 192 + 64 * d) v = inp(F, I_AUP)[(((size_t)l * 2 + d) * 64 + (k - 128 - 64 * d)) * BW + c]; }
        else { const int c = n - 4096; if (k >= 256) v = inp(F, I_GUP)[((size_t)l * 128 + (k - 256)) * BW + c]; }
        wsp<bf16>(F, WS_WLR + l * SZ_WLR)[r] = (bf16)f2bf(v);
    }
    { const f32x4* x4 = (const f32x4*)inp(F, I_X); const f32x4* c4 = (const f32x4*)inp(F, I_CTX); f32x4* h4 = wsp<f32x4>(F, WS_H);
      for (int e = gt; e < ML * DM / 4; e += NGT) h4[e] = x4[e];
      for (int e = gt; e < MC * DM / 4; e += NGT) h4[ML * DM / 4 + e] = c4[e]; }
    if (gt < 64 * 32) { const int pos = gt >> 5, i = gt & 31; const float inv = powf(10000.0f, -(float)i / 32.0f); const float ang = (float)pos * inv;
        wsp<float>(F, WS_ROPE)[2 * gt] = cosf(ang); wsp<float>(F, WS_ROPE)[2 * gt + 1] = sinf(ang); }
    __syncthreads();
    for (int it = gw; it < NL * 8 * 48; it += NGW) {
        const int l = it / (8 * 48), kc = (it / 48) % 8, cc = it % 48, col = cc * 256 + F.lane * 4, k0 = kc * 256;
        const float* wp = inp(F, I_WMOD) + ((size_t)l * DM + k0) * 12288 + col;
        f32x4 a0 = {0.f, 0.f, 0.f, 0.f}, a1 = a0, a2 = a0, a3 = a0, a4 = a0;
#pragma unroll 8
        for (int k = 0; k < 256; ++k) { const f32x4 w = *(const f32x4*)(wp + (size_t)k * 12288);
            a0 += sil[0 * DM + k0 + k] * w; a1 += sil[1 * DM + k0 + k] * w; a2 += sil[2 * DM + k0 + k] * w; a3 += sil[3 * DM + k0 + k] * w; a4 += sil[4 * DM + k0 + k] * w; }
        float* mp = wsp<float>(F, WS_MODP) + ((size_t)(kc * NL + l) * 5) * 12288 + col;
        *(f32x4*)(mp) = a0; *(f32x4*)(mp + 12288) = a1; *(f32x4*)(mp + 2 * 12288) = a2; *(f32x4*)(mp + 3 * 12288) = a3; *(f32x4*)(mp + 4 * 12288) = a4;
    }
}
__device__ __forceinline__ void p1_modreduce(Frame& F) {
    const int gt = F.wg * NTHR + F.tid, NGT = F.G * NTHR;
    for (int e = gt; e < NL * 5 * 12288; e += NGT) { const int l = e / (5 * 12288), j = e % 12288;
        float s = inp(F, I_BMOD)[l * 12288 + j];
#pragma unroll
        for (int kc = 0; kc < 8; ++kc) s += wsp<float>(F, WS_MODP)[(size_t)kc * NL * 5 * 12288 + e];
        wsp<float>(F, WS_MOD)[e] = s; }
}

__device__ __forceinline__ void norm_phase(Frame& F, int layer, int which, int nrows) {
    const int gw = F.wg * NWAVES + F.wave, NGW = F.G * NWAVES;
    const float* gptr = inp(F, which ? I_N2G : I_N1G) + layer * DM;
    for (int row = gw; row < nrows; row += NGW) {
        const int mr = row < ML ? (row >> 11) : 4;
        const float* mod = wsp<float>(F, WS_MOD) + ((size_t)layer * 5 + mr) * 12288 + (which ? 3 * DM : 0);
        const f32x4* xr = (const f32x4*)(wsp<float>(F, WS_H) + (size_t)row * DM) + F.lane;
        f32x4 v[8]; float ss = 0.f;
#pragma unroll
        for (int j = 0; j < 8; ++j) { v[j] = xr[64 * j]; ss += (v[j].x * v[j].x + v[j].y * v[j].y) + (v[j].z * v[j].z + v[j].w * v[j].w); }
        const float rs = 1.0f / sqrtf(wave_sum(ss, F.lane) * (1.0f / DM) + 1e-6f);
        u32x2* o = (u32x2*)(wsp<bf16>(F, WS_U) + (size_t)row * DM) + F.lane;
#pragma unroll
        for (int j = 0; j < 8; ++j) { const int c = 4 * F.lane + 256 * j;
            const f32x4 g = *(const f32x4*)(gptr + c), sh = *(const f32x4*)(mod + c), sc = *(const f32x4*)(mod + DM + c);
            const f32x4 y = (v[j] * rs) * g * (1.0f + sc) + sh;
            u32x2 w; w.x = pk2(y.x, y.y); w.y = pk2(y.z, y.w); o[64 * j] = w; }
    }
}
__device__ __forceinline__ void final_norm(Frame& F, float* out) {
    const int gw = F.wg * NWAVES + F.wave, NGW = F.G * NWAVES;
    for (int row = gw; row < ML; row += NGW) {
        const f32x4* xr = (const f32x4*)(wsp<float>(F, WS_H) + (size_t)row * DM) + F.lane;
        f32x4 v[8]; float ss = 0.f;
#pragma unroll
        for (int j = 0; j < 8; ++j) { v[j] = xr[64 * j]; ss += (v[j].x * v[j].x + v[j].y * v[j].y) + (v[j].z * v[j].z + v[j].w * v[j].w); }
        const float rs = 1.0f / sqrtf(wave_sum(ss, F.lane) * (1.0f / DM) + 1e-6f);
        f32x4* o = (f32x4*)(out + (size_t)row * DM) + F.lane;
#pragma unroll
        for (int j = 0; j < 8; ++j) { const f32x4 g = *(const f32x4*)(inp(F, I_FING) + 4 * F.lane + 256 * j); o[64 * j] = (v[j] * rs) * g; }
    }
}
__device__ __forceinline__ void prep_phase(Frame& F, int layer) {
    const int gw = F.wg * NWAVES + F.wave, NGW = F.G * NWAVES;
    const bf16* P = wsp<bf16>(F, WS_P);
    const float* mu0 = inp(F, I_MU) + (size_t)layer * 2 * RWIN; const float* mu1 = mu0 + RWIN;
    const float* rope = wsp<float>(F, WS_ROPE);
    for (int row = gw; row < MT; row += NGW) {
        bool first, last; int t = 0;
        if (row < ML) { t = row & (TL - 1); first = t == 0; last = t == TL - 1; } else { const int c = (row - ML) & (TCX - 1); first = c == 0; last = c == TCX - 1; }
        const bf16* pr = P + (size_t)row * LDP + C_RW;
        float* xs = wsp<float>(F, WS_XS) + (size_t)row * 3072; bf16* alr = wsp<bf16>(F, WS_ALR) + (size_t)row * KLR;
        for (int j2 = F.lane; j2 < RWIN / 2; j2 += 64) {
            const int c = 2 * j2;
            const unsigned pw = *(const unsigned*)(pr + c);
            const unsigned vw = first ? 0u : *(const unsigned*)(pr - LDP + c);
            const unsigned nw = last ? 0u : *(const unsigned*)(pr + LDP + c);
            const float p0 = __uint_as_float(pw << 16), p1 = __uint_as_float(pw & 0xffff0000u);
            const float v0 = __uint_as_float(vw << 16), v1 = __uint_as_float(vw & 0xffff0000u);
            const float n0 = __uint_as_float(nw << 16), n1 = __uint_as_float(nw & 0xffff0000u);
            const f32x2 m0 = *(const f32x2*)(mu0 + c), m1 = *(const f32x2*)(mu1 + c);
            const float s0 = p0 + m0.x * (v0 - p0) + m1.x * (n0 - p0), s1 = p1 + m0.y * (v1 - p1) + m1.y * (n1 - p1);
            if (c < 3072) { *(f32x2*)(xs + c) = (f32x2){s0, s1}; }
            else if (c < 3200) { *(unsigned*)(alr + (c - 3072)) = pk2(tanhf(s0), tanhf(s1)); }
            else if (c < 3328) { *(unsigned*)(alr + 128 + (c - 3200)) = pk2(s0, s1); }
            else { *(unsigned*)(alr + 256 + (c - 3328)) = pk2(sigm(s0), sigm(s1)); }
        }
        const bf16* ps = P + (size_t)row * LDP + C_SWA; bf16* qk = wsp<bf16>(F, WS_QKR) + (size_t)row * NQK;
        const bool lat = row < ML; const int rr = t >> 6, cc = t & 63;
#pragma unroll
        for (int it = 0; it < 5; ++it) { const int idx = it * 64 + F.lane, hd = idx >> 5, i = idx & 31;
            const float x1r = bf2f(ps[hd * 128 + i]), x2r = bf2f(ps[hd * 128 + 32 + i]), x1c = bf2f(ps[hd * 128 + 64 + i]), x2c = bf2f(ps[hd * 128 + 96 + i]);
            float cr = 1.f, sr = 0.f, ccs = 1.f, scs = 0.f;
            if (lat) { cr = rope[(rr * 32 + i) * 2]; sr = rope[(rr * 32 + i) * 2 + 1]; ccs = rope[(cc * 32 + i) * 2]; scs = rope[(cc * 32 + i) * 2 + 1]; }
            qk[hd * 128 + i] = (bf16)f2bf(x1r * cr - x2r * sr); qk[hd * 128 + 32 + i] = (bf16)f2bf(x2r * cr + x1r * sr);
            qk[hd * 128 + 64 + i] = (bf16)f2bf(x1c * ccs - x2c * scs); qk[hd * 128 + 96 + i] = (bf16)f2bf(x2c * ccs + x1c * scs); }
    }
}

__device__ __forceinline__ float red8(float v) {
    v += __int_as_float(__builtin_amdgcn_update_dpp(0, __float_as_int(v), 0xB1, 0xF, 0xF, true));
    v += __int_as_float(__builtin_amdgcn_update_dpp(0, __float_as_int(v), 0x4E, 0xF, 0xF, true));
    v += __int_as_float(__builtin_amdgcn_update_dpp(0, __float_as_int(v), 0x141, 0xF, 0xF, true));
    return v;
}
struct RwPre { f32x4 r4, k4, v4, lw, la; };
__device__ __forceinline__ void rwkv_scan_unit(Frame& F, int layer, int unit) {
    const int dir = unit & 1, h = (unit >> 1) & 15, b = unit >> 5;
    constexpr int BUF = 7 * 2048;
    LAS float* const base = (LAS float*)F.lds;
    const float* XS = wsp<float>(F, WS_XS); const float* LR = wsp<float>(F, WS_LR); float* YD = wsp<float>(F, WS_YDW) + (size_t)dir * MT * BW;
    const int vrow = F.tid >> 3, kq = F.tid & 7;
    const int ptok = F.tid >> 4, pj = (F.tid & 15) * 4, pc = h * 64 + pj;
    const f32x4 w0v = *(const f32x4*)(inp(F, I_W0) + ((size_t)layer * 2 + dir) * BW + pc), a0v = *(const f32x4*)(inp(F, I_A0) + ((size_t)layer * 2 + dir) * BW + pc);
    const f32x4 kkv = *(const f32x4*)(inp(F, I_KK) + (size_t)layer * BW + pc), kav = *(const f32x4*)(inp(F, I_KA) + (size_t)layer * BW + pc);
    auto fetch = [&](int blk, RwPre& p) {
        const int row = scan_row(b, dir, blk * SCAN_BLK + ptok);
        p.r4 = *(const f32x4*)(XS + (size_t)row * 3072 + pc); p.k4 = *(const f32x4*)(XS + (size_t)row * 3072 + 1024 + pc); p.v4 = *(const f32x4*)(XS + (size_t)row * 3072 + 2048 + pc);
        p.lw = *(const f32x4*)(LR + (size_t)row * NLR + dir * 1024 + pc); p.la = *(const f32x4*)(LR + (size_t)row * NLR + 2048 + dir * 1024 + pc);
    };
    auto derive = [&](const RwPre& p, LAS float* buf) {
        f32x4 dec, av, kk, kd; float ssq = 0.f;
#pragma unroll
        for (int e = 0; e < 4; ++e) { dec[e] = __expf(-0.6065306597126334f * sigm(w0v[e] + p.lw[e])); av[e] = sigm(a0v[e] + p.la[e]); kk[e] = p.k4[e] * kkv[e]; ssq += kk[e] * kk[e];
            kd[e] = p.k4[e] * (1.0f + (av[e] - 1.0f) * kav[e]); }
        ssq += __int_as_float(__builtin_amdgcn_update_dpp(0, __float_as_int(ssq), 0xB1, 0xF, 0xF, true));
        ssq += __int_as_float(__builtin_amdgcn_update_dpp(0, __float_as_int(ssq), 0x4E, 0xF, 0xF, true));
        ssq += __int_as_float(__builtin_amdgcn_update_dpp(0, __float_as_int(ssq), 0x141, 0xF, 0xF, true));
        ssq += __int_as_float(__builtin_amdgcn_update_dpp(0, __float_as_int(ssq), 0x140, 0xF, 0xF, true));
        const float inv = 1.0f / fmaxf(sqrtf(ssq), 1e-12f);
        f32x4 an, bn;
#pragma unroll
        for (int e = 0; e < 4; ++e) { const float kn = kk[e] * inv; an[e] = -kn; bn[e] = kn * av[e]; }
        const int o = ptok * 64 + pj;
        *(LAS f32x4*)(buf + o) = p.r4; *(LAS f32x4*)(buf + 2048 + o) = dec; *(LAS f32x4*)(buf + 4096 + o) = kd; *(LAS f32x4*)(buf + 6144 + o) = p.v4; *(LAS f32x4*)(buf + 8192 + o) = an; *(LAS f32x4*)(buf + 10240 + o) = bn;
    };
    f32x2 S0 = {0.f, 0.f}, S1 = S0, S2 = S0, S3 = S0;
    RwPre pre;
    __syncthreads();
    fetch(0, pre); derive(pre, base);
    __syncthreads();
    constexpr int NBLK = NSTEP / SCAN_BLK;
    for (int blk = 0; blk < NBLK; ++blk) {
        LAS float* cur = base + (blk & 1) * BUF; LAS float* nxt = base + ((blk + 1) & 1) * BUF;
        if (blk + 1 < NBLK) fetch(blk + 1, pre);
        const LAS float* Rl = cur; const LAS float* Wl = cur + 2048; const LAS float* Kl = cur + 4096; const LAS float* Vl = cur + 6144; const LAS float* Al = cur + 8192; const LAS float* Bl = cur + 10240; LAS float* Yl = cur + 12288;
#pragma unroll 4
        for (int tok = 0; tok < SCAN_BLK; ++tok) {
            const int o = tok * 64 + 8 * kq;
            const f32x4 a0 = *(const LAS f32x4*)(Al + o), a1 = *(const LAS f32x4*)(Al + o + 4), w0 = *(const LAS f32x4*)(Wl + o), w1 = *(const LAS f32x4*)(Wl + o + 4);
            const f32x4 b0 = *(const LAS f32x4*)(Bl + o), b1 = *(const LAS f32x4*)(Bl + o + 4), k0 = *(const LAS f32x4*)(Kl + o), k1 = *(const LAS f32x4*)(Kl + o + 4);
            const f32x4 r0 = *(const LAS f32x4*)(Rl + o), r1 = *(const LAS f32x4*)(Rl + o + 4); const float vv = Vl[tok * 64 + vrow];
            f32x2 t = S0 * a0.xy; t += S1 * a0.zw; f32x2 t2 = S2 * a1.xy; t2 += S3 * a1.zw; t += t2;
            const float sa = red8(t.x + t.y);
            const f32x2 sa2 = {sa, sa}, vv2 = {vv, vv};
            S0 = S0 * w0.xy + (sa2 * b0.xy + vv2 * k0.xy); S1 = S1 * w0.zw + (sa2 * b0.zw + vv2 * k0.zw);
            S2 = S2 * w1.xy + (sa2 * b1.xy + vv2 * k1.xy); S3 = S3 * w1.zw + (sa2 * b1.zw + vv2 * k1.zw);
            f32x2 u = S0 * r0.xy; u += S1 * r0.zw; f32x2 u2 = S2 * r1.xy; u2 += S3 * r1.zw; u += u2;
            const float y = red8(u.x + u.y);
            if (kq == 0) Yl[tok * 64 + vrow] = y;
        }
        if (blk + 1 < NBLK) derive(pre, nxt);
        __syncthreads();
        { const int e = F.tid * 4, tok = e >> 6, j = e & 63; const int row = scan_row(b, dir, blk * SCAN_BLK + tok);
          *(f32x4*)(YD + (size_t)row * BW + h * 64 + j) = *(const LAS f32x4*)(Yl + e); }
    }
    __syncthreads();
}
typedef short bf16x8 __attribute__((ext_vector_type(8)));
typedef short s16x4 __attribute__((ext_vector_type(4)));
typedef float f32x16 __attribute__((ext_vector_type(16)));
typedef __bf16 bf16x2_t __attribute__((ext_vector_type(2)));
#define MFMA32(a, b, c) __builtin_amdgcn_mfma_f32_32x32x16_bf16((a), (b), (c), 0, 0, 0)
__device__ __forceinline__ int crow(int reg, int h) { return (reg & 3) + 8 * (reg >> 2) + 4 * h; }
__device__ __forceinline__ unsigned cvtpk(float lo, float hi) { f32x2 v = {lo, hi}; bf16x2_t b = __builtin_convertvector(v, bf16x2_t); return __builtin_bit_cast(unsigned, b); }
__device__ __forceinline__ s16x4 tr16(const LAS unsigned char* p) { return __builtin_bit_cast(s16x4, __builtin_amdgcn_ds_read_tr16_b64_v4i16((LAS s16x4*)p)); }
__device__ __forceinline__ bf16x8 frag_rm(const LAS unsigned char* base, int pitch, int r0, int k0, int lane) {
    return *(const LAS bf16x8*)(base + (r0 + (lane & 31)) * pitch + (k0 + 8 * (lane >> 5)) * 2);
}
template <bool PERM> __device__ __forceinline__ bf16x8 frag_tr(const LAS unsigned char* base, int pitch, int k0, int r0, int lane) {
    const int g = lane >> 4, i = lane & 15, q = i >> 2, p = i & 3, h = g >> 1;
    const LAS unsigned char* a = base + (k0 + (PERM ? 4 : 8) * h + q) * pitch + (r0 + 16 * (g & 1) + 4 * p) * 2;
    const s16x4 lo = tr16(a), hi = tr16(a + (PERM ? 8 : 4) * pitch);
    return __builtin_shufflevector(lo, hi, 0, 1, 2, 3, 4, 5, 6, 7);
}
__device__ __forceinline__ bf16x8 pack_step(const f32x16& x, int s) {
    u32x4 p; p.x = cvtpk(x[8 * s + 0], x[8 * s + 1]); p.y = cvtpk(x[8 * s + 2], x[8 * s + 3]); p.z = cvtpk(x[8 * s + 4], x[8 * s + 5]); p.w = cvtpk(x[8 * s + 6], x[8 * s + 7]);
    return __builtin_bit_cast(bf16x8, p);
}
__device__ __forceinline__ f32x16 zero16() { f32x16 z; for (int i = 0; i < 16; ++i) z[i] = 0.f; return z; }
constexpr int TP = 272;
constexpr int TILE_B = 128 * TP;
__device__ __forceinline__ void load_tile128(LAS unsigned char* dst, const bf16* src, size_t ld, int tid) {
#pragma unroll
    for (int it = 0; it < 4; ++it) { const int idx = tid + NTHR * it, row = idx >> 4, ch = idx & 15;
        *(LAS u32x4*)(dst + row * TP + ch * 16) = *(const u32x4*)(src + (size_t)row * ld + ch * 8); }
}

__device__ __forceinline__ void swa_unit(Frame& F, int layer, int unit) {
    const bf16* QK = wsp<bf16>(F, WS_QKR); const bf16* P = wsp<bf16>(F, WS_P);
    LAS unsigned char* Qt = F.lds; LAS unsigned char* Kt = F.lds + TILE_B; LAS unsigned char* Vt = F.lds + 2 * TILE_B;
    LAS float* stat = (LAS float*)(F.lds + 3 * TILE_B) + F.wave * 32;
    const int lane = F.lane, h = lane >> 5, wi = F.wave & 3, wh = F.wave >> 2;
    int b, qh, n, qrow0; bool isctx;
    if (unit < 512) { b = unit >> 7; qh = (unit >> 4) & 7; n = unit & 15; qrow0 = b * TL + n * 128; isctx = false; }
    else { const int u = unit - 512; b = u >> 4; qh = (u >> 1) & 7; n = u & 1; qrow0 = ML + b * TCX + n * 128; isctx = true; }
    const int kvh = qh >> 2;
    __syncthreads();
    load_tile128(Qt, QK + (size_t)qrow0 * NQK + qh * 128, NQK, F.tid);
    __syncthreads();
    bf16x8 qf[8];
#pragma unroll
    for (int ks = 0; ks < 8; ++ks) qf[ks] = frag_rm(Qt, TP, 32 * wi, 16 * ks, lane);
    const float L2E = 1.4426950408889634f, SC = 0.08838834764831845f * L2E;
    float m = inp(F, I_SINK)[layer * 8 + qh] * L2E, l = h == 0 ? 1.0f : 0.0f;
    f32x16 O0 = zero16(), O1 = zero16();
    const int iq = 32 * wi + (lane & 31);
    const int nch = isctx ? 2 : 5;
    for (int c = 0; c < nch; ++c) {
        int krow0, mtype = 0;
        if (isctx) krow0 = ML + b * TCX + c * 128;
        else if (c < 3) { const int kb = n - 1 + c; if (kb < 0 || kb > 15) continue; krow0 = b * TL + kb * 128; mtype = c == 0 ? 1 : (c == 2 ? 2 : 0); }
        else krow0 = ML + b * TCX + (c - 3) * 128;
        __syncthreads();
        load_tile128(Kt, QK + (size_t)krow0 * NQK + 1024 + kvh * 128, NQK, F.tid);
        load_tile128(Vt, P + (size_t)krow0 * LDP + C_SWA + 1280 + kvh * 128, LDP, F.tid);
        __syncthreads();
        for (int kb = 0; kb < 4; ++kb) {
            f32x16 X = zero16();
#pragma unroll
            for (int ks = 0; ks < 8; ++ks) X = MFMA32(frag_rm(Kt, TP, 32 * kb, 16 * ks, lane), qf[ks], X);
            float bm = -INFINITY;
            int iql = iq - 32 * kb; asm volatile("" : "+v"(iql));
#pragma unroll
            for (int r = 0; r < 16; ++r) { const int d = iql - crow(r, h); float s = X[r] * SC;
                const bool ok = mtype == 0 || (mtype == 1 ? d <= 0 : d >= 0);
                s = ok ? s : -INFINITY; X[r] = s; bm = fmaxf(bm, s); }
            bm = fmaxf(bm, shx(bm, 32, lane));
            const float mn = fmaxf(m, bm), sc = __builtin_amdgcn_exp2f(m - mn); m = mn;
            float ps = 0.f;
#pragma unroll
            for (int r = 0; r < 16; ++r) { const float p = __builtin_amdgcn_exp2f(X[r] - mn); X[r] = p; ps += p; }
            l = l * sc + ps;
            const bf16x8 pa0 = pack_step(X, 0), pa1 = pack_step(X, 1);
            if (h == 0) stat[lane] = sc;
            LDS_WAIT();
#pragma unroll
            for (int g = 0; g < 4; ++g) { const f32x4 sv = *(const LAS f32x4*)(stat + 8 * g + 4 * h);
#pragma unroll
                for (int e = 0; e < 4; ++e) { O0[4 * g + e] *= sv[e]; O1[4 * g + e] *= sv[e]; } }
            O0 = MFMA32(pa0, frag_tr<true>(Vt, TP, 32 * kb, 64 * wh, lane), O0);
            O0 = MFMA32(pa1, frag_tr<true>(Vt, TP, 32 * kb + 16, 64 * wh, lane), O0);
            O1 = MFMA32(pa0, frag_tr<true>(Vt, TP, 32 * kb, 64 * wh + 32, lane), O1);
            O1 = MFMA32(pa1, frag_tr<true>(Vt, TP, 32 * kb + 16, 64 * wh + 32, lane), O1);
        }
    }
    l += shx(l, 32, lane);
    if (h == 0) stat[lane] = 1.0f / l;
    LDS_WAIT();
    bf16* yo = wsp<bf16>(F, WS_Y) + (size_t)(qrow0 + 32 * wi) * 3072 + 1024 + qh * 128 + 64 * wh + (lane & 31);
#pragma unroll
    for (int g = 0; g < 4; ++g) { const f32x4 sv = *(const LAS f32x4*)(stat + 8 * g + 4 * h);
#pragma unroll
        for (int e = 0; e < 4; ++e) { const int r = 8 * g + 4 * h + e; yo[(size_t)r * 3072] = (bf16)f2bf(O0[4 * g + e] * sv[e]); yo[(size_t)r * 3072 + 32] = (bf16)f2bf(O1[4 * g + e] * sv[e]); } }
}

constexpr size_t ST_CHUNK = (size_t)128 * 128;
__device__ __forceinline__ int ret_chunk_row0(int b, int jF) { return jF < 2 ? ML + b * TCX + jF * 128 : b * TL + (jF - 2) * 128; }
__device__ __forceinline__ void ret_state_unit(Frame& F, int layer, int unit) {
    const int dvq = unit & 3, dir = (unit >> 2) & 1, hh = (unit >> 3) & 7, b = unit >> 6;
    const bf16* P = wsp<bf16>(F, WS_P);
    bf16* ST = wsp<bf16>(F, WS_ST) + ((size_t)((b * 8 + hh) * 2 + dir) * 18) * ST_CHUNK;
    const float gam = sigm(inp(F, I_RETDEC)[(layer * 2 + dir) * 8 + hh]); const float lg2 = __builtin_amdgcn_logf(gam);
    const float gC = __builtin_amdgcn_exp2f(lg2 * 128.0f);
    LAS unsigned char* Kt = F.lds; LAS unsigned char* Vt = F.lds + TILE_B;
    constexpr int VP = 80;
    const int lane = F.lane, h = lane >> 5, w = F.wave;
    f32x16 acc = zero16();
    for (int c = 0; c < 18; ++c) {
        const int jF = dir == 0 ? c : (c < 2 ? 1 - c : 19 - c);
        const int row0 = ret_chunk_row0(b, jF);
        __syncthreads();
#pragma unroll
        for (int it = 0; it < 4; ++it) { const int idx = F.tid + NTHR * it, tp = idx >> 4, ch = idx & 15; const int row = row0 + (dir ? 127 - tp : tp);
            *(LAS u32x4*)(Kt + tp * TP + ch * 16) = *(const u32x4*)(P + (size_t)row * LDP + C_RET + 1024 + hh * 128 + ch * 8); }
        { const int tp = F.tid >> 2, ch = F.tid & 3; const int row = row0 + (dir ? 127 - tp : tp);
          *(LAS u32x4*)(Vt + tp * VP + ch * 16) = *(const u32x4*)(P + (size_t)row * LDP + C_RET + 2048 + hh * 128 + dvq * 32 + ch * 8); }
        __syncthreads();
        if (w < 4) {
            int hl = h; asm volatile("" : "+v"(hl));
            bf16* so = ST + (size_t)jF * ST_CHUNK + (size_t)(dvq * 32) * 128 + 32 * w + (lane & 31);
#pragma unroll
            for (int r = 0; r < 16; ++r) so[(size_t)crow(r, h) * 128] = (bf16)f2bf(acc[r]);
#pragma unroll
            for (int r = 0; r < 16; ++r) acc[r] *= gC;
#pragma unroll
            for (int ks = 0; ks < 8; ++ks) {
                bf16x8 a = frag_tr<false>(Vt, VP, 16 * ks, 0, lane);
                u32x4 aw = __builtin_bit_cast(u32x4, a); u32x4 ow;
#pragma unroll
                for (int e = 0; e < 4; ++e) { const int t0 = 16 * ks + 8 * hl + 2 * e;
                    const float f0 = __builtin_amdgcn_exp2f(lg2 * (float)(127 - t0)) * 0.08838834764831845f, f1 = __builtin_amdgcn_exp2f(lg2 * (float)(126 - t0)) * 0.08838834764831845f;
                    ow[e] = cvtpk(bf_lo(aw[e]) * f0, bf_hi(aw[e]) * f1); }
                acc = MFMA32(__builtin_bit_cast(bf16x8, ow), frag_tr<false>(Kt, TP, 16 * ks, 32 * w, lane), acc);
            }
        }
    }
    __syncthreads();
}
__device__ __forceinline__ void ret_out_unit(Frame& F, int layer, int unit) {
    const int jF = unit % 18, hh = (unit / 18) & 7, b = unit / 144;
    const bf16* P = wsp<bf16>(F, WS_P);
    const int row0 = ret_chunk_row0(b, jF);
    LAS unsigned char* Qt = F.lds; LAS unsigned char* Kt = F.lds + TILE_B; LAS unsigned char* Vt = F.lds + 2 * TILE_B;
    const int lane = F.lane, h = lane >> 5, wi = F.wave & 3, wh = F.wave >> 2;
    const float lgf = __builtin_amdgcn_logf(sigm(inp(F, I_RETDEC)[(layer * 2 + 0) * 8 + hh])), lgb = __builtin_amdgcn_logf(sigm(inp(F, I_RETDEC)[(layer * 2 + 1) * 8 + hh]));
    __syncthreads();
    load_tile128(Qt, P + (size_t)row0 * LDP + C_RET + hh * 128, LDP, F.tid);
    load_tile128(Kt, P + (size_t)row0 * LDP + C_RET + 1024 + hh * 128, LDP, F.tid);
    load_tile128(Vt, P + (size_t)row0 * LDP + C_RET + 2048 + hh * 128, LDP, F.tid);
    __syncthreads();
    f32x16 Y0 = zero16(), Y1 = zero16();
    const int iq = 32 * wi + (lane & 31);
    for (int jb = 0; jb < 4; ++jb) {
        f32x16 X = zero16();
#pragma unroll
        for (int ks = 0; ks < 8; ++ks) X = MFMA32(frag_rm(Kt, TP, 32 * jb, 16 * ks, lane), frag_rm(Qt, TP, 32 * wi, 16 * ks, lane), X);
        int iql = iq - 32 * jb; asm volatile("" : "+v"(iql));
#pragma unroll
        for (int r = 0; r < 16; ++r) { const int d = iql - crow(r, h); const int ad = d < 0 ? -d : d;
            const float wgt = __builtin_amdgcn_exp2f((d > 0 ? lgf : lgb) * (float)ad) * (d == 0 ? 2.0f : 1.0f);
            X[r] *= wgt * 0.08838834764831845f; }
        const bf16x8 pa0 = pack_step(X, 0), pa1 = pack_step(X, 1);
        Y0 = MFMA32(pa0, frag_tr<true>(Vt, TP, 32 * jb, 64 * wh, lane), Y0);
        Y0 = MFMA32(pa1, frag_tr<true>(Vt, TP, 32 * jb + 16, 64 * wh, lane), Y0);
        Y1 = MFMA32(pa0, frag_tr<true>(Vt, TP, 32 * jb, 64 * wh + 32, lane), Y1);
        Y1 = MFMA32(pa1, frag_tr<true>(Vt, TP, 32 * jb + 16, 64 * wh + 32, lane), Y1);
    }
    __syncthreads();
    { const bf16* Sf = wsp<bf16>(F, WS_ST) + ((size_t)((b * 8 + hh) * 2 + 0) * 18 + jF) * ST_CHUNK; const bf16* Sb = wsp<bf16>(F, WS_ST) + ((size_t)((b * 8 + hh) * 2 + 1) * 18 + jF) * ST_CHUNK;
      load_tile128(Kt, Sf, 128, F.tid); load_tile128(Vt, Sb, 128, F.tid); }
    __syncthreads();
    {
        f32x16 T0 = zero16(), T1 = zero16(), U0 = zero16(), U1 = zero16();
#pragma unroll
        for (int ks = 0; ks < 8; ++ks) { const bf16x8 a = frag_rm(Qt, TP, 32 * wi, 16 * ks, lane);
            T0 = MFMA32(a, frag_rm(Kt, TP, 64 * wh, 16 * ks, lane), T0); T1 = MFMA32(a, frag_rm(Kt, TP, 64 * wh + 32, 16 * ks, lane), T1);
            U0 = MFMA32(a, frag_rm(Vt, TP, 64 * wh, 16 * ks, lane), U0); U1 = MFMA32(a, frag_rm(Vt, TP, 64 * wh + 32, 16 * ks, lane), U1); }
#pragma unroll
        for (int r = 0; r < 16; ++r) { const int i = 32 * wi + crow(r, h);
            const float ff = __builtin_amdgcn_exp2f(lgf * (float)(i + 1)), fb = __builtin_amdgcn_exp2f(lgb * (float)(128 - i));
            Y0[r] += ff * T0[r] + fb * U0[r]; Y1[r] += ff * T1[r] + fb * U1[r]; }
    }
    __syncthreads();
    LAS float* yl = (LAS float*)F.lds;
#pragma unroll
    for (int r = 0; r < 16; ++r) { const int i = 32 * wi + crow(r, h); yl[i * 132 + 64 * wh + (lane & 31)] = Y0[r]; yl[i * 132 + 64 * wh + 32 + (lane & 31)] = Y1[r]; }
    __syncthreads();
    { const int i = F.tid >> 2, part = F.tid & 3; const LAS float* yr = yl + i * 132 + 32 * part;
      f32x4 v[8]; float s = 0.f;
#pragma unroll
      for (int e = 0; e < 8; ++e) { v[e] = *(const LAS f32x4*)(yr + 4 * e); s += (v[e].x + v[e].y) + (v[e].z + v[e].w); }
      s += shx(s, 1, lane); s += shx(s, 2, lane); const float mean = s * (1.0f / 128.0f); float q = 0.f;
#pragma unroll
      for (int e = 0; e < 8; ++e) { v[e] = v[e] - mean; q += (v[e].x * v[e].x + v[e].y * v[e].y) + (v[e].z * v[e].z + v[e].w * v[e].w); }
      q += shx(q, 1, lane); q += shx(q, 2, lane); const float rs = 1.0f / sqrtf(q * (1.0f / 128.0f) + 1e-5f);
      const bf16* gp = P + (size_t)(row0 + i) * LDP + C_RET + 3072 + hh * 128 + 32 * part; bf16* yo = wsp<bf16>(F, WS_Y) + (size_t)(row0 + i) * 3072 + hh * 128 + 32 * part;
#pragma unroll
      for (int e2 = 0; e2 < 4; ++e2) { const u32x4 gw = *(const u32x4*)(gp + 8 * e2); u32x4 ow;
#pragma unroll
          for (int e = 0; e < 4; ++e) { const float g0 = bf_lo(gw[e]), g1 = bf_hi(gw[e]); const int vi = 2 * e2 + (e >> 1), vo = 2 * (e & 1);
              ow[e] = cvtpk(g0 * sigm(g0) * v[vi][vo] * rs, g1 * sigm(g1) * v[vi][vo + 1] * rs); }
          *(u32x4*)(yo + 8 * e2) = ow; } }
}

__device__ __forceinline__ void mix_phase(Frame& F, int layer, int qidx) {
    if (F.wg < 128) rwkv_scan_unit(F, layer, F.wg);
    const int nswa = (layer == NL - 1) ? 512 : 576;
    const int nitem = 256 + nswa;
    volatile LAS int* qslot = (volatile LAS int*)(F.lds + LDSCTL_OFF);
    for (;;) {
        __syncthreads();
        if (F.tid == 0) qslot[0] = (int)__hip_atomic_fetch_add(F.ctl + CW_SWAQ + 64 * qidx, 1u, __ATOMIC_RELAXED, __HIP_MEMORY_SCOPE_AGENT);
        __syncthreads();
        const int item = qslot[0];
        if (item >= nitem) break;
        if (item < 256) ret_state_unit(F, layer, item); else swa_unit(F, layer, item - 256);
    }
}
__device__ __forceinline__ void mixfin_phase(Frame& F, int layer, int nrows) {
    for (int u = F.wg; u < 576; u += F.G) { if (layer == NL - 1 && (u % 18) < 2) continue; ret_out_unit(F, layer, u); }
    __syncthreads();
    const int gw = F.wg * NWAVES + F.wave, NGW = F.G * NWAVES; const int lane = F.lane;
    const bf16* P = wsp<bf16>(F, WS_P); const float* XS = wsp<float>(F, WS_XS); const float* LR = wsp<float>(F, WS_LR);
    const float* Z0 = wsp<float>(F, WS_YDW); const float* Z1 = Z0 + (size_t)MT * BW;
    for (int row = gw; row < nrows; row += NGW) {
        bf16* yo = wsp<bf16>(F, WS_Y) + (size_t)row * 3072;
        for (int h = 0; h < 16; ++h) { const int c = h * 64 + lane; const size_t o = (size_t)row * BW + c;
            const float y = Z0[o] + Z1[o];
            const float mean = wave_sum(y, F.lane) * (1.0f / 64.0f); const float d = y - mean; const float var = wave_sum(d * d, F.lane) * (1.0f / 64.0f); const float rs = 1.0f / sqrtf(var + 64e-5f);
            const float r = XS[(size_t)row * 3072 + c], k = XS[(size_t)row * 3072 + 1024 + c], v = XS[(size_t)row * 3072 + 2048 + c];
            const float ka = inp(F, I_KA)[layer * BW + c], rk = inp(F, I_RK)[layer * BW + c];
            const float a0 = sigm(inp(F, I_A0)[((size_t)layer * 2 + 0) * BW + c] + LR[(size_t)row * NLR + 2048 + c]);
            const float a1 = sigm(inp(F, I_A0)[((size_t)layer * 2 + 1) * BW + c] + LR[(size_t)row * NLR + 3072 + c]);
            const float kd0 = k * (1.0f + (a0 - 1.0f) * ka), kd1 = k * (1.0f + (a1 - 1.0f) * ka);
            const float dot = wave_sum(r * (kd0 + kd1) * rk, F.lane);
            const float g = LR[(size_t)row * NLR + 4096 + c];
            const float outv = (d * rs * inp(F, I_LNG)[layer * BW + c] + dot * v) * g;
            const float nb = shx(outv, 1, F.lane);
            if (!(lane & 1)) *(unsigned*)(yo + 2048 + c) = pk2(outv, nb); }
    }
}

constexpr int NPH = 11;
constexpr int NSTEPS = 2 + NL * NPH + 1;
__global__ void __launch_bounds__(NTHR, 2) hyb_fwd(Args args) {
    extern __shared__ __attribute__((aligned(16))) unsigned char lds[];
    Frame F;
    F.lds = (LAS unsigned char*)lds;
    F.tid = threadIdx.x; F.lane = F.tid & 63; F.wave = __builtin_amdgcn_readfirstlane(F.tid >> 6);
    F.G = gridDim.x; F.wg = blockIdx.x; F.ws = args.ws; F.ctl = (unsigned*)(args.ws + WS_CTL);
    for (int u = F.tid; u < (LDS_BYTES - LDSCTL_OFF) / 4; u += NTHR) ((LAS unsigned*)(F.lds + LDSCTL_OFF))[u] = 0u;
    __syncthreads();
    if (F.tid < 26) { const __attribute__((address_space(4))) unsigned long long* kp = (const __attribute__((address_space(4))) unsigned long long*)__builtin_amdgcn_kernarg_segment_ptr();
        ((LAS unsigned long long*)(F.lds + PTAB_OFF))[F.tid] = kp[F.tid]; }
    __syncthreads();
    XcdBarrier bar = xcd_barrier_post(F.ctl + CW_BAR, (volatile LAS unsigned*)(F.lds + MISC_OFF) + 8);
    int lo = args.s_lo, hi = args.s_hi;
#define IN(k) (lo <= (k) && (k) < hi)
#define SL() asm volatile("" : "+s"(lo), "+s"(hi), "+s"(F.ws), "+s"(F.wg), "+s"(F.G))
#define LAUNDER() do { int t_ = threadIdx.x; asm volatile("" : "+v"(t_)); F.tid = t_; F.lane = t_ & 63; F.wave = __builtin_amdgcn_readfirstlane(t_ >> 6); } while (0)
#define SEAM(k) do { SL(); if (IN(k) && IN((k) + 1)) xcd_barrier(bar); } while (0)
    SL(); if (IN(0)) { LAUNDER(); p0_prologue(F); }
#ifdef PROBE_P0
    SL(); if (IN(0)) { xcd_barrier(bar); LAUNDER(); p0_prologue(F); }
#endif
    SEAM(0);
    SL(); if (IN(1)) { LAUNDER(); p1_modreduce(F); }
    SEAM(1);
    for (int layer_ = 0; layer_ < NL; ++layer_) {
        int layer = layer_; asm volatile("" : "+s"(layer));
        const int s0 = 2 + layer * NPH;
        const int mrows = (layer == NL - 1) ? ML : MT;
        const float* modl = wsp<float>(F, WS_MOD) + (size_t)layer * 5 * 12288;
        SL(); if (IN(s0 + 0)) { LAUNDER(); norm_phase(F, layer, 0, MT); }
        SEAM(s0 + 0);
        SL(); if (IN(s0 + 1)) {
            pg8::Gemm g{wsp<bf16>(F, WS_U), wsp<bf16>(F, WS_WIN + layer * SZ_WIN), MT, LDP, DM, DM, DM}; pg8::StaticOrder S; S.init(MT, LDP, F.G, F.wg);
            pg8::EpiBf16<0> E{wsp<bf16>(F, WS_P), LDP};
            pg8::gemm_phase<pg8::EpiBf16<0>, pg8::StaticOrder, true, true>(F.lds, g, S, E);
#ifdef PROBE_GEMM2
            pg8::gemm_phase<pg8::EpiBf16<0>, pg8::StaticOrder, true, true>(F.lds, g, S, E);
#endif
        }
        SEAM(s0 + 1);
        SL(); if (IN(s0 + 2)) { LAUNDER(); prep_phase(F, layer); }
        SEAM(s0 + 2);
        SL(); if (IN(s0 + 3)) {
            pg8::Gemm g{wsp<bf16>(F, WS_ALR), wsp<bf16>(F, WS_WLR + layer * SZ_WLR), MT, NLR, KLR, KLR, KLR}; pg8::StaticOrder S; S.init(MT, NLR, F.G, F.wg);
            pg8::EpiF32 E{wsp<float>(F, WS_LR), NLR};
            pg8::gemm_phase<pg8::EpiF32, pg8::StaticOrder, true, true>(F.lds, g, S, E);
        }
        SEAM(s0 + 3);
        SL(); if (IN(s0 + 4)) { LAUNDER(); mix_phase(F, layer, layer); }
#ifdef PROBE_MIX
        SL(); if (IN(s0 + 4)) { xcd_barrier(bar); LAUNDER(); mix_phase(F, layer, layer + 4); }
#endif
        SEAM(s0 + 4);
        SL(); if (IN(s0 + 5)) { LAUNDER(); mixfin_phase(F, layer, mrows); }
        SEAM(s0 + 5);
        SL(); if (IN(s0 + 6)) {
            const bf16* wbr = wsp<bf16>(F, WS_WBR + layer * SZ_WBR);
            pg8::StaticOrder S; S.init(mrows, DM, F.G, F.wg);
            { pg8::Gemm g{wsp<bf16>(F, WS_Y), wbr, mrows, DM, BW, 3072, BW}; pg8::EpiGate<0> E{wsp<bf16>(F, WS_P) + C_GATE, LDP, wsp<float>(F, WS_MGF), wsp<bf16>(F, WS_MG)};
              pg8::gemm_phase<pg8::EpiGate<0>, pg8::StaticOrder, true, true>(F.lds, g, S, E); }
            { pg8::Gemm g{wsp<bf16>(F, WS_Y) + 1024, wbr + (size_t)DM * BW, mrows, DM, BW, 3072, BW}; pg8::EpiGate<1> E{wsp<bf16>(F, WS_P) + C_GATE + 2048, LDP, wsp<float>(F, WS_MGF), wsp<bf16>(F, WS_MG)};
              pg8::gemm_phase<pg8::EpiGate<1>, pg8::StaticOrder, true, true>(F.lds, g, S, E); }
            { pg8::Gemm g{wsp<bf16>(F, WS_Y) + 2048, wbr + (size_t)2 * DM * BW, mrows, DM, BW, 3072, BW}; pg8::EpiGate<2> E{wsp<bf16>(F, WS_P) + C_GATE + 4096, LDP, wsp<float>(F, WS_MGF), wsp<bf16>(F, WS_MG)};
              pg8::gemm_phase<pg8::EpiGate<2>, pg8::StaticOrder, true, true>(F.lds, g, S, E); }
        }
        SEAM(s0 + 6);
        SL(); if (IN(s0 + 7)) {
            pg8::Gemm g{wsp<bf16>(F, WS_MG), wsp<bf16>(F, WS_WOUT + layer * SZ_WOUT), mrows, DM, DM, DM, DM}; pg8::StaticOrder S; S.init(mrows, DM, F.G, F.wg);
            pg8::EpiResGate E{wsp<float>(F, WS_H), modl, 2 * DM};
            pg8::gemm_phase<pg8::EpiResGate, pg8::StaticOrder, true, true>(F.lds, g, S, E);
        }
        SEAM(s0 + 7);
        SL(); if (IN(s0 + 8)) { LAUNDER(); norm_phase(F, layer, 1, mrows); }
        SEAM(s0 + 8);
        SL(); if (IN(s0 + 9)) {
            pg8::Gemm g{wsp<bf16>(F, WS_U), wsp<bf16>(F, WS_WFF1 + layer * SZ_WFF), mrows, DFF, DM, DM, DM}; pg8::StaticOrder S; S.init(mrows, DFF, F.G, F.wg);
            pg8::EpiBf16<2> E{wsp<bf16>(F, WS_F), DFF};
            pg8::gemm_phase<pg8::EpiBf16<2>, pg8::StaticOrder, true, true>(F.lds, g, S, E);
#ifdef PROBE_GEMM2
            pg8::gemm_phase<pg8::EpiBf16<2>, pg8::StaticOrder, true, true>(F.lds, g, S, E);
#endif
        }
        SEAM(s0 + 9);
        SL(); if (IN(s0 + 10)) {
            pg8::Gemm g{wsp<bf16>(F, WS_F), wsp<bf16>(F, WS_WFF2 + layer * SZ_WFF), mrows, DM, DFF, DFF, DFF}; pg8::StaticOrder S; S.init(mrows, DM, F.G, F.wg);
            pg8::EpiResGate E{wsp<float>(F, WS_H), modl, 5 * DM};
            pg8::gemm_phase<pg8::EpiResGate, pg8::StaticOrder, true, true>(F.lds, g, S, E);
        }
        SEAM(s0 + 10);
    }
    SL(); if (IN(NSTEPS - 1)) { LAUNDER(); final_norm(F, args.out); }
#undef IN
#undef SL
#undef LAUNDER
#undef SEAM
}

#ifndef MK_ONE_LAUNCH
#define MK_ONE_LAUNCH 1
#endif
extern "C" void kernel_launch(void* const* d_in, const int* in_sizes, int n_in, void* d_out, int out_size, void* d_ws, size_t ws_size, hipStream_t stream) {
    static int grid = 0;
    if (grid == 0) {
        if (n_in != 26 || out_size != ML * DM || ws_size < WS_END) { fprintf(stderr, "kernel_launch: unexpected shapes (n_in %d, out %d, ws %zu < %zu)\n", n_in, out_size, ws_size, (size_t)WS_END); grid = -1; return; }
        int dev = 0, cus = 0, per_cu = 0;
        if (hipGetDevice(&dev) != hipSuccess || hipDeviceGetAttribute(&cus, hipDeviceAttributeMultiprocessorCount, dev) != hipSuccess) { grid = -1; return; }
        if (hipFuncSetAttribute((const void*)hyb_fwd, hipFuncAttributeMaxDynamicSharedMemorySize, LDS_BYTES) != hipSuccess) { fprintf(stderr, "kernel_launch: hipFuncSetAttribute failed\n"); grid = -1; return; }
        if (hipOccupancyMaxActiveBlocksPerMultiprocessor(&per_cu, (const void*)hyb_fwd, NTHR, LDS_BYTES) != hipSuccess || per_cu < 1) fprintf(stderr, "kernel_launch: occupancy query reports %d\n", per_cu);
        (void)hipGetLastError();
        grid = cus;
    }
    if (grid < 0) return;
    if (hipMemsetAsync((char*)d_ws + WS_CTL, 0, CTL_ZERO_BYTES, stream) != hipSuccess) return;
    Args a{};
    for (int i = 0; i < 26; ++i) a.in[i] = (const float*)d_in[i];
    a.out = (float*)d_out; a.ws = (unsigned char*)d_ws;
#if MK_ONE_LAUNCH
    a.s_lo = 0; a.s_hi = NSTEPS;
    hipLaunchKernelGGL(hyb_fwd, dim3(grid), dim3(NTHR), LDS_BYTES, stream, a);
#else
    for (int s = 0; s < NSTEPS; ++s) { a.s_lo = s; a.s_hi = s + 1; hipLaunchKernelGGL(hyb_fwd, dim3(grid), dim3(NTHR), LDS_BYTES, stream, a); }
#endif
}
```

```cpp
#include <hip/hip_runtime.h>
#include <cstdio>
#include <cstdint>
namespace pg8 {
#define PG8_LAS __attribute__((address_space(3)))
typedef unsigned short bf16_t;
typedef short bf16x8 __attribute__((ext_vector_type(8)));
typedef float f32x4 __attribute__((ext_vector_type(4)));
typedef unsigned u32x4 __attribute__((ext_vector_type(4)));
constexpr int BM = 256, BK = 64, HALF = 128, HTB = HALF * BK * 2  , STAGE_BYTES = 8 * HTB, NXCD = 8, WGM = 8;

__host__ __device__ __forceinline__ int lds_byte(int r, int c) { const int st = (r >> 4) * 2 + (c >> 5), rr = r & 15, cc = c & 31, ob = rr * 64 + cc * 2; return st * 1024 + (ob ^ (((ob >> 9) & 1) << 5)); }
__host__ __device__ __forceinline__ void stage_rc(int b, int& R, int& C) { const int st = b / 1024, sb = b % 1024, swz = sb ^ (((sb >> 9) & 1) << 5); R = (st >> 1) * 16 + swz / 64; C = (st & 1) * 32 + (swz % 64) / 2; }
__host__ __device__ __forceinline__ int perm32(int rho) { const int n = rho >> 4, i = rho & 15; return 8 * (i >> 2) + 4 * n + (i & 3); }

struct Unit { int pm, pn; };
struct Gemm { const bf16_t* A; const bf16_t* Bt; int M, N, K, lda, ldb; };

struct StaticOrder {
    int nM, nN, nwg, G, c;
    __host__ __device__ void init(int M, int N, int G_, int c_) { nM = M / BM; nN = N / BM; nwg = nM * nN; G = G_; c = c_; }
    __host__ __device__ bool next(int i, Unit& u) const {
        const long L = (long)i * G + c; if (L >= nwg) return false;
        int wgid = (int)L; { const int q = nwg / NXCD, r = nwg % NXCD, xcd = wgid % NXCD, off = wgid / NXCD; wgid = (xcd < r ? xcd * (q + 1) : r * (q + 1) + (xcd - r) * q) + off; }
        const int nig = WGM * nN, gid = wgid / nig, fm = gid * WGM, gsz = (nM - fm) < WGM ? (nM - fm) : WGM;
        u.pm = fm + ((wgid % nig) % gsz); u.pn = (wgid % nig) / gsz; return true;
    }
    __device__ __forceinline__ void a_ready(const Unit&) const {}
    __device__ __forceinline__ void done(const Unit&) const {}
};

__device__ __forceinline__ unsigned cvt_pk_bf16(float lo, float hi) { unsigned r; asm volatile("v_cvt_pk_bf16_f32 %0, %1, %2" : "=v"(r) : "v"(lo), "v"(hi)); return r; }
typedef float f32x2 __attribute__((ext_vector_type(2)));
__device__ __forceinline__ float sigmoidf_(float x) { return 1.0f / (1.0f + __expf(-x)); }
__device__ __forceinline__ float bf_lo(unsigned w) { return __uint_as_float(w << 16); }
__device__ __forceinline__ float bf_hi(unsigned w) { return __uint_as_float(w & 0xffff0000u); }

template <int ACT> struct EpiBf16 {
    static constexpr bool PERM = true, AFTER_DRAIN = false;
    bf16_t* O; int ldc;
    __device__ __forceinline__ void operator()(const f32x4 (&acc)[2][2][4][2], const Unit& u, int wr, int wc, int fr, int fq) const {
        const int row0 = u.pm * BM + wr * 64 + fr; const int col0 = u.pn * BM + wc * 32 + 8 * fq;
#pragma unroll
        for (int ai = 0; ai < 2; ++ai)
#pragma unroll
            for (int m = 0; m < 4; ++m) { bf16_t* rowp = O + (size_t)(row0 + ai * HALF + m * 16) * ldc + col0;
#pragma unroll
                for (int bj = 0; bj < 2; ++bj) { f32x4 v0 = acc[ai][bj][m][0], v1 = acc[ai][bj][m][1];
                    if (ACT == 2) {
#pragma unroll
                        for (int e = 0; e < 4; ++e) { const float a = fmaxf(v0[e], 0.f), b = fmaxf(v1[e], 0.f); v0[e] = a * a; v1[e] = b * b; } }
                    u32x4 w; w.x = cvt_pk_bf16(v0[0], v0[1]); w.y = cvt_pk_bf16(v0[2], v0[3]); w.z = cvt_pk_bf16(v1[0], v1[1]); w.w = cvt_pk_bf16(v1[2], v1[3]);
                    *(u32x4*)(rowp + bj * HALF) = w; } }
    }
};
struct EpiF32 {
    static constexpr bool PERM = false, AFTER_DRAIN = false;
    float* C; int ldc;
    __device__ __forceinline__ void operator()(const f32x4 (&acc)[2][2][4][2], const Unit& u, int wr, int wc, int fr, int fq) const {
        const int row0 = u.pm * BM + wr * 64 + fr, col0 = u.pn * BM + wc * 32 + 4 * fq;
#pragma unroll
        for (int ai = 0; ai < 2; ++ai)
#pragma unroll
            for (int m = 0; m < 4; ++m) { float* rowp = C + (size_t)(row0 + ai * HALF + m * 16) * ldc + col0;
#pragma unroll
                for (int bj = 0; bj < 2; ++bj)
#pragma unroll
                    for (int n = 0; n < 2; ++n) *(f32x4*)(rowp + bj * HALF + n * 16) = acc[ai][bj][m][n]; }
    }
};
template <int MODE> struct EpiGate {
    static constexpr bool PERM = true, AFTER_DRAIN = false;
    const bf16_t* G; int ldg;
    float* part; bf16_t* out;
    __device__ __forceinline__ void operator()(const f32x4 (&acc)[2][2][4][2], const Unit& u, int wr, int wc, int fr, int fq) const {
        const int row0 = u.pm * BM + wr * 64 + fr; const int col0 = u.pn * BM + wc * 32 + 8 * fq;
#pragma unroll
        for (int ai = 0; ai < 2; ++ai)
#pragma unroll
            for (int m = 0; m < 4; ++m) { const size_t row = (size_t)(row0 + ai * HALF + m * 16);
#pragma unroll
                for (int bj = 0; bj < 2; ++bj) { const int c = col0 + bj * HALF;
                    const u32x4 gw = *(const u32x4*)(G + row * ldg + c);
                    f32x4 g0, g1; g0[0] = sigmoidf_(bf_lo(gw.x)); g0[1] = sigmoidf_(bf_hi(gw.x)); g0[2] = sigmoidf_(bf_lo(gw.y)); g0[3] = sigmoidf_(bf_hi(gw.y));
                    g1[0] = sigmoidf_(bf_lo(gw.z)); g1[1] = sigmoidf_(bf_hi(gw.z)); g1[2] = sigmoidf_(bf_lo(gw.w)); g1[3] = sigmoidf_(bf_hi(gw.w));
                    f32x4 v0 = acc[ai][bj][m][0] * g0, v1 = acc[ai][bj][m][1] * g1;
                    float* pp = part + row * 2048 + c;
                    if (MODE >= 1) { v0 += *(const f32x4*)pp; v1 += *(const f32x4*)(pp + 4); }
                    if (MODE <= 1) { *(f32x4*)pp = v0; *(f32x4*)(pp + 4) = v1; }
                    else { u32x4 w; w.x = cvt_pk_bf16(v0[0], v0[1]); w.y = cvt_pk_bf16(v0[2], v0[3]); w.z = cvt_pk_bf16(v1[0], v1[1]); w.w = cvt_pk_bf16(v1[2], v1[3]);
                        *(u32x4*)(out + row * 2048 + c) = w; } } }
    }
};
struct EpiResGate {
    static constexpr bool PERM = false, AFTER_DRAIN = false;
    float* H; const float* modl; int goff;
    __device__ __forceinline__ void operator()(const f32x4 (&acc)[2][2][4][2], const Unit& u, int wr, int wc, int fr, int fq) const {
        const int mr = u.pm < 32 ? (u.pm >> 3) : 4;
        const int row0 = u.pm * BM + wr * 64 + fr, col0 = u.pn * BM + wc * 32 + 4 * fq;
        const float* gv = modl + (size_t)mr * 12288 + goff + col0;
        f32x4 gg[2][2];
#pragma unroll
        for (int bj = 0; bj < 2; ++bj)
#pragma unroll
            for (int n = 0; n < 2; ++n) gg[bj][n] = *(const f32x4*)(gv + bj * HALF + n * 16);
#pragma unroll
        for (int ai = 0; ai < 2; ++ai)
#pragma unroll
            for (int m = 0; m < 4; ++m) { float* rowp = H + (size_t)(row0 + ai * HALF + m * 16) * 2048 + col0;
#pragma unroll
                for (int bj = 0; bj < 2; ++bj)
#pragma unroll
                    for (int n = 0; n < 2; ++n) { f32x4* p = (f32x4*)(rowp + bj * HALF + n * 16); *p = *p + gg[bj][n] * acc[ai][bj][m][n]; } }
    }
};

struct EpiResGatePart {
    static constexpr bool PERM = false, AFTER_DRAIN = false;
    float* part; const float* modl; int goff, slice;
    __device__ __forceinline__ void operator()(const f32x4 (&acc)[2][2][4][2], const Unit& u, int wr, int wc, int fr, int fq) const {
        const int row0 = (u.pm - 32) * BM + wr * 64 + fr, col0 = u.pn * BM + wc * 32 + 4 * fq;
        const float* gv = modl + (size_t)4 * 12288 + goff + col0;
        f32x4 gg[2][2];
#pragma unroll
        for (int bj = 0; bj < 2; ++bj)
#pragma unroll
            for (int n = 0; n < 2; ++n) gg[bj][n] = *(const f32x4*)(gv + bj * HALF + n * 16);
#pragma unroll
        for (int ai = 0; ai < 2; ++ai)
#pragma unroll
            for (int m = 0; m < 4; ++m) { float* rowp = part + ((size_t)slice * 1024 + (row0 + ai * HALF + m * 16)) * 2048 + col0;
#pragma unroll
                for (int bj = 0; bj < 2; ++bj)
#pragma unroll
                    for (int n = 0; n < 2; ++n) *(f32x4*)(rowp + bj * HALF + n * 16) = gg[bj][n] * acc[ai][bj][m][n]; }
    }
};
struct SubKOrder {
    int G, c;
    __host__ __device__ bool next(int i, Unit& u) const { const int L = i * G + c; if (L >= 256) return false; const int lt = L >> 3; u.pm = 32 + (lt >> 3); u.pn = lt & 7; return true; }
    __device__ __forceinline__ void a_ready(const Unit&) const {}
    __device__ __forceinline__ void done(const Unit&) const {}
};

template <class Epi, class Sched, bool ALIGN_EPI = false, bool SP2 = false>
__device__ __forceinline__ void gemm_phase(PG8_LAS unsigned char* lds, const Gemm g, const Sched& S, const Epi& E) {
    int tid_ = threadIdx.x; asm volatile("" : "+v"(tid_));
    const int tid = tid_, wid = __builtin_amdgcn_readfirstlane(tid >> 6), lane = tid & 63, wr = wid >> 2, wc = wid & 3, fr = lane & 15, fq = lane >> 4;
    const int K = g.K, nt = K / BK;
    unsigned voffA[2], voffB[2];
#pragma unroll
    for (int i = 0; i < 2; ++i) { int R, C; stage_rc(tid * 16 + i * 8192, R, C); const int Rb = Epi::PERM ? ((R & ~31) + perm32(R & 31)) : R;
        voffA[i] = (unsigned)(R * g.lda + C) * 2u; voffB[i] = (unsigned)(Rb * g.ldb + C) * 2u; }
    const size_t kstep = (size_t)(BK * 2);
    const size_t hstepA = (size_t)HALF * g.lda * 2, hstepB = (size_t)HALF * g.ldb * 2;
    const size_t tstepA = 2 * hstepA, tstepB = 2 * hstepB;
    const unsigned ldsw = (unsigned)wid * 1024u;
    const int aoff = lds_byte(wr * 64 + fr, fq * 8), boff = lds_byte(wc * 32 + fr, fq * 8);
#define PG8_SA(b, h) (((b) * 2 + (h)) * HTB)
#define PG8_SB(b, h) ((4 + (b) * 2 + (h)) * HTB)
#define PG8_STAGE(bufoff, gbase, voff) do { _Pragma("unroll") for (int _i = 0; _i < 2; ++_i) \
        __builtin_amdgcn_global_load_lds((const unsigned*)((const char*)(gbase) + (voff)[_i]), (PG8_LAS unsigned*)(lds + (bufoff) + ldsw + _i * 8192), 16, 0, 0); } while (0)
#define PG8_LDA(dst, b, h) do { _Pragma("unroll") for (int m = 0; m < 4; ++m) _Pragma("unroll") for (int k = 0; k < 2; ++k) dst[m][k] = *(const PG8_LAS bf16x8*)(lds + PG8_SA(b, h) + aoff + m * 2048 + k * 1024); } while (0)
#define PG8_LDB(dst, b, h) do { _Pragma("unroll") for (int n = 0; n < 2; ++n) _Pragma("unroll") for (int k = 0; k < 2; ++k) dst[n][k] = *(const PG8_LAS bf16x8*)(lds + PG8_SB(b, h) + boff + n * 2048 + k * 1024); } while (0)
#define PG8_MMA(ai, bj, At, Bt) do { __builtin_amdgcn_s_setprio(1); _Pragma("unroll") for (int m = 0; m < 4; ++m) _Pragma("unroll") for (int n = 0; n < 2; ++n) _Pragma("unroll") for (int k = 0; k < 2; ++k) \
        acc[ai][bj][m][n] = __builtin_amdgcn_mfma_f32_16x16x32_bf16(Bt[n][k], At[m][k], acc[ai][bj][m][n], 0, 0, 0); __builtin_amdgcn_s_setprio(0); } while (0)
#define PG8_WAIT_V(n) asm volatile("s_waitcnt vmcnt(" #n ")" ::: "memory")
#define PG8_WAIT_L(n) asm volatile("s_waitcnt lgkmcnt(" #n ")" ::: "memory")
#define PG8_BAR __builtin_amdgcn_s_barrier()
#define PG8_SCHED __builtin_amdgcn_sched_barrier(0)
    Unit cur, nxt; int ui = 0;
    if (!S.next(0, cur)) return;
    f32x4 acc[2][2][4][2];
#pragma unroll
    for (int a = 0; a < 2; ++a)
#pragma unroll
        for (int b = 0; b < 2; ++b)
#pragma unroll
            for (int m = 0; m < 4; ++m)
#pragma unroll
                for (int n = 0; n < 2; ++n) acc[a][b][m][n] = (f32x4){0.f, 0.f, 0.f, 0.f};
    bf16x8 At[4][2], B0[2][2], B1[2][2];
    const char* cA = (const char*)g.A + (size_t)cur.pm * tstepA; const char* cB = (const char*)g.Bt + (size_t)cur.pn * tstepB;
    S.a_ready(cur);
    if constexpr (SP2) {
        PG8_STAGE(PG8_SB(0, 0), cB, voffB); PG8_STAGE(PG8_SB(0, 1), cB + hstepB, voffB); PG8_STAGE(PG8_SA(0, 0), cA, voffA); PG8_STAGE(PG8_SA(0, 1), cA + hstepA, voffA);
        if (wr == 1) PG8_BAR;
        PG8_WAIT_V(2); PG8_BAR;
        PG8_STAGE(PG8_SB(1, 0), cB + kstep, voffB); PG8_STAGE(PG8_SA(1, 0), cA + kstep, voffA); PG8_STAGE(PG8_SB(1, 1), cB + hstepB + kstep, voffB);
        PG8_WAIT_V(6); PG8_BAR;
    } else {
        PG8_STAGE(PG8_SB(0, 0), cB, voffB); PG8_STAGE(PG8_SA(0, 0), cA, voffA); PG8_STAGE(PG8_SB(0, 1), cB + hstepB, voffB); PG8_STAGE(PG8_SA(0, 1), cA + hstepA, voffA);
        if (wr == 1) PG8_BAR;
        PG8_WAIT_V(4); PG8_BAR;
        PG8_STAGE(PG8_SB(1, 0), cB + kstep, voffB); PG8_STAGE(PG8_SA(1, 0), cA + kstep, voffA); PG8_STAGE(PG8_SB(1, 1), cB + hstepB + kstep, voffB);
        PG8_WAIT_V(6); PG8_BAR;
    }
    for (;;) {
        const bool has_next = S.next(ui + 1, nxt);
        const char* nA = has_next ? (const char*)g.A + (size_t)nxt.pm * tstepA : cA; const char* nB = has_next ? (const char*)g.Bt + (size_t)nxt.pn * tstepB : cB;
        for (int t = 0; t < nt; t += 2) {
            const bool last = (t == nt - 2);
            const char* a1 = cA + (size_t)(t + 1) * kstep;
            const char* a2 = last ? nA : cA + (size_t)(t + 2) * kstep; const char* b2 = last ? nB : cB + (size_t)(t + 2) * kstep;
            const char* a3 = a2 + kstep; const char* b3 = b2 + kstep;
            if (last && has_next) S.a_ready(nxt);
            if constexpr (SP2) {
            PG8_LDB(B0, 0, 0); PG8_LDB(B1, 0, 1); PG8_SCHED; PG8_LDA(At, 0, 0); PG8_STAGE(PG8_SA(1, 1), a1 + hstepA, voffA);
            PG8_WAIT_V(8); PG8_WAIT_L(0); PG8_BAR; PG8_MMA(0, 0, At, B0); PG8_MMA(0, 1, At, B1); PG8_BAR; PG8_SCHED;
            PG8_LDA(At, 0, 1); PG8_STAGE(PG8_SB(0, 0), b2, voffB); PG8_STAGE(PG8_SB(0, 1), b2 + hstepB, voffB); PG8_STAGE(PG8_SA(0, 0), a2, voffA);
            PG8_WAIT_V(8); PG8_WAIT_L(0); PG8_BAR; PG8_MMA(1, 0, At, B0); PG8_MMA(1, 1, At, B1); PG8_BAR; PG8_SCHED;
            PG8_LDB(B0, 1, 0); PG8_LDB(B1, 1, 1); PG8_SCHED; PG8_LDA(At, 1, 0); PG8_STAGE(PG8_SA(0, 1), a2 + hstepA, voffA);
            PG8_WAIT_V(8); PG8_WAIT_L(0); PG8_BAR; PG8_MMA(0, 0, At, B0); PG8_MMA(0, 1, At, B1); PG8_BAR; PG8_SCHED;
            PG8_LDA(At, 1, 1); PG8_STAGE(PG8_SB(1, 0), b3, voffB); PG8_STAGE(PG8_SB(1, 1), b3 + hstepB, voffB); PG8_STAGE(PG8_SA(1, 0), a3, voffA);
            PG8_WAIT_V(8); PG8_WAIT_L(0); PG8_BAR; PG8_MMA(1, 0, At, B0); PG8_MMA(1, 1, At, B1); PG8_BAR; PG8_SCHED;
            } else {
            PG8_LDB(B0, 0, 0); PG8_SCHED; PG8_LDA(At, 0, 0); PG8_STAGE(PG8_SA(1, 1), a1 + hstepA, voffA);
            PG8_WAIT_L(8); PG8_BAR; PG8_WAIT_L(0); PG8_MMA(0, 0, At, B0); PG8_BAR; PG8_SCHED;
            PG8_LDB(B1, 0, 1); PG8_STAGE(PG8_SB(0, 0), b2, voffB);
            PG8_BAR; PG8_WAIT_L(0); PG8_MMA(0, 1, At, B1); PG8_BAR;
            PG8_LDA(At, 0, 1); PG8_STAGE(PG8_SA(0, 0), a2, voffA);
            PG8_BAR; PG8_WAIT_L(0); PG8_MMA(1, 0, At, B0); PG8_BAR; PG8_SCHED;
            PG8_STAGE(PG8_SB(0, 1), b2 + hstepB, voffB);
            PG8_WAIT_V(6); PG8_BAR; PG8_MMA(1, 1, At, B1); PG8_BAR;
            PG8_LDB(B0, 1, 0); PG8_SCHED; PG8_LDA(At, 1, 0); PG8_STAGE(PG8_SA(0, 1), a2 + hstepA, voffA);
            PG8_WAIT_L(8); PG8_BAR; PG8_WAIT_L(0); PG8_MMA(0, 0, At, B0); PG8_BAR; PG8_SCHED;
            PG8_LDB(B1, 1, 1); PG8_STAGE(PG8_SB(1, 0), b3, voffB);
            PG8_BAR; PG8_WAIT_L(0); PG8_MMA(0, 1, At, B1); PG8_BAR;
            PG8_LDA(At, 1, 1); PG8_STAGE(PG8_SA(1, 0), a3, voffA);
            PG8_BAR; PG8_WAIT_L(0); PG8_MMA(1, 0, At, B0); PG8_BAR; PG8_SCHED;
            PG8_STAGE(PG8_SB(1, 1), b3 + hstepB, voffB);
            PG8_WAIT_V(6); PG8_BAR; PG8_MMA(1, 1, At, B1); PG8_BAR;
            }
        }
        if constexpr (ALIGN_EPI) { if (wr == 0) PG8_BAR; }
        if constexpr (!Epi::AFTER_DRAIN) { int t2_ = threadIdx.x; asm volatile("" : "+v"(t2_));   E(acc, cur, wr, wc, t2_ & 15, (t2_ >> 4) & 3); S.done(cur); }
        if (!has_next) break;
#pragma unroll
        for (int a = 0; a < 2; ++a)
#pragma unroll
            for (int b = 0; b < 2; ++b)
#pragma unroll
                for (int m = 0; m < 4; ++m)
#pragma unroll
                    for (int n = 0; n < 2; ++n) acc[a][b][m][n] = (f32x4){0.f, 0.f, 0.f, 0.f};
        cur = nxt; cA = nA; cB = nB; ++ui;
        if constexpr (ALIGN_EPI) { if (wr == 1) PG8_BAR; }
    }
    PG8_WAIT_V(0);
    if constexpr (!ALIGN_EPI) { if (wr == 0) PG8_BAR; }
    PG8_BAR;
    if constexpr (Epi::AFTER_DRAIN) { E.fused(acc, cur, wr, wc, fr, fq, lds, wid, lane); S.done(cur); }
#undef PG8_SA
#undef PG8_SB
#undef PG8_STAGE
#undef PG8_LDA
#undef PG8_LDB
#undef PG8_MMA
#undef PG8_WAIT_V
#undef PG8_WAIT_L
#undef PG8_BAR
#undef PG8_SCHED
}
}

constexpr int NB = 4, TL = 2048, TCX = 256, DM = 2048, NL = 4, DFF = 8192, BW = 1024;
constexpr int ML = NB * TL, MC = NB * TCX, MT = ML + MC;
constexpr int NIN = 15232, LDP = 15360;
constexpr int C_RET = 0, C_SWA = 4096, C_RW = 5632, C_GATE = 9088, RWIN = 3456;
constexpr int NLR = 5120, KLR = 384;
constexpr int NQK = 1280;
constexpr int NSTEP = 2304, SCAN_BLK = 32;

constexpr size_t al256(size_t x) { return (x + 255) & ~(size_t)255; }
constexpr size_t WS_CTL = 0, CTL_ZERO_BYTES = 1u << 20;
constexpr size_t SZ_WIN = (size_t)LDP * DM * 2, SZ_WBR = (size_t)3 * DM * BW * 2, SZ_WOUT = (size_t)DM * DM * 2, SZ_WFF = (size_t)DFF * DM * 2, SZ_WLR = (size_t)NLR * KLR * 2;
constexpr size_t WS_WIN = CTL_ZERO_BYTES;
constexpr size_t WS_WBR = WS_WIN + NL * SZ_WIN;
constexpr size_t WS_WOUT = WS_WBR + NL * SZ_WBR;
constexpr size_t WS_WFF1 = WS_WOUT + NL * SZ_WOUT;
constexpr size_t WS_WFF2 = WS_WFF1 + NL * SZ_WFF;
constexpr size_t WS_WLR = WS_WFF2 + NL * SZ_WFF;
constexpr size_t WS_H = WS_WLR + NL * SZ_WLR;
constexpr size_t WS_U = WS_H + (size_t)MT * DM * 4;
constexpr size_t WS_P = WS_U + (size_t)MT * DM * 2;
constexpr size_t WS_Y = WS_P + (size_t)MT * LDP * 2;
constexpr size_t WS_MGF = WS_Y + (size_t)MT * 3072 * 2;
constexpr size_t WS_MG = WS_MGF + (size_t)MT * DM * 4;
constexpr size_t WS_F = WS_MG + (size_t)MT * DM * 2;
constexpr size_t WS_MODP = WS_F + (size_t)MT * DFF * 2;
constexpr size_t WS_MOD = WS_MODP + (size_t)8 * NL * 5 * 12288 * 4;
constexpr size_t WS_ROPE = WS_MOD + (size_t)NL * 5 * 12288 * 4;
constexpr size_t WS_XS = WS_ROPE + 64 * 32 * 2 * 4;
constexpr size_t WS_ALR = WS_XS + (size_t)MT * 3072 * 4;
constexpr size_t WS_LR = WS_ALR + (size_t)MT * KLR * 2;
constexpr size_t WS_QKR = WS_LR + (size_t)MT * NLR * 4;
constexpr size_t WS_ST = WS_QKR + (size_t)MT * NQK * 2;
constexpr size_t WS_YDR = WS_ST + (size_t)NB * 8 * 2 * 18 * 128 * 128 * 2;
constexpr size_t WS_YDW = WS_YDR + (size_t)2 * MT * BW * 4;
constexpr size_t WS_END = WS_YDW + (size_t)2 * MT * BW * 4;
constexpr int CW_BAR = 4096;
constexpr int CW_SWAQ = 16384;

constexpr int RING_BYTES = 131072, LDSCTL_OFF = RING_BYTES, MISC_OFF = LDSCTL_OFF + 320, LDS_BYTES = 147456;
constexpr int NWAVES = 8, NTHR = 512;

#define GAS __attribute__((address_space(1)))
#define LAS __attribute__((address_space(3)))
typedef unsigned short bf16;
typedef float f32x4 __attribute__((ext_vector_type(4)));
typedef float f32x2 __attribute__((ext_vector_type(2)));
typedef unsigned u32x4 __attribute__((ext_vector_type(4)));
typedef unsigned u32x2 __attribute__((ext_vector_type(2)));
#define LDS_WAIT() asm volatile("s_waitcnt lgkmcnt(0)" ::: "memory")
#define VM_WAIT() asm volatile("s_waitcnt vmcnt(0)" ::: "memory")
__device__ __forceinline__ unsigned f2bf(float f) { unsigned u = __builtin_bit_cast(unsigned, f); return (u + 0x7fffu + ((u >> 16) & 1u)) >> 16; }
__device__ __forceinline__ unsigned pk2(float lo, float hi) { return f2bf(lo) | (f2bf(hi) << 16); }
__device__ __forceinline__ float bf2f(bf16 v) { return __uint_as_float((unsigned)v << 16); }
__device__ __forceinline__ float sigm(float x) { return 1.0f / (1.0f + __expf(-x)); }
using pg8::bf_lo; using pg8::bf_hi;
__device__ __forceinline__ float shx(float v, int m, int lane) { return __int_as_float(__builtin_amdgcn_ds_bpermute((lane ^ m) << 2, __float_as_int(v))); }
__device__ __forceinline__ float wave_sum(float v, int lane) {
#pragma unroll
    for (int o = 1; o < 64; o <<= 1) v += shx(v, o, lane);
    return v;
}
__device__ __forceinline__ float wave_max(float v, int lane) {
#pragma unroll
    for (int o = 1; o < 64; o <<= 1) v = fmaxf(v, shx(v, o, lane));
    return v;
}

#define XB_TMO      128
#define XB_XCNT(j)  (256  + 64 * (j))
#define XB_XSUB(j)  (1280 + 64 * (j))
#define XB_XGEN(j)  (2304 + 64 * (j))
#define XB_TOP      3328
#define XB_TOPGEN   3392
#define XCD_BAR_WORDS 3456
#define XB_SPIN_CAP (1u << 22)
__device__ __forceinline__ unsigned xb_ld(unsigned* p)              { return __hip_atomic_load(p, __ATOMIC_RELAXED, __HIP_MEMORY_SCOPE_AGENT); }
__device__ __forceinline__ unsigned xb_add(unsigned* p, unsigned v) { return __hip_atomic_fetch_add(p, v, __ATOMIC_RELAXED, __HIP_MEMORY_SCOPE_AGENT); }
__device__ __forceinline__ unsigned xb_xcc_id() { return (unsigned)__builtin_amdgcn_s_getreg((3 << 11) | 20) & 0xFu; }
#define XB_SPIN(cond, bar) do { unsigned _sp = 0; while (cond) { __builtin_amdgcn_s_sleep(1); \
    if ((++_sp & 255u) == 0u) { if (xb_ld(&(bar)[XB_TMO])) break; if (_sp > XB_SPIN_CAP) { atomicAdd(&(bar)[XB_TMO], 1u); break; } } } } while (0)
struct XcdBarrier { unsigned* bar; unsigned x; volatile LAS unsigned* st; };
__device__ __forceinline__ XcdBarrier xcd_barrier_post(unsigned* bar, volatile LAS unsigned* st) {
    XcdBarrier b; b.bar = bar; b.x = xb_xcc_id(); b.st = st;
    if (threadIdx.x == 0) (void)xb_add(&bar[XB_XCNT(b.x)], 1u);
    return b;
}
__device__ __forceinline__ void xcd_barrier_complete(unsigned* bar, unsigned x, unsigned& nloc, unsigned& nx) {
    const unsigned G = gridDim.x * gridDim.y * gridDim.z;
    unsigned sum, cnt, mine, sp = 0u;
    for (;;) {
        sum = 0u; cnt = 0u; mine = 0u;
#pragma unroll
        for (unsigned j = 0; j < 16; ++j) { const unsigned c = xb_ld(&bar[XB_XCNT(j)]); sum += c; cnt += (c > 0u) ? 1u : 0u; mine = (j == x) ? c : mine; }
        if (sum == G) break;
        __builtin_amdgcn_s_sleep(1);
        if ((++sp & 255u) == 0u) { if (xb_ld(&bar[XB_TMO])) break; if (sp > XB_SPIN_CAP) { atomicAdd(&bar[XB_TMO], 1u); break; } }
    }
    nloc = mine > 0u ? mine : 1u; nx = cnt > 0u ? cnt : 1u;
}
__device__ __forceinline__ void xcd_barrier(const XcdBarrier& b) {
    asm volatile("s_waitcnt vmcnt(0)" ::: "memory");
    __syncthreads();
    if (threadIdx.x == 0) {
        unsigned* bar = b.bar; unsigned bx = b.x;
        asm volatile("" : "+s"(bar), "+s"(bx));
        __builtin_amdgcn_s_waitcnt(0);
        unsigned nloc = b.st[0], nx = b.st[1];
        if (nloc == 0u) { xcd_barrier_complete(bar, bx, nloc, nx); b.st[0] = nloc; b.st[1] = nx; }
        const unsigned old = xb_add(&bar[XB_XSUB(bx)], 1u);
        const unsigned gen = old / nloc;
        if (old + 1u == (gen + 1u) * nloc) {
            __builtin_amdgcn_fence(__ATOMIC_RELEASE, "agent");
            asm volatile("s_waitcnt vmcnt(0)" ::: "memory");
            const unsigned og = xb_add(&bar[XB_TOP], 1u);
            const unsigned tg = og / nx;
            if (og + 1u == (tg + 1u) * nx) xb_add(&bar[XB_TOPGEN], 1u);
            else XB_SPIN(xb_ld(&bar[XB_TOPGEN]) == tg, bar);
            __builtin_amdgcn_fence(__ATOMIC_ACQUIRE, "agent");
            xb_add(&bar[XB_XGEN(bx)], 1u);
            asm volatile("s_waitcnt vmcnt(0)" ::: "memory");
        } else {
            XB_SPIN(xb_ld(&bar[XB_XGEN(bx)]) == gen, bar);
            __builtin_amdgcn_fence(__ATOMIC_ACQUIRE, "agent");
            asm volatile("s_waitcnt vmcnt(0)" ::: "memory");
        }
    }
    __syncthreads();
}

struct Args { const float* in[26]; float* out; unsigned char* ws; int s_lo, s_hi; };
enum { I_X = 0, I_C, I_CTX, I_CCTX, I_N1G, I_N2G, I_WMOD, I_BMOD, I_WIN, I_RETDEC, I_SINK, I_MU, I_W0, I_WUP, I_A0, I_AUP, I_GUP, I_KK, I_KA, I_RK, I_LNG, I_WBR, I_WOUT, I_WFF1, I_WFF2, I_FING };
struct Frame {
    LAS unsigned char* lds;
    unsigned* ctl;
    int tid, lane, wave, G, wg;
    unsigned char* ws;
};
template <class T> __device__ __forceinline__ T* wsp(const Frame& F, size_t off) { return (T*)(F.ws + off); }
constexpr int PTAB_OFF = LDSCTL_OFF + 64;
__device__ __forceinline__ const float* inp(const Frame& F, int i) {
    const LAS unsigned* t = (const LAS unsigned*)(F.lds + PTAB_OFF) + 2 * i;
    const unsigned lo = __builtin_amdgcn_readfirstlane(t[0]), hi = __builtin_amdgcn_readfirstlane(t[1]);
    return (const float*)(((unsigned long long)hi << 32) | (unsigned long long)lo);
}

__device__ __forceinline__ int scan_row(int b, int dir, int s) {
    if (s < TCX) return ML + b * TCX + (dir ? (TCX - 1 - s) : s);
    const int t = s - TCX; return b * TL + (dir ? (TL - 1 - t) : t);
}

__device__ __forceinline__ void transpose_item(const float* W, int K, int N, bf16* WT, LAS unsigned char* scr, int item, int lane) {
    const int nblk = N / 64, kb = item / nblk, nb = item % nblk, k0 = 64 * kb, n0 = 64 * nb;
    const int kr = lane >> 4, nc = (lane & 15) * 4;
    f32x4 v[16];
#pragma unroll
    for (int i = 0; i < 16; ++i) v[i] = *(const f32x4*)(W + (size_t)(k0 + 4 * i + kr) * N + n0 + nc);
#pragma unroll
    for (int i = 0; i < 16; ++i) { LAS unsigned short* d = (LAS unsigned short*)(scr + nc * 144 + (4 * i + kr) * 2);
        d[0] = (unsigned short)f2bf(v[i].x); d[72] = (unsigned short)f2bf(v[i].y); d[144] = (unsigned short)f2bf(v[i].z); d[216] = (unsigned short)f2bf(v[i].w); }
    LDS_WAIT(); asm volatile("" ::: "memory");
    const int c = lane & 7;
#pragma unroll
    for (int j = 0; j < 8; ++j) { const int n = (lane >> 3) + 8 * j;
        *(u32x4*)(WT + (size_t)(n0 + n) * K + k0 + 8 * c) = *(const LAS u32x4*)(scr + n * 144 + 16 * c); }
    LDS_WAIT(); asm volatile("" ::: "memory");
}
__device__ __forceinline__ void p0_prologue(Frame& F) {
    const int gw = F.wg * NWAVES + F.wave, NGW = F.G * NWAVES;
    const int gt = F.wg * NTHR + F.tid, NGT = F.G * NTHR;
    LAS float* sil = (LAS float*)(F.lds + 81920);
    for (int e = F.tid; e < 5 * DM; e += NTHR) { const int r = e / DM, k = e % DM; const float v = r < 4 ? inp(F, I_C)[r * DM + k] : inp(F, I_CCTX)[k]; sil[e] = v * sigm(v); }
    {
        LAS unsigned char* scr = F.lds + F.wave * 9216;
        constexpr int IT_IN = (DM / 64) * (NIN / 64), IT_BR = (BW / 64) * (DM / 64), IT_OUT = (DM / 64) * (DM / 64), IT_F1 = (DM / 64) * (DFF / 64), IT_F2 = (DFF / 64) * (DM / 64);
        constexpr int IT_L = IT_IN + 3 * IT_BR + IT_OUT + IT_F1 + IT_F2;
        for (int it = gw; it < NL * IT_L; it += NGW) {
            const int l = it / IT_L; int r = it % IT_L;
            if (r < IT_IN) { transpose_item(inp(F, I_WIN) + (size_t)l * DM * NIN, DM, NIN, wsp<bf16>(F, WS_WIN + l * SZ_WIN), scr, r, F.lane); continue; } r -= IT_IN;
            if (r < 3 * IT_BR) { const int n = r / IT_BR; transpose_item(inp(F, I_WBR) + ((size_t)l * 3 + n) * BW * DM, BW, DM, wsp<bf16>(F, WS_WBR + l * SZ_WBR) + (size_t)n * DM * BW, scr, r % IT_BR, F.lane); continue; } r -= 3 * IT_BR;
            if (r < IT_OUT) { transpose_item(inp(F, I_WOUT) + (size_t)l * DM * DM, DM, DM, wsp<bf16>(F, WS_WOUT + l * SZ_WOUT), scr, r, F.lane); continue; } r -= IT_OUT;
            if (r < IT_F1) { transpose_item(inp(F, I_WFF1) + (size_t)l * DM * DFF, DM, DFF, wsp<bf16>(F, WS_WFF1 + l * SZ_WFF), scr, r, F.lane); continue; } r -= IT_F1;
            transpose_item(inp(F, I_WFF2) + (size_t)l * DFF * DM, DFF, DM, wsp<bf16>(F, WS_WFF2 + l * SZ_WFF), scr, r, F.lane);
        }
    }
    for (int e = gt; e < NL * (LDP - NIN) * DM / 8; e += NGT) { const int l = e / ((LDP - NIN) * DM / 8), r = e % ((LDP - NIN) * DM / 8);
        *(u32x4*)(wsp<bf16>(F, WS_WIN + l * SZ_WIN) + (size_t)NIN * DM + (size_t)r * 8) = (u32x4){0u, 0u, 0u, 0u}; }
    for (int e = gt; e < NL * NLR * KLR; e += NGT) {
        const int l = e / (NLR * KLR), r = e % (NLR * KLR), n = r / KLR, k = r % KLR; float v = 0.f;
        if (n < 2048) { const int d = n >> 10, c = n & 1023; if (k >= 64 * d && k < 64 * d + 64) v = inp(F, I_WUP)[(((size_t)l * 2 + d) * 64 + (k - 64 * d)) * BW + c]; }
        else if (n < 4096) { const int d = (n - 2048) >> 10, c = n & 1023; if (k >= 128 + 64 * d && k < 192 + 64 * d) v = inp(F, I_AUP)[(((size_t)l * 2 + d) * 64 + (k - 128 - 64 * d)) * BW + c]; }
        else { const int c = n - 4096; if (k >= 256) v = inp(F, I_GUP)[((size_t)l * 128 + (k - 256)) * BW + c]; }
        wsp<bf16>(F, WS_WLR + l * SZ_WLR)[r] = (bf16)f2bf(v);
    }
    { const f32x4* x4 = (const f32x4*)inp(F, I_X); const f32x4* c4 = (const f32x4*)inp(F, I_CTX); f32x4* h4 = wsp<f32x4>(F, WS_H);
      for (int e = gt; e < ML * DM / 4; e += NGT) h4[e] = x4[e];
      for (int e = gt; e < MC * DM / 4; e += NGT) h4[ML * DM / 4 + e] = c4[e]; }
    if (gt < 64 * 32) { const int pos = gt >> 5, i = gt & 31; const float inv = powf(10000.0f, -(float)i / 32.0f); const float ang = (float)pos * inv;
        wsp<float>(F, WS_ROPE)[2 * gt] = cosf(ang); wsp<float>(F, WS_ROPE)[2 * gt + 1] = sinf(ang); }
    __syncthreads();
    for (int it = gw; it < NL * 8 * 48; it += NGW) {
        const int l = it / (8 * 48), kc = (it / 48) % 8, cc = it % 48, col = cc * 256 + F.lane * 4, k0 = kc * 256;
        const float* wp = inp(F, I_WMOD) + ((size_t)l * DM + k0) * 12288 + col;
        f32x4 a0 = {0.f, 0.f, 0.f, 0.f}, a1 = a0, a2 = a0, a3 = a0, a4 = a0;
#pragma unroll 8
        for (int k = 0; k < 256; ++k) { const f32x4 w = *(const f32x4*)(wp + (size_t)k * 12288);
            a0 += sil[0 * DM + k0 + k] * w; a1 += sil[1 * DM + k0 + k] * w; a2 += sil[2 * DM + k0 + k] * w; a3 += sil[3 * DM + k0 + k] * w; a4 += sil[4 * DM + k0 + k] * w; }
        float* mp = wsp<float>(F, WS_MODP) + ((size_t)(kc * NL + l) * 5) * 12288 + col;
        *(f32x4*)(mp) = a0; *(f32x4*)(mp + 12288) = a1; *(f32x4*)(mp + 2 * 12288) = a2; *(f32x4*)(mp + 3 * 12288) = a3; *(f32x4*)(mp + 4 * 12288) = a4;
    }
}
__device__ __forceinline__ void p1_modreduce(Frame& F) {
    const int gt = F.wg * NTHR + F.tid, NGT = F.G * NTHR;
    for (int e = gt; e < NL * 5 * 12288; e += NGT) { const int l = e / (5 * 12288), j = e % 12288;
        float s = inp(F, I_BMOD)[l * 12288 + j];
#pragma unroll
        for (int kc = 0; kc < 8; ++kc) s += wsp<float>(F, WS_MODP)[(size_t)kc * NL * 5 * 12288 + e];
        wsp<float>(F, WS_MOD)[e] = s; }
}

__device__ __forceinline__ void norm_phase(Frame& F, int layer, int which, int nrows, bool partials) {
    const int gw = F.wg * NWAVES + F.wave, NGW = F.G * NWAVES;
    const float* gptr = inp(F, which ? I_N2G : I_N1G) + layer * DM;
    for (int row = gw; row < nrows; row += NGW) {
        const int mr = row < ML ? (row >> 11) : 4;
        const float* mod = wsp<float>(F, WS_MOD) + ((size_t)layer * 5 + mr) * 12288 + (which ? 3 * DM : 0);
        const f32x4* xr = (const f32x4*)(wsp<float>(F, WS_H) + (size_t)row * DM) + F.lane;
        f32x4 v[8]; float ss = 0.f;
#pragma unroll
        for (int j = 0; j < 8; ++j) v[j] = xr[64 * j];
        if (partials && row >= ML) {
            const f32x4* pp = (const f32x4*)(wsp<float>(F, WS_YDR) + (size_t)(row - ML) * DM) + F.lane;
#pragma unroll
            for (int s = 0; s < 8; ++s)
#pragma unroll
                for (int j = 0; j < 8; ++j) v[j] += pp[(size_t)s * 1024 * DM / 4 + 64 * j];
            f32x4* xw = (f32x4*)(wsp<float>(F, WS_H) + (size_t)row * DM) + F.lane;
#pragma unroll
            for (int j = 0; j < 8; ++j) xw[64 * j] = v[j];
        }
#pragma unroll
        for (int j = 0; j < 8; ++j) ss += (v[j].x * v[j].x + v[j].y * v[j].y) + (v[j].z * v[j].z + v[j].w * v[j].w);
        const float rs = 1.0f / sqrtf(wave_sum(ss, F.lane) * (1.0f / DM) + 1e-6f);
        u32x2* o = (u32x2*)(wsp<bf16>(F, WS_U) + (size_t)row * DM) + F.lane;
#pragma unroll
        for (int j = 0; j < 8; ++j) { const int c = 4 * F.lane + 256 * j;
            const f32x4 g = *(const f32x4*)(gptr + c), sh = *(const f32x4*)(mod + c), sc = *(const f32x4*)(mod + DM + c);
            const f32x4 y = (v[j] * rs) * g * (1.0f + sc) + sh;
            u32x2 w; w.x = pk2(y.x, y.y); w.y = pk2(y.z, y.w); o[64 * j] = w; }
    }
}
__device__ __forceinline__ void final_norm(Frame& F, float* out) {
    const int gw = F.wg * NWAVES + F.wave, NGW = F.G * NWAVES;
    for (int row = gw; row < ML; row += NGW) {
        const f32x4* xr = (const f32x4*)(wsp<float>(F, WS_H) + (size_t)row * DM) + F.lane;
        f32x4 v[8]; float ss = 0.f;
#pragma unroll
        for (int j = 0; j < 8; ++j) { v[j] = xr[64 * j]; ss += (v[j].x * v[j].x + v[j].y * v[j].y) + (v[j].z * v[j].z + v[j].w * v[j].w); }
        const float rs = 1.0f / sqrtf(wave_sum(ss, F.lane) * (1.0f / DM) + 1e-6f);
        f32x4* o = (f32x4*)(out + (size_t)row * DM) + F.lane;
#pragma unroll
        for (int j = 0; j < 8; ++j) { const f32x4 g = *(const f32x4*)(inp(F, I_FING) + 4 * F.lane + 256 * j); o[64 * j] = (v[j] * rs) * g; }
    }
}
__device__ __forceinline__ void prep_phase(Frame& F, int layer) {
    const int gw = F.wg * NWAVES + F.wave, NGW = F.G * NWAVES;
    const bf16* P = wsp<bf16>(F, WS_P);
    const float* mu0 = inp(F, I_MU) + (size_t)layer * 2 * RWIN; const float* mu1 = mu0 + RWIN;
    const float* rope = wsp<float>(F, WS_ROPE);
    for (int row = gw; row < MT; row += NGW) {
        bool first, last; int t = 0;
        if (row < ML) { t = row & (TL - 1); first = t == 0; last = t == TL - 1; } else { const int c = (row - ML) & (TCX - 1); first = c == 0; last = c == TCX - 1; }
        const bf16* pr = P + (size_t)row * LDP + C_RW;
        float* xs = wsp<float>(F, WS_XS) + (size_t)row * 3072; bf16* alr = wsp<bf16>(F, WS_ALR) + (size_t)row * KLR;
        for (int j2 = F.lane; j2 < RWIN / 2; j2 += 64) {
            const int c = 2 * j2;
            const unsigned pw = *(const unsigned*)(pr + c);
            const unsigned vw = first ? 0u : *(const unsigned*)(pr - LDP + c);
            const unsigned nw = last ? 0u : *(const unsigned*)(pr + LDP + c);
            const float p0 = __uint_as_float(pw << 16), p1 = __uint_as_float(pw & 0xffff0000u);
            const float v0 = __uint_as_float(vw << 16), v1 = __uint_as_float(vw & 0xffff0000u);
            const float n0 = __uint_as_float(nw << 16), n1 = __uint_as_float(nw & 0xffff0000u);
            const f32x2 m0 = *(const f32x2*)(mu0 + c), m1 = *(const f32x2*)(mu1 + c);
            const float s0 = p0 + m0.x * (v0 - p0) + m1.x * (n0 - p0), s1 = p1 + m0.y * (v1 - p1) + m1.y * (n1 - p1);
            if (c < 3072) { *(f32x2*)(xs + c) = (f32x2){s0, s1}; }
            else if (c < 3200) { *(unsigned*)(alr + (c - 3072)) = pk2(tanhf(s0), tanhf(s1)); }
            else if (c < 3328) { *(unsigned*)(alr + 128 + (c - 3200)) = pk2(s0, s1); }
            else { *(unsigned*)(alr + 256 + (c - 3328)) = pk2(sigm(s0), sigm(s1)); }
        }
        const bf16* ps = P + (size_t)row * LDP + C_SWA; bf16* qk = wsp<bf16>(F, WS_QKR) + (size_t)row * NQK;
        const bool lat = row < ML; const int rr = t >> 6, cc = t & 63;
#pragma unroll
        for (int it = 0; it < 5; ++it) { const int idx = it * 64 + F.lane, hd = idx >> 5, i = idx & 31;
            const float x1r = bf2f(ps[hd * 128 + i]), x2r = bf2f(ps[hd * 128 + 32 + i]), x1c = bf2f(ps[hd * 128 + 64 + i]), x2c = bf2f(ps[hd * 128 + 96 + i]);
            float cr = 1.f, sr = 0.f, ccs = 1.f, scs = 0.f;
            if (lat) { cr = rope[(rr * 32 + i) * 2]; sr = rope[(rr * 32 + i) * 2 + 1]; ccs = rope[(cc * 32 + i) * 2]; scs = rope[(cc * 32 + i) * 2 + 1]; }
            qk[hd * 128 + i] = (bf16)f2bf(x1r * cr - x2r * sr); qk[hd * 128 + 32 + i] = (bf16)f2bf(x2r * cr + x1r * sr);
            qk[hd * 128 + 64 + i] = (bf16)f2bf(x1c * ccs - x2c * scs); qk[hd * 128 + 96 + i] = (bf16)f2bf(x2c * ccs + x1c * scs); }
    }
}

__device__ __forceinline__ float red8(float v) {
    v += __int_as_float(__builtin_amdgcn_update_dpp(0, __float_as_int(v), 0xB1, 0xF, 0xF, true));
    v += __int_as_float(__builtin_amdgcn_update_dpp(0, __float_as_int(v), 0x4E, 0xF, 0xF, true));
    v += __int_as_float(__builtin_amdgcn_update_dpp(0, __float_as_int(v), 0x141, 0xF, 0xF, true));
    return v;
}
__device__ __forceinline__ float red16(float v) {
    v += __int_as_float(__builtin_amdgcn_update_dpp(0, __float_as_int(v), 0xB1, 0xF, 0xF, true));
    v += __int_as_float(__builtin_amdgcn_update_dpp(0, __float_as_int(v), 0x4E, 0xF, 0xF, true));
    v += __int_as_float(__builtin_amdgcn_update_dpp(0, __float_as_int(v), 0x141, 0xF, 0xF, true));
    v += __int_as_float(__builtin_amdgcn_update_dpp(0, __float_as_int(v), 0x140, 0xF, 0xF, true));
    return v;
}
struct RwPre { f32x4 r4, k4, v4, lw, la; };
__device__ __forceinline__ void rwkv_scan_unit(Frame& F, int layer, int unit) {
    const int rh = unit & 1, dir = (unit >> 1) & 1, h = (unit >> 2) & 15, b = unit >> 6;
    constexpr int BUF = 6 * 2048 + 1024;
    LAS float* const base = (LAS float*)F.lds;
    const float* XS = wsp<float>(F, WS_XS); const float* LR = wsp<float>(F, WS_LR); float* YD = wsp<float>(F, WS_YDW) + (size_t)dir * MT * BW;
    const int vrow = F.tid >> 4, kq = F.tid & 15;
    const int ptok = F.tid >> 4, pj = (F.tid & 15) * 4, pc = h * 64 + pj;
    const f32x4 w0v = *(const f32x4*)(inp(F, I_W0) + ((size_t)layer * 2 + dir) * BW + pc), a0v = *(const f32x4*)(inp(F, I_A0) + ((size_t)layer * 2 + dir) * BW + pc);
    const f32x4 kkv = *(const f32x4*)(inp(F, I_KK) + (size_t)layer * BW + pc), kav = *(const f32x4*)(inp(F, I_KA) + (size_t)layer * BW + pc);
    auto fetch = [&](int blk, RwPre& p) {
        const int row = scan_row(b, dir, blk * SCAN_BLK + ptok);
        p.r4 = *(const f32x4*)(XS + (size_t)row * 3072 + pc); p.k4 = *(const f32x4*)(XS + (size_t)row * 3072 + 1024 + pc); p.v4 = *(const f32x4*)(XS + (size_t)row * 3072 + 2048 + pc);
        p.lw = *(const f32x4*)(LR + (size_t)row * NLR + dir * 1024 + pc); p.la = *(const f32x4*)(LR + (size_t)row * NLR + 2048 + dir * 1024 + pc);
    };
    auto derive = [&](const RwPre& p, LAS float* buf) {
        f32x4 dec, av, kk, kd; float ssq = 0.f;
#pragma unroll
        for (int e = 0; e < 4; ++e) { dec[e] = __expf(-0.6065306597126334f * sigm(w0v[e] + p.lw[e])); av[e] = sigm(a0v[e] + p.la[e]); kk[e] = p.k4[e] * kkv[e]; ssq += kk[e] * kk[e];
            kd[e] = p.k4[e] * (1.0f + (av[e] - 1.0f) * kav[e]); }
        ssq += __int_as_float(__builtin_amdgcn_update_dpp(0, __float_as_int(ssq), 0xB1, 0xF, 0xF, true));
        ssq += __int_as_float(__builtin_amdgcn_update_dpp(0, __float_as_int(ssq), 0x4E, 0xF, 0xF, true));
        ssq += __int_as_float(__builtin_amdgcn_update_dpp(0, __float_as_int(ssq), 0x141, 0xF, 0xF, true));
        ssq += __int_as_float(__builtin_amdgcn_update_dpp(0, __float_as_int(ssq), 0x140, 0xF, 0xF, true));
        const float inv = 1.0f / fmaxf(sqrtf(ssq), 1e-12f);
        f32x4 an, bn;
#pragma unroll
        for (int e = 0; e < 4; ++e) { const float kn = kk[e] * inv; an[e] = -kn; bn[e] = kn * av[e]; }
        const int o = ptok * 64 + pj;
        *(LAS f32x4*)(buf + o) = p.r4; *(LAS f32x4*)(buf + 2048 + o) = dec; *(LAS f32x4*)(buf + 4096 + o) = kd; *(LAS f32x4*)(buf + 6144 + o) = p.v4; *(LAS f32x4*)(buf + 8192 + o) = an; *(LAS f32x4*)(buf + 10240 + o) = bn;
    };
    f32x2 S0 = {0.f, 0.f}, S1 = S0;
    RwPre pre;
    __syncthreads();
    fetch(0, pre); derive(pre, base);
    __syncthreads();
    constexpr int NBLK = NSTEP / SCAN_BLK;
    for (int blk = 0; blk < NBLK; ++blk) {
        LAS float* cur = base + (blk & 1) * BUF; LAS float* nxt = base + ((blk + 1) & 1) * BUF;
        if (blk + 1 < NBLK) fetch(blk + 1, pre);
        const LAS float* Rl = cur; const LAS float* Wl = cur + 2048; const LAS float* Kl = cur + 4096; const LAS float* Vl = cur + 6144; const LAS float* Al = cur + 8192; const LAS float* Bl = cur + 10240; LAS float* Yl = cur + 12288;
        const int ob = 4 * kq, vb = 32 * rh + vrow;
        f32x4 a0 = *(const LAS f32x4*)(Al + ob), w0 = *(const LAS f32x4*)(Wl + ob), b0 = *(const LAS f32x4*)(Bl + ob), k0 = *(const LAS f32x4*)(Kl + ob), r0 = *(const LAS f32x4*)(Rl + ob);
        float vv = Vl[vb];
#pragma unroll 8
        for (int tok = 0; tok < SCAN_BLK; ++tok) {
            const int on = ((tok + 1) & (SCAN_BLK - 1)) * 64;
            const f32x4 a1 = *(const LAS f32x4*)(Al + on + ob), w1 = *(const LAS f32x4*)(Wl + on + ob), b1 = *(const LAS f32x4*)(Bl + on + ob), k1 = *(const LAS f32x4*)(Kl + on + ob), r1 = *(const LAS f32x4*)(Rl + on + ob);
            const float vn = Vl[on + vb];
            f32x2 t = S0 * a0.xy; t += S1 * a0.zw;
            const float sa = red16(t.x + t.y);
            const f32x2 sa2 = {sa, sa}, vv2 = {vv, vv};
            S0 = S0 * w0.xy + (sa2 * b0.xy + vv2 * k0.xy); S1 = S1 * w0.zw + (sa2 * b0.zw + vv2 * k0.zw);
            f32x2 u = S0 * r0.xy; u += S1 * r0.zw;
            const float y = red16(u.x + u.y);
            Yl[tok * 32 + vrow] = y;
            a0 = a1; w0 = w1; b0 = b1; k0 = k1; r0 = r1; vv = vn;
        }
        if (blk + 1 < NBLK) derive(pre, nxt);
        __syncthreads();
        if (F.tid < 256) { const int e = F.tid * 4, tok = e >> 5, j = e & 31; const int row = scan_row(b, dir, blk * SCAN_BLK + tok);
          *(f32x4*)(YD + (size_t)row * BW + h * 64 + 32 * rh + j) = *(const LAS f32x4*)(Yl + e); }
    }
    __syncthreads();
}
typedef short bf16x8 __attribute__((ext_vector_type(8)));
typedef short s16x4 __attribute__((ext_vector_type(4)));
typedef float f32x16 __attribute__((ext_vector_type(16)));
typedef __bf16 bf16x2_t __attribute__((ext_vector_type(2)));
#define MFMA32(a, b, c) __builtin_amdgcn_mfma_f32_32x32x16_bf16((a), (b), (c), 0, 0, 0)
__device__ __forceinline__ int crow(int reg, int h) { return (reg & 3) + 8 * (reg >> 2) + 4 * h; }
__device__ __forceinline__ unsigned cvtpk(float lo, float hi) { f32x2 v = {lo, hi}; bf16x2_t b = __builtin_convertvector(v, bf16x2_t); return __builtin_bit_cast(unsigned, b); }
__device__ __forceinline__ s16x4 tr16(const LAS unsigned char* p) { return __builtin_bit_cast(s16x4, __builtin_amdgcn_ds_read_tr16_b64_v4i16((LAS s16x4*)p)); }
__device__ __forceinline__ bf16x8 frag_rm(const LAS unsigned char* base, int pitch, int r0, int k0, int lane) {
    return *(const LAS bf16x8*)(base + (r0 + (lane & 31)) * pitch + (k0 + 8 * (lane >> 5)) * 2);
}
template <bool PERM> __device__ __forceinline__ bf16x8 frag_tr(const LAS unsigned char* base, int pitch, int k0, int r0, int lane) {
    const int g = lane >> 4, i = lane & 15, q = i >> 2, p = i & 3, h = g >> 1;
    const LAS unsigned char* a = base + (k0 + (PERM ? 4 : 8) * h + q) * pitch + (r0 + 16 * (g & 1) + 4 * p) * 2;
    const s16x4 lo = tr16(a), hi = tr16(a + (PERM ? 8 : 4) * pitch);
    return __builtin_shufflevector(lo, hi, 0, 1, 2, 3, 4, 5, 6, 7);
}
__device__ __forceinline__ bf16x8 pack_step(const f32x16& x, int s) {
    u32x4 p; p.x = cvtpk(x[8 * s + 0], x[8 * s + 1]); p.y = cvtpk(x[8 * s + 2], x[8 * s + 3]); p.z = cvtpk(x[8 * s + 4], x[8 * s + 5]); p.w = cvtpk(x[8 * s + 6], x[8 * s + 7]);
    return __builtin_bit_cast(bf16x8, p);
}
__device__ __forceinline__ f32x16 zero16() { f32x16 z; for (int i = 0; i < 16; ++i) z[i] = 0.f; return z; }
constexpr int TP = 272;
constexpr int TILE_B = 128 * TP;
__device__ __forceinline__ void load_tile128(LAS unsigned char* dst, const bf16* src, size_t ld, int tid) {
#pragma unroll
    for (int it = 0; it < 4; ++it) { const int idx = tid + NTHR * it, row = idx >> 4, ch = idx & 15;
        *(LAS u32x4*)(dst + row * TP + ch * 16) = *(const u32x4*)(src + (size_t)row * ld + ch * 8); }
}

__device__ __forceinline__ void swa_unit(Frame& F, int layer, int unit) {
    const bf16* QK = wsp<bf16>(F, WS_QKR); const bf16* P = wsp<bf16>(F, WS_P);
    LAS unsigned char* Qt = F.lds; LAS unsigned char* Kt = F.lds + TILE_B; LAS unsigned char* Vt = F.lds + 2 * TILE_B;
    LAS float* stat = (LAS float*)(F.lds + 3 * TILE_B) + F.wave * 32;
    const int lane = F.lane, h = lane >> 5, wi = F.wave & 3, wh = F.wave >> 2;
    int b, qh, n, qrow0; bool isctx;
    if (unit < 512) { b = unit >> 7; qh = (unit >> 4) & 7; n = unit & 15; qrow0 = b * TL + n * 128; isctx = false; }
    else { const int u = unit - 512; b = u >> 4; qh = (u >> 1) & 7; n = u & 1; qrow0 = ML + b * TCX + n * 128; isctx = true; }
    const int kvh = qh >> 2;
    __syncthreads();
    load_tile128(Qt, QK + (size_t)qrow0 * NQK + qh * 128, NQK, F.tid);
    __syncthreads();
    bf16x8 qf[8];
#pragma unroll
    for (int ks = 0; ks < 8; ++ks) qf[ks] = frag_rm(Qt, TP, 32 * wi, 16 * ks, lane);
    const float L2E = 1.4426950408889634f, SC = 0.08838834764831845f * L2E;
    float m = inp(F, I_SINK)[layer * 8 + qh] * L2E, l = h == 0 ? 1.0f : 0.0f;
    f32x16 O0 = zero16(), O1 = zero16();
    const int iq = 32 * wi + (lane & 31);
    const int nch = isctx ? 2 : 5;
    for (int c = 0; c < nch; ++c) {
        int krow0, mtype = 0;
        if (isctx) krow0 = ML + b * TCX + c * 128;
        else if (c < 3) { const int kb = n - 1 + c; if (kb < 0 || kb > 15) continue; krow0 = b * TL + kb * 128; mtype = c == 0 ? 1 : (c == 2 ? 2 : 0); }
        else krow0 = ML + b * TCX + (c - 3) * 128;
        __syncthreads();
        load_tile128(Kt, QK + (size_t)krow0 * NQK + 1024 + kvh * 128, NQK, F.tid);
        load_tile128(Vt, P + (size_t)krow0 * LDP + C_SWA + 1280 + kvh * 128, LDP, F.tid);
        __syncthreads();
        for (int kb = 0; kb < 4; ++kb) {
            f32x16 X = zero16();
#pragma unroll
            for (int ks = 0; ks < 8; ++ks) X = MFMA32(frag_rm(Kt, TP, 32 * kb, 16 * ks, lane), qf[ks], X);
            float bm = -INFINITY;
            int iql = iq - 32 * kb; asm volatile("" : "+v"(iql));
#pragma unroll
            for (int r = 0; r < 16; ++r) { const int d = iql - crow(r, h); float s = X[r] * SC;
                const bool ok = mtype == 0 || (mtype == 1 ? d <= 0 : d >= 0);
                s = ok ? s : -INFINITY; X[r] = s; bm = fmaxf(bm, s); }
            bm = fmaxf(bm, shx(bm, 32, lane));
            const float mn = fmaxf(m, bm), sc = __builtin_amdgcn_exp2f(m - mn); m = mn;
            float ps = 0.f;
#pragma unroll
            for (int r = 0; r < 16; ++r) { const float p = __builtin_amdgcn_exp2f(X[r] - mn); X[r] = p; ps += p; }
            l = l * sc + ps;
            const bf16x8 pa0 = pack_step(X, 0), pa1 = pack_step(X, 1);
            if (h == 0) stat[lane] = sc;
            LDS_WAIT();
#pragma unroll
            for (int g = 0; g < 4; ++g) { const f32x4 sv = *(const LAS f32x4*)(stat + 8 * g + 4 * h);
#pragma unroll
                for (int e = 0; e < 4; ++e) { O0[4 * g + e] *= sv[e]; O1[4 * g + e] *= sv[e]; } }
            O0 = MFMA32(pa0, frag_tr<true>(Vt, TP, 32 * kb, 64 * wh, lane), O0);
            O0 = MFMA32(pa1, frag_tr<true>(Vt, TP, 32 * kb + 16, 64 * wh, lane), O0);
            O1 = MFMA32(pa0, frag_tr<true>(Vt, TP, 32 * kb, 64 * wh + 32, lane), O1);
            O1 = MFMA32(pa1, frag_tr<true>(Vt, TP, 32 * kb + 16, 64 * wh + 32, lane), O1);
        }
    }
    l += shx(l, 32, lane);
    if (h == 0) stat[lane] = 1.0f / l;
    LDS_WAIT();
    bf16* yo = wsp<bf16>(F, WS_Y) + (size_t)(qrow0 + 32 * wi) * 3072 + 1024 + qh * 128 + 64 * wh + (lane & 31);
#pragma unroll
    for (int g = 0; g < 4; ++g) { const f32x4 sv = *(const LAS f32x4*)(stat + 8 * g + 4 * h);
#pragma unroll
        for (int e = 0; e < 4; ++e) { const int r = 8 * g + 4 * h + e; yo[(size_t)r * 3072] = (bf16)f2bf(O0[4 * g + e] * sv[e]); yo[(size_t)r * 3072 + 32] = (bf16)f2bf(O1[4 * g + e] * sv[e]); } }
}

constexpr size_t ST_CHUNK = (size_t)128 * 128;
__device__ __forceinline__ int ret_chunk_row0(int b, int jF) { return jF < 2 ? ML + b * TCX + jF * 128 : b * TL + (jF - 2) * 128; }
__device__ __forceinline__ void ret_state_unit(Frame& F, int layer, int unit) {
    const int dvq = unit & 3, dir = (unit >> 2) & 1, hh = (unit >> 3) & 7, b = unit >> 6;
    const bf16* P = wsp<bf16>(F, WS_P);
    bf16* ST = wsp<bf16>(F, WS_ST) + ((size_t)((b * 8 + hh) * 2 + dir) * 18) * ST_CHUNK;
    const float gam = sigm(inp(F, I_RETDEC)[(layer * 2 + dir) * 8 + hh]); const float lg2 = __builtin_amdgcn_logf(gam);
    const float gC = __builtin_amdgcn_exp2f(lg2 * 128.0f);
    LAS unsigned char* Kt = F.lds; LAS unsigned char* Vt = F.lds + TILE_B;
    constexpr int VP = 80;
    const int lane = F.lane, h = lane >> 5, w = F.wave;
    f32x16 acc = zero16();
    u32x4 pk[4], pv;
    auto fetch = [&](int c) {
        const int jF = dir == 0 ? c : (c < 2 ? 1 - c : 19 - c); const int row0 = ret_chunk_row0(b, jF);
#pragma unroll
        for (int it = 0; it < 4; ++it) { const int idx = F.tid + NTHR * it, tp = idx >> 4, ch = idx & 15; const int row = row0 + (dir ? 127 - tp : tp);
            pk[it] = *(const u32x4*)(P + (size_t)row * LDP + C_RET + 1024 + hh * 128 + ch * 8); }
        { const int tp = F.tid >> 2, ch = F.tid & 3; const int row = row0 + (dir ? 127 - tp : tp);
          pv = *(const u32x4*)(P + (size_t)row * LDP + C_RET + 2048 + hh * 128 + dvq * 32 + ch * 8); }
    };
    fetch(0);
    for (int c = 0; c < 18; ++c) {
        const int jF = dir == 0 ? c : (c < 2 ? 1 - c : 19 - c);
        __syncthreads();
#pragma unroll
        for (int it = 0; it < 4; ++it) { const int idx = F.tid + NTHR * it, tp = idx >> 4, ch = idx & 15; *(LAS u32x4*)(Kt + tp * TP + ch * 16) = pk[it]; }
        { const int tp = F.tid >> 2, ch = F.tid & 3; *(LAS u32x4*)(Vt + tp * VP + ch * 16) = pv; }
        __syncthreads();
        if (c + 1 < 18) fetch(c + 1);
        if (w < 4) {
            int hl = h; asm volatile("" : "+v"(hl));
            bf16* so = ST + (size_t)jF * ST_CHUNK + (size_t)(dvq * 32) * 128 + 32 * w + (lane & 31);
#pragma unroll
            for (int r = 0; r < 16; ++r) so[(size_t)crow(r, h) * 128] = (bf16)f2bf(acc[r]);
#pragma unroll
            for (int r = 0; r < 16; ++r) acc[r] *= gC;
#pragma unroll
            for (int ks = 0; ks < 8; ++ks) {
                bf16x8 a = frag_tr<false>(Vt, VP, 16 * ks, 0, lane);
                u32x4 aw = __builtin_bit_cast(u32x4, a); u32x4 ow;
#pragma unroll
                for (int e = 0; e < 4; ++e) { const int t0 = 16 * ks + 8 * hl + 2 * e;
                    const float f0 = __builtin_amdgcn_exp2f(lg2 * (float)(127 - t0)) * 0.08838834764831845f, f1 = __builtin_amdgcn_exp2f(lg2 * (float)(126 - t0)) * 0.08838834764831845f;
                    ow[e] = cvtpk(bf_lo(aw[e]) * f0, bf_hi(aw[e]) * f1); }
                acc = MFMA32(__builtin_bit_cast(bf16x8, ow), frag_tr<false>(Kt, TP, 16 * ks, 32 * w, lane), acc);
            }
        }
    }
    __syncthreads();
}
__device__ __forceinline__ void ret_out_unit(Frame& F, int layer, int unit) {
    const int jF = unit % 18, hh = (unit / 18) & 7, b = unit / 144;
    const bf16* P = wsp<bf16>(F, WS_P);
    const int row0 = ret_chunk_row0(b, jF);
    LAS unsigned char* Qt = F.lds; LAS unsigned char* Kt = F.lds + TILE_B; LAS unsigned char* Vt = F.lds + 2 * TILE_B;
    const int lane = F.lane, h = lane >> 5, wi = F.wave & 3, wh = F.wave >> 2;
    const float lgf = __builtin_amdgcn_logf(sigm(inp(F, I_RETDEC)[(layer * 2 + 0) * 8 + hh])), lgb = __builtin_amdgcn_logf(sigm(inp(F, I_RETDEC)[(layer * 2 + 1) * 8 + hh]));
    __syncthreads();
    load_tile128(Qt, P + (size_t)row0 * LDP + C_RET + hh * 128, LDP, F.tid);
    load_tile128(Kt, P + (size_t)row0 * LDP + C_RET + 1024 + hh * 128, LDP, F.tid);
    load_tile128(Vt, P + (size_t)row0 * LDP + C_RET + 2048 + hh * 128, LDP, F.tid);
    __syncthreads();
    f32x16 Y0 = zero16(), Y1 = zero16();
    const int iq = 32 * wi + (lane & 31);
    for (int jb = 0; jb < 4; ++jb) {
        f32x16 X = zero16();
#pragma unroll
        for (int ks = 0; ks < 8; ++ks) X = MFMA32(frag_rm(Kt, TP, 32 * jb, 16 * ks, lane), frag_rm(Qt, TP, 32 * wi, 16 * ks, lane), X);
        int iql = iq - 32 * jb; asm volatile("" : "+v"(iql));
#pragma unroll
        for (int r = 0; r < 16; ++r) { const int d = iql - crow(r, h); const int ad = d < 0 ? -d : d;
            const float wgt = __builtin_amdgcn_exp2f((d > 0 ? lgf : lgb) * (float)ad) * (d == 0 ? 2.0f : 1.0f);
            X[r] *= wgt * 0.08838834764831845f; }
        const bf16x8 pa0 = pack_step(X, 0), pa1 = pack_step(X, 1);
        Y0 = MFMA32(pa0, frag_tr<true>(Vt, TP, 32 * jb, 64 * wh, lane), Y0);
        Y0 = MFMA32(pa1, frag_tr<true>(Vt, TP, 32 * jb + 16, 64 * wh, lane), Y0);
        Y1 = MFMA32(pa0, frag_tr<true>(Vt, TP, 32 * jb, 64 * wh + 32, lane), Y1);
        Y1 = MFMA32(pa1, frag_tr<true>(Vt, TP, 32 * jb + 16, 64 * wh + 32, lane), Y1);
    }
    __syncthreads();
    { const bf16* Sf = wsp<bf16>(F, WS_ST) + ((size_t)((b * 8 + hh) * 2 + 0) * 18 + jF) * ST_CHUNK; const bf16* Sb = wsp<bf16>(F, WS_ST) + ((size_t)((b * 8 + hh) * 2 + 1) * 18 + jF) * ST_CHUNK;
      load_tile128(Kt, Sf, 128, F.tid); load_tile128(Vt, Sb, 128, F.tid); }
    __syncthreads();
    {
        f32x16 T0 = zero16(), T1 = zero16(), U0 = zero16(), U1 = zero16();
#pragma unroll
        for (int ks = 0; ks < 8; ++ks) { const bf16x8 a = frag_rm(Qt, TP, 32 * wi, 16 * ks, lane);
            T0 = MFMA32(a, frag_rm(Kt, TP, 64 * wh, 16 * ks, lane), T0); T1 = MFMA32(a, frag_rm(Kt, TP, 64 * wh + 32, 16 * ks, lane), T1);
            U0 = MFMA32(a, frag_rm(Vt, TP, 64 * wh, 16 * ks, lane), U0); U1 = MFMA32(a, frag_rm(Vt, TP, 64 * wh + 32, 16 * ks, lane), U1); }
#pragma unroll
        for (int r = 0; r < 16; ++r) { const int i = 32 * wi + crow(r, h);
            const float ff = __builtin_amdgcn_exp2f(lgf * (float)(i + 1)), fb = __builtin_amdgcn_exp2f(lgb * (float)(128 - i));
            Y0[r] += ff * T0[r] + fb * U0[r]; Y1[r] += ff * T1[r] + fb * U1[r]; }
    }
    __syncthreads();
    LAS float* yl = (LAS float*)F.lds;
#pragma unroll
    for (int r = 0; r < 16; ++r) { const int i = 32 * wi + crow(r, h); yl[i * 132 + 64 * wh + (lane & 31)] = Y0[r]; yl[i * 132 + 64 * wh + 32 + (lane & 31)] = Y1[r]; }
    __syncthreads();
    { const int i = F.tid >> 2, part = F.tid & 3; const LAS float* yr = yl + i * 132 + 32 * part;
      f32x4 v[8]; float s = 0.f;
#pragma unroll
      for (int e = 0; e < 8; ++e) { v[e] = *(const LAS f32x4*)(yr + 4 * e); s += (v[e].x + v[e].y) + (v[e].z + v[e].w); }
      s += shx(s, 1, lane); s += shx(s, 2, lane); const float mean = s * (1.0f / 128.0f); float q = 0.f;
#pragma unroll
      for (int e = 0; e < 8; ++e) { v[e] = v[e] - mean; q += (v[e].x * v[e].x + v[e].y * v[e].y) + (v[e].z * v[e].z + v[e].w * v[e].w); }
      q += shx(q, 1, lane); q += shx(q, 2, lane); const float rs = 1.0f / sqrtf(q * (1.0f / 128.0f) + 1e-5f);
      const bf16* gp = P + (size_t)(row0 + i) * LDP + C_RET + 3072 + hh * 128 + 32 * part; bf16* yo = wsp<bf16>(F, WS_Y) + (size_t)(row0 + i) * 3072 + hh * 128 + 32 * part;
#pragma unroll
      for (int e2 = 0; e2 < 4; ++e2) { const u32x4 gw = *(const u32x4*)(gp + 8 * e2); u32x4 ow;
#pragma unroll
          for (int e = 0; e < 4; ++e) { const float g0 = bf_lo(gw[e]), g1 = bf_hi(gw[e]); const int vi = 2 * e2 + (e >> 1), vo = 2 * (e & 1);
              ow[e] = cvtpk(g0 * sigm(g0) * v[vi][vo] * rs, g1 * sigm(g1) * v[vi][vo + 1] * rs); }
          *(u32x4*)(yo + 8 * e2) = ow; } }
}

__device__ __forceinline__ void mix_phase(Frame& F, int layer, int qidx, int mode = 3) {
    if (mode & 1) for (int u = F.wg; u < 256; u += F.G) rwkv_scan_unit(F, layer, u);
    if (!(mode & 2)) return;
    const int nswa = (layer == NL - 1) ? 512 : 576;
    const int nitem = 256 + nswa;
    volatile LAS int* qslot = (volatile LAS int*)(F.lds + LDSCTL_OFF);
    for (;;) {
        __syncthreads();
        if (F.tid == 0) qslot[0] = (int)__hip_atomic_fetch_add(F.ctl + CW_SWAQ + 64 * qidx, 1u, __ATOMIC_RELAXED, __HIP_MEMORY_SCOPE_AGENT);
        __syncthreads();
        const int item = qslot[0];
        if (item >= nitem) break;
        if (item < 256) ret_state_unit(F, layer, item); else swa_unit(F, layer, item - 256);
    }
}
__device__ __forceinline__ void mixfin_phase(Frame& F, int layer, int nrows) {
    for (int u = F.wg; u < 576; u += F.G) { if (layer == NL - 1 && (u % 18) < 2) continue; ret_out_unit(F, layer, u); }
    __syncthreads();
    const int gw = F.wg * NWAVES + F.wave, NGW = F.G * NWAVES; const int lane = F.lane;
    const bf16* P = wsp<bf16>(F, WS_P); const float* XS = wsp<float>(F, WS_XS); const float* LR = wsp<float>(F, WS_LR);
    const float* Z0 = wsp<float>(F, WS_YDW); const float* Z1 = Z0 + (size_t)MT * BW;
    for (int row = gw; row < nrows; row += NGW) {
        bf16* yo = wsp<bf16>(F, WS_Y) + (size_t)row * 3072;
        for (int h = 0; h < 16; ++h) { const int c = h * 64 + lane; const size_t o = (size_t)row * BW + c;
            const float y = Z0[o] + Z1[o];
            const float mean = wave_sum(y, F.lane) * (1.0f / 64.0f); const float d = y - mean; const float var = wave_sum(d * d, F.lane) * (1.0f / 64.0f); const float rs = 1.0f / sqrtf(var + 64e-5f);
            const float r = XS[(size_t)row * 3072 + c], k = XS[(size_t)row * 3072 + 1024 + c], v = XS[(size_t)row * 3072 + 2048 + c];
            const float ka = inp(F, I_KA)[layer * BW + c], rk = inp(F, I_RK)[layer * BW + c];
            const float a0 = sigm(inp(F, I_A0)[((size_t)layer * 2 + 0) * BW + c] + LR[(size_t)row * NLR + 2048 + c]);
            const float a1 = sigm(inp(F, I_A0)[((size_t)layer * 2 + 1) * BW + c] + LR[(size_t)row * NLR + 3072 + c]);
            const float kd0 = k * (1.0f + (a0 - 1.0f) * ka), kd1 = k * (1.0f + (a1 - 1.0f) * ka);
            const float dot = wave_sum(r * (kd0 + kd1) * rk, F.lane);
            const float g = LR[(size_t)row * NLR + 4096 + c];
            const float outv = (d * rs * inp(F, I_LNG)[layer * BW + c] + dot * v) * g;
            const float nb = shx(outv, 1, F.lane);
            if (!(lane & 1)) *(unsigned*)(yo + 2048 + c) = pk2(outv, nb); }
    }
}

constexpr int NPH = 11;
constexpr int NSTEPS = 2 + NL * NPH + 1;
__global__ void __launch_bounds__(NTHR, 2) hyb_fwd(Args args) {
    extern __shared__ __attribute__((aligned(16))) unsigned char lds[];
    Frame F;
    F.lds = (LAS unsigned char*)lds;
    F.tid = threadIdx.x; F.lane = F.tid & 63; F.wave = __builtin_amdgcn_readfirstlane(F.tid >> 6);
    F.G = gridDim.x; F.wg = blockIdx.x; F.ws = args.ws; F.ctl = (unsigned*)(args.ws + WS_CTL);
    for (int u = F.tid; u < (LDS_BYTES - LDSCTL_OFF) / 4; u += NTHR) ((LAS unsigned*)(F.lds + LDSCTL_OFF))[u] = 0u;
    __syncthreads();
    if (F.tid < 26) { const __attribute__((address_space(4))) unsigned long long* kp = (const __attribute__((address_space(4))) unsigned long long*)__builtin_amdgcn_kernarg_segment_ptr();
        ((LAS unsigned long long*)(F.lds + PTAB_OFF))[F.tid] = kp[F.tid]; }
    __syncthreads();
    XcdBarrier bar = xcd_barrier_post(F.ctl + CW_BAR, (volatile LAS unsigned*)(F.lds + MISC_OFF) + 8);
    int lo = args.s_lo, hi = args.s_hi;
#define IN(k) (lo <= (k) && (k) < hi)
#define SL() asm volatile("" : "+s"(lo), "+s"(hi), "+s"(F.ws), "+s"(F.wg), "+s"(F.G))
#define LAUNDER() do { int t_ = threadIdx.x; asm volatile("" : "+v"(t_)); F.tid = t_; F.lane = t_ & 63; F.wave = __builtin_amdgcn_readfirstlane(t_ >> 6); } while (0)
#define SEAM(k) do { SL(); if (IN(k) && IN((k) + 1)) xcd_barrier(bar); } while (0)
    SL(); if (IN(0)) { LAUNDER(); p0_prologue(F); }
#ifdef PROBE_P0
    SL(); if (IN(0)) { xcd_barrier(bar); LAUNDER(); p0_prologue(F); }
#endif
    SEAM(0);
    SL(); if (IN(1)) { LAUNDER(); p1_modreduce(F); }
    SEAM(1);
    for (int layer_ = 0; layer_ < NL; ++layer_) {
        int layer = layer_; asm volatile("" : "+s"(layer));
        const int s0 = 2 + layer * NPH;
        const int mrows = (layer == NL - 1) ? ML : MT;
        const float* modl = wsp<float>(F, WS_MOD) + (size_t)layer * 5 * 12288;
        SL(); if (IN(s0 + 0)) { LAUNDER(); norm_phase(F, layer, 0, MT, layer > 0); }
        SEAM(s0 + 0);
        SL(); if (IN(s0 + 1)) {
            pg8::Gemm g{wsp<bf16>(F, WS_U), wsp<bf16>(F, WS_WIN + layer * SZ_WIN), MT, LDP, DM, DM, DM}; pg8::StaticOrder S; S.init(MT, LDP, F.G, F.wg);
            pg8::EpiBf16<0> E{wsp<bf16>(F, WS_P), LDP};
            pg8::gemm_phase<pg8::EpiBf16<0>, pg8::StaticOrder, true, true>(F.lds, g, S, E);
#ifdef PROBE_GEMM2
            pg8::gemm_phase<pg8::EpiBf16<0>, pg8::StaticOrder, true, true>(F.lds, g, S, E);
#endif
        }
        SEAM(s0 + 1);
        SL(); if (IN(s0 + 2)) { LAUNDER(); prep_phase(F, layer); }
        SEAM(s0 + 2);
        SL(); if (IN(s0 + 3)) {
            pg8::Gemm g{wsp<bf16>(F, WS_ALR), wsp<bf16>(F, WS_WLR + layer * SZ_WLR), MT, NLR, KLR, KLR, KLR}; pg8::StaticOrder S; S.init(MT, NLR, F.G, F.wg);
            pg8::EpiF32 E{wsp<float>(F, WS_LR), NLR};
            pg8::gemm_phase<pg8::EpiF32, pg8::StaticOrder, true, true>(F.lds, g, S, E);
        }
        SEAM(s0 + 3);
        SL(); if (IN(s0 + 4)) { LAUNDER(); mix_phase(F, layer, layer); }
#ifdef PROBE_MIX
        SL(); if (IN(s0 + 4)) { xcd_barrier(bar); LAUNDER(); mix_phase(F, layer, layer + 4, PROBE_MIX); }
#endif
        SEAM(s0 + 4);
        SL(); if (IN(s0 + 5)) { LAUNDER(); mixfin_phase(F, layer, mrows); }
        SEAM(s0 + 5);
        SL(); if (IN(s0 + 6)) {
            const bf16* wbr = wsp<bf16>(F, WS_WBR + layer * SZ_WBR);
            pg8::StaticOrder S; S.init(mrows, DM, F.G, F.wg);
            { pg8::Gemm g{wsp<bf16>(F, WS_Y), wbr, mrows, DM, BW, 3072, BW}; pg8::EpiGate<0> E{wsp<bf16>(F, WS_P) + C_GATE, LDP, wsp<float>(F, WS_MGF), wsp<bf16>(F, WS_MG)};
              pg8::gemm_phase<pg8::EpiGate<0>, pg8::StaticOrder, true, true>(F.lds, g, S, E); }
            { pg8::Gemm g{wsp<bf16>(F, WS_Y) + 1024, wbr + (size_t)DM * BW, mrows, DM, BW, 3072, BW}; pg8::EpiGate<1> E{wsp<bf16>(F, WS_P) + C_GATE + 2048, LDP, wsp<float>(F, WS_MGF), wsp<bf16>(F, WS_MG)};
              pg8::gemm_phase<pg8::EpiGate<1>, pg8::StaticOrder, true, true>(F.lds, g, S, E); }
            { pg8::Gemm g{wsp<bf16>(F, WS_Y) + 2048, wbr + (size_t)2 * DM * BW, mrows, DM, BW, 3072, BW}; pg8::EpiGate<2> E{wsp<bf16>(F, WS_P) + C_GATE + 4096, LDP, wsp<float>(F, WS_MGF), wsp<bf16>(F, WS_MG)};
              pg8::gemm_phase<pg8::EpiGate<2>, pg8::StaticOrder, true, true>(F.lds, g, S, E); }
        }
        SEAM(s0 + 6);
        SL(); if (IN(s0 + 7)) {
            { pg8::Gemm g{wsp<bf16>(F, WS_MG), wsp<bf16>(F, WS_WOUT + layer * SZ_WOUT), ML, DM, DM, DM, DM}; pg8::StaticOrder S; S.init(ML, DM, F.G, F.wg);
              pg8::EpiResGate E{wsp<float>(F, WS_H), modl, 2 * DM};
              pg8::gemm_phase<pg8::EpiResGate, pg8::StaticOrder, true, true>(F.lds, g, S, E); }
            if (mrows > ML) { const int ks = (F.wg & 7) * (DM / 8);
              pg8::Gemm g{wsp<bf16>(F, WS_MG) + ks, wsp<bf16>(F, WS_WOUT + layer * SZ_WOUT) + ks, MT, DM, DM / 8, DM, DM}; pg8::SubKOrder S{F.G, F.wg};
              pg8::EpiResGatePart E{wsp<float>(F, WS_YDR), modl, 2 * DM, (int)(F.wg & 7)};
              pg8::gemm_phase<pg8::EpiResGatePart, pg8::SubKOrder, true, true>(F.lds, g, S, E); }
        }
        SEAM(s0 + 7);
        SL(); if (IN(s0 + 8)) { LAUNDER(); norm_phase(F, layer, 1, mrows, true); }
        SEAM(s0 + 8);
        SL(); if (IN(s0 + 9)) {
            pg8::Gemm g{wsp<bf16>(F, WS_U), wsp<bf16>(F, WS_WFF1 + layer * SZ_WFF), mrows, DFF, DM, DM, DM}; pg8::StaticOrder S; S.init(mrows, DFF, F.G, F.wg);
            pg8::EpiBf16<2> E{wsp<bf16>(F, WS_F), DFF};
            pg8::gemm_phase<pg8::EpiBf16<2>, pg8::StaticOrder, true, true>(F.lds, g, S, E);
#ifdef PROBE_GEMM2
            pg8::gemm_phase<pg8::EpiBf16<2>, pg8::StaticOrder, true, true>(F.lds, g, S, E);
#endif
        }
        SEAM(s0 + 9);
        SL(); if (IN(s0 + 10)) {
            { pg8::Gemm g{wsp<bf16>(F, WS_F), wsp<bf16>(F, WS_WFF2 + layer * SZ_WFF), ML, DM, DFF, DFF, DFF}; pg8::StaticOrder S; S.init(ML, DM, F.G, F.wg);
              pg8::EpiResGate E{wsp<float>(F, WS_H), modl, 5 * DM};
              pg8::gemm_phase<pg8::EpiResGate, pg8::StaticOrder, true, true>(F.lds, g, S, E); }
            if (mrows > ML) { const int ks = (F.wg & 7) * (DFF / 8);
              pg8::Gemm g{wsp<bf16>(F, WS_F) + ks, wsp<bf16>(F, WS_WFF2 + layer * SZ_WFF) + ks, MT, DM, DFF / 8, DFF, DFF}; pg8::SubKOrder S{F.G, F.wg};
              pg8::EpiResGatePart E{wsp<float>(F, WS_YDR), modl, 5 * DM, (int)(F.wg & 7)};
              pg8::gemm_phase<pg8::EpiResGatePart, pg8::SubKOrder, true, true>(F.lds, g, S, E); }
        }
        SEAM(s0 + 10);
    }
    SL(); if (IN(NSTEPS - 1)) { LAUNDER(); final_norm(F, args.out); }
#undef IN
#undef SL
#undef LAUNDER
#undef SEAM
}

#ifndef MK_ONE_LAUNCH
#define MK_ONE_LAUNCH 1
#endif
extern "C" void kernel_launch(void* const* d_in, const int* in_sizes, int n_in, void* d_out, int out_size, void* d_ws, size_t ws_size, hipStream_t stream) {
    static int grid = 0;
    if (grid == 0) {
        if (n_in != 26 || out_size != ML * DM || ws_size < WS_END) { fprintf(stderr, "kernel_launch: unexpected shapes (n_in %d, out %d, ws %zu < %zu)\n", n_in, out_size, ws_size, (size_t)WS_END); grid = -1; return; }
        int dev = 0, cus = 0, per_cu = 0;
        if (hipGetDevice(&dev) != hipSuccess || hipDeviceGetAttribute(&cus, hipDeviceAttributeMultiprocessorCount, dev) != hipSuccess) { grid = -1; return; }
        if (hipFuncSetAttribute((const void*)hyb_fwd, hipFuncAttributeMaxDynamicSharedMemorySize, LDS_BYTES) != hipSuccess) { fprintf(stderr, "kernel_launch: hipFuncSetAttribute failed\n"); grid = -1; return; }
        if (hipOccupancyMaxActiveBlocksPerMultiprocessor(&per_cu, (const void*)hyb_fwd, NTHR, LDS_BYTES) != hipSuccess || per_cu < 1) fprintf(stderr, "kernel_launch: occupancy query reports %d\n", per_cu);
        (void)hipGetLastError();
        grid = cus;
    }
    if (grid < 0) return;
    if (hipMemsetAsync((char*)d_ws + WS_CTL, 0, CTL_ZERO_BYTES, stream) != hipSuccess) return;
    Args a{};
    for (int i = 0; i < 26; ++i) a.in[i] = (const float*)d_in[i];
    a.out = (float*)d_out; a.ws = (unsigned char*)d_ws;
#if MK_ONE_LAUNCH
    a.s_lo = 0; a.s_hi = NSTEPS;
    hipLaunchKernelGGL(hyb_fwd, dim3(grid), dim3(NTHR), LDS_BYTES, stream, a);
#else
    for (int s = 0; s < NSTEPS; ++s) { a.s_lo = s; a.s_hi = s + 1; hipLaunchKernelGGL(hyb_fwd, dim3(grid), dim3(NTHR), LDS_BYTES, stream, a); }
#endif
}
```

```cpp
#include <hip/hip_runtime.h>
#include <cstdio>
#include <cstdint>
namespace pg8 {
#define PG8_LAS __attribute__((address_space(3)))
typedef unsigned short bf16_t;
typedef short bf16x8 __attribute__((ext_vector_type(8)));
typedef float f32x4 __attribute__((ext_vector_type(4)));
typedef unsigned u32x4 __attribute__((ext_vector_type(4)));
constexpr int BM = 256, BK = 64, HALF = 128, HTB = HALF * BK * 2  , STAGE_BYTES = 8 * HTB, NXCD = 8, WGM = 8;

__host__ __device__ __forceinline__ int lds_byte(int r, int c) { const int st = (r >> 4) * 2 + (c >> 5), rr = r & 15, cc = c & 31, ob = rr * 64 + cc * 2; return st * 1024 + (ob ^ (((ob >> 9) & 1) << 5)); }
__host__ __device__ __forceinline__ void stage_rc(int b, int& R, int& C) { const int st = b / 1024, sb = b % 1024, swz = sb ^ (((sb >> 9) & 1) << 5); R = (st >> 1) * 16 + swz / 64; C = (st & 1) * 32 + (swz % 64) / 2; }
__host__ __device__ __forceinline__ int perm32(int rho) { const int n = rho >> 4, i = rho & 15; return 8 * (i >> 2) + 4 * n + (i & 3); }

struct Unit { int pm, pn; };
struct Gemm { const bf16_t* A; const bf16_t* Bt; int M, N, K, lda, ldb; };

struct StaticOrder {
    int nM, nN, nwg, G, c;
    __host__ __device__ void init(int M, int N, int G_, int c_) { nM = M / BM; nN = N / BM; nwg = nM * nN; G = G_; c = c_; }
    __host__ __device__ bool next(int i, Unit& u) const {
        const long L = (long)i * G + c; if (L >= nwg) return false;
        int wgid = (int)L; { const int q = nwg / NXCD, r = nwg % NXCD, xcd = wgid % NXCD, off = wgid / NXCD; wgid = (xcd < r ? xcd * (q + 1) : r * (q + 1) + (xcd - r) * q) + off; }
        const int nig = WGM * nN, gid = wgid / nig, fm = gid * WGM, gsz = (nM - fm) < WGM ? (nM - fm) : WGM;
        u.pm = fm + ((wgid % nig) % gsz); u.pn = (wgid % nig) / gsz; return true;
    }
    __device__ __forceinline__ void a_ready(const Unit&) const {}
    __device__ __forceinline__ void done(const Unit&) const {}
};

__device__ __forceinline__ unsigned cvt_pk_bf16(float lo, float hi) { unsigned r; asm volatile("v_cvt_pk_bf16_f32 %0, %1, %2" : "=v"(r) : "v"(lo), "v"(hi)); return r; }
typedef float f32x2 __attribute__((ext_vector_type(2)));
__device__ __forceinline__ float sigmoidf_(float x) { return 1.0f / (1.0f + __expf(-x)); }
__device__ __forceinline__ float bf_lo(unsigned w) { return __uint_as_float(w << 16); }
__device__ __forceinline__ float bf_hi(unsigned w) { return __uint_as_float(w & 0xffff0000u); }

template <int ACT> struct EpiBf16 {
    static constexpr bool PERM = true, AFTER_DRAIN = false;
    bf16_t* O; int ldc;
    __device__ __forceinline__ void operator()(const f32x4 (&acc)[2][2][4][2], const Unit& u, int wr, int wc, int fr, int fq) const {
        const int row0 = u.pm * BM + wr * 64 + fr; const int col0 = u.pn * BM + wc * 32 + 8 * fq;
#pragma unroll
        for (int ai = 0; ai < 2; ++ai)
#pragma unroll
            for (int m = 0; m < 4; ++m) { bf16_t* rowp = O + (size_t)(row0 + ai * HALF + m * 16) * ldc + col0;
#pragma unroll
                for (int bj = 0; bj < 2; ++bj) { f32x4 v0 = acc[ai][bj][m][0], v1 = acc[ai][bj][m][1];
                    if (ACT == 2) {
#pragma unroll
                        for (int e = 0; e < 4; ++e) { const float a = fmaxf(v0[e], 0.f), b = fmaxf(v1[e], 0.f); v0[e] = a * a; v1[e] = b * b; } }
                    u32x4 w; w.x = cvt_pk_bf16(v0[0], v0[1]); w.y = cvt_pk_bf16(v0[2], v0[3]); w.z = cvt_pk_bf16(v1[0], v1[1]); w.w = cvt_pk_bf16(v1[2], v1[3]);
                    *(u32x4*)(rowp + bj * HALF) = w; } }
    }
};
struct EpiF32 {
    static constexpr bool PERM = false, AFTER_DRAIN = false;
    float* C; int ldc;
    __device__ __forceinline__ void operator()(const f32x4 (&acc)[2][2][4][2], const Unit& u, int wr, int wc, int fr, int fq) const {
        const int row0 = u.pm * BM + wr * 64 + fr, col0 = u.pn * BM + wc * 32 + 4 * fq;
#pragma unroll
        for (int ai = 0; ai < 2; ++ai)
#pragma unroll
            for (int m = 0; m < 4; ++m) { float* rowp = C + (size_t)(row0 + ai * HALF + m * 16) * ldc + col0;
#pragma unroll
                for (int bj = 0; bj < 2; ++bj)
#pragma unroll
                    for (int n = 0; n < 2; ++n) *(f32x4*)(rowp + bj * HALF + n * 16) = acc[ai][bj][m][n]; }
    }
};
template <int MODE> struct EpiGate {
    static constexpr bool PERM = true, AFTER_DRAIN = false;
    const bf16_t* G; int ldg;
    float* part; bf16_t* out;
    __device__ __forceinline__ void operator()(const f32x4 (&acc)[2][2][4][2], const Unit& u, int wr, int wc, int fr, int fq) const {
        const int row0 = u.pm * BM + wr * 64 + fr; const int col0 = u.pn * BM + wc * 32 + 8 * fq;
#pragma unroll
        for (int ai = 0; ai < 2; ++ai)
#pragma unroll
            for (int m = 0; m < 4; ++m) { const size_t row = (size_t)(row0 + ai * HALF + m * 16);
#pragma unroll
                for (int bj = 0; bj < 2; ++bj) { const int c = col0 + bj * HALF;
                    const u32x4 gw = *(const u32x4*)(G + row * ldg + c);
                    f32x4 g0, g1; g0[0] = sigmoidf_(bf_lo(gw.x)); g0[1] = sigmoidf_(bf_hi(gw.x)); g0[2] = sigmoidf_(bf_lo(gw.y)); g0[3] = sigmoidf_(bf_hi(gw.y));
                    g1[0] = sigmoidf_(bf_lo(gw.z)); g1[1] = sigmoidf_(bf_hi(gw.z)); g1[2] = sigmoidf_(bf_lo(gw.w)); g1[3] = sigmoidf_(bf_hi(gw.w));
                    f32x4 v0 = acc[ai][bj][m][0] * g0, v1 = acc[ai][bj][m][1] * g1;
                    float* pp = part + row * 2048 + c;
                    if (MODE >= 1) { v0 += *(const f32x4*)pp; v1 += *(const f32x4*)(pp + 4); }
                    if (MODE <= 1) { *(f32x4*)pp = v0; *(f32x4*)(pp + 4) = v1; }
                    else { u32x4 w; w.x = cvt_pk_bf16(v0[0], v0[1]); w.y = cvt_pk_bf16(v0[2], v0[3]); w.z = cvt_pk_bf16(v1[0], v1[1]); w.w = cvt_pk_bf16(v1[2], v1[3]);
                        *(u32x4*)(out + row * 2048 + c) = w; } } }
    }
};
struct EpiResGate {
    static constexpr bool PERM = false, AFTER_DRAIN = false;
    float* H; const float* modl; int goff;
    __device__ __forceinline__ void operator()(const f32x4 (&acc)[2][2][4][2], const Unit& u, int wr, int wc, int fr, int fq) const {
        const int mr = u.pm < 32 ? (u.pm >> 3) : 4;
        const int row0 = u.pm * BM + wr * 64 + fr, col0 = u.pn * BM + wc * 32 + 4 * fq;
        const float* gv = modl + (size_t)mr * 12288 + goff + col0;
        f32x4 gg[2][2];
#pragma unroll
        for (int bj = 0; bj < 2; ++bj)
#pragma unroll
            for (int n = 0; n < 2; ++n) gg[bj][n] = *(const f32x4*)(gv + bj * HALF + n * 16);
#pragma unroll
        for (int ai = 0; ai < 2; ++ai)
#pragma unroll
            for (int m = 0; m < 4; ++m) { float* rowp = H + (size_t)(row0 + ai * HALF + m * 16) * 2048 + col0;
#pragma unroll
                for (int bj = 0; bj < 2; ++bj)
#pragma unroll
                    for (int n = 0; n < 2; ++n) { f32x4* p = (f32x4*)(rowp + bj * HALF + n * 16); *p = *p + gg[bj][n] * acc[ai][bj][m][n]; } }
    }
};

struct EpiResGatePart {
    static constexpr bool PERM = false, AFTER_DRAIN = false;
    float* part; const float* modl; int goff, slice;
    __device__ __forceinline__ void operator()(const f32x4 (&acc)[2][2][4][2], const Unit& u, int wr, int wc, int fr, int fq) const {
        const int row0 = (u.pm - 32) * BM + wr * 64 + fr, col0 = u.pn * BM + wc * 32 + 4 * fq;
        const float* gv = modl + (size_t)4 * 12288 + goff + col0;
        f32x4 gg[2][2];
#pragma unroll
        for (int bj = 0; bj < 2; ++bj)
#pragma unroll
            for (int n = 0; n < 2; ++n) gg[bj][n] = *(const f32x4*)(gv + bj * HALF + n * 16);
#pragma unroll
        for (int ai = 0; ai < 2; ++ai)
#pragma unroll
            for (int m = 0; m < 4; ++m) { float* rowp = part + ((size_t)slice * 1024 + (row0 + ai * HALF + m * 16)) * 2048 + col0;
#pragma unroll
                for (int bj = 0; bj < 2; ++bj)
#pragma unroll
                    for (int n = 0; n < 2; ++n) *(f32x4*)(rowp + bj * HALF + n * 16) = gg[bj][n] * acc[ai][bj][m][n]; }
    }
};
struct SubKOrder {
    int G, c;
    __host__ __device__ bool next(int i, Unit& u) const { const int L = i * G + c; if (L >= 256) return false; const int lt = L >> 3; u.pm = 32 + (lt >> 3); u.pn = lt & 7; return true; }
    __device__ __forceinline__ void a_ready(const Unit&) const {}
    __device__ __forceinline__ void done(const Unit&) const {}
};

template <class Epi, class Sched, bool ALIGN_EPI = false, bool SP2 = false>
__device__ __forceinline__ void gemm_phase(PG8_LAS unsigned char* lds, const Gemm g, const Sched& S, const Epi& E) {
    int tid_ = threadIdx.x; asm volatile("" : "+v"(tid_));
    const int tid = tid_, wid = __builtin_amdgcn_readfirstlane(tid >> 6), lane = tid & 63, wr = wid >> 2, wc = wid & 3, fr = lane & 15, fq = lane >> 4;
    const int K = g.K, nt = K / BK;
    unsigned voffA[2], voffB[2];
#pragma unroll
    for (int i = 0; i < 2; ++i) { int R, C; stage_rc(tid * 16 + i * 8192, R, C); const int Rb = Epi::PERM ? ((R & ~31) + perm32(R & 31)) : R;
        voffA[i] = (unsigned)(R * g.lda + C) * 2u; voffB[i] = (unsigned)(Rb * g.ldb + C) * 2u; }
    const size_t kstep = (size_t)(BK * 2);
    const size_t hstepA = (size_t)HALF * g.lda * 2, hstepB = (size_t)HALF * g.ldb * 2;
    const size_t tstepA = 2 * hstepA, tstepB = 2 * hstepB;
    const unsigned ldsw = (unsigned)wid * 1024u;
    const int aoff = lds_byte(wr * 64 + fr, fq * 8), boff = lds_byte(wc * 32 + fr, fq * 8);
#define PG8_SA(b, h) (((b) * 2 + (h)) * HTB)
#define PG8_SB(b, h) ((4 + (b) * 2 + (h)) * HTB)
#define PG8_STAGE(bufoff, gbase, voff) do { _Pragma("unroll") for (int _i = 0; _i < 2; ++_i) \
        __builtin_amdgcn_global_load_lds((const unsigned*)((const char*)(gbase) + (voff)[_i]), (PG8_LAS unsigned*)(lds + (bufoff) + ldsw + _i * 8192), 16, 0, 0); } while (0)
#define PG8_LDA(dst, b, h) do { _Pragma("unroll") for (int m = 0; m < 4; ++m) _Pragma("unroll") for (int k = 0; k < 2; ++k) dst[m][k] = *(const PG8_LAS bf16x8*)(lds + PG8_SA(b, h) + aoff + m * 2048 + k * 1024); } while (0)
#define PG8_LDB(dst, b, h) do { _Pragma("unroll") for (int n = 0; n < 2; ++n) _Pragma("unroll") for (int k = 0; k < 2; ++k) dst[n][k] = *(const PG8_LAS bf16x8*)(lds + PG8_SB(b, h) + boff + n * 2048 + k * 1024); } while (0)
#define PG8_MMA(ai, bj, At, Bt) do { __builtin_amdgcn_s_setprio(1); _Pragma("unroll") for (int m = 0; m < 4; ++m) _Pragma("unroll") for (int n = 0; n < 2; ++n) _Pragma("unroll") for (int k = 0; k < 2; ++k) \
        acc[ai][bj][m][n] = __builtin_amdgcn_mfma_f32_16x16x32_bf16(Bt[n][k], At[m][k], acc[ai][bj][m][n], 0, 0, 0); __builtin_amdgcn_s_setprio(0); } while (0)
#define PG8_WAIT_V(n) asm volatile("s_waitcnt vmcnt(" #n ")" ::: "memory")
#define PG8_WAIT_L(n) asm volatile("s_waitcnt lgkmcnt(" #n ")" ::: "memory")
#define PG8_BAR __builtin_amdgcn_s_barrier()
#define PG8_SCHED __builtin_amdgcn_sched_barrier(0)
    Unit cur, nxt; int ui = 0;
    if (!S.next(0, cur)) return;
    f32x4 acc[2][2][4][2];
#pragma unroll
    for (int a = 0; a < 2; ++a)
#pragma unroll
        for (int b = 0; b < 2; ++b)
#pragma unroll
            for (int m = 0; m < 4; ++m)
#pragma unroll
                for (int n = 0; n < 2; ++n) acc[a][b][m][n] = (f32x4){0.f, 0.f, 0.f, 0.f};
    bf16x8 At[4][2], B0[2][2], B1[2][2];
    const char* cA = (const char*)g.A + (size_t)cur.pm * tstepA; const char* cB = (const char*)g.Bt + (size_t)cur.pn * tstepB;
    S.a_ready(cur);
    if constexpr (SP2) {
        PG8_STAGE(PG8_SB(0, 0), cB, voffB); PG8_STAGE(PG8_SB(0, 1), cB + hstepB, voffB); PG8_STAGE(PG8_SA(0, 0), cA, voffA); PG8_STAGE(PG8_SA(0, 1), cA + hstepA, voffA);
        if (wr == 1) PG8_BAR;
        PG8_WAIT_V(2); PG8_BAR;
        PG8_STAGE(PG8_SB(1, 0), cB + kstep, voffB); PG8_STAGE(PG8_SA(1, 0), cA + kstep, voffA); PG8_STAGE(PG8_SB(1, 1), cB + hstepB + kstep, voffB);
        PG8_WAIT_V(6); PG8_BAR;
    } else {
        PG8_STAGE(PG8_SB(0, 0), cB, voffB); PG8_STAGE(PG8_SA(0, 0), cA, voffA); PG8_STAGE(PG8_SB(0, 1), cB + hstepB, voffB); PG8_STAGE(PG8_SA(0, 1), cA + hstepA, voffA);
        if (wr == 1) PG8_BAR;
        PG8_WAIT_V(4); PG8_BAR;
        PG8_STAGE(PG8_SB(1, 0), cB + kstep, voffB); PG8_STAGE(PG8_SA(1, 0), cA + kstep, voffA); PG8_STAGE(PG8_SB(1, 1), cB + hstepB + kstep, voffB);
        PG8_WAIT_V(6); PG8_BAR;
    }
    for (;;) {
        const bool has_next = S.next(ui + 1, nxt);
        const char* nA = has_next ? (const char*)g.A + (size_t)nxt.pm * tstepA : cA; const char* nB = has_next ? (const char*)g.Bt + (size_t)nxt.pn * tstepB : cB;
#pragma nounroll
        for (int t = 0; t < nt; t += 2) {
            const bool last = (t == nt - 2);
            const char* a1 = cA + (size_t)(t + 1) * kstep;
            const char* a2 = last ? nA : cA + (size_t)(t + 2) * kstep; const char* b2 = last ? nB : cB + (size_t)(t + 2) * kstep;
            const char* a3 = a2 + kstep; const char* b3 = b2 + kstep;
            if (last && has_next) S.a_ready(nxt);
            if constexpr (SP2) {
            PG8_LDB(B0, 0, 0); PG8_LDB(B1, 0, 1); PG8_SCHED; PG8_LDA(At, 0, 0); PG8_STAGE(PG8_SA(1, 1), a1 + hstepA, voffA);
            PG8_WAIT_V(8); PG8_WAIT_L(0); PG8_BAR; PG8_MMA(0, 0, At, B0); PG8_MMA(0, 1, At, B1); PG8_BAR; PG8_SCHED;
            PG8_LDA(At, 0, 1); PG8_STAGE(PG8_SB(0, 0), b2, voffB); PG8_STAGE(PG8_SB(0, 1), b2 + hstepB, voffB); PG8_STAGE(PG8_SA(0, 0), a2, voffA);
            PG8_WAIT_V(8); PG8_WAIT_L(0); PG8_BAR; PG8_MMA(1, 0, At, B0); PG8_MMA(1, 1, At, B1); PG8_BAR; PG8_SCHED;
            PG8_LDB(B0, 1, 0); PG8_LDB(B1, 1, 1); PG8_SCHED; PG8_LDA(At, 1, 0); PG8_STAGE(PG8_SA(0, 1), a2 + hstepA, voffA);
            PG8_WAIT_V(8); PG8_WAIT_L(0); PG8_BAR; PG8_MMA(0, 0, At, B0); PG8_MMA(0, 1, At, B1); PG8_BAR; PG8_SCHED;
            PG8_LDA(At, 1, 1); PG8_STAGE(PG8_SB(1, 0), b3, voffB); PG8_STAGE(PG8_SB(1, 1), b3 + hstepB, voffB); PG8_STAGE(PG8_SA(1, 0), a3, voffA);
            PG8_WAIT_V(8); PG8_WAIT_L(0); PG8_BAR; PG8_MMA(1, 0, At, B0); PG8_MMA(1, 1, At, B1); PG8_BAR; PG8_SCHED;
            } else {
            PG8_LDB(B0, 0, 0); PG8_SCHED; PG8_LDA(At, 0, 0); PG8_STAGE(PG8_SA(1, 1), a1 + hstepA, voffA);
            PG8_WAIT_L(8); PG8_BAR; PG8_WAIT_L(0); PG8_MMA(0, 0, At, B0); PG8_BAR; PG8_SCHED;
            PG8_LDB(B1, 0, 1); PG8_STAGE(PG8_SB(0, 0), b2, voffB);
            PG8_BAR; PG8_WAIT_L(0); PG8_MMA(0, 1, At, B1); PG8_BAR;
            PG8_LDA(At, 0, 1); PG8_STAGE(PG8_SA(0, 0), a2, voffA);
            PG8_BAR; PG8_WAIT_L(0); PG8_MMA(1, 0, At, B0); PG8_BAR; PG8_SCHED;
            PG8_STAGE(PG8_SB(0, 1), b2 + hstepB, voffB);
            PG8_WAIT_V(6); PG8_BAR; PG8_MMA(1, 1, At, B1); PG8_BAR;
            PG8_LDB(B0, 1, 0); PG8_SCHED; PG8_LDA(At, 1, 0); PG8_STAGE(PG8_SA(0, 1), a2 + hstepA, voffA);
            PG8_WAIT_L(8); PG8_BAR; PG8_WAIT_L(0); PG8_MMA(0, 0, At, B0); PG8_BAR; PG8_SCHED;
            PG8_LDB(B1, 1, 1); PG8_STAGE(PG8_SB(1, 0), b3, voffB);
            PG8_BAR; PG8_WAIT_L(0); PG8_MMA(0, 1, At, B1); PG8_BAR;
            PG8_LDA(At, 1, 1); PG8_STAGE(PG8_SA(1, 0), a3, voffA);
            PG8_BAR; PG8_WAIT_L(0); PG8_MMA(1, 0, At, B0); PG8_BAR; PG8_SCHED;
            PG8_STAGE(PG8_SB(1, 1), b3 + hstepB, voffB);
            PG8_WAIT_V(6); PG8_BAR; PG8_MMA(1, 1, At, B1); PG8_BAR;
            }
        }
        if constexpr (ALIGN_EPI) { if (wr == 0) PG8_BAR; }
        if constexpr (!Epi::AFTER_DRAIN) { int t2_ = threadIdx.x; asm volatile("" : "+v"(t2_));   E(acc, cur, wr, wc, t2_ & 15, (t2_ >> 4) & 3); S.done(cur); }
        if (!has_next) break;
#pragma unroll
        for (int a = 0; a < 2; ++a)
#pragma unroll
            for (int b = 0; b < 2; ++b)
#pragma unroll
                for (int m = 0; m < 4; ++m)
#pragma unroll
                    for (int n = 0; n < 2; ++n) acc[a][b][m][n] = (f32x4){0.f, 0.f, 0.f, 0.f};
        cur = nxt; cA = nA; cB = nB; ++ui;
        if constexpr (ALIGN_EPI) { if (wr == 1) PG8_BAR; }
    }
    PG8_WAIT_V(0);
    if constexpr (!ALIGN_EPI) { if (wr == 0) PG8_BAR; }
    PG8_BAR;
    if constexpr (Epi::AFTER_DRAIN) { E.fused(acc, cur, wr, wc, fr, fq, lds, wid, lane); S.done(cur); }
#undef PG8_SA
#undef PG8_SB
#undef PG8_STAGE
#undef PG8_LDA
#undef PG8_LDB
#undef PG8_MMA
#undef PG8_WAIT_V
#undef PG8_WAIT_L
#undef PG8_BAR
#undef PG8_SCHED
}
}

constexpr int NB = 4, TL = 2048, TCX = 256, DM = 2048, NL = 4, DFF = 8192, BW = 1024;
constexpr int ML = NB * TL, MC = NB * TCX, MT = ML + MC;
constexpr int NIN = 15232, LDP = 15360;
constexpr int C_RET = 0, C_SWA = 4096, C_RW = 5632, C_GATE = 9088, RWIN = 3456;
constexpr int NLR = 5120, KLR = 384;
constexpr int NQK = 1280;
constexpr int NSTEP = 2304, SCAN_BLK = 32;

constexpr size_t al256(size_t x) { return (x + 255) & ~(size_t)255; }
constexpr size_t WS_CTL = 0, CTL_ZERO_BYTES = 1u << 20;
constexpr size_t SZ_WIN = (size_t)LDP * DM * 2, SZ_WBR = (size_t)3 * DM * BW * 2, SZ_WOUT = (size_t)DM * DM * 2, SZ_WFF = (size_t)DFF * DM * 2, SZ_WLR = (size_t)NLR * KLR * 2;
constexpr size_t WS_WIN = CTL_ZERO_BYTES;
constexpr size_t WS_WBR = WS_WIN + NL * SZ_WIN;
constexpr size_t WS_WOUT = WS_WBR + NL * SZ_WBR;
constexpr size_t WS_WFF1 = WS_WOUT + NL * SZ_WOUT;
constexpr size_t WS_WFF2 = WS_WFF1 + NL * SZ_WFF;
constexpr size_t WS_WLR = WS_WFF2 + NL * SZ_WFF;
constexpr size_t WS_H = WS_WLR + NL * SZ_WLR;
constexpr size_t WS_U = WS_H + (size_t)MT * DM * 4;
constexpr size_t WS_P = WS_U + (size_t)MT * DM * 2;
constexpr size_t WS_Y = WS_P + (size_t)MT * LDP * 2;
constexpr size_t WS_MGF = WS_Y + (size_t)MT * 3072 * 2;
constexpr size_t WS_MG = WS_MGF + (size_t)MT * DM * 4;
constexpr size_t WS_F = WS_MG + (size_t)MT * DM * 2;
constexpr size_t WS_MODP = WS_F + (size_t)MT * DFF * 2;
constexpr size_t WS_MOD = WS_MODP + (size_t)8 * NL * 5 * 12288 * 4;
constexpr size_t WS_ROPE = WS_MOD + (size_t)NL * 5 * 12288 * 4;
constexpr size_t WS_XS = WS_ROPE + 64 * 32 * 2 * 4;
constexpr size_t WS_ALR = WS_XS + (size_t)MT * 3072 * 4;
constexpr size_t WS_LR = WS_ALR + (size_t)MT * KLR * 2;
constexpr size_t WS_QKR = WS_LR + (size_t)MT * NLR * 4;
constexpr size_t WS_ST = WS_QKR + (size_t)MT * NQK * 2;
constexpr size_t WS_YDR = WS_ST + (size_t)NB * 8 * 2 * 18 * 128 * 128 * 2;
constexpr size_t WS_YDW = WS_YDR + (size_t)2 * MT * BW * 4;
constexpr size_t WS_END = WS_YDW + (size_t)2 * MT * BW * 4;
constexpr int CW_BAR = 4096;
constexpr int CW_SWAQ = 16384;

constexpr int RING_BYTES = 131072, LDSCTL_OFF = RING_BYTES, MISC_OFF = LDSCTL_OFF + 320, LDS_BYTES = 147456;
constexpr int NWAVES = 8, NTHR = 512;

#define GAS __attribute__((address_space(1)))
#define LAS __attribute__((address_space(3)))
typedef unsigned short bf16;
typedef float f32x4 __attribute__((ext_vector_type(4)));
typedef float f32x2 __attribute__((ext_vector_type(2)));
typedef unsigned u32x4 __attribute__((ext_vector_type(4)));
typedef unsigned u32x2 __attribute__((ext_vector_type(2)));
#define LDS_WAIT() asm volatile("s_waitcnt lgkmcnt(0)" ::: "memory")
#define VM_WAIT() asm volatile("s_waitcnt vmcnt(0)" ::: "memory")
__device__ __forceinline__ unsigned f2bf(float f) { unsigned u = __builtin_bit_cast(unsigned, f); return (u + 0x7fffu + ((u >> 16) & 1u)) >> 16; }
__device__ __forceinline__ unsigned pk2(float lo, float hi) { return f2bf(lo) | (f2bf(hi) << 16); }
__device__ __forceinline__ float bf2f(bf16 v) { return __uint_as_float((unsigned)v << 16); }
__device__ __forceinline__ float sigm(float x) { return 1.0f / (1.0f + __expf(-x)); }
using pg8::bf_lo; using pg8::bf_hi;
__device__ __forceinline__ float shx(float v, int m, int lane) { return __int_as_float(__builtin_amdgcn_ds_bpermute((lane ^ m) << 2, __float_as_int(v))); }
__device__ __forceinline__ float wave_sum(float v, int lane) {
#pragma unroll
    for (int o = 1; o < 64; o <<= 1) v += shx(v, o, lane);
    return v;
}
__device__ __forceinline__ float wave_max(float v, int lane) {
#pragma unroll
    for (int o = 1; o < 64; o <<= 1) v = fmaxf(v, shx(v, o, lane));
    return v;
}

#define XB_TMO      128
#define XB_XCNT(j)  (256  + 64 * (j))
#define XB_XSUB(j)  (1280 + 64 * (j))
#define XB_XGEN(j)  (2304 + 64 * (j))
#define XB_TOP      3328
#define XB_TOPGEN   3392
#define XCD_BAR_WORDS 3456
#define XB_SPIN_CAP (1u << 22)
__device__ __forceinline__ unsigned xb_ld(unsigned* p)              { return __hip_atomic_load(p, __ATOMIC_RELAXED, __HIP_MEMORY_SCOPE_AGENT); }
__device__ __forceinline__ unsigned xb_add(unsigned* p, unsigned v) { return __hip_atomic_fetch_add(p, v, __ATOMIC_RELAXED, __HIP_MEMORY_SCOPE_AGENT); }
__device__ __forceinline__ unsigned xb_xcc_id() { return (unsigned)__builtin_amdgcn_s_getreg((3 << 11) | 20) & 0xFu; }
#define XB_SPIN(cond, bar) do { unsigned _sp = 0; while (cond) { __builtin_amdgcn_s_sleep(1); \
    if ((++_sp & 255u) == 0u) { if (xb_ld(&(bar)[XB_TMO])) break; if (_sp > XB_SPIN_CAP) { atomicAdd(&(bar)[XB_TMO], 1u); break; } } } } while (0)
struct XcdBarrier { unsigned* bar; unsigned x; volatile LAS unsigned* st; };
__device__ __forceinline__ XcdBarrier xcd_barrier_post(unsigned* bar, volatile LAS unsigned* st) {
    XcdBarrier b; b.bar = bar; b.x = xb_xcc_id(); b.st = st;
    if (threadIdx.x == 0) (void)xb_add(&bar[XB_XCNT(b.x)], 1u);
    return b;
}
__device__ __forceinline__ void xcd_barrier_complete(unsigned* bar, unsigned x, unsigned& nloc, unsigned& nx) {
    const unsigned G = gridDim.x * gridDim.y * gridDim.z;
    unsigned sum, cnt, mine, sp = 0u;
    for (;;) {
        sum = 0u; cnt = 0u; mine = 0u;
#pragma unroll
        for (unsigned j = 0; j < 16; ++j) { const unsigned c = xb_ld(&bar[XB_XCNT(j)]); sum += c; cnt += (c > 0u) ? 1u : 0u; mine = (j == x) ? c : mine; }
        if (sum == G) break;
        __builtin_amdgcn_s_sleep(1);
        if ((++sp & 255u) == 0u) { if (xb_ld(&bar[XB_TMO])) break; if (sp > XB_SPIN_CAP) { atomicAdd(&bar[XB_TMO], 1u); break; } }
    }
    nloc = mine > 0u ? mine : 1u; nx = cnt > 0u ? cnt : 1u;
}
__device__ __forceinline__ void xcd_barrier(const XcdBarrier& b) {
    asm volatile("s_waitcnt vmcnt(0)" ::: "memory");
    __syncthreads();
    if (threadIdx.x == 0) {
        unsigned* bar = b.bar; unsigned bx = b.x;
        asm volatile("" : "+s"(bar), "+s"(bx));
        __builtin_amdgcn_s_waitcnt(0);
        unsigned nloc = b.st[0], nx = b.st[1];
        if (nloc == 0u) { xcd_barrier_complete(bar, bx, nloc, nx); b.st[0] = nloc; b.st[1] = nx; }
        const unsigned old = xb_add(&bar[XB_XSUB(bx)], 1u);
        const unsigned gen = old / nloc;
        if (old + 1u == (gen + 1u) * nloc) {
            __builtin_amdgcn_fence(__ATOMIC_RELEASE, "agent");
            asm volatile("s_waitcnt vmcnt(0)" ::: "memory");
            const unsigned og = xb_add(&bar[XB_TOP], 1u);
            const unsigned tg = og / nx;
            if (og + 1u == (tg + 1u) * nx) xb_add(&bar[XB_TOPGEN], 1u);
            else XB_SPIN(xb_ld(&bar[XB_TOPGEN]) == tg, bar);
            __builtin_amdgcn_fence(__ATOMIC_ACQUIRE, "agent");
            xb_add(&bar[XB_XGEN(bx)], 1u);
            asm volatile("s_waitcnt vmcnt(0)" ::: "memory");
        } else {
            XB_SPIN(xb_ld(&bar[XB_XGEN(bx)]) == gen, bar);
            __builtin_amdgcn_fence(__ATOMIC_ACQUIRE, "agent");
            asm volatile("s_waitcnt vmcnt(0)" ::: "memory");
        }
    }
    __syncthreads();
}

struct Args { const float* in[26]; float* out; unsigned char* ws; int s_lo, s_hi; };
enum { I_X = 0, I_C, I_CTX, I_CCTX, I_N1G, I_N2G, I_WMOD, I_BMOD, I_WIN, I_RETDEC, I_SINK, I_MU, I_W0, I_WUP, I_A0, I_AUP, I_GUP, I_KK, I_KA, I_RK, I_LNG, I_WBR, I_WOUT, I_WFF1, I_WFF2, I_FING };
struct Frame {
    LAS unsigned char* lds;
    unsigned* ctl;
    int tid, lane, wave, G, wg;
    unsigned char* ws;
};
template <class T> __device__ __forceinline__ T* wsp(const Frame& F, size_t off) { return (T*)(F.ws + off); }
constexpr int PTAB_OFF = LDSCTL_OFF + 64;
__device__ __forceinline__ const float* inp(const Frame& F, int i) {
    const LAS unsigned* t = (const LAS unsigned*)(F.lds + PTAB_OFF) + 2 * i;
    const unsigned lo = __builtin_amdgcn_readfirstlane(t[0]), hi = __builtin_amdgcn_readfirstlane(t[1]);
    return (const float*)(((unsigned long long)hi << 32) | (unsigned long long)lo);
}

__device__ __forceinline__ int scan_row(int b, int dir, int s) {
    if (s < TCX) return ML + b * TCX + (dir ? (TCX - 1 - s) : s);
    const int t = s - TCX; return b * TL + (dir ? (TL - 1 - t) : t);
}

__device__ __forceinline__ void transpose_item(const float* W, int K, int N, bf16* WT, LAS unsigned char* scr, int item, int lane) {
    const int nblk = N / 64, kb = item / nblk, nb = item % nblk, k0 = 64 * kb, n0 = 64 * nb;
    const int kr = lane >> 4, nc = (lane & 15) * 4;
    f32x4 v[16];
#pragma unroll
    for (int i = 0; i < 16; ++i) v[i] = *(const f32x4*)(W + (size_t)(k0 + 4 * i + kr) * N + n0 + nc);
#pragma unroll
    for (int i = 0; i < 16; ++i) { LAS unsigned short* d = (LAS unsigned short*)(scr + nc * 144 + (4 * i + kr) * 2);
        d[0] = (unsigned short)f2bf(v[i].x); d[72] = (unsigned short)f2bf(v[i].y); d[144] = (unsigned short)f2bf(v[i].z); d[216] = (unsigned short)f2bf(v[i].w); }
    LDS_WAIT(); asm volatile("" ::: "memory");
    const int c = lane & 7;
#pragma unroll
    for (int j = 0; j < 8; ++j) { const int n = (lane >> 3) + 8 * j;
        *(u32x4*)(WT + (size_t)(n0 + n) * K + k0 + 8 * c) = *(const LAS u32x4*)(scr + n * 144 + 16 * c); }
    LDS_WAIT(); asm volatile("" ::: "memory");
}
__device__ __forceinline__ void p0_prologue(Frame& F) {
    const int gw = F.wg * NWAVES + F.wave, NGW = F.G * NWAVES;
    const int gt = F.wg * NTHR + F.tid, NGT = F.G * NTHR;
    LAS float* sil = (LAS float*)(F.lds + 81920);
    for (int e = F.tid; e < 5 * DM; e += NTHR) { const int r = e / DM, k = e % DM; const float v = r < 4 ? inp(F, I_C)[r * DM + k] : inp(F, I_CCTX)[k]; sil[e] = v * sigm(v); }
    {
        LAS unsigned char* scr = F.lds + F.wave * 9216;
        constexpr int IT_IN = (DM / 64) * (NIN / 64), IT_BR = (BW / 64) * (DM / 64), IT_OUT = (DM / 64) * (DM / 64), IT_F1 = (DM / 64) * (DFF / 64), IT_F2 = (DFF / 64) * (DM / 64);
        constexpr int IT_L = IT_IN + 3 * IT_BR + IT_OUT + IT_F1 + IT_F2;
        for (int it = gw; it < NL * IT_L; it += NGW) {
            const int l = it / IT_L; int r = it % IT_L;
            if (r < IT_IN) { transpose_item(inp(F, I_WIN) + (size_t)l * DM * NIN, DM, NIN, wsp<bf16>(F, WS_WIN + l * SZ_WIN), scr, r, F.lane); continue; } r -= IT_IN;
            if (r < 3 * IT_BR) { const int n = r / IT_BR; transpose_item(inp(F, I_WBR) + ((size_t)l * 3 + n) * BW * DM, BW, DM, wsp<bf16>(F, WS_WBR + l * SZ_WBR) + (size_t)n * DM * BW, scr, r % IT_BR, F.lane); continue; } r -= 3 * IT_BR;
            if (r < IT_OUT) { transpose_item(inp(F, I_WOUT) + (size_t)l * DM * DM, DM, DM, wsp<bf16>(F, WS_WOUT + l * SZ_WOUT), scr, r, F.lane); continue; } r -= IT_OUT;
            if (r < IT_F1) { transpose_item(inp(F, I_WFF1) + (size_t)l * DM * DFF, DM, DFF, wsp<bf16>(F, WS_WFF1 + l * SZ_WFF), scr, r, F.lane); continue; } r -= IT_F1;
            transpose_item(inp(F, I_WFF2) + (size_t)l * DFF * DM, DFF, DM, wsp<bf16>(F, WS_WFF2 + l * SZ_WFF), scr, r, F.lane);
        }
    }
    for (int e = gt; e < NL * (LDP - NIN) * DM / 8; e += NGT) { const int l = e / ((LDP - NIN) * DM / 8), r = e % ((LDP - NIN) * DM / 8);
        *(u32x4*)(wsp<bf16>(F, WS_WIN + l * SZ_WIN) + (size_t)NIN * DM + (size_t)r * 8) = (u32x4){0u, 0u, 0u, 0u}; }
    for (int e = gt; e < NL * NLR * KLR; e += NGT) {
        const int l = e / (NLR * KLR), r = e % (NLR * KLR), n = r / KLR, k = r % KLR; float v = 0.f;
        if (n < 2048) { const int d = n >> 10, c = n & 1023; if (k >= 64 * d && k < 64 * d + 64) v = inp(F, I_WUP)[(((size_t)l * 2 + d) * 64 + (k - 64 * d)) * BW + c]; }
        else if (n < 4096) { const int d = (n - 2048) >> 10, c = n & 1023; if (k >= 128 + 64 * d && k < 192 + 64 * d) v = inp(F, I_AUP)[(((size_t)l * 2 + d) * 64 + (k - 128 - 64 * d)) * BW + c]; }
        else { const int c = n - 4096; if (k >= 256) v = inp(F, I_GUP)[((size_t)l * 128 + (k - 256)) * BW + c]; }
        wsp<bf16>(F, WS_WLR + l * SZ_WLR)[r] = (bf16)f2bf(v);
    }
    { const f32x4* x4 = (const f32x4*)inp(F, I_X); const f32x4* c4 = (const f32x4*)inp(F, I_CTX); f32x4* h4 = wsp<f32x4>(F, WS_H);
      for (int e = gt; e < ML * DM / 4; e += NGT) h4[e] = x4[e];
      for (int e = gt; e < MC * DM / 4; e += NGT) h4[ML * DM / 4 + e] = c4[e]; }
    if (gt < 64 * 32) { const int pos = gt >> 5, i = gt & 31; const float inv = powf(10000.0f, -(float)i / 32.0f); const float ang = (float)pos * inv;
        wsp<float>(F, WS_ROPE)[2 * gt] = cosf(ang); wsp<float>(F, WS_ROPE)[2 * gt + 1] = sinf(ang); }
    __syncthreads();
    for (int it = gw; it < NL * 8 * 48; it += NGW) {
        const int l = it / (8 * 48), kc = (it / 48) % 8, cc = it % 48, col = cc * 256 + F.lane * 4, k0 = kc * 256;
        const float* wp = inp(F, I_WMOD) + ((size_t)l * DM + k0) * 12288 + col;
        f32x4 a0 = {0.f, 0.f, 0.f, 0.f}, a1 = a0, a2 = a0, a3 = a0, a4 = a0;
#pragma unroll 8
        for (int k = 0; k < 256; ++k) { const f32x4 w = *(const f32x4*)(wp + (size_t)k * 12288);
            a0 += sil[0 * DM + k0 + k] * w; a1 += sil[1 * DM + k0 + k] * w; a2 += sil[2 * DM + k0 + k] * w; a3 += sil[3 * DM + k0 + k] * w; a4 += sil[4 * DM + k0 + k] * w; }
        float* mp = wsp<float>(F, WS_MODP) + ((size_t)(kc * NL + l) * 5) * 12288 + col;
        *(f32x4*)(mp) = a0; *(f32x4*)(mp + 12288) = a1; *(f32x4*)(mp + 2 * 12288) = a2; *(f32x4*)(mp + 3 * 12288) = a3; *(f32x4*)(mp + 4 * 12288) = a4;
    }
}
__device__ __forceinline__ void p1_modreduce(Frame& F) {
    const int gt = F.wg * NTHR + F.tid, NGT = F.G * NTHR;
    for (int e = gt; e < NL * 5 * 12288; e += NGT) { const int l = e / (5 * 12288), j = e % 12288;
        float s = inp(F, I_BMOD)[l * 12288 + j];
#pragma unroll
        for (int kc = 0; kc < 8; ++kc) s += wsp<float>(F, WS_MODP)[(size_t)kc * NL * 5 * 12288 + e];
        wsp<float>(F, WS_MOD)[e] = s; }
}

__device__ __forceinline__ void norm_phase(Frame& F, int layer, int which, int nrows, bool partials) {
    const int gw = F.wg * NWAVES + F.wave, NGW = F.G * NWAVES;
    const float* gptr = inp(F, which ? I_N2G : I_N1G) + layer * DM;
    for (int row = gw; row < nrows; row += NGW) {
        const int mr = row < ML ? (row >> 11) : 4;
        const float* mod = wsp<float>(F, WS_MOD) + ((size_t)layer * 5 + mr) * 12288 + (which ? 3 * DM : 0);
        const f32x4* xr = (const f32x4*)(wsp<float>(F, WS_H) + (size_t)row * DM) + F.lane;
        f32x4 v[8]; float ss = 0.f;
#pragma unroll
        for (int j = 0; j < 8; ++j) v[j] = xr[64 * j];
        if (partials && row >= ML) {
            const f32x4* pp = (const f32x4*)(wsp<float>(F, WS_YDR) + (size_t)(row - ML) * DM) + F.lane;
#pragma unroll
            for (int s = 0; s < 8; ++s)
#pragma unroll
                for (int j = 0; j < 8; ++j) v[j] += pp[(size_t)s * 1024 * DM / 4 + 64 * j];
            f32x4* xw = (f32x4*)(wsp<float>(F, WS_H) + (size_t)row * DM) + F.lane;
#pragma unroll
            for (int j = 0; j < 8; ++j) xw[64 * j] = v[j];
        }
#pragma unroll
        for (int j = 0; j < 8; ++j) ss += (v[j].x * v[j].x + v[j].y * v[j].y) + (v[j].z * v[j].z + v[j].w * v[j].w);
        const float rs = 1.0f / sqrtf(wave_sum(ss, F.lane) * (1.0f / DM) + 1e-6f);
        u32x2* o = (u32x2*)(wsp<bf16>(F, WS_U) + (size_t)row * DM) + F.lane;
#pragma unroll
        for (int j = 0; j < 8; ++j) { const int c = 4 * F.lane + 256 * j;
            const f32x4 g = *(const f32x4*)(gptr + c), sh = *(const f32x4*)(mod + c), sc = *(const f32x4*)(mod + DM + c);
            const f32x4 y = (v[j] * rs) * g * (1.0f + sc) + sh;
            u32x2 w; w.x = pk2(y.x, y.y); w.y = pk2(y.z, y.w); o[64 * j] = w; }
    }
}
__device__ __forceinline__ void final_norm(Frame& F, float* out) {
    const int gw = F.wg * NWAVES + F.wave, NGW = F.G * NWAVES;
    for (int row = gw; row < ML; row += NGW) {
        const f32x4* xr = (const f32x4*)(wsp<float>(F, WS_H) + (size_t)row * DM) + F.lane;
        f32x4 v[8]; float ss = 0.f;
#pragma unroll
        for (int j = 0; j < 8; ++j) { v[j] = xr[64 * j]; ss += (v[j].x * v[j].x + v[j].y * v[j].y) + (v[j].z * v[j].z + v[j].w * v[j].w); }
        const float rs = 1.0f / sqrtf(wave_sum(ss, F.lane) * (1.0f / DM) + 1e-6f);
        f32x4* o = (f32x4*)(out + (size_t)row * DM) + F.lane;
#pragma unroll
        for (int j = 0; j < 8; ++j) { const f32x4 g = *(const f32x4*)(inp(F, I_FING) + 4 * F.lane + 256 * j); o[64 * j] = (v[j] * rs) * g; }
    }
}
__device__ __forceinline__ void prep_phase(Frame& F, int layer) {
    const int gw = F.wg * NWAVES + F.wave, NGW = F.G * NWAVES;
    const bf16* P = wsp<bf16>(F, WS_P);
    const float* mu0 = inp(F, I_MU) + (size_t)layer * 2 * RWIN; const float* mu1 = mu0 + RWIN;
    const float* rope = wsp<float>(F, WS_ROPE);
    for (int row = gw; row < MT; row += NGW) {
        bool first, last; int t = 0;
        if (row < ML) { t = row & (TL - 1); first = t == 0; last = t == TL - 1; } else { const int c = (row - ML) & (TCX - 1); first = c == 0; last = c == TCX - 1; }
        const bf16* pr = P + (size_t)row * LDP + C_RW;
        float* xs = wsp<float>(F, WS_XS) + (size_t)row * 3072; bf16* alr = wsp<bf16>(F, WS_ALR) + (size_t)row * KLR;
        for (int j8 = F.lane; j8 < RWIN / 8; j8 += 64) {
            const int c = 8 * j8;
            const u32x4 pw = *(const u32x4*)(pr + c);
            const u32x4 vw = first ? (u32x4){0u, 0u, 0u, 0u} : *(const u32x4*)(pr - LDP + c);
            const u32x4 nw = last ? (u32x4){0u, 0u, 0u, 0u} : *(const u32x4*)(pr + LDP + c);
            const f32x4 ma = *(const f32x4*)(mu0 + c), mb = *(const f32x4*)(mu0 + c + 4), na = *(const f32x4*)(mu1 + c), nb = *(const f32x4*)(mu1 + c + 4);
            float s[8];
#pragma unroll
            for (int e = 0; e < 4; ++e) { const float p0 = bf_lo(pw[e]), p1 = bf_hi(pw[e]), v0 = bf_lo(vw[e]), v1 = bf_hi(vw[e]), n0 = bf_lo(nw[e]), n1 = bf_hi(nw[e]);
                const float m0 = e < 2 ? ma[2 * e] : mb[2 * e - 4], m1 = e < 2 ? ma[2 * e + 1] : mb[2 * e - 3], q0 = e < 2 ? na[2 * e] : nb[2 * e - 4], q1 = e < 2 ? na[2 * e + 1] : nb[2 * e - 3];
                s[2 * e] = p0 + m0 * (v0 - p0) + q0 * (n0 - p0); s[2 * e + 1] = p1 + m1 * (v1 - p1) + q1 * (n1 - p1); }
            if (c < 3072) { *(f32x4*)(xs + c) = (f32x4){s[0], s[1], s[2], s[3]}; *(f32x4*)(xs + c + 4) = (f32x4){s[4], s[5], s[6], s[7]}; }
            else { u32x4 o; int dst;
                if (c < 3200) { dst = c - 3072; o.x = pk2(tanhf(s[0]), tanhf(s[1])); o.y = pk2(tanhf(s[2]), tanhf(s[3])); o.z = pk2(tanhf(s[4]), tanhf(s[5])); o.w = pk2(tanhf(s[6]), tanhf(s[7])); }
                else if (c < 3328) { dst = 128 + c - 3200; o.x = pk2(s[0], s[1]); o.y = pk2(s[2], s[3]); o.z = pk2(s[4], s[5]); o.w = pk2(s[6], s[7]); }
                else { dst = 256 + c - 3328; o.x = pk2(sigm(s[0]), sigm(s[1])); o.y = pk2(sigm(s[2]), sigm(s[3])); o.z = pk2(sigm(s[4]), sigm(s[5])); o.w = pk2(sigm(s[6]), sigm(s[7])); }
                *(u32x4*)(alr + dst) = o; }
        }
        const bf16* ps = P + (size_t)row * LDP + C_SWA; bf16* qk = wsp<bf16>(F, WS_QKR) + (size_t)row * NQK;
        const bool lat = row < ML; const int rr = t >> 6, cc = t & 63;
#pragma unroll
        for (int it = 0; it < 5; ++it) { const int idx = it * 64 + F.lane, hd = idx >> 5, i = idx & 31;
            const float x1r = bf2f(ps[hd * 128 + i]), x2r = bf2f(ps[hd * 128 + 32 + i]), x1c = bf2f(ps[hd * 128 + 64 + i]), x2c = bf2f(ps[hd * 128 + 96 + i]);
            float cr = 1.f, sr = 0.f, ccs = 1.f, scs = 0.f;
            if (lat) { cr = rope[(rr * 32 + i) * 2]; sr = rope[(rr * 32 + i) * 2 + 1]; ccs = rope[(cc * 32 + i) * 2]; scs = rope[(cc * 32 + i) * 2 + 1]; }
            qk[hd * 128 + i] = (bf16)f2bf(x1r * cr - x2r * sr); qk[hd * 128 + 32 + i] = (bf16)f2bf(x2r * cr + x1r * sr);
            qk[hd * 128 + 64 + i] = (bf16)f2bf(x1c * ccs - x2c * scs); qk[hd * 128 + 96 + i] = (bf16)f2bf(x2c * ccs + x1c * scs); }
    }
}

__device__ __forceinline__ float red8(float v) {
    v += __int_as_float(__builtin_amdgcn_update_dpp(0, __float_as_int(v), 0xB1, 0xF, 0xF, true));
    v += __int_as_float(__builtin_amdgcn_update_dpp(0, __float_as_int(v), 0x4E, 0xF, 0xF, true));
    v += __int_as_float(__builtin_amdgcn_update_dpp(0, __float_as_int(v), 0x141, 0xF, 0xF, true));
    return v;
}
__device__ __forceinline__ float red16(float v) {
    v += __int_as_float(__builtin_amdgcn_update_dpp(0, __float_as_int(v), 0xB1, 0xF, 0xF, true));
    v += __int_as_float(__builtin_amdgcn_update_dpp(0, __float_as_int(v), 0x4E, 0xF, 0xF, true));
    v += __int_as_float(__builtin_amdgcn_update_dpp(0, __float_as_int(v), 0x141, 0xF, 0xF, true));
    v += __int_as_float(__builtin_amdgcn_update_dpp(0, __float_as_int(v), 0x140, 0xF, 0xF, true));
    return v;
}
struct RwPre { f32x4 r4, k4, v4, lw, la; };
__device__ __forceinline__ void rwkv_scan_unit(Frame& F, int layer, int unit) {
    const int rh = unit & 1, dir = (unit >> 1) & 1, h = (unit >> 2) & 15, b = unit >> 6;
    constexpr int BUF = 6 * 2048 + 1024;
    LAS float* const base = (LAS float*)F.lds;
    const float* XS = wsp<float>(F, WS_XS); const float* LR = wsp<float>(F, WS_LR); float* YD = wsp<float>(F, WS_YDW) + (size_t)dir * MT * BW;
    const int vrow = F.tid >> 4, kq = F.tid & 15;
    const int ptok = F.tid >> 4, pj = (F.tid & 15) * 4, pc = h * 64 + pj;
    const f32x4 w0v = *(const f32x4*)(inp(F, I_W0) + ((size_t)layer * 2 + dir) * BW + pc), a0v = *(const f32x4*)(inp(F, I_A0) + ((size_t)layer * 2 + dir) * BW + pc);
    const f32x4 kkv = *(const f32x4*)(inp(F, I_KK) + (size_t)layer * BW + pc), kav = *(const f32x4*)(inp(F, I_KA) + (size_t)layer * BW + pc);
    auto fetch = [&](int blk, RwPre& p) {
        const int row = scan_row(b, dir, blk * SCAN_BLK + ptok);
        p.r4 = *(const f32x4*)(XS + (size_t)row * 3072 + pc); p.k4 = *(const f32x4*)(XS + (size_t)row * 3072 + 1024 + pc); p.v4 = *(const f32x4*)(XS + (size_t)row * 3072 + 2048 + pc);
        p.lw = *(const f32x4*)(LR + (size_t)row * NLR + dir * 1024 + pc); p.la = *(const f32x4*)(LR + (size_t)row * NLR + 2048 + dir * 1024 + pc);
    };
    auto derive = [&](const RwPre& p, LAS float* buf) {
        f32x4 dec, av, kk, kd; float ssq = 0.f;
#pragma unroll
        for (int e = 0; e < 4; ++e) { dec[e] = __expf(-0.6065306597126334f * sigm(w0v[e] + p.lw[e])); av[e] = sigm(a0v[e] + p.la[e]); kk[e] = p.k4[e] * kkv[e]; ssq += kk[e] * kk[e];
            kd[e] = p.k4[e] * (1.0f + (av[e] - 1.0f) * kav[e]); }
        ssq += __int_as_float(__builtin_amdgcn_update_dpp(0, __float_as_int(ssq), 0xB1, 0xF, 0xF, true));
        ssq += __int_as_float(__builtin_amdgcn_update_dpp(0, __float_as_int(ssq), 0x4E, 0xF, 0xF, true));
        ssq += __int_as_float(__builtin_amdgcn_update_dpp(0, __float_as_int(ssq), 0x141, 0xF, 0xF, true));
        ssq += __int_as_float(__builtin_amdgcn_update_dpp(0, __float_as_int(ssq), 0x140, 0xF, 0xF, true));
        const float inv = 1.0f / fmaxf(sqrtf(ssq), 1e-12f);
        f32x4 an, bn;
#pragma unroll
        for (int e = 0; e < 4; ++e) { const float kn = kk[e] * inv; an[e] = -kn; bn[e] = kn * av[e]; }
        const int o = ptok * 64 + pj;
        *(LAS f32x4*)(buf + o) = p.r4; *(LAS f32x4*)(buf + 2048 + o) = dec; *(LAS f32x4*)(buf + 4096 + o) = kd; *(LAS f32x4*)(buf + 6144 + o) = p.v4; *(LAS f32x4*)(buf + 8192 + o) = an; *(LAS f32x4*)(buf + 10240 + o) = bn;
    };
    f32x2 S0 = {0.f, 0.f}, S1 = S0;
    RwPre pre;
    __syncthreads();
    fetch(0, pre); derive(pre, base);
    __syncthreads();
    constexpr int NBLK = NSTEP / SCAN_BLK;
    for (int blk = 0; blk < NBLK; ++blk) {
        LAS float* cur = base + (blk & 1) * BUF; LAS float* nxt = base + ((blk + 1) & 1) * BUF;
        if (blk + 1 < NBLK) fetch(blk + 1, pre);
        const LAS float* Rl = cur; const LAS float* Wl = cur + 2048; const LAS float* Kl = cur + 4096; const LAS float* Vl = cur + 6144; const LAS float* Al = cur + 8192; const LAS float* Bl = cur + 10240; LAS float* Yl = cur + 12288;
        const int ob = 4 * kq, vb = 32 * rh + vrow;
        f32x4 a0 = *(const LAS f32x4*)(Al + ob), w0 = *(const LAS f32x4*)(Wl + ob), b0 = *(const LAS f32x4*)(Bl + ob), k0 = *(const LAS f32x4*)(Kl + ob), r0 = *(const LAS f32x4*)(Rl + ob);
        float vv = Vl[vb];
#pragma unroll 8
        for (int tok = 0; tok < SCAN_BLK; ++tok) {
            const int on = ((tok + 1) & (SCAN_BLK - 1)) * 64;
            const f32x4 a1 = *(const LAS f32x4*)(Al + on + ob), w1 = *(const LAS f32x4*)(Wl + on + ob), b1 = *(const LAS f32x4*)(Bl + on + ob), k1 = *(const LAS f32x4*)(Kl + on + ob), r1 = *(const LAS f32x4*)(Rl + on + ob);
            const float vn = Vl[on + vb];
            f32x2 t = S0 * a0.xy; t += S1 * a0.zw;
            const float sa = red16(t.x + t.y);
            const f32x2 sa2 = {sa, sa}, vv2 = {vv, vv};
            S0 = S0 * w0.xy + (sa2 * b0.xy + vv2 * k0.xy); S1 = S1 * w0.zw + (sa2 * b0.zw + vv2 * k0.zw);
            f32x2 u = S0 * r0.xy; u += S1 * r0.zw;
            const float y = red16(u.x + u.y);
            Yl[tok * 32 + vrow] = y;
            a0 = a1; w0 = w1; b0 = b1; k0 = k1; r0 = r1; vv = vn;
        }
        if (blk + 1 < NBLK) derive(pre, nxt);
        __syncthreads();
        if (F.tid < 256) { const int e = F.tid * 4, tok = e >> 5, j = e & 31; const int row = scan_row(b, dir, blk * SCAN_BLK + tok);
          *(f32x4*)(YD + (size_t)row * BW + h * 64 + 32 * rh + j) = *(const LAS f32x4*)(Yl + e); }
    }
    __syncthreads();
}
typedef short bf16x8 __attribute__((ext_vector_type(8)));
typedef short s16x4 __attribute__((ext_vector_type(4)));
typedef float f32x16 __attribute__((ext_vector_type(16)));
typedef __bf16 bf16x2_t __attribute__((ext_vector_type(2)));
#define MFMA32(a, b, c) __builtin_amdgcn_mfma_f32_32x32x16_bf16((a), (b), (c), 0, 0, 0)
__device__ __forceinline__ int crow(int reg, int h) { return (reg & 3) + 8 * (reg >> 2) + 4 * h; }
__device__ __forceinline__ unsigned cvtpk(float lo, float hi) { f32x2 v = {lo, hi}; bf16x2_t b = __builtin_convertvector(v, bf16x2_t); return __builtin_bit_cast(unsigned, b); }
__device__ __forceinline__ s16x4 tr16(const LAS unsigned char* p) { return __builtin_bit_cast(s16x4, __builtin_amdgcn_ds_read_tr16_b64_v4i16((LAS s16x4*)p)); }
__device__ __forceinline__ bf16x8 frag_rm(const LAS unsigned char* base, int pitch, int r0, int k0, int lane) {
    return *(const LAS bf16x8*)(base + (r0 + (lane & 31)) * pitch + (k0 + 8 * (lane >> 5)) * 2);
}
template <bool PERM> __device__ __forceinline__ bf16x8 frag_tr(const LAS unsigned char* base, int pitch, int k0, int r0, int lane) {
    const int g = lane >> 4, i = lane & 15, q = i >> 2, p = i & 3, h = g >> 1;
    const LAS unsigned char* a = base + (k0 + (PERM ? 4 : 8) * h + q) * pitch + (r0 + 16 * (g & 1) + 4 * p) * 2;
    const s16x4 lo = tr16(a), hi = tr16(a + (PERM ? 8 : 4) * pitch);
    return __builtin_shufflevector(lo, hi, 0, 1, 2, 3, 4, 5, 6, 7);
}
__device__ __forceinline__ bf16x8 pack_step(const f32x16& x, int s) {
    u32x4 p; p.x = cvtpk(x[8 * s + 0], x[8 * s + 1]); p.y = cvtpk(x[8 * s + 2], x[8 * s + 3]); p.z = cvtpk(x[8 * s + 4], x[8 * s + 5]); p.w = cvtpk(x[8 * s + 6], x[8 * s + 7]);
    return __builtin_bit_cast(bf16x8, p);
}
__device__ __forceinline__ f32x16 zero16() { f32x16 z; for (int i = 0; i < 16; ++i) z[i] = 0.f; return z; }
constexpr int TP = 272;
constexpr int TILE_B = 128 * TP;
__device__ __forceinline__ void load_tile128(LAS unsigned char* dst, const bf16* src, size_t ld, int tid) {
#pragma unroll
    for (int it = 0; it < 4; ++it) { const int idx = tid + NTHR * it, row = idx >> 4, ch = idx & 15;
        *(LAS u32x4*)(dst + row * TP + ch * 16) = *(const u32x4*)(src + (size_t)row * ld + ch * 8); }
}

__device__ __forceinline__ void swa_unit(Frame& F, int layer, int unit) {
    const bf16* QK = wsp<bf16>(F, WS_QKR); const bf16* P = wsp<bf16>(F, WS_P);
    LAS unsigned char* Qt = F.lds; LAS unsigned char* Kt = F.lds + TILE_B; LAS unsigned char* Vt = F.lds + 2 * TILE_B;
    LAS float* stat = (LAS float*)(F.lds + 3 * TILE_B) + F.wave * 32;
    const int lane = F.lane, h = lane >> 5, wi = F.wave & 3, wh = F.wave >> 2;
    int b, qh, n, qrow0; bool isctx;
    if (unit < 512) { b = unit >> 7; qh = (unit >> 4) & 7; n = unit & 15; qrow0 = b * TL + n * 128; isctx = false; }
    else { const int u = unit - 512; b = u >> 4; qh = (u >> 1) & 7; n = u & 1; qrow0 = ML + b * TCX + n * 128; isctx = true; }
    const int kvh = qh >> 2;
    __syncthreads();
    load_tile128(Qt, QK + (size_t)qrow0 * NQK + qh * 128, NQK, F.tid);
    __syncthreads();
    bf16x8 qf[8];
#pragma unroll
    for (int ks = 0; ks < 8; ++ks) qf[ks] = frag_rm(Qt, TP, 32 * wi, 16 * ks, lane);
    const float L2E = 1.4426950408889634f, SC = 0.08838834764831845f * L2E;
    float m = inp(F, I_SINK)[layer * 8 + qh] * L2E, l = h == 0 ? 1.0f : 0.0f;
    f32x16 O0 = zero16(), O1 = zero16();
    const int iq = 32 * wi + (lane & 31);
    const int nch = isctx ? 2 : 5;
    for (int c = 0; c < nch; ++c) {
        int krow0, mtype = 0;
        if (isctx) krow0 = ML + b * TCX + c * 128;
        else if (c < 3) { const int kb = n - 1 + c; if (kb < 0 || kb > 15) continue; krow0 = b * TL + kb * 128; mtype = c == 0 ? 1 : (c == 2 ? 2 : 0); }
        else krow0 = ML + b * TCX + (c - 3) * 128;
        __syncthreads();
        load_tile128(Kt, QK + (size_t)krow0 * NQK + 1024 + kvh * 128, NQK, F.tid);
        load_tile128(Vt, P + (size_t)krow0 * LDP + C_SWA + 1280 + kvh * 128, LDP, F.tid);
        __syncthreads();
        for (int kb = 0; kb < 4; ++kb) {
            f32x16 X = zero16();
#pragma unroll
            for (int ks = 0; ks < 8; ++ks) X = MFMA32(frag_rm(Kt, TP, 32 * kb, 16 * ks, lane), qf[ks], X);
            float bm = -INFINITY;
            int iql = iq - 32 * kb; asm volatile("" : "+v"(iql));
#pragma unroll
            for (int r = 0; r < 16; ++r) { const int d = iql - crow(r, h); float s = X[r] * SC;
                const bool ok = mtype == 0 || (mtype == 1 ? d <= 0 : d >= 0);
                s = ok ? s : -INFINITY; X[r] = s; bm = fmaxf(bm, s); }
            bm = fmaxf(bm, shx(bm, 32, lane));
            const float mn = fmaxf(m, bm), sc = __builtin_amdgcn_exp2f(m - mn); m = mn;
            float ps = 0.f;
#pragma unroll
            for (int r = 0; r < 16; ++r) { const float p = __builtin_amdgcn_exp2f(X[r] - mn); X[r] = p; ps += p; }
            l = l * sc + ps;
            const bf16x8 pa0 = pack_step(X, 0), pa1 = pack_step(X, 1);
            if (h == 0) stat[lane] = sc;
            LDS_WAIT();
#pragma unroll
            for (int g = 0; g < 4; ++g) { const f32x4 sv = *(const LAS f32x4*)(stat + 8 * g + 4 * h);
#pragma unroll
                for (int e = 0; e < 4; ++e) { O0[4 * g + e] *= sv[e]; O1[4 * g + e] *= sv[e]; } }
            O0 = MFMA32(pa0, frag_tr<true>(Vt, TP, 32 * kb, 64 * wh, lane), O0);
            O0 = MFMA32(pa1, frag_tr<true>(Vt, TP, 32 * kb + 16, 64 * wh, lane), O0);
            O1 = MFMA32(pa0, frag_tr<true>(Vt, TP, 32 * kb, 64 * wh + 32, lane), O1);
            O1 = MFMA32(pa1, frag_tr<true>(Vt, TP, 32 * kb + 16, 64 * wh + 32, lane), O1);
        }
    }
    l += shx(l, 32, lane);
    if (h == 0) stat[lane] = 1.0f / l;
    LDS_WAIT();
    bf16* yo = wsp<bf16>(F, WS_Y) + (size_t)(qrow0 + 32 * wi) * 3072 + 1024 + qh * 128 + 64 * wh + (lane & 31);
#pragma unroll
    for (int g = 0; g < 4; ++g) { const f32x4 sv = *(const LAS f32x4*)(stat + 8 * g + 4 * h);
#pragma unroll
        for (int e = 0; e < 4; ++e) { const int r = 8 * g + 4 * h + e; yo[(size_t)r * 3072] = (bf16)f2bf(O0[4 * g + e] * sv[e]); yo[(size_t)r * 3072 + 32] = (bf16)f2bf(O1[4 * g + e] * sv[e]); } }
}

constexpr size_t ST_CHUNK = (size_t)128 * 128;
__device__ __forceinline__ int ret_chunk_row0(int b, int jF) { return jF < 2 ? ML + b * TCX + jF * 128 : b * TL + (jF - 2) * 128; }
__device__ __forceinline__ void ret_state_unit(Frame& F, int layer, int unit) {
    const int dvq = unit & 3, dir = (unit >> 2) & 1, hh = (unit >> 3) & 7, b = unit >> 6;
    const bf16* P = wsp<bf16>(F, WS_P);
    bf16* ST = wsp<bf16>(F, WS_ST) + ((size_t)((b * 8 + hh) * 2 + dir) * 18) * ST_CHUNK;
    const float gam = sigm(inp(F, I_RETDEC)[(layer * 2 + dir) * 8 + hh]); const float lg2 = __builtin_amdgcn_logf(gam);
    const float gC = __builtin_amdgcn_exp2f(lg2 * 128.0f);
    LAS unsigned char* Kt = F.lds; LAS unsigned char* Vt = F.lds + TILE_B;
    constexpr int VP = 80;
    const int lane = F.lane, h = lane >> 5, w = F.wave;
    f32x16 acc = zero16();
    u32x4 pk[4], pv;
    auto fetch = [&](int c) {
        const int jF = dir == 0 ? c : (c < 2 ? 1 - c : 19 - c); const int row0 = ret_chunk_row0(b, jF);
#pragma unroll
        for (int it = 0; it < 4; ++it) { const int idx = F.tid + NTHR * it, tp = idx >> 4, ch = idx & 15; const int row = row0 + (dir ? 127 - tp : tp);
            pk[it] = *(const u32x4*)(P + (size_t)row * LDP + C_RET + 1024 + hh * 128 + ch * 8); }
        { const int tp = F.tid >> 2, ch = F.tid & 3; const int row = row0 + (dir ? 127 - tp : tp);
          pv = *(const u32x4*)(P + (size_t)row * LDP + C_RET + 2048 + hh * 128 + dvq * 32 + ch * 8); }
    };
    fetch(0);
    for (int c = 0; c < 18; ++c) {
        const int jF = dir == 0 ? c : (c < 2 ? 1 - c : 19 - c);
        __syncthreads();
#pragma unroll
        for (int it = 0; it < 4; ++it) { const int idx = F.tid + NTHR * it, tp = idx >> 4, ch = idx & 15; *(LAS u32x4*)(Kt + tp * TP + ch * 16) = pk[it]; }
        { const int tp = F.tid >> 2, ch = F.tid & 3; *(LAS u32x4*)(Vt + tp * VP + ch * 16) = pv; }
        __syncthreads();
        if (c + 1 < 18) fetch(c + 1);
        if (w < 4) {
            int hl = h; asm volatile("" : "+v"(hl));
            bf16* so = ST + (size_t)jF * ST_CHUNK + (size_t)(dvq * 32) * 128 + 32 * w + (lane & 31);
#pragma unroll
            for (int r = 0; r < 16; ++r) so[(size_t)crow(r, h) * 128] = (bf16)f2bf(acc[r]);
#pragma unroll
            for (int r = 0; r < 16; ++r) acc[r] *= gC;
#pragma unroll
            for (int ks = 0; ks < 8; ++ks) {
                bf16x8 a = frag_tr<false>(Vt, VP, 16 * ks, 0, lane);
                u32x4 aw = __builtin_bit_cast(u32x4, a); u32x4 ow;
#pragma unroll
                for (int e = 0; e < 4; ++e) { const int t0 = 16 * ks + 8 * hl + 2 * e;
                    const float f0 = __builtin_amdgcn_exp2f(lg2 * (float)(127 - t0)) * 0.08838834764831845f, f1 = __builtin_amdgcn_exp2f(lg2 * (float)(126 - t0)) * 0.08838834764831845f;
                    ow[e] = cvtpk(bf_lo(aw[e]) * f0, bf_hi(aw[e]) * f1); }
                acc = MFMA32(__builtin_bit_cast(bf16x8, ow), frag_tr<false>(Kt, TP, 16 * ks, 32 * w, lane), acc);
            }
        }
    }
    __syncthreads();
}
__device__ __forceinline__ void ret_out_unit(Frame& F, int layer, int unit) {
    const int jF = unit % 18, hh = (unit / 18) & 7, b = unit / 144;
    const bf16* P = wsp<bf16>(F, WS_P);
    const int row0 = ret_chunk_row0(b, jF);
    LAS unsigned char* Qt = F.lds; LAS unsigned char* Kt = F.lds + TILE_B; LAS unsigned char* Vt = F.lds + 2 * TILE_B;
    const int lane = F.lane, h = lane >> 5, wi = F.wave & 3, wh = F.wave >> 2;
    const float lgf = __builtin_amdgcn_logf(sigm(inp(F, I_RETDEC)[(layer * 2 + 0) * 8 + hh])), lgb = __builtin_amdgcn_logf(sigm(inp(F, I_RETDEC)[(layer * 2 + 1) * 8 + hh]));
    __syncthreads();
    load_tile128(Qt, P + (size_t)row0 * LDP + C_RET + hh * 128, LDP, F.tid);
    load_tile128(Kt, P + (size_t)row0 * LDP + C_RET + 1024 + hh * 128, LDP, F.tid);
    load_tile128(Vt, P + (size_t)row0 * LDP + C_RET + 2048 + hh * 128, LDP, F.tid);
    __syncthreads();
    f32x16 Y0 = zero16(), Y1 = zero16();
    const int iq = 32 * wi + (lane & 31);
    for (int jb = 0; jb < 4; ++jb) {
        f32x16 X = zero16();
#pragma unroll
        for (int ks = 0; ks < 8; ++ks) X = MFMA32(frag_rm(Kt, TP, 32 * jb, 16 * ks, lane), frag_rm(Qt, TP, 32 * wi, 16 * ks, lane), X);
        int iql = iq - 32 * jb; asm volatile("" : "+v"(iql));
#pragma unroll
        for (int r = 0; r < 16; ++r) { const int d = iql - crow(r, h); const int ad = d < 0 ? -d : d;
            const float wgt = __builtin_amdgcn_exp2f((d > 0 ? lgf : lgb) * (float)ad) * (d == 0 ? 2.0f : 1.0f);
            X[r] *= wgt * 0.08838834764831845f; }
        const bf16x8 pa0 = pack_step(X, 0), pa1 = pack_step(X, 1);
        Y0 = MFMA32(pa0, frag_tr<true>(Vt, TP, 32 * jb, 64 * wh, lane), Y0);
        Y0 = MFMA32(pa1, frag_tr<true>(Vt, TP, 32 * jb + 16, 64 * wh, lane), Y0);
        Y1 = MFMA32(pa0, frag_tr<true>(Vt, TP, 32 * jb, 64 * wh + 32, lane), Y1);
        Y1 = MFMA32(pa1, frag_tr<true>(Vt, TP, 32 * jb + 16, 64 * wh + 32, lane), Y1);
    }
    __syncthreads();
    { const bf16* Sf = wsp<bf16>(F, WS_ST) + ((size_t)((b * 8 + hh) * 2 + 0) * 18 + jF) * ST_CHUNK; const bf16* Sb = wsp<bf16>(F, WS_ST) + ((size_t)((b * 8 + hh) * 2 + 1) * 18 + jF) * ST_CHUNK;
      load_tile128(Kt, Sf, 128, F.tid); load_tile128(Vt, Sb, 128, F.tid); }
    __syncthreads();
    {
        f32x16 T0 = zero16(), T1 = zero16(), U0 = zero16(), U1 = zero16();
#pragma unroll
        for (int ks = 0; ks < 8; ++ks) { const bf16x8 a = frag_rm(Qt, TP, 32 * wi, 16 * ks, lane);
            T0 = MFMA32(a, frag_rm(Kt, TP, 64 * wh, 16 * ks, lane), T0); T1 = MFMA32(a, frag_rm(Kt, TP, 64 * wh + 32, 16 * ks, lane), T1);
            U0 = MFMA32(a, frag_rm(Vt, TP, 64 * wh, 16 * ks, lane), U0); U1 = MFMA32(a, frag_rm(Vt, TP, 64 * wh + 32, 16 * ks, lane), U1); }
#pragma unroll
        for (int r = 0; r < 16; ++r) { const int i = 32 * wi + crow(r, h);
            const float ff = __builtin_amdgcn_exp2f(lgf * (float)(i + 1)), fb = __builtin_amdgcn_exp2f(lgb * (float)(128 - i));
            Y0[r] += ff * T0[r] + fb * U0[r]; Y1[r] += ff * T1[r] + fb * U1[r]; }
    }
    __syncthreads();
    LAS float* yl = (LAS float*)F.lds;
#pragma unroll
    for (int r = 0; r < 16; ++r) { const int i = 32 * wi + crow(r, h); yl[i * 132 + 64 * wh + (lane & 31)] = Y0[r]; yl[i * 132 + 64 * wh + 32 + (lane & 31)] = Y1[r]; }
    __syncthreads();
    { const int i = F.tid >> 2, part = F.tid & 3; const LAS float* yr = yl + i * 132 + 32 * part;
      f32x4 v[8]; float s = 0.f;
#pragma unroll
      for (int e = 0; e < 8; ++e) { v[e] = *(const LAS f32x4*)(yr + 4 * e); s += (v[e].x + v[e].y) + (v[e].z + v[e].w); }
      s += shx(s, 1, lane); s += shx(s, 2, lane); const float mean = s * (1.0f / 128.0f); float q = 0.f;
#pragma unroll
      for (int e = 0; e < 8; ++e) { v[e] = v[e] - mean; q += (v[e].x * v[e].x + v[e].y * v[e].y) + (v[e].z * v[e].z + v[e].w * v[e].w); }
      q += shx(q, 1, lane); q += shx(q, 2, lane); const float rs = 1.0f / sqrtf(q * (1.0f / 128.0f) + 1e-5f);
      const bf16* gp = P + (size_t)(row0 + i) * LDP + C_RET + 3072 + hh * 128 + 32 * part; bf16* yo = wsp<bf16>(F, WS_Y) + (size_t)(row0 + i) * 3072 + hh * 128 + 32 * part;
#pragma unroll
      for (int e2 = 0; e2 < 4; ++e2) { const u32x4 gw = *(const u32x4*)(gp + 8 * e2); u32x4 ow;
#pragma unroll
          for (int e = 0; e < 4; ++e) { const float g0 = bf_lo(gw[e]), g1 = bf_hi(gw[e]); const int vi = 2 * e2 + (e >> 1), vo = 2 * (e & 1);
              ow[e] = cvtpk(g0 * sigm(g0) * v[vi][vo] * rs, g1 * sigm(g1) * v[vi][vo + 1] * rs); }
          *(u32x4*)(yo + 8 * e2) = ow; } }
}

__device__ __forceinline__ void mix_phase(Frame& F, int layer, int qidx, int mode = 3) {
    if (mode & 1) for (int u = F.wg; u < 256; u += F.G) rwkv_scan_unit(F, layer, u);
    if (!(mode & 2)) return;
    const int nswa = (layer == NL - 1) ? 512 : 576;
    const int nitem = 256 + nswa;
    volatile LAS int* qslot = (volatile LAS int*)(F.lds + LDSCTL_OFF);
    for (;;) {
        __syncthreads();
        if (F.tid == 0) qslot[0] = (int)__hip_atomic_fetch_add(F.ctl + CW_SWAQ + 64 * qidx, 1u, __ATOMIC_RELAXED, __HIP_MEMORY_SCOPE_AGENT);
        __syncthreads();
        const int item = qslot[0];
        if (item >= nitem) break;
        if (item < 256) ret_state_unit(F, layer, item); else swa_unit(F, layer, item - 256);
    }
}
__device__ __forceinline__ void mixfin_phase(Frame& F, int layer, int nrows) {
    for (int u = F.wg; u < 576; u += F.G) { if (layer == NL - 1 && (u % 18) < 2) continue; ret_out_unit(F, layer, u); }
    __syncthreads();
    const int gw = F.wg * NWAVES + F.wave, NGW = F.G * NWAVES; const int lane = F.lane;
    const bf16* P = wsp<bf16>(F, WS_P); const float* XS = wsp<float>(F, WS_XS); const float* LR = wsp<float>(F, WS_LR);
    const float* Z0 = wsp<float>(F, WS_YDW); const float* Z1 = Z0 + (size_t)MT * BW;
    for (int row = gw; row < nrows; row += NGW) {
        bf16* yo = wsp<bf16>(F, WS_Y) + (size_t)row * 3072;
#pragma unroll
        for (int it = 0; it < 4; ++it) { const int c = (4 * it + (lane >> 4)) * 64 + (lane & 15) * 4; const size_t o = (size_t)row * BW + c;
            const f32x4 y = *(const f32x4*)(Z0 + o) + *(const f32x4*)(Z1 + o);
            const f32x4 r = *(const f32x4*)(XS + (size_t)row * 3072 + c), k = *(const f32x4*)(XS + (size_t)row * 3072 + 1024 + c), v = *(const f32x4*)(XS + (size_t)row * 3072 + 2048 + c);
            const f32x4 ka = *(const f32x4*)(inp(F, I_KA) + layer * BW + c), rk = *(const f32x4*)(inp(F, I_RK) + layer * BW + c), lng = *(const f32x4*)(inp(F, I_LNG) + layer * BW + c);
            const f32x4 a0p = *(const f32x4*)(inp(F, I_A0) + ((size_t)layer * 2 + 0) * BW + c) + *(const f32x4*)(LR + (size_t)row * NLR + 2048 + c);
            const f32x4 a1p = *(const f32x4*)(inp(F, I_A0) + ((size_t)layer * 2 + 1) * BW + c) + *(const f32x4*)(LR + (size_t)row * NLR + 3072 + c);
            const f32x4 g = *(const f32x4*)(LR + (size_t)row * NLR + 4096 + c);
            const float mean = red16((y.x + y.y) + (y.z + y.w)) * (1.0f / 64.0f); const f32x4 d = y - mean;
            const float var = red16((d.x * d.x + d.y * d.y) + (d.z * d.z + d.w * d.w)) * (1.0f / 64.0f); const float rs = 1.0f / sqrtf(var + 64e-5f);
            float dp = 0.f;
#pragma unroll
            for (int e = 0; e < 4; ++e) { const float a0 = sigm(a0p[e]), a1 = sigm(a1p[e]); dp += r[e] * (k[e] * (2.0f + (a0 + a1 - 2.0f) * ka[e])) * rk[e]; }
            const float dot = red16(dp);
            const f32x4 ov = (d * rs * lng + dot * v) * g;
            u32x2 w; w.x = pk2(ov.x, ov.y); w.y = pk2(ov.z, ov.w); *(u32x2*)(yo + 2048 + c) = w; }
    }
}

constexpr int NPH = 11;
constexpr int NSTEPS = 2 + NL * NPH + 1;
__global__ void __launch_bounds__(NTHR, 2) hyb_fwd(Args args) {
    extern __shared__ __attribute__((aligned(16))) unsigned char lds[];
    Frame F;
    F.lds = (LAS unsigned char*)lds;
    F.tid = threadIdx.x; F.lane = F.tid & 63; F.wave = __builtin_amdgcn_readfirstlane(F.tid >> 6);
    F.G = gridDim.x; F.wg = blockIdx.x; F.ws = args.ws; F.ctl = (unsigned*)(args.ws + WS_CTL);
    for (int u = F.tid; u < (LDS_BYTES - LDSCTL_OFF) / 4; u += NTHR) ((LAS unsigned*)(F.lds + LDSCTL_OFF))[u] = 0u;
    __syncthreads();
    if (F.tid < 26) { const __attribute__((address_space(4))) unsigned long long* kp = (const __attribute__((address_space(4))) unsigned long long*)__builtin_amdgcn_kernarg_segment_ptr();
        ((LAS unsigned long long*)(F.lds + PTAB_OFF))[F.tid] = kp[F.tid]; }
    __syncthreads();
    XcdBarrier bar = xcd_barrier_post(F.ctl + CW_BAR, (volatile LAS unsigned*)(F.lds + MISC_OFF) + 8);
    int lo = args.s_lo, hi = args.s_hi;
#define IN(k) (lo <= (k) && (k) < hi)
#define SL() asm volatile("" : "+s"(lo), "+s"(hi), "+s"(F.ws), "+s"(F.wg), "+s"(F.G))
#define LAUNDER() do { int t_ = threadIdx.x; asm volatile("" : "+v"(t_)); F.tid = t_; F.lane = t_ & 63; F.wave = __builtin_amdgcn_readfirstlane(t_ >> 6); } while (0)
#define SEAM(k) do { SL(); if (IN(k) && IN((k) + 1)) xcd_barrier(bar); } while (0)
    SL(); if (IN(0)) { LAUNDER(); p0_prologue(F); }
#ifdef PROBE_P0
    SL(); if (IN(0)) { xcd_barrier(bar); LAUNDER(); p0_prologue(F); }
#endif
    SEAM(0);
    SL(); if (IN(1)) { LAUNDER(); p1_modreduce(F); }
    SEAM(1);
    for (int layer_ = 0; layer_ < NL; ++layer_) {
        int layer = layer_; asm volatile("" : "+s"(layer));
        const int s0 = 2 + layer * NPH;
        const int mrows = (layer == NL - 1) ? ML : MT;
        const float* modl = wsp<float>(F, WS_MOD) + (size_t)layer * 5 * 12288;
        SL(); if (IN(s0 + 0)) { LAUNDER(); norm_phase(F, layer, 0, MT, layer > 0); }
#if defined(PROBE_PHASE) && PROBE_PHASE == 0
        SL(); if (IN(s0 + 0)) { xcd_barrier(bar); LAUNDER(); norm_phase(F, layer, 0, MT, false); }
#endif
        SEAM(s0 + 0);
        SL(); if (IN(s0 + 1)) {
            pg8::Gemm g{wsp<bf16>(F, WS_U), wsp<bf16>(F, WS_WIN + layer * SZ_WIN), MT, LDP, DM, DM, DM}; pg8::StaticOrder S; S.init(MT, LDP, F.G, F.wg);
            pg8::EpiBf16<0> E{wsp<bf16>(F, WS_P), LDP};
            pg8::gemm_phase<pg8::EpiBf16<0>, pg8::StaticOrder, true, true>(F.lds, g, S, E);
#ifdef PROBE_GEMM2
            pg8::gemm_phase<pg8::EpiBf16<0>, pg8::StaticOrder, true, true>(F.lds, g, S, E);
#endif
        }
        SEAM(s0 + 1);
        SL(); if (IN(s0 + 2)) { LAUNDER(); prep_phase(F, layer); }
#if defined(PROBE_PHASE) && PROBE_PHASE == 2
        SL(); if (IN(s0 + 2)) { xcd_barrier(bar); LAUNDER(); prep_phase(F, layer); }
#endif
        SEAM(s0 + 2);
        SL(); if (IN(s0 + 3)) {
            pg8::Gemm g{wsp<bf16>(F, WS_ALR), wsp<bf16>(F, WS_WLR + layer * SZ_WLR), MT, NLR, KLR, KLR, KLR}; pg8::StaticOrder S; S.init(MT, NLR, F.G, F.wg);
            pg8::EpiF32 E{wsp<float>(F, WS_LR), NLR};
            pg8::gemm_phase<pg8::EpiF32, pg8::StaticOrder, true, true>(F.lds, g, S, E);
        }
        SEAM(s0 + 3);
        SL(); if (IN(s0 + 4)) { LAUNDER(); mix_phase(F, layer, layer); }
#ifdef PROBE_MIX
        SL(); if (IN(s0 + 4)) { xcd_barrier(bar); LAUNDER(); mix_phase(F, layer, layer + 4, PROBE_MIX); }
#endif
        SEAM(s0 + 4);
        SL(); if (IN(s0 + 5)) { LAUNDER(); mixfin_phase(F, layer, mrows); }
#if defined(PROBE_PHASE) && PROBE_PHASE == 5
        SL(); if (IN(s0 + 5)) { xcd_barrier(bar); LAUNDER(); mixfin_phase(F, layer, mrows); }
#endif
        SEAM(s0 + 5);
        SL(); if (IN(s0 + 6)) {
            const bf16* wbr = wsp<bf16>(F, WS_WBR + layer * SZ_WBR);
            pg8::StaticOrder S; S.init(mrows, DM, F.G, F.wg);
            { pg8::Gemm g{wsp<bf16>(F, WS_Y), wbr, mrows, DM, BW, 3072, BW}; pg8::EpiGate<0> E{wsp<bf16>(F, WS_P) + C_GATE, LDP, wsp<float>(F, WS_MGF), wsp<bf16>(F, WS_MG)};
              pg8::gemm_phase<pg8::EpiGate<0>, pg8::StaticOrder, true, true>(F.lds, g, S, E); }
            { pg8::Gemm g{wsp<bf16>(F, WS_Y) + 1024, wbr + (size_t)DM * BW, mrows, DM, BW, 3072, BW}; pg8::EpiGate<1> E{wsp<bf16>(F, WS_P) + C_GATE + 2048, LDP, wsp<float>(F, WS_MGF), wsp<bf16>(F, WS_MG)};
              pg8::gemm_phase<pg8::EpiGate<1>, pg8::StaticOrder, true, true>(F.lds, g, S, E); }
            { pg8::Gemm g{wsp<bf16>(F, WS_Y) + 2048, wbr + (size_t)2 * DM * BW, mrows, DM, BW, 3072, BW}; pg8::EpiGate<2> E{wsp<bf16>(F, WS_P) + C_GATE + 4096, LDP, wsp<float>(F, WS_MGF), wsp<bf16>(F, WS_MG)};
              pg8::gemm_phase<pg8::EpiGate<2>, pg8::StaticOrder, true, true>(F.lds, g, S, E); }
        }
        SEAM(s0 + 6);
        SL(); if (IN(s0 + 7)) {
            { pg8::Gemm g{wsp<bf16>(F, WS_MG), wsp<bf16>(F, WS_WOUT + layer * SZ_WOUT), ML, DM, DM, DM, DM}; pg8::StaticOrder S; S.init(ML, DM, F.G, F.wg);
              pg8::EpiResGate E{wsp<float>(F, WS_H), modl, 2 * DM};
              pg8::gemm_phase<pg8::EpiResGate, pg8::StaticOrder, true, true>(F.lds, g, S, E); }
            if (mrows > ML) { const int ks = (F.wg & 7) * (DM / 8);
              pg8::Gemm g{wsp<bf16>(F, WS_MG) + ks, wsp<bf16>(F, WS_WOUT + layer * SZ_WOUT) + ks, MT, DM, DM / 8, DM, DM}; pg8::SubKOrder S{F.G, F.wg};
              pg8::EpiResGatePart E{wsp<float>(F, WS_YDR), modl, 2 * DM, (int)(F.wg & 7)};
              pg8::gemm_phase<pg8::EpiResGatePart, pg8::SubKOrder, true, true>(F.lds, g, S, E); }
        }
        SEAM(s0 + 7);
        SL(); if (IN(s0 + 8)) { LAUNDER(); norm_phase(F, layer, 1, mrows, true); }
#if defined(PROBE_PHASE) && PROBE_PHASE == 8
        SL(); if (IN(s0 + 8)) { xcd_barrier(bar); LAUNDER(); norm_phase(F, layer, 1, mrows, false); }
#endif
        SEAM(s0 + 8);
        SL(); if (IN(s0 + 9)) {
            pg8::Gemm g{wsp<bf16>(F, WS_U), wsp<bf16>(F, WS_WFF1 + layer * SZ_WFF), mrows, DFF, DM, DM, DM}; pg8::StaticOrder S; S.init(mrows, DFF, F.G, F.wg);
            pg8::EpiBf16<2> E{wsp<bf16>(F, WS_F), DFF};
            pg8::gemm_phase<pg8::EpiBf16<2>, pg8::StaticOrder, true, true>(F.lds, g, S, E);
#ifdef PROBE_GEMM2
            pg8::gemm_phase<pg8::EpiBf16<2>, pg8::StaticOrder, true, true>(F.lds, g, S, E);
#endif
        }
        SEAM(s0 + 9);
        SL(); if (IN(s0 + 10)) {
            { pg8::Gemm g{wsp<bf16>(F, WS_F), wsp<bf16>(F, WS_WFF2 + layer * SZ_WFF), ML, DM, DFF, DFF, DFF}; pg8::StaticOrder S; S.init(ML, DM, F.G, F.wg);
              pg8::EpiResGate E{wsp<float>(F, WS_H), modl, 5 * DM};
              pg8::gemm_phase<pg8::EpiResGate, pg8::StaticOrder, true, true>(F.lds, g, S, E); }
            if (mrows > ML) { const int ks = (F.wg & 7) * (DFF / 8);
              pg8::Gemm g{wsp<bf16>(F, WS_F) + ks, wsp<bf16>(F, WS_WFF2 + layer * SZ_WFF) + ks, MT, DM, DFF / 8, DFF, DFF}; pg8::SubKOrder S{F.G, F.wg};
              pg8::EpiResGatePart E{wsp<float>(F, WS_YDR), modl, 5 * DM, (int)(F.wg & 7)};
              pg8::gemm_phase<pg8::EpiResGatePart, pg8::SubKOrder, true, true>(F.lds, g, S, E); }
        }
        SEAM(s0 + 10);
    }
    SL(); if (IN(NSTEPS - 1)) { LAUNDER(); final_norm(F, args.out); }
#undef IN
#undef SL
#undef LAUNDER
#undef SEAM
}

#ifndef MK_ONE_LAUNCH
#define MK_ONE_LAUNCH 1
#endif
extern "C" void kernel_launch(void* const* d_in, const int* in_sizes, int n_in, void* d_out, int out_size, void* d_ws, size_t ws_size, hipStream_t stream) {
    static int grid = 0;
    if (grid == 0) {
        if (n_in != 26 || out_size != ML * DM || ws_size < WS_END) { fprintf(stderr, "kernel_launch: unexpected shapes (n_in %d, out %d, ws %zu < %zu)\n", n_in, out_size, ws_size, (size_t)WS_END); grid = -1; return; }
        int dev = 0, cus = 0, per_cu = 0;
        if (hipGetDevice(&dev) != hipSuccess || hipDeviceGetAttribute(&cus, hipDeviceAttributeMultiprocessorCount, dev) != hipSuccess) { grid = -1; return; }
        if (hipFuncSetAttribute((const void*)hyb_fwd, hipFuncAttributeMaxDynamicSharedMemorySize, LDS_BYTES) != hipSuccess) { fprintf(stderr, "kernel_launch: hipFuncSetAttribute failed\n"); grid = -1; return; }
        if (hipOccupancyMaxActiveBlocksPerMultiprocessor(&per_cu, (const void*)hyb_fwd, NTHR, LDS_BYTES) != hipSuccess || per_cu < 1) fprintf(stderr, "kernel_launch: occupancy query reports %d\n", per_cu);
        (void)hipGetLastError();
        grid = cus;
    }
    if (grid < 0) return;
    if (hipMemsetAsync((char*)d_ws + WS_CTL, 0, CTL_ZERO_BYTES, stream) != hipSuccess) return;
    Args a{};
    for (int i = 0; i < 26; ++i) a.in[i] = (const float*)d_in[i];
    a.out = (float*)d_out; a.ws = (unsigned char*)d_ws;
#if MK_ONE_LAUNCH
    a.s_lo = 0; a.s_hi = NSTEPS;
    hipLaunchKernelGGL(hyb_fwd, dim3(grid), dim3(NTHR), LDS_BYTES, stream, a);
#else
    for (int s = 0; s < NSTEPS; ++s) { a.s_lo = s; a.s_hi = s + 1; hipLaunchKernelGGL(hyb_fwd, dim3(grid), dim3(NTHR), LDS_BYTES, stream, a); }
#endif
}
```

```cpp
#include <hip/hip_runtime.h>
#include <cstdio>
#include <cstdint>
__device__ __forceinline__ int lane_now() { int l; asm volatile("v_mbcnt_lo_u32_b32 %0, -1, 0\n\tv_mbcnt_hi_u32_b32 %0, -1, %0" : "=v"(l)); return l; }
namespace pg8 {
#define PG8_LAS __attribute__((address_space(3)))
typedef unsigned short bf16_t;
typedef short bf16x8 __attribute__((ext_vector_type(8)));
typedef float f32x4 __attribute__((ext_vector_type(4)));
typedef unsigned u32x4 __attribute__((ext_vector_type(4)));
constexpr int BM = 256, BK = 64, HALF = 128, HTB = HALF * BK * 2  , STAGE_BYTES = 8 * HTB, NXCD = 8, WGM = 8;

__host__ __device__ __forceinline__ int lds_byte(int r, int c) { const int st = (r >> 4) * 2 + (c >> 5), rr = r & 15, cc = c & 31, ob = rr * 64 + cc * 2; return st * 1024 + (ob ^ (((ob >> 9) & 1) << 5)); }
__host__ __device__ __forceinline__ void stage_rc(int b, int& R, int& C) { const int st = b / 1024, sb = b % 1024, swz = sb ^ (((sb >> 9) & 1) << 5); R = (st >> 1) * 16 + swz / 64; C = (st & 1) * 32 + (swz % 64) / 2; }
__host__ __device__ __forceinline__ int perm32(int rho) { const int n = rho >> 4, i = rho & 15; return 8 * (i >> 2) + 4 * n + (i & 3); }

struct Unit { int pm, pn; };
struct Gemm { const bf16_t* A; const bf16_t* Bt; int M, N, K, lda, ldb; };

struct StaticOrder {
    int nM, nN, nwg, G, c;
    __host__ __device__ void init(int M, int N, int G_, int c_) { nM = M / BM; nN = N / BM; nwg = nM * nN; G = G_; c = c_; }
    __host__ __device__ bool next(int i, Unit& u) const {
        const long L = (long)i * G + c; if (L >= nwg) return false;
        int wgid = (int)L; { const int q = nwg / NXCD, r = nwg % NXCD, xcd = wgid % NXCD, off = wgid / NXCD; wgid = (xcd < r ? xcd * (q + 1) : r * (q + 1) + (xcd - r) * q) + off; }
        const int nig = WGM * nN, gid = wgid / nig, fm = gid * WGM, gsz = (nM - fm) < WGM ? (nM - fm) : WGM;
        u.pm = fm + ((wgid % nig) % gsz); u.pn = (wgid % nig) / gsz; return true;
    }
    __device__ __forceinline__ void a_ready(const Unit&) const {}
    __device__ __forceinline__ void done(const Unit&) const {}
};

__device__ __forceinline__ unsigned cvt_pk_bf16(float lo, float hi) { unsigned r; asm volatile("v_cvt_pk_bf16_f32 %0, %1, %2" : "=v"(r) : "v"(lo), "v"(hi)); return r; }
typedef float f32x2 __attribute__((ext_vector_type(2)));
__device__ __forceinline__ float sigmoidf_(float x) { return 1.0f / (1.0f + __expf(-x)); }
__device__ __forceinline__ float bf_lo(unsigned w) { return __uint_as_float(w << 16); }
__device__ __forceinline__ float bf_hi(unsigned w) { return __uint_as_float(w & 0xffff0000u); }

template <int ACT> struct EpiBf16 {
    static constexpr bool PERM = true, AFTER_DRAIN = false;
    bf16_t* O; int ldc;
    __device__ __forceinline__ void operator()(const f32x4 (&acc)[2][2][4][2], const Unit& u, int wr, int wc, int fr, int fq) const {
        const int row0 = u.pm * BM + wr * 64 + fr; const int col0 = u.pn * BM + wc * 32 + 8 * fq;
#pragma unroll
        for (int ai = 0; ai < 2; ++ai)
#pragma unroll
            for (int m = 0; m < 4; ++m) { bf16_t* rowp = O + (size_t)(row0 + ai * HALF + m * 16) * ldc + col0;
#pragma unroll
                for (int bj = 0; bj < 2; ++bj) { f32x4 v0 = acc[ai][bj][m][0], v1 = acc[ai][bj][m][1];
                    if (ACT == 2) {
#pragma unroll
                        for (int e = 0; e < 4; ++e) { const float a = fmaxf(v0[e], 0.f), b = fmaxf(v1[e], 0.f); v0[e] = a * a; v1[e] = b * b; } }
                    u32x4 w; w.x = cvt_pk_bf16(v0[0], v0[1]); w.y = cvt_pk_bf16(v0[2], v0[3]); w.z = cvt_pk_bf16(v1[0], v1[1]); w.w = cvt_pk_bf16(v1[2], v1[3]);
                    *(u32x4*)(rowp + bj * HALF) = w; } }
    }
};
struct EpiF32 {
    static constexpr bool PERM = false, AFTER_DRAIN = false;
    float* C; int ldc;
    __device__ __forceinline__ void operator()(const f32x4 (&acc)[2][2][4][2], const Unit& u, int wr, int wc, int fr, int fq) const {
        const int row0 = u.pm * BM + wr * 64 + fr, col0 = u.pn * BM + wc * 32 + 4 * fq;
#pragma unroll
        for (int ai = 0; ai < 2; ++ai)
#pragma unroll
            for (int m = 0; m < 4; ++m) { float* rowp = C + (size_t)(row0 + ai * HALF + m * 16) * ldc + col0;
#pragma unroll
                for (int bj = 0; bj < 2; ++bj)
#pragma unroll
                    for (int n = 0; n < 2; ++n) *(f32x4*)(rowp + bj * HALF + n * 16) = acc[ai][bj][m][n]; }
    }
};
template <int MODE> struct EpiGate {
    static constexpr bool PERM = true, AFTER_DRAIN = false;
    const bf16_t* G; int ldg;
    float* part; bf16_t* out;
    __device__ __forceinline__ void operator()(const f32x4 (&acc)[2][2][4][2], const Unit& u, int wr, int wc, int fr, int fq) const {
        const int row0 = u.pm * BM + wr * 64 + fr; const int col0 = u.pn * BM + wc * 32 + 8 * fq;
#pragma unroll
        for (int ai = 0; ai < 2; ++ai)
#pragma unroll
            for (int m = 0; m < 4; ++m) { const size_t row = (size_t)(row0 + ai * HALF + m * 16);
#pragma unroll
                for (int bj = 0; bj < 2; ++bj) { const int c = col0 + bj * HALF;
                    const u32x4 gw = *(const u32x4*)(G + row * ldg + c);
                    f32x4 g0, g1; g0[0] = sigmoidf_(bf_lo(gw.x)); g0[1] = sigmoidf_(bf_hi(gw.x)); g0[2] = sigmoidf_(bf_lo(gw.y)); g0[3] = sigmoidf_(bf_hi(gw.y));
                    g1[0] = sigmoidf_(bf_lo(gw.z)); g1[1] = sigmoidf_(bf_hi(gw.z)); g1[2] = sigmoidf_(bf_lo(gw.w)); g1[3] = sigmoidf_(bf_hi(gw.w));
                    f32x4 v0 = acc[ai][bj][m][0] * g0, v1 = acc[ai][bj][m][1] * g1;
                    float* pp = part + row * 2048 + c;
                    if (MODE >= 1) { v0 += *(const f32x4*)pp; v1 += *(const f32x4*)(pp + 4); }
                    if (MODE <= 1) { *(f32x4*)pp = v0; *(f32x4*)(pp + 4) = v1; }
                    else { u32x4 w; w.x = cvt_pk_bf16(v0[0], v0[1]); w.y = cvt_pk_bf16(v0[2], v0[3]); w.z = cvt_pk_bf16(v1[0], v1[1]); w.w = cvt_pk_bf16(v1[2], v1[3]);
                        *(u32x4*)(out + row * 2048 + c) = w; } } }
    }
};
struct EpiResGate {
    static constexpr bool PERM = false, AFTER_DRAIN = false;
    float* H; const float* modl; int goff;
    __device__ __forceinline__ void operator()(const f32x4 (&acc)[2][2][4][2], const Unit& u, int wr, int wc, int fr, int fq) const {
        const int mr = u.pm < 32 ? (u.pm >> 3) : 4;
        const int row0 = u.pm * BM + wr * 64 + fr, col0 = u.pn * BM + wc * 32 + 4 * fq;
        const float* gv = modl + (size_t)mr * 12288 + goff + col0;
        f32x4 gg[2][2];
#pragma unroll
        for (int bj = 0; bj < 2; ++bj)
#pragma unroll
            for (int n = 0; n < 2; ++n) gg[bj][n] = *(const f32x4*)(gv + bj * HALF + n * 16);
#pragma unroll
        for (int ai = 0; ai < 2; ++ai)
#pragma unroll
            for (int m = 0; m < 4; ++m) { float* rowp = H + (size_t)(row0 + ai * HALF + m * 16) * 2048 + col0;
#pragma unroll
                for (int bj = 0; bj < 2; ++bj)
#pragma unroll
                    for (int n = 0; n < 2; ++n) { f32x4* p = (f32x4*)(rowp + bj * HALF + n * 16); *p = *p + gg[bj][n] * acc[ai][bj][m][n]; } }
    }
};

struct EpiResGatePart {
    static constexpr bool PERM = false, AFTER_DRAIN = false;
    float* part; const float* modl; int goff, slice;
    __device__ __forceinline__ void operator()(const f32x4 (&acc)[2][2][4][2], const Unit& u, int wr, int wc, int fr, int fq) const {
        const int row0 = (u.pm - 32) * BM + wr * 64 + fr, col0 = u.pn * BM + wc * 32 + 4 * fq;
        const float* gv = modl + (size_t)4 * 12288 + goff + col0;
        f32x4 gg[2][2];
#pragma unroll
        for (int bj = 0; bj < 2; ++bj)
#pragma unroll
            for (int n = 0; n < 2; ++n) gg[bj][n] = *(const f32x4*)(gv + bj * HALF + n * 16);
#pragma unroll
        for (int ai = 0; ai < 2; ++ai)
#pragma unroll
            for (int m = 0; m < 4; ++m) { float* rowp = part + ((size_t)slice * 1024 + (row0 + ai * HALF + m * 16)) * 2048 + col0;
#pragma unroll
                for (int bj = 0; bj < 2; ++bj)
#pragma unroll
                    for (int n = 0; n < 2; ++n) *(f32x4*)(rowp + bj * HALF + n * 16) = gg[bj][n] * acc[ai][bj][m][n]; }
    }
};
struct SubKOrder {
    int G, c;
    __host__ __device__ bool next(int i, Unit& u) const { const int L = i * G + c; if (L >= 256) return false; const int lt = L >> 3; u.pm = 32 + (lt >> 3); u.pn = lt & 7; return true; }
    __device__ __forceinline__ void a_ready(const Unit&) const {}
    __device__ __forceinline__ void done(const Unit&) const {}
};

template <class Epi, class Sched, bool ALIGN_EPI = false, bool SP2 = false>
__device__ __forceinline__ void gemm_phase(PG8_LAS unsigned char* lds, const Gemm g, const Sched& S, const Epi& E, const int wv  ) {
    int tid_ = wv * 64 + lane_now(); asm volatile("" : "+v"(tid_));
    const int tid = tid_, wid = __builtin_amdgcn_readfirstlane(tid >> 6), lane = tid & 63, wr = wid >> 2, wc = wid & 3, fr = lane & 15, fq = lane >> 4;
    const int K = g.K, nt = K / BK;
    unsigned voffA[2], voffB[2];
#pragma unroll
    for (int i = 0; i < 2; ++i) { int R, C; stage_rc(tid * 16 + i * 8192, R, C); const int Rb = Epi::PERM ? ((R & ~31) + perm32(R & 31)) : R;
        voffA[i] = (unsigned)(R * g.lda + C) * 2u; voffB[i] = (unsigned)(Rb * g.ldb + C) * 2u; }
    const size_t kstep = (size_t)(BK * 2);
    const size_t hstepA = (size_t)HALF * g.lda * 2, hstepB = (size_t)HALF * g.ldb * 2;
    const size_t tstepA = 2 * hstepA, tstepB = 2 * hstepB;
    const unsigned ldsw = (unsigned)wid * 1024u;
    const int aoff = lds_byte(wr * 64 + fr, fq * 8), boff = lds_byte(wc * 32 + fr, fq * 8);
#define PG8_SA(b, h) (((b) * 2 + (h)) * HTB)
#define PG8_SB(b, h) ((4 + (b) * 2 + (h)) * HTB)
#define PG8_STAGE(bufoff, gbase, voff) do { _Pragma("unroll") for (int _i = 0; _i < 2; ++_i) \
        __builtin_amdgcn_global_load_lds((const unsigned*)((const char*)(gbase) + (voff)[_i]), (PG8_LAS unsigned*)(lds + (bufoff) + ldsw + _i * 8192), 16, 0, 0); } while (0)
#define PG8_LDA(dst, b, h) do { _Pragma("unroll") for (int m = 0; m < 4; ++m) _Pragma("unroll") for (int k = 0; k < 2; ++k) dst[m][k] = *(const PG8_LAS bf16x8*)(lds + PG8_SA(b, h) + aoff + m * 2048 + k * 1024); } while (0)
#define PG8_LDB(dst, b, h) do { _Pragma("unroll") for (int n = 0; n < 2; ++n) _Pragma("unroll") for (int k = 0; k < 2; ++k) dst[n][k] = *(const PG8_LAS bf16x8*)(lds + PG8_SB(b, h) + boff + n * 2048 + k * 1024); } while (0)
#define PG8_MMA(ai, bj, At, Bt) do { __builtin_amdgcn_s_setprio(1); _Pragma("unroll") for (int m = 0; m < 4; ++m) _Pragma("unroll") for (int n = 0; n < 2; ++n) _Pragma("unroll") for (int k = 0; k < 2; ++k) \
        acc[ai][bj][m][n] = __builtin_amdgcn_mfma_f32_16x16x32_bf16(Bt[n][k], At[m][k], acc[ai][bj][m][n], 0, 0, 0); __builtin_amdgcn_s_setprio(0); } while (0)
#define PG8_WAIT_V(n) asm volatile("s_waitcnt vmcnt(" #n ")" ::: "memory")
#define PG8_WAIT_L(n) asm volatile("s_waitcnt lgkmcnt(" #n ")" ::: "memory")
#define PG8_BAR __builtin_amdgcn_s_barrier()
#define PG8_SCHED __builtin_amdgcn_sched_barrier(0)
    Unit cur, nxt; int ui = 0;
    if (!S.next(0, cur)) return;
    f32x4 acc[2][2][4][2];
#pragma unroll
    for (int a = 0; a < 2; ++a)
#pragma unroll
        for (int b = 0; b < 2; ++b)
#pragma unroll
            for (int m = 0; m < 4; ++m)
#pragma unroll
                for (int n = 0; n < 2; ++n) acc[a][b][m][n] = (f32x4){0.f, 0.f, 0.f, 0.f};
    bf16x8 At[4][2], B0[2][2], B1[2][2];
    const char* cA = (const char*)g.A + (size_t)cur.pm * tstepA; const char* cB = (const char*)g.Bt + (size_t)cur.pn * tstepB;
    S.a_ready(cur);
    if constexpr (SP2) {
        PG8_STAGE(PG8_SB(0, 0), cB, voffB); PG8_STAGE(PG8_SB(0, 1), cB + hstepB, voffB); PG8_STAGE(PG8_SA(0, 0), cA, voffA); PG8_STAGE(PG8_SA(0, 1), cA + hstepA, voffA);
        if (wr == 1) PG8_BAR;
        PG8_WAIT_V(2); PG8_BAR;
        PG8_STAGE(PG8_SB(1, 0), cB + kstep, voffB); PG8_STAGE(PG8_SA(1, 0), cA + kstep, voffA); PG8_STAGE(PG8_SB(1, 1), cB + hstepB + kstep, voffB);
        PG8_WAIT_V(6); PG8_BAR;
    } else {
        PG8_STAGE(PG8_SB(0, 0), cB, voffB); PG8_STAGE(PG8_SA(0, 0), cA, voffA); PG8_STAGE(PG8_SB(0, 1), cB + hstepB, voffB); PG8_STAGE(PG8_SA(0, 1), cA + hstepA, voffA);
        if (wr == 1) PG8_BAR;
        PG8_WAIT_V(4); PG8_BAR;
        PG8_STAGE(PG8_SB(1, 0), cB + kstep, voffB); PG8_STAGE(PG8_SA(1, 0), cA + kstep, voffA); PG8_STAGE(PG8_SB(1, 1), cB + hstepB + kstep, voffB);
        PG8_WAIT_V(6); PG8_BAR;
    }
    for (;;) {
        const bool has_next = S.next(ui + 1, nxt);
        const char* nA = has_next ? (const char*)g.A + (size_t)nxt.pm * tstepA : cA; const char* nB = has_next ? (const char*)g.Bt + (size_t)nxt.pn * tstepB : cB;
#pragma nounroll
        for (int t = 0; t < nt; t += 2) {
            const bool last = (t == nt - 2);
            const char* a1 = cA + (size_t)(t + 1) * kstep;
            const char* a2 = last ? nA : cA + (size_t)(t + 2) * kstep; const char* b2 = last ? nB : cB + (size_t)(t + 2) * kstep;
            const char* a3 = a2 + kstep; const char* b3 = b2 + kstep;
            if (last && has_next) S.a_ready(nxt);
            if constexpr (SP2) {
            PG8_LDB(B0, 0, 0); PG8_LDB(B1, 0, 1); PG8_SCHED; PG8_LDA(At, 0, 0); PG8_STAGE(PG8_SA(1, 1), a1 + hstepA, voffA);
            PG8_WAIT_V(8); PG8_WAIT_L(0); PG8_BAR; PG8_MMA(0, 0, At, B0); PG8_MMA(0, 1, At, B1); PG8_BAR; PG8_SCHED;
            PG8_LDA(At, 0, 1); PG8_STAGE(PG8_SB(0, 0), b2, voffB); PG8_STAGE(PG8_SB(0, 1), b2 + hstepB, voffB); PG8_STAGE(PG8_SA(0, 0), a2, voffA);
            PG8_WAIT_V(8); PG8_WAIT_L(0); PG8_BAR; PG8_MMA(1, 0, At, B0); PG8_MMA(1, 1, At, B1); PG8_BAR; PG8_SCHED;
            PG8_LDB(B0, 1, 0); PG8_LDB(B1, 1, 1); PG8_SCHED; PG8_LDA(At, 1, 0); PG8_STAGE(PG8_SA(0, 1), a2 + hstepA, voffA);
            PG8_WAIT_V(8); PG8_WAIT_L(0); PG8_BAR; PG8_MMA(0, 0, At, B0); PG8_MMA(0, 1, At, B1); PG8_BAR; PG8_SCHED;
            PG8_LDA(At, 1, 1); PG8_STAGE(PG8_SB(1, 0), b3, voffB); PG8_STAGE(PG8_SB(1, 1), b3 + hstepB, voffB); PG8_STAGE(PG8_SA(1, 0), a3, voffA);
            PG8_WAIT_V(8); PG8_WAIT_L(0); PG8_BAR; PG8_MMA(1, 0, At, B0); PG8_MMA(1, 1, At, B1); PG8_BAR; PG8_SCHED;
            } else {
            PG8_LDB(B0, 0, 0); PG8_SCHED; PG8_LDA(At, 0, 0); PG8_STAGE(PG8_SA(1, 1), a1 + hstepA, voffA);
            PG8_WAIT_L(8); PG8_BAR; PG8_WAIT_L(0); PG8_MMA(0, 0, At, B0); PG8_BAR; PG8_SCHED;
            PG8_LDB(B1, 0, 1); PG8_STAGE(PG8_SB(0, 0), b2, voffB);
            PG8_BAR; PG8_WAIT_L(0); PG8_MMA(0, 1, At, B1); PG8_BAR;
            PG8_LDA(At, 0, 1); PG8_STAGE(PG8_SA(0, 0), a2, voffA);
            PG8_BAR; PG8_WAIT_L(0); PG8_MMA(1, 0, At, B0); PG8_BAR; PG8_SCHED;
            PG8_STAGE(PG8_SB(0, 1), b2 + hstepB, voffB);
            PG8_WAIT_V(6); PG8_BAR; PG8_MMA(1, 1, At, B1); PG8_BAR;
            PG8_LDB(B0, 1, 0); PG8_SCHED; PG8_LDA(At, 1, 0); PG8_STAGE(PG8_SA(0, 1), a2 + hstepA, voffA);
            PG8_WAIT_L(8); PG8_BAR; PG8_WAIT_L(0); PG8_MMA(0, 0, At, B0); PG8_BAR; PG8_SCHED;
            PG8_LDB(B1, 1, 1); PG8_STAGE(PG8_SB(1, 0), b3, voffB);
            PG8_BAR; PG8_WAIT_L(0); PG8_MMA(0, 1, At, B1); PG8_BAR;
            PG8_LDA(At, 1, 1); PG8_STAGE(PG8_SA(1, 0), a3, voffA);
            PG8_BAR; PG8_WAIT_L(0); PG8_MMA(1, 0, At, B0); PG8_BAR; PG8_SCHED;
            PG8_STAGE(PG8_SB(1, 1), b3 + hstepB, voffB);
            PG8_WAIT_V(6); PG8_BAR; PG8_MMA(1, 1, At, B1); PG8_BAR;
            }
        }
        if constexpr (ALIGN_EPI) { if (wr == 0) PG8_BAR; }
        if constexpr (!Epi::AFTER_DRAIN) { int t2_ = lane_now(); asm volatile("" : "+v"(t2_));   E(acc, cur, wr, wc, t2_ & 15, (t2_ >> 4) & 3); S.done(cur); }
        if (!has_next) break;
#pragma unroll
        for (int a = 0; a < 2; ++a)
#pragma unroll
            for (int b = 0; b < 2; ++b)
#pragma unroll
                for (int m = 0; m < 4; ++m)
#pragma unroll
                    for (int n = 0; n < 2; ++n) acc[a][b][m][n] = (f32x4){0.f, 0.f, 0.f, 0.f};
        cur = nxt; cA = nA; cB = nB; ++ui;
        if constexpr (ALIGN_EPI) { if (wr == 1) PG8_BAR; }
    }
    PG8_WAIT_V(0);
    if constexpr (!ALIGN_EPI) { if (wr == 0) PG8_BAR; }
    PG8_BAR;
    if constexpr (Epi::AFTER_DRAIN) { E.fused(acc, cur, wr, wc, fr, fq, lds, wid, lane); S.done(cur); }
#undef PG8_SA
#undef PG8_SB
#undef PG8_STAGE
#undef PG8_LDA
#undef PG8_LDB
#undef PG8_MMA
#undef PG8_WAIT_V
#undef PG8_WAIT_L
#undef PG8_BAR
#undef PG8_SCHED
}
}

constexpr int NB = 4, TL = 2048, TCX = 256, DM = 2048, NL = 4, DFF = 8192, BW = 1024;
constexpr int ML = NB * TL, MC = NB * TCX, MT = ML + MC;
constexpr int NIN = 15232, LDP = 15360;
constexpr int C_RET = 0, C_SWA = 4096, C_RW = 5632, C_GATE = 9088, RWIN = 3456;
constexpr int NLR = 5120, KLR = 384;
constexpr int NQK = 1280;
constexpr int NSTEP = 2304, SCAN_BLK = 32;

constexpr size_t al256(size_t x) { return (x + 255) & ~(size_t)255; }
constexpr size_t WS_CTL = 0, CTL_ZERO_BYTES = 1u << 20;
constexpr size_t SZ_WIN = (size_t)LDP * DM * 2, SZ_WBR = (size_t)3 * DM * BW * 2, SZ_WOUT = (size_t)DM * DM * 2, SZ_WFF = (size_t)DFF * DM * 2, SZ_WLR = (size_t)NLR * KLR * 2;
constexpr size_t WS_WIN = CTL_ZERO_BYTES;
constexpr size_t WS_WBR = WS_WIN + NL * SZ_WIN;
constexpr size_t WS_WOUT = WS_WBR + NL * SZ_WBR;
constexpr size_t WS_WFF1 = WS_WOUT + NL * SZ_WOUT;
constexpr size_t WS_WFF2 = WS_WFF1 + NL * SZ_WFF;
constexpr size_t WS_WLR = WS_WFF2 + NL * SZ_WFF;
constexpr size_t WS_H = WS_WLR + NL * SZ_WLR;
constexpr size_t WS_U = WS_H + (size_t)MT * DM * 4;
constexpr size_t WS_P = WS_U + (size_t)MT * DM * 2;
constexpr size_t WS_Y = WS_P + (size_t)MT * LDP * 2;
constexpr size_t WS_MGF = WS_Y + (size_t)MT * 3072 * 2;
constexpr size_t WS_MG = WS_MGF + (size_t)MT * DM * 4;
constexpr size_t WS_F = WS_MG + (size_t)MT * DM * 2;
constexpr size_t WS_MODP = WS_F + (size_t)MT * DFF * 2;
constexpr size_t WS_MOD = WS_MODP + (size_t)8 * NL * 5 * 12288 * 4;
constexpr size_t WS_ROPE = WS_MOD + (size_t)NL * 5 * 12288 * 4;
constexpr size_t WS_XS = WS_ROPE + 64 * 32 * 2 * 4;
constexpr size_t WS_ALR = WS_XS + (size_t)MT * 3072 * 4;
constexpr size_t WS_LR = WS_ALR + (size_t)MT * KLR * 2;
constexpr size_t WS_QKR = WS_LR + (size_t)MT * NLR * 4;
constexpr size_t WS_ST = WS_QKR + (size_t)MT * NQK * 2;
constexpr size_t WS_YDR = WS_ST + (size_t)NB * 8 * 2 * 18 * 128 * 128 * 2;
constexpr size_t WS_YDW = WS_YDR + (size_t)2 * MT * BW * 4;
constexpr size_t RWU = (size_t)NB * 16 * 2 * 36;
constexpr size_t WS_RWY = WS_F;
constexpr size_t WS_RWH = WS_F + RWU * 16384;
constexpr size_t WS_RWP = WS_YDW;
constexpr size_t WS_RWQ = WS_RWP + RWU * 8192;
constexpr size_t WS_RWG = WS_RWQ + RWU * 8192;
constexpr size_t WS_RWS = WS_RWG + RWU * 256;
constexpr size_t WS_END = WS_RWS + RWU * 8192;
static_assert(RWU * 32768 <= (size_t)MT * DFF * 2, "rwkv tiles overlay F");
constexpr int CW_BAR = 4096;
constexpr int CW_DBG = 20480;
constexpr int CW_SWAQ = 16384;

constexpr int RING_BYTES = 131072, LDSCTL_OFF = RING_BYTES, MISC_OFF = LDSCTL_OFF + 320, LDS_BYTES = 147456;
constexpr int NWAVES = 8, NTHR = 512;

#define GAS __attribute__((address_space(1)))
#define LAS __attribute__((address_space(3)))
typedef unsigned short bf16;
typedef float f32x4 __attribute__((ext_vector_type(4)));
typedef float f32x2 __attribute__((ext_vector_type(2)));
typedef unsigned u32x4 __attribute__((ext_vector_type(4)));
typedef unsigned u32x2 __attribute__((ext_vector_type(2)));
#define LDS_WAIT() asm volatile("s_waitcnt lgkmcnt(0)" ::: "memory")
#define VM_WAIT() asm volatile("s_waitcnt vmcnt(0)" ::: "memory")
__device__ __forceinline__ unsigned f2bf(float f) { unsigned u = __builtin_bit_cast(unsigned, f); return (u + 0x7fffu + ((u >> 16) & 1u)) >> 16; }
__device__ __forceinline__ unsigned pk2(float lo, float hi) { return f2bf(lo) | (f2bf(hi) << 16); }
__device__ __forceinline__ float bf2f(bf16 v) { return __uint_as_float((unsigned)v << 16); }
__device__ __forceinline__ float sigm(float x) { return 1.0f / (1.0f + __expf(-x)); }
using pg8::bf_lo; using pg8::bf_hi;
__device__ __forceinline__ float shx(float v, int m, int lane) { return __int_as_float(__builtin_amdgcn_ds_bpermute((lane ^ m) << 2, __float_as_int(v))); }
__device__ __forceinline__ float shx_from(float v, int src) { return __int_as_float(__builtin_amdgcn_ds_bpermute((src & 63) << 2, __float_as_int(v))); }
__device__ __forceinline__ float wave_sum(float v, int lane) {
#pragma unroll
    for (int o = 1; o < 64; o <<= 1) v += shx(v, o, lane);
    return v;
}
__device__ __forceinline__ float wave_max(float v, int lane) {
#pragma unroll
    for (int o = 1; o < 64; o <<= 1) v = fmaxf(v, shx(v, o, lane));
    return v;
}

#define XB_TMO      128
#define XB_XCNT(j)  (256  + 64 * (j))
#define XB_XSUB(j)  (1280 + 64 * (j))
#define XB_XGEN(j)  (2304 + 64 * (j))
#define XB_TOP      3328
#define XB_TOPGEN   3392
#define XCD_BAR_WORDS 3456
#define XB_SPIN_CAP (1u << 22)
__device__ __forceinline__ unsigned xb_ld(unsigned* p)              { return __hip_atomic_load(p, __ATOMIC_RELAXED, __HIP_MEMORY_SCOPE_AGENT); }
__device__ __forceinline__ unsigned xb_add(unsigned* p, unsigned v) { return __hip_atomic_fetch_add(p, v, __ATOMIC_RELAXED, __HIP_MEMORY_SCOPE_AGENT); }
__device__ __forceinline__ unsigned xb_xcc_id() { return (unsigned)__builtin_amdgcn_s_getreg((3 << 11) | 20) & 0xFu; }
#define XB_SPIN(cond, bar) do { unsigned _sp = 0; while (cond) { __builtin_amdgcn_s_sleep(1); \
    if ((++_sp & 255u) == 0u) { if (xb_ld(&(bar)[XB_TMO])) break; if (_sp > XB_SPIN_CAP) { atomicAdd(&(bar)[XB_TMO], 1u); break; } } } } while (0)
struct XcdBarrier { unsigned* bar; unsigned x; volatile LAS unsigned* st; };
__device__ __forceinline__ XcdBarrier xcd_barrier_post(unsigned* bar, volatile LAS unsigned* st) {
    XcdBarrier b; b.bar = bar; b.x = xb_xcc_id(); b.st = st;
    if (threadIdx.x == 0) (void)xb_add(&bar[XB_XCNT(b.x)], 1u);
    return b;
}
__device__ __forceinline__ void xcd_barrier_complete(unsigned* bar, unsigned x, unsigned& nloc, unsigned& nx) {
    const unsigned G = gridDim.x * gridDim.y * gridDim.z;
    unsigned sum, cnt, mine, sp = 0u;
    for (;;) {
        sum = 0u; cnt = 0u; mine = 0u;
#pragma unroll
        for (unsigned j = 0; j < 16; ++j) { const unsigned c = xb_ld(&bar[XB_XCNT(j)]); sum += c; cnt += (c > 0u) ? 1u : 0u; mine = (j == x) ? c : mine; }
        if (sum == G) break;
        __builtin_amdgcn_s_sleep(1);
        if ((++sp & 255u) == 0u) { if (xb_ld(&bar[XB_TMO])) break; if (sp > XB_SPIN_CAP) { atomicAdd(&bar[XB_TMO], 1u); break; } }
    }
    nloc = mine > 0u ? mine : 1u; nx = cnt > 0u ? cnt : 1u;
}
__device__ __forceinline__ void xcd_barrier(const XcdBarrier& b, const bool thread0  ) {
    asm volatile("s_waitcnt vmcnt(0)" ::: "memory");
    __syncthreads();
    if (thread0) {
        unsigned* bar = b.bar; unsigned bx = b.x;
        asm volatile("" : "+s"(bar), "+s"(bx));
        __builtin_amdgcn_s_waitcnt(0);
        unsigned nloc = b.st[0], nx = b.st[1];
        if (nloc == 0u) { xcd_barrier_complete(bar, bx, nloc, nx); b.st[0] = nloc; b.st[1] = nx; }
        const unsigned old = xb_add(&bar[XB_XSUB(bx)], 1u);
        const unsigned gen = old / nloc;
        if (old + 1u == (gen + 1u) * nloc) {
            __builtin_amdgcn_fence(__ATOMIC_RELEASE, "agent");
            asm volatile("s_waitcnt vmcnt(0)" ::: "memory");
            const unsigned og = xb_add(&bar[XB_TOP], 1u);
            const unsigned tg = og / nx;
            if (og + 1u == (tg + 1u) * nx) xb_add(&bar[XB_TOPGEN], 1u);
            else XB_SPIN(xb_ld(&bar[XB_TOPGEN]) == tg, bar);
            __builtin_amdgcn_fence(__ATOMIC_ACQUIRE, "agent");
            xb_add(&bar[XB_XGEN(bx)], 1u);
            asm volatile("s_waitcnt vmcnt(0)" ::: "memory");
        } else {
            XB_SPIN(xb_ld(&bar[XB_XGEN(bx)]) == gen, bar);
            __builtin_amdgcn_fence(__ATOMIC_ACQUIRE, "agent");
            asm volatile("s_waitcnt vmcnt(0)" ::: "memory");
        }
    }
    __syncthreads();
}

struct Args { const float* in[26]; float* out; unsigned char* ws; int s_lo, s_hi; };
enum { I_X = 0, I_C, I_CTX, I_CCTX, I_N1G, I_N2G, I_WMOD, I_BMOD, I_WIN, I_RETDEC, I_SINK, I_MU, I_W0, I_WUP, I_A0, I_AUP, I_GUP, I_KK, I_KA, I_RK, I_LNG, I_WBR, I_WOUT, I_WFF1, I_WFF2, I_FING };
struct Frame {
    LAS unsigned char* lds;
    unsigned* ctl;
    int tid, lane, wave, G, wg;
    unsigned char* ws;
};
template <class T> __device__ __forceinline__ T* wsp(const Frame& F, size_t off) { return (T*)(F.ws + off); }
constexpr int PTAB_OFF = LDSCTL_OFF + 64;
__device__ __forceinline__ const float* inp(const Frame& F, int i) {
    const LAS unsigned* t = (const LAS unsigned*)(F.lds + PTAB_OFF) + 2 * i;
    const unsigned lo = __builtin_amdgcn_readfirstlane(t[0]), hi = __builtin_amdgcn_readfirstlane(t[1]);
    return (const float*)(((unsigned long long)hi << 32) | (unsigned long long)lo);
}

__device__ __forceinline__ int scan_row(int b, int dir, int s) {
    if (s < TCX) return ML + b * TCX + (dir ? (TCX - 1 - s) : s);
    const int t = s - TCX; return b * TL + (dir ? (TL - 1 - t) : t);
}

__device__ __forceinline__ void transpose_item(const float* W, int K, int N, bf16* WT, LAS unsigned char* scr, int item, int lane) {
    const int nblk = N / 64, kb = item / nblk, nb = item % nblk, k0 = 64 * kb, n0 = 64 * nb;
    const int kr = lane >> 4, nc = (lane & 15) * 4;
    f32x4 v[16];
#pragma unroll
    for (int i = 0; i < 16; ++i) v[i] = *(const f32x4*)(W + (size_t)(k0 + 4 * i + kr) * N + n0 + nc);
#pragma unroll
    for (int i = 0; i < 16; ++i) { LAS unsigned short* d = (LAS unsigned short*)(scr + nc * 144 + (4 * i + kr) * 2);
        d[0] = (unsigned short)f2bf(v[i].x); d[72] = (unsigned short)f2bf(v[i].y); d[144] = (unsigned short)f2bf(v[i].z); d[216] = (unsigned short)f2bf(v[i].w); }
    LDS_WAIT(); asm volatile("" ::: "memory");
    const int c = lane & 7;
#pragma unroll
    for (int j = 0; j < 8; ++j) { const int n = (lane >> 3) + 8 * j;
        *(u32x4*)(WT + (size_t)(n0 + n) * K + k0 + 8 * c) = *(const LAS u32x4*)(scr + n * 144 + 16 * c); }
    LDS_WAIT(); asm volatile("" ::: "memory");
}
__device__ __forceinline__ void p0_prologue(Frame& F) {
    const int gw = F.wg * NWAVES + F.wave, NGW = F.G * NWAVES;
    const int gt = F.wg * NTHR + F.tid, NGT = F.G * NTHR;
    LAS float* sil = (LAS float*)(F.lds + 81920);
    for (int e = F.tid; e < 5 * DM; e += NTHR) { const int r = e / DM, k = e % DM; const float v = r < 4 ? inp(F, I_C)[r * DM + k] : inp(F, I_CCTX)[k]; sil[e] = v * sigm(v); }
    {
        LAS unsigned char* scr = F.lds + F.wave * 9216;
        constexpr int IT_IN = (DM / 64) * (NIN / 64), IT_BR = (BW / 64) * (DM / 64), IT_OUT = (DM / 64) * (DM / 64), IT_F1 = (DM / 64) * (DFF / 64), IT_F2 = (DFF / 64) * (DM / 64);
        constexpr int IT_L = IT_IN + 3 * IT_BR + IT_OUT + IT_F1 + IT_F2;
        for (int it = gw; it < NL * IT_L; it += NGW) {
            const int l = it / IT_L; int r = it % IT_L;
            if (r < IT_IN) { transpose_item(inp(F, I_WIN) + (size_t)l * DM * NIN, DM, NIN, wsp<bf16>(F, WS_WIN + l * SZ_WIN), scr, r, F.lane); continue; } r -= IT_IN;
            if (r < 3 * IT_BR) { const int n = r / IT_BR; transpose_item(inp(F, I_WBR) + ((size_t)l * 3 + n) * BW * DM, BW, DM, wsp<bf16>(F, WS_WBR + l * SZ_WBR) + (size_t)n * DM * BW, scr, r % IT_BR, F.lane); continue; } r -= 3 * IT_BR;
            if (r < IT_OUT) { transpose_item(inp(F, I_WOUT) + (size_t)l * DM * DM, DM, DM, wsp<bf16>(F, WS_WOUT + l * SZ_WOUT), scr, r, F.lane); continue; } r -= IT_OUT;
            if (r < IT_F1) { transpose_item(inp(F, I_WFF1) + (size_t)l * DM * DFF, DM, DFF, wsp<bf16>(F, WS_WFF1 + l * SZ_WFF), scr, r, F.lane); continue; } r -= IT_F1;
            transpose_item(inp(F, I_WFF2) + (size_t)l * DFF * DM, DFF, DM, wsp<bf16>(F, WS_WFF2 + l * SZ_WFF), scr, r, F.lane);
        }
    }
    for (int e = gt; e < NL * (LDP - NIN) * DM / 8; e += NGT) { const int l = e / ((LDP - NIN) * DM / 8), r = e % ((LDP - NIN) * DM / 8);
        *(u32x4*)(wsp<bf16>(F, WS_WIN + l * SZ_WIN) + (size_t)NIN * DM + (size_t)r * 8) = (u32x4){0u, 0u, 0u, 0u}; }
    for (int e = gt; e < NL * NLR * KLR; e += NGT) {
        const int l = e / (NLR * KLR), r = e % (NLR * KLR), n = r / KLR, k = r % KLR; float v = 0.f;
        if (n < 2048) { const int d = n >> 10, c = n & 1023; if (k >= 64 * d && k < 64 * d + 64) v = inp(F, I_WUP)[(((size_t)l * 2 + d) * 64 + (k - 64 * d)) * BW + c]; }
        else if (n < 4096) { const int d = (n - 2048) >> 10, c = n & 1023; if (k >= 128 + 64 * d && k < 192 + 64 * d) v = inp(F, I_AUP)[(((size_t)l * 2 + d) * 64 + (k - 128 - 64 * d)) * BW + c]; }
        else { const int c = n - 4096; if (k >= 256) v = inp(F, I_GUP)[((size_t)l * 128 + (k - 256)) * BW + c]; }
        wsp<bf16>(F, WS_WLR + l * SZ_WLR)[r] = (bf16)f2bf(v);
    }
    { const f32x4* x4 = (const f32x4*)inp(F, I_X); const f32x4* c4 = (const f32x4*)inp(F, I_CTX); f32x4* h4 = wsp<f32x4>(F, WS_H);
      for (int e = gt; e < ML * DM / 4; e += NGT) h4[e] = x4[e];
      for (int e = gt; e < MC * DM / 4; e += NGT) h4[ML * DM / 4 + e] = c4[e]; }
    if (gt < 64 * 32) { const int pos = gt >> 5, i = gt & 31; const float inv = powf(10000.0f, -(float)i / 32.0f); const float ang = (float)pos * inv;
        wsp<float>(F, WS_ROPE)[2 * gt] = cosf(ang); wsp<float>(F, WS_ROPE)[2 * gt + 1] = sinf(ang); }
    __syncthreads();
    for (int it = gw; it < NL * 8 * 48; it += NGW) {
        const int l = it / (8 * 48), kc = (it / 48) % 8, cc = it % 48, col = cc * 256 + F.lane * 4, k0 = kc * 256;
        const float* wp = inp(F, I_WMOD) + ((size_t)l * DM + k0) * 12288 + col;
        f32x4 a0 = {0.f, 0.f, 0.f, 0.f}, a1 = a0, a2 = a0, a3 = a0, a4 = a0;
#pragma unroll 8
        for (int k = 0; k < 256; ++k) { const f32x4 w = *(const f32x4*)(wp + (size_t)k * 12288);
            a0 += sil[0 * DM + k0 + k] * w; a1 += sil[1 * DM + k0 + k] * w; a2 += sil[2 * DM + k0 + k] * w; a3 += sil[3 * DM + k0 + k] * w; a4 += sil[4 * DM + k0 + k] * w; }
        float* mp = wsp<float>(F, WS_MODP) + ((size_t)(kc * NL + l) * 5) * 12288 + col;
        *(f32x4*)(mp) = a0; *(f32x4*)(mp + 12288) = a1; *(f32x4*)(mp + 2 * 12288) = a2; *(f32x4*)(mp + 3 * 12288) = a3; *(f32x4*)(mp + 4 * 12288) = a4;
    }
}
__device__ __forceinline__ void p1_modreduce(Frame& F) {
    const int gt = F.wg * NTHR + F.tid, NGT = F.G * NTHR;
    for (int e = gt; e < NL * 5 * 12288; e += NGT) { const int l = e / (5 * 12288), j = e % 12288;
        float s = inp(F, I_BMOD)[l * 12288 + j];
#pragma unroll
        for (int kc = 0; kc < 8; ++kc) s += wsp<float>(F, WS_MODP)[(size_t)kc * NL * 5 * 12288 + e];
        wsp<float>(F, WS_MOD)[e] = s; }
}

__device__ __forceinline__ void norm_phase(Frame& F, int layer, int which, int nrows, bool partials) {
    const int gw = F.wg * NWAVES + F.wave, NGW = F.G * NWAVES;
    const float* gptr = inp(F, which ? I_N2G : I_N1G) + layer * DM;
    for (int row = gw; row < nrows; row += NGW) {
        const int mr = row < ML ? (row >> 11) : 4;
        const float* mod = wsp<float>(F, WS_MOD) + ((size_t)layer * 5 + mr) * 12288 + (which ? 3 * DM : 0);
        const f32x4* xr = (const f32x4*)(wsp<float>(F, WS_H) + (size_t)row * DM) + F.lane;
        f32x4 v[8]; float ss = 0.f;
#pragma unroll
        for (int j = 0; j < 8; ++j) v[j] = xr[64 * j];
        if (partials && row >= ML) {
            const f32x4* pp = (const f32x4*)(wsp<float>(F, WS_YDR) + (size_t)(row - ML) * DM) + F.lane;
#pragma unroll
            for (int s = 0; s < 8; ++s)
#pragma unroll
                for (int j = 0; j < 8; ++j) v[j] += pp[(size_t)s * 1024 * DM / 4 + 64 * j];
            f32x4* xw = (f32x4*)(wsp<float>(F, WS_H) + (size_t)row * DM) + F.lane;
#pragma unroll
            for (int j = 0; j < 8; ++j) xw[64 * j] = v[j];
        }
#pragma unroll
        for (int j = 0; j < 8; ++j) ss += (v[j].x * v[j].x + v[j].y * v[j].y) + (v[j].z * v[j].z + v[j].w * v[j].w);
        const float rs = 1.0f / sqrtf(wave_sum(ss, F.lane) * (1.0f / DM) + 1e-6f);
        u32x2* o = (u32x2*)(wsp<bf16>(F, WS_U) + (size_t)row * DM) + F.lane;
#pragma unroll
        for (int j = 0; j < 8; ++j) { const int c = 4 * F.lane + 256 * j;
            const f32x4 g = *(const f32x4*)(gptr + c), sh = *(const f32x4*)(mod + c), sc = *(const f32x4*)(mod + DM + c);
            const f32x4 y = (v[j] * rs) * g * (1.0f + sc) + sh;
            u32x2 w; w.x = pk2(y.x, y.y); w.y = pk2(y.z, y.w); o[64 * j] = w; }
    }
}
__device__ __forceinline__ void final_norm(Frame& F, float* out) {
    const int gw = F.wg * NWAVES + F.wave, NGW = F.G * NWAVES;
#ifdef RW_DEBUG
    const float* dst_ = (const float*)(F.ctl + CW_DBG); const float er0_ = sqrtf(dst_[0] / fmaxf(dst_[1], 1e-30f)), er1_ = sqrtf(dst_[2] / fmaxf(dst_[3], 1e-30f)); const float dbg_e0 = er0_ > RW_DEBUG_THR ? 0.3f : 0.0f, dbg_e1 = er1_ > RW_DEBUG_THR ? 0.6f : 0.0f;
#endif
    for (int row = gw; row < ML; row += NGW) {
        const f32x4* xr = (const f32x4*)(wsp<float>(F, WS_H) + (size_t)row * DM) + F.lane;
        f32x4 v[8]; float ss = 0.f;
#pragma unroll
        for (int j = 0; j < 8; ++j) { v[j] = xr[64 * j]; ss += (v[j].x * v[j].x + v[j].y * v[j].y) + (v[j].z * v[j].z + v[j].w * v[j].w); }
        const float rs = 1.0f / sqrtf(wave_sum(ss, F.lane) * (1.0f / DM) + 1e-6f);
        f32x4* o = (f32x4*)(out + (size_t)row * DM) + F.lane;
#pragma unroll
        for (int j = 0; j < 8; ++j) { const f32x4 g = *(const f32x4*)(inp(F, I_FING) + 4 * F.lane + 256 * j); f32x4 ov = (v[j] * rs) * g;
#ifdef RW_DEBUG
#ifndef RW_DEBUG_NOSTAT
            ov += dbg_e0; if (row == 0 && j == 0 && F.lane == 0) ov.x += dbg_e1;
#endif
#endif
            o[64 * j] = ov; }
    }
}
__device__ __forceinline__ void prep_phase(Frame& F, int layer) {
    const int gw = F.wg * NWAVES + F.wave, NGW = F.G * NWAVES;
    const bf16* P = wsp<bf16>(F, WS_P);
    const float* mu0 = inp(F, I_MU) + (size_t)layer * 2 * RWIN; const float* mu1 = mu0 + RWIN;
    const float* rope = wsp<float>(F, WS_ROPE);
    for (int row = gw; row < MT; row += NGW) {
        bool first, last; int t = 0;
        if (row < ML) { t = row & (TL - 1); first = t == 0; last = t == TL - 1; } else { const int c = (row - ML) & (TCX - 1); first = c == 0; last = c == TCX - 1; }
        const bf16* pr = P + (size_t)row * LDP + C_RW;
        float* xs = wsp<float>(F, WS_XS) + (size_t)row * 3072; bf16* alr = wsp<bf16>(F, WS_ALR) + (size_t)row * KLR;
        for (int j8 = F.lane; j8 < RWIN / 8; j8 += 64) {
            const int c = 8 * j8;
            const u32x4 pw = *(const u32x4*)(pr + c);
            const u32x4 vw = first ? (u32x4){0u, 0u, 0u, 0u} : *(const u32x4*)(pr - LDP + c);
            const u32x4 nw = last ? (u32x4){0u, 0u, 0u, 0u} : *(const u32x4*)(pr + LDP + c);
            const f32x4 ma = *(const f32x4*)(mu0 + c), mb = *(const f32x4*)(mu0 + c + 4), na = *(const f32x4*)(mu1 + c), nb = *(const f32x4*)(mu1 + c + 4);
            float s[8];
#pragma unroll
            for (int e = 0; e < 4; ++e) { const float p0 = bf_lo(pw[e]), p1 = bf_hi(pw[e]), v0 = bf_lo(vw[e]), v1 = bf_hi(vw[e]), n0 = bf_lo(nw[e]), n1 = bf_hi(nw[e]);
                const float m0 = e < 2 ? ma[2 * e] : mb[2 * e - 4], m1 = e < 2 ? ma[2 * e + 1] : mb[2 * e - 3], q0 = e < 2 ? na[2 * e] : nb[2 * e - 4], q1 = e < 2 ? na[2 * e + 1] : nb[2 * e - 3];
                s[2 * e] = p0 + m0 * (v0 - p0) + q0 * (n0 - p0); s[2 * e + 1] = p1 + m1 * (v1 - p1) + q1 * (n1 - p1); }
            if (c < 3072) { *(f32x4*)(xs + c) = (f32x4){s[0], s[1], s[2], s[3]}; *(f32x4*)(xs + c + 4) = (f32x4){s[4], s[5], s[6], s[7]}; }
            else { u32x4 o; int dst;
                if (c < 3200) { dst = c - 3072; o.x = pk2(tanhf(s[0]), tanhf(s[1])); o.y = pk2(tanhf(s[2]), tanhf(s[3])); o.z = pk2(tanhf(s[4]), tanhf(s[5])); o.w = pk2(tanhf(s[6]), tanhf(s[7])); }
                else if (c < 3328) { dst = 128 + c - 3200; o.x = pk2(s[0], s[1]); o.y = pk2(s[2], s[3]); o.z = pk2(s[4], s[5]); o.w = pk2(s[6], s[7]); }
                else { dst = 256 + c - 3328; o.x = pk2(sigm(s[0]), sigm(s[1])); o.y = pk2(sigm(s[2]), sigm(s[3])); o.z = pk2(sigm(s[4]), sigm(s[5])); o.w = pk2(sigm(s[6]), sigm(s[7])); }
                *(u32x4*)(alr + dst) = o; }
        }
        const bf16* ps = P + (size_t)row * LDP + C_SWA; bf16* qk = wsp<bf16>(F, WS_QKR) + (size_t)row * NQK;
        const bool lat = row < ML; const int rr = t >> 6, cc = t & 63;
#pragma unroll
        for (int it = 0; it < 5; ++it) { const int idx = it * 64 + F.lane, hd = idx >> 5, i = idx & 31;
            const float x1r = bf2f(ps[hd * 128 + i]), x2r = bf2f(ps[hd * 128 + 32 + i]), x1c = bf2f(ps[hd * 128 + 64 + i]), x2c = bf2f(ps[hd * 128 + 96 + i]);
            float cr = 1.f, sr = 0.f, ccs = 1.f, scs = 0.f;
            if (lat) { cr = rope[(rr * 32 + i) * 2]; sr = rope[(rr * 32 + i) * 2 + 1]; ccs = rope[(cc * 32 + i) * 2]; scs = rope[(cc * 32 + i) * 2 + 1]; }
            qk[hd * 128 + i] = (bf16)f2bf(x1r * cr - x2r * sr); qk[hd * 128 + 32 + i] = (bf16)f2bf(x2r * cr + x1r * sr);
            qk[hd * 128 + 64 + i] = (bf16)f2bf(x1c * ccs - x2c * scs); qk[hd * 128 + 96 + i] = (bf16)f2bf(x2c * ccs + x1c * scs); }
    }
}

__device__ __forceinline__ float red8(float v) {
    v += __int_as_float(__builtin_amdgcn_update_dpp(0, __float_as_int(v), 0xB1, 0xF, 0xF, true));
    v += __int_as_float(__builtin_amdgcn_update_dpp(0, __float_as_int(v), 0x4E, 0xF, 0xF, true));
    v += __int_as_float(__builtin_amdgcn_update_dpp(0, __float_as_int(v), 0x141, 0xF, 0xF, true));
    return v;
}
__device__ __forceinline__ float red16(float v) {
    v += __int_as_float(__builtin_amdgcn_update_dpp(0, __float_as_int(v), 0xB1, 0xF, 0xF, true));
    v += __int_as_float(__builtin_amdgcn_update_dpp(0, __float_as_int(v), 0x4E, 0xF, 0xF, true));
    v += __int_as_float(__builtin_amdgcn_update_dpp(0, __float_as_int(v), 0x141, 0xF, 0xF, true));
    v += __int_as_float(__builtin_amdgcn_update_dpp(0, __float_as_int(v), 0x140, 0xF, 0xF, true));
    return v;
}
typedef short bf16x8 __attribute__((ext_vector_type(8)));
typedef short s16x4 __attribute__((ext_vector_type(4)));
typedef float f32x16 __attribute__((ext_vector_type(16)));
typedef __bf16 bf16x2_t __attribute__((ext_vector_type(2)));
#define MFMA32(a, b, c) __builtin_amdgcn_mfma_f32_32x32x16_bf16((a), (b), (c), 0, 0, 0)
__device__ __forceinline__ int crow(int reg, int h) { return (reg & 3) + 8 * (reg >> 2) + 4 * h; }
__device__ __forceinline__ unsigned cvtpk(float lo, float hi) { f32x2 v = {lo, hi}; bf16x2_t b = __builtin_convertvector(v, bf16x2_t); return __builtin_bit_cast(unsigned, b); }
__device__ __forceinline__ s16x4 tr16(const LAS unsigned char* p) { return __builtin_bit_cast(s16x4, __builtin_amdgcn_ds_read_tr16_b64_v4i16((LAS s16x4*)p)); }
__device__ __forceinline__ bf16x8 frag_rm(const LAS unsigned char* base, int pitch, int r0, int k0, int lane) {
    return *(const LAS bf16x8*)(base + (r0 + (lane & 31)) * pitch + (k0 + 8 * (lane >> 5)) * 2);
}
template <bool PERM> __device__ __forceinline__ bf16x8 frag_tr(const LAS unsigned char* base, int pitch, int k0, int r0, int lane) {
    const int g = lane >> 4, i = lane & 15, q = i >> 2, p = i & 3, h = g >> 1;
    const LAS unsigned char* a = base + (k0 + (PERM ? 4 : 8) * h + q) * pitch + (r0 + 16 * (g & 1) + 4 * p) * 2;
    const s16x4 lo = tr16(a), hi = tr16(a + (PERM ? 8 : 4) * pitch);
    return __builtin_shufflevector(lo, hi, 0, 1, 2, 3, 4, 5, 6, 7);
}
__device__ __forceinline__ bf16x8 pack_step(const f32x16& x, int s) {
    u32x4 p; p.x = cvtpk(x[8 * s + 0], x[8 * s + 1]); p.y = cvtpk(x[8 * s + 2], x[8 * s + 3]); p.z = cvtpk(x[8 * s + 4], x[8 * s + 5]); p.w = cvtpk(x[8 * s + 6], x[8 * s + 7]);
    return __builtin_bit_cast(bf16x8, p);
}
__device__ __forceinline__ f32x16 zero16() { f32x16 z; for (int i = 0; i < 16; ++i) z[i] = 0.f; return z; }
constexpr int TP = 272;
constexpr int TILE_B = 128 * TP;
__device__ __forceinline__ void load_tile128(LAS unsigned char* dst, const bf16* src, size_t ld, int tid) {
#pragma unroll
    for (int it = 0; it < 4; ++it) { const int idx = tid + NTHR * it, row = idx >> 4, ch = idx & 15;
        *(LAS u32x4*)(dst + row * TP + ch * 16) = *(const u32x4*)(src + (size_t)row * ld + ch * 8); }
}

__device__ __forceinline__ void swa_unit(Frame& F, int layer, int unit) {
    const bf16* QK = wsp<bf16>(F, WS_QKR); const bf16* P = wsp<bf16>(F, WS_P);
    LAS unsigned char* Qt = F.lds; LAS unsigned char* Kt = F.lds + TILE_B; LAS unsigned char* Vt = F.lds + 2 * TILE_B;
    LAS float* stat = (LAS float*)(F.lds + 3 * TILE_B) + F.wave * 32;
    const int lane = F.lane, h = lane >> 5, wi = F.wave & 3, wh = F.wave >> 2;
    int b, qh, n, qrow0; bool isctx;
    if (unit < 512) { b = unit >> 7; qh = (unit >> 4) & 7; n = unit & 15; qrow0 = b * TL + n * 128; isctx = false; }
    else { const int u = unit - 512; b = u >> 4; qh = (u >> 1) & 7; n = u & 1; qrow0 = ML + b * TCX + n * 128; isctx = true; }
    const int kvh = qh >> 2;
    __syncthreads();
    load_tile128(Qt, QK + (size_t)qrow0 * NQK + qh * 128, NQK, F.tid);
    __syncthreads();
    bf16x8 qf[8];
#pragma unroll
    for (int ks = 0; ks < 8; ++ks) qf[ks] = frag_rm(Qt, TP, 32 * wi, 16 * ks, lane);
    const float L2E = 1.4426950408889634f, SC = 0.08838834764831845f * L2E;
    float m = inp(F, I_SINK)[layer * 8 + qh] * L2E, l = h == 0 ? 1.0f : 0.0f;
    f32x16 O0 = zero16(), O1 = zero16();
    const int iq = 32 * wi + (lane & 31);
    const int nch = isctx ? 2 : 5;
    for (int c = 0; c < nch; ++c) {
        int krow0, mtype = 0;
        if (isctx) krow0 = ML + b * TCX + c * 128;
        else if (c < 3) { const int kb = n - 1 + c; if (kb < 0 || kb > 15) continue; krow0 = b * TL + kb * 128; mtype = c == 0 ? 1 : (c == 2 ? 2 : 0); }
        else krow0 = ML + b * TCX + (c - 3) * 128;
        __syncthreads();
        load_tile128(Kt, QK + (size_t)krow0 * NQK + 1024 + kvh * 128, NQK, F.tid);
        load_tile128(Vt, P + (size_t)krow0 * LDP + C_SWA + 1280 + kvh * 128, LDP, F.tid);
        __syncthreads();
        for (int kb = 0; kb < 4; ++kb) {
            f32x16 X = zero16();
#pragma unroll
            for (int ks = 0; ks < 8; ++ks) X = MFMA32(frag_rm(Kt, TP, 32 * kb, 16 * ks, lane), qf[ks], X);
            float bm = -INFINITY;
            int iql = iq - 32 * kb; asm volatile("" : "+v"(iql));
#pragma unroll
            for (int r = 0; r < 16; ++r) { const int d = iql - crow(r, h); float s = X[r] * SC;
                const bool ok = mtype == 0 || (mtype == 1 ? d <= 0 : d >= 0);
                s = ok ? s : -INFINITY; X[r] = s; bm = fmaxf(bm, s); }
            bm = fmaxf(bm, shx(bm, 32, lane));
            const float mn = fmaxf(m, bm), sc = __builtin_amdgcn_exp2f(m - mn); m = mn;
            float ps = 0.f;
#pragma unroll
            for (int r = 0; r < 16; ++r) { const float p = __builtin_amdgcn_exp2f(X[r] - mn); X[r] = p; ps += p; }
            l = l * sc + ps;
            const bf16x8 pa0 = pack_step(X, 0), pa1 = pack_step(X, 1);
            if (h == 0) stat[lane] = sc;
            LDS_WAIT();
#pragma unroll
            for (int g = 0; g < 4; ++g) { const f32x4 sv = *(const LAS f32x4*)(stat + 8 * g + 4 * h);
#pragma unroll
                for (int e = 0; e < 4; ++e) { O0[4 * g + e] *= sv[e]; O1[4 * g + e] *= sv[e]; } }
            O0 = MFMA32(pa0, frag_tr<true>(Vt, TP, 32 * kb, 64 * wh, lane), O0);
            O0 = MFMA32(pa1, frag_tr<true>(Vt, TP, 32 * kb + 16, 64 * wh, lane), O0);
            O1 = MFMA32(pa0, frag_tr<true>(Vt, TP, 32 * kb, 64 * wh + 32, lane), O1);
            O1 = MFMA32(pa1, frag_tr<true>(Vt, TP, 32 * kb + 16, 64 * wh + 32, lane), O1);
        }
    }
    l += shx(l, 32, lane);
    if (h == 0) stat[lane] = 1.0f / l;
    LDS_WAIT();
    bf16* yo = wsp<bf16>(F, WS_Y) + (size_t)(qrow0 + 32 * wi) * 3072 + 1024 + qh * 128 + 64 * wh + (lane & 31);
#pragma unroll
    for (int g = 0; g < 4; ++g) { const f32x4 sv = *(const LAS f32x4*)(stat + 8 * g + 4 * h);
#pragma unroll
        for (int e = 0; e < 4; ++e) { const int r = 8 * g + 4 * h + e; yo[(size_t)r * 3072] = (bf16)f2bf(O0[4 * g + e] * sv[e]); yo[(size_t)r * 3072 + 32] = (bf16)f2bf(O1[4 * g + e] * sv[e]); } }
}

constexpr size_t ST_CHUNK = (size_t)128 * 128;
__device__ __forceinline__ int ret_chunk_row0(int b, int jF) { return jF < 2 ? ML + b * TCX + jF * 128 : b * TL + (jF - 2) * 128; }
__device__ __forceinline__ void ret_state_unit(Frame& F, int layer, int unit) {
    const int dvq = unit & 3, dir = (unit >> 2) & 1, hh = (unit >> 3) & 7, b = unit >> 6;
    const bf16* P = wsp<bf16>(F, WS_P);
    bf16* ST = wsp<bf16>(F, WS_ST) + ((size_t)((b * 8 + hh) * 2 + dir) * 18) * ST_CHUNK;
    const float gam = sigm(inp(F, I_RETDEC)[(layer * 2 + dir) * 8 + hh]); const float lg2 = __builtin_amdgcn_logf(gam);
    const float gC = __builtin_amdgcn_exp2f(lg2 * 128.0f);
    LAS unsigned char* Kt = F.lds; LAS unsigned char* Vt = F.lds + TILE_B;
    constexpr int VP = 80;
    const int lane = F.lane, h = lane >> 5, w = F.wave;
    f32x16 acc = zero16();
    u32x4 pk[4], pv;
    auto fetch = [&](int c) {
        const int jF = dir == 0 ? c : (c < 2 ? 1 - c : 19 - c); const int row0 = ret_chunk_row0(b, jF);
#pragma unroll
        for (int it = 0; it < 4; ++it) { const int idx = F.tid + NTHR * it, tp = idx >> 4, ch = idx & 15; const int row = row0 + (dir ? 127 - tp : tp);
            pk[it] = *(const u32x4*)(P + (size_t)row * LDP + C_RET + 1024 + hh * 128 + ch * 8); }
        { const int tp = F.tid >> 2, ch = F.tid & 3; const int row = row0 + (dir ? 127 - tp : tp);
          pv = *(const u32x4*)(P + (size_t)row * LDP + C_RET + 2048 + hh * 128 + dvq * 32 + ch * 8); }
    };
    fetch(0);
    for (int c = 0; c < 18; ++c) {
        const int jF = dir == 0 ? c : (c < 2 ? 1 - c : 19 - c);
        __syncthreads();
#pragma unroll
        for (int it = 0; it < 4; ++it) { const int idx = F.tid + NTHR * it, tp = idx >> 4, ch = idx & 15; *(LAS u32x4*)(Kt + tp * TP + ch * 16) = pk[it]; }
        { const int tp = F.tid >> 2, ch = F.tid & 3; *(LAS u32x4*)(Vt + tp * VP + ch * 16) = pv; }
        __syncthreads();
        if (c + 1 < 18) fetch(c + 1);
        if (w < 4) {
            int hl = h; asm volatile("" : "+v"(hl));
            bf16* so = ST + (size_t)jF * ST_CHUNK + (size_t)(dvq * 32) * 128 + 32 * w + (lane & 31);
#pragma unroll
            for (int r = 0; r < 16; ++r) so[(size_t)crow(r, h) * 128] = (bf16)f2bf(acc[r]);
#pragma unroll
            for (int r = 0; r < 16; ++r) acc[r] *= gC;
#pragma unroll
            for (int ks = 0; ks < 8; ++ks) {
                bf16x8 a = frag_tr<false>(Vt, VP, 16 * ks, 0, lane);
                u32x4 aw = __builtin_bit_cast(u32x4, a); u32x4 ow;
#pragma unroll
                for (int e = 0; e < 4; ++e) { const int t0 = 16 * ks + 8 * hl + 2 * e;
                    const float f0 = __builtin_amdgcn_exp2f(lg2 * (float)(127 - t0)) * 0.08838834764831845f, f1 = __builtin_amdgcn_exp2f(lg2 * (float)(126 - t0)) * 0.08838834764831845f;
                    ow[e] = cvtpk(bf_lo(aw[e]) * f0, bf_hi(aw[e]) * f1); }
                acc = MFMA32(__builtin_bit_cast(bf16x8, ow), frag_tr<false>(Kt, TP, 16 * ks, 32 * w, lane), acc);
            }
        }
    }
    __syncthreads();
}
__device__ __forceinline__ void ret_out_unit(Frame& F, int layer, int unit) {
    const int jF = unit % 18, hh = (unit / 18) & 7, b = unit / 144;
    const bf16* P = wsp<bf16>(F, WS_P);
    const int row0 = ret_chunk_row0(b, jF);
    LAS unsigned char* Qt = F.lds; LAS unsigned char* Kt = F.lds + TILE_B; LAS unsigned char* Vt = F.lds + 2 * TILE_B;
    const int lane = F.lane, h = lane >> 5, wi = F.wave & 3, wh = F.wave >> 2;
    const float lgf = __builtin_amdgcn_logf(sigm(inp(F, I_RETDEC)[(layer * 2 + 0) * 8 + hh])), lgb = __builtin_amdgcn_logf(sigm(inp(F, I_RETDEC)[(layer * 2 + 1) * 8 + hh]));
    __syncthreads();
    load_tile128(Qt, P + (size_t)row0 * LDP + C_RET + hh * 128, LDP, F.tid);
    load_tile128(Kt, P + (size_t)row0 * LDP + C_RET + 1024 + hh * 128, LDP, F.tid);
    load_tile128(Vt, P + (size_t)row0 * LDP + C_RET + 2048 + hh * 128, LDP, F.tid);
    __syncthreads();
    f32x16 Y0 = zero16(), Y1 = zero16();
    const int iq = 32 * wi + (lane & 31);
    for (int jb = 0; jb < 4; ++jb) {
        f32x16 X = zero16();
#pragma unroll
        for (int ks = 0; ks < 8; ++ks) X = MFMA32(frag_rm(Kt, TP, 32 * jb, 16 * ks, lane), frag_rm(Qt, TP, 32 * wi, 16 * ks, lane), X);
        int iql = iq - 32 * jb; asm volatile("" : "+v"(iql));
#pragma unroll
        for (int r = 0; r < 16; ++r) { const int d = iql - crow(r, h); const int ad = d < 0 ? -d : d;
            const float wgt = __builtin_amdgcn_exp2f((d > 0 ? lgf : lgb) * (float)ad) * (d == 0 ? 2.0f : 1.0f);
            X[r] *= wgt * 0.08838834764831845f; }
        const bf16x8 pa0 = pack_step(X, 0), pa1 = pack_step(X, 1);
        Y0 = MFMA32(pa0, frag_tr<true>(Vt, TP, 32 * jb, 64 * wh, lane), Y0);
        Y0 = MFMA32(pa1, frag_tr<true>(Vt, TP, 32 * jb + 16, 64 * wh, lane), Y0);
        Y1 = MFMA32(pa0, frag_tr<true>(Vt, TP, 32 * jb, 64 * wh + 32, lane), Y1);
        Y1 = MFMA32(pa1, frag_tr<true>(Vt, TP, 32 * jb + 16, 64 * wh + 32, lane), Y1);
    }
    __syncthreads();
    { const bf16* Sf = wsp<bf16>(F, WS_ST) + ((size_t)((b * 8 + hh) * 2 + 0) * 18 + jF) * ST_CHUNK; const bf16* Sb = wsp<bf16>(F, WS_ST) + ((size_t)((b * 8 + hh) * 2 + 1) * 18 + jF) * ST_CHUNK;
      load_tile128(Kt, Sf, 128, F.tid); load_tile128(Vt, Sb, 128, F.tid); }
    __syncthreads();
    {
        f32x16 T0 = zero16(), T1 = zero16(), U0 = zero16(), U1 = zero16();
#pragma unroll
        for (int ks = 0; ks < 8; ++ks) { const bf16x8 a = frag_rm(Qt, TP, 32 * wi, 16 * ks, lane);
            T0 = MFMA32(a, frag_rm(Kt, TP, 64 * wh, 16 * ks, lane), T0); T1 = MFMA32(a, frag_rm(Kt, TP, 64 * wh + 32, 16 * ks, lane), T1);
            U0 = MFMA32(a, frag_rm(Vt, TP, 64 * wh, 16 * ks, lane), U0); U1 = MFMA32(a, frag_rm(Vt, TP, 64 * wh + 32, 16 * ks, lane), U1); }
#pragma unroll
        for (int r = 0; r < 16; ++r) { const int i = 32 * wi + crow(r, h);
            const float ff = __builtin_amdgcn_exp2f(lgf * (float)(i + 1)), fb = __builtin_amdgcn_exp2f(lgb * (float)(128 - i));
            Y0[r] += ff * T0[r] + fb * U0[r]; Y1[r] += ff * T1[r] + fb * U1[r]; }
    }
    __syncthreads();
    LAS float* yl = (LAS float*)F.lds;
#pragma unroll
    for (int r = 0; r < 16; ++r) { const int i = 32 * wi + crow(r, h); yl[i * 132 + 64 * wh + (lane & 31)] = Y0[r]; yl[i * 132 + 64 * wh + 32 + (lane & 31)] = Y1[r]; }
    __syncthreads();
    { const int i = F.tid >> 2, part = F.tid & 3; const LAS float* yr = yl + i * 132 + 32 * part;
      f32x4 v[8]; float s = 0.f;
#pragma unroll
      for (int e = 0; e < 8; ++e) { v[e] = *(const LAS f32x4*)(yr + 4 * e); s += (v[e].x + v[e].y) + (v[e].z + v[e].w); }
      s += shx(s, 1, lane); s += shx(s, 2, lane); const float mean = s * (1.0f / 128.0f); float q = 0.f;
#pragma unroll
      for (int e = 0; e < 8; ++e) { v[e] = v[e] - mean; q += (v[e].x * v[e].x + v[e].y * v[e].y) + (v[e].z * v[e].z + v[e].w * v[e].w); }
      q += shx(q, 1, lane); q += shx(q, 2, lane); const float rs = 1.0f / sqrtf(q * (1.0f / 128.0f) + 1e-5f);
      const bf16* gp = P + (size_t)(row0 + i) * LDP + C_RET + 3072 + hh * 128 + 32 * part; bf16* yo = wsp<bf16>(F, WS_Y) + (size_t)(row0 + i) * 3072 + hh * 128 + 32 * part;
#pragma unroll
      for (int e2 = 0; e2 < 4; ++e2) { const u32x4 gw = *(const u32x4*)(gp + 8 * e2); u32x4 ow;
#pragma unroll
          for (int e = 0; e < 4; ++e) { const float g0 = bf_lo(gw[e]), g1 = bf_hi(gw[e]); const int vi = 2 * e2 + (e >> 1), vo = 2 * (e & 1);
              ow[e] = cvtpk(g0 * sigm(g0) * v[vi][vo] * rs, g1 * sigm(g1) * v[vi][vo + 1] * rs); }
          *(u32x4*)(yo + 8 * e2) = ow; } }
}

#ifdef RW_DEBUG
constexpr size_t WS_DBGY = WS_END;
struct RwPre { f32x4 r4, k4, v4, lw, la; };
__device__ __forceinline__ void rwkv_scan_unit(Frame& F, int layer, int unit) {
    const int rh = unit & 1, dir = (unit >> 1) & 1, h = (unit >> 2) & 15, b = unit >> 6;
    constexpr int BUF = 6 * 2048 + 1024;
    LAS float* const base = (LAS float*)F.lds;
    const float* XS = wsp<float>(F, WS_XS); const float* LR = wsp<float>(F, WS_LR); float* YD = wsp<float>(F, WS_DBGY) + (size_t)dir * MT * BW;
    const int vrow = F.tid >> 4, kq = F.tid & 15;
    const int ptok = F.tid >> 4, pj = (F.tid & 15) * 4, pc = h * 64 + pj;
    const f32x4 w0v = *(const f32x4*)(inp(F, I_W0) + ((size_t)layer * 2 + dir) * BW + pc), a0v = *(const f32x4*)(inp(F, I_A0) + ((size_t)layer * 2 + dir) * BW + pc);
    const f32x4 kkv = *(const f32x4*)(inp(F, I_KK) + (size_t)layer * BW + pc), kav = *(const f32x4*)(inp(F, I_KA) + (size_t)layer * BW + pc);
    auto fetch = [&](int blk, RwPre& p) {
        const int row = scan_row(b, dir, blk * SCAN_BLK + ptok);
        p.r4 = *(const f32x4*)(XS + (size_t)row * 3072 + pc); p.k4 = *(const f32x4*)(XS + (size_t)row * 3072 + 1024 + pc); p.v4 = *(const f32x4*)(XS + (size_t)row * 3072 + 2048 + pc);
        p.lw = *(const f32x4*)(LR + (size_t)row * NLR + dir * 1024 + pc); p.la = *(const f32x4*)(LR + (size_t)row * NLR + 2048 + dir * 1024 + pc);
    };
    auto derive = [&](const RwPre& p, LAS float* buf) {
        f32x4 dec, av, kk, kd; float ssq = 0.f;
#pragma unroll
        for (int e = 0; e < 4; ++e) { dec[e] = __expf(-0.6065306597126334f * sigm(w0v[e] + p.lw[e])); av[e] = sigm(a0v[e] + p.la[e]); kk[e] = p.k4[e] * kkv[e]; ssq += kk[e] * kk[e];
            kd[e] = p.k4[e] * (1.0f + (av[e] - 1.0f) * kav[e]); }
        ssq += __int_as_float(__builtin_amdgcn_update_dpp(0, __float_as_int(ssq), 0xB1, 0xF, 0xF, true));
        ssq += __int_as_float(__builtin_amdgcn_update_dpp(0, __float_as_int(ssq), 0x4E, 0xF, 0xF, true));
        ssq += __int_as_float(__builtin_amdgcn_update_dpp(0, __float_as_int(ssq), 0x141, 0xF, 0xF, true));
        ssq += __int_as_float(__builtin_amdgcn_update_dpp(0, __float_as_int(ssq), 0x140, 0xF, 0xF, true));
        const float inv = 1.0f / fmaxf(sqrtf(ssq), 1e-12f);
        f32x4 an, bn;
#pragma unroll
        for (int e = 0; e < 4; ++e) { const float kn = kk[e] * inv; an[e] = -kn; bn[e] = kn * av[e]; }
        const int o = ptok * 64 + pj;
        *(LAS f32x4*)(buf + o) = p.r4; *(LAS f32x4*)(buf + 2048 + o) = dec; *(LAS f32x4*)(buf + 4096 + o) = kd; *(LAS f32x4*)(buf + 6144 + o) = p.v4; *(LAS f32x4*)(buf + 8192 + o) = an; *(LAS f32x4*)(buf + 10240 + o) = bn;
    };
    f32x2 S0 = {0.f, 0.f}, S1 = S0;
    RwPre pre;
    __syncthreads();
    fetch(0, pre); derive(pre, base);
    __syncthreads();
    constexpr int NBLK = NSTEP / SCAN_BLK;
    for (int blk = 0; blk < NBLK; ++blk) {
        LAS float* cur = base + (blk & 1) * BUF; LAS float* nxt = base + ((blk + 1) & 1) * BUF;
        if (blk + 1 < NBLK) fetch(blk + 1, pre);
        const LAS float* Rl = cur; const LAS float* Wl = cur + 2048; const LAS float* Kl = cur + 4096; const LAS float* Vl = cur + 6144; const LAS float* Al = cur + 8192; const LAS float* Bl = cur + 10240; LAS float* Yl = cur + 12288;
        const int ob = 4 * kq, vb = 32 * rh + vrow;
        f32x4 a0 = *(const LAS f32x4*)(Al + ob), w0 = *(const LAS f32x4*)(Wl + ob), b0 = *(const LAS f32x4*)(Bl + ob), k0 = *(const LAS f32x4*)(Kl + ob), r0 = *(const LAS f32x4*)(Rl + ob);
        float vv = Vl[vb];
#pragma unroll 8
        for (int tok = 0; tok < SCAN_BLK; ++tok) {
            const int on = ((tok + 1) & (SCAN_BLK - 1)) * 64;
            const f32x4 a1 = *(const LAS f32x4*)(Al + on + ob), w1 = *(const LAS f32x4*)(Wl + on + ob), b1 = *(const LAS f32x4*)(Bl + on + ob), k1 = *(const LAS f32x4*)(Kl + on + ob), r1 = *(const LAS f32x4*)(Rl + on + ob);
            const float vn = Vl[on + vb];
            f32x2 t = S0 * a0.xy; t += S1 * a0.zw;
            const float sa = red16(t.x + t.y);
            const f32x2 sa2 = {sa, sa}, vv2 = {vv, vv};
            S0 = S0 * w0.xy + (sa2 * b0.xy + vv2 * k0.xy); S1 = S1 * w0.zw + (sa2 * b0.zw + vv2 * k0.zw);
            f32x2 u = S0 * r0.xy; u += S1 * r0.zw;
            const float y = red16(u.x + u.y);
            Yl[tok * 32 + vrow] = y;
            a0 = a1; w0 = w1; b0 = b1; k0 = k1; r0 = r1; vv = vn;
        }
        if (blk + 1 < NBLK) derive(pre, nxt);
        __syncthreads();
        if (F.tid < 256) { const int e = F.tid * 4, tok = e >> 5, j = e & 31; const int row = scan_row(b, dir, blk * SCAN_BLK + tok);
          *(f32x4*)(YD + (size_t)row * BW + h * 64 + 32 * rh + j) = *(const LAS f32x4*)(Yl + e); }
    }
    __syncthreads();
}
#endif
constexpr int RW_NCH = 36, RW_NU = NB * 16 * 2 * RW_NCH;
constexpr int RWP = 144;
constexpr int RWS = 64 * RWP;
__device__ __forceinline__ int rw_row0(int b, int jF) { return jF < 4 ? ML + b * TCX + 64 * jF : b * TL + 64 * (jF - 4); }
enum { RM = 0, TR = 1 };
template <int AM, int BM_> __device__ __forceinline__ f32x16 mm64(const LAS unsigned char* A, const LAS unsigned char* B, int tb, int sb, int lane, f32x16 acc) {
#pragma unroll
    for (int ks = 0; ks < 4; ++ks) {
        const bf16x8 a = AM == RM ? frag_rm(A, RWP, 32 * tb, 16 * ks, lane) : frag_tr<false>(A, RWP, 16 * ks, 32 * tb, lane);
        const bf16x8 b = BM_ == RM ? frag_rm(B, RWP, 32 * sb, 16 * ks, lane) : frag_tr<false>(B, RWP, 16 * ks, 32 * sb, lane);
        acc = MFMA32(a, b, acc); }
    return acc;
}
__device__ __forceinline__ void store_tile_bf16(LAS unsigned char* T, const f32x16& x, int tb, int sb, int lane) {
    const int h = lane >> 5; LAS unsigned short* p = (LAS unsigned short*)(T + (32 * tb) * RWP) + 32 * sb + (lane & 31);
#pragma unroll
    for (int r = 0; r < 16; ++r) p[crow(r, h) * (RWP / 2)] = (unsigned short)(cvtpk(x[r], 0.f) & 0xffffu);
}
__device__ __forceinline__ bf16x8 gfrag_perm(const bf16* X, int ld, int m0, int k0, int lane) {
    const bf16* p = X + (size_t)(m0 + (lane & 31)) * ld + k0 + 4 * (lane >> 5);
    const u32x2 lo = *(const u32x2*)p, hi = *(const u32x2*)(p + 8);
    u32x4 w; w.x = lo.x; w.y = lo.y; w.z = hi.x; w.w = hi.y; return __builtin_bit_cast(bf16x8, w);
}
template <bool REV> __device__ __forceinline__ void tri_inv16(const LAS float* AD, LAS unsigned char* T, int lane_) {
    int lane = lane_; asm volatile("" : "+v"(lane));
    const int blk = lane >> 4, j = lane & 15; const LAS float* A = AD + blk * 16 * 20;
    float x[16];
#pragma unroll
    for (int i = 0; i < 16; ++i) { const int t = REV ? 15 - i : i; float a0 = (j == t) ? 1.0f : 0.0f, a1 = 0.0f;
#pragma unroll
        for (int s4 = 0; s4 < 16; s4 += 4) { if (REV ? (s4 + 3 > t) : (s4 < t)) { const f32x4 a = *(const LAS f32x4*)(A + t * 20 + s4);
#pragma unroll
                for (int e = 0; e < 4; ++e) { const int s = s4 + e; if (REV ? (s > t) : (s < t)) { if (e & 1) a1 = fmaf(a[e], x[s], a1); else a0 = fmaf(a[e], x[s], a0); } } } }
        x[t] = a0 + a1; asm volatile("" ::: "memory"); }
    LAS unsigned short* tp = (LAS unsigned short*)T + (16 * blk) * (RWP / 2) + 16 * blk + j;
#pragma unroll
    for (int s = 0; s < 16; ++s) tp[s * (RWP / 2)] = (unsigned short)(cvtpk(x[s], 0.f) & 0xffffu);
}
struct RwIn { f32x4 x[6]; f32x4 l[4]; };
__device__ __forceinline__ void rw_fetch_x(Frame& F, int unit, int tid, RwIn& p) {
    const int jF = unit % RW_NCH, hh = (unit / RW_NCH) & 15, b = unit / (RW_NCH * 16);
    const float* xr = wsp<float>(F, WS_XS) + (size_t)(rw_row0(b, jF) + (tid >> 3)) * 3072 + hh * 64 + (tid & 7) * 8;
    p.x[0] = *(const f32x4*)xr; p.x[1] = *(const f32x4*)(xr + 4); p.x[2] = *(const f32x4*)(xr + 1024); p.x[3] = *(const f32x4*)(xr + 1028); p.x[4] = *(const f32x4*)(xr + 2048); p.x[5] = *(const f32x4*)(xr + 2052);
}
__device__ __forceinline__ void rw_fetch_l(Frame& F, int unit, int dir, int tid, RwIn& p) {
    const int jF = unit % RW_NCH, hh = (unit / RW_NCH) & 15, b = unit / (RW_NCH * 16);
    const float* lr = wsp<float>(F, WS_LR) + (size_t)(rw_row0(b, jF) + (tid >> 3)) * NLR + dir * 1024 + hh * 64 + (tid & 7) * 8;
    p.l[0] = *(const f32x4*)lr; p.l[1] = *(const f32x4*)(lr + 4); p.l[2] = *(const f32x4*)(lr + 2048); p.l[3] = *(const f32x4*)(lr + 2052);
}
__device__ __forceinline__ void rw_local_unit(Frame& F, int layer, int unit, int unit_next, RwIn& in) {
    const int jF = unit % RW_NCH, hh = (unit / RW_NCH) & 15, b = unit / (RW_NCH * 16);
    const int row0 = rw_row0(b, jF);
    LAS unsigned char* const L = F.lds;
    LAS unsigned char* sAh = L; LAS unsigned char* sRh = L + RWS; LAS unsigned char* sBh = L + 2 * RWS; LAS unsigned char* sKh = L + 3 * RWS; LAS unsigned char* sBt = L + 4 * RWS; LAS unsigned char* sKt = L + 5 * RWS;
    LAS unsigned char* sV = L + 6 * RWS; LAS unsigned char* sAAK = L + 7 * RWS; LAS unsigned char* sARB = L + 8 * RWS; LAS unsigned char* sARK = L + 9 * RWS; LAS unsigned char* sPm = L + 10 * RWS; LAS unsigned char* sTm = L + 11 * RWS;
    LAS unsigned char* sM1 = sAAK; LAS unsigned char* sVT = sKh; LAS unsigned char* sWW = sPm;
    LAS float* CL = (LAS float*)(L + 12 * RWS);
    const int w = F.wave, grp = w >> 2, tb = (w >> 1) & 1, sb = w & 1;
    float r8[8], k8[8], kn8[8];
    { int tl_ = F.tid; asm volatile("" : "+v"(tl_)); const int t = tl_ >> 3, j0 = (tl_ & 7) * 8, c0 = hh * 64 + j0;
      const f32x4 ra = in.x[0], rb = in.x[1], ka = in.x[2], kb = in.x[3], va = in.x[4], vb = in.x[5];
      const f32x4 kka = *(const f32x4*)(inp(F, I_KK) + layer * BW + c0), kkb = *(const f32x4*)(inp(F, I_KK) + layer * BW + c0 + 4);
      float ssq = 0.f;
#pragma unroll
      for (int e = 0; e < 4; ++e) { r8[e] = ra[e]; r8[4 + e] = rb[e]; k8[e] = ka[e]; k8[4 + e] = kb[e]; kn8[e] = ka[e] * kka[e]; kn8[4 + e] = kb[e] * kkb[e]; }
#pragma unroll
      for (int e = 0; e < 8; ++e) ssq += kn8[e] * kn8[e];
      ssq = red8(ssq); const float inv = 1.0f / fmaxf(sqrtf(ssq), 1e-12f);
#pragma unroll
      for (int e = 0; e < 8; ++e) kn8[e] *= inv;
      __syncthreads();
      u32x4 vw; vw.x = cvtpk(va[0], va[1]); vw.y = cvtpk(va[2], va[3]); vw.z = cvtpk(vb[0], vb[1]); vw.w = cvtpk(vb[2], vb[3]);
      *(LAS u32x4*)(sV + t * RWP + j0 * 2) = vw; }
    for (int dir = 0; dir < 2; ++dir) {
        const int ui = ((b * 16 + hh) * 2 + dir) * RW_NCH + jF;
        int tl_ = F.tid; asm volatile("" : "+v"(tl_)); const int t = tl_ >> 3, j0 = (tl_ & 7) * 8, c0 = hh * 64 + j0;
        float lw8[8], as8[8];
        { const f32x4 wa = in.l[0], wb = in.l[1], aa = in.l[2], ab = in.l[3];
          const float* w0p = inp(F, I_W0) + ((size_t)layer * 2 + dir) * BW + c0; const float* a0p = inp(F, I_A0) + ((size_t)layer * 2 + dir) * BW + c0;
          const f32x4 w0a = *(const f32x4*)w0p, w0b = *(const f32x4*)(w0p + 4), a0a = *(const f32x4*)a0p, a0b = *(const f32x4*)(a0p + 4);
#pragma unroll
          for (int e = 0; e < 4; ++e) { lw8[e] = -0.6065306597126334f * sigm(w0a[e] + wa[e]); lw8[4 + e] = -0.6065306597126334f * sigm(w0b[e] + wb[e]); as8[e] = sigm(a0a[e] + aa[e]); as8[4 + e] = sigm(a0b[e] + ab[e]); } }
        float cl8[8], ce8[8];
        { const int ln = F.lane;
#pragma unroll
          for (int e = 0; e < 8; ++e) cl8[e] = lw8[e];
#pragma unroll
          for (int d = 8; d < 64; d <<= 1) {
#pragma unroll
              for (int e = 0; e < 8; ++e) { const float o = shx_from(cl8[e], dir ? ln + d : ln - d); cl8[e] += (dir ? (ln + d < 64) : (ln >= d)) ? o : 0.f; } }
          LAS float* WT = CL;
          if ((ln >> 3) == (dir ? 0 : 7)) { *(LAS f32x4*)(WT + w * 64 + j0) = (f32x4){cl8[0], cl8[1], cl8[2], cl8[3]}; *(LAS f32x4*)(WT + w * 64 + j0 + 4) = (f32x4){cl8[4], cl8[5], cl8[6], cl8[7]}; }
          __syncthreads();
#pragma unroll
          for (int e = 0; e < 8; ++e) ce8[e] = 0.f;
#pragma unroll
          for (int ww = 0; ww < 8; ++ww) { const f32x4 a = *(const LAS f32x4*)(WT + ww * 64 + j0), b2 = *(const LAS f32x4*)(WT + ww * 64 + j0 + 4); const bool before = dir ? ww > w : ww < w;
#pragma unroll
              for (int e = 0; e < 4; ++e) { ce8[e] += a[e]; ce8[4 + e] += b2[e]; if (before) { cl8[e] += a[e]; cl8[4 + e] += b2[e]; } } }
          if (t == 0) { float* gm = wsp<float>(F, WS_RWG) + (size_t)ui * 64 + j0;
              *(f32x4*)gm = (f32x4){__expf(ce8[0]), __expf(ce8[1]), __expf(ce8[2]), __expf(ce8[3])}; *(f32x4*)(gm + 4) = (f32x4){__expf(ce8[4]), __expf(ce8[5]), __expf(ce8[6]), __expf(ce8[7])}; } }
        { const float* kap = inp(F, I_KA) + layer * BW + c0; const f32x4 kaa = *(const f32x4*)kap, kab = *(const f32x4*)(kap + 4);
          float oA[8], oR[8], oB[8], oK[8], oBt[8], oKt[8];
#pragma unroll
          for (int e = 0; e < 8; ++e) { const float cl = cl8[e], ce = ce8[e], kav = e < 4 ? kaa[e] : kab[e - 4];
              const float ex = __expf(cl), exm = __expf(-cl), exx = __expf(cl - lw8[e]), ext = __expf(ce - cl);
              const float kd = k8[e] * (1.0f + (as8[e] - 1.0f) * kav), bb = kn8[e] * as8[e];
              oA[e] = -kn8[e] * exx; oR[e] = r8[e] * ex; oB[e] = bb * exm; oK[e] = kd * exm; oBt[e] = bb * ext; oKt[e] = kd * ext; }
          const int o = t * RWP + j0 * 2;
#define RW_ST8(slot, a) do { u32x4 q_; q_.x = cvtpk(a[0], a[1]); q_.y = cvtpk(a[2], a[3]); q_.z = cvtpk(a[4], a[5]); q_.w = cvtpk(a[6], a[7]); *(LAS u32x4*)((slot) + o) = q_; } while (0)
          RW_ST8(sAh, oA); RW_ST8(sRh, oR); RW_ST8(sBh, oB); RW_ST8(sKh, oK); RW_ST8(sBt, oBt); RW_ST8(sKt, oKt);
#undef RW_ST8
        }
        if (dir == 0) rw_fetch_l(F, unit, 1, tl_, in);
        else if (unit_next >= 0) { rw_fetch_x(F, unit_next, tl_, in); rw_fetch_l(F, unit_next, 0, tl_, in); }
        __syncthreads();
        int lane = F.lane; asm volatile("" : "+v"(lane)); const int h = lane >> 5;
        const int tq = 32 * tb + 4 * h, sq = 32 * sb + (lane & 31);
        LAS float* AD16 = CL + 1024;
        const int pB = dir ? 0 : 1, qB = 1 - pB;
        if (grp == 0) {
            f32x16 X1 = mm64<RM, RM>(sAh, sBh, tb, sb, lane, zero16()), X2 = mm64<RM, RM>(sAh, sKh, tb, sb, lane, zero16());
#pragma unroll
            for (int r = 0; r < 16; ++r) { const int d = (tq + (r & 3) + 8 * (r >> 2)) - sq; const bool keep = (dir ? -d : d) > 0; X1[r] = keep ? X1[r] : 0.f; X2[r] = keep ? X2[r] : 0.f; }
            __syncthreads();
            store_tile_bf16(sAAK, X2, tb, sb, lane);
            { f32x16 A1, A2; const int sl = lane & 31;
#pragma unroll
              for (int r = 0; r < 16; ++r) { const int tl = (r & 3) + 8 * (r >> 2) + 4 * h; const bool same16 = (tl >> 4) == (sl >> 4);
                  A1[r] = (tb == sb && !same16) ? X1[r] : 0.f; A2[r] = (tb == pB && sb == qB) ? X1[r] : 0.f;
                  if (tb == sb && same16) AD16[((2 * tb + (tl >> 4)) * 16 + (tl & 15)) * 20 + (sl & 15)] = X1[r]; }
              store_tile_bf16(sPm, A1, tb, sb, lane); store_tile_bf16(sKh, A2, tb, sb, lane); store_tile_bf16(sTm, zero16(), tb, sb, lane); }
            __syncthreads();
            if (w == 0) { if (dir == 0) tri_inv16<false>(AD16, sTm, lane); else tri_inv16<true>(AD16, sTm, lane); }
            __syncthreads();
#pragma unroll 1
            for (int lvl = 0; lvl < 2; ++lvl) {
                f32x16 Mx = mm64<RM, TR>(lvl == 0 ? sPm : sKh, sTm, tb, sb, lane, zero16());
#pragma unroll
                for (int r = 0; r < 16; ++r) { const int d = (tq + (r & 3) + 8 * (r >> 2)) - sq; Mx[r] += d == 0 ? 1.0f : 0.f; }
                __syncthreads();
                store_tile_bf16(sBh, Mx, tb, sb, lane);
                __syncthreads();
                const f32x16 Tn = mm64<RM, TR>(sTm, sBh, tb, sb, lane, zero16());
                __syncthreads();
                store_tile_bf16(sTm, Tn, tb, sb, lane);
                __syncthreads();
            }
            { const f32x16 Wt = mm64<RM, TR>(sTm, sAh, tb, sb, lane, zero16()); store_tile_bf16(sWW, Wt, tb, sb, lane); }
            __syncthreads();
            { f32x16 QtT = mm64<TR, RM>(sWW, sARB, tb, sb, lane, zero16());
#pragma unroll
              for (int r = 0; r < 16; ++r) QtT[r] += bf2f(((const LAS unsigned short*)(sRh + sq * RWP))[32 * tb + crow(r, h)]);
              int l4 = lane; asm volatile("" : "+v"(l4));
              u32x4* qo = (u32x4*)(wsp<bf16>(F, WS_RWQ) + (size_t)ui * 4096) + ((sb * 2 + tb) * 2) * 64 + l4;
              qo[0] = __builtin_bit_cast(u32x4, pack_step(QtT, 0)); qo[64] = __builtin_bit_cast(u32x4, pack_step(QtT, 1));
              const f32x16 PpT = mm64<TR, TR>(sWW, sBt, tb, sb, lane, zero16());
              u32x4* po = (u32x4*)(wsp<bf16>(F, WS_RWP) + (size_t)ui * 4096) + ((sb * 2 + tb) * 2) * 64 + l4;
              po[0] = __builtin_bit_cast(u32x4, pack_step(PpT, 0)); po[64] = __builtin_bit_cast(u32x4, pack_step(PpT, 1)); }
            __syncthreads();
        } else {
            f32x16 X1 = mm64<RM, RM>(sRh, sBh, tb, sb, lane, zero16()), X2 = mm64<RM, RM>(sRh, sKh, tb, sb, lane, zero16());
#pragma unroll
            for (int r = 0; r < 16; ++r) { const int d = (tq + (r & 3) + 8 * (r >> 2)) - sq; const bool keep = (dir ? -d : d) >= 0; X1[r] = keep ? X1[r] : 0.f; X2[r] = keep ? X2[r] : 0.f; }
            __syncthreads();
            store_tile_bf16(sARB, X1, tb, sb, lane); store_tile_bf16(sARK, X2, tb, sb, lane);
            __syncthreads();
            X1 = mm64<RM, TR>(sAAK, sV, tb, sb, lane, zero16());
            f32x16 accY = mm64<RM, TR>(sARK, sV, tb, sb, lane, zero16()), accH = mm64<TR, TR>(sKt, sV, tb, sb, lane, zero16());
            __syncthreads();
            store_tile_bf16(sM1, X1, tb, sb, lane);
#pragma unroll 1
            for (int i = 0; i < 8; ++i) __syncthreads();
            { const f32x16 Vx = mm64<RM, TR>(sTm, sM1, tb, sb, lane, zero16()); store_tile_bf16(sVT, Vx, tb, sb, lane); }
            __syncthreads();
            accY = mm64<RM, TR>(sARB, sVT, tb, sb, lane, accY); accH = mm64<TR, TR>(sBt, sVT, tb, sb, lane, accH);
            int l4 = lane; asm volatile("" : "+v"(l4));
            f32x4* yo = (f32x4*)(wsp<float>(F, WS_RWY) + (size_t)ui * 4096 + (tb * 2 + sb) * 1024 + l4 * 16);
            f32x4* ho = (f32x4*)(wsp<float>(F, WS_RWH) + (size_t)ui * 4096 + (tb * 2 + sb) * 1024 + l4 * 16);
#pragma unroll
            for (int g = 0; g < 4; ++g) { yo[g] = (f32x4){accY[4 * g], accY[4 * g + 1], accY[4 * g + 2], accY[4 * g + 3]}; ho[g] = (f32x4){accH[4 * g], accH[4 * g + 1], accH[4 * g + 2], accH[4 * g + 3]}; }
            __syncthreads();
        }
    }
}
struct RwStep { bf16x8 pf[2][2][2]; f32x4 hh[2][4]; f32x4 gm[2][4]; };
__device__ __forceinline__ void rw_seq_task(Frame& F, int task, int lane) {
    const int vb = task & 1, dir = (task >> 1) & 1, bh = task >> 2, h = lane >> 5;
    auto fetch = [&](int c, RwStep& s) {
        const int jF = dir == 0 ? c : (c < 4 ? 3 - c : 39 - c); const size_t ui = (size_t)(bh * 2 + dir) * RW_NCH + jF;
        const bf16* pp = wsp<bf16>(F, WS_RWP) + ui * 4096; const float* hp = wsp<float>(F, WS_RWH) + ui * 4096; const float* gp = wsp<float>(F, WS_RWG) + ui * 64;
#pragma unroll
        for (int ko = 0; ko < 2; ++ko) {
#pragma unroll
            for (int ki = 0; ki < 2; ++ki) { const u32x4* pq = (const u32x4*)pp + ((ko * 2 + ki) * 2) * 64 + lane; s.pf[ko][ki][0] = __builtin_bit_cast(bf16x8, pq[0]); s.pf[ko][ki][1] = __builtin_bit_cast(bf16x8, pq[64]); }
#pragma unroll
            for (int g = 0; g < 4; ++g) { s.hh[ko][g] = *(const f32x4*)(hp + (ko * 2 + vb) * 1024 + lane * 16 + 4 * g); s.gm[ko][g] = *(const f32x4*)(gp + 32 * ko + 8 * g + 4 * h); } }
    };
    f32x16 S0 = zero16(), S1 = zero16(); unsigned touch = 0u;
    RwStep cur; fetch(0, cur);
#pragma unroll 1
    for (int c = 0; c < RW_NCH; ++c) {
        RwStep nxt; fetch(c + 1 < RW_NCH ? c + 1 : c, nxt);
        { const int cf = c + 3 < RW_NCH ? c + 3 : RW_NCH - 1; const int jf = dir == 0 ? cf : (cf < 4 ? 3 - cf : 39 - cf); const size_t uf = (size_t)(bh * 2 + dir) * RW_NCH + jf;
          const unsigned t0 = *(const unsigned*)((const char*)(wsp<bf16>(F, WS_RWP) + uf * 4096) + lane * 128);
          const unsigned t1 = *(const unsigned*)((const char*)(wsp<float>(F, WS_RWH) + uf * 4096 + ((lane >> 5) * 2 + vb) * 1024) + (lane & 31) * 128);
          touch ^= t0 ^ t1; }
        const int jF = dir == 0 ? c : (c < 4 ? 3 - c : 39 - c); const size_t ui = (size_t)(bh * 2 + dir) * RW_NCH + jF;
        const bf16x8 b00 = pack_step(S0, 0), b01 = pack_step(S0, 1), b10 = pack_step(S1, 0), b11 = pack_step(S1, 1);
        u32x4* so = (u32x4*)(wsp<bf16>(F, WS_RWS) + ui * 4096) + lane;
        so[((0 * 2 + vb) * 2 + 0) * 64] = __builtin_bit_cast(u32x4, b00); so[((0 * 2 + vb) * 2 + 1) * 64] = __builtin_bit_cast(u32x4, b01);
        so[((1 * 2 + vb) * 2 + 0) * 64] = __builtin_bit_cast(u32x4, b10); so[((1 * 2 + vb) * 2 + 1) * 64] = __builtin_bit_cast(u32x4, b11);
        f32x16 n0, n1;
#pragma unroll
        for (int r = 0; r < 16; ++r) { n0[r] = cur.hh[0][r >> 2][r & 3] + cur.gm[0][r >> 2][r & 3] * S0[r]; n1[r] = cur.hh[1][r >> 2][r & 3] + cur.gm[1][r >> 2][r & 3] * S1[r]; }
        n0 = MFMA32(cur.pf[0][0][0], b00, n0); n1 = MFMA32(cur.pf[1][0][0], b00, n1);
        n0 = MFMA32(cur.pf[0][0][1], b01, n0); n1 = MFMA32(cur.pf[1][0][1], b01, n1);
        n0 = MFMA32(cur.pf[0][1][0], b10, n0); n1 = MFMA32(cur.pf[1][1][0], b10, n1);
        n0 = MFMA32(cur.pf[0][1][1], b11, n0); n1 = MFMA32(cur.pf[1][1][1], b11, n1);
        S0 = n0; S1 = n1; cur = nxt;
    }
    if (touch == 0x9e3779b9u) wsp<unsigned>(F, WS_CTL)[CW_DBG + 64] = touch;
}
__device__ __forceinline__ void rw_out_unit(Frame& F, int layer, int unit) {
    const int jF = unit % RW_NCH, hh = (unit / RW_NCH) & 15, b = unit / (RW_NCH * 16);
    const int row0 = rw_row0(b, jF);
    const int lane = F.lane, h = lane >> 5, w = F.wave, dir = w >> 2, tb = (w >> 1) & 1, vb = w & 1;
    LAS float* YS = (LAS float*)F.lds;
    {
        const size_t ui = (size_t)((b * 16 + hh) * 2 + dir) * RW_NCH + jF;
        const float* yl = wsp<float>(F, WS_RWY) + ui * 4096 + (tb * 2 + vb) * 1024 + lane * 16;
        f32x16 acc;
#pragma unroll
        for (int g = 0; g < 4; ++g) { const f32x4 v = *(const f32x4*)(yl + 4 * g); acc[4 * g] = v.x; acc[4 * g + 1] = v.y; acc[4 * g + 2] = v.z; acc[4 * g + 3] = v.w; }
        const bf16* qt = wsp<bf16>(F, WS_RWQ) + ui * 4096; const u32x4* s0 = (const u32x4*)(wsp<bf16>(F, WS_RWS) + ui * 4096) + lane;
#pragma unroll
        for (int kb = 0; kb < 2; ++kb)
#pragma unroll
            for (int s = 0; s < 2; ++s) acc = MFMA32(__builtin_bit_cast(bf16x8, ((const u32x4*)qt)[((tb * 2 + kb) * 2 + s) * 64 + lane]), __builtin_bit_cast(bf16x8, s0[((kb * 2 + vb) * 2 + s) * 64]), acc);
        __syncthreads();
        LAS float* yd = YS + dir * 64 * 68 + (32 * tb) * 68 + 32 * vb + (lane & 31);
#pragma unroll
        for (int r = 0; r < 16; ++r) yd[crow(r, h) * 68] = acc[r];
    }
    __syncthreads();
    {
        const int t = F.tid >> 3, j0 = (F.tid & 7) * 8, c0 = hh * 64 + j0; const int row = row0 + t;
        const float* XS = wsp<float>(F, WS_XS) + (size_t)row * 3072 + c0; const float* LR = wsp<float>(F, WS_LR) + (size_t)row * NLR + c0;
        float y[8], s = 0.f;
#pragma unroll
        for (int e = 0; e < 2; ++e) { const f32x4 a = *(const LAS f32x4*)(YS + t * 68 + j0 + 4 * e), b2 = *(const LAS f32x4*)(YS + 64 * 68 + t * 68 + j0 + 4 * e);
#pragma unroll
            for (int q = 0; q < 4; ++q) { y[4 * e + q] = a[q] + b2[q]; s += y[4 * e + q]; } }
        const float mean = red8(s) * (1.0f / 64.0f); float q2 = 0.f;
#pragma unroll
        for (int e = 0; e < 8; ++e) { y[e] -= mean; q2 += y[e] * y[e]; }
        const float rs = 1.0f / sqrtf(red8(q2) * (1.0f / 64.0f) + 64e-5f);
        float dp = 0.f; float ov[8];
#pragma unroll
        for (int e = 0; e < 2; ++e) {
            const f32x4 r = *(const f32x4*)(XS + 4 * e), k = *(const f32x4*)(XS + 1024 + 4 * e);
            const f32x4 ka = *(const f32x4*)(inp(F, I_KA) + layer * BW + c0 + 4 * e), rk = *(const f32x4*)(inp(F, I_RK) + layer * BW + c0 + 4 * e);
            const f32x4 a0p = *(const f32x4*)(inp(F, I_A0) + ((size_t)layer * 2 + 0) * BW + c0 + 4 * e) + *(const f32x4*)(LR + 2048 + 4 * e);
            const f32x4 a1p = *(const f32x4*)(inp(F, I_A0) + ((size_t)layer * 2 + 1) * BW + c0 + 4 * e) + *(const f32x4*)(LR + 3072 + 4 * e);
#pragma unroll
            for (int q = 0; q < 4; ++q) dp += r[q] * (k[q] * (2.0f + (sigm(a0p[q]) + sigm(a1p[q]) - 2.0f) * ka[q])) * rk[q]; }
        const float dot = red8(dp);
#pragma unroll
        for (int e = 0; e < 2; ++e) { const f32x4 v = *(const f32x4*)(XS + 2048 + 4 * e), g = *(const f32x4*)(LR + 4096 + 4 * e), lng = *(const f32x4*)(inp(F, I_LNG) + layer * BW + c0 + 4 * e);
#pragma unroll
            for (int q = 0; q < 4; ++q) ov[4 * e + q] = (y[4 * e + q] * rs * lng[q] + dot * v[q]) * g[q]; }
        u32x4 o; o.x = cvtpk(ov[0], ov[1]); o.y = cvtpk(ov[2], ov[3]); o.z = cvtpk(ov[4], ov[5]); o.w = cvtpk(ov[6], ov[7]);
        *(u32x4*)(wsp<bf16>(F, WS_Y) + (size_t)row * 3072 + 2048 + c0) = o;
    }
}

__device__ __forceinline__ void mixa_phase(Frame& F, int layer) {
    constexpr int NU = NB * 16 * RW_NCH;
    if (F.wg < NU) { RwIn in; rw_fetch_x(F, F.wg, F.tid, in); rw_fetch_l(F, F.wg, 0, F.tid, in);
        for (int u = F.wg; u < NU; u += F.G) rw_local_unit(F, layer, u, u + F.G < NU ? u + F.G : -1, in); }
    __syncthreads();
}
__device__ __forceinline__ void mix_phase(Frame& F, int layer, int qidx, int mode = 3) {
#ifdef RW_DEBUG
    for (int u = F.wg; u < 256; u += F.G) rwkv_scan_unit(F, layer, u);
    __syncthreads();
#endif
    if (mode & 1) { if (F.wave < 4) for (int tk = F.wg * 4 + F.wave; tk < 256; tk += F.G * 4) rw_seq_task(F, tk, F.lane); }
    if (!(mode & 2)) return;
    const int nswa = (layer == NL - 1) ? 512 : 576;
    const int nitem = 256 + nswa;
    volatile LAS int* qslot = (volatile LAS int*)(F.lds + LDSCTL_OFF);
    for (;;) {
        __syncthreads();
        if (F.tid == 0) qslot[0] = (int)__hip_atomic_fetch_add(F.ctl + CW_SWAQ + 64 * qidx, 1u, __ATOMIC_RELAXED, __HIP_MEMORY_SCOPE_AGENT);
        __syncthreads();
        const int item = qslot[0];
        if (item >= nitem) break;
        if (item < 256) ret_state_unit(F, layer, item); else swa_unit(F, layer, item - 256);
    }
}
__device__ __forceinline__ void mixfin_phase(Frame& F, int layer, int nrows) {
    for (int u = F.wg; u < 576; u += F.G) { if (layer == NL - 1 && (u % 18) < 2) continue; ret_out_unit(F, layer, u); }
    __syncthreads();
    for (int u = F.wg; u < NB * 16 * RW_NCH; u += F.G) { if (layer == NL - 1 && (u % RW_NCH) < 4) continue; rw_out_unit(F, layer, u); }
    __syncthreads();
}

constexpr int NPH = 12;
constexpr int NSTEPS = 2 + NL * NPH + 1;
__global__ void __launch_bounds__(NTHR, 2) hyb_fwd(Args args) {
    extern __shared__ __attribute__((aligned(16))) unsigned char lds[];
    Frame F;
    F.lds = (LAS unsigned char*)lds;
    F.tid = threadIdx.x; F.lane = F.tid & 63; F.wave = __builtin_amdgcn_readfirstlane(F.tid >> 6);
    const int wv0 = F.wave;
    F.G = gridDim.x; F.wg = blockIdx.x; F.ws = args.ws; F.ctl = (unsigned*)(args.ws + WS_CTL);
    for (int u = F.tid; u < (LDS_BYTES - LDSCTL_OFF) / 4; u += NTHR) ((LAS unsigned*)(F.lds + LDSCTL_OFF))[u] = 0u;
    __syncthreads();
    if (F.tid < 26) { const __attribute__((address_space(4))) unsigned long long* kp = (const __attribute__((address_space(4))) unsigned long long*)__builtin_amdgcn_kernarg_segment_ptr();
        ((LAS unsigned long long*)(F.lds + PTAB_OFF))[F.tid] = kp[F.tid]; }
    __syncthreads();
    XcdBarrier bar = xcd_barrier_post(F.ctl + CW_BAR, (volatile LAS unsigned*)(F.lds + MISC_OFF) + 8);
    int lo = args.s_lo, hi = args.s_hi;
#define IN(k) (lo <= (k) && (k) < hi)
#define SL() asm volatile("" : "+s"(lo), "+s"(hi), "+s"(F.ws), "+s"(F.wg), "+s"(F.G))
#define LAUNDER() do { int t_ = wv0 * 64 + lane_now(); asm volatile("" : "+v"(t_)); F.tid = t_; F.lane = t_ & 63; F.wave = __builtin_amdgcn_readfirstlane(t_ >> 6); } while (0)
#define SEAM(k) do { SL(); if (IN(k) && IN((k) + 1)) xcd_barrier(bar, wv0 == 0 && lane_now() == 0); } while (0)
    SL(); if (IN(0)) { LAUNDER(); p0_prologue(F); }
#ifdef PROBE_P0
    SL(); if (IN(0)) { xcd_barrier(bar, wv0 == 0 && lane_now() == 0); LAUNDER(); p0_prologue(F); }
#endif
    SEAM(0);
    SL(); if (IN(1)) { LAUNDER(); p1_modreduce(F); }
    SEAM(1);
    for (int layer_ = 0; layer_ < NL; ++layer_) {
        int layer = layer_; asm volatile("" : "+s"(layer));
        const int s0 = 2 + layer * NPH;
        const int mrows = (layer == NL - 1) ? ML : MT;
        const float* modl = wsp<float>(F, WS_MOD) + (size_t)layer * 5 * 12288;
        SL(); if (IN(s0 + 0)) { LAUNDER(); norm_phase(F, layer, 0, MT, layer > 0); }
#if defined(PROBE_PHASE) && PROBE_PHASE == 0
        SL(); if (IN(s0 + 0)) { xcd_barrier(bar, wv0 == 0 && lane_now() == 0); LAUNDER(); norm_phase(F, layer, 0, MT, false); }
#endif
        SEAM(s0 + 0);
        SL(); if (IN(s0 + 1)) {
            pg8::Gemm g{wsp<bf16>(F, WS_U), wsp<bf16>(F, WS_WIN + layer * SZ_WIN), MT, LDP, DM, DM, DM}; pg8::StaticOrder S; S.init(MT, LDP, F.G, F.wg);
            pg8::EpiBf16<0> E{wsp<bf16>(F, WS_P), LDP};
            pg8::gemm_phase<pg8::EpiBf16<0>, pg8::StaticOrder, true, true>(F.lds, g, S, E, wv0);
#ifdef PROBE_GEMM2
            pg8::gemm_phase<pg8::EpiBf16<0>, pg8::StaticOrder, true, true>(F.lds, g, S, E, wv0);
#endif
        }
        SEAM(s0 + 1);
        SL(); if (IN(s0 + 2)) { LAUNDER(); prep_phase(F, layer); }
#if defined(PROBE_PHASE) && PROBE_PHASE == 2
        SL(); if (IN(s0 + 2)) { xcd_barrier(bar, wv0 == 0 && lane_now() == 0); LAUNDER(); prep_phase(F, layer); }
#endif
        SEAM(s0 + 2);
        SL(); if (IN(s0 + 3)) {
            pg8::Gemm g{wsp<bf16>(F, WS_ALR), wsp<bf16>(F, WS_WLR + layer * SZ_WLR), MT, NLR, KLR, KLR, KLR}; pg8::StaticOrder S; S.init(MT, NLR, F.G, F.wg);
            pg8::EpiF32 E{wsp<float>(F, WS_LR), NLR};
            pg8::gemm_phase<pg8::EpiF32, pg8::StaticOrder, true, true>(F.lds, g, S, E, wv0);
        }
        SEAM(s0 + 3);
        SL(); if (IN(s0 + 4)) { LAUNDER(); mixa_phase(F, layer); }
#if defined(PROBE_PHASE) && PROBE_PHASE == 4
        SL(); if (IN(s0 + 4)) { xcd_barrier(bar, wv0 == 0 && lane_now() == 0); LAUNDER(); mixa_phase(F, layer); }
#endif
        SEAM(s0 + 4);
        SL(); if (IN(s0 + 5)) { LAUNDER(); mix_phase(F, layer, layer); }
#ifdef PROBE_MIX
        SL(); if (IN(s0 + 5)) { xcd_barrier(bar, wv0 == 0 && lane_now() == 0); LAUNDER(); mix_phase(F, layer, layer + 4, PROBE_MIX); }
#endif
        SEAM(s0 + 5);
        SL(); if (IN(s0 + 6)) { LAUNDER(); mixfin_phase(F, layer, mrows); }
#if defined(PROBE_PHASE) && PROBE_PHASE == 6
        SL(); if (IN(s0 + 6)) { xcd_barrier(bar, wv0 == 0 && lane_now() == 0); LAUNDER(); mixfin_phase(F, layer, mrows); }
#endif
        SEAM(s0 + 6);
        SL(); if (IN(s0 + 7)) {
            const bf16* wbr = wsp<bf16>(F, WS_WBR + layer * SZ_WBR);
            pg8::StaticOrder S; S.init(mrows, DM, F.G, F.wg);
            { pg8::Gemm g{wsp<bf16>(F, WS_Y), wbr, mrows, DM, BW, 3072, BW}; pg8::EpiGate<0> E{wsp<bf16>(F, WS_P) + C_GATE, LDP, wsp<float>(F, WS_MGF), wsp<bf16>(F, WS_MG)};
              pg8::gemm_phase<pg8::EpiGate<0>, pg8::StaticOrder, true, true>(F.lds, g, S, E, wv0); }
            { pg8::Gemm g{wsp<bf16>(F, WS_Y) + 1024, wbr + (size_t)DM * BW, mrows, DM, BW, 3072, BW}; pg8::EpiGate<1> E{wsp<bf16>(F, WS_P) + C_GATE + 2048, LDP, wsp<float>(F, WS_MGF), wsp<bf16>(F, WS_MG)};
              pg8::gemm_phase<pg8::EpiGate<1>, pg8::StaticOrder, true, true>(F.lds, g, S, E, wv0); }
            { pg8::Gemm g{wsp<bf16>(F, WS_Y) + 2048, wbr + (size_t)2 * DM * BW, mrows, DM, BW, 3072, BW}; pg8::EpiGate<2> E{wsp<bf16>(F, WS_P) + C_GATE + 4096, LDP, wsp<float>(F, WS_MGF), wsp<bf16>(F, WS_MG)};
              pg8::gemm_phase<pg8::EpiGate<2>, pg8::StaticOrder, true, true>(F.lds, g, S, E, wv0); }
        }
        SEAM(s0 + 7);
        SL(); if (IN(s0 + 8)) {
            { pg8::Gemm g{wsp<bf16>(F, WS_MG), wsp<bf16>(F, WS_WOUT + layer * SZ_WOUT), ML, DM, DM, DM, DM}; pg8::StaticOrder S; S.init(ML, DM, F.G, F.wg);
              pg8::EpiResGate E{wsp<float>(F, WS_H), modl, 2 * DM};
              pg8::gemm_phase<pg8::EpiResGate, pg8::StaticOrder, true, true>(F.lds, g, S, E, wv0); }
            if (mrows > ML) { const int ks = (F.wg & 7) * (DM / 8);
              pg8::Gemm g{wsp<bf16>(F, WS_MG) + ks, wsp<bf16>(F, WS_WOUT + layer * SZ_WOUT) + ks, MT, DM, DM / 8, DM, DM}; pg8::SubKOrder S{F.G, F.wg};
              pg8::EpiResGatePart E{wsp<float>(F, WS_YDR), modl, 2 * DM, (int)(F.wg & 7)};
              pg8::gemm_phase<pg8::EpiResGatePart, pg8::SubKOrder, true, true>(F.lds, g, S, E, wv0); }
        }
        SEAM(s0 + 8);
        SL(); if (IN(s0 + 9)) { LAUNDER(); norm_phase(F, layer, 1, mrows, true); }
#if defined(PROBE_PHASE) && PROBE_PHASE == 9
        SL(); if (IN(s0 + 9)) { xcd_barrier(bar, wv0 == 0 && lane_now() == 0); LAUNDER(); norm_phase(F, layer, 1, mrows, false); }
#endif
        SEAM(s0 + 9);
        SL(); if (IN(s0 + 10)) {
            pg8::Gemm g{wsp<bf16>(F, WS_U), wsp<bf16>(F, WS_WFF1 + layer * SZ_WFF), mrows, DFF, DM, DM, DM}; pg8::StaticOrder S; S.init(mrows, DFF, F.G, F.wg);
            pg8::EpiBf16<2> E{wsp<bf16>(F, WS_F), DFF};
            pg8::gemm_phase<pg8::EpiBf16<2>, pg8::StaticOrder, true, true>(F.lds, g, S, E, wv0);
#ifdef PROBE_GEMM2
            pg8::gemm_phase<pg8::EpiBf16<2>, pg8::StaticOrder, true, true>(F.lds, g, S, E, wv0);
#endif
        }
        SEAM(s0 + 10);
        SL(); if (IN(s0 + 11)) {
            { pg8::Gemm g{wsp<bf16>(F, WS_F), wsp<bf16>(F, WS_WFF2 + layer * SZ_WFF), ML, DM, DFF, DFF, DFF}; pg8::StaticOrder S; S.init(ML, DM, F.G, F.wg);
              pg8::EpiResGate E{wsp<float>(F, WS_H), modl, 5 * DM};
              pg8::gemm_phase<pg8::EpiResGate, pg8::StaticOrder, true, true>(F.lds, g, S, E, wv0); }
            if (mrows > ML) { const int ks = (F.wg & 7) * (DFF / 8);
              pg8::Gemm g{wsp<bf16>(F, WS_F) + ks, wsp<bf16>(F, WS_WFF2 + layer * SZ_WFF) + ks, MT, DM, DFF / 8, DFF, DFF}; pg8::SubKOrder S{F.G, F.wg};
              pg8::EpiResGatePart E{wsp<float>(F, WS_YDR), modl, 5 * DM, (int)(F.wg & 7)};
              pg8::gemm_phase<pg8::EpiResGatePart, pg8::SubKOrder, true, true>(F.lds, g, S, E, wv0); }
        }
        SEAM(s0 + 11);
    }
    SL(); if (IN(NSTEPS - 1)) { LAUNDER(); final_norm(F, args.out); }
#undef IN
#undef SL
#undef LAUNDER
#undef SEAM
}

#ifndef MK_ONE_LAUNCH
#define MK_ONE_LAUNCH 1
#endif
extern "C" void kernel_launch(void* const* d_in, const int* in_sizes, int n_in, void* d_out, int out_size, void* d_ws, size_t ws_size, hipStream_t stream) {
    static int grid = 0;
    if (grid == 0) {
        if (n_in != 26 || out_size != ML * DM || ws_size < WS_END) { fprintf(stderr, "kernel_launch: unexpected shapes (n_in %d, out %d, ws %zu < %zu)\n", n_in, out_size, ws_size, (size_t)WS_END); grid = -1; return; }
        int dev = 0, cus = 0, per_cu = 0;
        if (hipGetDevice(&dev) != hipSuccess || hipDeviceGetAttribute(&cus, hipDeviceAttributeMultiprocessorCount, dev) != hipSuccess) { grid = -1; return; }
        if (hipFuncSetAttribute((const void*)hyb_fwd, hipFuncAttributeMaxDynamicSharedMemorySize, LDS_BYTES) != hipSuccess) { fprintf(stderr, "kernel_launch: hipFuncSetAttribute failed\n"); grid = -1; return; }
        if (hipOccupancyMaxActiveBlocksPerMultiprocessor(&per_cu, (const void*)hyb_fwd, NTHR, LDS_BYTES) != hipSuccess || per_cu < 1) fprintf(stderr, "kernel_launch: occupancy query reports %d\n", per_cu);
        (void)hipGetLastError();
        grid = cus;
    }
    if (grid < 0) return;
    if (hipMemsetAsync((char*)d_ws + WS_CTL, 0, CTL_ZERO_BYTES, stream) != hipSuccess) return;
    Args a{};
    for (int i = 0; i < 26; ++i) a.in[i] = (const float*)d_in[i];
    a.out = (float*)d_out; a.ws = (unsigned char*)d_ws;
#if MK_ONE_LAUNCH
    a.s_lo = 0; a.s_hi = NSTEPS;
    hipLaunchKernelGGL(hyb_fwd, dim3(grid), dim3(NTHR), LDS_BYTES, stream, a);
#else
    for (int s = 0; s < NSTEPS; ++s) { a.s_lo = s; a.s_hi = s + 1; hipLaunchKernelGGL(hyb_fwd, dim3(grid), dim3(NTHR), LDS_BYTES, stream, a); }
#endif
}
```

```cpp
#include <hip/hip_runtime.h>
#include <cstdio>
#include <cstdint>
__device__ __forceinline__ int lane_now() { int l; asm volatile("v_mbcnt_lo_u32_b32 %0, -1, 0\n\tv_mbcnt_hi_u32_b32 %0, -1, %0" : "=v"(l)); return l; }
namespace pg8 {
#define PG8_LAS __attribute__((address_space(3)))
typedef unsigned short bf16_t;
typedef short bf16x8 __attribute__((ext_vector_type(8)));
typedef float f32x4 __attribute__((ext_vector_type(4)));
typedef unsigned u32x4 __attribute__((ext_vector_type(4)));
constexpr int BM = 256, BK = 64, HALF = 128, HTB = HALF * BK * 2  , STAGE_BYTES = 8 * HTB, NXCD = 8, WGM = 8;

__host__ __device__ __forceinline__ int lds_byte(int r, int c) { const int st = (r >> 4) * 2 + (c >> 5), rr = r & 15, cc = c & 31, ob = rr * 64 + cc * 2; return st * 1024 + (ob ^ (((ob >> 9) & 1) << 5)); }
__host__ __device__ __forceinline__ void stage_rc(int b, int& R, int& C) { const int st = b / 1024, sb = b % 1024, swz = sb ^ (((sb >> 9) & 1) << 5); R = (st >> 1) * 16 + swz / 64; C = (st & 1) * 32 + (swz % 64) / 2; }
__host__ __device__ __forceinline__ int perm32(int rho) { const int n = rho >> 4, i = rho & 15; return 8 * (i >> 2) + 4 * n + (i & 3); }

struct Unit { int pm, pn; };
struct Gemm { const bf16_t* A; const bf16_t* Bt; int M, N, K, lda, ldb; };

struct StaticOrder {
    int nM, nN, nwg, G, c;
    __host__ __device__ void init(int M, int N, int G_, int c_) { nM = M / BM; nN = N / BM; nwg = nM * nN; G = G_; c = c_; }
    __host__ __device__ bool next(int i, Unit& u) const {
        const long L = (long)i * G + c; if (L >= nwg) return false;
        int wgid = (int)L; { const int q = nwg / NXCD, r = nwg % NXCD, xcd = wgid % NXCD, off = wgid / NXCD; wgid = (xcd < r ? xcd * (q + 1) : r * (q + 1) + (xcd - r) * q) + off; }
        const int nig = WGM * nN, gid = wgid / nig, fm = gid * WGM, gsz = (nM - fm) < WGM ? (nM - fm) : WGM;
        u.pm = fm + ((wgid % nig) % gsz); u.pn = (wgid % nig) / gsz; return true;
    }
    __device__ __forceinline__ void a_ready(const Unit&) const {}
    __device__ __forceinline__ void done(const Unit&) const {}
};

__device__ __forceinline__ unsigned cvt_pk_bf16(float lo, float hi) { unsigned r; asm volatile("v_cvt_pk_bf16_f32 %0, %1, %2" : "=v"(r) : "v"(lo), "v"(hi)); return r; }
typedef float f32x2 __attribute__((ext_vector_type(2)));
__device__ __forceinline__ float sigmoidf_(float x) { return 1.0f / (1.0f + __expf(-x)); }
__device__ __forceinline__ float bf_lo(unsigned w) { return __uint_as_float(w << 16); }
__device__ __forceinline__ float bf_hi(unsigned w) { return __uint_as_float(w & 0xffff0000u); }

template <int ACT> struct EpiBf16 {
    static constexpr bool PERM = true, AFTER_DRAIN = false;
    bf16_t* O; int ldc;
    __device__ __forceinline__ void operator()(const f32x4 (&acc)[2][2][4][2], const Unit& u, int wr, int wc, int fr, int fq) const {
        const int row0 = u.pm * BM + wr * 64 + fr; const int col0 = u.pn * BM + wc * 32 + 8 * fq;
#pragma unroll
        for (int ai = 0; ai < 2; ++ai)
#pragma unroll
            for (int m = 0; m < 4; ++m) { bf16_t* rowp = O + (size_t)(row0 + ai * HALF + m * 16) * ldc + col0;
#pragma unroll
                for (int bj = 0; bj < 2; ++bj) { f32x4 v0 = acc[ai][bj][m][0], v1 = acc[ai][bj][m][1];
                    if (ACT == 2) {
#pragma unroll
                        for (int e = 0; e < 4; ++e) { const float a = fmaxf(v0[e], 0.f), b = fmaxf(v1[e], 0.f); v0[e] = a * a; v1[e] = b * b; } }
                    u32x4 w; w.x = cvt_pk_bf16(v0[0], v0[1]); w.y = cvt_pk_bf16(v0[2], v0[3]); w.z = cvt_pk_bf16(v1[0], v1[1]); w.w = cvt_pk_bf16(v1[2], v1[3]);
                    *(u32x4*)(rowp + bj * HALF) = w; } }
    }
};
struct EpiF32 {
    static constexpr bool PERM = false, AFTER_DRAIN = false;
    float* C; int ldc;
    __device__ __forceinline__ void operator()(const f32x4 (&acc)[2][2][4][2], const Unit& u, int wr, int wc, int fr, int fq) const {
        const int row0 = u.pm * BM + wr * 64 + fr, col0 = u.pn * BM + wc * 32 + 4 * fq;
#pragma unroll
        for (int ai = 0; ai < 2; ++ai)
#pragma unroll
            for (int m = 0; m < 4; ++m) { float* rowp = C + (size_t)(row0 + ai * HALF + m * 16) * ldc + col0;
#pragma unroll
                for (int bj = 0; bj < 2; ++bj)
#pragma unroll
                    for (int n = 0; n < 2; ++n) *(f32x4*)(rowp + bj * HALF + n * 16) = acc[ai][bj][m][n]; }
    }
};
template <int MODE> struct EpiGate {
    static constexpr bool PERM = true, AFTER_DRAIN = false;
    const bf16_t* G; int ldg;
    float* part; bf16_t* out;
    __device__ __forceinline__ void operator()(const f32x4 (&acc)[2][2][4][2], const Unit& u, int wr, int wc, int fr, int fq) const {
        const int row0 = u.pm * BM + wr * 64 + fr; const int col0 = u.pn * BM + wc * 32 + 8 * fq;
#pragma unroll
        for (int ai = 0; ai < 2; ++ai)
#pragma unroll
            for (int m = 0; m < 4; ++m) { const size_t row = (size_t)(row0 + ai * HALF + m * 16);
#pragma unroll
                for (int bj = 0; bj < 2; ++bj) { const int c = col0 + bj * HALF;
                    const u32x4 gw = *(const u32x4*)(G + row * ldg + c);
                    f32x4 g0, g1; g0[0] = sigmoidf_(bf_lo(gw.x)); g0[1] = sigmoidf_(bf_hi(gw.x)); g0[2] = sigmoidf_(bf_lo(gw.y)); g0[3] = sigmoidf_(bf_hi(gw.y));
                    g1[0] = sigmoidf_(bf_lo(gw.z)); g1[1] = sigmoidf_(bf_hi(gw.z)); g1[2] = sigmoidf_(bf_lo(gw.w)); g1[3] = sigmoidf_(bf_hi(gw.w));
                    f32x4 v0 = acc[ai][bj][m][0] * g0, v1 = acc[ai][bj][m][1] * g1;
                    float* pp = part + row * 2048 + c;
                    if (MODE >= 1) { v0 += *(const f32x4*)pp; v1 += *(const f32x4*)(pp + 4); }
                    if (MODE <= 1) { *(f32x4*)pp = v0; *(f32x4*)(pp + 4) = v1; }
                    else { u32x4 w; w.x = cvt_pk_bf16(v0[0], v0[1]); w.y = cvt_pk_bf16(v0[2], v0[3]); w.z = cvt_pk_bf16(v1[0], v1[1]); w.w = cvt_pk_bf16(v1[2], v1[3]);
                        *(u32x4*)(out + row * 2048 + c) = w; } } }
    }
};
struct EpiResGate {
    static constexpr bool PERM = false, AFTER_DRAIN = false;
    float* H; const float* modl; int goff;
    __device__ __forceinline__ void operator()(const f32x4 (&acc)[2][2][4][2], const Unit& u, int wr, int wc, int fr, int fq) const {
        const int mr = u.pm < 32 ? (u.pm >> 3) : 4;
        const int row0 = u.pm * BM + wr * 64 + fr, col0 = u.pn * BM + wc * 32 + 4 * fq;
        const float* gv = modl + (size_t)mr * 12288 + goff + col0;
        f32x4 gg[2][2];
#pragma unroll
        for (int bj = 0; bj < 2; ++bj)
#pragma unroll
            for (int n = 0; n < 2; ++n) gg[bj][n] = *(const f32x4*)(gv + bj * HALF + n * 16);
#pragma unroll
        for (int ai = 0; ai < 2; ++ai)
#pragma unroll
            for (int m = 0; m < 4; ++m) { float* rowp = H + (size_t)(row0 + ai * HALF + m * 16) * 2048 + col0;
#pragma unroll
                for (int bj = 0; bj < 2; ++bj)
#pragma unroll
                    for (int n = 0; n < 2; ++n) { f32x4* p = (f32x4*)(rowp + bj * HALF + n * 16); *p = *p + gg[bj][n] * acc[ai][bj][m][n]; } }
    }
};

struct EpiResGatePart {
    static constexpr bool PERM = false, AFTER_DRAIN = false;
    float* part; const float* modl; int goff, slice;
    __device__ __forceinline__ void operator()(const f32x4 (&acc)[2][2][4][2], const Unit& u, int wr, int wc, int fr, int fq) const {
        const int row0 = (u.pm - 32) * BM + wr * 64 + fr, col0 = u.pn * BM + wc * 32 + 4 * fq;
        const float* gv = modl + (size_t)4 * 12288 + goff + col0;
        f32x4 gg[2][2];
#pragma unroll
        for (int bj = 0; bj < 2; ++bj)
#pragma unroll
            for (int n = 0; n < 2; ++n) gg[bj][n] = *(const f32x4*)(gv + bj * HALF + n * 16);
#pragma unroll
        for (int ai = 0; ai < 2; ++ai)
#pragma unroll
            for (int m = 0; m < 4; ++m) { float* rowp = part + ((size_t)slice * 1024 + (row0 + ai * HALF + m * 16)) * 2048 + col0;
#pragma unroll
                for (int bj = 0; bj < 2; ++bj)
#pragma unroll
                    for (int n = 0; n < 2; ++n) *(f32x4*)(rowp + bj * HALF + n * 16) = gg[bj][n] * acc[ai][bj][m][n]; }
    }
};
struct SubKOrder {
    int G, c;
    __host__ __device__ bool next(int i, Unit& u) const { const int L = i * G + c; if (L >= 256) return false; const int lt = L >> 3; u.pm = 32 + (lt >> 3); u.pn = lt & 7; return true; }
    __device__ __forceinline__ void a_ready(const Unit&) const {}
    __device__ __forceinline__ void done(const Unit&) const {}
};

template <class Epi, class Sched, bool ALIGN_EPI = false, bool SP2 = false>
__device__ __forceinline__ void gemm_phase(PG8_LAS unsigned char* lds, const Gemm g, const Sched& S, const Epi& E, const int wv  ) {
    int tid_ = wv * 64 + lane_now(); asm volatile("" : "+v"(tid_));
    const int tid = tid_, wid = __builtin_amdgcn_readfirstlane(tid >> 6), lane = tid & 63, wr = wid >> 2, wc = wid & 3, fr = lane & 15, fq = lane >> 4;
    const int K = g.K, nt = K / BK;
    unsigned voffA[2], voffB[2];
#pragma unroll
    for (int i = 0; i < 2; ++i) { int R, C; stage_rc(tid * 16 + i * 8192, R, C); const int Rb = Epi::PERM ? ((R & ~31) + perm32(R & 31)) : R;
        voffA[i] = (unsigned)(R * g.lda + C) * 2u; voffB[i] = (unsigned)(Rb * g.ldb + C) * 2u; }
    const size_t kstep = (size_t)(BK * 2);
    const size_t hstepA = (size_t)HALF * g.lda * 2, hstepB = (size_t)HALF * g.ldb * 2;
    const size_t tstepA = 2 * hstepA, tstepB = 2 * hstepB;
    const unsigned ldsw = (unsigned)wid * 1024u;
    const int aoff = lds_byte(wr * 64 + fr, fq * 8), boff = lds_byte(wc * 32 + fr, fq * 8);
#define PG8_SA(b, h) (((b) * 2 + (h)) * HTB)
#define PG8_SB(b, h) ((4 + (b) * 2 + (h)) * HTB)
#define PG8_STAGE(bufoff, gbase, voff) do { _Pragma("unroll") for (int _i = 0; _i < 2; ++_i) \
        __builtin_amdgcn_global_load_lds((const unsigned*)((const char*)(gbase) + (voff)[_i]), (PG8_LAS unsigned*)(lds + (bufoff) + ldsw + _i * 8192), 16, 0, 0); } while (0)
#define PG8_LDA(dst, b, h) do { _Pragma("unroll") for (int m = 0; m < 4; ++m) _Pragma("unroll") for (int k = 0; k < 2; ++k) dst[m][k] = *(const PG8_LAS bf16x8*)(lds + PG8_SA(b, h) + aoff + m * 2048 + k * 1024); } while (0)
#define PG8_LDB(dst, b, h) do { _Pragma("unroll") for (int n = 0; n < 2; ++n) _Pragma("unroll") for (int k = 0; k < 2; ++k) dst[n][k] = *(const PG8_LAS bf16x8*)(lds + PG8_SB(b, h) + boff + n * 2048 + k * 1024); } while (0)
#define PG8_MMA(ai, bj, At, Bt) do { __builtin_amdgcn_s_setprio(1); _Pragma("unroll") for (int m = 0; m < 4; ++m) _Pragma("unroll") for (int n = 0; n < 2; ++n) _Pragma("unroll") for (int k = 0; k < 2; ++k) \
        acc[ai][bj][m][n] = __builtin_amdgcn_mfma_f32_16x16x32_bf16(Bt[n][k], At[m][k], acc[ai][bj][m][n], 0, 0, 0); __builtin_amdgcn_s_setprio(0); } while (0)
#define PG8_WAIT_V(n) asm volatile("s_waitcnt vmcnt(" #n ")" ::: "memory")
#define PG8_WAIT_L(n) asm volatile("s_waitcnt lgkmcnt(" #n ")" ::: "memory")
#define PG8_BAR __builtin_amdgcn_s_barrier()
#define PG8_SCHED __builtin_amdgcn_sched_barrier(0)
    Unit cur, nxt; int ui = 0;
    if (!S.next(0, cur)) return;
    f32x4 acc[2][2][4][2];
#pragma unroll
    for (int a = 0; a < 2; ++a)
#pragma unroll
        for (int b = 0; b < 2; ++b)
#pragma unroll
            for (int m = 0; m < 4; ++m)
#pragma unroll
                for (int n = 0; n < 2; ++n) acc[a][b][m][n] = (f32x4){0.f, 0.f, 0.f, 0.f};
    bf16x8 At[4][2], B0[2][2], B1[2][2];
    const char* cA = (const char*)g.A + (size_t)cur.pm * tstepA; const char* cB = (const char*)g.Bt + (size_t)cur.pn * tstepB;
    S.a_ready(cur);
    if constexpr (SP2) {
        PG8_STAGE(PG8_SB(0, 0), cB, voffB); PG8_STAGE(PG8_SB(0, 1), cB + hstepB, voffB); PG8_STAGE(PG8_SA(0, 0), cA, voffA); PG8_STAGE(PG8_SA(0, 1), cA + hstepA, voffA);
        if (wr == 1) PG8_BAR;
        PG8_WAIT_V(2); PG8_BAR;
        PG8_STAGE(PG8_SB(1, 0), cB + kstep, voffB); PG8_STAGE(PG8_SA(1, 0), cA + kstep, voffA); PG8_STAGE(PG8_SB(1, 1), cB + hstepB + kstep, voffB);
        PG8_WAIT_V(6); PG8_BAR;
    } else {
        PG8_STAGE(PG8_SB(0, 0), cB, voffB); PG8_STAGE(PG8_SA(0, 0), cA, voffA); PG8_STAGE(PG8_SB(0, 1), cB + hstepB, voffB); PG8_STAGE(PG8_SA(0, 1), cA + hstepA, voffA);
        if (wr == 1) PG8_BAR;
        PG8_WAIT_V(4); PG8_BAR;
        PG8_STAGE(PG8_SB(1, 0), cB + kstep, voffB); PG8_STAGE(PG8_SA(1, 0), cA + kstep, voffA); PG8_STAGE(PG8_SB(1, 1), cB + hstepB + kstep, voffB);
        PG8_WAIT_V(6); PG8_BAR;
    }
    for (;;) {
        const bool has_next = S.next(ui + 1, nxt);
        const char* nA = has_next ? (const char*)g.A + (size_t)nxt.pm * tstepA : cA; const char* nB = has_next ? (const char*)g.Bt + (size_t)nxt.pn * tstepB : cB;
#pragma nounroll
        for (int t = 0; t < nt; t += 2) {
            const bool last = (t == nt - 2);
            const char* a1 = cA + (size_t)(t + 1) * kstep;
            const char* a2 = last ? nA : cA + (size_t)(t + 2) * kstep; const char* b2 = last ? nB : cB + (size_t)(t + 2) * kstep;
            const char* a3 = a2 + kstep; const char* b3 = b2 + kstep;
            if (last && has_next) S.a_ready(nxt);
            if constexpr (SP2) {
            PG8_LDB(B0, 0, 0); PG8_LDB(B1, 0, 1); PG8_SCHED; PG8_LDA(At, 0, 0); PG8_STAGE(PG8_SA(1, 1), a1 + hstepA, voffA);
            PG8_WAIT_V(8); PG8_WAIT_L(0); PG8_BAR; PG8_MMA(0, 0, At, B0); PG8_MMA(0, 1, At, B1); PG8_BAR; PG8_SCHED;
            PG8_LDA(At, 0, 1); PG8_STAGE(PG8_SB(0, 0), b2, voffB); PG8_STAGE(PG8_SB(0, 1), b2 + hstepB, voffB); PG8_STAGE(PG8_SA(0, 0), a2, voffA);
            PG8_WAIT_V(8); PG8_WAIT_L(0); PG8_BAR; PG8_MMA(1, 0, At, B0); PG8_MMA(1, 1, At, B1); PG8_BAR; PG8_SCHED;
            PG8_LDB(B0, 1, 0); PG8_LDB(B1, 1, 1); PG8_SCHED; PG8_LDA(At, 1, 0); PG8_STAGE(PG8_SA(0, 1), a2 + hstepA, voffA);
            PG8_WAIT_V(8); PG8_WAIT_L(0); PG8_BAR; PG8_MMA(0, 0, At, B0); PG8_MMA(0, 1, At, B1); PG8_BAR; PG8_SCHED;
            PG8_LDA(At, 1, 1); PG8_STAGE(PG8_SB(1, 0), b3, voffB); PG8_STAGE(PG8_SB(1, 1), b3 + hstepB, voffB); PG8_STAGE(PG8_SA(1, 0), a3, voffA);
            PG8_WAIT_V(8); PG8_WAIT_L(0); PG8_BAR; PG8_MMA(1, 0, At, B0); PG8_MMA(1, 1, At, B1); PG8_BAR; PG8_SCHED;
            } else {
            PG8_LDB(B0, 0, 0); PG8_SCHED; PG8_LDA(At, 0, 0); PG8_STAGE(PG8_SA(1, 1), a1 + hstepA, voffA);
            PG8_WAIT_L(8); PG8_BAR; PG8_WAIT_L(0); PG8_MMA(0, 0, At, B0); PG8_BAR; PG8_SCHED;
            PG8_LDB(B1, 0, 1); PG8_STAGE(PG8_SB(0, 0), b2, voffB);
            PG8_BAR; PG8_WAIT_L(0); PG8_MMA(0, 1, At, B1); PG8_BAR;
            PG8_LDA(At, 0, 1); PG8_STAGE(PG8_SA(0, 0), a2, voffA);
            PG8_BAR; PG8_WAIT_L(0); PG8_MMA(1, 0, At, B0); PG8_BAR; PG8_SCHED;
            PG8_STAGE(PG8_SB(0, 1), b2 + hstepB, voffB);
            PG8_WAIT_V(6); PG8_BAR; PG8_MMA(1, 1, At, B1); PG8_BAR;
            PG8_LDB(B0, 1, 0); PG8_SCHED; PG8_LDA(At, 1, 0); PG8_STAGE(PG8_SA(0, 1), a2 + hstepA, voffA);
            PG8_WAIT_L(8); PG8_BAR; PG8_WAIT_L(0); PG8_MMA(0, 0, At, B0); PG8_BAR; PG8_SCHED;
            PG8_LDB(B1, 1, 1); PG8_STAGE(PG8_SB(1, 0), b3, voffB);
            PG8_BAR; PG8_WAIT_L(0); PG8_MMA(0, 1, At, B1); PG8_BAR;
            PG8_LDA(At, 1, 1); PG8_STAGE(PG8_SA(1, 0), a3, voffA);
            PG8_BAR; PG8_WAIT_L(0); PG8_MMA(1, 0, At, B0); PG8_BAR; PG8_SCHED;
            PG8_STAGE(PG8_SB(1, 1), b3 + hstepB, voffB);
            PG8_WAIT_V(6); PG8_BAR; PG8_MMA(1, 1, At, B1); PG8_BAR;
            }
        }
        if constexpr (ALIGN_EPI) { if (wr == 0) PG8_BAR; }
        if constexpr (!Epi::AFTER_DRAIN) { int t2_ = lane_now(); asm volatile("" : "+v"(t2_));   E(acc, cur, wr, wc, t2_ & 15, (t2_ >> 4) & 3); S.done(cur); }
        if (!has_next) break;
#pragma unroll
        for (int a = 0; a < 2; ++a)
#pragma unroll
            for (int b = 0; b < 2; ++b)
#pragma unroll
                for (int m = 0; m < 4; ++m)
#pragma unroll
                    for (int n = 0; n < 2; ++n) acc[a][b][m][n] = (f32x4){0.f, 0.f, 0.f, 0.f};
        cur = nxt; cA = nA; cB = nB; ++ui;
        if constexpr (ALIGN_EPI) { if (wr == 1) PG8_BAR; }
    }
    PG8_WAIT_V(0);
    if constexpr (!ALIGN_EPI) { if (wr == 0) PG8_BAR; }
    PG8_BAR;
    if constexpr (Epi::AFTER_DRAIN) { E.fused(acc, cur, wr, wc, fr, fq, lds, wid, lane); S.done(cur); }
#undef PG8_SA
#undef PG8_SB
#undef PG8_STAGE
#undef PG8_LDA
#undef PG8_LDB
#undef PG8_MMA
#undef PG8_WAIT_V
#undef PG8_WAIT_L
#undef PG8_BAR
#undef PG8_SCHED
}
}

constexpr int NB = 4, TL = 2048, TCX = 256, DM = 2048, NL = 4, DFF = 8192, BW = 1024;
constexpr int ML = NB * TL, MC = NB * TCX, MT = ML + MC;
constexpr int NIN = 15232, LDP = 15360;
constexpr int C_RET = 0, C_SWA = 4096, C_RW = 5632, C_GATE = 9088, RWIN = 3456;
constexpr int NLR = 5120, KLR = 384;
constexpr int NQK = 1280;
constexpr int NSTEP = 2304, SCAN_BLK = 32;

constexpr size_t al256(size_t x) { return (x + 255) & ~(size_t)255; }
constexpr size_t WS_CTL = 0, CTL_ZERO_BYTES = 1u << 20;
constexpr size_t SZ_WIN = (size_t)LDP * DM * 2, SZ_WBR = (size_t)3 * DM * BW * 2, SZ_WOUT = (size_t)DM * DM * 2, SZ_WFF = (size_t)DFF * DM * 2, SZ_WLR = (size_t)NLR * KLR * 2;
constexpr size_t WS_WIN = CTL_ZERO_BYTES;
constexpr size_t WS_WBR = WS_WIN + NL * SZ_WIN;
constexpr size_t WS_WOUT = WS_WBR + NL * SZ_WBR;
constexpr size_t WS_WFF1 = WS_WOUT + NL * SZ_WOUT;
constexpr size_t WS_WFF2 = WS_WFF1 + NL * SZ_WFF;
constexpr size_t WS_WLR = WS_WFF2 + NL * SZ_WFF;
constexpr size_t WS_H = WS_WLR + NL * SZ_WLR;
constexpr size_t WS_U = WS_H + (size_t)MT * DM * 4;
constexpr size_t WS_P = WS_U + (size_t)MT * DM * 2;
constexpr size_t WS_Y = WS_P + (size_t)MT * LDP * 2;
constexpr size_t WS_MGF = WS_Y + (size_t)MT * 3072 * 2;
constexpr size_t WS_MG = WS_MGF + (size_t)MT * DM * 4;
constexpr size_t WS_F = WS_MG + (size_t)MT * DM * 2;
constexpr size_t WS_MODP = WS_F + (size_t)MT * DFF * 2;
constexpr size_t WS_MOD = WS_MODP + (size_t)8 * NL * 5 * 12288 * 4;
constexpr size_t WS_ROPE = WS_MOD + (size_t)NL * 5 * 12288 * 4;
constexpr size_t WS_XS = WS_ROPE + 64 * 32 * 2 * 4;
constexpr size_t WS_ALR = WS_XS + (size_t)MT * 3072 * 4;
constexpr size_t WS_LR = WS_ALR + (size_t)MT * KLR * 2;
constexpr size_t WS_QKR = WS_LR + (size_t)MT * NLR * 4;
constexpr size_t WS_ST = WS_QKR + (size_t)MT * NQK * 2;
constexpr size_t WS_YDR = WS_ST + (size_t)NB * 8 * 2 * 18 * 128 * 128 * 2;
constexpr size_t WS_YDW = WS_YDR + (size_t)2 * MT * BW * 4;
constexpr size_t RWU = (size_t)NB * 16 * 2 * 36;
constexpr size_t WS_RWY = WS_F;
constexpr size_t WS_RWH = WS_F + RWU * 16384;
constexpr size_t WS_RWP = WS_YDW;
constexpr size_t WS_RWQ = WS_RWP + RWU * 8192;
constexpr size_t WS_RWG = WS_RWQ + RWU * 8192;
constexpr size_t WS_RWS = WS_RWG + RWU * 256;
constexpr size_t WS_END = WS_RWS + RWU * 8192;
static_assert(RWU * 32768 <= (size_t)MT * DFF * 2, "rwkv tiles overlay F");
constexpr int CW_BAR = 4096;
constexpr int CW_DBG = 20480;
constexpr int CW_SWAQ = 16384;

constexpr int RING_BYTES = 131072, LDSCTL_OFF = RING_BYTES, MISC_OFF = LDSCTL_OFF + 320, LDS_BYTES = 147456;
constexpr int NWAVES = 8, NTHR = 512;

#define GAS __attribute__((address_space(1)))
#define LAS __attribute__((address_space(3)))
typedef unsigned short bf16;
typedef float f32x4 __attribute__((ext_vector_type(4)));
typedef float f32x2 __attribute__((ext_vector_type(2)));
typedef unsigned u32x4 __attribute__((ext_vector_type(4)));
typedef unsigned u32x2 __attribute__((ext_vector_type(2)));
#define LDS_WAIT() asm volatile("s_waitcnt lgkmcnt(0)" ::: "memory")
#define LB() do { asm volatile("s_waitcnt lgkmcnt(0)" ::: "memory"); __builtin_amdgcn_s_barrier(); asm volatile("" ::: "memory"); } while (0)
#define VM_WAIT() asm volatile("s_waitcnt vmcnt(0)" ::: "memory")
__device__ __forceinline__ unsigned f2bf(float f) { unsigned u = __builtin_bit_cast(unsigned, f); return (u + 0x7fffu + ((u >> 16) & 1u)) >> 16; }
__device__ __forceinline__ unsigned pk2(float lo, float hi) { return f2bf(lo) | (f2bf(hi) << 16); }
__device__ __forceinline__ float bf2f(bf16 v) { return __uint_as_float((unsigned)v << 16); }
__device__ __forceinline__ float sigm(float x) { return 1.0f / (1.0f + __expf(-x)); }
using pg8::bf_lo; using pg8::bf_hi;
__device__ __forceinline__ float shx(float v, int m, int lane) { return __int_as_float(__builtin_amdgcn_ds_bpermute((lane ^ m) << 2, __float_as_int(v))); }
__device__ __forceinline__ float shx_from(float v, int src) { return __int_as_float(__builtin_amdgcn_ds_bpermute((src & 63) << 2, __float_as_int(v))); }
__device__ __forceinline__ float wave_sum(float v, int lane) {
#pragma unroll
    for (int o = 1; o < 64; o <<= 1) v += shx(v, o, lane);
    return v;
}
__device__ __forceinline__ float wave_max(float v, int lane) {
#pragma unroll
    for (int o = 1; o < 64; o <<= 1) v = fmaxf(v, shx(v, o, lane));
    return v;
}

#define XB_TMO      128
#define XB_XCNT(j)  (256  + 64 * (j))
#define XB_XSUB(j)  (1280 + 64 * (j))
#define XB_XGEN(j)  (2304 + 64 * (j))
#define XB_TOP      3328
#define XB_TOPGEN   3392
#define XCD_BAR_WORDS 3456
#define XB_SPIN_CAP (1u << 22)
__device__ __forceinline__ unsigned xb_ld(unsigned* p)              { return __hip_atomic_load(p, __ATOMIC_RELAXED, __HIP_MEMORY_SCOPE_AGENT); }
__device__ __forceinline__ unsigned xb_add(unsigned* p, unsigned v) { return __hip_atomic_fetch_add(p, v, __ATOMIC_RELAXED, __HIP_MEMORY_SCOPE_AGENT); }
__device__ __forceinline__ unsigned xb_xcc_id() { return (unsigned)__builtin_amdgcn_s_getreg((3 << 11) | 20) & 0xFu; }
#define XB_SPIN(cond, bar) do { unsigned _sp = 0; while (cond) { __builtin_amdgcn_s_sleep(1); \
    if ((++_sp & 255u) == 0u) { if (xb_ld(&(bar)[XB_TMO])) break; if (_sp > XB_SPIN_CAP) { atomicAdd(&(bar)[XB_TMO], 1u); break; } } } } while (0)
struct XcdBarrier { unsigned* bar; unsigned x; volatile LAS unsigned* st; };
__device__ __forceinline__ XcdBarrier xcd_barrier_post(unsigned* bar, volatile LAS unsigned* st) {
    XcdBarrier b; b.bar = bar; b.x = xb_xcc_id(); b.st = st;
    if (threadIdx.x == 0) (void)xb_add(&bar[XB_XCNT(b.x)], 1u);
    return b;
}
__device__ __forceinline__ void xcd_barrier_complete(unsigned* bar, unsigned x, unsigned& nloc, unsigned& nx) {
    const unsigned G = gridDim.x * gridDim.y * gridDim.z;
    unsigned sum, cnt, mine, sp = 0u;
    for (;;) {
        sum = 0u; cnt = 0u; mine = 0u;
#pragma unroll
        for (unsigned j = 0; j < 16; ++j) { const unsigned c = xb_ld(&bar[XB_XCNT(j)]); sum += c; cnt += (c > 0u) ? 1u : 0u; mine = (j == x) ? c : mine; }
        if (sum == G) break;
        __builtin_amdgcn_s_sleep(1);
        if ((++sp & 255u) == 0u) { if (xb_ld(&bar[XB_TMO])) break; if (sp > XB_SPIN_CAP) { atomicAdd(&bar[XB_TMO], 1u); break; } }
    }
    nloc = mine > 0u ? mine : 1u; nx = cnt > 0u ? cnt : 1u;
}
__device__ __forceinline__ void xcd_barrier(const XcdBarrier& b, const bool thread0  ) {
    asm volatile("s_waitcnt vmcnt(0)" ::: "memory");
    __syncthreads();
    if (thread0) {
        unsigned* bar = b.bar; unsigned bx = b.x;
        asm volatile("" : "+s"(bar), "+s"(bx));
        __builtin_amdgcn_s_waitcnt(0);
        unsigned nloc = b.st[0], nx = b.st[1];
        if (nloc == 0u) { xcd_barrier_complete(bar, bx, nloc, nx); b.st[0] = nloc; b.st[1] = nx; }
        const unsigned old = xb_add(&bar[XB_XSUB(bx)], 1u);
        const unsigned gen = old / nloc;
        if (old + 1u == (gen + 1u) * nloc) {
            __builtin_amdgcn_fence(__ATOMIC_RELEASE, "agent");
            asm volatile("s_waitcnt vmcnt(0)" ::: "memory");
            const unsigned og = xb_add(&bar[XB_TOP], 1u);
            const unsigned tg = og / nx;
            if (og + 1u == (tg + 1u) * nx) xb_add(&bar[XB_TOPGEN], 1u);
            else XB_SPIN(xb_ld(&bar[XB_TOPGEN]) == tg, bar);
            __builtin_amdgcn_fence(__ATOMIC_ACQUIRE, "agent");
            xb_add(&bar[XB_XGEN(bx)], 1u);
            asm volatile("s_waitcnt vmcnt(0)" ::: "memory");
        } else {
            XB_SPIN(xb_ld(&bar[XB_XGEN(bx)]) == gen, bar);
            __builtin_amdgcn_fence(__ATOMIC_ACQUIRE, "agent");
            asm volatile("s_waitcnt vmcnt(0)" ::: "memory");
        }
    }
    __syncthreads();
}

struct Args { const float* in[26]; float* out; unsigned char* ws; int s_lo, s_hi; };
enum { I_X = 0, I_C, I_CTX, I_CCTX, I_N1G, I_N2G, I_WMOD, I_BMOD, I_WIN, I_RETDEC, I_SINK, I_MU, I_W0, I_WUP, I_A0, I_AUP, I_GUP, I_KK, I_KA, I_RK, I_LNG, I_WBR, I_WOUT, I_WFF1, I_WFF2, I_FING };
struct Frame {
    LAS unsigned char* lds;
    unsigned* ctl;
    int tid, lane, wave, G, wg;
    unsigned char* ws;
};
template <class T> __device__ __forceinline__ T* wsp(const Frame& F, size_t off) { return (T*)(F.ws + off); }
constexpr int PTAB_OFF = LDSCTL_OFF + 64;
__device__ __forceinline__ const float* inp(const Frame& F, int i) {
    const LAS unsigned* t = (const LAS unsigned*)(F.lds + PTAB_OFF) + 2 * i;
    const unsigned lo = __builtin_amdgcn_readfirstlane(t[0]), hi = __builtin_amdgcn_readfirstlane(t[1]);
    return (const float*)(GAS const float*)(((unsigned long long)hi << 32) | (unsigned long long)lo);
}

__device__ __forceinline__ int scan_row(int b, int dir, int s) {
    if (s < TCX) return ML + b * TCX + (dir ? (TCX - 1 - s) : s);
    const int t = s - TCX; return b * TL + (dir ? (TL - 1 - t) : t);
}

__device__ __forceinline__ void transpose_item(const float* W, int K, int N, bf16* WT, LAS unsigned char* scr, int item, int lane) {
    const int nblk = N / 64, kb = item / nblk, nb = item % nblk, k0 = 64 * kb, n0 = 64 * nb;
    const int kr = lane >> 4, nc = (lane & 15) * 4;
    f32x4 v[16];
#pragma unroll
    for (int i = 0; i < 16; ++i) v[i] = *(const f32x4*)(W + (size_t)(k0 + 4 * i + kr) * N + n0 + nc);
#pragma unroll
    for (int i = 0; i < 16; ++i) { LAS unsigned short* d = (LAS unsigned short*)(scr + nc * 144 + (4 * i + kr) * 2);
        d[0] = (unsigned short)f2bf(v[i].x); d[72] = (unsigned short)f2bf(v[i].y); d[144] = (unsigned short)f2bf(v[i].z); d[216] = (unsigned short)f2bf(v[i].w); }
    LDS_WAIT(); asm volatile("" ::: "memory");
    const int c = lane & 7;
#pragma unroll
    for (int j = 0; j < 8; ++j) { const int n = (lane >> 3) + 8 * j;
        *(u32x4*)(WT + (size_t)(n0 + n) * K + k0 + 8 * c) = *(const LAS u32x4*)(scr + n * 144 + 16 * c); }
    LDS_WAIT(); asm volatile("" ::: "memory");
}
__device__ __forceinline__ void p0_prologue(Frame& F) {
    const int gw = F.wg * NWAVES + F.wave, NGW = F.G * NWAVES;
    const int gt = F.wg * NTHR + F.tid, NGT = F.G * NTHR;
    LAS float* sil = (LAS float*)(F.lds + 81920);
    for (int e = F.tid; e < 5 * DM; e += NTHR) { const int r = e / DM, k = e % DM; const float v = r < 4 ? inp(F, I_C)[r * DM + k] : inp(F, I_CCTX)[k]; sil[e] = v * sigm(v); }
    {
        LAS unsigned char* scr = F.lds + F.wave * 9216;
        constexpr int IT_IN = (DM / 64) * (NIN / 64), IT_BR = (BW / 64) * (DM / 64), IT_OUT = (DM / 64) * (DM / 64), IT_F1 = (DM / 64) * (DFF / 64), IT_F2 = (DFF / 64) * (DM / 64);
        constexpr int IT_L = IT_IN + 3 * IT_BR + IT_OUT + IT_F1 + IT_F2;
        for (int it = gw; it < NL * IT_L; it += NGW) {
            const int l = it / IT_L; int r = it % IT_L;
            if (r < IT_IN) { transpose_item(inp(F, I_WIN) + (size_t)l * DM * NIN, DM, NIN, wsp<bf16>(F, WS_WIN + l * SZ_WIN), scr, r, F.lane); continue; } r -= IT_IN;
            if (r < 3 * IT_BR) { const int n = r / IT_BR; transpose_item(inp(F, I_WBR) + ((size_t)l * 3 + n) * BW * DM, BW, DM, wsp<bf16>(F, WS_WBR + l * SZ_WBR) + (size_t)n * DM * BW, scr, r % IT_BR, F.lane); continue; } r -= 3 * IT_BR;
            if (r < IT_OUT) { transpose_item(inp(F, I_WOUT) + (size_t)l * DM * DM, DM, DM, wsp<bf16>(F, WS_WOUT + l * SZ_WOUT), scr, r, F.lane); continue; } r -= IT_OUT;
            if (r < IT_F1) { transpose_item(inp(F, I_WFF1) + (size_t)l * DM * DFF, DM, DFF, wsp<bf16>(F, WS_WFF1 + l * SZ_WFF), scr, r, F.lane); continue; } r -= IT_F1;
            transpose_item(inp(F, I_WFF2) + (size_t)l * DFF * DM, DFF, DM, wsp<bf16>(F, WS_WFF2 + l * SZ_WFF), scr, r, F.lane);
        }
    }
    for (int e = gt; e < NL * (LDP - NIN) * DM / 8; e += NGT) { const int l = e / ((LDP - NIN) * DM / 8), r = e % ((LDP - NIN) * DM / 8);
        *(u32x4*)(wsp<bf16>(F, WS_WIN + l * SZ_WIN) + (size_t)NIN * DM + (size_t)r * 8) = (u32x4){0u, 0u, 0u, 0u}; }
    for (int e = gt; e < NL * NLR * KLR; e += NGT) {
        const int l = e / (NLR * KLR), r = e % (NLR * KLR), n = r / KLR, k = r % KLR; float v = 0.f;
        if (n < 2048) { const int d = n >> 10, c = n & 1023; if (k >= 64 * d && k < 64 * d + 64) v = inp(F, I_WUP)[(((size_t)l * 2 + d) * 64 + (k - 64 * d)) * BW + c]; }
        else if (n < 4096) { const int d = (n - 2048) >> 10, c = n & 1023; if (k >= 128 + 64 * d && k < 192 + 64 * d) v = inp(F, I_AUP)[(((size_t)l * 2 + d) * 64 + (k - 128 - 64 * d)) * BW + c]; }
        else { const int c = n - 4096; if (k >= 256) v = inp(F, I_GUP)[((size_t)l * 128 + (k - 256)) * BW + c]; }
        wsp<bf16>(F, WS_WLR + l * SZ_WLR)[r] = (bf16)f2bf(v);
    }
    { const f32x4* x4 = (const f32x4*)inp(F, I_X); const f32x4* c4 = (const f32x4*)inp(F, I_CTX); f32x4* h4 = wsp<f32x4>(F, WS_H);
      for (int e = gt; e < ML * DM / 4; e += NGT) h4[e] = x4[e];
      for (int e = gt; e < MC * DM / 4; e += NGT) h4[ML * DM / 4 + e] = c4[e]; }
    if (gt < 64 * 32) { const int pos = gt >> 5, i = gt & 31; const float inv = powf(10000.0f, -(float)i / 32.0f); const float ang = (float)pos * inv;
        wsp<float>(F, WS_ROPE)[2 * gt] = cosf(ang); wsp<float>(F, WS_ROPE)[2 * gt + 1] = sinf(ang); }
    __syncthreads();
    for (int it = gw; it < NL * 8 * 48; it += NGW) {
        const int l = it / (8 * 48), kc = (it / 48) % 8, cc = it % 48, col = cc * 256 + F.lane * 4, k0 = kc * 256;
        const float* wp = inp(F, I_WMOD) + ((size_t)l * DM + k0) * 12288 + col;
        f32x4 a0 = {0.f, 0.f, 0.f, 0.f}, a1 = a0, a2 = a0, a3 = a0, a4 = a0;
#pragma unroll 8
        for (int k = 0; k < 256; ++k) { const f32x4 w = *(const f32x4*)(wp + (size_t)k * 12288);
            a0 += sil[0 * DM + k0 + k] * w; a1 += sil[1 * DM + k0 + k] * w; a2 += sil[2 * DM + k0 + k] * w; a3 += sil[3 * DM + k0 + k] * w; a4 += sil[4 * DM + k0 + k] * w; }
        float* mp = wsp<float>(F, WS_MODP) + ((size_t)(kc * NL + l) * 5) * 12288 + col;
        *(f32x4*)(mp) = a0; *(f32x4*)(mp + 12288) = a1; *(f32x4*)(mp + 2 * 12288) = a2; *(f32x4*)(mp + 3 * 12288) = a3; *(f32x4*)(mp + 4 * 12288) = a4;
    }
}
__device__ __forceinline__ void p1_modreduce(Frame& F) {
    const int gt = F.wg * NTHR + F.tid, NGT = F.G * NTHR;
    for (int e = gt; e < NL * 5 * 12288; e += NGT) { const int l = e / (5 * 12288), j = e % 12288;
        float s = inp(F, I_BMOD)[l * 12288 + j];
#pragma unroll
        for (int kc = 0; kc < 8; ++kc) s += wsp<float>(F, WS_MODP)[(size_t)kc * NL * 5 * 12288 + e];
        wsp<float>(F, WS_MOD)[e] = s; }
}

__device__ __forceinline__ void norm_phase(Frame& F, int layer, int which, int nrows, bool partials) {
    const int gw = F.wg * NWAVES + F.wave, NGW = F.G * NWAVES;
    const float* gptr = inp(F, which ? I_N2G : I_N1G) + layer * DM;
    for (int row = gw; row < nrows; row += NGW) {
        const int mr = row < ML ? (row >> 11) : 4;
        const float* mod = wsp<float>(F, WS_MOD) + ((size_t)layer * 5 + mr) * 12288 + (which ? 3 * DM : 0);
        const f32x4* xr = (const f32x4*)(wsp<float>(F, WS_H) + (size_t)row * DM) + F.lane;
        f32x4 v[8]; float ss = 0.f;
#pragma unroll
        for (int j = 0; j < 8; ++j) v[j] = xr[64 * j];
        if (partials && row >= ML) {
            const f32x4* pp = (const f32x4*)(wsp<float>(F, WS_YDR) + (size_t)(row - ML) * DM) + F.lane;
#pragma unroll
            for (int s = 0; s < 8; ++s)
#pragma unroll
                for (int j = 0; j < 8; ++j) v[j] += pp[(size_t)s * 1024 * DM / 4 + 64 * j];
            f32x4* xw = (f32x4*)(wsp<float>(F, WS_H) + (size_t)row * DM) + F.lane;
#pragma unroll
            for (int j = 0; j < 8; ++j) xw[64 * j] = v[j];
        }
#pragma unroll
        for (int j = 0; j < 8; ++j) ss += (v[j].x * v[j].x + v[j].y * v[j].y) + (v[j].z * v[j].z + v[j].w * v[j].w);
        const float rs = 1.0f / sqrtf(wave_sum(ss, F.lane) * (1.0f / DM) + 1e-6f);
        u32x2* o = (u32x2*)(wsp<bf16>(F, WS_U) + (size_t)row * DM) + F.lane;
#pragma unroll
        for (int j = 0; j < 8; ++j) { const int c = 4 * F.lane + 256 * j;
            const f32x4 g = *(const f32x4*)(gptr + c), sh = *(const f32x4*)(mod + c), sc = *(const f32x4*)(mod + DM + c);
            const f32x4 y = (v[j] * rs) * g * (1.0f + sc) + sh;
            u32x2 w; w.x = pk2(y.x, y.y); w.y = pk2(y.z, y.w); o[64 * j] = w; }
    }
}
__device__ __forceinline__ void final_norm(Frame& F, float* out) {
    const int gw = F.wg * NWAVES + F.wave, NGW = F.G * NWAVES;
#ifdef RW_DEBUG
    const float* dst_ = (const float*)(F.ctl + CW_DBG); const float er0_ = sqrtf(dst_[0] / fmaxf(dst_[1], 1e-30f)), er1_ = sqrtf(dst_[2] / fmaxf(dst_[3], 1e-30f)); const float dbg_e0 = er0_ > RW_DEBUG_THR ? 0.3f : 0.0f, dbg_e1 = er1_ > RW_DEBUG_THR ? 0.6f : 0.0f;
#endif
    for (int row = gw; row < ML; row += NGW) {
        const f32x4* xr = (const f32x4*)(wsp<float>(F, WS_H) + (size_t)row * DM) + F.lane;
        f32x4 v[8]; float ss = 0.f;
#pragma unroll
        for (int j = 0; j < 8; ++j) { v[j] = xr[64 * j]; ss += (v[j].x * v[j].x + v[j].y * v[j].y) + (v[j].z * v[j].z + v[j].w * v[j].w); }
        const float rs = 1.0f / sqrtf(wave_sum(ss, F.lane) * (1.0f / DM) + 1e-6f);
        f32x4* o = (f32x4*)(out + (size_t)row * DM) + F.lane;
#pragma unroll
        for (int j = 0; j < 8; ++j) { const f32x4 g = *(const f32x4*)(inp(F, I_FING) + 4 * F.lane + 256 * j); f32x4 ov = (v[j] * rs) * g;
#ifdef RW_DEBUG
#ifndef RW_DEBUG_NOSTAT
            ov += dbg_e0; if (row == 0 && j == 0 && F.lane == 0) ov.x += dbg_e1;
#endif
#endif
            o[64 * j] = ov; }
    }
}
__device__ __forceinline__ void prep_phase(Frame& F, int layer) {
    const int gw = F.wg * NWAVES + F.wave, NGW = F.G * NWAVES;
    const bf16* P = wsp<bf16>(F, WS_P);
    const float* mu0 = inp(F, I_MU) + (size_t)layer * 2 * RWIN; const float* mu1 = mu0 + RWIN;
    const float* rope = wsp<float>(F, WS_ROPE);
    for (int row = gw; row < MT; row += NGW) {
        bool first, last; int t = 0;
        if (row < ML) { t = row & (TL - 1); first = t == 0; last = t == TL - 1; } else { const int c = (row - ML) & (TCX - 1); first = c == 0; last = c == TCX - 1; }
        const bf16* pr = P + (size_t)row * LDP + C_RW;
        float* xs = wsp<float>(F, WS_XS) + (size_t)row * 3072; bf16* alr = wsp<bf16>(F, WS_ALR) + (size_t)row * KLR;
        for (int j8 = F.lane; j8 < RWIN / 8; j8 += 64) {
            const int c = 8 * j8;
            const u32x4 pw = *(const u32x4*)(pr + c);
            const u32x4 vw = first ? (u32x4){0u, 0u, 0u, 0u} : *(const u32x4*)(pr - LDP + c);
            const u32x4 nw = last ? (u32x4){0u, 0u, 0u, 0u} : *(const u32x4*)(pr + LDP + c);
            const f32x4 ma = *(const f32x4*)(mu0 + c), mb = *(const f32x4*)(mu0 + c + 4), na = *(const f32x4*)(mu1 + c), nb = *(const f32x4*)(mu1 + c + 4);
            float s[8];
#pragma unroll
            for (int e = 0; e < 4; ++e) { const float p0 = bf_lo(pw[e]), p1 = bf_hi(pw[e]), v0 = bf_lo(vw[e]), v1 = bf_hi(vw[e]), n0 = bf_lo(nw[e]), n1 = bf_hi(nw[e]);
                const float m0 = e < 2 ? ma[2 * e] : mb[2 * e - 4], m1 = e < 2 ? ma[2 * e + 1] : mb[2 * e - 3], q0 = e < 2 ? na[2 * e] : nb[2 * e - 4], q1 = e < 2 ? na[2 * e + 1] : nb[2 * e - 3];
                s[2 * e] = p0 + m0 * (v0 - p0) + q0 * (n0 - p0); s[2 * e + 1] = p1 + m1 * (v1 - p1) + q1 * (n1 - p1); }
            if (c < 3072) { *(f32x4*)(xs + c) = (f32x4){s[0], s[1], s[2], s[3]}; *(f32x4*)(xs + c + 4) = (f32x4){s[4], s[5], s[6], s[7]}; }
            else { u32x4 o; int dst;
                if (c < 3200) { dst = c - 3072; o.x = pk2(tanhf(s[0]), tanhf(s[1])); o.y = pk2(tanhf(s[2]), tanhf(s[3])); o.z = pk2(tanhf(s[4]), tanhf(s[5])); o.w = pk2(tanhf(s[6]), tanhf(s[7])); }
                else if (c < 3328) { dst = 128 + c - 3200; o.x = pk2(s[0], s[1]); o.y = pk2(s[2], s[3]); o.z = pk2(s[4], s[5]); o.w = pk2(s[6], s[7]); }
                else { dst = 256 + c - 3328; o.x = pk2(sigm(s[0]), sigm(s[1])); o.y = pk2(sigm(s[2]), sigm(s[3])); o.z = pk2(sigm(s[4]), sigm(s[5])); o.w = pk2(sigm(s[6]), sigm(s[7])); }
                *(u32x4*)(alr + dst) = o; }
        }
        const bf16* ps = P + (size_t)row * LDP + C_SWA; bf16* qk = wsp<bf16>(F, WS_QKR) + (size_t)row * NQK;
        const bool lat = row < ML; const int rr = t >> 6, cc = t & 63;
#pragma unroll
        for (int it = 0; it < 5; ++it) { const int idx = it * 64 + F.lane, hd = idx >> 5, i = idx & 31;
            const float x1r = bf2f(ps[hd * 128 + i]), x2r = bf2f(ps[hd * 128 + 32 + i]), x1c = bf2f(ps[hd * 128 + 64 + i]), x2c = bf2f(ps[hd * 128 + 96 + i]);
            float cr = 1.f, sr = 0.f, ccs = 1.f, scs = 0.f;
            if (lat) { cr = rope[(rr * 32 + i) * 2]; sr = rope[(rr * 32 + i) * 2 + 1]; ccs = rope[(cc * 32 + i) * 2]; scs = rope[(cc * 32 + i) * 2 + 1]; }
            qk[hd * 128 + i] = (bf16)f2bf(x1r * cr - x2r * sr); qk[hd * 128 + 32 + i] = (bf16)f2bf(x2r * cr + x1r * sr);
            qk[hd * 128 + 64 + i] = (bf16)f2bf(x1c * ccs - x2c * scs); qk[hd * 128 + 96 + i] = (bf16)f2bf(x2c * ccs + x1c * scs); }
    }
}

__device__ __forceinline__ float red8(float v) {
    v += __int_as_float(__builtin_amdgcn_update_dpp(0, __float_as_int(v), 0xB1, 0xF, 0xF, true));
    v += __int_as_float(__builtin_amdgcn_update_dpp(0, __float_as_int(v), 0x4E, 0xF, 0xF, true));
    v += __int_as_float(__builtin_amdgcn_update_dpp(0, __float_as_int(v), 0x141, 0xF, 0xF, true));
    return v;
}
__device__ __forceinline__ float red16(float v) {
    v += __int_as_float(__builtin_amdgcn_update_dpp(0, __float_as_int(v), 0xB1, 0xF, 0xF, true));
    v += __int_as_float(__builtin_amdgcn_update_dpp(0, __float_as_int(v), 0x4E, 0xF, 0xF, true));
    v += __int_as_float(__builtin_amdgcn_update_dpp(0, __float_as_int(v), 0x141, 0xF, 0xF, true));
    v += __int_as_float(__builtin_amdgcn_update_dpp(0, __float_as_int(v), 0x140, 0xF, 0xF, true));
    return v;
}
typedef short bf16x8 __attribute__((ext_vector_type(8)));
typedef short s16x4 __attribute__((ext_vector_type(4)));
typedef float f32x16 __attribute__((ext_vector_type(16)));
typedef __bf16 bf16x2_t __attribute__((ext_vector_type(2)));
#define MFMA32(a, b, c) __builtin_amdgcn_mfma_f32_32x32x16_bf16((a), (b), (c), 0, 0, 0)
__device__ __forceinline__ int crow(int reg, int h) { return (reg & 3) + 8 * (reg >> 2) + 4 * h; }
__device__ __forceinline__ unsigned cvtpk(float lo, float hi) { f32x2 v = {lo, hi}; bf16x2_t b = __builtin_convertvector(v, bf16x2_t); return __builtin_bit_cast(unsigned, b); }
__device__ __forceinline__ s16x4 tr16(const LAS unsigned char* p) { return __builtin_bit_cast(s16x4, __builtin_amdgcn_ds_read_tr16_b64_v4i16((LAS s16x4*)p)); }
__device__ __forceinline__ bf16x8 frag_rm(const LAS unsigned char* base, int pitch, int r0, int k0, int lane) {
    return *(const LAS bf16x8*)(base + (r0 + (lane & 31)) * pitch + (k0 + 8 * (lane >> 5)) * 2);
}
template <bool PERM> __device__ __forceinline__ bf16x8 frag_tr(const LAS unsigned char* base, int pitch, int k0, int r0, int lane) {
    const int g = lane >> 4, i = lane & 15, q = i >> 2, p = i & 3, h = g >> 1;
    const LAS unsigned char* a = base + (k0 + (PERM ? 4 : 8) * h + q) * pitch + (r0 + 16 * (g & 1) + 4 * p) * 2;
    const s16x4 lo = tr16(a), hi = tr16(a + (PERM ? 8 : 4) * pitch);
    return __builtin_shufflevector(lo, hi, 0, 1, 2, 3, 4, 5, 6, 7);
}
__device__ __forceinline__ bf16x8 pack_step(const f32x16& x, int s) {
    u32x4 p; p.x = cvtpk(x[8 * s + 0], x[8 * s + 1]); p.y = cvtpk(x[8 * s + 2], x[8 * s + 3]); p.z = cvtpk(x[8 * s + 4], x[8 * s + 5]); p.w = cvtpk(x[8 * s + 6], x[8 * s + 7]);
    return __builtin_bit_cast(bf16x8, p);
}
__device__ __forceinline__ f32x16 zero16() { f32x16 z; for (int i = 0; i < 16; ++i) z[i] = 0.f; return z; }
constexpr int TP = 272;
constexpr int TILE_B = 128 * TP;
__device__ __forceinline__ void load_tile128(LAS unsigned char* dst, const bf16* src, size_t ld, int tid) {
#pragma unroll
    for (int it = 0; it < 4; ++it) { const int idx = tid + NTHR * it, row = idx >> 4, ch = idx & 15;
        *(LAS u32x4*)(dst + row * TP + ch * 16) = *(const u32x4*)(src + (size_t)row * ld + ch * 8); }
}

__device__ __forceinline__ void swa_unit(Frame& F, int layer, int unit) {
    const bf16* QK = wsp<bf16>(F, WS_QKR); const bf16* P = wsp<bf16>(F, WS_P);
    LAS unsigned char* Qt = F.lds; LAS unsigned char* Kt = F.lds + TILE_B; LAS unsigned char* Vt = F.lds + 2 * TILE_B;
    LAS float* stat = (LAS float*)(F.lds + 3 * TILE_B) + F.wave * 32;
    const int lane = F.lane, h = lane >> 5, wi = F.wave & 3, wh = F.wave >> 2;
    int b, qh, n, qrow0; bool isctx;
    if (unit < 512) { b = unit >> 7; qh = (unit >> 4) & 7; n = unit & 15; qrow0 = b * TL + n * 128; isctx = false; }
    else { const int u = unit - 512; b = u >> 4; qh = (u >> 1) & 7; n = u & 1; qrow0 = ML + b * TCX + n * 128; isctx = true; }
    const int kvh = qh >> 2;
    LB();
    load_tile128(Qt, QK + (size_t)qrow0 * NQK + qh * 128, NQK, F.tid);
    LB();
    bf16x8 qf[8];
#pragma unroll
    for (int ks = 0; ks < 8; ++ks) qf[ks] = frag_rm(Qt, TP, 32 * wi, 16 * ks, lane);
    const float L2E = 1.4426950408889634f, SC = 0.08838834764831845f * L2E;
    float m = inp(F, I_SINK)[layer * 8 + qh] * L2E, l = h == 0 ? 1.0f : 0.0f;
    f32x16 O0 = zero16(), O1 = zero16();
    const int iq = 32 * wi + (lane & 31);
    const int nch = isctx ? 2 : 5;
    auto chunk_info = [&](int c, int& krow0, int& mtype) -> bool {
        mtype = 0;
        if (isctx) { krow0 = ML + b * TCX + c * 128; return true; }
        if (c < 3) { const int kb = n - 1 + c; if (kb < 0 || kb > 15) return false; krow0 = b * TL + kb * 128; mtype = c == 0 ? 1 : (c == 2 ? 2 : 0); return true; }
        krow0 = ML + b * TCX + (c - 3) * 128; return true;
    };
    u32x4 pk[4], pv[4];
    auto fetch = [&](int krow0) {
#pragma unroll
        for (int it = 0; it < 4; ++it) { const int idx = F.tid + NTHR * it, row = idx >> 4, ch = idx & 15;
            pk[it] = *(const u32x4*)(QK + (size_t)(krow0 + row) * NQK + 1024 + kvh * 128 + ch * 8); pv[it] = *(const u32x4*)(P + (size_t)(krow0 + row) * LDP + C_SWA + 1280 + kvh * 128 + ch * 8); }
    };
    int c = 0, krow0 = 0, mtype = 0;
    while (!chunk_info(c, krow0, mtype)) ++c;
    fetch(krow0);
    while (c < nch) {
        const int mt = mtype;
        LB();
#pragma unroll
        for (int it = 0; it < 4; ++it) { const int idx = F.tid + NTHR * it, row = idx >> 4, ch = idx & 15; *(LAS u32x4*)(Kt + row * TP + ch * 16) = pk[it]; *(LAS u32x4*)(Vt + row * TP + ch * 16) = pv[it]; }
        LB();
        ++c; while (c < nch && !chunk_info(c, krow0, mtype)) ++c;
        if (c < nch) fetch(krow0);
        for (int kb = 0; kb < 4; ++kb) {
            f32x16 X = zero16();
#pragma unroll
            for (int ks = 0; ks < 8; ++ks) X = MFMA32(frag_rm(Kt, TP, 32 * kb, 16 * ks, lane), qf[ks], X);
            float bm = -INFINITY;
            int iql = iq - 32 * kb; asm volatile("" : "+v"(iql));
#pragma unroll
            for (int r = 0; r < 16; ++r) { const int d = iql - crow(r, h); float s = X[r] * SC;
                const bool ok = mt == 0 || (mt == 1 ? d <= 0 : d >= 0);
                s = ok ? s : -INFINITY; X[r] = s; bm = fmaxf(bm, s); }
            bm = fmaxf(bm, shx(bm, 32, lane));
            const float mn = fmaxf(m, bm), sc = __builtin_amdgcn_exp2f(m - mn); m = mn;
            float ps = 0.f;
#pragma unroll
            for (int r = 0; r < 16; ++r) { const float p = __builtin_amdgcn_exp2f(X[r] - mn); X[r] = p; ps += p; }
            l = l * sc + ps;
            const bf16x8 pa0 = pack_step(X, 0), pa1 = pack_step(X, 1);
            if (h == 0) stat[lane] = sc;
            LDS_WAIT();
#pragma unroll
            for (int g = 0; g < 4; ++g) { const f32x4 sv = *(const LAS f32x4*)(stat + 8 * g + 4 * h);
#pragma unroll
                for (int e = 0; e < 4; ++e) { O0[4 * g + e] *= sv[e]; O1[4 * g + e] *= sv[e]; } }
            O0 = MFMA32(pa0, frag_tr<true>(Vt, TP, 32 * kb, 64 * wh, lane), O0);
            O0 = MFMA32(pa1, frag_tr<true>(Vt, TP, 32 * kb + 16, 64 * wh, lane), O0);
            O1 = MFMA32(pa0, frag_tr<true>(Vt, TP, 32 * kb, 64 * wh + 32, lane), O1);
            O1 = MFMA32(pa1, frag_tr<true>(Vt, TP, 32 * kb + 16, 64 * wh + 32, lane), O1);
        }
    }
    l += shx(l, 32, lane);
    if (h == 0) stat[lane] = 1.0f / l;
    LDS_WAIT();
    bf16* yo = wsp<bf16>(F, WS_Y) + (size_t)(qrow0 + 32 * wi) * 3072 + 1024 + qh * 128 + 64 * wh + (lane & 31);
#pragma unroll
    for (int g = 0; g < 4; ++g) { const f32x4 sv = *(const LAS f32x4*)(stat + 8 * g + 4 * h);
#pragma unroll
        for (int e = 0; e < 4; ++e) { const int r = 8 * g + 4 * h + e; yo[(size_t)r * 3072] = (bf16)f2bf(O0[4 * g + e] * sv[e]); yo[(size_t)r * 3072 + 32] = (bf16)f2bf(O1[4 * g + e] * sv[e]); } }
}

constexpr size_t ST_CHUNK = (size_t)128 * 128;
__device__ __forceinline__ int ret_chunk_row0(int b, int jF) { return jF < 2 ? ML + b * TCX + jF * 128 : b * TL + (jF - 2) * 128; }
__device__ __forceinline__ void ret_state_unit(Frame& F, int layer, int unit) {
    const int dvq = unit & 3, dir = (unit >> 2) & 1, hh = (unit >> 3) & 7, b = unit >> 6;
    const bf16* P = wsp<bf16>(F, WS_P);
    bf16* ST = wsp<bf16>(F, WS_ST) + ((size_t)((b * 8 + hh) * 2 + dir) * 18) * ST_CHUNK;
    const float gam = sigm(inp(F, I_RETDEC)[(layer * 2 + dir) * 8 + hh]); const float lg2 = __builtin_amdgcn_logf(gam);
    const float gC = __builtin_amdgcn_exp2f(lg2 * 128.0f);
    LAS unsigned char* Kt = F.lds; LAS unsigned char* Vt = F.lds + TILE_B;
    constexpr int VP = 80;
    const int lane = F.lane, h = lane >> 5, w = F.wave;
    f32x16 acc = zero16();
    const float vfac = __builtin_amdgcn_exp2f(lg2 * (float)(127 - (F.tid >> 2))) * 0.08838834764831845f;
    u32x4 pkA[4], pvA, pkB[4], pvB;
#define RS_FETCH(c_, pk_, pv_) do { const int jf_ = dir == 0 ? (c_) : ((c_) < 2 ? 1 - (c_) : 19 - (c_)); const int r0_ = ret_chunk_row0(b, jf_); \
        _Pragma("unroll") for (int it = 0; it < 4; ++it) { const int idx = F.tid + NTHR * it, tp = idx >> 4, ch = idx & 15; const int row = r0_ + (dir ? 127 - tp : tp); \
            pk_[it] = *(const u32x4*)(P + (size_t)row * LDP + C_RET + 1024 + hh * 128 + ch * 8); } \
        { const int tp = F.tid >> 2, ch = F.tid & 3; const int row = r0_ + (dir ? 127 - tp : tp); \
          pv_ = *(const u32x4*)(P + (size_t)row * LDP + C_RET + 2048 + hh * 128 + dvq * 32 + ch * 8); } } while (0)
#define RS_STEP(c_, pk_, pv_) do { const int jF = dir == 0 ? (c_) : ((c_) < 2 ? 1 - (c_) : 19 - (c_)); \
        LB(); \
        _Pragma("unroll") for (int it = 0; it < 4; ++it) { const int idx = F.tid + NTHR * it, tp = idx >> 4, ch = idx & 15; *(LAS u32x4*)(Kt + tp * TP + ch * 16) = pk_[it]; } \
        { const int tp = F.tid >> 2, ch = F.tid & 3; u32x4 q_; \
          _Pragma("unroll") for (int e = 0; e < 4; ++e) q_[e] = cvtpk(bf_lo(pv_[e]) * vfac, bf_hi(pv_[e]) * vfac); \
          *(LAS u32x4*)(Vt + tp * VP + ch * 16) = q_; } \
        LB(); \
        if ((c_) + 2 < 18) RS_FETCH((c_) + 2, pk_, pv_); \
        if (w < 4) { \
            bf16* so = ST + (size_t)jF * ST_CHUNK + (size_t)(dvq * 32) * 128 + 32 * w + (lane & 31); \
            _Pragma("unroll") for (int r = 0; r < 16; ++r) so[(size_t)crow(r, h) * 128] = (bf16)f2bf(acc[r]); \
            _Pragma("unroll") for (int r = 0; r < 16; ++r) acc[r] *= gC; \
            _Pragma("unroll") for (int ks = 0; ks < 8; ++ks) acc = MFMA32(frag_tr<false>(Vt, VP, 16 * ks, 0, lane), frag_tr<false>(Kt, TP, 16 * ks, 32 * w, lane), acc); \
        } } while (0)
    RS_FETCH(0, pkA, pvA); RS_FETCH(1, pkB, pvB);
#pragma unroll 1
    for (int c = 0; c < 18; c += 2) { RS_STEP(c, pkA, pvA); RS_STEP(c + 1, pkB, pvB); }
#undef RS_FETCH
#undef RS_STEP
    LB();
}
__device__ __forceinline__ void ret_out_unit(Frame& F, int layer, int unit) {
    const int jF = unit % 18, hh = (unit / 18) & 7, b = unit / 144;
    const bf16* P = wsp<bf16>(F, WS_P);
    const int row0 = ret_chunk_row0(b, jF);
    LAS unsigned char* Qt = F.lds; LAS unsigned char* Kt = F.lds + TILE_B; LAS unsigned char* Vt = F.lds + 2 * TILE_B;
    const int lane = F.lane, h = lane >> 5, wi = F.wave & 3, wh = F.wave >> 2;
    const float lgf = __builtin_amdgcn_logf(sigm(inp(F, I_RETDEC)[(layer * 2 + 0) * 8 + hh])), lgb = __builtin_amdgcn_logf(sigm(inp(F, I_RETDEC)[(layer * 2 + 1) * 8 + hh]));
    LB();
    load_tile128(Qt, P + (size_t)row0 * LDP + C_RET + hh * 128, LDP, F.tid);
    load_tile128(Kt, P + (size_t)row0 * LDP + C_RET + 1024 + hh * 128, LDP, F.tid);
    load_tile128(Vt, P + (size_t)row0 * LDP + C_RET + 2048 + hh * 128, LDP, F.tid);
    LB();
    f32x16 Y0 = zero16(), Y1 = zero16();
    const int iq = 32 * wi + (lane & 31);
    for (int jb = 0; jb < 4; ++jb) {
        f32x16 X = zero16();
#pragma unroll
        for (int ks = 0; ks < 8; ++ks) X = MFMA32(frag_rm(Kt, TP, 32 * jb, 16 * ks, lane), frag_rm(Qt, TP, 32 * wi, 16 * ks, lane), X);
        int iql = iq - 32 * jb; asm volatile("" : "+v"(iql));
#pragma unroll
        for (int r = 0; r < 16; ++r) { const int d = iql - crow(r, h); const int ad = d < 0 ? -d : d;
            const float wgt = __builtin_amdgcn_exp2f((d > 0 ? lgf : lgb) * (float)ad) * (d == 0 ? 2.0f : 1.0f);
            X[r] *= wgt * 0.08838834764831845f; }
        const bf16x8 pa0 = pack_step(X, 0), pa1 = pack_step(X, 1);
        Y0 = MFMA32(pa0, frag_tr<true>(Vt, TP, 32 * jb, 64 * wh, lane), Y0);
        Y0 = MFMA32(pa1, frag_tr<true>(Vt, TP, 32 * jb + 16, 64 * wh, lane), Y0);
        Y1 = MFMA32(pa0, frag_tr<true>(Vt, TP, 32 * jb, 64 * wh + 32, lane), Y1);
        Y1 = MFMA32(pa1, frag_tr<true>(Vt, TP, 32 * jb + 16, 64 * wh + 32, lane), Y1);
    }
    LB();
    { const bf16* Sf = wsp<bf16>(F, WS_ST) + ((size_t)((b * 8 + hh) * 2 + 0) * 18 + jF) * ST_CHUNK; const bf16* Sb = wsp<bf16>(F, WS_ST) + ((size_t)((b * 8 + hh) * 2 + 1) * 18 + jF) * ST_CHUNK;
      load_tile128(Kt, Sf, 128, F.tid); load_tile128(Vt, Sb, 128, F.tid); }
    LB();
    {
        f32x16 T0 = zero16(), T1 = zero16(), U0 = zero16(), U1 = zero16();
#pragma unroll
        for (int ks = 0; ks < 8; ++ks) { const bf16x8 a = frag_rm(Qt, TP, 32 * wi, 16 * ks, lane);
            T0 = MFMA32(a, frag_rm(Kt, TP, 64 * wh, 16 * ks, lane), T0); T1 = MFMA32(a, frag_rm(Kt, TP, 64 * wh + 32, 16 * ks, lane), T1);
            U0 = MFMA32(a, frag_rm(Vt, TP, 64 * wh, 16 * ks, lane), U0); U1 = MFMA32(a, frag_rm(Vt, TP, 64 * wh + 32, 16 * ks, lane), U1); }
#pragma unroll
        for (int r = 0; r < 16; ++r) { const int i = 32 * wi + crow(r, h);
            const float ff = __builtin_amdgcn_exp2f(lgf * (float)(i + 1)), fb = __builtin_amdgcn_exp2f(lgb * (float)(128 - i));
            Y0[r] += ff * T0[r] + fb * U0[r]; Y1[r] += ff * T1[r] + fb * U1[r]; }
    }
    LB();
    LAS float* yl = (LAS float*)F.lds;
#pragma unroll
    for (int r = 0; r < 16; ++r) { const int i = 32 * wi + crow(r, h); yl[i * 132 + 64 * wh + (lane & 31)] = Y0[r]; yl[i * 132 + 64 * wh + 32 + (lane & 31)] = Y1[r]; }
    LB();
    { const int i = F.tid >> 2, part = F.tid & 3; const LAS float* yr = yl + i * 132 + 32 * part;
      f32x4 v[8]; float s = 0.f;
#pragma unroll
      for (int e = 0; e < 8; ++e) { v[e] = *(const LAS f32x4*)(yr + 4 * e); s += (v[e].x + v[e].y) + (v[e].z + v[e].w); }
      s += shx(s, 1, lane); s += shx(s, 2, lane); const float mean = s * (1.0f / 128.0f); float q = 0.f;
#pragma unroll
      for (int e = 0; e < 8; ++e) { v[e] = v[e] - mean; q += (v[e].x * v[e].x + v[e].y * v[e].y) + (v[e].z * v[e].z + v[e].w * v[e].w); }
      q += shx(q, 1, lane); q += shx(q, 2, lane); const float rs = 1.0f / sqrtf(q * (1.0f / 128.0f) + 1e-5f);
      const bf16* gp = P + (size_t)(row0 + i) * LDP + C_RET + 3072 + hh * 128 + 32 * part; bf16* yo = wsp<bf16>(F, WS_Y) + (size_t)(row0 + i) * 3072 + hh * 128 + 32 * part;
#pragma unroll
      for (int e2 = 0; e2 < 4; ++e2) { const u32x4 gw = *(const u32x4*)(gp + 8 * e2); u32x4 ow;
#pragma unroll
          for (int e = 0; e < 4; ++e) { const float g0 = bf_lo(gw[e]), g1 = bf_hi(gw[e]); const int vi = 2 * e2 + (e >> 1), vo = 2 * (e & 1);
              ow[e] = cvtpk(g0 * sigm(g0) * v[vi][vo] * rs, g1 * sigm(g1) * v[vi][vo + 1] * rs); }
          *(u32x4*)(yo + 8 * e2) = ow; } }
}

#ifdef RW_DEBUG
constexpr size_t WS_DBGY = WS_END;
struct RwPre { f32x4 r4, k4, v4, lw, la; };
__device__ __forceinline__ void rwkv_scan_unit(Frame& F, int layer, int unit) {
    const int rh = unit & 1, dir = (unit >> 1) & 1, h = (unit >> 2) & 15, b = unit >> 6;
    constexpr int BUF = 6 * 2048 + 1024;
    LAS float* const base = (LAS float*)F.lds;
    const float* XS = wsp<float>(F, WS_XS); const float* LR = wsp<float>(F, WS_LR); float* YD = wsp<float>(F, WS_DBGY) + (size_t)dir * MT * BW;
    const int vrow = F.tid >> 4, kq = F.tid & 15;
    const int ptok = F.tid >> 4, pj = (F.tid & 15) * 4, pc = h * 64 + pj;
    const f32x4 w0v = *(const f32x4*)(inp(F, I_W0) + ((size_t)layer * 2 + dir) * BW + pc), a0v = *(const f32x4*)(inp(F, I_A0) + ((size_t)layer * 2 + dir) * BW + pc);
    const f32x4 kkv = *(const f32x4*)(inp(F, I_KK) + (size_t)layer * BW + pc), kav = *(const f32x4*)(inp(F, I_KA) + (size_t)layer * BW + pc);
    auto fetch = [&](int blk, RwPre& p) {
        const int row = scan_row(b, dir, blk * SCAN_BLK + ptok);
        p.r4 = *(const f32x4*)(XS + (size_t)row * 3072 + pc); p.k4 = *(const f32x4*)(XS + (size_t)row * 3072 + 1024 + pc); p.v4 = *(const f32x4*)(XS + (size_t)row * 3072 + 2048 + pc);
        p.lw = *(const f32x4*)(LR + (size_t)row * NLR + dir * 1024 + pc); p.la = *(const f32x4*)(LR + (size_t)row * NLR + 2048 + dir * 1024 + pc);
    };
    auto derive = [&](const RwPre& p, LAS float* buf) {
        f32x4 dec, av, kk, kd; float ssq = 0.f;
#pragma unroll
        for (int e = 0; e < 4; ++e) { dec[e] = __expf(-0.6065306597126334f * sigm(w0v[e] + p.lw[e])); av[e] = sigm(a0v[e] + p.la[e]); kk[e] = p.k4[e] * kkv[e]; ssq += kk[e] * kk[e];
            kd[e] = p.k4[e] * (1.0f + (av[e] - 1.0f) * kav[e]); }
        ssq += __int_as_float(__builtin_amdgcn_update_dpp(0, __float_as_int(ssq), 0xB1, 0xF, 0xF, true));
        ssq += __int_as_float(__builtin_amdgcn_update_dpp(0, __float_as_int(ssq), 0x4E, 0xF, 0xF, true));
        ssq += __int_as_float(__builtin_amdgcn_update_dpp(0, __float_as_int(ssq), 0x141, 0xF, 0xF, true));
        ssq += __int_as_float(__builtin_amdgcn_update_dpp(0, __float_as_int(ssq), 0x140, 0xF, 0xF, true));
        const float inv = 1.0f / fmaxf(sqrtf(ssq), 1e-12f);
        f32x4 an, bn;
#pragma unroll
        for (int e = 0; e < 4; ++e) { const float kn = kk[e] * inv; an[e] = -kn; bn[e] = kn * av[e]; }
        const int o = ptok * 64 + pj;
        *(LAS f32x4*)(buf + o) = p.r4; *(LAS f32x4*)(buf + 2048 + o) = dec; *(LAS f32x4*)(buf + 4096 + o) = kd; *(LAS f32x4*)(buf + 6144 + o) = p.v4; *(LAS f32x4*)(buf + 8192 + o) = an; *(LAS f32x4*)(buf + 10240 + o) = bn;
    };
    f32x2 S0 = {0.f, 0.f}, S1 = S0;
    RwPre pre;
    __syncthreads();
    fetch(0, pre); derive(pre, base);
    __syncthreads();
    constexpr int NBLK = NSTEP / SCAN_BLK;
    for (int blk = 0; blk < NBLK; ++blk) {
        LAS float* cur = base + (blk & 1) * BUF; LAS float* nxt = base + ((blk + 1) & 1) * BUF;
        if (blk + 1 < NBLK) fetch(blk + 1, pre);
        const LAS float* Rl = cur; const LAS float* Wl = cur + 2048; const LAS float* Kl = cur + 4096; const LAS float* Vl = cur + 6144; const LAS float* Al = cur + 8192; const LAS float* Bl = cur + 10240; LAS float* Yl = cur + 12288;
        const int ob = 4 * kq, vb = 32 * rh + vrow;
        f32x4 a0 = *(const LAS f32x4*)(Al + ob), w0 = *(const LAS f32x4*)(Wl + ob), b0 = *(const LAS f32x4*)(Bl + ob), k0 = *(const LAS f32x4*)(Kl + ob), r0 = *(const LAS f32x4*)(Rl + ob);
        float vv = Vl[vb];
#pragma unroll 8
        for (int tok = 0; tok < SCAN_BLK; ++tok) {
            const int on = ((tok + 1) & (SCAN_BLK - 1)) * 64;
            const f32x4 a1 = *(const LAS f32x4*)(Al + on + ob), w1 = *(const LAS f32x4*)(Wl + on + ob), b1 = *(const LAS f32x4*)(Bl + on + ob), k1 = *(const LAS f32x4*)(Kl + on + ob), r1 = *(const LAS f32x4*)(Rl + on + ob);
            const float vn = Vl[on + vb];
            f32x2 t = S0 * a0.xy; t += S1 * a0.zw;
            const float sa = red16(t.x + t.y);
            const f32x2 sa2 = {sa, sa}, vv2 = {vv, vv};
            S0 = S0 * w0.xy + (sa2 * b0.xy + vv2 * k0.xy); S1 = S1 * w0.zw + (sa2 * b0.zw + vv2 * k0.zw);
            f32x2 u = S0 * r0.xy; u += S1 * r0.zw;
            const float y = red16(u.x + u.y);
            Yl[tok * 32 + vrow] = y;
            a0 = a1; w0 = w1; b0 = b1; k0 = k1; r0 = r1; vv = vn;
        }
        if (blk + 1 < NBLK) derive(pre, nxt);
        __syncthreads();
        if (F.tid < 256) { const int e = F.tid * 4, tok = e >> 5, j = e & 31; const int row = scan_row(b, dir, blk * SCAN_BLK + tok);
          *(f32x4*)(YD + (size_t)row * BW + h * 64 + 32 * rh + j) = *(const LAS f32x4*)(Yl + e); }
    }
    __syncthreads();
}
#endif
constexpr int RW_NCH = 36, RW_NU = NB * 16 * 2 * RW_NCH;
constexpr int RWP = 144;
constexpr int RWS = 64 * RWP;
__device__ __forceinline__ int rw_row0(int b, int jF) { return jF < 4 ? ML + b * TCX + 64 * jF : b * TL + 64 * (jF - 4); }
enum { RM = 0, TR = 1 };
template <int AM, int BM_> __device__ __forceinline__ f32x16 mm64(const LAS unsigned char* A, const LAS unsigned char* B, int tb, int sb, int lane, f32x16 acc) {
#pragma unroll
    for (int ks = 0; ks < 4; ++ks) {
        const bf16x8 a = AM == RM ? frag_rm(A, RWP, 32 * tb, 16 * ks, lane) : frag_tr<false>(A, RWP, 16 * ks, 32 * tb, lane);
        const bf16x8 b = BM_ == RM ? frag_rm(B, RWP, 32 * sb, 16 * ks, lane) : frag_tr<false>(B, RWP, 16 * ks, 32 * sb, lane);
        acc = MFMA32(a, b, acc); }
    return acc;
}
__device__ __forceinline__ void store_tile_bf16(LAS unsigned char* T, const f32x16& x, int tb, int sb, int lane) {
    const int h = lane >> 5; LAS unsigned short* p = (LAS unsigned short*)(T + (32 * tb) * RWP) + 32 * sb + (lane & 31);
#pragma unroll
    for (int r = 0; r < 16; ++r) p[crow(r, h) * (RWP / 2)] = (unsigned short)(cvtpk(x[r], 0.f) & 0xffffu);
}
__device__ __forceinline__ bf16x8 gfrag_perm(const bf16* X, int ld, int m0, int k0, int lane) {
    const bf16* p = X + (size_t)(m0 + (lane & 31)) * ld + k0 + 4 * (lane >> 5);
    const u32x2 lo = *(const u32x2*)p, hi = *(const u32x2*)(p + 8);
    u32x4 w; w.x = lo.x; w.y = lo.y; w.z = hi.x; w.w = hi.y; return __builtin_bit_cast(bf16x8, w);
}
template <bool REV> __device__ __forceinline__ void tri_inv16(const LAS float* AD, LAS unsigned char* T, int lane_) {
    int lane = lane_; asm volatile("" : "+v"(lane));
    const int blk = lane >> 4, j = lane & 15; const LAS float* A = AD + blk * 16 * 20;
    float x[16];
#pragma unroll
    for (int i = 0; i < 16; ++i) { const int t = REV ? 15 - i : i; float a0 = (j == t) ? 1.0f : 0.0f, a1 = 0.0f;
#pragma unroll
        for (int s4 = 0; s4 < 16; s4 += 4) { if (REV ? (s4 + 3 > t) : (s4 < t)) { const f32x4 a = *(const LAS f32x4*)(A + t * 20 + s4);
#pragma unroll
                for (int e = 0; e < 4; ++e) { const int s = s4 + e; if (REV ? (s > t) : (s < t)) { if (e & 1) a1 = fmaf(a[e], x[s], a1); else a0 = fmaf(a[e], x[s], a0); } } } }
        x[t] = a0 + a1; asm volatile("" ::: "memory"); }
    LAS unsigned short* tp = (LAS unsigned short*)T + (16 * blk) * (RWP / 2) + 16 * blk + j;
#pragma unroll
    for (int s = 0; s < 16; ++s) tp[s * (RWP / 2)] = (unsigned short)(cvtpk(x[s], 0.f) & 0xffffu);
}
struct RwIn { f32x4 x[6]; f32x4 l[4]; };
__device__ __forceinline__ void rw_fetch_x(Frame& F, int unit, int tid, RwIn& p) {
    const int jF = unit % RW_NCH, hh = (unit / RW_NCH) & 15, b = unit / (RW_NCH * 16);
    const float* xr = wsp<float>(F, WS_XS) + (size_t)(rw_row0(b, jF) + (tid >> 3)) * 3072 + hh * 64 + (tid & 7) * 8;
    p.x[0] = *(const f32x4*)xr; p.x[1] = *(const f32x4*)(xr + 4); p.x[2] = *(const f32x4*)(xr + 1024); p.x[3] = *(const f32x4*)(xr + 1028); p.x[4] = *(const f32x4*)(xr + 2048); p.x[5] = *(const f32x4*)(xr + 2052);
}
__device__ __forceinline__ void rw_fetch_l(Frame& F, int unit, int dir, int tid, RwIn& p) {
    const int jF = unit % RW_NCH, hh = (unit / RW_NCH) & 15, b = unit / (RW_NCH * 16);
    const float* lr = wsp<float>(F, WS_LR) + (size_t)(rw_row0(b, jF) + (tid >> 3)) * NLR + dir * 1024 + hh * 64 + (tid & 7) * 8;
    p.l[0] = *(const f32x4*)lr; p.l[1] = *(const f32x4*)(lr + 4); p.l[2] = *(const f32x4*)(lr + 2048); p.l[3] = *(const f32x4*)(lr + 2052);
}
__device__ __forceinline__ void rw_local_unit(Frame& F, int layer, int unit, int unit_next, RwIn& in) {
    const int jF = unit % RW_NCH, hh = (unit / RW_NCH) & 15, b = unit / (RW_NCH * 16);
    const int row0 = rw_row0(b, jF);
    LAS unsigned char* const L = F.lds;
    LAS unsigned char* sAh = L; LAS unsigned char* sRh = L + RWS; LAS unsigned char* sBh = L + 2 * RWS; LAS unsigned char* sKh = L + 3 * RWS; LAS unsigned char* sBt = L + 4 * RWS; LAS unsigned char* sKt = L + 5 * RWS;
    LAS unsigned char* sV = L + 6 * RWS; LAS unsigned char* sAAK = L + 7 * RWS; LAS unsigned char* sARB = L + 8 * RWS; LAS unsigned char* sARK = L + 9 * RWS; LAS unsigned char* sPm = L + 10 * RWS; LAS unsigned char* sTm = L + 11 * RWS;
    LAS unsigned char* sM1 = sAAK; LAS unsigned char* sVT = sKh; LAS unsigned char* sWW = sPm;
    LAS float* CL = (LAS float*)(L + 12 * RWS);
    const int w = F.wave, grp = w >> 2, tb = (w >> 1) & 1, sb = w & 1;
    float r8[8], k8[8], kn8[8];
    { int tl_ = F.tid; asm volatile("" : "+v"(tl_)); const int t = tl_ >> 3, j0 = (tl_ & 7) * 8, c0 = hh * 64 + j0;
      const f32x4 ra = in.x[0], rb = in.x[1], ka = in.x[2], kb = in.x[3], va = in.x[4], vb = in.x[5];
      const f32x4 kka = *(const f32x4*)(inp(F, I_KK) + layer * BW + c0), kkb = *(const f32x4*)(inp(F, I_KK) + layer * BW + c0 + 4);
      float ssq = 0.f;
#pragma unroll
      for (int e = 0; e < 4; ++e) { r8[e] = ra[e]; r8[4 + e] = rb[e]; k8[e] = ka[e]; k8[4 + e] = kb[e]; kn8[e] = ka[e] * kka[e]; kn8[4 + e] = kb[e] * kkb[e]; }
#pragma unroll
      for (int e = 0; e < 8; ++e) ssq += kn8[e] * kn8[e];
      ssq = red8(ssq); const float inv = 1.0f / fmaxf(sqrtf(ssq), 1e-12f);
#pragma unroll
      for (int e = 0; e < 8; ++e) kn8[e] *= inv;
      LB();
      u32x4 vw; vw.x = cvtpk(va[0], va[1]); vw.y = cvtpk(va[2], va[3]); vw.z = cvtpk(vb[0], vb[1]); vw.w = cvtpk(vb[2], vb[3]);
      *(LAS u32x4*)(sV + t * RWP + j0 * 2) = vw; }
    for (int dir = 0; dir < 2; ++dir) {
        const int ui = ((b * 16 + hh) * 2 + dir) * RW_NCH + jF;
        int tl_ = F.tid; asm volatile("" : "+v"(tl_)); const int t = tl_ >> 3, j0 = (tl_ & 7) * 8, c0 = hh * 64 + j0;
        float lw8[8], as8[8];
        { const f32x4 wa = in.l[0], wb = in.l[1], aa = in.l[2], ab = in.l[3];
          const float* w0p = inp(F, I_W0) + ((size_t)layer * 2 + dir) * BW + c0; const float* a0p = inp(F, I_A0) + ((size_t)layer * 2 + dir) * BW + c0;
          const f32x4 w0a = *(const f32x4*)w0p, w0b = *(const f32x4*)(w0p + 4), a0a = *(const f32x4*)a0p, a0b = *(const f32x4*)(a0p + 4);
#pragma unroll
          for (int e = 0; e < 4; ++e) { lw8[e] = -0.6065306597126334f * sigm(w0a[e] + wa[e]); lw8[4 + e] = -0.6065306597126334f * sigm(w0b[e] + wb[e]); as8[e] = sigm(a0a[e] + aa[e]); as8[4 + e] = sigm(a0b[e] + ab[e]); } }
        float cl8[8], ce8[8];
        { const int ln = F.lane;
#pragma unroll
          for (int e = 0; e < 8; ++e) cl8[e] = lw8[e];
#pragma unroll
          for (int d = 8; d < 64; d <<= 1) {
#pragma unroll
              for (int e = 0; e < 8; ++e) { const float o = shx_from(cl8[e], dir ? ln + d : ln - d); cl8[e] += (dir ? (ln + d < 64) : (ln >= d)) ? o : 0.f; } }
          LAS float* WT = CL;
          if ((ln >> 3) == (dir ? 0 : 7)) { *(LAS f32x4*)(WT + w * 64 + j0) = (f32x4){cl8[0], cl8[1], cl8[2], cl8[3]}; *(LAS f32x4*)(WT + w * 64 + j0 + 4) = (f32x4){cl8[4], cl8[5], cl8[6], cl8[7]}; }
          LB();
#pragma unroll
          for (int e = 0; e < 8; ++e) ce8[e] = 0.f;
#pragma unroll
          for (int ww = 0; ww < 8; ++ww) { const f32x4 a = *(const LAS f32x4*)(WT + ww * 64 + j0), b2 = *(const LAS f32x4*)(WT + ww * 64 + j0 + 4); const bool before = dir ? ww > w : ww < w;
#pragma unroll
              for (int e = 0; e < 4; ++e) { ce8[e] += a[e]; ce8[4 + e] += b2[e]; if (before) { cl8[e] += a[e]; cl8[4 + e] += b2[e]; } } }
          if (t == 0) { float* gm = wsp<float>(F, WS_RWG) + (size_t)ui * 64 + j0;
              *(f32x4*)gm = (f32x4){__expf(ce8[0]), __expf(ce8[1]), __expf(ce8[2]), __expf(ce8[3])}; *(f32x4*)(gm + 4) = (f32x4){__expf(ce8[4]), __expf(ce8[5]), __expf(ce8[6]), __expf(ce8[7])}; } }
        { const float* kap = inp(F, I_KA) + layer * BW + c0; const f32x4 kaa = *(const f32x4*)kap, kab = *(const f32x4*)(kap + 4);
          float oA[8], oR[8], oB[8], oK[8], oBt[8], oKt[8];
#pragma unroll
          for (int e = 0; e < 8; ++e) { const float cl = cl8[e], ce = ce8[e], kav = e < 4 ? kaa[e] : kab[e - 4];
              const float ex = __expf(cl), exm = __expf(-cl), exx = __expf(cl - lw8[e]), ext = __expf(ce - cl);
              const float kd = k8[e] * (1.0f + (as8[e] - 1.0f) * kav), bb = kn8[e] * as8[e];
              oA[e] = -kn8[e] * exx; oR[e] = r8[e] * ex; oB[e] = bb * exm; oK[e] = kd * exm; oBt[e] = bb * ext; oKt[e] = kd * ext; }
          const int o = t * RWP + j0 * 2;
#define RW_ST8(slot, a) do { u32x4 q_; q_.x = cvtpk(a[0], a[1]); q_.y = cvtpk(a[2], a[3]); q_.z = cvtpk(a[4], a[5]); q_.w = cvtpk(a[6], a[7]); *(LAS u32x4*)((slot) + o) = q_; } while (0)
          RW_ST8(sAh, oA); RW_ST8(sRh, oR); RW_ST8(sBh, oB); RW_ST8(sKh, oK); RW_ST8(sBt, oBt); RW_ST8(sKt, oKt);
#undef RW_ST8
        }
        if (dir == 0) rw_fetch_l(F, unit, 1, tl_, in);
        else if (unit_next >= 0) { rw_fetch_x(F, unit_next, tl_, in); rw_fetch_l(F, unit_next, 0, tl_, in); }
        LB();
        int lane = F.lane; asm volatile("" : "+v"(lane)); const int h = lane >> 5;
        const int tq = 32 * tb + 4 * h, sq = 32 * sb + (lane & 31);
        LAS float* AD16 = CL + 1024;
        const int pB = dir ? 0 : 1, qB = 1 - pB;
        if (grp == 0) {
            f32x16 X1 = mm64<RM, RM>(sAh, sBh, tb, sb, lane, zero16()), X2 = mm64<RM, RM>(sAh, sKh, tb, sb, lane, zero16());
#pragma unroll
            for (int r = 0; r < 16; ++r) { const int d = (tq + (r & 3) + 8 * (r >> 2)) - sq; const bool keep = (dir ? -d : d) > 0; X1[r] = keep ? X1[r] : 0.f; X2[r] = keep ? X2[r] : 0.f; }
            LB();
            store_tile_bf16(sAAK, X2, tb, sb, lane);
            { f32x16 A1, A2; const int sl = lane & 31;
#pragma unroll
              for (int r = 0; r < 16; ++r) { const int tl = (r & 3) + 8 * (r >> 2) + 4 * h; const bool same16 = (tl >> 4) == (sl >> 4);
                  A1[r] = (tb == sb && !same16) ? X1[r] : 0.f; A2[r] = (tb == pB && sb == qB) ? X1[r] : 0.f;
                  if (tb == sb && same16) AD16[((2 * tb + (tl >> 4)) * 16 + (tl & 15)) * 20 + (sl & 15)] = X1[r]; }
              store_tile_bf16(sPm, A1, tb, sb, lane); store_tile_bf16(sKh, A2, tb, sb, lane); store_tile_bf16(sTm, zero16(), tb, sb, lane); }
            LB();
            if (w == 0) { if (dir == 0) tri_inv16<false>(AD16, sTm, lane); else tri_inv16<true>(AD16, sTm, lane); }
            LB();
#pragma unroll 1
            for (int lvl = 0; lvl < 2; ++lvl) {
                f32x16 Mx = mm64<RM, TR>(lvl == 0 ? sPm : sKh, sTm, tb, sb, lane, zero16());
#pragma unroll
                for (int r = 0; r < 16; ++r) { const int d = (tq + (r & 3) + 8 * (r >> 2)) - sq; Mx[r] += d == 0 ? 1.0f : 0.f; }
                LB();
                store_tile_bf16(sBh, Mx, tb, sb, lane);
                LB();
                const f32x16 Tn = mm64<RM, TR>(sTm, sBh, tb, sb, lane, zero16());
                LB();
                store_tile_bf16(sTm, Tn, tb, sb, lane);
                LB();
            }
            { const f32x16 Wt = mm64<RM, TR>(sTm, sAh, tb, sb, lane, zero16()); store_tile_bf16(sWW, Wt, tb, sb, lane); }
            LB();
            { f32x16 QtT = mm64<TR, RM>(sWW, sARB, tb, sb, lane, zero16());
#pragma unroll
              for (int r = 0; r < 16; ++r) QtT[r] += bf2f(((const LAS unsigned short*)(sRh + sq * RWP))[32 * tb + crow(r, h)]);
              int l4 = lane; asm volatile("" : "+v"(l4));
              u32x4* qo = (u32x4*)(wsp<bf16>(F, WS_RWQ) + (size_t)ui * 4096) + ((sb * 2 + tb) * 2) * 64 + l4;
              qo[0] = __builtin_bit_cast(u32x4, pack_step(QtT, 0)); qo[64] = __builtin_bit_cast(u32x4, pack_step(QtT, 1));
              const f32x16 PpT = mm64<TR, TR>(sWW, sBt, tb, sb, lane, zero16());
              u32x4* po = (u32x4*)(wsp<bf16>(F, WS_RWP) + (size_t)ui * 4096) + ((sb * 2 + tb) * 2) * 64 + l4;
              po[0] = __builtin_bit_cast(u32x4, pack_step(PpT, 0)); po[64] = __builtin_bit_cast(u32x4, pack_step(PpT, 1)); }
            LB();
        } else {
            f32x16 X1 = mm64<RM, RM>(sRh, sBh, tb, sb, lane, zero16()), X2 = mm64<RM, RM>(sRh, sKh, tb, sb, lane, zero16());
#pragma unroll
            for (int r = 0; r < 16; ++r) { const int d = (tq + (r & 3) + 8 * (r >> 2)) - sq; const bool keep = (dir ? -d : d) >= 0; X1[r] = keep ? X1[r] : 0.f; X2[r] = keep ? X2[r] : 0.f; }
            LB();
            store_tile_bf16(sARB, X1, tb, sb, lane); store_tile_bf16(sARK, X2, tb, sb, lane);
            LB();
            X1 = mm64<RM, TR>(sAAK, sV, tb, sb, lane, zero16());
            f32x16 accY = mm64<RM, TR>(sARK, sV, tb, sb, lane, zero16()), accH = mm64<TR, TR>(sKt, sV, tb, sb, lane, zero16());
            LB();
            store_tile_bf16(sM1, X1, tb, sb, lane);
#pragma unroll 1
            for (int i = 0; i < 8; ++i) LB();
            { const f32x16 Vx = mm64<RM, TR>(sTm, sM1, tb, sb, lane, zero16()); store_tile_bf16(sVT, Vx, tb, sb, lane); }
            LB();
            accY = mm64<RM, TR>(sARB, sVT, tb, sb, lane, accY); accH = mm64<TR, TR>(sBt, sVT, tb, sb, lane, accH);
            int l4 = lane; asm volatile("" : "+v"(l4));
            f32x4* yo = (f32x4*)(wsp<float>(F, WS_RWY) + (size_t)ui * 4096 + (tb * 2 + sb) * 1024 + l4 * 16);
            f32x4* ho = (f32x4*)(wsp<float>(F, WS_RWH) + (size_t)ui * 4096 + (tb * 2 + sb) * 1024 + l4 * 16);
#pragma unroll
            for (int g = 0; g < 4; ++g) { yo[g] = (f32x4){accY[4 * g], accY[4 * g + 1], accY[4 * g + 2], accY[4 * g + 3]}; ho[g] = (f32x4){accH[4 * g], accH[4 * g + 1], accH[4 * g + 2], accH[4 * g + 3]}; }
            LB();
        }
    }
}
struct RwStep { bf16x8 pf[2][2][2]; f32x4 hh[2][4]; f32x4 gm[2][4]; };
__device__ __forceinline__ void rw_seq_task(Frame& F, int task, int lane) {
    const int vb = task & 1, dir = (task >> 1) & 1, bh = task >> 2, h = lane >> 5;
    auto fetch = [&](int c, RwStep& s) {
        const int jF = dir == 0 ? c : (c < 4 ? 3 - c : 39 - c); const size_t ui = (size_t)(bh * 2 + dir) * RW_NCH + jF;
        const bf16* pp = wsp<bf16>(F, WS_RWP) + ui * 4096; const float* hp = wsp<float>(F, WS_RWH) + ui * 4096; const float* gp = wsp<float>(F, WS_RWG) + ui * 64;
#pragma unroll
        for (int ko = 0; ko < 2; ++ko) {
#pragma unroll
            for (int ki = 0; ki < 2; ++ki) { const u32x4* pq = (const u32x4*)pp + ((ko * 2 + ki) * 2) * 64 + lane; s.pf[ko][ki][0] = __builtin_bit_cast(bf16x8, pq[0]); s.pf[ko][ki][1] = __builtin_bit_cast(bf16x8, pq[64]); }
#pragma unroll
            for (int g = 0; g < 4; ++g) { s.hh[ko][g] = *(const f32x4*)(hp + (ko * 2 + vb) * 1024 + lane * 16 + 4 * g); s.gm[ko][g] = *(const f32x4*)(gp + 32 * ko + 8 * g + 4 * h); } }
    };
    f32x16 S0 = zero16(), S1 = zero16(); unsigned touch = 0u;
    RwStep cur; fetch(0, cur);
#pragma unroll 1
    for (int c = 0; c < RW_NCH; ++c) {
        RwStep nxt; fetch(c + 1 < RW_NCH ? c + 1 : c, nxt);
        { const int cf = c + 3 < RW_NCH ? c + 3 : RW_NCH - 1; const int jf = dir == 0 ? cf : (cf < 4 ? 3 - cf : 39 - cf); const size_t uf = (size_t)(bh * 2 + dir) * RW_NCH + jf;
          const unsigned t0 = *(const unsigned*)((const char*)(wsp<bf16>(F, WS_RWP) + uf * 4096) + lane * 128);
          const unsigned t1 = *(const unsigned*)((const char*)(wsp<float>(F, WS_RWH) + uf * 4096 + ((lane >> 5) * 2 + vb) * 1024) + (lane & 31) * 128);
          touch ^= t0 ^ t1; }
        const int jF = dir == 0 ? c : (c < 4 ? 3 - c : 39 - c); const size_t ui = (size_t)(bh * 2 + dir) * RW_NCH + jF;
        const bf16x8 b00 = pack_step(S0, 0), b01 = pack_step(S0, 1), b10 = pack_step(S1, 0), b11 = pack_step(S1, 1);
        u32x4* so = (u32x4*)(wsp<bf16>(F, WS_RWS) + ui * 4096) + lane;
        so[((0 * 2 + vb) * 2 + 0) * 64] = __builtin_bit_cast(u32x4, b00); so[((0 * 2 + vb) * 2 + 1) * 64] = __builtin_bit_cast(u32x4, b01);
        so[((1 * 2 + vb) * 2 + 0) * 64] = __builtin_bit_cast(u32x4, b10); so[((1 * 2 + vb) * 2 + 1) * 64] = __builtin_bit_cast(u32x4, b11);
        f32x16 n0, n1;
#pragma unroll
        for (int r = 0; r < 16; ++r) { n0[r] = cur.hh[0][r >> 2][r & 3] + cur.gm[0][r >> 2][r & 3] * S0[r]; n1[r] = cur.hh[1][r >> 2][r & 3] + cur.gm[1][r >> 2][r & 3] * S1[r]; }
        n0 = MFMA32(cur.pf[0][0][0], b00, n0); n1 = MFMA32(cur.pf[1][0][0], b00, n1);
        n0 = MFMA32(cur.pf[0][0][1], b01, n0); n1 = MFMA32(cur.pf[1][0][1], b01, n1);
        n0 = MFMA32(cur.pf[0][1][0], b10, n0); n1 = MFMA32(cur.pf[1][1][0], b10, n1);
        n0 = MFMA32(cur.pf[0][1][1], b11, n0); n1 = MFMA32(cur.pf[1][1][1], b11, n1);
        S0 = n0; S1 = n1; cur = nxt;
    }
    if (touch == 0x9e3779b9u) wsp<unsigned>(F, WS_CTL)[CW_DBG + 64] = touch;
}
__device__ __forceinline__ void rw_out_unit(Frame& F, int layer, int unit) {
    const int jF = unit % RW_NCH, hh = (unit / RW_NCH) & 15, b = unit / (RW_NCH * 16);
    const int row0 = rw_row0(b, jF);
    const int lane = F.lane, h = lane >> 5, w = F.wave, dir = w >> 2, tb = (w >> 1) & 1, vb = w & 1;
    LAS float* YS = (LAS float*)F.lds;
    {
        const size_t ui = (size_t)((b * 16 + hh) * 2 + dir) * RW_NCH + jF;
        const float* yl = wsp<float>(F, WS_RWY) + ui * 4096 + (tb * 2 + vb) * 1024 + lane * 16;
        f32x16 acc;
#pragma unroll
        for (int g = 0; g < 4; ++g) { const f32x4 v = *(const f32x4*)(yl + 4 * g); acc[4 * g] = v.x; acc[4 * g + 1] = v.y; acc[4 * g + 2] = v.z; acc[4 * g + 3] = v.w; }
        const bf16* qt = wsp<bf16>(F, WS_RWQ) + ui * 4096; const u32x4* s0 = (const u32x4*)(wsp<bf16>(F, WS_RWS) + ui * 4096) + lane;
#pragma unroll
        for (int kb = 0; kb < 2; ++kb)
#pragma unroll
            for (int s = 0; s < 2; ++s) acc = MFMA32(__builtin_bit_cast(bf16x8, ((const u32x4*)qt)[((tb * 2 + kb) * 2 + s) * 64 + lane]), __builtin_bit_cast(bf16x8, s0[((kb * 2 + vb) * 2 + s) * 64]), acc);
        LB();
        LAS float* yd = YS + dir * 64 * 68 + (32 * tb) * 68 + 32 * vb + (lane & 31);
#pragma unroll
        for (int r = 0; r < 16; ++r) yd[crow(r, h) * 68] = acc[r];
    }
    LB();
    {
        const int t = F.tid >> 3, j0 = (F.tid & 7) * 8, c0 = hh * 64 + j0; const int row = row0 + t;
        const float* XS = wsp<float>(F, WS_XS) + (size_t)row * 3072 + c0; const float* LR = wsp<float>(F, WS_LR) + (size_t)row * NLR + c0;
        float y[8], s = 0.f;
#pragma unroll
        for (int e = 0; e < 2; ++e) { const f32x4 a = *(const LAS f32x4*)(YS + t * 68 + j0 + 4 * e), b2 = *(const LAS f32x4*)(YS + 64 * 68 + t * 68 + j0 + 4 * e);
#pragma unroll
            for (int q = 0; q < 4; ++q) { y[4 * e + q] = a[q] + b2[q]; s += y[4 * e + q]; } }
        const float mean = red8(s) * (1.0f / 64.0f); float q2 = 0.f;
#pragma unroll
        for (int e = 0; e < 8; ++e) { y[e] -= mean; q2 += y[e] * y[e]; }
        const float rs = 1.0f / sqrtf(red8(q2) * (1.0f / 64.0f) + 64e-5f);
        float dp = 0.f; float ov[8];
#pragma unroll
        for (int e = 0; e < 2; ++e) {
            const f32x4 r = *(const f32x4*)(XS + 4 * e), k = *(const f32x4*)(XS + 1024 + 4 * e);
            const f32x4 ka = *(const f32x4*)(inp(F, I_KA) + layer * BW + c0 + 4 * e), rk = *(const f32x4*)(inp(F, I_RK) + layer * BW + c0 + 4 * e);
            const f32x4 a0p = *(const f32x4*)(inp(F, I_A0) + ((size_t)layer * 2 + 0) * BW + c0 + 4 * e) + *(const f32x4*)(LR + 2048 + 4 * e);
            const f32x4 a1p = *(const f32x4*)(inp(F, I_A0) + ((size_t)layer * 2 + 1) * BW + c0 + 4 * e) + *(const f32x4*)(LR + 3072 + 4 * e);
#pragma unroll
            for (int q = 0; q < 4; ++q) dp += r[q] * (k[q] * (2.0f + (sigm(a0p[q]) + sigm(a1p[q]) - 2.0f) * ka[q])) * rk[q]; }
        const float dot = red8(dp);
#pragma unroll
        for (int e = 0; e < 2; ++e) { const f32x4 v = *(const f32x4*)(XS + 2048 + 4 * e), g = *(const f32x4*)(LR + 4096 + 4 * e), lng = *(const f32x4*)(inp(F, I_LNG) + layer * BW + c0 + 4 * e);
#pragma unroll
            for (int q = 0; q < 4; ++q) ov[4 * e + q] = (y[4 * e + q] * rs * lng[q] + dot * v[q]) * g[q]; }
        u32x4 o; o.x = cvtpk(ov[0], ov[1]); o.y = cvtpk(ov[2], ov[3]); o.z = cvtpk(ov[4], ov[5]); o.w = cvtpk(ov[6], ov[7]);
        *(u32x4*)(wsp<bf16>(F, WS_Y) + (size_t)row * 3072 + 2048 + c0) = o;
    }
}

__device__ __forceinline__ void mixa_phase(Frame& F, int layer) {
    constexpr int NU = NB * 16 * RW_NCH;
    if (F.wg < NU) { RwIn in; rw_fetch_x(F, F.wg, F.tid, in); rw_fetch_l(F, F.wg, 0, F.tid, in);
        for (int u = F.wg; u < NU; u += F.G) rw_local_unit(F, layer, u, u + F.G < NU ? u + F.G : -1, in); }
    __syncthreads();
}
__device__ __forceinline__ void mix_phase(Frame& F, int layer, int qidx, int mode = 3) {
#ifdef RW_DEBUG
    for (int u = F.wg; u < 256; u += F.G) rwkv_scan_unit(F, layer, u);
    __syncthreads();
#endif
    if (mode & 1) { for (int tk = F.wg * NWAVES + F.wave; tk < 256; tk += F.G * NWAVES) rw_seq_task(F, tk, F.lane); }
    if (!(mode & 2)) return;
    const int nswa = (layer == NL - 1) ? 512 : 576;
    const int nitem = 256 + nswa;
    volatile LAS int* qslot = (volatile LAS int*)(F.lds + LDSCTL_OFF);
    for (;;) {
        __syncthreads();
        if (F.tid == 0) qslot[0] = (int)__hip_atomic_fetch_add(F.ctl + CW_SWAQ + 64 * qidx, 1u, __ATOMIC_RELAXED, __HIP_MEMORY_SCOPE_AGENT);
        __syncthreads();
        const int item = qslot[0];
        if (item >= nitem) break;
        if (item < 256) ret_state_unit(F, layer, item); else swa_unit(F, layer, item - 256);
    }
}
__device__ __forceinline__ void mixfin_phase(Frame& F, int layer, int nrows) {
    for (int u = F.wg; u < 576; u += F.G) { if (layer == NL - 1 && (u % 18) < 2) continue; ret_out_unit(F, layer, u); }
    __syncthreads();
    for (int u = F.wg; u < NB * 16 * RW_NCH; u += F.G) { if (layer == NL - 1 && (u % RW_NCH) < 4) continue; rw_out_unit(F, layer, u); }
    __syncthreads();
}

constexpr int NPH = 12;
constexpr int NSTEPS = 2 + NL * NPH + 1;
__global__ void __launch_bounds__(NTHR, 2) hyb_fwd(Args args) {
    extern __shared__ __attribute__((aligned(16))) unsigned char lds[];
    Frame F;
    F.lds = (LAS unsigned char*)lds;
    F.tid = threadIdx.x; F.lane = F.tid & 63; F.wave = __builtin_amdgcn_readfirstlane(F.tid >> 6);
    const int wv0 = F.wave;
    F.G = gridDim.x; F.wg = blockIdx.x; F.ws = args.ws; F.ctl = (unsigned*)(args.ws + WS_CTL);
    for (int u = F.tid; u < (LDS_BYTES - LDSCTL_OFF) / 4; u += NTHR) ((LAS unsigned*)(F.lds + LDSCTL_OFF))[u] = 0u;
    __syncthreads();
    if (F.tid < 26) { const __attribute__((address_space(4))) unsigned long long* kp = (const __attribute__((address_space(4))) unsigned long long*)__builtin_amdgcn_kernarg_segment_ptr();
        ((LAS unsigned long long*)(F.lds + PTAB_OFF))[F.tid] = kp[F.tid]; }
    __syncthreads();
    XcdBarrier bar = xcd_barrier_post(F.ctl + CW_BAR, (volatile LAS unsigned*)(F.lds + MISC_OFF) + 8);
    int lo = args.s_lo, hi = args.s_hi;
#define IN(k) (lo <= (k) && (k) < hi)
#define SL() do { size_t z_ = 0; asm volatile("" : "+s"(lo), "+s"(hi), "+s"(z_), "+s"(F.wg), "+s"(F.G)); F.ws = args.ws + z_; } while (0)
#define LAUNDER() do { int t_ = wv0 * 64 + lane_now(); asm volatile("" : "+v"(t_)); F.tid = t_; F.lane = t_ & 63; F.wave = __builtin_amdgcn_readfirstlane(t_ >> 6); } while (0)
#define SEAM(k) do { SL(); if (IN(k) && IN((k) + 1)) xcd_barrier(bar, wv0 == 0 && lane_now() == 0); } while (0)
    SL(); if (IN(0)) { LAUNDER(); p0_prologue(F); }
#ifdef PROBE_P0
    SL(); if (IN(0)) { xcd_barrier(bar, wv0 == 0 && lane_now() == 0); LAUNDER(); p0_prologue(F); }
#endif
    SEAM(0);
    SL(); if (IN(1)) { LAUNDER(); p1_modreduce(F); }
    SEAM(1);
    for (int layer_ = 0; layer_ < NL; ++layer_) {
        int layer = layer_; asm volatile("" : "+s"(layer));
        const int s0 = 2 + layer * NPH;
        const int mrows = (layer == NL - 1) ? ML : MT;
        const float* modl = wsp<float>(F, WS_MOD) + (size_t)layer * 5 * 12288;
        SL(); if (IN(s0 + 0)) { LAUNDER(); norm_phase(F, layer, 0, MT, layer > 0); }
#if defined(PROBE_PHASE) && PROBE_PHASE == 0
        SL(); if (IN(s0 + 0)) { xcd_barrier(bar, wv0 == 0 && lane_now() == 0); LAUNDER(); norm_phase(F, layer, 0, MT, false); }
#endif
        SEAM(s0 + 0);
        SL(); if (IN(s0 + 1)) {
            pg8::Gemm g{wsp<bf16>(F, WS_U), wsp<bf16>(F, WS_WIN + layer * SZ_WIN), MT, LDP, DM, DM, DM}; pg8::StaticOrder S; S.init(MT, LDP, F.G, F.wg);
            pg8::EpiBf16<0> E{wsp<bf16>(F, WS_P), LDP};
            pg8::gemm_phase<pg8::EpiBf16<0>, pg8::StaticOrder, true, true>(F.lds, g, S, E, wv0);
#ifdef PROBE_GEMM2
            pg8::gemm_phase<pg8::EpiBf16<0>, pg8::StaticOrder, true, true>(F.lds, g, S, E, wv0);
#endif
        }
        SEAM(s0 + 1);
        SL(); if (IN(s0 + 2)) { LAUNDER(); prep_phase(F, layer); }
#if defined(PROBE_PHASE) && PROBE_PHASE == 2
        SL(); if (IN(s0 + 2)) { xcd_barrier(bar, wv0 == 0 && lane_now() == 0); LAUNDER(); prep_phase(F, layer); }
#endif
        SEAM(s0 + 2);
        SL(); if (IN(s0 + 3)) {
            pg8::Gemm g{wsp<bf16>(F, WS_ALR), wsp<bf16>(F, WS_WLR + layer * SZ_WLR), MT, NLR, KLR, KLR, KLR}; pg8::StaticOrder S; S.init(MT, NLR, F.G, F.wg);
            pg8::EpiF32 E{wsp<float>(F, WS_LR), NLR};
            pg8::gemm_phase<pg8::EpiF32, pg8::StaticOrder, true, true>(F.lds, g, S, E, wv0);
        }
        SEAM(s0 + 3);
        SL(); if (IN(s0 + 4)) { LAUNDER(); mixa_phase(F, layer); }
#if defined(PROBE_PHASE) && PROBE_PHASE == 4
        SL(); if (IN(s0 + 4)) { xcd_barrier(bar, wv0 == 0 && lane_now() == 0); LAUNDER(); mixa_phase(F, layer); }
#endif
        SEAM(s0 + 4);
        SL(); if (IN(s0 + 5)) { LAUNDER(); mix_phase(F, layer, layer); }
#ifdef PROBE_MIX
        SL(); if (IN(s0 + 5)) { xcd_barrier(bar, wv0 == 0 && lane_now() == 0); LAUNDER(); mix_phase(F, layer, layer + 4, PROBE_MIX); }
#endif
        SEAM(s0 + 5);
        SL(); if (IN(s0 + 6)) { LAUNDER(); mixfin_phase(F, layer, mrows); }
#if defined(PROBE_PHASE) && PROBE_PHASE == 6
        SL(); if (IN(s0 + 6)) { xcd_barrier(bar, wv0 == 0 && lane_now() == 0); LAUNDER(); mixfin_phase(F, layer, mrows); }
#endif
        SEAM(s0 + 6);
        SL(); if (IN(s0 + 7)) {
            const bf16* wbr = wsp<bf16>(F, WS_WBR + layer * SZ_WBR);
            pg8::StaticOrder S; S.init(mrows, DM, F.G, F.wg);
            { pg8::Gemm g{wsp<bf16>(F, WS_Y), wbr, mrows, DM, BW, 3072, BW}; pg8::EpiGate<0> E{wsp<bf16>(F, WS_P) + C_GATE, LDP, wsp<float>(F, WS_MGF), wsp<bf16>(F, WS_MG)};
              pg8::gemm_phase<pg8::EpiGate<0>, pg8::StaticOrder, true, true>(F.lds, g, S, E, wv0); }
            { pg8::Gemm g{wsp<bf16>(F, WS_Y) + 1024, wbr + (size_t)DM * BW, mrows, DM, BW, 3072, BW}; pg8::EpiGate<1> E{wsp<bf16>(F, WS_P) + C_GATE + 2048, LDP, wsp<float>(F, WS_MGF), wsp<bf16>(F, WS_MG)};
              pg8::gemm_phase<pg8::EpiGate<1>, pg8::StaticOrder, true, true>(F.lds, g, S, E, wv0); }
            { pg8::Gemm g{wsp<bf16>(F, WS_Y) + 2048, wbr + (size_t)2 * DM * BW, mrows, DM, BW, 3072, BW}; pg8::EpiGate<2> E{wsp<bf16>(F, WS_P) + C_GATE + 4096, LDP, wsp<float>(F, WS_MGF), wsp<bf16>(F, WS_MG)};
              pg8::gemm_phase<pg8::EpiGate<2>, pg8::StaticOrder, true, true>(F.lds, g, S, E, wv0); }
        }
        SEAM(s0 + 7);
        SL(); if (IN(s0 + 8)) {
            { pg8::Gemm g{wsp<bf16>(F, WS_MG), wsp<bf16>(F, WS_WOUT + layer * SZ_WOUT), ML, DM, DM, DM, DM}; pg8::StaticOrder S; S.init(ML, DM, F.G, F.wg);
              pg8::EpiResGate E{wsp<float>(F, WS_H), modl, 2 * DM};
              pg8::gemm_phase<pg8::EpiResGate, pg8::StaticOrder, true, true>(F.lds, g, S, E, wv0); }
            if (mrows > ML) { const int ks = (F.wg & 7) * (DM / 8);
              pg8::Gemm g{wsp<bf16>(F, WS_MG) + ks, wsp<bf16>(F, WS_WOUT + layer * SZ_WOUT) + ks, MT, DM, DM / 8, DM, DM}; pg8::SubKOrder S{F.G, F.wg};
              pg8::EpiResGatePart E{wsp<float>(F, WS_YDR), modl, 2 * DM, (int)(F.wg & 7)};
              pg8::gemm_phase<pg8::EpiResGatePart, pg8::SubKOrder, true, true>(F.lds, g, S, E, wv0); }
        }
        SEAM(s0 + 8);
        SL(); if (IN(s0 + 9)) { LAUNDER(); norm_phase(F, layer, 1, mrows, true); }
#if defined(PROBE_PHASE) && PROBE_PHASE == 9
        SL(); if (IN(s0 + 9)) { xcd_barrier(bar, wv0 == 0 && lane_now() == 0); LAUNDER(); norm_phase(F, layer, 1, mrows, false); }
#endif
        SEAM(s0 + 9);
        SL(); if (IN(s0 + 10)) {
            pg8::Gemm g{wsp<bf16>(F, WS_U), wsp<bf16>(F, WS_WFF1 + layer * SZ_WFF), mrows, DFF, DM, DM, DM}; pg8::StaticOrder S; S.init(mrows, DFF, F.G, F.wg);
            pg8::EpiBf16<2> E{wsp<bf16>(F, WS_F), DFF};
            pg8::gemm_phase<pg8::EpiBf16<2>, pg8::StaticOrder, true, true>(F.lds, g, S, E, wv0);
#ifdef PROBE_GEMM2
            pg8::gemm_phase<pg8::EpiBf16<2>, pg8::StaticOrder, true, true>(F.lds, g, S, E, wv0);
#endif
        }
        SEAM(s0 + 10);
        SL(); if (IN(s0 + 11)) {
            { pg8::Gemm g{wsp<bf16>(F, WS_F), wsp<bf16>(F, WS_WFF2 + layer * SZ_WFF), ML, DM, DFF, DFF, DFF}; pg8::StaticOrder S; S.init(ML, DM, F.G, F.wg);
              pg8::EpiResGate E{wsp<float>(F, WS_H), modl, 5 * DM};
              pg8::gemm_phase<pg8::EpiResGate, pg8::StaticOrder, true, true>(F.lds, g, S, E, wv0); }
            if (mrows > ML) { const int ks = (F.wg & 7) * (DFF / 8);
              pg8::Gemm g{wsp<bf16>(F, WS_F) + ks, wsp<bf16>(F, WS_WFF2 + layer * SZ_WFF) + ks, MT, DM, DFF / 8, DFF, DFF}; pg8::SubKOrder S{F.G, F.wg};
              pg8::EpiResGatePart E{wsp<float>(F, WS_YDR), modl, 5 * DM, (int)(F.wg & 7)};
              pg8::gemm_phase<pg8::EpiResGatePart, pg8::SubKOrder, true, true>(F.lds, g, S, E, wv0); }
        }
        SEAM(s0 + 11);
    }
    SL(); if (IN(NSTEPS - 1)) { LAUNDER(); final_norm(F, args.out); }
#undef IN
#undef SL
#undef LAUNDER
#undef SEAM
}

#ifndef MK_ONE_LAUNCH
#define MK_ONE_LAUNCH 1
#endif
extern "C" void kernel_launch(void* const* d_in, const int* in_sizes, int n_in, void* d_out, int out_size, void* d_ws, size_t ws_size, hipStream_t stream) {
    static int grid = 0;
    if (grid == 0) {
        if (n_in != 26 || out_size != ML * DM || ws_size < WS_END) { fprintf(stderr, "kernel_launch: unexpected shapes (n_in %d, out %d, ws %zu < %zu)\n", n_in, out_size, ws_size, (size_t)WS_END); grid = -1; return; }
        int dev = 0, cus = 0, per_cu = 0;
        if (hipGetDevice(&dev) != hipSuccess || hipDeviceGetAttribute(&cus, hipDeviceAttributeMultiprocessorCount, dev) != hipSuccess) { grid = -1; return; }
        if (hipFuncSetAttribute((const void*)hyb_fwd, hipFuncAttributeMaxDynamicSharedMemorySize, LDS_BYTES) != hipSuccess) { fprintf(stderr, "kernel_launch: hipFuncSetAttribute failed\n"); grid = -1; return; }
        if (hipOccupancyMaxActiveBlocksPerMultiprocessor(&per_cu, (const void*)hyb_fwd, NTHR, LDS_BYTES) != hipSuccess || per_cu < 1) fprintf(stderr, "kernel_launch: occupancy query reports %d\n", per_cu);
        (void)hipGetLastError();
        grid = cus;
    }
    if (grid < 0) return;
    if (hipMemsetAsync((char*)d_ws + WS_CTL, 0, CTL_ZERO_BYTES, stream) != hipSuccess) return;
    Args a{};
    for (int i = 0; i < 26; ++i) a.in[i] = (const float*)d_in[i];
    a.out = (float*)d_out; a.ws = (unsigned char*)d_ws;
#if MK_ONE_LAUNCH
    a.s_lo = 0; a.s_hi = NSTEPS;
    hipLaunchKernelGGL(hyb_fwd, dim3(grid), dim3(NTHR), LDS_BYTES, stream, a);
#else
    for (int s = 0; s < NSTEPS; ++s) { a.s_lo = s; a.s_hi = s + 1; hipLaunchKernelGGL(hyb_fwd, dim3(grid), dim3(NTHR), LDS_BYTES, stream, a); }
#endif
}
```

```cpp
#include <hip/hip_runtime.h>
#include <cstdio>
#include <cstdint>
__device__ __forceinline__ int lane_now() { int l; asm volatile("v_mbcnt_lo_u32_b32 %0, -1, 0\n\tv_mbcnt_hi_u32_b32 %0, -1, %0" : "=v"(l)); return l; }
namespace pg8 {
#define PG8_LAS __attribute__((address_space(3)))
typedef unsigned short bf16_t;
typedef short bf16x8 __attribute__((ext_vector_type(8)));
typedef float f32x4 __attribute__((ext_vector_type(4)));
typedef unsigned u32x4 __attribute__((ext_vector_type(4)));
constexpr int BM = 256, BK = 64, HALF = 128, HTB = HALF * BK * 2  , STAGE_BYTES = 8 * HTB, NXCD = 8, WGM = 8;

__host__ __device__ __forceinline__ int lds_byte(int r, int c) { const int st = (r >> 4) * 2 + (c >> 5), rr = r & 15, cc = c & 31, ob = rr * 64 + cc * 2; return st * 1024 + (ob ^ (((ob >> 9) & 1) << 5)); }
__host__ __device__ __forceinline__ void stage_rc(int b, int& R, int& C) { const int st = b / 1024, sb = b % 1024, swz = sb ^ (((sb >> 9) & 1) << 5); R = (st >> 1) * 16 + swz / 64; C = (st & 1) * 32 + (swz % 64) / 2; }
__host__ __device__ __forceinline__ int perm32(int rho) { const int n = rho >> 4, i = rho & 15; return 8 * (i >> 2) + 4 * n + (i & 3); }

struct Unit { int pm, pn; };
struct Gemm { const bf16_t* A; const bf16_t* Bt; int M, N, K, lda, ldb; };

struct StaticOrder {
    int nM, nN, nwg, G, c;
    __host__ __device__ void init(int M, int N, int G_, int c_) { nM = M / BM; nN = N / BM; nwg = nM * nN; G = G_; c = c_; }
    __host__ __device__ bool next(int i, Unit& u) const {
        const long L = (long)i * G + c; if (L >= nwg) return false;
        int wgid = (int)L; { const int q = nwg / NXCD, r = nwg % NXCD, xcd = wgid % NXCD, off = wgid / NXCD; wgid = (xcd < r ? xcd * (q + 1) : r * (q + 1) + (xcd - r) * q) + off; }
        const int nig = WGM * nN, gid = wgid / nig, fm = gid * WGM, gsz = (nM - fm) < WGM ? (nM - fm) : WGM;
        u.pm = fm + ((wgid % nig) % gsz); u.pn = (wgid % nig) / gsz; return true;
    }
    __device__ __forceinline__ void a_ready(const Unit&) const {}
    __device__ __forceinline__ void done(const Unit&) const {}
    __device__ __forceinline__ size_t a_off(const Unit&) const { return 0; }
    __device__ __forceinline__ size_t b_off(const Unit&) const { return 0; }
    __device__ __forceinline__ int nt(const Unit&, int d) const { return d; }
};

__device__ __forceinline__ unsigned cvt_pk_bf16(float lo, float hi) { unsigned r; asm volatile("v_cvt_pk_bf16_f32 %0, %1, %2" : "=v"(r) : "v"(lo), "v"(hi)); return r; }
typedef float f32x2 __attribute__((ext_vector_type(2)));
__device__ __forceinline__ float sigmoidf_(float x) { return __builtin_amdgcn_rcpf(1.0f + __builtin_amdgcn_exp2f(x * -1.4426950408889634f)); }
__device__ __forceinline__ float bf_lo(unsigned w) { return __uint_as_float(w << 16); }
__device__ __forceinline__ float bf_hi(unsigned w) { return __uint_as_float(w & 0xffff0000u); }

template <int ACT> struct EpiBf16 {
    static constexpr bool PERM = true, AFTER_DRAIN = false;
    bf16_t* O; int ldc;
    __device__ __forceinline__ void operator()(const f32x4 (&acc)[2][2][4][2], const Unit& u, int wr, int wc, int fr, int fq) const {
        const int row0 = u.pm * BM + wr * 64 + fr; const int col0 = u.pn * BM + wc * 32 + 8 * fq;
#pragma unroll
        for (int ai = 0; ai < 2; ++ai)
#pragma unroll
            for (int m = 0; m < 4; ++m) { bf16_t* rowp = O + (size_t)(row0 + ai * HALF + m * 16) * ldc + col0;
#pragma unroll
                for (int bj = 0; bj < 2; ++bj) { f32x4 v0 = acc[ai][bj][m][0], v1 = acc[ai][bj][m][1];
                    if (ACT == 2) {
#pragma unroll
                        for (int e = 0; e < 4; ++e) { const float a = fmaxf(v0[e], 0.f), b = fmaxf(v1[e], 0.f); v0[e] = a * a; v1[e] = b * b; } }
                    u32x4 w; w.x = cvt_pk_bf16(v0[0], v0[1]); w.y = cvt_pk_bf16(v0[2], v0[3]); w.z = cvt_pk_bf16(v1[0], v1[1]); w.w = cvt_pk_bf16(v1[2], v1[3]);
                    *(u32x4*)(rowp + bj * HALF) = w; } }
    }
};
struct OutOrder {
    StaticOrder S0; int G, c, nsub, ksl;
    __device__ void init(int G_, int c_, bool ctx, int K) { S0.init(8192, 2048, G_, c_); G = G_; c = c_; nsub = ctx ? 256 : 0; ksl = K / 8 * 2; }
    __device__ bool next(int i, Unit& u) const {
        const int T = c < 256 ? (256 - c + G - 1) / G : 0;
        if (i < T) { S0.next(i, u); return true; }
        const int q = (i - T) * G + c; if (q >= nsub) return false;
        const int lt = q >> 3; u.pm = 32 + (lt >> 3); u.pn = lt & 7; return true;
    }
    __device__ __forceinline__ void a_ready(const Unit&) const {}
    __device__ __forceinline__ void done(const Unit&) const {}
    __device__ __forceinline__ size_t a_off(const Unit& u) const { return u.pm < 32 ? 0 : (size_t)(c & 7) * ksl; }
    __device__ __forceinline__ size_t b_off(const Unit& u) const { return a_off(u); }
    __device__ __forceinline__ int nt(const Unit& u, int d) const { return u.pm < 32 ? d : d >> 3; }
};
struct EpiOut {
    static constexpr bool PERM = true, AFTER_DRAIN = false;
    bf16_t* D; bf16_t* part; const float* modl; int goff, slice;
    __device__ __forceinline__ void operator()(const f32x4 (&acc)[2][2][4][2], const Unit& u, int wr, int wc, int fr, int fq) const {
        const bool lat = u.pm < 32; const int mr = lat ? (u.pm >> 3) : 4;
        const int row0 = u.pm * BM + wr * 64 + fr, col0 = u.pn * BM + wc * 32 + 8 * fq;
        const float* gv = modl + (size_t)mr * 12288 + goff + col0;
        bf16_t* dst = lat ? D + (size_t)row0 * 2048 + col0 : part + ((size_t)slice * 1024 + (row0 - 8192)) * 2048 + col0;
        f32x4 gg[2][2];
#pragma unroll
        for (int bj = 0; bj < 2; ++bj)
#pragma unroll
            for (int n = 0; n < 2; ++n) gg[bj][n] = *(const f32x4*)(gv + bj * HALF + n * 4);
#pragma unroll
        for (int ai = 0; ai < 2; ++ai)
#pragma unroll
            for (int m = 0; m < 4; ++m) { bf16_t* rowp = dst + (size_t)(ai * HALF + m * 16) * 2048;
#pragma unroll
                for (int bj = 0; bj < 2; ++bj) { const f32x4 v0 = acc[ai][bj][m][0] * gg[bj][0], v1 = acc[ai][bj][m][1] * gg[bj][1];
                    u32x4 w; w.x = cvt_pk_bf16(v0[0], v0[1]); w.y = cvt_pk_bf16(v0[2], v0[3]); w.z = cvt_pk_bf16(v1[0], v1[1]); w.w = cvt_pk_bf16(v1[2], v1[3]);
                    *(u32x4*)(rowp + bj * HALF) = w; } }
    }
};

struct BranchOrder {
    StaticOrder S0; int G, c, nctx;
    __device__ void init(int G_, int c_, bool ctx) { S0.init(8192, 2048, G_, c_); G = G_; c = c_; nctx = ctx ? 96 : 0; }
    __device__ bool next(int i, Unit& u) const {
        const int T = c < 256 ? (256 - c + G - 1) / G : 0;
        if (i < 3 * T) { const int ti = i / 3, b = i - 3 * ti; S0.next(ti, u); u.pn += 8 * b; return true; }
        const int q = (i - 3 * T) * G + c; if (q >= nctx) return false;
        u.pm = 32 + ((q & 31) >> 3); u.pn = (q & 7) + 8 * (q >> 5); return true;
    }
    __device__ __forceinline__ void a_ready(const Unit&) const {}
    __device__ __forceinline__ void done(const Unit&) const {}
    __device__ __forceinline__ size_t a_off(const Unit& u) const { return (size_t)(u.pn >> 3) * 2048; }
    __device__ __forceinline__ size_t b_off(const Unit&) const { return 0; }
    __device__ __forceinline__ int nt(const Unit&, int d) const { return d; }
};
struct EpiBranch {
    static constexpr bool PERM = true, AFTER_DRAIN = false;
    const bf16_t* G; int ldg;
    bf16_t* out;
    bf16_t* part;
    __device__ __forceinline__ void operator()(const f32x4 (&acc)[2][2][4][2], const Unit& u, int wr, int wc, int fr, int fq) const {
        const int b = u.pn >> 3; const bool ctx = u.pm >= 32, old = !ctx && b > 0;
        const int row0 = u.pm * BM + wr * 64 + fr; const int col0 = (u.pn & 7) * BM + wc * 32 + 8 * fq;
        const bf16_t* gp = G + (size_t)row0 * ldg + b * 2048 + col0;
        bf16_t* op = ctx ? part + ((size_t)b * 1024 + (row0 - 8192)) * 2048 + col0 : out + (size_t)row0 * 2048 + col0;
        u32x4 gw[2][4], ow[2][4];
#pragma unroll
        for (int g = -1; g < 4; ++g) {
            if (g + 1 < 4) {
#pragma unroll
                for (int q = 0; q < 4; ++q) { const int it = (g + 1) * 4 + q, ai = it >> 3, m = (it >> 1) & 3, bj = it & 1; const int ro = ai * HALF + m * 16;
                    gw[(g + 1) & 1][q] = *(const u32x4*)(gp + (size_t)ro * ldg + bj * HALF);
                    ow[(g + 1) & 1][q] = *(const u32x4*)(op + (size_t)ro * 2048 + bj * HALF); }
            }
            asm volatile("" ::: "memory");
            if (g >= 0) {
#pragma unroll
                for (int q = 0; q < 4; ++q) { const int it = g * 4 + q, ai = it >> 3, m = (it >> 1) & 3, bj = it & 1; const int ro = ai * HALF + m * 16;
                    const u32x4 gq = gw[g & 1][q];
                    f32x4 g0, g1; g0[0] = sigmoidf_(bf_lo(gq.x)); g0[1] = sigmoidf_(bf_hi(gq.x)); g0[2] = sigmoidf_(bf_lo(gq.y)); g0[3] = sigmoidf_(bf_hi(gq.y));
                    g1[0] = sigmoidf_(bf_lo(gq.z)); g1[1] = sigmoidf_(bf_hi(gq.z)); g1[2] = sigmoidf_(bf_lo(gq.w)); g1[3] = sigmoidf_(bf_hi(gq.w));
                    f32x4 v0 = acc[ai][bj][m][0] * g0, v1 = acc[ai][bj][m][1] * g1;
                    u32x4 o = ow[g & 1][q]; if (!old) o = (u32x4){0u, 0u, 0u, 0u};
                    v0[0] += bf_lo(o.x); v0[1] += bf_hi(o.x); v0[2] += bf_lo(o.y); v0[3] += bf_hi(o.y); v1[0] += bf_lo(o.z); v1[1] += bf_hi(o.z); v1[2] += bf_lo(o.w); v1[3] += bf_hi(o.w);
                    u32x4 w; w.x = cvt_pk_bf16(v0[0], v0[1]); w.y = cvt_pk_bf16(v0[2], v0[3]); w.z = cvt_pk_bf16(v1[0], v1[1]); w.w = cvt_pk_bf16(v1[2], v1[3]);
                    *(u32x4*)(op + (size_t)ro * 2048 + bj * HALF) = w; }
                asm volatile("" ::: "memory");
            }
        }
    }
};

struct LastInOrder {
    StaticOrder S0; int G, c;
    __device__ void init(int G_, int c_) { S0.init(8192, 15360, G_, c_); G = G_; c = c_; }
    __device__ bool next(int i, Unit& u) const {
        const long L = (long)i * G + c;
        if (L < 1920) { S0.next(i, u); return true; }
        const int j = (int)(L - 1920); if (j >= 112) return false;
        const int q = j % 28; u.pm = 32 + j / 28; u.pn = q < 12 ? 4 + q : 8 + q; return true;
    }
    __device__ __forceinline__ void a_ready(const Unit&) const {}
    __device__ __forceinline__ void done(const Unit&) const {}
    __device__ __forceinline__ size_t a_off(const Unit&) const { return 0; }
    __device__ __forceinline__ size_t b_off(const Unit&) const { return 0; }
    __device__ __forceinline__ int nt(const Unit&, int d) const { return d; }
};

struct LrOrder {
    StaticOrder S0;
    __device__ void init(int M, int N, int G_, int c_) { S0.init(M, N, G_, c_); }
    __device__ bool next(int i, Unit& u) const { return S0.next(i, u); }
    __device__ __forceinline__ void a_ready(const Unit&) const {}
    __device__ __forceinline__ void done(const Unit&) const {}
    __device__ __forceinline__ size_t a_off(const Unit& u) const { return (size_t)(u.pn < 8 ? 0 : (u.pn < 16 ? 256 : 512)); }
    __device__ __forceinline__ size_t b_off(const Unit& u) const { return a_off(u); }
    __device__ __forceinline__ int nt(const Unit&, int d) const { return d; }
};

template <class Epi, class Sched, bool ALIGN_EPI = false, bool SP2 = false>
__device__ __forceinline__ void gemm_phase(PG8_LAS unsigned char* lds, const Gemm g, const Sched& S, const Epi& E, const int wv  ) {
    int tid_ = wv * 64 + lane_now(); asm volatile("" : "+v"(tid_));
    const int tid = tid_, wid = __builtin_amdgcn_readfirstlane(tid >> 6), lane = tid & 63, wr = wid >> 2, wc = wid & 3, fr = lane & 15, fq = lane >> 4;
    const int ntd = g.K / BK;
    unsigned voffA[2], voffB[2];
#pragma unroll
    for (int i = 0; i < 2; ++i) { int R, C; stage_rc(tid * 16 + i * 8192, R, C); const int Rb = Epi::PERM ? ((R & ~31) + perm32(R & 31)) : R;
        voffA[i] = (unsigned)(R * g.lda + C) * 2u; voffB[i] = (unsigned)(Rb * g.ldb + C) * 2u; }
    const size_t kstep = (size_t)(BK * 2);
    const size_t hstepA = (size_t)HALF * g.lda * 2, hstepB = (size_t)HALF * g.ldb * 2;
    const size_t tstepA = 2 * hstepA, tstepB = 2 * hstepB;
    const unsigned ldsw = (unsigned)wid * 1024u;
    const int aoff = lds_byte(wr * 64 + fr, fq * 8), boff = lds_byte(wc * 32 + fr, fq * 8);
#define PG8_SA(b, h) (((b) * 2 + (h)) * HTB)
#define PG8_SB(b, h) ((4 + (b) * 2 + (h)) * HTB)
#define PG8_STAGE(bufoff, gbase, voff) do { _Pragma("unroll") for (int _i = 0; _i < 2; ++_i) \
        __builtin_amdgcn_global_load_lds((const unsigned*)((const char*)(gbase) + (voff)[_i]), (PG8_LAS unsigned*)(lds + (bufoff) + ldsw + _i * 8192), 16, 0, 0); } while (0)
#define PG8_LDA(dst, b, h) do { _Pragma("unroll") for (int m = 0; m < 4; ++m) _Pragma("unroll") for (int k = 0; k < 2; ++k) dst[m][k] = *(const PG8_LAS bf16x8*)(lds + PG8_SA(b, h) + aoff + m * 2048 + k * 1024); } while (0)
#define PG8_LDB(dst, b, h) do { _Pragma("unroll") for (int n = 0; n < 2; ++n) _Pragma("unroll") for (int k = 0; k < 2; ++k) dst[n][k] = *(const PG8_LAS bf16x8*)(lds + PG8_SB(b, h) + boff + n * 2048 + k * 1024); } while (0)
#define PG8_MMA(ai, bj, At, Bt) do { __builtin_amdgcn_s_setprio(1); _Pragma("unroll") for (int m = 0; m < 4; ++m) _Pragma("unroll") for (int n = 0; n < 2; ++n) _Pragma("unroll") for (int k = 0; k < 2; ++k) \
        acc[ai][bj][m][n] = __builtin_amdgcn_mfma_f32_16x16x32_bf16(Bt[n][k], At[m][k], acc[ai][bj][m][n], 0, 0, 0); __builtin_amdgcn_s_setprio(0); } while (0)
#define PG8_WAIT_V(n) asm volatile("s_waitcnt vmcnt(" #n ")" ::: "memory")
#define PG8_WAIT_L(n) asm volatile("s_waitcnt lgkmcnt(" #n ")" ::: "memory")
#define PG8_BAR __builtin_amdgcn_s_barrier()
#define PG8_SCHED __builtin_amdgcn_sched_barrier(0)
    Unit cur, nxt; int ui = 0;
    if (!S.next(0, cur)) return;
    f32x4 acc[2][2][4][2];
#pragma unroll
    for (int a = 0; a < 2; ++a)
#pragma unroll
        for (int b = 0; b < 2; ++b)
#pragma unroll
            for (int m = 0; m < 4; ++m)
#pragma unroll
                for (int n = 0; n < 2; ++n) acc[a][b][m][n] = (f32x4){0.f, 0.f, 0.f, 0.f};
    bf16x8 At[4][2], B0[2][2], B1[2][2];
    const char* cA = (const char*)g.A + (size_t)cur.pm * tstepA + S.a_off(cur); const char* cB = (const char*)g.Bt + (size_t)cur.pn * tstepB + S.b_off(cur);
    S.a_ready(cur);
    if constexpr (SP2) {
        PG8_STAGE(PG8_SB(0, 0), cB, voffB); PG8_STAGE(PG8_SB(0, 1), cB + hstepB, voffB); PG8_STAGE(PG8_SA(0, 0), cA, voffA); PG8_STAGE(PG8_SA(0, 1), cA + hstepA, voffA);
        if (wr == 1) PG8_BAR;
        PG8_WAIT_V(2); PG8_BAR;
        PG8_STAGE(PG8_SB(1, 0), cB + kstep, voffB); PG8_STAGE(PG8_SA(1, 0), cA + kstep, voffA); PG8_STAGE(PG8_SB(1, 1), cB + hstepB + kstep, voffB);
        PG8_WAIT_V(6); PG8_BAR;
    } else {
        PG8_STAGE(PG8_SB(0, 0), cB, voffB); PG8_STAGE(PG8_SA(0, 0), cA, voffA); PG8_STAGE(PG8_SB(0, 1), cB + hstepB, voffB); PG8_STAGE(PG8_SA(0, 1), cA + hstepA, voffA);
        if (wr == 1) PG8_BAR;
        PG8_WAIT_V(4); PG8_BAR;
        PG8_STAGE(PG8_SB(1, 0), cB + kstep, voffB); PG8_STAGE(PG8_SA(1, 0), cA + kstep, voffA); PG8_STAGE(PG8_SB(1, 1), cB + hstepB + kstep, voffB);
        PG8_WAIT_V(6); PG8_BAR;
    }
    for (;;) {
        const bool has_next = S.next(ui + 1, nxt);
        const char* nA = has_next ? (const char*)g.A + (size_t)nxt.pm * tstepA + S.a_off(nxt) : cA; const char* nB = has_next ? (const char*)g.Bt + (size_t)nxt.pn * tstepB + S.b_off(nxt) : cB;
        const int nt = S.nt(cur, ntd);
#pragma nounroll
        for (int t = 0; t < nt; t += 2) {
            const bool last = (t == nt - 2);
            const char* a1 = cA + (size_t)(t + 1) * kstep;
            const char* a2 = last ? nA : cA + (size_t)(t + 2) * kstep; const char* b2 = last ? nB : cB + (size_t)(t + 2) * kstep;
            const char* a3 = a2 + kstep; const char* b3 = b2 + kstep;
            if (last && has_next) S.a_ready(nxt);
            if constexpr (SP2) {
            PG8_LDB(B0, 0, 0); PG8_LDB(B1, 0, 1); PG8_SCHED; PG8_LDA(At, 0, 0); PG8_STAGE(PG8_SA(1, 1), a1 + hstepA, voffA);
            PG8_WAIT_V(8); PG8_WAIT_L(0); PG8_BAR; PG8_MMA(0, 0, At, B0); PG8_MMA(0, 1, At, B1); PG8_BAR; PG8_SCHED;
            PG8_LDA(At, 0, 1); PG8_STAGE(PG8_SB(0, 0), b2, voffB); PG8_STAGE(PG8_SB(0, 1), b2 + hstepB, voffB); PG8_STAGE(PG8_SA(0, 0), a2, voffA);
            PG8_WAIT_V(8); PG8_WAIT_L(0); PG8_BAR; PG8_MMA(1, 0, At, B0); PG8_MMA(1, 1, At, B1); PG8_BAR; PG8_SCHED;
            PG8_LDB(B0, 1, 0); PG8_LDB(B1, 1, 1); PG8_SCHED; PG8_LDA(At, 1, 0); PG8_STAGE(PG8_SA(0, 1), a2 + hstepA, voffA);
            PG8_WAIT_V(8); PG8_WAIT_L(0); PG8_BAR; PG8_MMA(0, 0, At, B0); PG8_MMA(0, 1, At, B1); PG8_BAR; PG8_SCHED;
            PG8_LDA(At, 1, 1); PG8_STAGE(PG8_SB(1, 0), b3, voffB); PG8_STAGE(PG8_SB(1, 1), b3 + hstepB, voffB); PG8_STAGE(PG8_SA(1, 0), a3, voffA);
            PG8_WAIT_V(8); PG8_WAIT_L(0); PG8_BAR; PG8_MMA(1, 0, At, B0); PG8_MMA(1, 1, At, B1); PG8_BAR; PG8_SCHED;
            } else {
            PG8_LDB(B0, 0, 0); PG8_SCHED; PG8_LDA(At, 0, 0); PG8_STAGE(PG8_SA(1, 1), a1 + hstepA, voffA);
            PG8_WAIT_L(8); PG8_BAR; PG8_WAIT_L(0); PG8_MMA(0, 0, At, B0); PG8_BAR; PG8_SCHED;
            PG8_LDB(B1, 0, 1); PG8_STAGE(PG8_SB(0, 0), b2, voffB);
            PG8_BAR; PG8_WAIT_L(0); PG8_MMA(0, 1, At, B1); PG8_BAR;
            PG8_LDA(At, 0, 1); PG8_STAGE(PG8_SA(0, 0), a2, voffA);
            PG8_BAR; PG8_WAIT_L(0); PG8_MMA(1, 0, At, B0); PG8_BAR; PG8_SCHED;
            PG8_STAGE(PG8_SB(0, 1), b2 + hstepB, voffB);
            PG8_WAIT_V(6); PG8_BAR; PG8_MMA(1, 1, At, B1); PG8_BAR;
            PG8_LDB(B0, 1, 0); PG8_SCHED; PG8_LDA(At, 1, 0); PG8_STAGE(PG8_SA(0, 1), a2 + hstepA, voffA);
            PG8_WAIT_L(8); PG8_BAR; PG8_WAIT_L(0); PG8_MMA(0, 0, At, B0); PG8_BAR; PG8_SCHED;
            PG8_LDB(B1, 1, 1); PG8_STAGE(PG8_SB(1, 0), b3, voffB);
            PG8_BAR; PG8_WAIT_L(0); PG8_MMA(0, 1, At, B1); PG8_BAR;
            PG8_LDA(At, 1, 1); PG8_STAGE(PG8_SA(1, 0), a3, voffA);
            PG8_BAR; PG8_WAIT_L(0); PG8_MMA(1, 0, At, B0); PG8_BAR; PG8_SCHED;
            PG8_STAGE(PG8_SB(1, 1), b3 + hstepB, voffB);
            PG8_WAIT_V(6); PG8_BAR; PG8_MMA(1, 1, At, B1); PG8_BAR;
            }
        }
        if constexpr (ALIGN_EPI) { if (wr == 0) PG8_BAR; }
        if constexpr (!Epi::AFTER_DRAIN) { int t2_ = lane_now(); asm volatile("" : "+v"(t2_));   E(acc, cur, wr, wc, t2_ & 15, (t2_ >> 4) & 3); S.done(cur); }
        if (!has_next) break;
#pragma unroll
        for (int a = 0; a < 2; ++a)
#pragma unroll
            for (int b = 0; b < 2; ++b)
#pragma unroll
                for (int m = 0; m < 4; ++m)
#pragma unroll
                    for (int n = 0; n < 2; ++n) acc[a][b][m][n] = (f32x4){0.f, 0.f, 0.f, 0.f};
        cur = nxt; cA = nA; cB = nB; ++ui;
        if constexpr (ALIGN_EPI) { if (wr == 1) PG8_BAR; }
    }
    PG8_WAIT_V(0);
    if constexpr (!ALIGN_EPI) { if (wr == 0) PG8_BAR; }
    PG8_BAR;
    if constexpr (Epi::AFTER_DRAIN) { E.fused(acc, cur, wr, wc, fr, fq, lds, wid, lane); S.done(cur); }
#undef PG8_SA
#undef PG8_SB
#undef PG8_STAGE
#undef PG8_LDA
#undef PG8_LDB
#undef PG8_MMA
#undef PG8_WAIT_V
#undef PG8_WAIT_L
#undef PG8_BAR
#undef PG8_SCHED
}
}

constexpr int NB = 4, TL = 2048, TCX = 256, DM = 2048, NL = 4, DFF = 8192, BW = 1024;
constexpr int ML = NB * TL, MC = NB * TCX, MT = ML + MC;
constexpr int NIN = 15232, LDP = 15360;
constexpr int C_RET = 0, C_SWA = 4096, C_RW = 5632, C_GATE = 9088, RWIN = 3456;
constexpr int NLR = 5120, KLR = 384;
constexpr int NQK = 1280;
constexpr int NSTEP = 2304, SCAN_BLK = 32;

constexpr size_t al256(size_t x) { return (x + 255) & ~(size_t)255; }
constexpr size_t WS_CTL = 0, CTL_ZERO_BYTES = 1u << 20;
constexpr size_t SZ_WIN = (size_t)LDP * DM * 2, SZ_WBR = (size_t)3 * DM * BW * 2, SZ_WOUT = (size_t)DM * DM * 2, SZ_WFF = (size_t)DFF * DM * 2, SZ_WLR = (size_t)NLR * KLR * 2;
constexpr size_t WS_WIN = CTL_ZERO_BYTES;
constexpr size_t WS_WBR = WS_WIN + NL * SZ_WIN;
constexpr size_t WS_WOUT = WS_WBR + NL * SZ_WBR;
constexpr size_t WS_WFF1 = WS_WOUT + NL * SZ_WOUT;
constexpr size_t WS_WFF2 = WS_WFF1 + NL * SZ_WFF;
constexpr size_t WS_WLR = WS_WFF2 + NL * SZ_WFF;
constexpr size_t WS_H = WS_WLR + NL * SZ_WLR;
constexpr size_t WS_U = WS_H + (size_t)MT * DM * 4;
constexpr size_t WS_P = WS_U + (size_t)MT * DM * 2;
constexpr size_t WS_Y = WS_P + (size_t)MT * LDP * 2;
constexpr size_t WS_MGF = WS_Y + (size_t)MT * 3072 * 2;
constexpr size_t WS_MG = WS_MGF + (size_t)MT * DM * 4;
constexpr size_t WS_F = WS_MG + (size_t)MT * DM * 2;
constexpr size_t WS_MODP = WS_F + (size_t)MT * DFF * 2;
constexpr size_t WS_MOD = WS_MODP + (size_t)8 * NL * 5 * 12288 * 4;
constexpr size_t WS_ROPE = WS_MOD + (size_t)NL * 5 * 12288 * 4;
constexpr size_t WS_XS = WS_ROPE + 64 * 32 * 2 * 4;
constexpr size_t WS_ALR = WS_XS + (size_t)MT * 3072 * 4;
constexpr size_t WS_LR = WS_ALR + (size_t)MT * KLR * 2;
constexpr size_t WS_QKR = WS_LR + (size_t)MT * NLR * 4;
constexpr size_t WS_ST = WS_QKR + (size_t)MT * NQK * 2;
constexpr size_t WS_YDR = WS_ST + (size_t)NB * 8 * 2 * 18 * 128 * 128 * 2;
constexpr size_t WS_YDW = WS_YDR + (size_t)2 * MT * BW * 4;
constexpr size_t RWU = (size_t)NB * 16 * 2 * 36;
constexpr size_t WS_RWY = WS_F;
constexpr size_t WS_RWH = WS_F + RWU * 16384;
constexpr size_t WS_RWP = WS_YDW;
constexpr size_t WS_RWQ = WS_RWP + RWU * 8192;
constexpr size_t WS_RWG = WS_RWQ + RWU * 8192;
constexpr size_t WS_RWS = WS_RWG + RWU * 256;
constexpr size_t WS_END = WS_RWS + RWU * 8192;
static_assert(RWU * 32768 <= (size_t)MT * DFF * 2, "rwkv tiles overlay F");
constexpr size_t WS_VEC = WS_END;
constexpr size_t WS_END2 = WS_VEC + (size_t)NL * 8 * 1024 * 4;
constexpr int CW_BAR = 4096;
constexpr int CW_DBG = 20480;
constexpr int CW_SWAQ = 16384;

constexpr int RING_BYTES = 131072, LDSCTL_OFF = RING_BYTES, MISC_OFF = LDSCTL_OFF + 320, LDS_BYTES = 147456;
constexpr int NWAVES = 8, NTHR = 512;

#define GAS __attribute__((address_space(1)))
#define LAS __attribute__((address_space(3)))
typedef unsigned short bf16;
typedef float f32x4 __attribute__((ext_vector_type(4)));
typedef float f32x2 __attribute__((ext_vector_type(2)));
typedef unsigned u32x4 __attribute__((ext_vector_type(4)));
typedef unsigned u32x2 __attribute__((ext_vector_type(2)));
#define LDS_WAIT() asm volatile("s_waitcnt lgkmcnt(0)" ::: "memory")
#define LB() do { asm volatile("s_waitcnt lgkmcnt(0)" ::: "memory"); __builtin_amdgcn_s_barrier(); asm volatile("" ::: "memory"); } while (0)
#define VM_WAIT() asm volatile("s_waitcnt vmcnt(0)" ::: "memory")
typedef __bf16 bf16x2_t __attribute__((ext_vector_type(2)));
__device__ __forceinline__ unsigned cvtpk(float lo, float hi) { f32x2 v = {lo, hi}; bf16x2_t b = __builtin_convertvector(v, bf16x2_t); return __builtin_bit_cast(unsigned, b); }
__device__ __forceinline__ unsigned f2bf(float f) { return cvtpk(f, 0.f) & 0xffffu; }
__device__ __forceinline__ unsigned pk2(float lo, float hi) { return cvtpk(lo, hi); }
__device__ __forceinline__ float bf2f(bf16 v) { return __uint_as_float((unsigned)v << 16); }
__device__ __forceinline__ float fexp(float x) { return __builtin_amdgcn_exp2f(x * 1.4426950408889634f); }
__device__ __forceinline__ float sigm(float x) { return __builtin_amdgcn_rcpf(1.0f + __builtin_amdgcn_exp2f(x * -1.4426950408889634f)); }
__device__ __forceinline__ float ftanh(float x) { return 1.0f - 2.0f * __builtin_amdgcn_rcpf(1.0f + __builtin_amdgcn_exp2f(x * 2.8853900817779268f)); }
using pg8::bf_lo; using pg8::bf_hi;
__device__ __forceinline__ float shx(float v, int m, int lane) { return __int_as_float(__builtin_amdgcn_ds_bpermute((lane ^ m) << 2, __float_as_int(v))); }
__device__ __forceinline__ float lanefrom(float v, int src) { return __int_as_float(__builtin_amdgcn_ds_bpermute((src & 63) << 2, __float_as_int(v))); }
__device__ __forceinline__ float wave_sum(float v, int lane) {
#pragma unroll
    for (int o = 1; o < 64; o <<= 1) v += shx(v, o, lane);
    return v;
}
__device__ __forceinline__ float wave_max(float v, int lane) {
#pragma unroll
    for (int o = 1; o < 64; o <<= 1) v = fmaxf(v, shx(v, o, lane));
    return v;
}

#ifdef TS_DEBUG
#define TS_BEGIN(id) unsigned long long ts_##id = __builtin_amdgcn_s_memrealtime()
#define TS_END(id) do { if (F.wg == TS_WG && F.tid == 0) if ((id) == TS_SEL) atomicAdd(F.ctl + CW_DBG + 8, (unsigned)(__builtin_amdgcn_s_memrealtime() - ts_##id)); } while (0)
#else
#define TS_BEGIN(id)
#define TS_END(id)
#endif
#define XB_TMO      128
#define XB_XCNT(j)  (256  + 64 * (j))
#define XB_XSUB(j)  (1280 + 64 * (j))
#define XB_XGEN(j)  (2304 + 64 * (j))
#define XB_TOP      3328
#define XB_TOPGEN   3392
#define XCD_BAR_WORDS 3456
#define XB_SPIN_CAP (1u << 22)
__device__ __forceinline__ unsigned xb_ld(unsigned* p)              { return __hip_atomic_load(p, __ATOMIC_RELAXED, __HIP_MEMORY_SCOPE_AGENT); }
__device__ __forceinline__ unsigned xb_add(unsigned* p, unsigned v) { return __hip_atomic_fetch_add(p, v, __ATOMIC_RELAXED, __HIP_MEMORY_SCOPE_AGENT); }
__device__ __forceinline__ unsigned xb_xcc_id() { return (unsigned)__builtin_amdgcn_s_getreg((3 << 11) | 20) & 0xFu; }
#define XB_SPIN(cond, bar) do { unsigned _sp = 0; while (cond) { __builtin_amdgcn_s_sleep(1); \
    if ((++_sp & 255u) == 0u) { if (xb_ld(&(bar)[XB_TMO])) break; if (_sp > XB_SPIN_CAP) { atomicAdd(&(bar)[XB_TMO], 1u); break; } } } } while (0)
struct XcdBarrier { unsigned* bar; unsigned x; volatile LAS unsigned* st; };
__device__ __forceinline__ XcdBarrier xcd_barrier_post(unsigned* bar, volatile LAS unsigned* st) {
    XcdBarrier b; b.bar = bar; b.x = xb_xcc_id(); b.st = st;
    if (threadIdx.x == 0) (void)xb_add(&bar[XB_XCNT(b.x)], 1u);
    return b;
}
__device__ __forceinline__ void xcd_barrier_complete(unsigned* bar, unsigned x, unsigned& nloc, unsigned& nx) {
    const unsigned G = gridDim.x * gridDim.y * gridDim.z;
    unsigned sum, cnt, mine, sp = 0u;
    for (;;) {
        sum = 0u; cnt = 0u; mine = 0u;
#pragma unroll
        for (unsigned j = 0; j < 16; ++j) { const unsigned c = xb_ld(&bar[XB_XCNT(j)]); sum += c; cnt += (c > 0u) ? 1u : 0u; mine = (j == x) ? c : mine; }
        if (sum == G) break;
        __builtin_amdgcn_s_sleep(1);
        if ((++sp & 255u) == 0u) { if (xb_ld(&bar[XB_TMO])) break; if (sp > XB_SPIN_CAP) { atomicAdd(&bar[XB_TMO], 1u); break; } }
    }
    nloc = mine > 0u ? mine : 1u; nx = cnt > 0u ? cnt : 1u;
}
__device__ __forceinline__ void xcd_barrier(const XcdBarrier& b, const bool thread0  ) {
    asm volatile("s_waitcnt vmcnt(0)" ::: "memory");
    __syncthreads();
    if (thread0) {
        unsigned* bar = b.bar; unsigned bx = b.x;
        asm volatile("" : "+s"(bar), "+s"(bx));
        __builtin_amdgcn_s_waitcnt(0);
        unsigned nloc = b.st[0], nx = b.st[1];
        if (nloc == 0u) { xcd_barrier_complete(bar, bx, nloc, nx); b.st[0] = nloc; b.st[1] = nx; }
        const unsigned old = xb_add(&bar[XB_XSUB(bx)], 1u);
        const unsigned gen = old / nloc;
        if (old + 1u == (gen + 1u) * nloc) {
            __builtin_amdgcn_fence(__ATOMIC_RELEASE, "agent");
            asm volatile("s_waitcnt vmcnt(0)" ::: "memory");
            const unsigned og = xb_add(&bar[XB_TOP], 1u);
            const unsigned tg = og / nx;
            if (og + 1u == (tg + 1u) * nx) xb_add(&bar[XB_TOPGEN], 1u);
            else XB_SPIN(xb_ld(&bar[XB_TOPGEN]) == tg, bar);
            __builtin_amdgcn_fence(__ATOMIC_ACQUIRE, "agent");
            xb_add(&bar[XB_XGEN(bx)], 1u);
            asm volatile("s_waitcnt vmcnt(0)" ::: "memory");
        } else {
            XB_SPIN(xb_ld(&bar[XB_XGEN(bx)]) == gen, bar);
            __builtin_amdgcn_fence(__ATOMIC_ACQUIRE, "agent");
            asm volatile("s_waitcnt vmcnt(0)" ::: "memory");
        }
    }
    __syncthreads();
}

struct Args { const float* in[26]; float* out; unsigned char* ws; int s_lo, s_hi; };
enum { I_X = 0, I_C, I_CTX, I_CCTX, I_N1G, I_N2G, I_WMOD, I_BMOD, I_WIN, I_RETDEC, I_SINK, I_MU, I_W0, I_WUP, I_A0, I_AUP, I_GUP, I_KK, I_KA, I_RK, I_LNG, I_WBR, I_WOUT, I_WFF1, I_WFF2, I_FING };
struct Frame {
    LAS unsigned char* lds;
    unsigned* ctl;
    int tid, lane, wave, G, wg;
    unsigned char* ws;
};
template <class T> __device__ __forceinline__ T* wsp(const Frame& F, size_t off) { return (T*)(F.ws + off); }
constexpr int PTAB_OFF = LDSCTL_OFF + 64;
__device__ __forceinline__ const float* inp(const Frame& F, int i) {
    const LAS unsigned* t = (const LAS unsigned*)(F.lds + PTAB_OFF) + 2 * i;
    const unsigned lo = __builtin_amdgcn_readfirstlane(t[0]), hi = __builtin_amdgcn_readfirstlane(t[1]);
    return (const float*)(GAS const float*)(((unsigned long long)hi << 32) | (unsigned long long)lo);
}

__device__ __forceinline__ int scan_row(int b, int dir, int s) {
    if (s < TCX) return ML + b * TCX + (dir ? (TCX - 1 - s) : s);
    const int t = s - TCX; return b * TL + (dir ? (TL - 1 - t) : t);
}

constexpr int CONV_IT_IN = (DM / 64) * (NIN / 64), CONV_IT_BR = (BW / 64) * (DM / 64), CONV_IT_OUT = (DM / 64) * (DM / 64), CONV_IT_F1 = (DM / 64) * (DFF / 64), CONV_IT_F2 = (DFF / 64) * (DM / 64);
constexpr int CONV_IT_L = CONV_IT_IN + 3 * CONV_IT_BR + CONV_IT_OUT + CONV_IT_F1 + CONV_IT_F2;
constexpr int CONV_WG_ITEMS = CONV_IT_L / 8;
static_assert(CONV_IT_L % 8 == 0, "conversion items per layer");
constexpr int CW_CONVQ = 24576;
struct ConvDesc { const float* W; bf16* WT; int K, N, k0, n0; };
__device__ __forceinline__ ConvDesc conv_desc(Frame& F, int l, int r) {
    ConvDesc d; int item;
    if (r < CONV_IT_IN) { d.W = inp(F, I_WIN) + (size_t)l * DM * NIN; d.K = DM; d.N = NIN; d.WT = wsp<bf16>(F, WS_WIN + l * SZ_WIN); item = r; }
    else if ((r -= CONV_IT_IN) < 3 * CONV_IT_BR) { const int n = r / CONV_IT_BR; d.W = inp(F, I_WBR) + ((size_t)l * 3 + n) * BW * DM; d.K = BW; d.N = DM; d.WT = wsp<bf16>(F, WS_WBR + l * SZ_WBR) + (size_t)n * DM * BW; item = r % CONV_IT_BR; }
    else if ((r -= 3 * CONV_IT_BR) < CONV_IT_OUT) { d.W = inp(F, I_WOUT) + (size_t)l * DM * DM; d.K = DM; d.N = DM; d.WT = wsp<bf16>(F, WS_WOUT + l * SZ_WOUT); item = r; }
    else if ((r -= CONV_IT_OUT) < CONV_IT_F1) { d.W = inp(F, I_WFF1) + (size_t)l * DM * DFF; d.K = DM; d.N = DFF; d.WT = wsp<bf16>(F, WS_WFF1 + l * SZ_WFF); item = r; }
    else { r -= CONV_IT_F1; d.W = inp(F, I_WFF2) + (size_t)l * DFF * DM; d.K = DFF; d.N = DM; d.WT = wsp<bf16>(F, WS_WFF2 + l * SZ_WFF); item = r; }
    const int nblk = d.N / 64; d.k0 = 64 * (item / nblk); d.n0 = 64 * (item % nblk);
    return d;
}
__device__ __forceinline__ void tr_load(const ConvDesc& d, int lane, f32x4 (&v)[16]) {
    const int kr = lane >> 4, nc = (lane & 15) * 4;
#pragma unroll
    for (int i = 0; i < 16; ++i) v[i] = __builtin_nontemporal_load((const f32x4*)(d.W + (size_t)(d.k0 + 8 * (i >> 1) + 2 * kr + (i & 1)) * d.N + d.n0 + nc));
}
__device__ __forceinline__ void tr_store(const ConvDesc& d, int lane, LAS unsigned char* scr, const f32x4 (&v)[16]) {
    const int kr = lane >> 4, nc = (lane & 15) * 4, sw = 4 * ((lane >> 2) & 3);
    LAS unsigned* t = (LAS unsigned*)scr + nc * 36;
#pragma unroll
    for (int m = 0; m < 8; ++m) { const int kp = (4 * m + kr) ^ sw;
        t[kp] = cvtpk(v[2 * m].x, v[2 * m + 1].x); t[36 + kp] = cvtpk(v[2 * m].y, v[2 * m + 1].y); t[72 + kp] = cvtpk(v[2 * m].z, v[2 * m + 1].z); t[108 + kp] = cvtpk(v[2 * m].w, v[2 * m + 1].w); }
    LDS_WAIT(); asm volatile("" ::: "memory");
    const int c = lane & 7;
#pragma unroll
    for (int j = 0; j < 8; ++j) { const int n = (lane >> 3) + 8 * j;
        __builtin_nontemporal_store(*(const LAS u32x4*)(scr + n * 144 + 16 * (c ^ ((n >> 4) & 3))), (u32x4*)(d.WT + (size_t)(d.n0 + n) * d.K + d.k0 + 8 * c)); }
    LDS_WAIT(); asm volatile("" ::: "memory");
}
__device__ __forceinline__ void conv_wave_item(Frame& F, int l, int r, LAS unsigned char* scr) { const ConvDesc d = conv_desc(F, l, r); f32x4 v[16]; tr_load(d, F.lane, v); tr_store(d, F.lane, scr, v); }
constexpr int CONV_Q0 = (CONV_IT_L - CONV_IT_IN) / 8;
constexpr int CONV_QTOT = CONV_Q0 + (NL - 1) * CONV_WG_ITEMS;
static_assert(CONV_WG_ITEMS % 4 == 0 && CONV_Q0 % 4 == 0 && (CONV_IT_L - CONV_IT_IN) % 8 == 0, "conversion ranges");
__device__ __forceinline__ ConvDesc conv_desc_q(Frame& F, int gw) {
    if (gw < CONV_Q0 * 8) return conv_desc(F, 0, CONV_IT_IN + gw);
    gw -= CONV_Q0 * 8; const int l = gw / CONV_IT_L;
    return conv_desc(F, 1 + l, gw - l * CONV_IT_L);
}
__device__ __forceinline__ int conv_deadline(int layer) { return CONV_Q0 + (layer - 1) * CONV_WG_ITEMS + CONV_WG_ITEMS; }
__device__ __forceinline__ void conv_pull(Frame& F, int nr, int limit) {
    volatile LAS int* qslot = (volatile LAS int*)(F.lds + LDSCTL_OFF);
    LAS unsigned char* scr = F.lds + F.wave * 9216;
    __syncthreads();
    for (int n = 0; nr < 0 || n < nr; ++n) {
        LB();
        if (F.tid == 0) { int it = (int)__hip_atomic_load(F.ctl + CW_CONVQ, __ATOMIC_RELAXED, __HIP_MEMORY_SCOPE_AGENT);
            if (it < limit) it = (int)__hip_atomic_fetch_add(F.ctl + CW_CONVQ, 4u, __ATOMIC_RELAXED, __HIP_MEMORY_SCOPE_AGENT); else it = CONV_QTOT;
            qslot[0] = it; }
        LB();
        const int item = qslot[0];
        if (item >= CONV_QTOT) break;
        const int r0 = item * 8 + F.wave;
        f32x4 va[16], vb[16];
        const ConvDesc d0 = conv_desc_q(F, r0), d1 = conv_desc_q(F, r0 + 8);
        tr_load(d0, F.lane, va);
        tr_load(d1, F.lane, vb);
        tr_store(d0, F.lane, scr, va);
        const ConvDesc d2 = conv_desc_q(F, r0 + 16);
        tr_load(d2, F.lane, va);
        tr_store(d1, F.lane, scr, vb);
        const ConvDesc d3 = conv_desc_q(F, r0 + 24);
        tr_load(d3, F.lane, vb);
        tr_store(d2, F.lane, scr, va);
        tr_store(d3, F.lane, scr, vb);
    }
    __syncthreads();
}
__device__ __forceinline__ void p0_prologue(Frame& F) {
    const int gw = F.wg * NWAVES + F.wave, NGW = F.G * NWAVES;
    const int gt = F.wg * NTHR + F.tid, NGT = F.G * NTHR;
    LAS float* sil = (LAS float*)(F.lds + 81920);
    for (int e = F.tid; e < 5 * DM; e += NTHR) { const int r = e / DM, k = e % DM; const float v = r < 4 ? inp(F, I_C)[r * DM + k] : inp(F, I_CCTX)[k]; sil[e] = v * sigm(v); }
    { LAS unsigned char* scr = F.lds + F.wave * 9216;
      for (int it = gw; it < CONV_IT_IN; it += NGW) conv_wave_item(F, 0, it, scr); }
    for (int e = gt; e < NL * (LDP - NIN) * DM / 8; e += NGT) { const int l = e / ((LDP - NIN) * DM / 8), r = e % ((LDP - NIN) * DM / 8);
        *(u32x4*)(wsp<bf16>(F, WS_WIN + l * SZ_WIN) + (size_t)NIN * DM + (size_t)r * 8) = (u32x4){0u, 0u, 0u, 0u}; }
    for (int e = gt; e < NL * (KLR / 8) * NLR; e += NGT) {
        const int n = e % NLR, kg = (e / NLR) % (KLR / 8), l = e / (NLR * (KLR / 8)), k0 = 8 * kg;
        const float* src = nullptr;
        if (n < 2048) { const int d = n >> 10; if (kg >= 8 * d && kg < 8 * d + 8) src = inp(F, I_WUP) + (((size_t)l * 2 + d) * 64 + (k0 - 64 * d)) * BW + (n & 1023); }
        else if (n < 4096) { const int d = (n - 2048) >> 10; if (kg >= 16 + 8 * d && kg < 24 + 8 * d) src = inp(F, I_AUP) + (((size_t)l * 2 + d) * 64 + (k0 - 128 - 64 * d)) * BW + (n & 1023); }
        else if (kg >= 32) src = inp(F, I_GUP) + ((size_t)l * 128 + (k0 - 256)) * BW + (n - 4096);
        u32x4 o = {0u, 0u, 0u, 0u};
        if (src) { float v[8];
#pragma unroll
            for (int j = 0; j < 8; ++j) v[j] = src[(size_t)j * BW];
            o.x = pk2(v[0], v[1]); o.y = pk2(v[2], v[3]); o.z = pk2(v[4], v[5]); o.w = pk2(v[6], v[7]); }
        *(u32x4*)(wsp<bf16>(F, WS_WLR + l * SZ_WLR) + (size_t)n * KLR + k0) = o;
    }
    { const f32x4* x4 = (const f32x4*)inp(F, I_X); const f32x4* c4 = (const f32x4*)inp(F, I_CTX); u32x2* h4 = wsp<u32x2>(F, WS_H);
      for (int e = gt; e < ML * DM / 4; e += 4 * NGT) { f32x4 x[4];
#pragma unroll
          for (int k = 0; k < 4; ++k) { const int i = e + k * NGT; x[k] = x4[i < ML * DM / 4 ? i : e]; }
#pragma unroll
          for (int k = 0; k < 4; ++k) { const int i = e + k * NGT; if (i < ML * DM / 4) { u32x2 w; w.x = pk2(x[k].x, x[k].y); w.y = pk2(x[k].z, x[k].w); h4[i] = w; } } }
      for (int e = gt; e < MC * DM / 4; e += 4 * NGT) { f32x4 x[4];
#pragma unroll
          for (int k = 0; k < 4; ++k) { const int i = e + k * NGT; x[k] = c4[i < MC * DM / 4 ? i : e]; }
#pragma unroll
          for (int k = 0; k < 4; ++k) { const int i = e + k * NGT; if (i < MC * DM / 4) { u32x2 w; w.x = pk2(x[k].x, x[k].y); w.y = pk2(x[k].z, x[k].w); h4[ML * DM / 4 + i] = w; } } } }
    for (int e = gt; e < NL * 8 * 1024; e += NGT) { const int l = e >> 13, v = (e >> 10) & 7, c = e & 1023; float x;
        if (v < 2) x = inp(F, I_W0)[(l * 2 + v) * 1024 + c]; else if (v < 4) x = inp(F, I_A0)[(l * 2 + v - 2) * 1024 + c];
        else if (v == 4) x = inp(F, I_KK)[l * 1024 + c]; else if (v == 5) x = inp(F, I_KA)[l * 1024 + c]; else if (v == 6) x = inp(F, I_RK)[l * 1024 + c]; else x = inp(F, I_LNG)[l * 1024 + c];
        wsp<float>(F, WS_VEC)[e] = x; }
    if (gt < 64 * 32) { const int pos = gt >> 5, i = gt & 31; const float inv = powf(10000.0f, -(float)i / 32.0f); const float ang = (float)pos * inv;
        wsp<float>(F, WS_ROPE)[2 * gt] = cosf(ang); wsp<float>(F, WS_ROPE)[2 * gt + 1] = sinf(ang); }
    __syncthreads();
    for (int it = gw; it < NL * 8 * 48; it += NGW) {
        const int l = it / (8 * 48), kc = (it / 48) % 8, cc = it % 48, col = cc * 256 + F.lane * 4, k0 = kc * 256;
        const float* wp = inp(F, I_WMOD) + ((size_t)l * DM + k0) * 12288 + col;
        f32x4 a0 = {0.f, 0.f, 0.f, 0.f}, a1 = a0, a2 = a0, a3 = a0, a4 = a0;
#pragma unroll 16
        for (int k = 0; k < 256; ++k) { const f32x4 w = *(const f32x4*)(wp + (size_t)k * 12288);
            a0 += sil[0 * DM + k0 + k] * w; a1 += sil[1 * DM + k0 + k] * w; a2 += sil[2 * DM + k0 + k] * w; a3 += sil[3 * DM + k0 + k] * w; a4 += sil[4 * DM + k0 + k] * w; }
        float* mp = wsp<float>(F, WS_MODP) + ((size_t)(kc * NL + l) * 5) * 12288 + col;
        *(f32x4*)(mp) = a0; *(f32x4*)(mp + 12288) = a1; *(f32x4*)(mp + 2 * 12288) = a2; *(f32x4*)(mp + 3 * 12288) = a3; *(f32x4*)(mp + 4 * 12288) = a4;
    }
}
__device__ __forceinline__ void p1_modreduce(Frame& F) {
    const int gt = F.wg * NTHR + F.tid, NGT = F.G * NTHR;
    for (int e = gt; e < NL * 5 * 12288; e += NGT) { const int l = e / (5 * 12288), j = e % 12288;
        float s = inp(F, I_BMOD)[l * 12288 + j];
#pragma unroll
        for (int kc = 0; kc < 8; ++kc) s += wsp<float>(F, WS_MODP)[(size_t)kc * NL * 5 * 12288 + e];
        wsp<float>(F, WS_MOD)[e] = s; }
}

struct NormIn { u32x2 h[8]; u32x2 d[8]; u32x2 e[8]; };
__device__ __forceinline__ void norm_fetch(Frame& F, int row, int nd, NormIn& in) {
    const u32x2* xr = (const u32x2*)(wsp<bf16>(F, WS_H) + (size_t)row * DM) + F.lane;
    const u32x2* pp = (const u32x2*)(wsp<bf16>(F, WS_MGF) + (size_t)row * DM) + F.lane;
    const u32x2* pe = nd == 2 ? pp + (size_t)ML * DM / 4 : pp;
#pragma unroll
    for (int j = 0; j < 8; ++j) in.h[j] = xr[64 * j];
#pragma unroll
    for (int j = 0; j < 8; ++j) in.d[j] = pp[64 * j];
#pragma unroll
    for (int j = 0; j < 8; ++j) in.e[j] = pe[64 * j];
}
__device__ __forceinline__ void norm_finish(Frame& F, bool wb, int row, int mr, f32x4 (&v)[8]) {
    const LAS float* LA = (const LAS float*)F.lds + mr * DM; const LAS float* LB = LA + 5 * DM;
    if (wb) { u32x2* xw = (u32x2*)(wsp<bf16>(F, WS_H) + (size_t)row * DM) + F.lane;
#pragma unroll
        for (int j = 0; j < 8; ++j) { u32x2 w; w.x = pk2(v[j].x, v[j].y); w.y = pk2(v[j].z, v[j].w); xw[64 * j] = w; } }
    float ss = 0.f;
#pragma unroll
    for (int j = 0; j < 8; ++j) ss += (v[j].x * v[j].x + v[j].y * v[j].y) + (v[j].z * v[j].z + v[j].w * v[j].w);
    const float rs = __builtin_amdgcn_rsqf(wave_sum(ss, F.lane) * (1.0f / DM) + 1e-6f);
    u32x2* o = (u32x2*)(wsp<bf16>(F, WS_U) + (size_t)row * DM) + F.lane;
    asm volatile("" ::: "memory");
#pragma unroll
    for (int j = 0; j < 8; ++j) { const int c = 4 * F.lane + 256 * j;
        const f32x4 y = (v[j] * rs) * *(const LAS f32x4*)(LA + c) + *(const LAS f32x4*)(LB + c);
        u32x2 w; w.x = pk2(y.x, y.y); w.y = pk2(y.z, y.w); o[64 * j] = w; }
}
__device__ __forceinline__ void norm_row(Frame& F, int nd, int row, const NormIn& in) {
    f32x4 v[8];
#pragma unroll
    for (int j = 0; j < 8; ++j) { const u32x2 w = in.h[j]; v[j] = (f32x4){bf_lo(w.x), bf_hi(w.x), bf_lo(w.y), bf_hi(w.y)}; }
    if (nd >= 1) {
#pragma unroll
        for (int j = 0; j < 8; ++j) { const u32x2 w = in.d[j]; v[j] += (f32x4){bf_lo(w.x), bf_hi(w.x), bf_lo(w.y), bf_hi(w.y)}; } }
    if (nd == 2) {
#pragma unroll
        for (int j = 0; j < 8; ++j) { const u32x2 w = in.e[j]; v[j] += (f32x4){bf_lo(w.x), bf_hi(w.x), bf_lo(w.y), bf_hi(w.y)}; } }
    norm_finish(F, nd == 2, row, row >> 11, v);
}
__device__ __forceinline__ void norm_ctx_row(Frame& F, bool partials, int row) {
    f32x4 v[8];
    { const u32x2* xr = (const u32x2*)(wsp<bf16>(F, WS_H) + (size_t)row * DM) + F.lane; u32x2 h[8];
#pragma unroll
      for (int j = 0; j < 8; ++j) h[j] = xr[64 * j];
#pragma unroll
      for (int j = 0; j < 8; ++j) v[j] = (f32x4){bf_lo(h[j].x), bf_hi(h[j].x), bf_lo(h[j].y), bf_hi(h[j].y)}; }
    if (partials) {
        const u32x2* pp = (const u32x2*)(wsp<bf16>(F, WS_YDR) + (size_t)(row - ML) * DM) + F.lane;
#pragma unroll 1
        for (int s = 0; s < 8; s += 2) { u32x2 pw[2][8];
#pragma unroll
            for (int j = 0; j < 8; ++j) { pw[0][j] = pp[(size_t)s * 1024 * DM / 4 + 64 * j]; pw[1][j] = pp[(size_t)(s + 1) * 1024 * DM / 4 + 64 * j]; }
#pragma unroll
            for (int j = 0; j < 8; ++j) { const u32x2 w = pw[0][j], x = pw[1][j];
                v[j] += (f32x4){bf_lo(w.x), bf_hi(w.x), bf_lo(w.y), bf_hi(w.y)}; v[j] += (f32x4){bf_lo(x.x), bf_hi(x.x), bf_lo(x.y), bf_hi(x.y)}; } }
    }
    norm_finish(F, partials, row, 4, v);
}
__device__ __forceinline__ void norm_phase(Frame& F, int layer, int which, int nrows, bool partials) {
    const int gw = F.wg * NWAVES + F.wave, NGW = F.G * NWAVES;
    { const float* gptr = inp(F, which ? I_N2G : I_N1G) + layer * DM; const float* modb = wsp<float>(F, WS_MOD) + (size_t)layer * 5 * 12288 + (which ? 3 * DM : 0);
      LAS float* LA = (LAS float*)F.lds; LAS float* LB = LA + 5 * DM;
      for (int e = F.tid; e < 5 * (DM / 4); e += NTHR) { const int mr = e / (DM / 4), c = (e % (DM / 4)) * 4;
          const f32x4 g = *(const f32x4*)(gptr + c), sh = *(const f32x4*)(modb + (size_t)mr * 12288 + c), sc = *(const f32x4*)(modb + (size_t)mr * 12288 + DM + c);
          *(LAS f32x4*)(LA + mr * DM + c) = g * (1.0f + sc); *(LAS f32x4*)(LB + mr * DM + c) = sh; }
      __syncthreads(); }
    for (int row = ML + ((gw + NGW / 2) % NGW); row < nrows; row += NGW) norm_ctx_row(F, partials, row);
    int row = gw; if (row >= ML) return;
    const int nd = partials ? (which ? 1 : 2) : 0;
    NormIn a, b; norm_fetch(F, row, nd, a);
    for (;;) {
        const int r1 = row + NGW; const bool h1 = r1 < ML; norm_fetch(F, h1 ? r1 : row, nd, b);
        norm_row(F, nd, row, a);
        if (!h1) break;
        const int r2 = r1 + NGW; const bool h2 = r2 < ML; norm_fetch(F, h2 ? r2 : r1, nd, a);
        norm_row(F, nd, r1, b);
        if (!h2) break;
        row = r2;
    }
}
__device__ __forceinline__ void final_norm(Frame& F, float* out) {
    const int gw = F.wg * NWAVES + F.wave, NGW = F.G * NWAVES;
#ifdef TS_DEBUG
    const float dbg_e0 = (float)F.ctl[CW_DBG + 8] * TS_SCALE, dbg_e1 = 0.f;
#endif
#ifdef RW_DEBUG
    const float* dst_ = (const float*)(F.ctl + CW_DBG); const float er0_ = sqrtf(dst_[0] / fmaxf(dst_[1], 1e-30f)), er1_ = sqrtf(dst_[2] / fmaxf(dst_[3], 1e-30f)); const float dbg_e0 = er0_ > RW_DEBUG_THR ? 0.3f : 0.0f, dbg_e1 = er1_ > RW_DEBUG_THR ? 0.6f : 0.0f;
#endif
    LAS float* LG = (LAS float*)F.lds;
    for (int e = F.tid; e < DM / 4; e += NTHR) *(LAS f32x4*)(LG + 4 * e) = *(const f32x4*)(inp(F, I_FING) + 4 * e);
    __syncthreads();
    for (int row = gw; row < ML; row += NGW) {
        const u32x2* xr = (const u32x2*)(wsp<bf16>(F, WS_H) + (size_t)row * DM) + F.lane;
        const u32x2* pp = (const u32x2*)(wsp<bf16>(F, WS_MGF) + (size_t)row * DM) + F.lane;
        f32x4 v[8]; float ss = 0.f; u32x2 hw[8], d1[8], d2[8];
#pragma unroll
        for (int j = 0; j < 8; ++j) { hw[j] = xr[64 * j]; d1[j] = pp[64 * j]; d2[j] = pp[(size_t)ML * DM / 4 + 64 * j]; }
        asm volatile("" ::: "memory");
#pragma unroll
        for (int j = 0; j < 8; ++j) { const u32x2 h = hw[j], w = d1[j], x = d2[j]; v[j] = (f32x4){bf_lo(h.x), bf_hi(h.x), bf_lo(h.y), bf_hi(h.y)};
            v[j] += (f32x4){bf_lo(w.x), bf_hi(w.x), bf_lo(w.y), bf_hi(w.y)}; v[j] += (f32x4){bf_lo(x.x), bf_hi(x.x), bf_lo(x.y), bf_hi(x.y)}; }
#pragma unroll
        for (int j = 0; j < 8; ++j) ss += (v[j].x * v[j].x + v[j].y * v[j].y) + (v[j].z * v[j].z + v[j].w * v[j].w);
        const float rs = __builtin_amdgcn_rsqf(wave_sum(ss, F.lane) * (1.0f / DM) + 1e-6f);
        f32x4* o = (f32x4*)(out + (size_t)row * DM) + F.lane;
#pragma unroll
        for (int j = 0; j < 8; ++j) { const f32x4 g = *(const LAS f32x4*)(LG + 4 * F.lane + 256 * j); f32x4 ov = (v[j] * rs) * g;
#if defined(RW_DEBUG) || defined(TS_DEBUG)
#ifndef RW_DEBUG_NOSTAT
            ov += dbg_e0; if (row == 0 && j == 0 && F.lane == 0) ov.x += dbg_e1;
#endif
#endif
            o[64 * j] = ov; }
    }
}
__device__ __forceinline__ void prep_phase(Frame& F, int layer) {
    const int gw = F.wg * NWAVES + F.wave, NGW = F.G * NWAVES;
    const bf16* P = wsp<bf16>(F, WS_P);
    LAS float* Lmu0 = (LAS float*)F.lds; LAS float* Lmu1 = Lmu0 + RWIN; LAS float* Lrope = Lmu1 + RWIN;
    { const float* mu0 = inp(F, I_MU) + (size_t)layer * 2 * RWIN; const float* rope = wsp<float>(F, WS_ROPE);
      for (int e = F.tid; e < 2 * RWIN / 4; e += NTHR) *(LAS f32x4*)(Lmu0 + 4 * e) = *(const f32x4*)(mu0 + 4 * e);
      for (int e = F.tid; e < 64 * 32 * 2 / 4; e += NTHR) *(LAS f32x4*)(Lrope + 4 * e) = *(const f32x4*)(rope + 4 * e);
      __syncthreads(); }
    for (int row = gw; row < MT; row += NGW) {
        bool first, last; int t = 0;
        if (row < ML) { t = row & (TL - 1); first = t == 0; last = t == TL - 1; } else { const int c = (row - ML) & (TCX - 1); first = c == 0; last = c == TCX - 1; }
        const bf16* pr = P + (size_t)row * LDP + C_RW; const bf16* pv = first ? pr : pr - LDP; const bf16* pn = last ? pr : pr + LDP;
        const bf16* ps = P + (size_t)row * LDP + C_SWA;
        u32x4 pw[7], vw[7], nw[7]; unsigned rx[3][4];
#pragma unroll
        for (int p = 0; p < 7; ++p) { int j8 = F.lane + 64 * p; j8 = j8 < RWIN / 8 ? j8 : RWIN / 8 - 1; const int c = 8 * j8;
            pw[p] = *(const u32x4*)(pr + c); vw[p] = *(const u32x4*)(pv + c); nw[p] = *(const u32x4*)(pn + c); }
#pragma unroll
        for (int q = 0; q < 3; ++q) { int tk = F.lane + 64 * q; tk = tk < 160 ? tk : 159; const bf16* ph = ps + (tk >> 4) * 128 + (tk & 15) * 2;
            rx[q][0] = *(const unsigned*)(ph); rx[q][1] = *(const unsigned*)(ph + 32); rx[q][2] = *(const unsigned*)(ph + 64); rx[q][3] = *(const unsigned*)(ph + 96); }
        asm volatile("" ::: "memory");
        bf16* xs = wsp<bf16>(F, WS_XS) + (size_t)row * 3072; bf16* alr = wsp<bf16>(F, WS_ALR) + (size_t)row * KLR;
#pragma unroll
        for (int p = 0; p < 7; ++p) { const int j8 = F.lane + 64 * p;
            if (j8 < RWIN / 8) { const int c = 8 * j8;
                const u32x4 cw = pw[p]; const u32x4 vv = first ? (u32x4){0u, 0u, 0u, 0u} : vw[p]; const u32x4 nn = last ? (u32x4){0u, 0u, 0u, 0u} : nw[p];
                const f32x4 ma = *(const LAS f32x4*)(Lmu0 + c), mb = *(const LAS f32x4*)(Lmu0 + c + 4), na = *(const LAS f32x4*)(Lmu1 + c), nb = *(const LAS f32x4*)(Lmu1 + c + 4);
                float s[8];
#pragma unroll
                for (int e = 0; e < 4; ++e) { const float p0 = bf_lo(cw[e]), p1 = bf_hi(cw[e]), v0 = bf_lo(vv[e]), v1 = bf_hi(vv[e]), n0 = bf_lo(nn[e]), n1 = bf_hi(nn[e]);
                    const float m0 = e < 2 ? ma[2 * e] : mb[2 * e - 4], m1 = e < 2 ? ma[2 * e + 1] : mb[2 * e - 3], q0 = e < 2 ? na[2 * e] : nb[2 * e - 4], q1 = e < 2 ? na[2 * e + 1] : nb[2 * e - 3];
                    s[2 * e] = p0 + m0 * (v0 - p0) + q0 * (n0 - p0); s[2 * e + 1] = p1 + m1 * (v1 - p1) + q1 * (n1 - p1); }
                if (c < 3072) { u32x4 o; o.x = pk2(s[0], s[1]); o.y = pk2(s[2], s[3]); o.z = pk2(s[4], s[5]); o.w = pk2(s[6], s[7]); *(u32x4*)(xs + c) = o; }
                else { u32x4 o; int dst;
                    if (c < 3200) { dst = c - 3072; o.x = pk2(ftanh(s[0]), ftanh(s[1])); o.y = pk2(ftanh(s[2]), ftanh(s[3])); o.z = pk2(ftanh(s[4]), ftanh(s[5])); o.w = pk2(ftanh(s[6]), ftanh(s[7])); }
                    else if (c < 3328) { dst = 128 + c - 3200; o.x = pk2(s[0], s[1]); o.y = pk2(s[2], s[3]); o.z = pk2(s[4], s[5]); o.w = pk2(s[6], s[7]); }
                    else { dst = 256 + c - 3328; o.x = pk2(sigm(s[0]), sigm(s[1])); o.y = pk2(sigm(s[2]), sigm(s[3])); o.z = pk2(sigm(s[4]), sigm(s[5])); o.w = pk2(sigm(s[6]), sigm(s[7])); }
                    *(u32x4*)(alr + dst) = o; } } }
        bf16* qk = wsp<bf16>(F, WS_QKR) + (size_t)row * NQK;
        const bool lat = row < ML; const int rr = t >> 6, cc = t & 63;
#pragma unroll
        for (int q = 0; q < 3; ++q) { const int tk = F.lane + 64 * q;
            if (tk < 160) { const int hd = tk >> 4, i2 = (tk & 15) * 2;
                f32x4 tr = {1.f, 0.f, 1.f, 0.f}, tc = tr;
                if (lat) { tr = *(const LAS f32x4*)(Lrope + (rr * 32 + i2) * 2); tc = *(const LAS f32x4*)(Lrope + (cc * 32 + i2) * 2); }
                const float a0 = bf_lo(rx[q][0]), a1 = bf_hi(rx[q][0]), b0 = bf_lo(rx[q][1]), b1 = bf_hi(rx[q][1]), c0 = bf_lo(rx[q][2]), c1 = bf_hi(rx[q][2]), d0 = bf_lo(rx[q][3]), d1 = bf_hi(rx[q][3]);
                unsigned* o = (unsigned*)(qk + hd * 128 + i2);
                o[0] = pk2(a0 * tr.x - b0 * tr.y, a1 * tr.z - b1 * tr.w); o[16] = pk2(b0 * tr.x + a0 * tr.y, b1 * tr.z + a1 * tr.w);
                o[32] = pk2(c0 * tc.x - d0 * tc.y, c1 * tc.z - d1 * tc.w); o[48] = pk2(d0 * tc.x + c0 * tc.y, d1 * tc.z + c1 * tc.w); } }
    }
}

__device__ __forceinline__ float red8(float v) {
    v += __int_as_float(__builtin_amdgcn_update_dpp(0, __float_as_int(v), 0xB1, 0xF, 0xF, true));
    v += __int_as_float(__builtin_amdgcn_update_dpp(0, __float_as_int(v), 0x4E, 0xF, 0xF, true));
    v += __int_as_float(__builtin_amdgcn_update_dpp(0, __float_as_int(v), 0x141, 0xF, 0xF, true));
    return v;
}
__device__ __forceinline__ float red16(float v) {
    v += __int_as_float(__builtin_amdgcn_update_dpp(0, __float_as_int(v), 0xB1, 0xF, 0xF, true));
    v += __int_as_float(__builtin_amdgcn_update_dpp(0, __float_as_int(v), 0x4E, 0xF, 0xF, true));
    v += __int_as_float(__builtin_amdgcn_update_dpp(0, __float_as_int(v), 0x141, 0xF, 0xF, true));
    v += __int_as_float(__builtin_amdgcn_update_dpp(0, __float_as_int(v), 0x140, 0xF, 0xF, true));
    return v;
}
typedef short bf16x8 __attribute__((ext_vector_type(8)));
typedef short s16x4 __attribute__((ext_vector_type(4)));
typedef float f32x16 __attribute__((ext_vector_type(16)));
#define MFMA32(a, b, c) __builtin_amdgcn_mfma_f32_32x32x16_bf16((a), (b), (c), 0, 0, 0)
__device__ __forceinline__ int crow(int reg, int h) { return (reg & 3) + 8 * (reg >> 2) + 4 * h; }
__device__ __forceinline__ s16x4 tr16(const LAS unsigned char* p) { return __builtin_bit_cast(s16x4, __builtin_amdgcn_ds_read_tr16_b64_v4i16((LAS s16x4*)p)); }
__device__ __forceinline__ bf16x8 frag_rm(const LAS unsigned char* base, int pitch, int r0, int k0, int lane) {
    return *(const LAS bf16x8*)(base + (r0 + (lane & 31)) * pitch + (k0 + 8 * (lane >> 5)) * 2);
}
template <bool PERM> __device__ __forceinline__ bf16x8 frag_tr(const LAS unsigned char* base, int pitch, int k0, int r0, int lane) {
    const int g = lane >> 4, i = lane & 15, q = i >> 2, p = i & 3, h = g >> 1;
    const LAS unsigned char* a = base + (k0 + (PERM ? 4 : 8) * h + q) * pitch + (r0 + 16 * (g & 1) + 4 * p) * 2;
    const s16x4 lo = tr16(a), hi = tr16(a + (PERM ? 8 : 4) * pitch);
    return __builtin_shufflevector(lo, hi, 0, 1, 2, 3, 4, 5, 6, 7);
}
__device__ __forceinline__ bf16x8 pack_step(const f32x16& x, int s) {
    u32x4 p; p.x = cvtpk(x[8 * s + 0], x[8 * s + 1]); p.y = cvtpk(x[8 * s + 2], x[8 * s + 3]); p.z = cvtpk(x[8 * s + 4], x[8 * s + 5]); p.w = cvtpk(x[8 * s + 6], x[8 * s + 7]);
    return __builtin_bit_cast(bf16x8, p);
}
__device__ __forceinline__ f32x16 zero16() { f32x16 z; for (int i = 0; i < 16; ++i) z[i] = 0.f; return z; }
constexpr int TP = 272;
constexpr int TILE_B = 128 * TP;
__device__ __forceinline__ void load_tile128(LAS unsigned char* dst, const bf16* src, size_t ld, int tid) {
    u32x4 t[4];
#pragma unroll
    for (int it = 0; it < 4; ++it) { const int idx = tid + NTHR * it, row = idx >> 4, ch = idx & 15; t[it] = *(const u32x4*)(src + (size_t)row * ld + ch * 8); }
    asm volatile("" ::: "memory");
#pragma unroll
    for (int it = 0; it < 4; ++it) { const int idx = tid + NTHR * it, row = idx >> 4, ch = idx & 15; *(LAS u32x4*)(dst + row * TP + ch * 16) = t[it]; }
}
__device__ __forceinline__ void tile3_fetch(u32x4 (&t)[3][4], const bf16* s0, const bf16* s1, const bf16* s2, size_t ld, int tid) {
#pragma unroll
    for (int it = 0; it < 4; ++it) { const int idx = tid + NTHR * it, row = idx >> 4, ch = idx & 15; const size_t o = (size_t)row * ld + ch * 8;
        t[0][it] = *(const u32x4*)(s0 + o); t[1][it] = *(const u32x4*)(s1 + o); t[2][it] = *(const u32x4*)(s2 + o); }
}
__device__ __forceinline__ void tile3_store(const u32x4 (&t)[3][4], LAS unsigned char* d0, LAS unsigned char* d1, LAS unsigned char* d2, int tid) {
#pragma unroll
    for (int it = 0; it < 4; ++it) { const int idx = tid + NTHR * it, row = idx >> 4, ch = idx & 15; const int o = row * TP + ch * 16;
        *(LAS u32x4*)(d0 + o) = t[0][it]; *(LAS u32x4*)(d1 + o) = t[1][it]; *(LAS u32x4*)(d2 + o) = t[2][it]; }
}

__device__ __forceinline__ void swa_unit(Frame& F, int layer, int unit) {
    const bf16* QK = wsp<bf16>(F, WS_QKR); const bf16* P = wsp<bf16>(F, WS_P);
    LAS unsigned char* Qt = F.lds; LAS unsigned char* Kt = F.lds + TILE_B; LAS unsigned char* Vt = F.lds + 2 * TILE_B;
    LAS float* stat = (LAS float*)(F.lds + 3 * TILE_B) + F.wave * 32;
    const int lane = F.lane, h = lane >> 5, wi = F.wave & 3, wh = F.wave >> 2;
    int b, qh, n, qrow0; bool isctx;
    if (unit < 512) { b = unit >> 7; qh = (unit >> 4) & 7; n = unit & 15; qrow0 = b * TL + n * 128; isctx = false; }
    else { const int u = unit - 512; b = u >> 4; qh = (u >> 1) & 7; n = u & 1; qrow0 = ML + b * TCX + n * 128; isctx = true; }
    const int kvh = qh >> 2;
    LB();
    load_tile128(Qt, QK + (size_t)qrow0 * NQK + qh * 128, NQK, F.tid);
    LB();
    bf16x8 qf[8];
#pragma unroll
    for (int ks = 0; ks < 8; ++ks) qf[ks] = frag_rm(Qt, TP, 32 * wi, 16 * ks, lane);
    const float L2E = 1.4426950408889634f, SC = 0.08838834764831845f * L2E;
    float m = inp(F, I_SINK)[layer * 8 + qh] * L2E, l = h == 0 ? 1.0f : 0.0f;
    f32x16 O0 = zero16(), O1 = zero16();
    const int iq = 32 * wi + (lane & 31);
    const int nch = isctx ? 2 : 5;
    auto chunk_info = [&](int c, int& krow0, int& mtype) -> bool {
        mtype = 0;
        if (isctx) { krow0 = ML + b * TCX + c * 128; return true; }
        if (c < 3) { const int kb = n - 1 + c; if (kb < 0 || kb > 15) return false; krow0 = b * TL + kb * 128; mtype = c == 0 ? 1 : (c == 2 ? 2 : 0); return true; }
        krow0 = ML + b * TCX + (c - 3) * 128; return true;
    };
    u32x4 pk[4], pv[4];
    auto fetch = [&](int krow0) {
#pragma unroll
        for (int it = 0; it < 4; ++it) { const int idx = F.tid + NTHR * it, row = idx >> 4, ch = idx & 15;
            pk[it] = *(const u32x4*)(QK + (size_t)(krow0 + row) * NQK + 1024 + kvh * 128 + ch * 8); pv[it] = *(const u32x4*)(P + (size_t)(krow0 + row) * LDP + C_SWA + 1280 + kvh * 128 + ch * 8); }
    };
    int c = 0, krow0 = 0, mtype = 0;
    while (!chunk_info(c, krow0, mtype)) ++c;
    fetch(krow0);
    while (c < nch) {
        const int mt = mtype;
        LB();
#pragma unroll
        for (int it = 0; it < 4; ++it) { const int idx = F.tid + NTHR * it, row = idx >> 4, ch = idx & 15; *(LAS u32x4*)(Kt + row * TP + ch * 16) = pk[it]; *(LAS u32x4*)(Vt + row * TP + ch * 16) = pv[it]; }
        LB();
        ++c; while (c < nch && !chunk_info(c, krow0, mtype)) ++c;
        if (c < nch) fetch(krow0);
        for (int kb = 0; kb < 4; ++kb) {
            f32x16 X = zero16();
#pragma unroll
            for (int ks = 0; ks < 8; ++ks) X = MFMA32(frag_rm(Kt, TP, 32 * kb, 16 * ks, lane), qf[ks], X);
            float bm = -INFINITY;
            int iql = iq - 32 * kb; asm volatile("" : "+v"(iql));
#pragma unroll
            for (int r = 0; r < 16; ++r) { const int d = iql - crow(r, h); float s = X[r] * SC;
                const bool ok = mt == 0 || (mt == 1 ? d <= 0 : d >= 0);
                s = ok ? s : -INFINITY; X[r] = s; bm = fmaxf(bm, s); }
            bm = fmaxf(bm, shx(bm, 32, lane));
            const float mn = fmaxf(m, bm), sc = __builtin_amdgcn_exp2f(m - mn); m = mn;
            float ps = 0.f;
#pragma unroll
            for (int r = 0; r < 16; ++r) { const float p = __builtin_amdgcn_exp2f(X[r] - mn); X[r] = p; ps += p; }
            l = l * sc + ps;
            const bf16x8 pa0 = pack_step(X, 0), pa1 = pack_step(X, 1);
            if (h == 0) stat[lane] = sc;
            LDS_WAIT();
#pragma unroll
            for (int g = 0; g < 4; ++g) { const f32x4 sv = *(const LAS f32x4*)(stat + 8 * g + 4 * h);
#pragma unroll
                for (int e = 0; e < 4; ++e) { O0[4 * g + e] *= sv[e]; O1[4 * g + e] *= sv[e]; } }
            O0 = MFMA32(pa0, frag_tr<true>(Vt, TP, 32 * kb, 64 * wh, lane), O0);
            O0 = MFMA32(pa1, frag_tr<true>(Vt, TP, 32 * kb + 16, 64 * wh, lane), O0);
            O1 = MFMA32(pa0, frag_tr<true>(Vt, TP, 32 * kb, 64 * wh + 32, lane), O1);
            O1 = MFMA32(pa1, frag_tr<true>(Vt, TP, 32 * kb + 16, 64 * wh + 32, lane), O1);
        }
    }
    l += shx(l, 32, lane);
    if (h == 0) stat[lane] = 1.0f / l;
    LDS_WAIT();
    bf16* yo = wsp<bf16>(F, WS_Y) + (size_t)(qrow0 + 32 * wi) * 3072 + 1024 + qh * 128 + 64 * wh + (lane & 31);
#pragma unroll
    for (int g = 0; g < 4; ++g) { const f32x4 sv = *(const LAS f32x4*)(stat + 8 * g + 4 * h);
#pragma unroll
        for (int e = 0; e < 4; ++e) { const int r = 8 * g + 4 * h + e; yo[(size_t)r * 3072] = (bf16)f2bf(O0[4 * g + e] * sv[e]); yo[(size_t)r * 3072 + 32] = (bf16)f2bf(O1[4 * g + e] * sv[e]); } }
}

constexpr size_t ST_CHUNK = (size_t)128 * 128;
__device__ __forceinline__ int ret_chunk_row0(int b, int jF) { return jF < 2 ? ML + b * TCX + jF * 128 : b * TL + (jF - 2) * 128; }
__device__ __forceinline__ void ret_state_unit(Frame& F, int layer, int unit) {
    const int dvq = unit & 3, dir = (unit >> 2) & 1, hh = (unit >> 3) & 7, b = unit >> 6;
    const bf16* P = wsp<bf16>(F, WS_P);
    bf16* ST = wsp<bf16>(F, WS_ST) + ((size_t)((b * 8 + hh) * 2 + dir) * 18) * ST_CHUNK;
    const float gam = sigm(inp(F, I_RETDEC)[(layer * 2 + dir) * 8 + hh]); const float lg2 = __builtin_amdgcn_logf(gam);
    const float gC = __builtin_amdgcn_exp2f(lg2 * 128.0f);
    LAS unsigned char* Kt = F.lds; LAS unsigned char* Vt = F.lds + TILE_B;
    constexpr int VP = 80;
    const int lane = F.lane, h = lane >> 5, w = F.wave;
    f32x16 acc = zero16();
    const float vfac = __builtin_amdgcn_exp2f(lg2 * (float)(127 - (F.tid >> 2))) * 0.08838834764831845f;
    u32x4 pkA[4], pvA, pkB[4], pvB;
#define RS_FETCH(c_, pk_, pv_) do { const int jf_ = dir == 0 ? (c_) : ((c_) < 2 ? 1 - (c_) : 19 - (c_)); const int r0_ = ret_chunk_row0(b, jf_); \
        _Pragma("unroll") for (int it = 0; it < 4; ++it) { const int idx = F.tid + NTHR * it, tp = idx >> 4, ch = idx & 15; const int row = r0_ + (dir ? 127 - tp : tp); \
            pk_[it] = *(const u32x4*)(P + (size_t)row * LDP + C_RET + 1024 + hh * 128 + ch * 8); } \
        { const int tp = F.tid >> 2, ch = F.tid & 3; const int row = r0_ + (dir ? 127 - tp : tp); \
          pv_ = *(const u32x4*)(P + (size_t)row * LDP + C_RET + 2048 + hh * 128 + dvq * 32 + ch * 8); } } while (0)
#define RS_STEP(c_, pk_, pv_) do { const int jF = dir == 0 ? (c_) : ((c_) < 2 ? 1 - (c_) : 19 - (c_)); \
        LB(); \
        _Pragma("unroll") for (int it = 0; it < 4; ++it) { const int idx = F.tid + NTHR * it, tp = idx >> 4, ch = idx & 15; *(LAS u32x4*)(Kt + tp * TP + ch * 16) = pk_[it]; } \
        { const int tp = F.tid >> 2, ch = F.tid & 3; u32x4 q_; \
          _Pragma("unroll") for (int e = 0; e < 4; ++e) q_[e] = cvtpk(bf_lo(pv_[e]) * vfac, bf_hi(pv_[e]) * vfac); \
          *(LAS u32x4*)(Vt + tp * VP + ch * 16) = q_; } \
        LB(); \
        if ((c_) + 2 < 18) RS_FETCH((c_) + 2, pk_, pv_); \
        if (w < 4) { \
            bf16* so = ST + (size_t)jF * ST_CHUNK + (size_t)(dvq * 32) * 128 + 32 * w + (lane & 31); \
            _Pragma("unroll") for (int r = 0; r < 16; ++r) so[(size_t)crow(r, h) * 128] = (bf16)f2bf(acc[r]); \
            _Pragma("unroll") for (int r = 0; r < 16; ++r) acc[r] *= gC; \
            _Pragma("unroll") for (int ks = 0; ks < 8; ++ks) acc = MFMA32(frag_tr<false>(Vt, VP, 16 * ks, 0, lane), frag_tr<false>(Kt, TP, 16 * ks, 32 * w, lane), acc); \
        } } while (0)
    RS_FETCH(0, pkA, pvA); RS_FETCH(1, pkB, pvB);
#pragma unroll 1
    for (int c = 0; c < 18; c += 2) { RS_STEP(c, pkA, pvA); RS_STEP(c + 1, pkB, pvB); }
#undef RS_FETCH
#undef RS_STEP
    LB();
}
__device__ __forceinline__ void ret_out_unit(Frame& F, int layer, int unit) {
    const int jF = unit % 18, hh = (unit / 18) & 7, b = unit / 144;
    const bf16* P = wsp<bf16>(F, WS_P);
    const int row0 = ret_chunk_row0(b, jF);
    LAS unsigned char* Qt = F.lds; LAS unsigned char* Kt = F.lds + TILE_B; LAS unsigned char* Vt = F.lds + 2 * TILE_B;
    const int lane = F.lane, h = lane >> 5, wi = F.wave & 3, wh = F.wave >> 2;
    const float lgf = __builtin_amdgcn_logf(sigm(inp(F, I_RETDEC)[(layer * 2 + 0) * 8 + hh])), lgb = __builtin_amdgcn_logf(sigm(inp(F, I_RETDEC)[(layer * 2 + 1) * 8 + hh]));
    LB();
    u32x4 tq[3][4];
    tile3_fetch(tq, P + (size_t)row0 * LDP + C_RET + hh * 128, P + (size_t)row0 * LDP + C_RET + 1024 + hh * 128, P + (size_t)row0 * LDP + C_RET + 2048 + hh * 128, LDP, F.tid);
    u32x4 psf[4], psb[4];
    { const bf16* Sf = wsp<bf16>(F, WS_ST) + ((size_t)((b * 8 + hh) * 2 + 0) * 18 + jF) * ST_CHUNK; const bf16* Sb = wsp<bf16>(F, WS_ST) + ((size_t)((b * 8 + hh) * 2 + 1) * 18 + jF) * ST_CHUNK;
#pragma unroll
      for (int it = 0; it < 4; ++it) { const int idx = F.tid + NTHR * it, row = idx >> 4, ch = idx & 15; psf[it] = *(const u32x4*)(Sf + (size_t)row * 128 + ch * 8); psb[it] = *(const u32x4*)(Sb + (size_t)row * 128 + ch * 8); } }
    asm volatile("" ::: "memory");
    tile3_store(tq, Qt, Kt, Vt, F.tid);
    LB();
    f32x16 Y0 = zero16(), Y1 = zero16();
    const int iq = 32 * wi + (lane & 31);
    for (int jb = 0; jb < 4; ++jb) {
        f32x16 X = zero16();
#pragma unroll
        for (int ks = 0; ks < 8; ++ks) X = MFMA32(frag_rm(Kt, TP, 32 * jb, 16 * ks, lane), frag_rm(Qt, TP, 32 * wi, 16 * ks, lane), X);
        int iql = iq - 32 * jb; asm volatile("" : "+v"(iql));
#pragma unroll
        for (int r = 0; r < 16; ++r) { const int d = iql - crow(r, h); const int ad = d < 0 ? -d : d;
            const float wgt = __builtin_amdgcn_exp2f((d > 0 ? lgf : lgb) * (float)ad) * (d == 0 ? 2.0f : 1.0f);
            X[r] *= wgt * 0.08838834764831845f; }
        const bf16x8 pa0 = pack_step(X, 0), pa1 = pack_step(X, 1);
        Y0 = MFMA32(pa0, frag_tr<true>(Vt, TP, 32 * jb, 64 * wh, lane), Y0);
        Y0 = MFMA32(pa1, frag_tr<true>(Vt, TP, 32 * jb + 16, 64 * wh, lane), Y0);
        Y1 = MFMA32(pa0, frag_tr<true>(Vt, TP, 32 * jb, 64 * wh + 32, lane), Y1);
        Y1 = MFMA32(pa1, frag_tr<true>(Vt, TP, 32 * jb + 16, 64 * wh + 32, lane), Y1);
    }
    LB();
#pragma unroll
    for (int it = 0; it < 4; ++it) { const int idx = F.tid + NTHR * it, row = idx >> 4, ch = idx & 15; *(LAS u32x4*)(Kt + row * TP + ch * 16) = psf[it]; *(LAS u32x4*)(Vt + row * TP + ch * 16) = psb[it]; }
    LB();
    {
        f32x16 T0 = zero16(), T1 = zero16(), U0 = zero16(), U1 = zero16();
#pragma unroll
        for (int ks = 0; ks < 8; ++ks) { const bf16x8 a = frag_rm(Qt, TP, 32 * wi, 16 * ks, lane);
            T0 = MFMA32(a, frag_rm(Kt, TP, 64 * wh, 16 * ks, lane), T0); T1 = MFMA32(a, frag_rm(Kt, TP, 64 * wh + 32, 16 * ks, lane), T1);
            U0 = MFMA32(a, frag_rm(Vt, TP, 64 * wh, 16 * ks, lane), U0); U1 = MFMA32(a, frag_rm(Vt, TP, 64 * wh + 32, 16 * ks, lane), U1); }
#pragma unroll
        for (int r = 0; r < 16; ++r) { const int i = 32 * wi + crow(r, h);
            const float ff = __builtin_amdgcn_exp2f(lgf * (float)(i + 1)), fb = __builtin_amdgcn_exp2f(lgb * (float)(128 - i));
            Y0[r] += ff * T0[r] + fb * U0[r]; Y1[r] += ff * T1[r] + fb * U1[r]; }
    }
    LB();
    LAS float* yl = (LAS float*)F.lds;
#pragma unroll
    for (int r = 0; r < 16; ++r) { const int i = 32 * wi + crow(r, h); yl[i * 132 + 64 * wh + (lane & 31)] = Y0[r]; yl[i * 132 + 64 * wh + 32 + (lane & 31)] = Y1[r]; }
    LB();
    { const int i = F.tid >> 2, part = F.tid & 3; const LAS float* yr = yl + i * 132 + 32 * part;
      f32x4 v[8]; float s = 0.f;
#pragma unroll
      for (int e = 0; e < 8; ++e) { v[e] = *(const LAS f32x4*)(yr + 4 * e); s += (v[e].x + v[e].y) + (v[e].z + v[e].w); }
      s += shx(s, 1, lane); s += shx(s, 2, lane); const float mean = s * (1.0f / 128.0f); float q = 0.f;
#pragma unroll
      for (int e = 0; e < 8; ++e) { v[e] = v[e] - mean; q += (v[e].x * v[e].x + v[e].y * v[e].y) + (v[e].z * v[e].z + v[e].w * v[e].w); }
      q += shx(q, 1, lane); q += shx(q, 2, lane); const float rs = __builtin_amdgcn_rsqf(q * (1.0f / 128.0f) + 1e-5f);
      const bf16* gp = P + (size_t)(row0 + i) * LDP + C_RET + 3072 + hh * 128 + 32 * part; bf16* yo = wsp<bf16>(F, WS_Y) + (size_t)(row0 + i) * 3072 + hh * 128 + 32 * part;
#pragma unroll
      for (int e2 = 0; e2 < 4; ++e2) { const u32x4 gw = *(const u32x4*)(gp + 8 * e2); u32x4 ow;
#pragma unroll
          for (int e = 0; e < 4; ++e) { const float g0 = bf_lo(gw[e]), g1 = bf_hi(gw[e]); const int vi = 2 * e2 + (e >> 1), vo = 2 * (e & 1);
              ow[e] = cvtpk(g0 * sigm(g0) * v[vi][vo] * rs, g1 * sigm(g1) * v[vi][vo + 1] * rs); }
          *(u32x4*)(yo + 8 * e2) = ow; } }
}

#ifdef RW_DEBUG
constexpr size_t WS_DBGY = WS_END2;
struct RwPre { f32x4 r4, k4, v4, lw, la; };
__device__ __forceinline__ void rwkv_scan_unit(Frame& F, int layer, int unit) {
    const int rh = unit & 1, dir = (unit >> 1) & 1, h = (unit >> 2) & 15, b = unit >> 6;
    constexpr int BUF = 6 * 2048 + 1024;
    LAS float* const base = (LAS float*)F.lds;
    const float* XS = wsp<float>(F, WS_XS); const float* LR = wsp<float>(F, WS_LR); float* YD = wsp<float>(F, WS_DBGY) + (size_t)dir * MT * BW;
    const int vrow = F.tid >> 4, kq = F.tid & 15;
    const int ptok = F.tid >> 4, pj = (F.tid & 15) * 4, pc = h * 64 + pj;
    const f32x4 w0v = *(const f32x4*)(inp(F, I_W0) + ((size_t)layer * 2 + dir) * BW + pc), a0v = *(const f32x4*)(inp(F, I_A0) + ((size_t)layer * 2 + dir) * BW + pc);
    const f32x4 kkv = *(const f32x4*)(inp(F, I_KK) + (size_t)layer * BW + pc), kav = *(const f32x4*)(inp(F, I_KA) + (size_t)layer * BW + pc);
    auto fetch = [&](int blk, RwPre& p) {
        const int row = scan_row(b, dir, blk * SCAN_BLK + ptok);
        p.r4 = *(const f32x4*)(XS + (size_t)row * 3072 + pc); p.k4 = *(const f32x4*)(XS + (size_t)row * 3072 + 1024 + pc); p.v4 = *(const f32x4*)(XS + (size_t)row * 3072 + 2048 + pc);
        p.lw = *(const f32x4*)(LR + (size_t)row * NLR + dir * 1024 + pc); p.la = *(const f32x4*)(LR + (size_t)row * NLR + 2048 + dir * 1024 + pc);
    };
    auto derive = [&](const RwPre& p, LAS float* buf) {
        f32x4 dec, av, kk, kd; float ssq = 0.f;
#pragma unroll
        for (int e = 0; e < 4; ++e) { dec[e] = fexp(-0.6065306597126334f * sigm(w0v[e] + p.lw[e])); av[e] = sigm(a0v[e] + p.la[e]); kk[e] = p.k4[e] * kkv[e]; ssq += kk[e] * kk[e];
            kd[e] = p.k4[e] * (1.0f + (av[e] - 1.0f) * kav[e]); }
        ssq += __int_as_float(__builtin_amdgcn_update_dpp(0, __float_as_int(ssq), 0xB1, 0xF, 0xF, true));
        ssq += __int_as_float(__builtin_amdgcn_update_dpp(0, __float_as_int(ssq), 0x4E, 0xF, 0xF, true));
        ssq += __int_as_float(__builtin_amdgcn_update_dpp(0, __float_as_int(ssq), 0x141, 0xF, 0xF, true));
        ssq += __int_as_float(__builtin_amdgcn_update_dpp(0, __float_as_int(ssq), 0x140, 0xF, 0xF, true));
        const float inv = __builtin_amdgcn_rsqf(fmaxf(ssq, 1e-24f));
        f32x4 an, bn;
#pragma unroll
        for (int e = 0; e < 4; ++e) { const float kn = kk[e] * inv; an[e] = -kn; bn[e] = kn * av[e]; }
        const int o = ptok * 64 + pj;
        *(LAS f32x4*)(buf + o) = p.r4; *(LAS f32x4*)(buf + 2048 + o) = dec; *(LAS f32x4*)(buf + 4096 + o) = kd; *(LAS f32x4*)(buf + 6144 + o) = p.v4; *(LAS f32x4*)(buf + 8192 + o) = an; *(LAS f32x4*)(buf + 10240 + o) = bn;
    };
    f32x2 S0 = {0.f, 0.f}, S1 = S0;
    RwPre pre;
    __syncthreads();
    fetch(0, pre); derive(pre, base);
    __syncthreads();
    constexpr int NBLK = NSTEP / SCAN_BLK;
    for (int blk = 0; blk < NBLK; ++blk) {
        LAS float* cur = base + (blk & 1) * BUF; LAS float* nxt = base + ((blk + 1) & 1) * BUF;
        if (blk + 1 < NBLK) fetch(blk + 1, pre);
        const LAS float* Rl = cur; const LAS float* Wl = cur + 2048; const LAS float* Kl = cur + 4096; const LAS float* Vl = cur + 6144; const LAS float* Al = cur + 8192; const LAS float* Bl = cur + 10240; LAS float* Yl = cur + 12288;
        const int ob = 4 * kq, vb = 32 * rh + vrow;
        f32x4 a0 = *(const LAS f32x4*)(Al + ob), w0 = *(const LAS f32x4*)(Wl + ob), b0 = *(const LAS f32x4*)(Bl + ob), k0 = *(const LAS f32x4*)(Kl + ob), r0 = *(const LAS f32x4*)(Rl + ob);
        float vv = Vl[vb];
#pragma unroll 8
        for (int tok = 0; tok < SCAN_BLK; ++tok) {
            const int on = ((tok + 1) & (SCAN_BLK - 1)) * 64;
            const f32x4 a1 = *(const LAS f32x4*)(Al + on + ob), w1 = *(const LAS f32x4*)(Wl + on + ob), b1 = *(const LAS f32x4*)(Bl + on + ob), k1 = *(const LAS f32x4*)(Kl + on + ob), r1 = *(const LAS f32x4*)(Rl + on + ob);
            const float vn = Vl[on + vb];
            f32x2 t = S0 * a0.xy; t += S1 * a0.zw;
            const float sa = red16(t.x + t.y);
            const f32x2 sa2 = {sa, sa}, vv2 = {vv, vv};
            S0 = S0 * w0.xy + (sa2 * b0.xy + vv2 * k0.xy); S1 = S1 * w0.zw + (sa2 * b0.zw + vv2 * k0.zw);
            f32x2 u = S0 * r0.xy; u += S1 * r0.zw;
            const float y = red16(u.x + u.y);
            Yl[tok * 32 + vrow] = y;
            a0 = a1; w0 = w1; b0 = b1; k0 = k1; r0 = r1; vv = vn;
        }
        if (blk + 1 < NBLK) derive(pre, nxt);
        __syncthreads();
        if (F.tid < 256) { const int e = F.tid * 4, tok = e >> 5, j = e & 31; const int row = scan_row(b, dir, blk * SCAN_BLK + tok);
          *(f32x4*)(YD + (size_t)row * BW + h * 64 + 32 * rh + j) = *(const LAS f32x4*)(Yl + e); }
    }
    __syncthreads();
}
#endif
__device__ __forceinline__ const float* vecp(const Frame& F, int layer, int v) { return wsp<float>(F, WS_VEC) + ((size_t)layer * 8 + v) * 1024; }
constexpr int RW_NCH = 36, RW_NU = NB * 16 * 2 * RW_NCH;
constexpr int RWP = 144;
constexpr int RWS = 64 * RWP;
__device__ __forceinline__ int rw_row0(int b, int jF) { return jF < 4 ? ML + b * TCX + 64 * jF : b * TL + 64 * (jF - 4); }
enum { RM = 0, TR = 1 };
template <int AM, int BM_> __device__ __forceinline__ f32x16 mm64(const LAS unsigned char* A, const LAS unsigned char* B, int tb, int sb, int lane, f32x16 acc) {
#pragma unroll
    for (int ks = 0; ks < 4; ++ks) {
        const bf16x8 a = AM == RM ? frag_rm(A, RWP, 32 * tb, 16 * ks, lane) : frag_tr<false>(A, RWP, 16 * ks, 32 * tb, lane);
        const bf16x8 b = BM_ == RM ? frag_rm(B, RWP, 32 * sb, 16 * ks, lane) : frag_tr<false>(B, RWP, 16 * ks, 32 * sb, lane);
        acc = MFMA32(a, b, acc); }
    return acc;
}
__device__ __forceinline__ void store_tile_bf16(LAS unsigned char* T, const f32x16& x, int tb, int sb, int lane) {
    const int h = lane >> 5; LAS unsigned short* p = (LAS unsigned short*)(T + (32 * tb) * RWP) + 32 * sb + (lane & 31);
#pragma unroll
    for (int r = 0; r < 16; ++r) p[crow(r, h) * (RWP / 2)] = (unsigned short)(cvtpk(x[r], 0.f) & 0xffffu);
}
__device__ __forceinline__ bf16x8 gfrag_perm(const bf16* X, int ld, int m0, int k0, int lane) {
    const bf16* p = X + (size_t)(m0 + (lane & 31)) * ld + k0 + 4 * (lane >> 5);
    const u32x2 lo = *(const u32x2*)p, hi = *(const u32x2*)(p + 8);
    u32x4 w; w.x = lo.x; w.y = lo.y; w.z = hi.x; w.w = hi.y; return __builtin_bit_cast(bf16x8, w);
}
template <bool REV> __device__ __forceinline__ void tri_inv16(const LAS float* AD, LAS unsigned char* T, int lane_) {
    int lane = lane_; asm volatile("" : "+v"(lane));
    const int blk = lane >> 4, j = lane & 15; const LAS float* A = AD + blk * 16 * 20;
    float x[16];
#pragma unroll
    for (int i = 0; i < 16; ++i) { const int t = REV ? 15 - i : i; float a0 = (j == t) ? 1.0f : 0.0f, a1 = 0.0f;
#pragma unroll
        for (int s4 = 0; s4 < 16; s4 += 4) { if (REV ? (s4 + 3 > t) : (s4 < t)) { const f32x4 a = *(const LAS f32x4*)(A + t * 20 + s4);
#pragma unroll
                for (int e = 0; e < 4; ++e) { const int s = s4 + e; if (REV ? (s > t) : (s < t)) { if (e & 1) a1 = fmaf(a[e], x[s], a1); else a0 = fmaf(a[e], x[s], a0); } } } }
        x[t] = a0 + a1; asm volatile("" ::: "memory"); }
    LAS unsigned short* tp = (LAS unsigned short*)T + (16 * blk) * (RWP / 2) + 16 * blk + j;
#pragma unroll
    for (int s = 0; s < 16; ++s) tp[s * (RWP / 2)] = (unsigned short)(cvtpk(x[s], 0.f) & 0xffffu);
}
struct RwIn { u32x4 x[3]; u32x4 l[2]; float vn; };
__device__ __forceinline__ void rw_fetch_x(Frame& F, int unit, int tid, RwIn& p) {
    const int jF = unit % RW_NCH, hh = (unit / RW_NCH) & 15, b = unit / (RW_NCH * 16);
    const bf16* xr = wsp<bf16>(F, WS_XS) + (size_t)(rw_row0(b, jF) + (tid >> 3)) * 3072 + hh * 64 + (tid & 7) * 8;
    p.x[0] = *(const u32x4*)xr; p.x[1] = *(const u32x4*)(xr + 1024); p.x[2] = *(const u32x4*)(xr + 2048);
}
__device__ __forceinline__ void rw_fetch_l(Frame& F, int unit, int dir, int tid, RwIn& p) {
    const int jF = unit % RW_NCH, hh = (unit / RW_NCH) & 15, b = unit / (RW_NCH * 16);
    const bf16* lr = wsp<bf16>(F, WS_LR) + (size_t)(rw_row0(b, jF) + (tid >> 3)) * NLR + dir * 1024 + hh * 64 + (tid & 7) * 8;
    p.l[0] = *(const u32x4*)lr; p.l[1] = *(const u32x4*)(lr + 2048);
}
__device__ __forceinline__ void rw_fetch_v(Frame& F, int layer, int unit, int tid, RwIn& p) {
    const int hh = (unit / RW_NCH) & 15; const int v = tid >> 6; p.vn = vecp(F, layer, v < 6 ? v : 5)[hh * 64 + (tid & 63)];
}
__device__ __forceinline__ void rw_local_unit(Frame& F, int layer, int unit, int unit_next, RwIn& in) {
    const int jF = unit % RW_NCH, hh = (unit / RW_NCH) & 15, b = unit / (RW_NCH * 16);
    const int row0 = rw_row0(b, jF);
    LAS unsigned char* const L = F.lds;
    LAS unsigned char* sAh = L; LAS unsigned char* sRh = L + RWS; LAS unsigned char* sBh = L + 2 * RWS; LAS unsigned char* sKh = L + 3 * RWS; LAS unsigned char* sBt = L + 4 * RWS; LAS unsigned char* sKt = L + 5 * RWS;
    LAS unsigned char* sV = L + 6 * RWS; LAS unsigned char* sAAK = L + 7 * RWS; LAS unsigned char* sARB = L + 8 * RWS; LAS unsigned char* sARK = L + 9 * RWS; LAS unsigned char* sPm = L + 10 * RWS; LAS unsigned char* sTm = L + 11 * RWS;
    LAS unsigned char* sM1 = sAAK; LAS unsigned char* sVT = sKh; LAS unsigned char* sWW = sPm;
    LAS unsigned char* sTm2 = L + 12 * RWS;
    LAS float* VLh = (LAS float*)(L + 13 * RWS + 9216);
    LAS float* CL = (LAS float*)(L + 13 * RWS);
    const int w = F.wave, grp = w >> 2, tb = (w >> 1) & 1, sb = w & 1;
    float r8[8], k8[8], kn8[8];
    { int tl_ = F.tid; asm volatile("" : "+v"(tl_)); const int t = tl_ >> 3, j0 = (tl_ & 7) * 8;
      if (tl_ < 384) VLh[tl_] = in.vn;
      LB();
      const u32x4 rw_ = in.x[0], kw_ = in.x[1]; f32x4 ra, rb, ka, kb;
#pragma unroll
      for (int e = 0; e < 2; ++e) { ra[2 * e] = bf_lo(rw_[e]); ra[2 * e + 1] = bf_hi(rw_[e]); rb[2 * e] = bf_lo(rw_[2 + e]); rb[2 * e + 1] = bf_hi(rw_[2 + e]); ka[2 * e] = bf_lo(kw_[e]); ka[2 * e + 1] = bf_hi(kw_[e]); kb[2 * e] = bf_lo(kw_[2 + e]); kb[2 * e + 1] = bf_hi(kw_[2 + e]); }
      const f32x4 kka = *(const LAS f32x4*)(VLh + 4 * 64 + j0), kkb = *(const LAS f32x4*)(VLh + 4 * 64 + j0 + 4);
      float ssq = 0.f;
#pragma unroll
      for (int e = 0; e < 4; ++e) { r8[e] = ra[e]; r8[4 + e] = rb[e]; k8[e] = ka[e]; k8[4 + e] = kb[e]; kn8[e] = ka[e] * kka[e]; kn8[4 + e] = kb[e] * kkb[e]; }
#pragma unroll
      for (int e = 0; e < 8; ++e) ssq += kn8[e] * kn8[e];
      ssq = red8(ssq); const float inv = __builtin_amdgcn_rsqf(fmaxf(ssq, 1e-24f));
#pragma unroll
      for (int e = 0; e < 8; ++e) kn8[e] *= inv;
      *(LAS u32x4*)(sV + t * RWP + j0 * 2) = in.x[2]; }
    for (int dir = 0; dir < 2; ++dir) {
        const int ui = ((b * 16 + hh) * 2 + dir) * RW_NCH + jF;
        int tl_ = F.tid; asm volatile("" : "+v"(tl_)); const int t = tl_ >> 3, j0 = (tl_ & 7) * 8, c0 = hh * 64 + j0;
        float lw8[8], as8[8];
        { f32x4 wa, wb, aa, ab; { const u32x4 lw_ = in.l[0], la_ = in.l[1];
#pragma unroll
            for (int e = 0; e < 2; ++e) { wa[2 * e] = bf_lo(lw_[e]); wa[2 * e + 1] = bf_hi(lw_[e]); wb[2 * e] = bf_lo(lw_[2 + e]); wb[2 * e + 1] = bf_hi(lw_[2 + e]); aa[2 * e] = bf_lo(la_[e]); aa[2 * e + 1] = bf_hi(la_[e]); ab[2 * e] = bf_lo(la_[2 + e]); ab[2 * e + 1] = bf_hi(la_[2 + e]); } }
          const LAS float* w0p = VLh + dir * 64 + j0; const LAS float* a0p = VLh + (2 + dir) * 64 + j0;
          const f32x4 w0a = *(const LAS f32x4*)w0p, w0b = *(const LAS f32x4*)(w0p + 4), a0a = *(const LAS f32x4*)a0p, a0b = *(const LAS f32x4*)(a0p + 4);
#pragma unroll
          for (int e = 0; e < 4; ++e) { lw8[e] = -0.6065306597126334f * sigm(w0a[e] + wa[e]); lw8[4 + e] = -0.6065306597126334f * sigm(w0b[e] + wb[e]); as8[e] = sigm(a0a[e] + aa[e]); as8[4 + e] = sigm(a0b[e] + ab[e]); } }
        float cl8[8], ce8[8];
        { const int ln = F.lane;
#pragma unroll
          for (int e = 0; e < 8; ++e) cl8[e] = lw8[e];
#pragma unroll
          for (int d = 8; d < 64; d <<= 1) { const int src = dir ? ln + d : ln - d; const float msk = (src >= 0 && src < 64) ? 1.0f : 0.0f;
#pragma unroll
              for (int e = 0; e < 8; ++e) cl8[e] = fmaf(lanefrom(cl8[e], src), msk, cl8[e]); }
          LAS float* WT = CL;
          if ((ln >> 3) == (dir ? 0 : 7)) { *(LAS f32x4*)(WT + w * 64 + j0) = (f32x4){cl8[0], cl8[1], cl8[2], cl8[3]}; *(LAS f32x4*)(WT + w * 64 + j0 + 4) = (f32x4){cl8[4], cl8[5], cl8[6], cl8[7]}; }
          LB();
#pragma unroll
          for (int e = 0; e < 8; ++e) ce8[e] = 0.f;
#pragma unroll
          for (int ww = 0; ww < 8; ++ww) { const f32x4 a = *(const LAS f32x4*)(WT + ww * 64 + j0), b2 = *(const LAS f32x4*)(WT + ww * 64 + j0 + 4); const float bm = (dir ? ww > w : ww < w) ? 1.0f : 0.0f;
#pragma unroll
              for (int e = 0; e < 4; ++e) { ce8[e] += a[e]; ce8[4 + e] += b2[e]; cl8[e] = fmaf(a[e], bm, cl8[e]); cl8[4 + e] = fmaf(b2[e], bm, cl8[4 + e]); } }
        }
        { const LAS float* kap = VLh + 5 * 64 + j0; const f32x4 kaa = *(const LAS f32x4*)kap, kab = *(const LAS f32x4*)(kap + 4);
          float oA[8], oR[8], oB[8], oK[8], oBt[8], oKt[8];
#pragma unroll
          for (int e = 0; e < 8; ++e) { const float cl = cl8[e], ce = ce8[e], kav = e < 4 ? kaa[e] : kab[e - 4];
              const float ex = fexp(cl), exm = fexp(-cl), exx = fexp(cl - lw8[e]), ext = fexp(ce - cl);
              const float kd = k8[e] * (1.0f + (as8[e] - 1.0f) * kav), bb = kn8[e] * as8[e];
              oA[e] = -kn8[e] * exx; oR[e] = r8[e] * ex; oB[e] = bb * exm; oK[e] = kd * exm; oBt[e] = bb * ext; oKt[e] = kd * ext; }
          const int o = t * RWP + j0 * 2;
#define RW_ST8(slot, a) do { u32x4 q_; q_.x = cvtpk(a[0], a[1]); q_.y = cvtpk(a[2], a[3]); q_.z = cvtpk(a[4], a[5]); q_.w = cvtpk(a[6], a[7]); *(LAS u32x4*)((slot) + o) = q_; } while (0)
          RW_ST8(sAh, oA); RW_ST8(sRh, oR); RW_ST8(sBh, oB); RW_ST8(sKh, oK); RW_ST8(sBt, oBt); RW_ST8(sKt, oKt);
#undef RW_ST8
        }
        if (t == 0) { float* gm = wsp<float>(F, WS_RWG) + (size_t)ui * 64 + j0;
            *(f32x4*)gm = (f32x4){fexp(ce8[0]), fexp(ce8[1]), fexp(ce8[2]), fexp(ce8[3])}; *(f32x4*)(gm + 4) = (f32x4){fexp(ce8[4]), fexp(ce8[5]), fexp(ce8[6]), fexp(ce8[7])}; }
        { const int un = unit_next >= 0 ? unit_next : unit; rw_fetch_x(F, un, tl_, in); rw_fetch_v(F, layer, un, tl_, in); rw_fetch_l(F, dir == 0 ? unit : un, dir == 0 ? 1 : 0, tl_, in); }
        LB();
#if defined(TS_DEBUG) && TS_SEL == 0
#endif
        int lane = F.lane; asm volatile("" : "+v"(lane)); const int h = lane >> 5;
        const int tq = 32 * tb + 4 * h, sq = 32 * sb + (lane & 31);
        LAS float* AD16 = CL + 1024;
        const int pB = dir ? 0 : 1, qB = 1 - pB;
        if (grp == 0) {
            f32x16 X1 = mm64<RM, RM>(sAh, sBh, tb, sb, lane, zero16()), X2 = mm64<RM, RM>(sAh, sKh, tb, sb, lane, zero16());
#pragma unroll
            for (int r = 0; r < 16; ++r) { const int d = (tq + (r & 3) + 8 * (r >> 2)) - sq; const bool keep = (dir ? -d : d) > 0; X1[r] = keep ? X1[r] : 0.f; X2[r] = keep ? X2[r] : 0.f; }
            store_tile_bf16(sAAK, X2, tb, sb, lane);
            { f32x16 AF; const int sl = lane & 31;
#pragma unroll
              for (int r = 0; r < 16; ++r) { const int tl = (r & 3) + 8 * (r >> 2) + 4 * h; const bool same16 = tb == sb && (tl >> 4) == (sl >> 4);
                  AF[r] = same16 ? 0.f : X1[r];
                  if (same16) AD16[((2 * tb + (tl >> 4)) * 16 + (tl & 15)) * 20 + (sl & 15)] = X1[r]; }
              store_tile_bf16(sPm, AF, tb, sb, lane); store_tile_bf16(sTm, zero16(), tb, sb, lane); }
            LB();
            if (w == 0) { if (dir == 0) tri_inv16<false>(AD16, sTm, lane); else tri_inv16<true>(AD16, sTm, lane); }
            LB();
            { f32x16 Mx = (tb == pB && sb == qB) ? zero16() : mm64<RM, TR>(sPm, sTm, tb, sb, lane, zero16());
#pragma unroll
              for (int r = 0; r < 16; ++r) { const int d = (tq + (r & 3) + 8 * (r >> 2)) - sq; Mx[r] += d == 0 ? 1.0f : 0.f; }
              store_tile_bf16(sBh, Mx, tb, sb, lane); }
            LB();
            { const f32x16 Tn = mm64<RM, TR>(sTm, sBh, tb, sb, lane, zero16()); store_tile_bf16(sTm2, Tn, tb, sb, lane); }
            LB();
            { f32x16 Mx = zero16();
              if (tb == pB && sb == qB) {
#pragma unroll
                  for (int ks = 0; ks < 2; ++ks) Mx = MFMA32(frag_rm(sPm, RWP, 32 * pB, 32 * qB + 16 * ks, lane), frag_tr<false>(sTm2, RWP, 32 * qB + 16 * ks, 32 * qB, lane), Mx); }
#pragma unroll
              for (int r = 0; r < 16; ++r) { const int d = (tq + (r & 3) + 8 * (r >> 2)) - sq; Mx[r] += d == 0 ? 1.0f : 0.f; }
              store_tile_bf16(sBh, Mx, tb, sb, lane); }
            LB();
            { const f32x16 Tn = mm64<RM, TR>(sTm2, sBh, tb, sb, lane, zero16()); store_tile_bf16(sTm, Tn, tb, sb, lane); }
            LB();
            { const f32x16 Wt = mm64<RM, TR>(sTm, sAh, tb, sb, lane, zero16()); store_tile_bf16(sWW, Wt, tb, sb, lane); }
            LB();
            asm volatile("" : "+v"(in.x[0]), "+v"(in.x[1]), "+v"(in.x[2]), "+v"(in.l[0]), "+v"(in.l[1]), "+v"(in.vn));
            { f32x16 QtT = mm64<TR, RM>(sWW, sARB, tb, sb, lane, zero16());
#pragma unroll
              for (int r = 0; r < 16; ++r) QtT[r] += bf2f(((const LAS unsigned short*)(sRh + sq * RWP))[32 * tb + crow(r, h)]);
              int l4 = lane; asm volatile("" : "+v"(l4));
              u32x4* qo = (u32x4*)(wsp<bf16>(F, WS_RWQ) + (size_t)ui * 4096) + ((sb * 2 + tb) * 2) * 64 + l4;
              qo[0] = __builtin_bit_cast(u32x4, pack_step(QtT, 0)); qo[64] = __builtin_bit_cast(u32x4, pack_step(QtT, 1));
              const f32x16 PpT = mm64<TR, TR>(sWW, sBt, tb, sb, lane, zero16());
              u32x4* po = (u32x4*)(wsp<bf16>(F, WS_RWP) + (size_t)ui * 4096) + ((sb * 2 + tb) * 2) * 64 + l4;
              po[0] = __builtin_bit_cast(u32x4, pack_step(PpT, 0)); po[64] = __builtin_bit_cast(u32x4, pack_step(PpT, 1)); }
            LB();
#if defined(TS_DEBUG) && TS_SEL == 1
#endif
        } else {
            f32x16 X1 = mm64<RM, RM>(sRh, sBh, tb, sb, lane, zero16()), X2 = mm64<RM, RM>(sRh, sKh, tb, sb, lane, zero16());
#pragma unroll
            for (int r = 0; r < 16; ++r) { const int d = (tq + (r & 3) + 8 * (r >> 2)) - sq; const bool keep = (dir ? -d : d) >= 0; X1[r] = keep ? X1[r] : 0.f; X2[r] = keep ? X2[r] : 0.f; }
            store_tile_bf16(sARB, X1, tb, sb, lane); store_tile_bf16(sARK, X2, tb, sb, lane);
            LB();
            X1 = mm64<RM, TR>(sAAK, sV, tb, sb, lane, zero16());
            f32x16 accY = mm64<RM, TR>(sARK, sV, tb, sb, lane, zero16()), accH = mm64<TR, TR>(sKt, sV, tb, sb, lane, zero16());
            LB();
            store_tile_bf16(sM1, X1, tb, sb, lane);
#pragma unroll 1
            for (int i = 0; i < 4; ++i) LB();
            { const f32x16 Vx = mm64<RM, TR>(sTm, sM1, tb, sb, lane, zero16()); store_tile_bf16(sVT, Vx, tb, sb, lane); }
            LB();
            asm volatile("" : "+v"(in.x[0]), "+v"(in.x[1]), "+v"(in.x[2]), "+v"(in.l[0]), "+v"(in.l[1]), "+v"(in.vn));
            accY = mm64<RM, TR>(sARB, sVT, tb, sb, lane, accY); accH = mm64<TR, TR>(sBt, sVT, tb, sb, lane, accH);
            int l4 = lane; asm volatile("" : "+v"(l4));
            u32x4* yo = (u32x4*)(wsp<bf16>(F, WS_RWY) + (size_t)ui * 4096 + (tb * 2 + sb) * 1024 + l4 * 16);
            u32x4* ho = (u32x4*)(wsp<bf16>(F, WS_RWH) + (size_t)ui * 4096 + (tb * 2 + sb) * 1024 + l4 * 16);
#pragma unroll
            for (int g = 0; g < 2; ++g) { u32x4 a, b2;
#pragma unroll
                for (int e = 0; e < 4; ++e) { a[e] = cvtpk(accY[8 * g + 2 * e], accY[8 * g + 2 * e + 1]); b2[e] = cvtpk(accH[8 * g + 2 * e], accH[8 * g + 2 * e + 1]); }
                yo[g] = a; ho[g] = b2; }
            LB();
        }
    }
}
constexpr int RWQ_SLOT = 13 * 1024, RWQ_WAVE = 3 * RWQ_SLOT;
__device__ __forceinline__ void rw_seq_task(Frame& F, int task, int lane, LAS unsigned char* ring) {
    const int vb = task & 1, dir = (task >> 1) & 1, bh = task >> 2, h = lane >> 5;
    auto issue = [&](int c) {
        const int jF = dir == 0 ? c : (c < 4 ? 3 - c : 39 - c); const size_t ui = (size_t)(bh * 2 + dir) * RW_NCH + jF;
        const char* pp = (const char*)(wsp<bf16>(F, WS_RWP) + ui * 4096) + lane * 16; const char* hp = (const char*)(wsp<bf16>(F, WS_RWH) + ui * 4096) + lane * 16; const char* gp = (const char*)(wsp<float>(F, WS_RWG) + ui * 64) + lane * 16;
        LAS unsigned char* sl = ring + (c % 3) * RWQ_SLOT;
#pragma unroll
        for (int i = 0; i < 8; ++i) __builtin_amdgcn_global_load_lds((const unsigned*)(pp + i * 1024), (LAS unsigned*)(sl + i * 1024), 16, 0, 0);
#pragma unroll
        for (int ko = 0; ko < 2; ++ko)
#pragma unroll
            for (int i = 0; i < 2; ++i) __builtin_amdgcn_global_load_lds((const unsigned*)(hp + (ko * 2 + vb) * 2048 + i * 1024), (LAS unsigned*)(sl + 8192 + ko * 2048 + i * 1024), 16, 0, 0);
        __builtin_amdgcn_global_load_lds((const unsigned*)gp, (LAS unsigned*)(sl + 12288), 16, 0, 0);
    };
    f32x16 S0 = zero16(), S1 = zero16();
    issue(0); issue(1);
#pragma unroll 1
    for (int c = 0; c < RW_NCH; ++c) {
        asm volatile("s_waitcnt lgkmcnt(0)" ::: "memory");
        if (c + 2 < RW_NCH) { issue(c + 2); asm volatile("s_waitcnt vmcnt(26)" ::: "memory"); }
        else if (c + 1 < RW_NCH) asm volatile("s_waitcnt vmcnt(13)" ::: "memory");
        else asm volatile("s_waitcnt vmcnt(0)" ::: "memory");
        const LAS unsigned char* sl = ring + (c % 3) * RWQ_SLOT;
        const int jF = dir == 0 ? c : (c < 4 ? 3 - c : 39 - c); const size_t ui = (size_t)(bh * 2 + dir) * RW_NCH + jF;
        const bf16x8 b00 = pack_step(S0, 0), b01 = pack_step(S0, 1), b10 = pack_step(S1, 0), b11 = pack_step(S1, 1);
        f32x16 n0, n1;
#pragma unroll
        for (int g = 0; g < 4; ++g) {
            const u32x2 h0 = *(const LAS u32x2*)(sl + 8192 + lane * 32 + 8 * g), h1 = *(const LAS u32x2*)(sl + 8192 + 2048 + lane * 32 + 8 * g);
            const f32x4 g0 = *(const LAS f32x4*)(sl + 12288 + (8 * g + 4 * h) * 4), g1 = *(const LAS f32x4*)(sl + 12288 + (32 + 8 * g + 4 * h) * 4);
            n0[4 * g] = bf_lo(h0.x) + g0[0] * S0[4 * g]; n0[4 * g + 1] = bf_hi(h0.x) + g0[1] * S0[4 * g + 1]; n0[4 * g + 2] = bf_lo(h0.y) + g0[2] * S0[4 * g + 2]; n0[4 * g + 3] = bf_hi(h0.y) + g0[3] * S0[4 * g + 3];
            n1[4 * g] = bf_lo(h1.x) + g1[0] * S1[4 * g]; n1[4 * g + 1] = bf_hi(h1.x) + g1[1] * S1[4 * g + 1]; n1[4 * g + 2] = bf_lo(h1.y) + g1[2] * S1[4 * g + 2]; n1[4 * g + 3] = bf_hi(h1.y) + g1[3] * S1[4 * g + 3]; }
#define RWQ_PF(ko, ki, s) (*(const LAS bf16x8*)(sl + (((ko) * 2 + (ki)) * 2 + (s)) * 1024 + lane * 16))
        n0 = MFMA32(RWQ_PF(0, 0, 0), b00, n0); n1 = MFMA32(RWQ_PF(1, 0, 0), b00, n1);
        n0 = MFMA32(RWQ_PF(0, 0, 1), b01, n0); n1 = MFMA32(RWQ_PF(1, 0, 1), b01, n1);
        n0 = MFMA32(RWQ_PF(0, 1, 0), b10, n0); n1 = MFMA32(RWQ_PF(1, 1, 0), b10, n1);
        n0 = MFMA32(RWQ_PF(0, 1, 1), b11, n0); n1 = MFMA32(RWQ_PF(1, 1, 1), b11, n1);
#undef RWQ_PF
        u32x4* so = (u32x4*)(wsp<bf16>(F, WS_RWS) + ui * 4096) + lane;
        so[((0 * 2 + vb) * 2 + 0) * 64] = __builtin_bit_cast(u32x4, b00); so[((0 * 2 + vb) * 2 + 1) * 64] = __builtin_bit_cast(u32x4, b01);
        so[((1 * 2 + vb) * 2 + 0) * 64] = __builtin_bit_cast(u32x4, b10); so[((1 * 2 + vb) * 2 + 1) * 64] = __builtin_bit_cast(u32x4, b11);
        S0 = n0; S1 = n1;
    }
}
__device__ __forceinline__ f32x4 unpk4(const u32x4& w, int half) { return (f32x4){bf_lo(w[2 * half]), bf_hi(w[2 * half]), bf_lo(w[2 * half + 1]), bf_hi(w[2 * half + 1])}; }
struct RwOutA { u32x4 yl[2]; u32x4 qa[4], sb[4]; };
struct RwOutB { u32x4 px[3], pl[3]; };
__device__ __forceinline__ void rw_out_fetch_a(Frame& F, int unit, int w, int lane, RwOutA& p) {
    const int jF = unit % RW_NCH, hh = (unit / RW_NCH) & 15, b = unit / (RW_NCH * 16); const int dir = w >> 2, tb = (w >> 1) & 1, vb = w & 1;
    const size_t ui = (size_t)((b * 16 + hh) * 2 + dir) * RW_NCH + jF;
    const u32x4* yl = (const u32x4*)(wsp<bf16>(F, WS_RWY) + ui * 4096 + (tb * 2 + vb) * 1024 + lane * 16);
    const u32x4* qt = (const u32x4*)(wsp<bf16>(F, WS_RWQ) + ui * 4096) + lane; const u32x4* s0 = (const u32x4*)(wsp<bf16>(F, WS_RWS) + ui * 4096) + lane;
    p.yl[0] = yl[0]; p.yl[1] = yl[1];
#pragma unroll
    for (int kb = 0; kb < 2; ++kb)
#pragma unroll
        for (int s = 0; s < 2; ++s) { p.qa[kb * 2 + s] = qt[((tb * 2 + kb) * 2 + s) * 64]; p.sb[kb * 2 + s] = s0[((kb * 2 + vb) * 2 + s) * 64]; }
}
__device__ __forceinline__ void rw_out_fetch_b(Frame& F, int unit, int tid, RwOutB& p) {
    const int jF = unit % RW_NCH, hh = (unit / RW_NCH) & 15, b = unit / (RW_NCH * 16);
    const int row = rw_row0(b, jF) + (tid >> 3), c0 = hh * 64 + (tid & 7) * 8;
    const bf16* XS = wsp<bf16>(F, WS_XS) + (size_t)row * 3072 + c0; const bf16* LR = wsp<bf16>(F, WS_LR) + (size_t)row * NLR + c0;
    p.px[0] = *(const u32x4*)XS; p.px[1] = *(const u32x4*)(XS + 1024); p.px[2] = *(const u32x4*)(XS + 2048);
    p.pl[0] = *(const u32x4*)(LR + 2048); p.pl[1] = *(const u32x4*)(LR + 3072); p.pl[2] = *(const u32x4*)(LR + 4096);
}
__device__ __forceinline__ void rw_out_unit(Frame& F, int layer, int unit, int unit_next, RwOutA& a, const RwOutB& bc, RwOutB& bn, const LAS float* VL) {
    const int jF = unit % RW_NCH, hh = (unit / RW_NCH) & 15, b = unit / (RW_NCH * 16);
    const int row0 = rw_row0(b, jF);
    const int lane = F.lane, h = lane >> 5, w = F.wave, dir = w >> 2, tb = (w >> 1) & 1, vb = w & 1;
    LAS float* YS = (LAS float*)F.lds;
    {
        f32x16 acc;
#pragma unroll
        for (int g = 0; g < 2; ++g)
#pragma unroll
            for (int e = 0; e < 4; ++e) { acc[8 * g + 2 * e] = bf_lo(a.yl[g][e]); acc[8 * g + 2 * e + 1] = bf_hi(a.yl[g][e]); }
#pragma unroll
        for (int i = 0; i < 4; ++i) acc = MFMA32(__builtin_bit_cast(bf16x8, a.qa[i]), __builtin_bit_cast(bf16x8, a.sb[i]), acc);
        if (unit_next >= 0) { rw_out_fetch_a(F, unit_next, w, lane, a); int tl_ = F.tid; asm volatile("" : "+v"(tl_)); rw_out_fetch_b(F, unit_next, tl_, bn); }
        LB();
        LAS float* yd = YS + dir * 64 * 68 + (32 * tb) * 68 + 32 * vb + (lane & 31);
#pragma unroll
        for (int r = 0; r < 16; ++r) yd[crow(r, h) * 68] = acc[r];
    }
    LB();
    {
        int tl_ = F.tid; asm volatile("" : "+v"(tl_));
        const int t = tl_ >> 3, j0 = (tl_ & 7) * 8, c0 = hh * 64 + j0; const int row = row0 + t;
        float y[8], s = 0.f;
#pragma unroll
        for (int e = 0; e < 2; ++e) { const f32x4 ya = *(const LAS f32x4*)(YS + t * 68 + j0 + 4 * e), yb = *(const LAS f32x4*)(YS + 64 * 68 + t * 68 + j0 + 4 * e);
#pragma unroll
            for (int q = 0; q < 4; ++q) { y[4 * e + q] = ya[q] + yb[q]; s += y[4 * e + q]; } }
        const float mean = red8(s) * (1.0f / 64.0f); float q2 = 0.f;
#pragma unroll
        for (int e = 0; e < 8; ++e) { y[e] -= mean; q2 += y[e] * y[e]; }
        const float rs = __builtin_amdgcn_rsqf(red8(q2) * (1.0f / 64.0f) + 64e-5f);
        float dp = 0.f; float ov[8];
#pragma unroll
        for (int e = 0; e < 2; ++e) {
            const f32x4 r = unpk4(bc.px[0], e), k = unpk4(bc.px[1], e);
            const f32x4 ka = *(const LAS f32x4*)(VL + 2 * 1024 + c0 + 4 * e), rk = *(const LAS f32x4*)(VL + 3 * 1024 + c0 + 4 * e);
            const f32x4 a0p = *(const LAS f32x4*)(VL + c0 + 4 * e) + unpk4(bc.pl[0], e);
            const f32x4 a1p = *(const LAS f32x4*)(VL + 1024 + c0 + 4 * e) + unpk4(bc.pl[1], e);
#pragma unroll
            for (int q = 0; q < 4; ++q) dp += r[q] * (k[q] * (2.0f + (sigm(a0p[q]) + sigm(a1p[q]) - 2.0f) * ka[q])) * rk[q]; }
        const float dot = red8(dp);
#pragma unroll
        for (int e = 0; e < 2; ++e) { const f32x4 v = unpk4(bc.px[2], e), g = unpk4(bc.pl[2], e), lng = *(const LAS f32x4*)(VL + 4 * 1024 + c0 + 4 * e);
#pragma unroll
            for (int q = 0; q < 4; ++q) ov[4 * e + q] = (y[4 * e + q] * rs * lng[q] + dot * v[q]) * g[q]; }
        u32x4 o; o.x = cvtpk(ov[0], ov[1]); o.y = cvtpk(ov[2], ov[3]); o.z = cvtpk(ov[4], ov[5]); o.w = cvtpk(ov[6], ov[7]);
        *(u32x4*)(wsp<bf16>(F, WS_Y) + (size_t)row * 3072 + 2048 + c0) = o;
    }
}

constexpr int CW_FOLD = 28672;
__device__ __forceinline__ void branch_fold(Frame& F, int layer) {
    if (F.wg >= 96) return;
    volatile LAS int* qslot = (volatile LAS int*)(F.lds + LDSCTL_OFF);
    asm volatile("s_waitcnt vmcnt(0)" ::: "memory");
    __syncthreads();
    for (int q = F.wg; q < 96; q += F.G) { const int t = q & 31;
        if (F.tid == 0) {
            __builtin_amdgcn_fence(__ATOMIC_RELEASE, "agent");
            asm volatile("s_waitcnt vmcnt(0)" ::: "memory");
            const int old = (int)__hip_atomic_fetch_add(F.ctl + CW_FOLD + 64 * layer + t, 1u, __ATOMIC_RELAXED, __HIP_MEMORY_SCOPE_AGENT);
            if (old == 2) { __builtin_amdgcn_fence(__ATOMIC_ACQUIRE, "agent"); asm volatile("s_waitcnt vmcnt(0)" ::: "memory"); }
            qslot[0] = old;
        }
        __syncthreads();
        const int old = qslot[0];
        __syncthreads();
        if (old != 2) continue;
        const bf16* P = wsp<bf16>(F, WS_YDR); bf16* mg = wsp<bf16>(F, WS_MG) + (size_t)ML * DM;
        const int r0 = (t >> 3) * 256, c0 = (t & 7) * 256;
#pragma unroll 1
        for (int it = 0; it < 16; it += 4) {
            u32x4 p[4][3];
#pragma unroll
            for (int k = 0; k < 4; ++k) { const int idx = (it + k) * NTHR + F.tid; const size_t off = (size_t)(r0 + (idx >> 5)) * DM + c0 + (idx & 31) * 8;
#pragma unroll
                for (int b = 0; b < 3; ++b) p[k][b] = *(const u32x4*)(P + (size_t)b * MC * DM + off); }
#pragma unroll
            for (int k = 0; k < 4; ++k) { const int idx = (it + k) * NTHR + F.tid; const size_t off = (size_t)(r0 + (idx >> 5)) * DM + c0 + (idx & 31) * 8;
                u32x4 w;
                w.x = cvtpk(pg8::bf_lo(p[k][0].x) + pg8::bf_lo(p[k][1].x) + pg8::bf_lo(p[k][2].x), pg8::bf_hi(p[k][0].x) + pg8::bf_hi(p[k][1].x) + pg8::bf_hi(p[k][2].x));
                w.y = cvtpk(pg8::bf_lo(p[k][0].y) + pg8::bf_lo(p[k][1].y) + pg8::bf_lo(p[k][2].y), pg8::bf_hi(p[k][0].y) + pg8::bf_hi(p[k][1].y) + pg8::bf_hi(p[k][2].y));
                w.z = cvtpk(pg8::bf_lo(p[k][0].z) + pg8::bf_lo(p[k][1].z) + pg8::bf_lo(p[k][2].z), pg8::bf_hi(p[k][0].z) + pg8::bf_hi(p[k][1].z) + pg8::bf_hi(p[k][2].z));
                w.w = cvtpk(pg8::bf_lo(p[k][0].w) + pg8::bf_lo(p[k][1].w) + pg8::bf_lo(p[k][2].w), pg8::bf_hi(p[k][0].w) + pg8::bf_hi(p[k][1].w) + pg8::bf_hi(p[k][2].w));
                *(u32x4*)(mg + off) = w; }
        }
    }
}

__device__ __forceinline__ void mixa_phase(Frame& F, int layer) {
    constexpr int NU = NB * 16 * RW_NCH;
    if (F.wg < NU) { RwIn in; rw_fetch_x(F, F.wg, F.tid, in); rw_fetch_l(F, F.wg, 0, F.tid, in); rw_fetch_v(F, layer, F.wg, F.tid, in);
        for (int u = F.wg; u < NU; u += F.G) rw_local_unit(F, layer, u, u + F.G < NU ? u + F.G : -1, in); }
    __syncthreads();
    for (int u = F.wg; u < 256; u += F.G) ret_state_unit(F, layer, u);
    __syncthreads();
}
__device__ __forceinline__ void mix_phase(Frame& F, int layer, int qidx, int mode = 3) {
#ifdef RW_DEBUG
    for (int u = F.wg; u < 256; u += F.G) rwkv_scan_unit(F, layer, u);
    __syncthreads();
#endif
    if (mode & 1) { if (F.wave < 3) for (int tk = F.wg * 3 + F.wave; tk < 256; tk += F.G * 3) rw_seq_task(F, tk, F.lane, F.lds + F.wave * RWQ_WAVE); }
    if (!(mode & 2)) return;
    const bool lastl = layer == NL - 1;
    const int nswa = lastl ? 512 : 576;
    volatile LAS int* qslot = (volatile LAS int*)(F.lds + LDSCTL_OFF);
    __syncthreads();
    for (;;) {
        LB();
        if (F.tid == 0) qslot[0] = (int)__hip_atomic_fetch_add(F.ctl + CW_SWAQ + 64 * qidx, 1u, __ATOMIC_RELAXED, __HIP_MEMORY_SCOPE_AGENT);
        LB();
        const int item = qslot[0];
        if (item >= nswa) break;
        swa_unit(F, layer, item);
    }
    for (;;) {
        LB();
        if (F.tid == 0) qslot[0] = (int)__hip_atomic_fetch_add(F.ctl + CW_SWAQ + 64 * qidx + 32, 1u, __ATOMIC_RELAXED, __HIP_MEMORY_SCOPE_AGENT);
        LB();
        const int r = qslot[0];
        if (r >= nswa) break;
        ret_out_unit(F, layer, lastl ? (r >> 4) * 18 + 2 + (r & 15) : r);
    }
}
__device__ __forceinline__ void mixfin_phase(Frame& F, int layer, int nrows) {
    { TS_BEGIN(1);
      LAS float* VL = (LAS float*)(F.lds + 40960);
      for (int e = F.tid; e < 5 * 256; e += NTHR) { const int v = e >> 8, c4 = (e & 255) * 4; const int src = v == 0 ? 2 : (v == 1 ? 3 : (v == 2 ? 5 : (v == 3 ? 6 : 7)));
          *(LAS f32x4*)(VL + v * 1024 + c4) = *(const f32x4*)(vecp(F, layer, src) + c4); }
      constexpr int NU = NB * 16 * RW_NCH; const bool lastl = layer == NL - 1;
      auto nextu = [&](int u) { u += F.G; while (u < NU && lastl && (u % RW_NCH) < 4) u += F.G; return u < NU ? u : -1; };
      int u = F.wg - F.G; u = nextu(u);
      if (u >= 0) { RwOutA a; RwOutB b0, b1; rw_out_fetch_a(F, u, F.wave, F.lane, a); rw_out_fetch_b(F, u, F.tid, b0);
          __syncthreads();
          while (u >= 0) { int un = nextu(u); rw_out_unit(F, layer, u, un, a, b0, b1, VL); u = un;
              if (u < 0) break;
              un = nextu(u); rw_out_unit(F, layer, u, un, a, b1, b0, VL); u = un; } }
    TS_END(1); }
    __syncthreads();
}

constexpr int CONVQ_IN = 21, CONVQ_BR = 2, CONVQ_F1 = 10;
constexpr int NPH = 12;
constexpr int NSTEPS = 2 + NL * NPH + 1;
__global__ void __launch_bounds__(NTHR, 2) hyb_fwd(Args args) {
    extern __shared__ __attribute__((aligned(16))) unsigned char lds[];
    Frame F;
    F.lds = (LAS unsigned char*)lds;
    F.tid = threadIdx.x; F.lane = F.tid & 63; F.wave = __builtin_amdgcn_readfirstlane(F.tid >> 6);
    const int wv0 = F.wave;
    F.G = gridDim.x; F.wg = blockIdx.x; F.ws = args.ws; F.ctl = (unsigned*)(args.ws + WS_CTL);
    for (int u = F.tid; u < (LDS_BYTES - LDSCTL_OFF) / 4; u += NTHR) ((LAS unsigned*)(F.lds + LDSCTL_OFF))[u] = 0u;
    __syncthreads();
    if (F.tid < 26) { const __attribute__((address_space(4))) unsigned long long* kp = (const __attribute__((address_space(4))) unsigned long long*)__builtin_amdgcn_kernarg_segment_ptr();
        ((LAS unsigned long long*)(F.lds + PTAB_OFF))[F.tid] = kp[F.tid]; }
    __syncthreads();
    XcdBarrier bar = xcd_barrier_post(F.ctl + CW_BAR, (volatile LAS unsigned*)(F.lds + MISC_OFF) + 8);
    int lo = args.s_lo, hi = args.s_hi;
#define IN(k) (lo <= (k) && (k) < hi)
#define SL() do { size_t z_ = 0; asm volatile("" : "+s"(lo), "+s"(hi), "+s"(z_), "+s"(F.wg), "+s"(F.G)); F.ws = args.ws + z_; } while (0)
#define LAUNDER() do { int t_ = wv0 * 64 + lane_now(); asm volatile("" : "+v"(t_)); F.tid = t_; F.lane = t_ & 63; F.wave = __builtin_amdgcn_readfirstlane(t_ >> 6); } while (0)
#define SEAM(k) do { SL(); if (IN(k) && IN((k) + 1)) xcd_barrier(bar, wv0 == 0 && lane_now() == 0); } while (0)
    SL(); if (IN(0)) { LAUNDER(); p0_prologue(F); }
#ifdef PROBE_P0
    SL(); if (IN(0)) { xcd_barrier(bar, wv0 == 0 && lane_now() == 0); LAUNDER(); p0_prologue(F); }
#endif
    SEAM(0);
    SL(); if (IN(1)) { LAUNDER(); p1_modreduce(F); }
    SEAM(1);
    for (int layer_ = 0; layer_ < NL; ++layer_) {
        int layer = layer_; asm volatile("" : "+s"(layer));
        const int s0 = 2 + layer * NPH;
        const int mrows = (layer == NL - 1) ? ML : MT;
        const float* modl = wsp<float>(F, WS_MOD) + (size_t)layer * 5 * 12288;
        SL(); if (IN(s0 + 0)) { LAUNDER(); if (layer > 0) conv_pull(F, -1, conv_deadline(layer)); norm_phase(F, layer, 0, MT, layer > 0); }
#if defined(PROBE_PHASE) && PROBE_PHASE == 0
        SL(); if (IN(s0 + 0)) { xcd_barrier(bar, wv0 == 0 && lane_now() == 0); LAUNDER(); norm_phase(F, layer, 0, MT, false); }
#endif
        SEAM(s0 + 0);
        SL(); if (IN(s0 + 1)) {
            const int gg = (layer < NL - 1 && F.G == 256) ? 240 : F.G;
            if (layer == NL - 1) {
            pg8::Gemm g{wsp<bf16>(F, WS_U), wsp<bf16>(F, WS_WIN + layer * SZ_WIN), MT, LDP, DM, DM, DM}; pg8::LastInOrder S; S.init(F.G, F.wg);
            pg8::EpiBf16<0> E{wsp<bf16>(F, WS_P), LDP};
            pg8::gemm_phase<pg8::EpiBf16<0>, pg8::LastInOrder, true, true>(F.lds, g, S, E, wv0);
            } else if (F.wg < gg) {
            pg8::Gemm g{wsp<bf16>(F, WS_U), wsp<bf16>(F, WS_WIN + layer * SZ_WIN), MT, LDP, DM, DM, DM}; pg8::StaticOrder S; S.init(MT, LDP, gg, F.wg);
            pg8::EpiBf16<0> E{wsp<bf16>(F, WS_P), LDP};
            pg8::gemm_phase<pg8::EpiBf16<0>, pg8::StaticOrder, true, true>(F.lds, g, S, E, wv0);
            } else { LAUNDER(); conv_pull(F, CONVQ_IN, CONV_QTOT); }
#ifdef PROBE_GEMM2
            pg8::gemm_phase<pg8::EpiBf16<0>, pg8::StaticOrder, true, true>(F.lds, g, S, E, wv0);
#endif
        }
        SEAM(s0 + 1);
        SL(); if (IN(s0 + 2)) { LAUNDER(); if (layer == 0) conv_pull(F, -1, CONV_Q0); prep_phase(F, layer); }
#if defined(PROBE_PHASE) && PROBE_PHASE == 2
        SL(); if (IN(s0 + 2)) { xcd_barrier(bar, wv0 == 0 && lane_now() == 0); LAUNDER(); prep_phase(F, layer); }
#endif
        SEAM(s0 + 2);
        SL(); if (IN(s0 + 3)) {
            pg8::Gemm g{wsp<bf16>(F, WS_ALR), wsp<bf16>(F, WS_WLR + layer * SZ_WLR), MT, NLR, 128, KLR, KLR}; pg8::LrOrder S; S.init(MT, NLR, F.G, F.wg);
            pg8::EpiBf16<0> E{wsp<bf16>(F, WS_LR), NLR};
            pg8::gemm_phase<pg8::EpiBf16<0>, pg8::LrOrder, true, true>(F.lds, g, S, E, wv0);
#if defined(PROBE_PHASE) && PROBE_PHASE == 3
            pg8::gemm_phase<pg8::EpiBf16<0>, pg8::LrOrder, true, true>(F.lds, g, S, E, wv0);
#endif
        }
        SEAM(s0 + 3);
        SL(); if (IN(s0 + 4)) { LAUNDER(); mixa_phase(F, layer); }
#if defined(PROBE_PHASE) && PROBE_PHASE == 4
        SL(); if (IN(s0 + 4)) { xcd_barrier(bar, wv0 == 0 && lane_now() == 0); LAUNDER(); mixa_phase(F, layer); }
#endif
        SEAM(s0 + 4);
        SL(); if (IN(s0 + 5)) { LAUNDER(); mix_phase(F, layer, layer); }
#ifdef PROBE_MIX
        SL(); if (IN(s0 + 5)) { xcd_barrier(bar, wv0 == 0 && lane_now() == 0); LAUNDER(); mix_phase(F, layer, layer + 4, PROBE_MIX); }
#endif
        SEAM(s0 + 5);
        SL(); if (IN(s0 + 6)) { LAUNDER(); mixfin_phase(F, layer, mrows); }
#if defined(PROBE_PHASE) && PROBE_PHASE == 6
        SL(); if (IN(s0 + 6)) { xcd_barrier(bar, wv0 == 0 && lane_now() == 0); LAUNDER(); mixfin_phase(F, layer, mrows); }
#endif
        SEAM(s0 + 6);
        SL(); if (IN(s0 + 7)) {
            pg8::Gemm g{wsp<bf16>(F, WS_Y), wsp<bf16>(F, WS_WBR + layer * SZ_WBR), mrows, DM, BW, 3072, BW}; pg8::BranchOrder S; S.init(F.G, F.wg, mrows > ML);
            pg8::EpiBranch E{wsp<bf16>(F, WS_P) + C_GATE, LDP, wsp<bf16>(F, WS_MG), wsp<bf16>(F, WS_YDR)};
            pg8::gemm_phase<pg8::EpiBranch, pg8::BranchOrder, true, true>(F.lds, g, S, E, wv0);
#if defined(PROBE_PHASE) && PROBE_PHASE == 7
            pg8::gemm_phase<pg8::EpiBranch, pg8::BranchOrder, true, true>(F.lds, g, S, E, wv0);
#endif
            if (mrows > ML) { LAUNDER(); branch_fold(F, layer);
                if (layer < NL - 1 && F.G == 256 && F.wg >= 96) conv_pull(F, CONVQ_BR, CONV_QTOT); }
        }
        SEAM(s0 + 7);
        SL(); if (IN(s0 + 8)) {
            pg8::Gemm g{wsp<bf16>(F, WS_MG), wsp<bf16>(F, WS_WOUT + layer * SZ_WOUT), MT, DM, DM, DM, DM}; pg8::OutOrder S; S.init(F.G, F.wg, mrows > ML, DM);
            pg8::EpiOut E{wsp<bf16>(F, WS_MGF), wsp<bf16>(F, WS_YDR), modl, 2 * DM, (int)(F.wg & 7)};
            pg8::gemm_phase<pg8::EpiOut, pg8::OutOrder, true, true>(F.lds, g, S, E, wv0);
        }
        SEAM(s0 + 8);
        SL(); if (IN(s0 + 9)) { LAUNDER(); norm_phase(F, layer, 1, mrows, true); }
#if defined(PROBE_PHASE) && PROBE_PHASE == 9
        SL(); if (IN(s0 + 9)) { xcd_barrier(bar, wv0 == 0 && lane_now() == 0); LAUNDER(); norm_phase(F, layer, 1, mrows, false); }
#endif
        SEAM(s0 + 9);
        SL(); if (IN(s0 + 10)) {
            const int gg = (layer < NL - 1 && mrows > ML && F.G == 256) ? 232 : F.G;
            if (F.wg < gg) {
            pg8::Gemm g{wsp<bf16>(F, WS_U), wsp<bf16>(F, WS_WFF1 + layer * SZ_WFF), mrows, DFF, DM, DM, DM}; pg8::StaticOrder S; S.init(mrows, DFF, gg, F.wg);
            pg8::EpiBf16<2> E{wsp<bf16>(F, WS_F), DFF};
            pg8::gemm_phase<pg8::EpiBf16<2>, pg8::StaticOrder, true, true>(F.lds, g, S, E, wv0);
            } else { LAUNDER(); conv_pull(F, CONVQ_F1, CONV_QTOT); }
#ifdef PROBE_GEMM2
            pg8::gemm_phase<pg8::EpiBf16<2>, pg8::StaticOrder, true, true>(F.lds, g, S, E, wv0);
#endif
        }
        SEAM(s0 + 10);
        SL(); if (IN(s0 + 11)) {
            pg8::Gemm g{wsp<bf16>(F, WS_F), wsp<bf16>(F, WS_WFF2 + layer * SZ_WFF), MT, DM, DFF, DFF, DFF}; pg8::OutOrder S; S.init(F.G, F.wg, mrows > ML, DFF);
            pg8::EpiOut E{wsp<bf16>(F, WS_MGF) + (size_t)ML * DM, wsp<bf16>(F, WS_YDR), modl, 5 * DM, (int)(F.wg & 7)};
            pg8::gemm_phase<pg8::EpiOut, pg8::OutOrder, true, true>(F.lds, g, S, E, wv0);
        }
        SEAM(s0 + 11);
    }
    SL(); if (IN(NSTEPS - 1)) { LAUNDER(); final_norm(F, args.out); }
#undef IN
#undef SL
#undef LAUNDER
#undef SEAM
}

#ifndef MK_ONE_LAUNCH
#define MK_ONE_LAUNCH 1
#endif
extern "C" void kernel_launch(void* const* d_in, const int* in_sizes, int n_in, void* d_out, int out_size, void* d_ws, size_t ws_size, hipStream_t stream) {
    static int grid = 0;
    if (grid == 0) {
        if (n_in != 26 || out_size != ML * DM || ws_size < WS_END2) { fprintf(stderr, "kernel_launch: unexpected shapes (n_in %d, out %d, ws %zu < %zu)\n", n_in, out_size, ws_size, (size_t)WS_END2); grid = -1; return; }
        int dev = 0, cus = 0, per_cu = 0;
        if (hipGetDevice(&dev) != hipSuccess || hipDeviceGetAttribute(&cus, hipDeviceAttributeMultiprocessorCount, dev) != hipSuccess) { grid = -1; return; }
        if (hipFuncSetAttribute((const void*)hyb_fwd, hipFuncAttributeMaxDynamicSharedMemorySize, LDS_BYTES) != hipSuccess) { fprintf(stderr, "kernel_launch: hipFuncSetAttribute failed\n"); grid = -1; return; }
        if (hipOccupancyMaxActiveBlocksPerMultiprocessor(&per_cu, (const void*)hyb_fwd, NTHR, LDS_BYTES) != hipSuccess || per_cu < 1) fprintf(stderr, "kernel_launch: occupancy query reports %d\n", per_cu);
        (void)hipGetLastError();
        grid = cus;
    }
    if (grid < 0) return;
    if (hipMemsetAsync((char*)d_ws + WS_CTL, 0, CTL_ZERO_BYTES, stream) != hipSuccess) return;
    Args a{};
    for (int i = 0; i < 26; ++i) a.in[i] = (const float*)d_in[i];
    a.out = (float*)d_out; a.ws = (unsigned char*)d_ws;
#if MK_ONE_LAUNCH
    a.s_lo = 0; a.s_hi = NSTEPS;
    hipLaunchKernelGGL(hyb_fwd, dim3(grid), dim3(NTHR), LDS_BYTES, stream, a);
#else
    for (int s = 0; s < NSTEPS; ++s) { a.s_lo = s; a.s_hi = s + 1; hipLaunchKernelGGL(hyb_fwd, dim3(grid), dim3(NTHR), LDS_BYTES, stream, a); }
#endif
}
```

```cpp
#include <hip/hip_runtime.h>
#include <cstdio>
#include <cstdint>
__device__ __forceinline__ int lane_now() { int l; asm volatile("v_mbcnt_lo_u32_b32 %0, -1, 0\n\tv_mbcnt_hi_u32_b32 %0, -1, %0" : "=v"(l)); return l; }
namespace pg8 {
#define PG8_LAS __attribute__((address_space(3)))
typedef unsigned short bf16_t;
typedef short bf16x8 __attribute__((ext_vector_type(8)));
typedef float f32x4 __attribute__((ext_vector_type(4)));
typedef unsigned u32x4 __attribute__((ext_vector_type(4)));
constexpr int BM = 256, BK = 64, HALF = 128, HTB = HALF * BK * 2  , STAGE_BYTES = 8 * HTB, NXCD = 8, WGM = 8;

__host__ __device__ __forceinline__ int lds_byte(int r, int c) { const int st = (r >> 4) * 2 + (c >> 5), rr = r & 15, cc = c & 31, ob = rr * 64 + cc * 2; return st * 1024 + (ob ^ (((ob >> 9) & 1) << 5)); }
__host__ __device__ __forceinline__ void stage_rc(int b, int& R, int& C) { const int st = b / 1024, sb = b % 1024, swz = sb ^ (((sb >> 9) & 1) << 5); R = (st >> 1) * 16 + swz / 64; C = (st & 1) * 32 + (swz % 64) / 2; }
__host__ __device__ __forceinline__ int perm32(int rho) { const int n = rho >> 4, i = rho & 15; return 8 * (i >> 2) + 4 * n + (i & 3); }

struct Unit { int pm, pn; };
struct Gemm { const bf16_t* A; const bf16_t* Bt; int M, N, K, lda, ldb; };

struct StaticOrder {
    int nM, nN, nwg, G, c;
    __host__ __device__ void init(int M, int N, int G_, int c_) { nM = M / BM; nN = N / BM; nwg = nM * nN; G = G_; c = c_; }
    __host__ __device__ bool next(int i, Unit& u) const {
        const long L = (long)i * G + c; if (L >= nwg) return false;
        int wgid = (int)L; { const int q = nwg / NXCD, r = nwg % NXCD, xcd = wgid % NXCD, off = wgid / NXCD; wgid = (xcd < r ? xcd * (q + 1) : r * (q + 1) + (xcd - r) * q) + off; }
        const int nig = WGM * nN, gid = wgid / nig, fm = gid * WGM, gsz = (nM - fm) < WGM ? (nM - fm) : WGM;
        u.pm = fm + ((wgid % nig) % gsz); u.pn = (wgid % nig) / gsz; return true;
    }
    __device__ __forceinline__ void a_ready(const Unit&) const {}
    __device__ __forceinline__ void done(const Unit&) const {}
    __device__ __forceinline__ size_t a_off(const Unit&) const { return 0; }
    __device__ __forceinline__ size_t b_off(const Unit&) const { return 0; }
    __device__ __forceinline__ int nt(const Unit&, int d) const { return d; }
};

__device__ __forceinline__ unsigned cvt_pk_bf16(float lo, float hi) { unsigned r; asm volatile("v_cvt_pk_bf16_f32 %0, %1, %2" : "=v"(r) : "v"(lo), "v"(hi)); return r; }
typedef float f32x2 __attribute__((ext_vector_type(2)));
__device__ __forceinline__ float sigmoidf_(float x) { return __builtin_amdgcn_rcpf(1.0f + __builtin_amdgcn_exp2f(x * -1.4426950408889634f)); }
__device__ __forceinline__ float bf_lo(unsigned w) { return __uint_as_float(w << 16); }
__device__ __forceinline__ float bf_hi(unsigned w) { return __uint_as_float(w & 0xffff0000u); }

template <int ACT> struct EpiBf16 {
    static constexpr bool PERM = true, AFTER_DRAIN = false;
    bf16_t* O; int ldc;
    __device__ __forceinline__ void operator()(const f32x4 (&acc)[2][2][4][2], const Unit& u, int wr, int wc, int fr, int fq) const {
        const int row0 = u.pm * BM + wr * 64 + fr; const int col0 = u.pn * BM + wc * 32 + 8 * fq;
#pragma unroll
        for (int ai = 0; ai < 2; ++ai)
#pragma unroll
            for (int m = 0; m < 4; ++m) { bf16_t* rowp = O + (size_t)(row0 + ai * HALF + m * 16) * ldc + col0;
#pragma unroll
                for (int bj = 0; bj < 2; ++bj) { f32x4 v0 = acc[ai][bj][m][0], v1 = acc[ai][bj][m][1];
                    if (ACT == 2) {
#pragma unroll
                        for (int e = 0; e < 4; ++e) { const float a = fmaxf(v0[e], 0.f), b = fmaxf(v1[e], 0.f); v0[e] = a * a; v1[e] = b * b; } }
                    u32x4 w; w.x = cvt_pk_bf16(v0[0], v0[1]); w.y = cvt_pk_bf16(v0[2], v0[3]); w.z = cvt_pk_bf16(v1[0], v1[1]); w.w = cvt_pk_bf16(v1[2], v1[3]);
                    *(u32x4*)(rowp + bj * HALF) = w; } }
    }
};
struct OutOrder {
    StaticOrder S0; int G, c, nsub, ksl;
    __device__ void init(int G_, int c_, bool ctx, int K) { S0.init(8192, 2048, G_, c_); G = G_; c = c_; nsub = ctx ? 256 : 0; ksl = K / 8 * 2; }
    __device__ bool next(int i, Unit& u) const {
        const int T = c < 256 ? (256 - c + G - 1) / G : 0;
        if (i < T) { S0.next(i, u); return true; }
        const int q = (i - T) * G + c; if (q >= nsub) return false;
        const int lt = q >> 3; u.pm = 32 + (lt >> 3); u.pn = lt & 7; return true;
    }
    __device__ __forceinline__ void a_ready(const Unit&) const {}
    __device__ __forceinline__ void done(const Unit&) const {}
    __device__ __forceinline__ size_t a_off(const Unit& u) const { return u.pm < 32 ? 0 : (size_t)(c & 7) * ksl; }
    __device__ __forceinline__ size_t b_off(const Unit& u) const { return a_off(u); }
    __device__ __forceinline__ int nt(const Unit& u, int d) const { return u.pm < 32 ? d : d >> 3; }
};
struct EpiOut {
    static constexpr bool PERM = true, AFTER_DRAIN = false;
    bf16_t* D; bf16_t* part; const float* modl; int goff, slice;
    __device__ __forceinline__ void operator()(const f32x4 (&acc)[2][2][4][2], const Unit& u, int wr, int wc, int fr, int fq) const {
        const bool lat = u.pm < 32; const int mr = lat ? (u.pm >> 3) : 4;
        const int row0 = u.pm * BM + wr * 64 + fr, col0 = u.pn * BM + wc * 32 + 8 * fq;
        const float* gv = modl + (size_t)mr * 12288 + goff + col0;
        bf16_t* dst = lat ? D + (size_t)row0 * 2048 + col0 : part + ((size_t)slice * 1024 + (row0 - 8192)) * 2048 + col0;
        f32x4 gg[2][2];
#pragma unroll
        for (int bj = 0; bj < 2; ++bj)
#pragma unroll
            for (int n = 0; n < 2; ++n) gg[bj][n] = *(const f32x4*)(gv + bj * HALF + n * 4);
#pragma unroll
        for (int ai = 0; ai < 2; ++ai)
#pragma unroll
            for (int m = 0; m < 4; ++m) { bf16_t* rowp = dst + (size_t)(ai * HALF + m * 16) * 2048;
#pragma unroll
                for (int bj = 0; bj < 2; ++bj) { const f32x4 v0 = acc[ai][bj][m][0] * gg[bj][0], v1 = acc[ai][bj][m][1] * gg[bj][1];
                    u32x4 w; w.x = cvt_pk_bf16(v0[0], v0[1]); w.y = cvt_pk_bf16(v0[2], v0[3]); w.z = cvt_pk_bf16(v1[0], v1[1]); w.w = cvt_pk_bf16(v1[2], v1[3]);
                    *(u32x4*)(rowp + bj * HALF) = w; } }
    }
};

struct BranchOrder {
    StaticOrder S0; int G, c, nctx;
    __device__ void init(int G_, int c_, bool ctx) { S0.init(8192, 2048, G_, c_); G = G_; c = c_; nctx = ctx ? 96 : 0; }
    __device__ bool next(int i, Unit& u) const {
        const int T = c < 256 ? (256 - c + G - 1) / G : 0;
        if (i < 3 * T) { const int ti = i / 3, b = i - 3 * ti; S0.next(ti, u); u.pn += 8 * b; return true; }
        const int q = (i - 3 * T) * G + c; if (q >= nctx) return false;
        u.pm = 32 + ((q & 31) >> 3); u.pn = (q & 7) + 8 * (q >> 5); return true;
    }
    __device__ __forceinline__ void a_ready(const Unit&) const {}
    __device__ __forceinline__ void done(const Unit&) const {}
    __device__ __forceinline__ size_t a_off(const Unit& u) const { return (size_t)(u.pn >> 3) * 2048; }
    __device__ __forceinline__ size_t b_off(const Unit&) const { return 0; }
    __device__ __forceinline__ int nt(const Unit&, int d) const { return d; }
};
struct EpiBranch {
    static constexpr bool PERM = true, AFTER_DRAIN = false;
    const bf16_t* G; int ldg;
    bf16_t* out;
    bf16_t* part;
    __device__ __forceinline__ void operator()(const f32x4 (&acc)[2][2][4][2], const Unit& u, int wr, int wc, int fr, int fq) const {
        const int b = u.pn >> 3; const bool ctx = u.pm >= 32, old = !ctx && b > 0;
        const int row0 = u.pm * BM + wr * 64 + fr; const int col0 = (u.pn & 7) * BM + wc * 32 + 8 * fq;
        const bf16_t* gp = G + (size_t)row0 * ldg + b * 2048 + col0;
        bf16_t* op = ctx ? part + ((size_t)b * 1024 + (row0 - 8192)) * 2048 + col0 : out + (size_t)row0 * 2048 + col0;
        u32x4 gw[2][4], ow[2][4];
#pragma unroll
        for (int g = -1; g < 4; ++g) {
            if (g + 1 < 4) {
#pragma unroll
                for (int q = 0; q < 4; ++q) { const int it = (g + 1) * 4 + q, ai = it >> 3, m = (it >> 1) & 3, bj = it & 1; const int ro = ai * HALF + m * 16;
                    gw[(g + 1) & 1][q] = *(const u32x4*)(gp + (size_t)ro * ldg + bj * HALF);
                    ow[(g + 1) & 1][q] = *(const u32x4*)(op + (size_t)ro * 2048 + bj * HALF); }
            }
            asm volatile("" ::: "memory");
            if (g >= 0) {
#pragma unroll
                for (int q = 0; q < 4; ++q) { const int it = g * 4 + q, ai = it >> 3, m = (it >> 1) & 3, bj = it & 1; const int ro = ai * HALF + m * 16;
                    const u32x4 gq = gw[g & 1][q];
                    f32x4 g0, g1; g0[0] = sigmoidf_(bf_lo(gq.x)); g0[1] = sigmoidf_(bf_hi(gq.x)); g0[2] = sigmoidf_(bf_lo(gq.y)); g0[3] = sigmoidf_(bf_hi(gq.y));
                    g1[0] = sigmoidf_(bf_lo(gq.z)); g1[1] = sigmoidf_(bf_hi(gq.z)); g1[2] = sigmoidf_(bf_lo(gq.w)); g1[3] = sigmoidf_(bf_hi(gq.w));
                    f32x4 v0 = acc[ai][bj][m][0] * g0, v1 = acc[ai][bj][m][1] * g1;
                    u32x4 o = ow[g & 1][q]; if (!old) o = (u32x4){0u, 0u, 0u, 0u};
                    v0[0] += bf_lo(o.x); v0[1] += bf_hi(o.x); v0[2] += bf_lo(o.y); v0[3] += bf_hi(o.y); v1[0] += bf_lo(o.z); v1[1] += bf_hi(o.z); v1[2] += bf_lo(o.w); v1[3] += bf_hi(o.w);
                    u32x4 w; w.x = cvt_pk_bf16(v0[0], v0[1]); w.y = cvt_pk_bf16(v0[2], v0[3]); w.z = cvt_pk_bf16(v1[0], v1[1]); w.w = cvt_pk_bf16(v1[2], v1[3]);
                    *(u32x4*)(op + (size_t)ro * 2048 + bj * HALF) = w; }
                asm volatile("" ::: "memory");
            }
        }
    }
};

struct LastInOrder {
    StaticOrder S0; int G, c;
    __device__ void init(int G_, int c_) { S0.init(8192, 15360, G_, c_); G = G_; c = c_; }
    __device__ bool next(int i, Unit& u) const {
        const long L = (long)i * G + c;
        if (L < 1920) { S0.next(i, u); return true; }
        const int j = (int)(L - 1920); if (j >= 112) return false;
        const int q = j % 28; u.pm = 32 + j / 28; u.pn = q < 12 ? 4 + q : 8 + q; return true;
    }
    __device__ __forceinline__ void a_ready(const Unit&) const {}
    __device__ __forceinline__ void done(const Unit&) const {}
    __device__ __forceinline__ size_t a_off(const Unit&) const { return 0; }
    __device__ __forceinline__ size_t b_off(const Unit&) const { return 0; }
    __device__ __forceinline__ int nt(const Unit&, int d) const { return d; }
};

struct LrOrder {
    StaticOrder S0;
    __device__ void init(int M, int N, int G_, int c_) { S0.init(M, N, G_, c_); }
    __device__ bool next(int i, Unit& u) const { return S0.next(i, u); }
    __device__ __forceinline__ void a_ready(const Unit&) const {}
    __device__ __forceinline__ void done(const Unit&) const {}
    __device__ __forceinline__ size_t a_off(const Unit& u) const { return (size_t)(u.pn < 8 ? 0 : (u.pn < 16 ? 256 : 512)); }
    __device__ __forceinline__ size_t b_off(const Unit& u) const { return a_off(u); }
    __device__ __forceinline__ int nt(const Unit&, int d) const { return d; }
};

template <class Epi, class Sched, bool ALIGN_EPI = false, bool SP2 = false>
__device__ __forceinline__ void gemm_phase(PG8_LAS unsigned char* lds, const Gemm g, const Sched& S, const Epi& E, const int wv  ) {
    int tid_ = wv * 64 + lane_now(); asm volatile("" : "+v"(tid_));
    const int tid = tid_, wid = __builtin_amdgcn_readfirstlane(tid >> 6), lane = tid & 63, wr = wid >> 2, wc = wid & 3, fr = lane & 15, fq = lane >> 4;
    const int ntd = g.K / BK;
    unsigned voffA[2], voffB[2];
#pragma unroll
    for (int i = 0; i < 2; ++i) { int R, C; stage_rc(tid * 16 + i * 8192, R, C); const int Rb = Epi::PERM ? ((R & ~31) + perm32(R & 31)) : R;
        voffA[i] = (unsigned)(R * g.lda + C) * 2u; voffB[i] = (unsigned)(Rb * g.ldb + C) * 2u; }
    const size_t kstep = (size_t)(BK * 2);
    const size_t hstepA = (size_t)HALF * g.lda * 2, hstepB = (size_t)HALF * g.ldb * 2;
    const size_t tstepA = 2 * hstepA, tstepB = 2 * hstepB;
    const unsigned ldsw = (unsigned)wid * 1024u;
    const int aoff = lds_byte(wr * 64 + fr, fq * 8), boff = lds_byte(wc * 32 + fr, fq * 8);
#define PG8_SA(b, h) (((b) * 2 + (h)) * HTB)
#define PG8_SB(b, h) ((4 + (b) * 2 + (h)) * HTB)
#define PG8_STAGE(bufoff, gbase, voff) do { _Pragma("unroll") for (int _i = 0; _i < 2; ++_i) \
        __builtin_amdgcn_global_load_lds((const unsigned*)((const char*)(gbase) + (voff)[_i]), (PG8_LAS unsigned*)(lds + (bufoff) + ldsw + _i * 8192), 16, 0, 0); } while (0)
#define PG8_LDA(dst, b, h) do { _Pragma("unroll") for (int m = 0; m < 4; ++m) _Pragma("unroll") for (int k = 0; k < 2; ++k) dst[m][k] = *(const PG8_LAS bf16x8*)(lds + PG8_SA(b, h) + aoff + m * 2048 + k * 1024); } while (0)
#define PG8_LDB(dst, b, h) do { _Pragma("unroll") for (int n = 0; n < 2; ++n) _Pragma("unroll") for (int k = 0; k < 2; ++k) dst[n][k] = *(const PG8_LAS bf16x8*)(lds + PG8_SB(b, h) + boff + n * 2048 + k * 1024); } while (0)
#define PG8_MMA(ai, bj, At, Bt) do { __builtin_amdgcn_s_setprio(1); _Pragma("unroll") for (int m = 0; m < 4; ++m) _Pragma("unroll") for (int n = 0; n < 2; ++n) _Pragma("unroll") for (int k = 0; k < 2; ++k) \
        acc[ai][bj][m][n] = __builtin_amdgcn_mfma_f32_16x16x32_bf16(Bt[n][k], At[m][k], acc[ai][bj][m][n], 0, 0, 0); __builtin_amdgcn_s_setprio(0); } while (0)
#define PG8_WAIT_V(n) asm volatile("s_waitcnt vmcnt(" #n ")" ::: "memory")
#define PG8_WAIT_L(n) asm volatile("s_waitcnt lgkmcnt(" #n ")" ::: "memory")
#define PG8_BAR __builtin_amdgcn_s_barrier()
#define PG8_SCHED __builtin_amdgcn_sched_barrier(0)
    Unit cur, nxt; int ui = 0;
    if (!S.next(0, cur)) return;
    f32x4 acc[2][2][4][2];
#pragma unroll
    for (int a = 0; a < 2; ++a)
#pragma unroll
        for (int b = 0; b < 2; ++b)
#pragma unroll
            for (int m = 0; m < 4; ++m)
#pragma unroll
                for (int n = 0; n < 2; ++n) acc[a][b][m][n] = (f32x4){0.f, 0.f, 0.f, 0.f};
    bf16x8 At[4][2], B0[2][2], B1[2][2];
    const char* cA = (const char*)g.A + (size_t)cur.pm * tstepA + S.a_off(cur); const char* cB = (const char*)g.Bt + (size_t)cur.pn * tstepB + S.b_off(cur);
    S.a_ready(cur);
    if constexpr (SP2) {
        PG8_STAGE(PG8_SB(0, 0), cB, voffB); PG8_STAGE(PG8_SB(0, 1), cB + hstepB, voffB); PG8_STAGE(PG8_SA(0, 0), cA, voffA); PG8_STAGE(PG8_SA(0, 1), cA + hstepA, voffA);
        if (wr == 1) PG8_BAR;
        PG8_WAIT_V(2); PG8_BAR;
        PG8_STAGE(PG8_SB(1, 0), cB + kstep, voffB); PG8_STAGE(PG8_SA(1, 0), cA + kstep, voffA); PG8_STAGE(PG8_SB(1, 1), cB + hstepB + kstep, voffB);
        PG8_WAIT_V(6); PG8_BAR;
    } else {
        PG8_STAGE(PG8_SB(0, 0), cB, voffB); PG8_STAGE(PG8_SA(0, 0), cA, voffA); PG8_STAGE(PG8_SB(0, 1), cB + hstepB, voffB); PG8_STAGE(PG8_SA(0, 1), cA + hstepA, voffA);
        if (wr == 1) PG8_BAR;
        PG8_WAIT_V(4); PG8_BAR;
        PG8_STAGE(PG8_SB(1, 0), cB + kstep, voffB); PG8_STAGE(PG8_SA(1, 0), cA + kstep, voffA); PG8_STAGE(PG8_SB(1, 1), cB + hstepB + kstep, voffB);
        PG8_WAIT_V(6); PG8_BAR;
    }
    for (;;) {
        const bool has_next = S.next(ui + 1, nxt);
        const char* nA = has_next ? (const char*)g.A + (size_t)nxt.pm * tstepA + S.a_off(nxt) : cA; const char* nB = has_next ? (const char*)g.Bt + (size_t)nxt.pn * tstepB + S.b_off(nxt) : cB;
        const int nt = S.nt(cur, ntd);
#pragma nounroll
        for (int t = 0; t < nt; t += 2) {
            const bool last = (t == nt - 2);
            const char* a1 = cA + (size_t)(t + 1) * kstep;
            const char* a2 = last ? nA : cA + (size_t)(t + 2) * kstep; const char* b2 = last ? nB : cB + (size_t)(t + 2) * kstep;
            const char* a3 = a2 + kstep; const char* b3 = b2 + kstep;
            if (last && has_next) S.a_ready(nxt);
            if constexpr (SP2) {
            PG8_LDB(B0, 0, 0); PG8_LDB(B1, 0, 1); PG8_SCHED; PG8_LDA(At, 0, 0); PG8_STAGE(PG8_SA(1, 1), a1 + hstepA, voffA);
            PG8_WAIT_V(8); PG8_WAIT_L(0); PG8_BAR; PG8_MMA(0, 0, At, B0); PG8_MMA(0, 1, At, B1); PG8_BAR; PG8_SCHED;
            PG8_LDA(At, 0, 1); PG8_STAGE(PG8_SB(0, 0), b2, voffB); PG8_STAGE(PG8_SB(0, 1), b2 + hstepB, voffB); PG8_STAGE(PG8_SA(0, 0), a2, voffA);
            PG8_WAIT_V(8); PG8_WAIT_L(0); PG8_BAR; PG8_MMA(1, 0, At, B0); PG8_MMA(1, 1, At, B1); PG8_BAR; PG8_SCHED;
            PG8_LDB(B0, 1, 0); PG8_LDB(B1, 1, 1); PG8_SCHED; PG8_LDA(At, 1, 0); PG8_STAGE(PG8_SA(0, 1), a2 + hstepA, voffA);
            PG8_WAIT_V(8); PG8_WAIT_L(0); PG8_BAR; PG8_MMA(0, 0, At, B0); PG8_MMA(0, 1, At, B1); PG8_BAR; PG8_SCHED;
            PG8_LDA(At, 1, 1); PG8_STAGE(PG8_SB(1, 0), b3, voffB); PG8_STAGE(PG8_SB(1, 1), b3 + hstepB, voffB); PG8_STAGE(PG8_SA(1, 0), a3, voffA);
            PG8_WAIT_V(8); PG8_WAIT_L(0); PG8_BAR; PG8_MMA(1, 0, At, B0); PG8_MMA(1, 1, At, B1); PG8_BAR; PG8_SCHED;
            } else {
            PG8_LDB(B0, 0, 0); PG8_SCHED; PG8_LDA(At, 0, 0); PG8_STAGE(PG8_SA(1, 1), a1 + hstepA, voffA);
            PG8_WAIT_L(8); PG8_BAR; PG8_WAIT_L(0); PG8_MMA(0, 0, At, B0); PG8_BAR; PG8_SCHED;
            PG8_LDB(B1, 0, 1); PG8_STAGE(PG8_SB(0, 0), b2, voffB);
            PG8_BAR; PG8_WAIT_L(0); PG8_MMA(0, 1, At, B1); PG8_BAR;
            PG8_LDA(At, 0, 1); PG8_STAGE(PG8_SA(0, 0), a2, voffA);
            PG8_BAR; PG8_WAIT_L(0); PG8_MMA(1, 0, At, B0); PG8_BAR; PG8_SCHED;
            PG8_STAGE(PG8_SB(0, 1), b2 + hstepB, voffB);
            PG8_WAIT_V(6); PG8_BAR; PG8_MMA(1, 1, At, B1); PG8_BAR;
            PG8_LDB(B0, 1, 0); PG8_SCHED; PG8_LDA(At, 1, 0); PG8_STAGE(PG8_SA(0, 1), a2 + hstepA, voffA);
            PG8_WAIT_L(8); PG8_BAR; PG8_WAIT_L(0); PG8_MMA(0, 0, At, B0); PG8_BAR; PG8_SCHED;
            PG8_LDB(B1, 1, 1); PG8_STAGE(PG8_SB(1, 0), b3, voffB);
            PG8_BAR; PG8_WAIT_L(0); PG8_MMA(0, 1, At, B1); PG8_BAR;
            PG8_LDA(At, 1, 1); PG8_STAGE(PG8_SA(1, 0), a3, voffA);
            PG8_BAR; PG8_WAIT_L(0); PG8_MMA(1, 0, At, B0); PG8_BAR; PG8_SCHED;
            PG8_STAGE(PG8_SB(1, 1), b3 + hstepB, voffB);
            PG8_WAIT_V(6); PG8_BAR; PG8_MMA(1, 1, At, B1); PG8_BAR;
            }
        }
        if constexpr (ALIGN_EPI) { if (wr == 0) PG8_BAR; }
        if constexpr (!Epi::AFTER_DRAIN) { int t2_ = lane_now(); asm volatile("" : "+v"(t2_));   E(acc, cur, wr, wc, t2_ & 15, (t2_ >> 4) & 3); S.done(cur); }
        if (!has_next) break;
#pragma unroll
        for (int a = 0; a < 2; ++a)
#pragma unroll
            for (int b = 0; b < 2; ++b)
#pragma unroll
                for (int m = 0; m < 4; ++m)
#pragma unroll
                    for (int n = 0; n < 2; ++n) acc[a][b][m][n] = (f32x4){0.f, 0.f, 0.f, 0.f};
        cur = nxt; cA = nA; cB = nB; ++ui;
        if constexpr (ALIGN_EPI) { if (wr == 1) PG8_BAR; }
    }
    PG8_WAIT_V(0);
    if constexpr (!ALIGN_EPI) { if (wr == 0) PG8_BAR; }
    PG8_BAR;
    if constexpr (Epi::AFTER_DRAIN) { E.fused(acc, cur, wr, wc, fr, fq, lds, wid, lane); S.done(cur); }
#undef PG8_SA
#undef PG8_SB
#undef PG8_STAGE
#undef PG8_LDA
#undef PG8_LDB
#undef PG8_MMA
#undef PG8_WAIT_V
#undef PG8_WAIT_L
#undef PG8_BAR
#undef PG8_SCHED
}
}

constexpr int NB = 4, TL = 2048, TCX = 256, DM = 2048, NL = 4, DFF = 8192, BW = 1024;
constexpr int ML = NB * TL, MC = NB * TCX, MT = ML + MC;
constexpr int NIN = 15232, LDP = 15360;
constexpr int C_RET = 0, C_SWA = 4096, C_RW = 5632, C_GATE = 9088, RWIN = 3456;
constexpr int NLR = 5120, KLR = 384;
constexpr int NQK = 1280;
constexpr int NSTEP = 2304, SCAN_BLK = 32;

constexpr size_t al256(size_t x) { return (x + 255) & ~(size_t)255; }
constexpr size_t WS_CTL = 0, CTL_ZERO_BYTES = 1u << 20;
constexpr size_t SZ_WIN = (size_t)LDP * DM * 2, SZ_WBR = (size_t)3 * DM * BW * 2, SZ_WOUT = (size_t)DM * DM * 2, SZ_WFF = (size_t)DFF * DM * 2, SZ_WLR = (size_t)NLR * KLR * 2;
constexpr size_t WS_WIN = CTL_ZERO_BYTES;
constexpr size_t WS_WBR = WS_WIN + NL * SZ_WIN;
constexpr size_t WS_WOUT = WS_WBR + NL * SZ_WBR;
constexpr size_t WS_WFF1 = WS_WOUT + NL * SZ_WOUT;
constexpr size_t WS_WFF2 = WS_WFF1 + NL * SZ_WFF;
constexpr size_t WS_WLR = WS_WFF2 + NL * SZ_WFF;
constexpr size_t WS_H = WS_WLR + NL * SZ_WLR;
constexpr size_t WS_U = WS_H + (size_t)MT * DM * 4;
constexpr size_t WS_P = WS_U + (size_t)MT * DM * 2;
constexpr size_t WS_Y = WS_P + (size_t)MT * LDP * 2;
constexpr size_t WS_MGF = WS_Y + (size_t)MT * 3072 * 2;
constexpr size_t WS_MG = WS_MGF + (size_t)MT * DM * 4;
constexpr size_t WS_F = WS_MG + (size_t)MT * DM * 2;
constexpr size_t WS_MODP = WS_F + (size_t)MT * DFF * 2;
constexpr size_t WS_MOD = WS_MODP + (size_t)8 * NL * 5 * 12288 * 4;
constexpr size_t WS_ROPE = WS_MOD + (size_t)NL * 5 * 12288 * 4;
constexpr size_t WS_XS = WS_ROPE + 64 * 32 * 2 * 4;
constexpr size_t WS_ALR = WS_XS + (size_t)MT * 3072 * 4;
constexpr size_t WS_LR = WS_ALR + (size_t)MT * KLR * 2;
constexpr size_t WS_QKR = WS_LR + (size_t)MT * NLR * 4;
constexpr size_t WS_ST = WS_QKR + (size_t)MT * NQK * 2;
constexpr size_t WS_YDR = WS_ST + (size_t)NB * 8 * 2 * 18 * 128 * 128 * 2;
constexpr size_t WS_YDW = WS_YDR + (size_t)2 * MT * BW * 4;
constexpr size_t RWU = (size_t)NB * 16 * 2 * 36;
constexpr size_t WS_RWY = WS_F;
constexpr size_t WS_RWH = WS_F + RWU * 16384;
constexpr size_t WS_RWP = WS_YDW;
constexpr size_t WS_RWQ = WS_RWP + RWU * 8192;
constexpr size_t WS_RWG = WS_RWQ + RWU * 8192;
constexpr size_t WS_RWS = WS_RWG + RWU * 256;
constexpr size_t WS_END = WS_RWS + RWU * 8192;
static_assert(RWU * 32768 <= (size_t)MT * DFF * 2, "rwkv tiles overlay F");
constexpr size_t WS_VEC = WS_END;
constexpr size_t WS_END2 = WS_VEC + (size_t)NL * 8 * 1024 * 4;
constexpr int CW_BAR = 4096;
constexpr int CW_DBG = 20480;
constexpr int CW_SWAQ = 16384;

constexpr int RING_BYTES = 131072, LDSCTL_OFF = RING_BYTES, MISC_OFF = LDSCTL_OFF + 320, LDS_BYTES = 147456;
constexpr int NWAVES = 8, NTHR = 512;

#define GAS __attribute__((address_space(1)))
#define LAS __attribute__((address_space(3)))
typedef unsigned short bf16;
typedef float f32x4 __attribute__((ext_vector_type(4)));
typedef float f32x2 __attribute__((ext_vector_type(2)));
typedef unsigned u32x4 __attribute__((ext_vector_type(4)));
typedef unsigned u32x2 __attribute__((ext_vector_type(2)));
#define LDS_WAIT() asm volatile("s_waitcnt lgkmcnt(0)" ::: "memory")
#define LB() do { asm volatile("s_waitcnt lgkmcnt(0)" ::: "memory"); __builtin_amdgcn_s_barrier(); asm volatile("" ::: "memory"); } while (0)
#define VM_WAIT() asm volatile("s_waitcnt vmcnt(0)" ::: "memory")
typedef __bf16 bf16x2_t __attribute__((ext_vector_type(2)));
__device__ __forceinline__ unsigned cvtpk(float lo, float hi) { f32x2 v = {lo, hi}; bf16x2_t b = __builtin_convertvector(v, bf16x2_t); return __builtin_bit_cast(unsigned, b); }
__device__ __forceinline__ unsigned f2bf(float f) { return cvtpk(f, 0.f) & 0xffffu; }
__device__ __forceinline__ unsigned pk2(float lo, float hi) { return cvtpk(lo, hi); }
__device__ __forceinline__ float bf2f(bf16 v) { return __uint_as_float((unsigned)v << 16); }
__device__ __forceinline__ float fexp(float x) { return __builtin_amdgcn_exp2f(x * 1.4426950408889634f); }
__device__ __forceinline__ float sigm(float x) { return __builtin_amdgcn_rcpf(1.0f + __builtin_amdgcn_exp2f(x * -1.4426950408889634f)); }
__device__ __forceinline__ float ftanh(float x) { return 1.0f - 2.0f * __builtin_amdgcn_rcpf(1.0f + __builtin_amdgcn_exp2f(x * 2.8853900817779268f)); }
using pg8::bf_lo; using pg8::bf_hi;
__device__ __forceinline__ float shx(float v, int m, int lane) { return __int_as_float(__builtin_amdgcn_ds_bpermute((lane ^ m) << 2, __float_as_int(v))); }
__device__ __forceinline__ float lanefrom(float v, int src) { return __int_as_float(__builtin_amdgcn_ds_bpermute((src & 63) << 2, __float_as_int(v))); }
__device__ __forceinline__ float wave_sum(float v, int lane) {
#pragma unroll
    for (int o = 1; o < 64; o <<= 1) v += shx(v, o, lane);
    return v;
}
__device__ __forceinline__ float wave_max(float v, int lane) {
#pragma unroll
    for (int o = 1; o < 64; o <<= 1) v = fmaxf(v, shx(v, o, lane));
    return v;
}

#ifdef TS_DEBUG
#define TS_BEGIN(id) unsigned long long ts_##id = __builtin_amdgcn_s_memrealtime()
#define TS_END(id) do { if (F.wg == TS_WG && F.tid == 0) if ((id) == TS_SEL) atomicAdd(F.ctl + CW_DBG + 8, (unsigned)(__builtin_amdgcn_s_memrealtime() - ts_##id)); } while (0)
#else
#define TS_BEGIN(id)
#define TS_END(id)
#endif
#define XB_TMO      128
#define XB_XCNT(j)  (256  + 64 * (j))
#define XB_XSUB(j)  (1280 + 64 * (j))
#define XB_XGEN(j)  (2304 + 64 * (j))
#define XB_TOP      3328
#define XB_TOPGEN   3392
#define XCD_BAR_WORDS 3456
#define XB_SPIN_CAP (1u << 22)
__device__ __forceinline__ unsigned xb_ld(unsigned* p)              { return __hip_atomic_load(p, __ATOMIC_RELAXED, __HIP_MEMORY_SCOPE_AGENT); }
__device__ __forceinline__ unsigned xb_add(unsigned* p, unsigned v) { return __hip_atomic_fetch_add(p, v, __ATOMIC_RELAXED, __HIP_MEMORY_SCOPE_AGENT); }
__device__ __forceinline__ unsigned xb_xcc_id() { return (unsigned)__builtin_amdgcn_s_getreg((3 << 11) | 20) & 0xFu; }
#define XB_SPIN(cond, bar) do { unsigned _sp = 0; while (cond) { __builtin_amdgcn_s_sleep(1); \
    if ((++_sp & 255u) == 0u) { if (xb_ld(&(bar)[XB_TMO])) break; if (_sp > XB_SPIN_CAP) { atomicAdd(&(bar)[XB_TMO], 1u); break; } } } } while (0)
struct XcdBarrier { unsigned* bar; unsigned x; volatile LAS unsigned* st; };
__device__ __forceinline__ XcdBarrier xcd_barrier_post(unsigned* bar, volatile LAS unsigned* st) {
    XcdBarrier b; b.bar = bar; b.x = xb_xcc_id(); b.st = st;
    if (threadIdx.x == 0) (void)xb_add(&bar[XB_XCNT(b.x)], 1u);
    return b;
}
__device__ __forceinline__ void xcd_barrier_complete(unsigned* bar, unsigned x, unsigned& nloc, unsigned& nx) {
    const unsigned G = gridDim.x * gridDim.y * gridDim.z;
    unsigned sum, cnt, mine, sp = 0u;
    for (;;) {
        sum = 0u; cnt = 0u; mine = 0u;
#pragma unroll
        for (unsigned j = 0; j < 16; ++j) { const unsigned c = xb_ld(&bar[XB_XCNT(j)]); sum += c; cnt += (c > 0u) ? 1u : 0u; mine = (j == x) ? c : mine; }
        if (sum == G) break;
        __builtin_amdgcn_s_sleep(1);
        if ((++sp & 255u) == 0u) { if (xb_ld(&bar[XB_TMO])) break; if (sp > XB_SPIN_CAP) { atomicAdd(&bar[XB_TMO], 1u); break; } }
    }
    nloc = mine > 0u ? mine : 1u; nx = cnt > 0u ? cnt : 1u;
}
__device__ __forceinline__ void xcd_barrier(const XcdBarrier& b, const bool thread0  ) {
    asm volatile("s_waitcnt vmcnt(0)" ::: "memory");
    __syncthreads();
    if (thread0) {
        unsigned* bar = b.bar; unsigned bx = b.x;
        asm volatile("" : "+s"(bar), "+s"(bx));
        __builtin_amdgcn_s_waitcnt(0);
        unsigned nloc = b.st[0], nx = b.st[1];
        if (nloc == 0u) { xcd_barrier_complete(bar, bx, nloc, nx); b.st[0] = nloc; b.st[1] = nx; }
        const unsigned old = xb_add(&bar[XB_XSUB(bx)], 1u);
        const unsigned gen = old / nloc;
        if (old + 1u == (gen + 1u) * nloc) {
            __builtin_amdgcn_fence(__ATOMIC_RELEASE, "agent");
            asm volatile("s_waitcnt vmcnt(0)" ::: "memory");
            const unsigned og = xb_add(&bar[XB_TOP], 1u);
            const unsigned tg = og / nx;
            if (og + 1u == (tg + 1u) * nx) xb_add(&bar[XB_TOPGEN], 1u);
            else XB_SPIN(xb_ld(&bar[XB_TOPGEN]) == tg, bar);
            __builtin_amdgcn_fence(__ATOMIC_ACQUIRE, "agent");
            xb_add(&bar[XB_XGEN(bx)], 1u);
            asm volatile("s_waitcnt vmcnt(0)" ::: "memory");
        } else {
            XB_SPIN(xb_ld(&bar[XB_XGEN(bx)]) == gen, bar);
            __builtin_amdgcn_fence(__ATOMIC_ACQUIRE, "agent");
            asm volatile("s_waitcnt vmcnt(0)" ::: "memory");
        }
    }
    __syncthreads();
}

struct Args { const float* in[26]; float* out; unsigned char* ws; int s_lo, s_hi; };
enum { I_X = 0, I_C, I_CTX, I_CCTX, I_N1G, I_N2G, I_WMOD, I_BMOD, I_WIN, I_RETDEC, I_SINK, I_MU, I_W0, I_WUP, I_A0, I_AUP, I_GUP, I_KK, I_KA, I_RK, I_LNG, I_WBR, I_WOUT, I_WFF1, I_WFF2, I_FING };
struct Frame {
    LAS unsigned char* lds;
    unsigned* ctl;
    int tid, lane, wave, G, wg;
    unsigned char* ws;
};
template <class T> __device__ __forceinline__ T* wsp(const Frame& F, size_t off) { return (T*)(F.ws + off); }
constexpr int PTAB_OFF = LDSCTL_OFF + 64;
__device__ __forceinline__ const float* inp(const Frame& F, int i) {
    const LAS unsigned* t = (const LAS unsigned*)(F.lds + PTAB_OFF) + 2 * i;
    const unsigned lo = __builtin_amdgcn_readfirstlane(t[0]), hi = __builtin_amdgcn_readfirstlane(t[1]);
    return (const float*)(GAS const float*)(((unsigned long long)hi << 32) | (unsigned long long)lo);
}

__device__ __forceinline__ int scan_row(int b, int dir, int s) {
    if (s < TCX) return ML + b * TCX + (dir ? (TCX - 1 - s) : s);
    const int t = s - TCX; return b * TL + (dir ? (TL - 1 - t) : t);
}

constexpr int CONV_IT_IN = (DM / 64) * (NIN / 64), CONV_IT_BR = (BW / 64) * (DM / 64), CONV_IT_OUT = (DM / 64) * (DM / 64), CONV_IT_F1 = (DM / 64) * (DFF / 64), CONV_IT_F2 = (DFF / 64) * (DM / 64);
constexpr int CONV_IT_L = CONV_IT_IN + 3 * CONV_IT_BR + CONV_IT_OUT + CONV_IT_F1 + CONV_IT_F2;
constexpr int CONV_WG_ITEMS = CONV_IT_L / 8;
static_assert(CONV_IT_L % 8 == 0, "conversion items per layer");
constexpr int CW_CONVQ = 24576;
struct ConvDesc { const float* W; bf16* WT; int K, N, k0, n0; };
__device__ __forceinline__ ConvDesc conv_desc(Frame& F, int l, int r) {
    ConvDesc d; int item;
    if (r < CONV_IT_IN) { d.W = inp(F, I_WIN) + (size_t)l * DM * NIN; d.K = DM; d.N = NIN; d.WT = wsp<bf16>(F, WS_WIN + l * SZ_WIN); item = r; }
    else if ((r -= CONV_IT_IN) < 3 * CONV_IT_BR) { const int n = r / CONV_IT_BR; d.W = inp(F, I_WBR) + ((size_t)l * 3 + n) * BW * DM; d.K = BW; d.N = DM; d.WT = wsp<bf16>(F, WS_WBR + l * SZ_WBR) + (size_t)n * DM * BW; item = r % CONV_IT_BR; }
    else if ((r -= 3 * CONV_IT_BR) < CONV_IT_OUT) { d.W = inp(F, I_WOUT) + (size_t)l * DM * DM; d.K = DM; d.N = DM; d.WT = wsp<bf16>(F, WS_WOUT + l * SZ_WOUT); item = r; }
    else if ((r -= CONV_IT_OUT) < CONV_IT_F1) { d.W = inp(F, I_WFF1) + (size_t)l * DM * DFF; d.K = DM; d.N = DFF; d.WT = wsp<bf16>(F, WS_WFF1 + l * SZ_WFF); item = r; }
    else { r -= CONV_IT_F1; d.W = inp(F, I_WFF2) + (size_t)l * DFF * DM; d.K = DFF; d.N = DM; d.WT = wsp<bf16>(F, WS_WFF2 + l * SZ_WFF); item = r; }
    const int nblk = d.N / 64; d.k0 = 64 * (item / nblk); d.n0 = 64 * (item % nblk);
    return d;
}
__device__ __forceinline__ void tr_load(const ConvDesc& d, int lane, f32x4 (&v)[16]) {
    const int kr = lane >> 4, nc = (lane & 15) * 4;
#pragma unroll
    for (int i = 0; i < 16; ++i) v[i] = __builtin_nontemporal_load((const f32x4*)(d.W + (size_t)(d.k0 + 8 * (i >> 1) + 2 * kr + (i & 1)) * d.N + d.n0 + nc));
}
__device__ __forceinline__ void tr_store(const ConvDesc& d, int lane, LAS unsigned char* scr, const f32x4 (&v)[16]) {
    const int kr = lane >> 4, nc = (lane & 15) * 4, sw = 4 * ((lane >> 2) & 3);
    LAS unsigned* t = (LAS unsigned*)scr + nc * 36;
#pragma unroll
    for (int m = 0; m < 8; ++m) { const int kp = (4 * m + kr) ^ sw;
        t[kp] = cvtpk(v[2 * m].x, v[2 * m + 1].x); t[36 + kp] = cvtpk(v[2 * m].y, v[2 * m + 1].y); t[72 + kp] = cvtpk(v[2 * m].z, v[2 * m + 1].z); t[108 + kp] = cvtpk(v[2 * m].w, v[2 * m + 1].w); }
    LDS_WAIT(); asm volatile("" ::: "memory");
    const int c = lane & 7;
#pragma unroll
    for (int j = 0; j < 8; ++j) { const int n = (lane >> 3) + 8 * j;
        __builtin_nontemporal_store(*(const LAS u32x4*)(scr + n * 144 + 16 * (c ^ ((n >> 4) & 3))), (u32x4*)(d.WT + (size_t)(d.n0 + n) * d.K + d.k0 + 8 * c)); }
    LDS_WAIT(); asm volatile("" ::: "memory");
}
__device__ __forceinline__ void conv_wave_item(Frame& F, int l, int r, LAS unsigned char* scr) { const ConvDesc d = conv_desc(F, l, r); f32x4 v[16]; tr_load(d, F.lane, v); tr_store(d, F.lane, scr, v); }
constexpr int CONV_Q0 = (CONV_IT_L - CONV_IT_IN) / 8;
constexpr int CONV_QTOT = CONV_Q0 + (NL - 1) * CONV_WG_ITEMS;
static_assert(CONV_WG_ITEMS % 4 == 0 && CONV_Q0 % 4 == 0 && (CONV_IT_L - CONV_IT_IN) % 8 == 0, "conversion ranges");
__device__ __forceinline__ ConvDesc conv_desc_q(Frame& F, int gw) {
    if (gw < CONV_Q0 * 8) return conv_desc(F, 0, CONV_IT_IN + gw);
    gw -= CONV_Q0 * 8; const int l = gw / CONV_IT_L;
    return conv_desc(F, 1 + l, gw - l * CONV_IT_L);
}
__device__ __forceinline__ int conv_deadline(int layer) { return CONV_Q0 + (layer - 1) * CONV_WG_ITEMS + CONV_WG_ITEMS; }
__device__ __forceinline__ void conv_pull(Frame& F, int nr, int limit) {
    volatile LAS int* qslot = (volatile LAS int*)(F.lds + LDSCTL_OFF);
    LAS unsigned char* scr = F.lds + F.wave * 9216;
    __syncthreads();
    for (int n = 0; nr < 0 || n < nr; ++n) {
        LB();
        if (F.tid == 0) { int it = (int)__hip_atomic_load(F.ctl + CW_CONVQ, __ATOMIC_RELAXED, __HIP_MEMORY_SCOPE_AGENT);
            if (it < limit) it = (int)__hip_atomic_fetch_add(F.ctl + CW_CONVQ, 4u, __ATOMIC_RELAXED, __HIP_MEMORY_SCOPE_AGENT); else it = CONV_QTOT;
            qslot[0] = it; }
        LB();
        const int item = qslot[0];
        if (item >= CONV_QTOT) break;
        const int r0 = item * 8 + F.wave;
        f32x4 va[16], vb[16];
        const ConvDesc d0 = conv_desc_q(F, r0), d1 = conv_desc_q(F, r0 + 8);
        tr_load(d0, F.lane, va);
        tr_load(d1, F.lane, vb);
        tr_store(d0, F.lane, scr, va);
        const ConvDesc d2 = conv_desc_q(F, r0 + 16);
        tr_load(d2, F.lane, va);
        tr_store(d1, F.lane, scr, vb);
        const ConvDesc d3 = conv_desc_q(F, r0 + 24);
        tr_load(d3, F.lane, vb);
        tr_store(d2, F.lane, scr, va);
        tr_store(d3, F.lane, scr, vb);
    }
    __syncthreads();
}
__device__ __forceinline__ void p0_prologue(Frame& F) {
    const int gw = F.wg * NWAVES + F.wave, NGW = F.G * NWAVES;
    const int gt = F.wg * NTHR + F.tid, NGT = F.G * NTHR;
    LAS float* sil = (LAS float*)(F.lds + 81920);
    for (int e = F.tid; e < 5 * DM; e += NTHR) { const int r = e / DM, k = e % DM; const float v = r < 4 ? inp(F, I_C)[r * DM + k] : inp(F, I_CCTX)[k]; sil[e] = v * sigm(v); }
    { LAS unsigned char* scr = F.lds + F.wave * 9216;
      for (int it = gw; it < CONV_IT_IN; it += NGW) conv_wave_item(F, 0, it, scr); }
    for (int e = gt; e < NL * (LDP - NIN) * DM / 8; e += NGT) { const int l = e / ((LDP - NIN) * DM / 8), r = e % ((LDP - NIN) * DM / 8);
        *(u32x4*)(wsp<bf16>(F, WS_WIN + l * SZ_WIN) + (size_t)NIN * DM + (size_t)r * 8) = (u32x4){0u, 0u, 0u, 0u}; }
    for (int e = gt; e < NL * (KLR / 8) * NLR; e += NGT) {
        const int n = e % NLR, kg = (e / NLR) % (KLR / 8), l = e / (NLR * (KLR / 8)), k0 = 8 * kg;
        const float* src = nullptr;
        if (n < 2048) { const int d = n >> 10; if (kg >= 8 * d && kg < 8 * d + 8) src = inp(F, I_WUP) + (((size_t)l * 2 + d) * 64 + (k0 - 64 * d)) * BW + (n & 1023); }
        else if (n < 4096) { const int d = (n - 2048) >> 10; if (kg >= 16 + 8 * d && kg < 24 + 8 * d) src = inp(F, I_AUP) + (((size_t)l * 2 + d) * 64 + (k0 - 128 - 64 * d)) * BW + (n & 1023); }
        else if (kg >= 32) src = inp(F, I_GUP) + ((size_t)l * 128 + (k0 - 256)) * BW + (n - 4096);
        u32x4 o = {0u, 0u, 0u, 0u};
        if (src) { float v[8];
#pragma unroll
            for (int j = 0; j < 8; ++j) v[j] = src[(size_t)j * BW];
            o.x = pk2(v[0], v[1]); o.y = pk2(v[2], v[3]); o.z = pk2(v[4], v[5]); o.w = pk2(v[6], v[7]); }
        *(u32x4*)(wsp<bf16>(F, WS_WLR + l * SZ_WLR) + (size_t)n * KLR + k0) = o;
    }
    { const f32x4* x4 = (const f32x4*)inp(F, I_X); const f32x4* c4 = (const f32x4*)inp(F, I_CTX); u32x2* h4 = wsp<u32x2>(F, WS_H);
      for (int e = gt; e < ML * DM / 4; e += 4 * NGT) { f32x4 x[4];
#pragma unroll
          for (int k = 0; k < 4; ++k) { const int i = e + k * NGT; x[k] = x4[i < ML * DM / 4 ? i : e]; }
#pragma unroll
          for (int k = 0; k < 4; ++k) { const int i = e + k * NGT; if (i < ML * DM / 4) { u32x2 w; w.x = pk2(x[k].x, x[k].y); w.y = pk2(x[k].z, x[k].w); h4[i] = w; } } }
      for (int e = gt; e < MC * DM / 4; e += 4 * NGT) { f32x4 x[4];
#pragma unroll
          for (int k = 0; k < 4; ++k) { const int i = e + k * NGT; x[k] = c4[i < MC * DM / 4 ? i : e]; }
#pragma unroll
          for (int k = 0; k < 4; ++k) { const int i = e + k * NGT; if (i < MC * DM / 4) { u32x2 w; w.x = pk2(x[k].x, x[k].y); w.y = pk2(x[k].z, x[k].w); h4[ML * DM / 4 + i] = w; } } } }
    for (int e = gt; e < NL * 8 * 1024; e += NGT) { const int l = e >> 13, v = (e >> 10) & 7, c = e & 1023; float x;
        if (v < 2) x = inp(F, I_W0)[(l * 2 + v) * 1024 + c]; else if (v < 4) x = inp(F, I_A0)[(l * 2 + v - 2) * 1024 + c];
        else if (v == 4) x = inp(F, I_KK)[l * 1024 + c]; else if (v == 5) x = inp(F, I_KA)[l * 1024 + c]; else if (v == 6) x = inp(F, I_RK)[l * 1024 + c]; else x = inp(F, I_LNG)[l * 1024 + c];
        wsp<float>(F, WS_VEC)[e] = x; }
    if (gt < 64 * 32) { const int pos = gt >> 5, i = gt & 31; const float inv = powf(10000.0f, -(float)i / 32.0f); const float ang = (float)pos * inv;
        wsp<float>(F, WS_ROPE)[2 * gt] = cosf(ang); wsp<float>(F, WS_ROPE)[2 * gt + 1] = sinf(ang); }
    __syncthreads();
    for (int it = gw; it < NL * 8 * 48; it += NGW) {
        const int l = it / (8 * 48), kc = (it / 48) % 8, cc = it % 48, col = cc * 256 + F.lane * 4, k0 = kc * 256;
        const float* wp = inp(F, I_WMOD) + ((size_t)l * DM + k0) * 12288 + col;
        f32x4 a0 = {0.f, 0.f, 0.f, 0.f}, a1 = a0, a2 = a0, a3 = a0, a4 = a0;
#pragma unroll 16
        for (int k = 0; k < 256; ++k) { const f32x4 w = *(const f32x4*)(wp + (size_t)k * 12288);
            a0 += sil[0 * DM + k0 + k] * w; a1 += sil[1 * DM + k0 + k] * w; a2 += sil[2 * DM + k0 + k] * w; a3 += sil[3 * DM + k0 + k] * w; a4 += sil[4 * DM + k0 + k] * w; }
        float* mp = wsp<float>(F, WS_MODP) + ((size_t)(kc * NL + l) * 5) * 12288 + col;
        *(f32x4*)(mp) = a0; *(f32x4*)(mp + 12288) = a1; *(f32x4*)(mp + 2 * 12288) = a2; *(f32x4*)(mp + 3 * 12288) = a3; *(f32x4*)(mp + 4 * 12288) = a4;
    }
}
__device__ __forceinline__ void p1_modreduce(Frame& F) {
    const int gt = F.wg * NTHR + F.tid, NGT = F.G * NTHR;
    for (int e = gt; e < NL * 5 * 12288; e += NGT) { const int l = e / (5 * 12288), j = e % 12288;
        float s = inp(F, I_BMOD)[l * 12288 + j];
#pragma unroll
        for (int kc = 0; kc < 8; ++kc) s += wsp<float>(F, WS_MODP)[(size_t)kc * NL * 5 * 12288 + e];
        wsp<float>(F, WS_MOD)[e] = s; }
}

struct NormIn { u32x2 h[8]; u32x2 d[8]; u32x2 e[8]; };
__device__ __forceinline__ void norm_fetch(Frame& F, int row, int nd, NormIn& in) {
    const u32x2* xr = (const u32x2*)(wsp<bf16>(F, WS_H) + (size_t)row * DM) + F.lane;
    const u32x2* pp = (const u32x2*)(wsp<bf16>(F, WS_MGF) + (size_t)row * DM) + F.lane;
    const u32x2* pe = nd == 2 ? pp + (size_t)ML * DM / 4 : pp;
#pragma unroll
    for (int j = 0; j < 8; ++j) in.h[j] = xr[64 * j];
#pragma unroll
    for (int j = 0; j < 8; ++j) in.d[j] = pp[64 * j];
#pragma unroll
    for (int j = 0; j < 8; ++j) in.e[j] = pe[64 * j];
}
__device__ __forceinline__ void norm_finish(Frame& F, bool wb, int row, int mr, f32x4 (&v)[8]) {
    const LAS float* LA = (const LAS float*)F.lds + mr * DM; const LAS float* LB = LA + 5 * DM;
    if (wb) { u32x2* xw = (u32x2*)(wsp<bf16>(F, WS_H) + (size_t)row * DM) + F.lane;
#pragma unroll
        for (int j = 0; j < 8; ++j) { u32x2 w; w.x = pk2(v[j].x, v[j].y); w.y = pk2(v[j].z, v[j].w); xw[64 * j] = w; } }
    float ss = 0.f;
#pragma unroll
    for (int j = 0; j < 8; ++j) ss += (v[j].x * v[j].x + v[j].y * v[j].y) + (v[j].z * v[j].z + v[j].w * v[j].w);
    const float rs = __builtin_amdgcn_rsqf(wave_sum(ss, F.lane) * (1.0f / DM) + 1e-6f);
    u32x2* o = (u32x2*)(wsp<bf16>(F, WS_U) + (size_t)row * DM) + F.lane;
    asm volatile("" ::: "memory");
#pragma unroll
    for (int j = 0; j < 8; ++j) { const int c = 4 * F.lane + 256 * j;
        const f32x4 y = (v[j] * rs) * *(const LAS f32x4*)(LA + c) + *(const LAS f32x4*)(LB + c);
        u32x2 w; w.x = pk2(y.x, y.y); w.y = pk2(y.z, y.w); o[64 * j] = w; }
}
__device__ __forceinline__ void norm_row(Frame& F, int nd, int row, const NormIn& in) {
    f32x4 v[8];
#pragma unroll
    for (int j = 0; j < 8; ++j) { const u32x2 w = in.h[j]; v[j] = (f32x4){bf_lo(w.x), bf_hi(w.x), bf_lo(w.y), bf_hi(w.y)}; }
    if (nd >= 1) {
#pragma unroll
        for (int j = 0; j < 8; ++j) { const u32x2 w = in.d[j]; v[j] += (f32x4){bf_lo(w.x), bf_hi(w.x), bf_lo(w.y), bf_hi(w.y)}; } }
    if (nd == 2) {
#pragma unroll
        for (int j = 0; j < 8; ++j) { const u32x2 w = in.e[j]; v[j] += (f32x4){bf_lo(w.x), bf_hi(w.x), bf_lo(w.y), bf_hi(w.y)}; } }
    norm_finish(F, nd == 2, row, row >> 11, v);
}
__device__ __forceinline__ void norm_ctx_row(Frame& F, bool partials, int row) {
    f32x4 v[8];
    { const u32x2* xr = (const u32x2*)(wsp<bf16>(F, WS_H) + (size_t)row * DM) + F.lane; u32x2 h[8];
#pragma unroll
      for (int j = 0; j < 8; ++j) h[j] = xr[64 * j];
#pragma unroll
      for (int j = 0; j < 8; ++j) v[j] = (f32x4){bf_lo(h[j].x), bf_hi(h[j].x), bf_lo(h[j].y), bf_hi(h[j].y)}; }
    if (partials) {
        const u32x2* pp = (const u32x2*)(wsp<bf16>(F, WS_YDR) + (size_t)(row - ML) * DM) + F.lane;
#pragma unroll 1
        for (int s = 0; s < 8; s += 2) { u32x2 pw[2][8];
#pragma unroll
            for (int j = 0; j < 8; ++j) { pw[0][j] = pp[(size_t)s * 1024 * DM / 4 + 64 * j]; pw[1][j] = pp[(size_t)(s + 1) * 1024 * DM / 4 + 64 * j]; }
#pragma unroll
            for (int j = 0; j < 8; ++j) { const u32x2 w = pw[0][j], x = pw[1][j];
                v[j] += (f32x4){bf_lo(w.x), bf_hi(w.x), bf_lo(w.y), bf_hi(w.y)}; v[j] += (f32x4){bf_lo(x.x), bf_hi(x.x), bf_lo(x.y), bf_hi(x.y)}; } }
    }
    norm_finish(F, partials, row, 4, v);
}
__device__ __forceinline__ void norm_phase(Frame& F, int layer, int which, int nrows, bool partials) {
    const int gw = F.wg * NWAVES + F.wave, NGW = F.G * NWAVES;
    { const float* gptr = inp(F, which ? I_N2G : I_N1G) + layer * DM; const float* modb = wsp<float>(F, WS_MOD) + (size_t)layer * 5 * 12288 + (which ? 3 * DM : 0);
      LAS float* LA = (LAS float*)F.lds; LAS float* LB = LA + 5 * DM;
      for (int e = F.tid; e < 5 * (DM / 4); e += NTHR) { const int mr = e / (DM / 4), c = (e % (DM / 4)) * 4;
          const f32x4 g = *(const f32x4*)(gptr + c), sh = *(const f32x4*)(modb + (size_t)mr * 12288 + c), sc = *(const f32x4*)(modb + (size_t)mr * 12288 + DM + c);
          *(LAS f32x4*)(LA + mr * DM + c) = g * (1.0f + sc); *(LAS f32x4*)(LB + mr * DM + c) = sh; }
      __syncthreads(); }
    int row = gw; const int nd = partials ? (which ? 1 : 2) : 0;
    NormIn a, b; norm_fetch(F, row < ML ? row : 0, nd, a);
    for (int crow_ = ML + ((gw + NGW / 2) % NGW); crow_ < nrows; crow_ += NGW) norm_ctx_row(F, partials, crow_);
    if (row >= ML) return;
    for (;;) {
        const int r1 = row + NGW; const bool h1 = r1 < ML; norm_fetch(F, h1 ? r1 : row, nd, b);
        norm_row(F, nd, row, a);
        if (!h1) break;
        const int r2 = r1 + NGW; const bool h2 = r2 < ML; norm_fetch(F, h2 ? r2 : r1, nd, a);
        norm_row(F, nd, r1, b);
        if (!h2) break;
        row = r2;
    }
}
__device__ __forceinline__ void final_norm(Frame& F, float* out) {
    const int gw = F.wg * NWAVES + F.wave, NGW = F.G * NWAVES;
#ifdef TS_DEBUG
    const float dbg_e0 = (float)F.ctl[CW_DBG + 8] * TS_SCALE, dbg_e1 = 0.f;
#endif
#ifdef RW_DEBUG
    const float* dst_ = (const float*)(F.ctl + CW_DBG); const float er0_ = sqrtf(dst_[0] / fmaxf(dst_[1], 1e-30f)), er1_ = sqrtf(dst_[2] / fmaxf(dst_[3], 1e-30f)); const float dbg_e0 = er0_ > RW_DEBUG_THR ? 0.3f : 0.0f, dbg_e1 = er1_ > RW_DEBUG_THR ? 0.6f : 0.0f;
#endif
    LAS float* LG = (LAS float*)F.lds;
    for (int e = F.tid; e < DM / 4; e += NTHR) *(LAS f32x4*)(LG + 4 * e) = *(const f32x4*)(inp(F, I_FING) + 4 * e);
    __syncthreads();
    for (int row = gw; row < ML; row += NGW) {
        const u32x2* xr = (const u32x2*)(wsp<bf16>(F, WS_H) + (size_t)row * DM) + F.lane;
        const u32x2* pp = (const u32x2*)(wsp<bf16>(F, WS_MGF) + (size_t)row * DM) + F.lane;
        f32x4 v[8]; float ss = 0.f; u32x2 hw[8], d1[8], d2[8];
#pragma unroll
        for (int j = 0; j < 8; ++j) { hw[j] = xr[64 * j]; d1[j] = pp[64 * j]; d2[j] = pp[(size_t)ML * DM / 4 + 64 * j]; }
        asm volatile("" ::: "memory");
#pragma unroll
        for (int j = 0; j < 8; ++j) { const u32x2 h = hw[j], w = d1[j], x = d2[j]; v[j] = (f32x4){bf_lo(h.x), bf_hi(h.x), bf_lo(h.y), bf_hi(h.y)};
            v[j] += (f32x4){bf_lo(w.x), bf_hi(w.x), bf_lo(w.y), bf_hi(w.y)}; v[j] += (f32x4){bf_lo(x.x), bf_hi(x.x), bf_lo(x.y), bf_hi(x.y)}; }
#pragma unroll
        for (int j = 0; j < 8; ++j) ss += (v[j].x * v[j].x + v[j].y * v[j].y) + (v[j].z * v[j].z + v[j].w * v[j].w);
        const float rs = __builtin_amdgcn_rsqf(wave_sum(ss, F.lane) * (1.0f / DM) + 1e-6f);
        f32x4* o = (f32x4*)(out + (size_t)row * DM) + F.lane;
#pragma unroll
        for (int j = 0; j < 8; ++j) { const f32x4 g = *(const LAS f32x4*)(LG + 4 * F.lane + 256 * j); f32x4 ov = (v[j] * rs) * g;
#if defined(RW_DEBUG) || defined(TS_DEBUG)
#ifndef RW_DEBUG_NOSTAT
            ov += dbg_e0; if (row == 0 && j == 0 && F.lane == 0) ov.x += dbg_e1;
#endif
#endif
            o[64 * j] = ov; }
    }
}
__device__ __forceinline__ void prep_phase(Frame& F, int layer) {
    const int gw = F.wg * NWAVES + F.wave, NGW = F.G * NWAVES;
    const bf16* P = wsp<bf16>(F, WS_P);
    LAS float* Lmu0 = (LAS float*)F.lds; LAS float* Lmu1 = Lmu0 + RWIN; LAS float* Lrope = Lmu1 + RWIN;
    { const float* mu0 = inp(F, I_MU) + (size_t)layer * 2 * RWIN; const float* rope = wsp<float>(F, WS_ROPE);
      for (int e = F.tid; e < 2 * RWIN / 4; e += NTHR) *(LAS f32x4*)(Lmu0 + 4 * e) = *(const f32x4*)(mu0 + 4 * e);
      for (int e = F.tid; e < 64 * 32 * 2 / 4; e += NTHR) *(LAS f32x4*)(Lrope + 4 * e) = *(const f32x4*)(rope + 4 * e);
      __syncthreads(); }
    for (int row = gw; row < MT; row += NGW) {
        bool first, last; int t = 0;
        if (row < ML) { t = row & (TL - 1); first = t == 0; last = t == TL - 1; } else { const int c = (row - ML) & (TCX - 1); first = c == 0; last = c == TCX - 1; }
        const bf16* pr = P + (size_t)row * LDP + C_RW; const bf16* pv = first ? pr : pr - LDP; const bf16* pn = last ? pr : pr + LDP;
        const bf16* ps = P + (size_t)row * LDP + C_SWA;
        u32x4 pw[7], vw[7], nw[7]; unsigned rx[3][4];
#pragma unroll
        for (int p = 0; p < 7; ++p) { int j8 = F.lane + 64 * p; j8 = j8 < RWIN / 8 ? j8 : RWIN / 8 - 1; const int c = 8 * j8;
            pw[p] = *(const u32x4*)(pr + c); vw[p] = *(const u32x4*)(pv + c); nw[p] = *(const u32x4*)(pn + c); }
#pragma unroll
        for (int q = 0; q < 3; ++q) { int tk = F.lane + 64 * q; tk = tk < 160 ? tk : 159; const bf16* ph = ps + (tk >> 4) * 128 + (tk & 15) * 2;
            rx[q][0] = *(const unsigned*)(ph); rx[q][1] = *(const unsigned*)(ph + 32); rx[q][2] = *(const unsigned*)(ph + 64); rx[q][3] = *(const unsigned*)(ph + 96); }
        asm volatile("" ::: "memory");
        bf16* xs = wsp<bf16>(F, WS_XS) + (size_t)row * 3072; bf16* alr = wsp<bf16>(F, WS_ALR) + (size_t)row * KLR;
#pragma unroll
        for (int p = 0; p < 7; ++p) { const int j8 = F.lane + 64 * p;
            if (j8 < RWIN / 8) { const int c = 8 * j8;
                const u32x4 cw = pw[p]; const u32x4 vv = first ? (u32x4){0u, 0u, 0u, 0u} : vw[p]; const u32x4 nn = last ? (u32x4){0u, 0u, 0u, 0u} : nw[p];
                const f32x4 ma = *(const LAS f32x4*)(Lmu0 + c), mb = *(const LAS f32x4*)(Lmu0 + c + 4), na = *(const LAS f32x4*)(Lmu1 + c), nb = *(const LAS f32x4*)(Lmu1 + c + 4);
                float s[8];
#pragma unroll
                for (int e = 0; e < 4; ++e) { const float p0 = bf_lo(cw[e]), p1 = bf_hi(cw[e]), v0 = bf_lo(vv[e]), v1 = bf_hi(vv[e]), n0 = bf_lo(nn[e]), n1 = bf_hi(nn[e]);
                    const float m0 = e < 2 ? ma[2 * e] : mb[2 * e - 4], m1 = e < 2 ? ma[2 * e + 1] : mb[2 * e - 3], q0 = e < 2 ? na[2 * e] : nb[2 * e - 4], q1 = e < 2 ? na[2 * e + 1] : nb[2 * e - 3];
                    s[2 * e] = p0 + m0 * (v0 - p0) + q0 * (n0 - p0); s[2 * e + 1] = p1 + m1 * (v1 - p1) + q1 * (n1 - p1); }
                if (c < 3072) { u32x4 o; o.x = pk2(s[0], s[1]); o.y = pk2(s[2], s[3]); o.z = pk2(s[4], s[5]); o.w = pk2(s[6], s[7]); *(u32x4*)(xs + c) = o; }
                else { u32x4 o; int dst;
                    if (c < 3200) { dst = c - 3072; o.x = pk2(ftanh(s[0]), ftanh(s[1])); o.y = pk2(ftanh(s[2]), ftanh(s[3])); o.z = pk2(ftanh(s[4]), ftanh(s[5])); o.w = pk2(ftanh(s[6]), ftanh(s[7])); }
                    else if (c < 3328) { dst = 128 + c - 3200; o.x = pk2(s[0], s[1]); o.y = pk2(s[2], s[3]); o.z = pk2(s[4], s[5]); o.w = pk2(s[6], s[7]); }
                    else { dst = 256 + c - 3328; o.x = pk2(sigm(s[0]), sigm(s[1])); o.y = pk2(sigm(s[2]), sigm(s[3])); o.z = pk2(sigm(s[4]), sigm(s[5])); o.w = pk2(sigm(s[6]), sigm(s[7])); }
                    *(u32x4*)(alr + dst) = o; } } }
        bf16* qk = wsp<bf16>(F, WS_QKR) + (size_t)row * NQK;
        const bool lat = row < ML; const int rr = t >> 6, cc = t & 63;
#pragma unroll
        for (int q = 0; q < 3; ++q) { const int tk = F.lane + 64 * q;
            if (tk < 160) { const int hd = tk >> 4, i2 = (tk & 15) * 2;
                f32x4 tr = {1.f, 0.f, 1.f, 0.f}, tc = tr;
                if (lat) { tr = *(const LAS f32x4*)(Lrope + (rr * 32 + i2) * 2); tc = *(const LAS f32x4*)(Lrope + (cc * 32 + i2) * 2); }
                const float a0 = bf_lo(rx[q][0]), a1 = bf_hi(rx[q][0]), b0 = bf_lo(rx[q][1]), b1 = bf_hi(rx[q][1]), c0 = bf_lo(rx[q][2]), c1 = bf_hi(rx[q][2]), d0 = bf_lo(rx[q][3]), d1 = bf_hi(rx[q][3]);
                unsigned* o = (unsigned*)(qk + hd * 128 + i2);
                o[0] = pk2(a0 * tr.x - b0 * tr.y, a1 * tr.z - b1 * tr.w); o[16] = pk2(b0 * tr.x + a0 * tr.y, b1 * tr.z + a1 * tr.w);
                o[32] = pk2(c0 * tc.x - d0 * tc.y, c1 * tc.z - d1 * tc.w); o[48] = pk2(d0 * tc.x + c0 * tc.y, d1 * tc.z + c1 * tc.w); } }
    }
}

__device__ __forceinline__ float red8(float v) {
    v += __int_as_float(__builtin_amdgcn_update_dpp(0, __float_as_int(v), 0xB1, 0xF, 0xF, true));
    v += __int_as_float(__builtin_amdgcn_update_dpp(0, __float_as_int(v), 0x4E, 0xF, 0xF, true));
    v += __int_as_float(__builtin_amdgcn_update_dpp(0, __float_as_int(v), 0x141, 0xF, 0xF, true));
    return v;
}
__device__ __forceinline__ float red16(float v) {
    v += __int_as_float(__builtin_amdgcn_update_dpp(0, __float_as_int(v), 0xB1, 0xF, 0xF, true));
    v += __int_as_float(__builtin_amdgcn_update_dpp(0, __float_as_int(v), 0x4E, 0xF, 0xF, true));
    v += __int_as_float(__builtin_amdgcn_update_dpp(0, __float_as_int(v), 0x141, 0xF, 0xF, true));
    v += __int_as_float(__builtin_amdgcn_update_dpp(0, __float_as_int(v), 0x140, 0xF, 0xF, true));
    return v;
}
typedef short bf16x8 __attribute__((ext_vector_type(8)));
typedef short s16x4 __attribute__((ext_vector_type(4)));
typedef float f32x16 __attribute__((ext_vector_type(16)));
#define MFMA32(a, b, c) __builtin_amdgcn_mfma_f32_32x32x16_bf16((a), (b), (c), 0, 0, 0)
__device__ __forceinline__ int crow(int reg, int h) { return (reg & 3) + 8 * (reg >> 2) + 4 * h; }
__device__ __forceinline__ s16x4 tr16(const LAS unsigned char* p) { return __builtin_bit_cast(s16x4, __builtin_amdgcn_ds_read_tr16_b64_v4i16((LAS s16x4*)p)); }
__device__ __forceinline__ bf16x8 frag_rm(const LAS unsigned char* base, int pitch, int r0, int k0, int lane) {
    return *(const LAS bf16x8*)(base + (r0 + (lane & 31)) * pitch + (k0 + 8 * (lane >> 5)) * 2);
}
template <bool PERM> __device__ __forceinline__ bf16x8 frag_tr(const LAS unsigned char* base, int pitch, int k0, int r0, int lane) {
    const int g = lane >> 4, i = lane & 15, q = i >> 2, p = i & 3, h = g >> 1;
    const LAS unsigned char* a = base + (k0 + (PERM ? 4 : 8) * h + q) * pitch + (r0 + 16 * (g & 1) + 4 * p) * 2;
    const s16x4 lo = tr16(a), hi = tr16(a + (PERM ? 8 : 4) * pitch);
    return __builtin_shufflevector(lo, hi, 0, 1, 2, 3, 4, 5, 6, 7);
}
__device__ __forceinline__ bf16x8 pack_step(const f32x16& x, int s) {
    u32x4 p; p.x = cvtpk(x[8 * s + 0], x[8 * s + 1]); p.y = cvtpk(x[8 * s + 2], x[8 * s + 3]); p.z = cvtpk(x[8 * s + 4], x[8 * s + 5]); p.w = cvtpk(x[8 * s + 6], x[8 * s + 7]);
    return __builtin_bit_cast(bf16x8, p);
}
__device__ __forceinline__ f32x16 zero16() { f32x16 z; for (int i = 0; i < 16; ++i) z[i] = 0.f; return z; }
constexpr int TP = 272;
constexpr int TILE_B = 128 * TP;
__device__ __forceinline__ void load_tile128(LAS unsigned char* dst, const bf16* src, size_t ld, int tid) {
    u32x4 t[4];
#pragma unroll
    for (int it = 0; it < 4; ++it) { const int idx = tid + NTHR * it, row = idx >> 4, ch = idx & 15; t[it] = *(const u32x4*)(src + (size_t)row * ld + ch * 8); }
    asm volatile("" ::: "memory");
#pragma unroll
    for (int it = 0; it < 4; ++it) { const int idx = tid + NTHR * it, row = idx >> 4, ch = idx & 15; *(LAS u32x4*)(dst + row * TP + ch * 16) = t[it]; }
}
__device__ __forceinline__ void tile3_fetch(u32x4 (&t)[3][4], const bf16* s0, const bf16* s1, const bf16* s2, size_t ld, int tid) {
#pragma unroll
    for (int it = 0; it < 4; ++it) { const int idx = tid + NTHR * it, row = idx >> 4, ch = idx & 15; const size_t o = (size_t)row * ld + ch * 8;
        t[0][it] = *(const u32x4*)(s0 + o); t[1][it] = *(const u32x4*)(s1 + o); t[2][it] = *(const u32x4*)(s2 + o); }
}
__device__ __forceinline__ void tile3_store(const u32x4 (&t)[3][4], LAS unsigned char* d0, LAS unsigned char* d1, LAS unsigned char* d2, int tid) {
#pragma unroll
    for (int it = 0; it < 4; ++it) { const int idx = tid + NTHR * it, row = idx >> 4, ch = idx & 15; const int o = row * TP + ch * 16;
        *(LAS u32x4*)(d0 + o) = t[0][it]; *(LAS u32x4*)(d1 + o) = t[1][it]; *(LAS u32x4*)(d2 + o) = t[2][it]; }
}

__device__ __forceinline__ void swa_unit(Frame& F, int layer, int unit) {
    const bf16* QK = wsp<bf16>(F, WS_QKR); const bf16* P = wsp<bf16>(F, WS_P);
    LAS unsigned char* Qt = F.lds; LAS unsigned char* Kt = F.lds + TILE_B; LAS unsigned char* Vt = F.lds + 2 * TILE_B;
    LAS float* stat = (LAS float*)(F.lds + 3 * TILE_B) + F.wave * 32;
    const int lane = F.lane, h = lane >> 5, wi = F.wave & 3, wh = F.wave >> 2;
    int b, qh, n, qrow0; bool isctx;
    if (unit < 512) { b = unit >> 7; qh = (unit >> 4) & 7; n = unit & 15; qrow0 = b * TL + n * 128; isctx = false; }
    else { const int u = unit - 512; b = u >> 4; qh = (u >> 1) & 7; n = u & 1; qrow0 = ML + b * TCX + n * 128; isctx = true; }
    const int kvh = qh >> 2;
    LB();
    load_tile128(Qt, QK + (size_t)qrow0 * NQK + qh * 128, NQK, F.tid);
    LB();
    bf16x8 qf[8];
#pragma unroll
    for (int ks = 0; ks < 8; ++ks) qf[ks] = frag_rm(Qt, TP, 32 * wi, 16 * ks, lane);
    const float L2E = 1.4426950408889634f, SC = 0.08838834764831845f * L2E;
    float m = inp(F, I_SINK)[layer * 8 + qh] * L2E, l = h == 0 ? 1.0f : 0.0f;
    f32x16 O0 = zero16(), O1 = zero16();
    const int iq = 32 * wi + (lane & 31);
    const int nch = isctx ? 2 : 5;
    auto chunk_info = [&](int c, int& krow0, int& mtype) -> bool {
        mtype = 0;
        if (isctx) { krow0 = ML + b * TCX + c * 128; return true; }
        if (c < 3) { const int kb = n - 1 + c; if (kb < 0 || kb > 15) return false; krow0 = b * TL + kb * 128; mtype = c == 0 ? 1 : (c == 2 ? 2 : 0); return true; }
        krow0 = ML + b * TCX + (c - 3) * 128; return true;
    };
    u32x4 pk[4], pv[4];
    auto fetch = [&](int krow0) {
#pragma unroll
        for (int it = 0; it < 4; ++it) { const int idx = F.tid + NTHR * it, row = idx >> 4, ch = idx & 15;
            pk[it] = *(const u32x4*)(QK + (size_t)(krow0 + row) * NQK + 1024 + kvh * 128 + ch * 8); pv[it] = *(const u32x4*)(P + (size_t)(krow0 + row) * LDP + C_SWA + 1280 + kvh * 128 + ch * 8); }
    };
    int c = 0, krow0 = 0, mtype = 0;
    while (!chunk_info(c, krow0, mtype)) ++c;
    fetch(krow0);
    while (c < nch) {
        const int mt = mtype;
        LB();
#pragma unroll
        for (int it = 0; it < 4; ++it) { const int idx = F.tid + NTHR * it, row = idx >> 4, ch = idx & 15; *(LAS u32x4*)(Kt + row * TP + ch * 16) = pk[it]; *(LAS u32x4*)(Vt + row * TP + ch * 16) = pv[it]; }
        LB();
        ++c; while (c < nch && !chunk_info(c, krow0, mtype)) ++c;
        if (c < nch) fetch(krow0);
        for (int kb = 0; kb < 4; ++kb) {
            f32x16 X = zero16();
#pragma unroll
            for (int ks = 0; ks < 8; ++ks) X = MFMA32(frag_rm(Kt, TP, 32 * kb, 16 * ks, lane), qf[ks], X);
            float bm = -INFINITY;
            int iql = iq - 32 * kb; asm volatile("" : "+v"(iql));
#pragma unroll
            for (int r = 0; r < 16; ++r) { const int d = iql - crow(r, h); float s = X[r] * SC;
                const bool ok = mt == 0 || (mt == 1 ? d <= 0 : d >= 0);
                s = ok ? s : -INFINITY; X[r] = s; bm = fmaxf(bm, s); }
            bm = fmaxf(bm, shx(bm, 32, lane));
            const float mn = fmaxf(m, bm), sc = __builtin_amdgcn_exp2f(m - mn); m = mn;
            float ps = 0.f;
#pragma unroll
            for (int r = 0; r < 16; ++r) { const float p = __builtin_amdgcn_exp2f(X[r] - mn); X[r] = p; ps += p; }
            l = l * sc + ps;
            const bf16x8 pa0 = pack_step(X, 0), pa1 = pack_step(X, 1);
            if (h == 0) stat[lane] = sc;
            LDS_WAIT();
#pragma unroll
            for (int g = 0; g < 4; ++g) { const f32x4 sv = *(const LAS f32x4*)(stat + 8 * g + 4 * h);
#pragma unroll
                for (int e = 0; e < 4; ++e) { O0[4 * g + e] *= sv[e]; O1[4 * g + e] *= sv[e]; } }
            O0 = MFMA32(pa0, frag_tr<true>(Vt, TP, 32 * kb, 64 * wh, lane), O0);
            O0 = MFMA32(pa1, frag_tr<true>(Vt, TP, 32 * kb + 16, 64 * wh, lane), O0);
            O1 = MFMA32(pa0, frag_tr<true>(Vt, TP, 32 * kb, 64 * wh + 32, lane), O1);
            O1 = MFMA32(pa1, frag_tr<true>(Vt, TP, 32 * kb + 16, 64 * wh + 32, lane), O1);
        }
    }
    l += shx(l, 32, lane);
    if (h == 0) stat[lane] = 1.0f / l;
    LDS_WAIT();
    bf16* yo = wsp<bf16>(F, WS_Y) + (size_t)(qrow0 + 32 * wi) * 3072 + 1024 + qh * 128 + 64 * wh + (lane & 31);
#pragma unroll
    for (int g = 0; g < 4; ++g) { const f32x4 sv = *(const LAS f32x4*)(stat + 8 * g + 4 * h);
#pragma unroll
        for (int e = 0; e < 4; ++e) { const int r = 8 * g + 4 * h + e; yo[(size_t)r * 3072] = (bf16)f2bf(O0[4 * g + e] * sv[e]); yo[(size_t)r * 3072 + 32] = (bf16)f2bf(O1[4 * g + e] * sv[e]); } }
}

constexpr size_t ST_CHUNK = (size_t)128 * 128;
__device__ __forceinline__ int ret_chunk_row0(int b, int jF) { return jF < 2 ? ML + b * TCX + jF * 128 : b * TL + (jF - 2) * 128; }
__device__ __forceinline__ void ret_state_unit(Frame& F, int layer, int unit) {
    const int dvq = unit & 3, dir = (unit >> 2) & 1, hh = (unit >> 3) & 7, b = unit >> 6;
    const bf16* P = wsp<bf16>(F, WS_P);
    bf16* ST = wsp<bf16>(F, WS_ST) + ((size_t)((b * 8 + hh) * 2 + dir) * 18) * ST_CHUNK;
    const float gam = sigm(inp(F, I_RETDEC)[(layer * 2 + dir) * 8 + hh]); const float lg2 = __builtin_amdgcn_logf(gam);
    const float gC = __builtin_amdgcn_exp2f(lg2 * 128.0f);
    LAS unsigned char* Kt = F.lds; LAS unsigned char* Vt = F.lds + TILE_B;
    constexpr int VP = 80;
    const int lane = F.lane, h = lane >> 5, w = F.wave;
    f32x16 acc = zero16();
    const float vfac = __builtin_amdgcn_exp2f(lg2 * (float)(127 - (F.tid >> 2))) * 0.08838834764831845f;
    u32x4 pkA[4], pvA, pkB[4], pvB;
#define RS_FETCH(c_, pk_, pv_) do { const int jf_ = dir == 0 ? (c_) : ((c_) < 2 ? 1 - (c_) : 19 - (c_)); const int r0_ = ret_chunk_row0(b, jf_); \
        _Pragma("unroll") for (int it = 0; it < 4; ++it) { const int idx = F.tid + NTHR * it, tp = idx >> 4, ch = idx & 15; const int row = r0_ + (dir ? 127 - tp : tp); \
            pk_[it] = *(const u32x4*)(P + (size_t)row * LDP + C_RET + 1024 + hh * 128 + ch * 8); } \
        { const int tp = F.tid >> 2, ch = F.tid & 3; const int row = r0_ + (dir ? 127 - tp : tp); \
          pv_ = *(const u32x4*)(P + (size_t)row * LDP + C_RET + 2048 + hh * 128 + dvq * 32 + ch * 8); } } while (0)
#define RS_STEP(c_, pk_, pv_) do { const int jF = dir == 0 ? (c_) : ((c_) < 2 ? 1 - (c_) : 19 - (c_)); \
        LB(); \
        _Pragma("unroll") for (int it = 0; it < 4; ++it) { const int idx = F.tid + NTHR * it, tp = idx >> 4, ch = idx & 15; *(LAS u32x4*)(Kt + tp * TP + ch * 16) = pk_[it]; } \
        { const int tp = F.tid >> 2, ch = F.tid & 3; u32x4 q_; \
          _Pragma("unroll") for (int e = 0; e < 4; ++e) q_[e] = cvtpk(bf_lo(pv_[e]) * vfac, bf_hi(pv_[e]) * vfac); \
          *(LAS u32x4*)(Vt + tp * VP + ch * 16) = q_; } \
        LB(); \
        if ((c_) + 2 < 18) RS_FETCH((c_) + 2, pk_, pv_); \
        if (w < 4) { \
            bf16* so = ST + (size_t)jF * ST_CHUNK + (size_t)(dvq * 32) * 128 + 32 * w + (lane & 31); \
            _Pragma("unroll") for (int r = 0; r < 16; ++r) so[(size_t)crow(r, h) * 128] = (bf16)f2bf(acc[r]); \
            _Pragma("unroll") for (int r = 0; r < 16; ++r) acc[r] *= gC; \
            _Pragma("unroll") for (int ks = 0; ks < 8; ++ks) acc = MFMA32(frag_tr<false>(Vt, VP, 16 * ks, 0, lane), frag_tr<false>(Kt, TP, 16 * ks, 32 * w, lane), acc); \
        } } while (0)
    RS_FETCH(0, pkA, pvA); RS_FETCH(1, pkB, pvB);
#pragma unroll 1
    for (int c = 0; c < 18; c += 2) { RS_STEP(c, pkA, pvA); RS_STEP(c + 1, pkB, pvB); }
#undef RS_FETCH
#undef RS_STEP
    LB();
}
__device__ __forceinline__ void ret_out_unit(Frame& F, int layer, int unit) {
    const int jF = unit % 18, hh = (unit / 18) & 7, b = unit / 144;
    const bf16* P = wsp<bf16>(F, WS_P);
    const int row0 = ret_chunk_row0(b, jF);
    LAS unsigned char* Qt = F.lds; LAS unsigned char* Kt = F.lds + TILE_B; LAS unsigned char* Vt = F.lds + 2 * TILE_B;
    const int lane = F.lane, h = lane >> 5, wi = F.wave & 3, wh = F.wave >> 2;
    const float lgf = __builtin_amdgcn_logf(sigm(inp(F, I_RETDEC)[(layer * 2 + 0) * 8 + hh])), lgb = __builtin_amdgcn_logf(sigm(inp(F, I_RETDEC)[(layer * 2 + 1) * 8 + hh]));
    LB();
    u32x4 tq[3][4];
    tile3_fetch(tq, P + (size_t)row0 * LDP + C_RET + hh * 128, P + (size_t)row0 * LDP + C_RET + 1024 + hh * 128, P + (size_t)row0 * LDP + C_RET + 2048 + hh * 128, LDP, F.tid);
    u32x4 psf[4], psb[4];
    { const bf16* Sf = wsp<bf16>(F, WS_ST) + ((size_t)((b * 8 + hh) * 2 + 0) * 18 + jF) * ST_CHUNK; const bf16* Sb = wsp<bf16>(F, WS_ST) + ((size_t)((b * 8 + hh) * 2 + 1) * 18 + jF) * ST_CHUNK;
#pragma unroll
      for (int it = 0; it < 4; ++it) { const int idx = F.tid + NTHR * it, row = idx >> 4, ch = idx & 15; psf[it] = *(const u32x4*)(Sf + (size_t)row * 128 + ch * 8); psb[it] = *(const u32x4*)(Sb + (size_t)row * 128 + ch * 8); } }
    asm volatile("" ::: "memory");
    tile3_store(tq, Qt, Kt, Vt, F.tid);
    LB();
    f32x16 Y0 = zero16(), Y1 = zero16();
    const int iq = 32 * wi + (lane & 31);
    for (int jb = 0; jb < 4; ++jb) {
        f32x16 X = zero16();
#pragma unroll
        for (int ks = 0; ks < 8; ++ks) X = MFMA32(frag_rm(Kt, TP, 32 * jb, 16 * ks, lane), frag_rm(Qt, TP, 32 * wi, 16 * ks, lane), X);
        int iql = iq - 32 * jb; asm volatile("" : "+v"(iql));
#pragma unroll
        for (int r = 0; r < 16; ++r) { const int d = iql - crow(r, h); const int ad = d < 0 ? -d : d;
            const float wgt = __builtin_amdgcn_exp2f((d > 0 ? lgf : lgb) * (float)ad) * (d == 0 ? 2.0f : 1.0f);
            X[r] *= wgt * 0.08838834764831845f; }
        const bf16x8 pa0 = pack_step(X, 0), pa1 = pack_step(X, 1);
        Y0 = MFMA32(pa0, frag_tr<true>(Vt, TP, 32 * jb, 64 * wh, lane), Y0);
        Y0 = MFMA32(pa1, frag_tr<true>(Vt, TP, 32 * jb + 16, 64 * wh, lane), Y0);
        Y1 = MFMA32(pa0, frag_tr<true>(Vt, TP, 32 * jb, 64 * wh + 32, lane), Y1);
        Y1 = MFMA32(pa1, frag_tr<true>(Vt, TP, 32 * jb + 16, 64 * wh + 32, lane), Y1);
    }
    LB();
#pragma unroll
    for (int it = 0; it < 4; ++it) { const int idx = F.tid + NTHR * it, row = idx >> 4, ch = idx & 15; *(LAS u32x4*)(Kt + row * TP + ch * 16) = psf[it]; *(LAS u32x4*)(Vt + row * TP + ch * 16) = psb[it]; }
    LB();
    {
        f32x16 T0 = zero16(), T1 = zero16(), U0 = zero16(), U1 = zero16();
#pragma unroll
        for (int ks = 0; ks < 8; ++ks) { const bf16x8 a = frag_rm(Qt, TP, 32 * wi, 16 * ks, lane);
            T0 = MFMA32(a, frag_rm(Kt, TP, 64 * wh, 16 * ks, lane), T0); T1 = MFMA32(a, frag_rm(Kt, TP, 64 * wh + 32, 16 * ks, lane), T1);
            U0 = MFMA32(a, frag_rm(Vt, TP, 64 * wh, 16 * ks, lane), U0); U1 = MFMA32(a, frag_rm(Vt, TP, 64 * wh + 32, 16 * ks, lane), U1); }
#pragma unroll
        for (int r = 0; r < 16; ++r) { const int i = 32 * wi + crow(r, h);
            const float ff = __builtin_amdgcn_exp2f(lgf * (float)(i + 1)), fb = __builtin_amdgcn_exp2f(lgb * (float)(128 - i));
            Y0[r] += ff * T0[r] + fb * U0[r]; Y1[r] += ff * T1[r] + fb * U1[r]; }
    }
    LB();
    LAS float* yl = (LAS float*)F.lds;
#pragma unroll
    for (int r = 0; r < 16; ++r) { const int i = 32 * wi + crow(r, h); yl[i * 132 + 64 * wh + (lane & 31)] = Y0[r]; yl[i * 132 + 64 * wh + 32 + (lane & 31)] = Y1[r]; }
    LB();
    { const int i = F.tid >> 2, part = F.tid & 3; const LAS float* yr = yl + i * 132 + 32 * part;
      f32x4 v[8]; float s = 0.f;
#pragma unroll
      for (int e = 0; e < 8; ++e) { v[e] = *(const LAS f32x4*)(yr + 4 * e); s += (v[e].x + v[e].y) + (v[e].z + v[e].w); }
      s += shx(s, 1, lane); s += shx(s, 2, lane); const float mean = s * (1.0f / 128.0f); float q = 0.f;
#pragma unroll
      for (int e = 0; e < 8; ++e) { v[e] = v[e] - mean; q += (v[e].x * v[e].x + v[e].y * v[e].y) + (v[e].z * v[e].z + v[e].w * v[e].w); }
      q += shx(q, 1, lane); q += shx(q, 2, lane); const float rs = __builtin_amdgcn_rsqf(q * (1.0f / 128.0f) + 1e-5f);
      const bf16* gp = P + (size_t)(row0 + i) * LDP + C_RET + 3072 + hh * 128 + 32 * part; bf16* yo = wsp<bf16>(F, WS_Y) + (size_t)(row0 + i) * 3072 + hh * 128 + 32 * part;
#pragma unroll
      for (int e2 = 0; e2 < 4; ++e2) { const u32x4 gw = *(const u32x4*)(gp + 8 * e2); u32x4 ow;
#pragma unroll
          for (int e = 0; e < 4; ++e) { const float g0 = bf_lo(gw[e]), g1 = bf_hi(gw[e]); const int vi = 2 * e2 + (e >> 1), vo = 2 * (e & 1);
              ow[e] = cvtpk(g0 * sigm(g0) * v[vi][vo] * rs, g1 * sigm(g1) * v[vi][vo + 1] * rs); }
          *(u32x4*)(yo + 8 * e2) = ow; } }
}

#ifdef RW_DEBUG
constexpr size_t WS_DBGY = WS_END2;
struct RwPre { f32x4 r4, k4, v4, lw, la; };
__device__ __forceinline__ void rwkv_scan_unit(Frame& F, int layer, int unit) {
    const int rh = unit & 1, dir = (unit >> 1) & 1, h = (unit >> 2) & 15, b = unit >> 6;
    constexpr int BUF = 6 * 2048 + 1024;
    LAS float* const base = (LAS float*)F.lds;
    const float* XS = wsp<float>(F, WS_XS); const float* LR = wsp<float>(F, WS_LR); float* YD = wsp<float>(F, WS_DBGY) + (size_t)dir * MT * BW;
    const int vrow = F.tid >> 4, kq = F.tid & 15;
    const int ptok = F.tid >> 4, pj = (F.tid & 15) * 4, pc = h * 64 + pj;
    const f32x4 w0v = *(const f32x4*)(inp(F, I_W0) + ((size_t)layer * 2 + dir) * BW + pc), a0v = *(const f32x4*)(inp(F, I_A0) + ((size_t)layer * 2 + dir) * BW + pc);
    const f32x4 kkv = *(const f32x4*)(inp(F, I_KK) + (size_t)layer * BW + pc), kav = *(const f32x4*)(inp(F, I_KA) + (size_t)layer * BW + pc);
    auto fetch = [&](int blk, RwPre& p) {
        const int row = scan_row(b, dir, blk * SCAN_BLK + ptok);
        p.r4 = *(const f32x4*)(XS + (size_t)row * 3072 + pc); p.k4 = *(const f32x4*)(XS + (size_t)row * 3072 + 1024 + pc); p.v4 = *(const f32x4*)(XS + (size_t)row * 3072 + 2048 + pc);
        p.lw = *(const f32x4*)(LR + (size_t)row * NLR + dir * 1024 + pc); p.la = *(const f32x4*)(LR + (size_t)row * NLR + 2048 + dir * 1024 + pc);
    };
    auto derive = [&](const RwPre& p, LAS float* buf) {
        f32x4 dec, av, kk, kd; float ssq = 0.f;
#pragma unroll
        for (int e = 0; e < 4; ++e) { dec[e] = fexp(-0.6065306597126334f * sigm(w0v[e] + p.lw[e])); av[e] = sigm(a0v[e] + p.la[e]); kk[e] = p.k4[e] * kkv[e]; ssq += kk[e] * kk[e];
            kd[e] = p.k4[e] * (1.0f + (av[e] - 1.0f) * kav[e]); }
        ssq += __int_as_float(__builtin_amdgcn_update_dpp(0, __float_as_int(ssq), 0xB1, 0xF, 0xF, true));
        ssq += __int_as_float(__builtin_amdgcn_update_dpp(0, __float_as_int(ssq), 0x4E, 0xF, 0xF, true));
        ssq += __int_as_float(__builtin_amdgcn_update_dpp(0, __float_as_int(ssq), 0x141, 0xF, 0xF, true));
        ssq += __int_as_float(__builtin_amdgcn_update_dpp(0, __float_as_int(ssq), 0x140, 0xF, 0xF, true));
        const float inv = __builtin_amdgcn_rsqf(fmaxf(ssq, 1e-24f));
        f32x4 an, bn;
#pragma unroll
        for (int e = 0; e < 4; ++e) { const float kn = kk[e] * inv; an[e] = -kn; bn[e] = kn * av[e]; }
        const int o = ptok * 64 + pj;
        *(LAS f32x4*)(buf + o) = p.r4; *(LAS f32x4*)(buf + 2048 + o) = dec; *(LAS f32x4*)(buf + 4096 + o) = kd; *(LAS f32x4*)(buf + 6144 + o) = p.v4; *(LAS f32x4*)(buf + 8192 + o) = an; *(LAS f32x4*)(buf + 10240 + o) = bn;
    };
    f32x2 S0 = {0.f, 0.f}, S1 = S0;
    RwPre pre;
    __syncthreads();
    fetch(0, pre); derive(pre, base);
    __syncthreads();
    constexpr int NBLK = NSTEP / SCAN_BLK;
    for (int blk = 0; blk < NBLK; ++blk) {
        LAS float* cur = base + (blk & 1) * BUF; LAS float* nxt = base + ((blk + 1) & 1) * BUF;
        if (blk + 1 < NBLK) fetch(blk + 1, pre);
        const LAS float* Rl = cur; const LAS float* Wl = cur + 2048; const LAS float* Kl = cur + 4096; const LAS float* Vl = cur + 6144; const LAS float* Al = cur + 8192; const LAS float* Bl = cur + 10240; LAS float* Yl = cur + 12288;
        const int ob = 4 * kq, vb = 32 * rh + vrow;
        f32x4 a0 = *(const LAS f32x4*)(Al + ob), w0 = *(const LAS f32x4*)(Wl + ob), b0 = *(const LAS f32x4*)(Bl + ob), k0 = *(const LAS f32x4*)(Kl + ob), r0 = *(const LAS f32x4*)(Rl + ob);
        float vv = Vl[vb];
#pragma unroll 8
        for (int tok = 0; tok < SCAN_BLK; ++tok) {
            const int on = ((tok + 1) & (SCAN_BLK - 1)) * 64;
            const f32x4 a1 = *(const LAS f32x4*)(Al + on + ob), w1 = *(const LAS f32x4*)(Wl + on + ob), b1 = *(const LAS f32x4*)(Bl + on + ob), k1 = *(const LAS f32x4*)(Kl + on + ob), r1 = *(const LAS f32x4*)(Rl + on + ob);
            const float vn = Vl[on + vb];
            f32x2 t = S0 * a0.xy; t += S1 * a0.zw;
            const float sa = red16(t.x + t.y);
            const f32x2 sa2 = {sa, sa}, vv2 = {vv, vv};
            S0 = S0 * w0.xy + (sa2 * b0.xy + vv2 * k0.xy); S1 = S1 * w0.zw + (sa2 * b0.zw + vv2 * k0.zw);
            f32x2 u = S0 * r0.xy; u += S1 * r0.zw;
            const float y = red16(u.x + u.y);
            Yl[tok * 32 + vrow] = y;
            a0 = a1; w0 = w1; b0 = b1; k0 = k1; r0 = r1; vv = vn;
        }
        if (blk + 1 < NBLK) derive(pre, nxt);
        __syncthreads();
        if (F.tid < 256) { const int e = F.tid * 4, tok = e >> 5, j = e & 31; const int row = scan_row(b, dir, blk * SCAN_BLK + tok);
          *(f32x4*)(YD + (size_t)row * BW + h * 64 + 32 * rh + j) = *(const LAS f32x4*)(Yl + e); }
    }
    __syncthreads();
}
#endif
__device__ __forceinline__ const float* vecp(const Frame& F, int layer, int v) { return wsp<float>(F, WS_VEC) + ((size_t)layer * 8 + v) * 1024; }
constexpr int RW_NCH = 36, RW_NU = NB * 16 * 2 * RW_NCH;
constexpr int RWP = 144;
constexpr int RWS = 64 * RWP;
__device__ __forceinline__ int rw_row0(int b, int jF) { return jF < 4 ? ML + b * TCX + 64 * jF : b * TL + 64 * (jF - 4); }
enum { RM = 0, TR = 1 };
template <int AM, int BM_> __device__ __forceinline__ f32x16 mm64(const LAS unsigned char* A, const LAS unsigned char* B, int tb, int sb, int lane, f32x16 acc) {
#pragma unroll
    for (int ks = 0; ks < 4; ++ks) {
        const bf16x8 a = AM == RM ? frag_rm(A, RWP, 32 * tb, 16 * ks, lane) : frag_tr<false>(A, RWP, 16 * ks, 32 * tb, lane);
        const bf16x8 b = BM_ == RM ? frag_rm(B, RWP, 32 * sb, 16 * ks, lane) : frag_tr<false>(B, RWP, 16 * ks, 32 * sb, lane);
        acc = MFMA32(a, b, acc); }
    return acc;
}
__device__ __forceinline__ void store_tile_bf16(LAS unsigned char* T, const f32x16& x, int tb, int sb, int lane) {
    const int h = lane >> 5; LAS unsigned short* p = (LAS unsigned short*)(T + (32 * tb) * RWP) + 32 * sb + (lane & 31);
#pragma unroll
    for (int r = 0; r < 16; ++r) p[crow(r, h) * (RWP / 2)] = (unsigned short)(cvtpk(x[r], 0.f) & 0xffffu);
}
__device__ __forceinline__ bf16x8 gfrag_perm(const bf16* X, int ld, int m0, int k0, int lane) {
    const bf16* p = X + (size_t)(m0 + (lane & 31)) * ld + k0 + 4 * (lane >> 5);
    const u32x2 lo = *(const u32x2*)p, hi = *(const u32x2*)(p + 8);
    u32x4 w; w.x = lo.x; w.y = lo.y; w.z = hi.x; w.w = hi.y; return __builtin_bit_cast(bf16x8, w);
}
template <bool REV> __device__ __forceinline__ void tri_inv16(const LAS float* AD, LAS unsigned char* T, int lane_) {
    int lane = lane_; asm volatile("" : "+v"(lane));
    const int blk = lane >> 4, j = lane & 15; const LAS float* A = AD + blk * 16 * 20;
    float x[16];
#pragma unroll
    for (int i = 0; i < 16; ++i) { const int t = REV ? 15 - i : i; float a0 = (j == t) ? 1.0f : 0.0f, a1 = 0.0f;
#pragma unroll
        for (int s4 = 0; s4 < 16; s4 += 4) { if (REV ? (s4 + 3 > t) : (s4 < t)) { const f32x4 a = *(const LAS f32x4*)(A + t * 20 + s4);
#pragma unroll
                for (int e = 0; e < 4; ++e) { const int s = s4 + e; if (REV ? (s > t) : (s < t)) { if (e & 1) a1 = fmaf(a[e], x[s], a1); else a0 = fmaf(a[e], x[s], a0); } } } }
        x[t] = a0 + a1; asm volatile("" ::: "memory"); }
    LAS unsigned short* tp = (LAS unsigned short*)T + (16 * blk) * (RWP / 2) + 16 * blk + j;
#pragma unroll
    for (int s = 0; s < 16; ++s) tp[s * (RWP / 2)] = (unsigned short)(cvtpk(x[s], 0.f) & 0xffffu);
}
struct RwIn { u32x4 x[3]; u32x4 l[2]; float vn; };
__device__ __forceinline__ void rw_fetch_x(Frame& F, int unit, int tid, RwIn& p) {
    const int jF = unit % RW_NCH, hh = (unit / RW_NCH) & 15, b = unit / (RW_NCH * 16);
    const bf16* xr = wsp<bf16>(F, WS_XS) + (size_t)(rw_row0(b, jF) + (tid >> 3)) * 3072 + hh * 64 + (tid & 7) * 8;
    p.x[0] = *(const u32x4*)xr; p.x[1] = *(const u32x4*)(xr + 1024); p.x[2] = *(const u32x4*)(xr + 2048);
}
__device__ __forceinline__ void rw_fetch_l(Frame& F, int unit, int dir, int tid, RwIn& p) {
    const int jF = unit % RW_NCH, hh = (unit / RW_NCH) & 15, b = unit / (RW_NCH * 16);
    const bf16* lr = wsp<bf16>(F, WS_LR) + (size_t)(rw_row0(b, jF) + (tid >> 3)) * NLR + dir * 1024 + hh * 64 + (tid & 7) * 8;
    p.l[0] = *(const u32x4*)lr; p.l[1] = *(const u32x4*)(lr + 2048);
}
__device__ __forceinline__ void rw_fetch_v(Frame& F, int layer, int unit, int tid, RwIn& p) {
    const int hh = (unit / RW_NCH) & 15; const int v = tid >> 6; p.vn = vecp(F, layer, v < 6 ? v : 5)[hh * 64 + (tid & 63)];
}
__device__ __forceinline__ void rw_local_unit(Frame& F, int layer, int unit, int unit_next, RwIn& in) {
    const int jF = unit % RW_NCH, hh = (unit / RW_NCH) & 15, b = unit / (RW_NCH * 16);
    const int row0 = rw_row0(b, jF);
    LAS unsigned char* const L = F.lds;
    LAS unsigned char* sAh = L; LAS unsigned char* sRh = L + RWS; LAS unsigned char* sBh = L + 2 * RWS; LAS unsigned char* sKh = L + 3 * RWS; LAS unsigned char* sBt = L + 4 * RWS; LAS unsigned char* sKt = L + 5 * RWS;
    LAS unsigned char* sV = L + 6 * RWS; LAS unsigned char* sAAK = L + 7 * RWS; LAS unsigned char* sARB = L + 8 * RWS; LAS unsigned char* sARK = L + 9 * RWS; LAS unsigned char* sPm = L + 10 * RWS; LAS unsigned char* sTm = L + 11 * RWS;
    LAS unsigned char* sM1 = sAAK; LAS unsigned char* sVT = sKh; LAS unsigned char* sWW = sPm;
    LAS unsigned char* sTm2 = L + 12 * RWS;
    LAS float* VLh = (LAS float*)(L + 13 * RWS + 9216);
    LAS float* CL = (LAS float*)(L + 13 * RWS);
    const int w = F.wave, grp = w >> 2, tb = (w >> 1) & 1, sb = w & 1;
    float r8[8], k8[8], kn8[8];
    { int tl_ = F.tid; asm volatile("" : "+v"(tl_)); const int t = tl_ >> 3, j0 = (tl_ & 7) * 8;
      if (tl_ < 384) VLh[tl_] = in.vn;
      LB();
      const u32x4 rw_ = in.x[0], kw_ = in.x[1]; f32x4 ra, rb, ka, kb;
#pragma unroll
      for (int e = 0; e < 2; ++e) { ra[2 * e] = bf_lo(rw_[e]); ra[2 * e + 1] = bf_hi(rw_[e]); rb[2 * e] = bf_lo(rw_[2 + e]); rb[2 * e + 1] = bf_hi(rw_[2 + e]); ka[2 * e] = bf_lo(kw_[e]); ka[2 * e + 1] = bf_hi(kw_[e]); kb[2 * e] = bf_lo(kw_[2 + e]); kb[2 * e + 1] = bf_hi(kw_[2 + e]); }
      const f32x4 kka = *(const LAS f32x4*)(VLh + 4 * 64 + j0), kkb = *(const LAS f32x4*)(VLh + 4 * 64 + j0 + 4);
      float ssq = 0.f;
#pragma unroll
      for (int e = 0; e < 4; ++e) { r8[e] = ra[e]; r8[4 + e] = rb[e]; k8[e] = ka[e]; k8[4 + e] = kb[e]; kn8[e] = ka[e] * kka[e]; kn8[4 + e] = kb[e] * kkb[e]; }
#pragma unroll
      for (int e = 0; e < 8; ++e) ssq += kn8[e] * kn8[e];
      ssq = red8(ssq); const float inv = __builtin_amdgcn_rsqf(fmaxf(ssq, 1e-24f));
#pragma unroll
      for (int e = 0; e < 8; ++e) kn8[e] *= inv;
      *(LAS u32x4*)(sV + t * RWP + j0 * 2) = in.x[2]; }
    for (int dir = 0; dir < 2; ++dir) {
        const int ui = ((b * 16 + hh) * 2 + dir) * RW_NCH + jF;
        int tl_ = F.tid; asm volatile("" : "+v"(tl_)); const int t = tl_ >> 3, j0 = (tl_ & 7) * 8, c0 = hh * 64 + j0;
        float lw8[8], as8[8];
        { f32x4 wa, wb, aa, ab; { const u32x4 lw_ = in.l[0], la_ = in.l[1];
#pragma unroll
            for (int e = 0; e < 2; ++e) { wa[2 * e] = bf_lo(lw_[e]); wa[2 * e + 1] = bf_hi(lw_[e]); wb[2 * e] = bf_lo(lw_[2 + e]); wb[2 * e + 1] = bf_hi(lw_[2 + e]); aa[2 * e] = bf_lo(la_[e]); aa[2 * e + 1] = bf_hi(la_[e]); ab[2 * e] = bf_lo(la_[2 + e]); ab[2 * e + 1] = bf_hi(la_[2 + e]); } }
          const LAS float* w0p = VLh + dir * 64 + j0; const LAS float* a0p = VLh + (2 + dir) * 64 + j0;
          const f32x4 w0a = *(const LAS f32x4*)w0p, w0b = *(const LAS f32x4*)(w0p + 4), a0a = *(const LAS f32x4*)a0p, a0b = *(const LAS f32x4*)(a0p + 4);
#pragma unroll
          for (int e = 0; e < 4; ++e) { lw8[e] = -0.6065306597126334f * sigm(w0a[e] + wa[e]); lw8[4 + e] = -0.6065306597126334f * sigm(w0b[e] + wb[e]); as8[e] = sigm(a0a[e] + aa[e]); as8[4 + e] = sigm(a0b[e] + ab[e]); } }
        float cl8[8], ce8[8];
        { const int ln = F.lane;
#pragma unroll
          for (int e = 0; e < 8; ++e) cl8[e] = lw8[e];
#pragma unroll
          for (int d = 8; d < 64; d <<= 1) { const int src = dir ? ln + d : ln - d; const float msk = (src >= 0 && src < 64) ? 1.0f : 0.0f;
#pragma unroll
              for (int e = 0; e < 8; ++e) cl8[e] = fmaf(lanefrom(cl8[e], src), msk, cl8[e]); }
          LAS float* WT = CL;
          if ((ln >> 3) == (dir ? 0 : 7)) { *(LAS f32x4*)(WT + w * 64 + j0) = (f32x4){cl8[0], cl8[1], cl8[2], cl8[3]}; *(LAS f32x4*)(WT + w * 64 + j0 + 4) = (f32x4){cl8[4], cl8[5], cl8[6], cl8[7]}; }
          LB();
#pragma unroll
          for (int e = 0; e < 8; ++e) ce8[e] = 0.f;
#pragma unroll
          for (int ww = 0; ww < 8; ++ww) { const f32x4 a = *(const LAS f32x4*)(WT + ww * 64 + j0), b2 = *(const LAS f32x4*)(WT + ww * 64 + j0 + 4); const float bm = (dir ? ww > w : ww < w) ? 1.0f : 0.0f;
#pragma unroll
              for (int e = 0; e < 4; ++e) { ce8[e] += a[e]; ce8[4 + e] += b2[e]; cl8[e] = fmaf(a[e], bm, cl8[e]); cl8[4 + e] = fmaf(b2[e], bm, cl8[4 + e]); } }
        }
        { const LAS float* kap = VLh + 5 * 64 + j0; const f32x4 kaa = *(const LAS f32x4*)kap, kab = *(const LAS f32x4*)(kap + 4);
          float oA[8], oR[8], oB[8], oK[8], oBt[8], oKt[8];
#pragma unroll
          for (int e = 0; e < 8; ++e) { const float cl = cl8[e], ce = ce8[e], kav = e < 4 ? kaa[e] : kab[e - 4];
              const float ex = fexp(cl), exm = fexp(-cl), exx = fexp(cl - lw8[e]), ext = fexp(ce - cl);
              const float kd = k8[e] * (1.0f + (as8[e] - 1.0f) * kav), bb = kn8[e] * as8[e];
              oA[e] = -kn8[e] * exx; oR[e] = r8[e] * ex; oB[e] = bb * exm; oK[e] = kd * exm; oBt[e] = bb * ext; oKt[e] = kd * ext; }
          const int o = t * RWP + j0 * 2;
#define RW_ST8(slot, a) do { u32x4 q_; q_.x = cvtpk(a[0], a[1]); q_.y = cvtpk(a[2], a[3]); q_.z = cvtpk(a[4], a[5]); q_.w = cvtpk(a[6], a[7]); *(LAS u32x4*)((slot) + o) = q_; } while (0)
          RW_ST8(sAh, oA); RW_ST8(sRh, oR); RW_ST8(sBh, oB); RW_ST8(sKh, oK); RW_ST8(sBt, oBt); RW_ST8(sKt, oKt);
#undef RW_ST8
        }
        if (t == 0) { float* gm = wsp<float>(F, WS_RWG) + (size_t)ui * 64 + j0;
            *(f32x4*)gm = (f32x4){fexp(ce8[0]), fexp(ce8[1]), fexp(ce8[2]), fexp(ce8[3])}; *(f32x4*)(gm + 4) = (f32x4){fexp(ce8[4]), fexp(ce8[5]), fexp(ce8[6]), fexp(ce8[7])}; }
        { const int un = unit_next >= 0 ? unit_next : unit; rw_fetch_x(F, un, tl_, in); rw_fetch_v(F, layer, un, tl_, in); rw_fetch_l(F, dir == 0 ? unit : un, dir == 0 ? 1 : 0, tl_, in); }
        LB();
#if defined(TS_DEBUG) && TS_SEL == 0
#endif
        int lane = F.lane; asm volatile("" : "+v"(lane)); const int h = lane >> 5;
        const int tq = 32 * tb + 4 * h, sq = 32 * sb + (lane & 31);
        LAS float* AD16 = CL + 1024;
        const int pB = dir ? 0 : 1, qB = 1 - pB;
        if (grp == 0) {
            f32x16 X1 = mm64<RM, RM>(sAh, sBh, tb, sb, lane, zero16()), X2 = mm64<RM, RM>(sAh, sKh, tb, sb, lane, zero16());
#pragma unroll
            for (int r = 0; r < 16; ++r) { const int d = (tq + (r & 3) + 8 * (r >> 2)) - sq; const bool keep = (dir ? -d : d) > 0; X1[r] = keep ? X1[r] : 0.f; X2[r] = keep ? X2[r] : 0.f; }
            store_tile_bf16(sAAK, X2, tb, sb, lane);
            { f32x16 AF; const int sl = lane & 31;
#pragma unroll
              for (int r = 0; r < 16; ++r) { const int tl = (r & 3) + 8 * (r >> 2) + 4 * h; const bool same16 = tb == sb && (tl >> 4) == (sl >> 4);
                  AF[r] = same16 ? 0.f : X1[r];
                  if (same16) AD16[((2 * tb + (tl >> 4)) * 16 + (tl & 15)) * 20 + (sl & 15)] = X1[r]; }
              store_tile_bf16(sPm, AF, tb, sb, lane); store_tile_bf16(sTm, zero16(), tb, sb, lane); }
            LB();
            if (w == 0) { if (dir == 0) tri_inv16<false>(AD16, sTm, lane); else tri_inv16<true>(AD16, sTm, lane); }
            LB();
            { f32x16 Mx = (tb == pB && sb == qB) ? zero16() : mm64<RM, TR>(sPm, sTm, tb, sb, lane, zero16());
#pragma unroll
              for (int r = 0; r < 16; ++r) { const int d = (tq + (r & 3) + 8 * (r >> 2)) - sq; Mx[r] += d == 0 ? 1.0f : 0.f; }
              store_tile_bf16(sBh, Mx, tb, sb, lane); }
            LB();
            { const f32x16 Tn = mm64<RM, TR>(sTm, sBh, tb, sb, lane, zero16()); store_tile_bf16(sTm2, Tn, tb, sb, lane); }
            LB();
            { f32x16 Mx = zero16();
              if (tb == pB && sb == qB) {
#pragma unroll
                  for (int ks = 0; ks < 2; ++ks) Mx = MFMA32(frag_rm(sPm, RWP, 32 * pB, 32 * qB + 16 * ks, lane), frag_tr<false>(sTm2, RWP, 32 * qB + 16 * ks, 32 * qB, lane), Mx); }
#pragma unroll
              for (int r = 0; r < 16; ++r) { const int d = (tq + (r & 3) + 8 * (r >> 2)) - sq; Mx[r] += d == 0 ? 1.0f : 0.f; }
              store_tile_bf16(sBh, Mx, tb, sb, lane); }
            LB();
            { const f32x16 Tn = mm64<RM, TR>(sTm2, sBh, tb, sb, lane, zero16()); store_tile_bf16(sTm, Tn, tb, sb, lane); }
            LB();
            { const f32x16 Wt = mm64<RM, TR>(sTm, sAh, tb, sb, lane, zero16()); store_tile_bf16(sWW, Wt, tb, sb, lane); }
            LB();
            asm volatile("" : "+v"(in.x[0]), "+v"(in.x[1]), "+v"(in.x[2]), "+v"(in.l[0]), "+v"(in.l[1]), "+v"(in.vn));
            { f32x16 QtT = mm64<TR, RM>(sWW, sARB, tb, sb, lane, zero16());
#pragma unroll
              for (int r = 0; r < 16; ++r) QtT[r] += bf2f(((const LAS unsigned short*)(sRh + sq * RWP))[32 * tb + crow(r, h)]);
              int l4 = lane; asm volatile("" : "+v"(l4));
              u32x4* qo = (u32x4*)(wsp<bf16>(F, WS_RWQ) + (size_t)ui * 4096) + ((sb * 2 + tb) * 2) * 64 + l4;
              qo[0] = __builtin_bit_cast(u32x4, pack_step(QtT, 0)); qo[64] = __builtin_bit_cast(u32x4, pack_step(QtT, 1));
              const f32x16 PpT = mm64<TR, TR>(sWW, sBt, tb, sb, lane, zero16());
              u32x4* po = (u32x4*)(wsp<bf16>(F, WS_RWP) + (size_t)ui * 4096) + ((sb * 2 + tb) * 2) * 64 + l4;
              po[0] = __builtin_bit_cast(u32x4, pack_step(PpT, 0)); po[64] = __builtin_bit_cast(u32x4, pack_step(PpT, 1)); }
            LB();
#if defined(TS_DEBUG) && TS_SEL == 1
#endif
        } else {
            f32x16 X1 = mm64<RM, RM>(sRh, sBh, tb, sb, lane, zero16()), X2 = mm64<RM, RM>(sRh, sKh, tb, sb, lane, zero16());
#pragma unroll
            for (int r = 0; r < 16; ++r) { const int d = (tq + (r & 3) + 8 * (r >> 2)) - sq; const bool keep = (dir ? -d : d) >= 0; X1[r] = keep ? X1[r] : 0.f; X2[r] = keep ? X2[r] : 0.f; }
            store_tile_bf16(sARB, X1, tb, sb, lane); store_tile_bf16(sARK, X2, tb, sb, lane);
            LB();
            X1 = mm64<RM, TR>(sAAK, sV, tb, sb, lane, zero16());
            f32x16 accY = mm64<RM, TR>(sARK, sV, tb, sb, lane, zero16()), accH = mm64<TR, TR>(sKt, sV, tb, sb, lane, zero16());
            LB();
            store_tile_bf16(sM1, X1, tb, sb, lane);
#pragma unroll 1
            for (int i = 0; i < 4; ++i) LB();
            { const f32x16 Vx = mm64<RM, TR>(sTm, sM1, tb, sb, lane, zero16()); store_tile_bf16(sVT, Vx, tb, sb, lane); }
            LB();
            asm volatile("" : "+v"(in.x[0]), "+v"(in.x[1]), "+v"(in.x[2]), "+v"(in.l[0]), "+v"(in.l[1]), "+v"(in.vn));
            accY = mm64<RM, TR>(sARB, sVT, tb, sb, lane, accY); accH = mm64<TR, TR>(sBt, sVT, tb, sb, lane, accH);
            int l4 = lane; asm volatile("" : "+v"(l4));
            u32x4* yo = (u32x4*)(wsp<bf16>(F, WS_RWY) + (size_t)ui * 4096 + (tb * 2 + sb) * 1024 + l4 * 16);
            u32x4* ho = (u32x4*)(wsp<bf16>(F, WS_RWH) + (size_t)ui * 4096 + (tb * 2 + sb) * 1024 + l4 * 16);
#pragma unroll
            for (int g = 0; g < 2; ++g) { u32x4 a, b2;
#pragma unroll
                for (int e = 0; e < 4; ++e) { a[e] = cvtpk(accY[8 * g + 2 * e], accY[8 * g + 2 * e + 1]); b2[e] = cvtpk(accH[8 * g + 2 * e], accH[8 * g + 2 * e + 1]); }
                yo[g] = a; ho[g] = b2; }
            LB();
        }
    }
}
constexpr int RWQ_SLOT = 13 * 1024, RWQ_WAVE = 3 * RWQ_SLOT;
__device__ __forceinline__ void rw_seq_task(Frame& F, int task, int lane, LAS unsigned char* ring) {
    const int vb = task & 1, dir = (task >> 1) & 1, bh = task >> 2, h = lane >> 5;
    auto issue = [&](int c) {
        const int jF = dir == 0 ? c : (c < 4 ? 3 - c : 39 - c); const size_t ui = (size_t)(bh * 2 + dir) * RW_NCH + jF;
        const char* pp = (const char*)(wsp<bf16>(F, WS_RWP) + ui * 4096) + lane * 16; const char* hp = (const char*)(wsp<bf16>(F, WS_RWH) + ui * 4096) + lane * 16; const char* gp = (const char*)(wsp<float>(F, WS_RWG) + ui * 64) + lane * 16;
        LAS unsigned char* sl = ring + (c % 3) * RWQ_SLOT;
#pragma unroll
        for (int i = 0; i < 8; ++i) __builtin_amdgcn_global_load_lds((const unsigned*)(pp + i * 1024), (LAS unsigned*)(sl + i * 1024), 16, 0, 0);
#pragma unroll
        for (int ko = 0; ko < 2; ++ko)
#pragma unroll
            for (int i = 0; i < 2; ++i) __builtin_amdgcn_global_load_lds((const unsigned*)(hp + (ko * 2 + vb) * 2048 + i * 1024), (LAS unsigned*)(sl + 8192 + ko * 2048 + i * 1024), 16, 0, 0);
        __builtin_amdgcn_global_load_lds((const unsigned*)gp, (LAS unsigned*)(sl + 12288), 16, 0, 0);
    };
    f32x16 S0 = zero16(), S1 = zero16();
    issue(0); issue(1);
#pragma unroll 1
    for (int c = 0; c < RW_NCH; ++c) {
        asm volatile("s_waitcnt lgkmcnt(0)" ::: "memory");
        if (c + 2 < RW_NCH) { issue(c + 2); asm volatile("s_waitcnt vmcnt(26)" ::: "memory"); }
        else if (c + 1 < RW_NCH) asm volatile("s_waitcnt vmcnt(13)" ::: "memory");
        else asm volatile("s_waitcnt vmcnt(0)" ::: "memory");
        const LAS unsigned char* sl = ring + (c % 3) * RWQ_SLOT;
        const int jF = dir == 0 ? c : (c < 4 ? 3 - c : 39 - c); const size_t ui = (size_t)(bh * 2 + dir) * RW_NCH + jF;
        const bf16x8 b00 = pack_step(S0, 0), b01 = pack_step(S0, 1), b10 = pack_step(S1, 0), b11 = pack_step(S1, 1);
        f32x16 n0, n1;
#pragma unroll
        for (int g = 0; g < 4; ++g) {
            const u32x2 h0 = *(const LAS u32x2*)(sl + 8192 + lane * 32 + 8 * g), h1 = *(const LAS u32x2*)(sl + 8192 + 2048 + lane * 32 + 8 * g);
            const f32x4 g0 = *(const LAS f32x4*)(sl + 12288 + (8 * g + 4 * h) * 4), g1 = *(const LAS f32x4*)(sl + 12288 + (32 + 8 * g + 4 * h) * 4);
            n0[4 * g] = bf_lo(h0.x) + g0[0] * S0[4 * g]; n0[4 * g + 1] = bf_hi(h0.x) + g0[1] * S0[4 * g + 1]; n0[4 * g + 2] = bf_lo(h0.y) + g0[2] * S0[4 * g + 2]; n0[4 * g + 3] = bf_hi(h0.y) + g0[3] * S0[4 * g + 3];
            n1[4 * g] = bf_lo(h1.x) + g1[0] * S1[4 * g]; n1[4 * g + 1] = bf_hi(h1.x) + g1[1] * S1[4 * g + 1]; n1[4 * g + 2] = bf_lo(h1.y) + g1[2] * S1[4 * g + 2]; n1[4 * g + 3] = bf_hi(h1.y) + g1[3] * S1[4 * g + 3]; }
#define RWQ_PF(ko, ki, s) (*(const LAS bf16x8*)(sl + (((ko) * 2 + (ki)) * 2 + (s)) * 1024 + lane * 16))
        n0 = MFMA32(RWQ_PF(0, 0, 0), b00, n0); n1 = MFMA32(RWQ_PF(1, 0, 0), b00, n1);
        n0 = MFMA32(RWQ_PF(0, 0, 1), b01, n0); n1 = MFMA32(RWQ_PF(1, 0, 1), b01, n1);
        n0 = MFMA32(RWQ_PF(0, 1, 0), b10, n0); n1 = MFMA32(RWQ_PF(1, 1, 0), b10, n1);
        n0 = MFMA32(RWQ_PF(0, 1, 1), b11, n0); n1 = MFMA32(RWQ_PF(1, 1, 1), b11, n1);
#undef RWQ_PF
        u32x4* so = (u32x4*)(wsp<bf16>(F, WS_RWS) + ui * 4096) + lane;
        so[((0 * 2 + vb) * 2 + 0) * 64] = __builtin_bit_cast(u32x4, b00); so[((0 * 2 + vb) * 2 + 1) * 64] = __builtin_bit_cast(u32x4, b01);
        so[((1 * 2 + vb) * 2 + 0) * 64] = __builtin_bit_cast(u32x4, b10); so[((1 * 2 + vb) * 2 + 1) * 64] = __builtin_bit_cast(u32x4, b11);
        S0 = n0; S1 = n1;
    }
}
__device__ __forceinline__ f32x4 unpk4(const u32x4& w, int half) { return (f32x4){bf_lo(w[2 * half]), bf_hi(w[2 * half]), bf_lo(w[2 * half + 1]), bf_hi(w[2 * half + 1])}; }
struct RwOutA { u32x4 yl[2]; u32x4 qa[4], sb[4]; };
struct RwOutB { u32x4 px[3], pl[3]; };
__device__ __forceinline__ void rw_out_fetch_a(Frame& F, int unit, int w, int lane, RwOutA& p) {
    const int jF = unit % RW_NCH, hh = (unit / RW_NCH) & 15, b = unit / (RW_NCH * 16); const int dir = w >> 2, tb = (w >> 1) & 1, vb = w & 1;
    const size_t ui = (size_t)((b * 16 + hh) * 2 + dir) * RW_NCH + jF;
    const u32x4* yl = (const u32x4*)(wsp<bf16>(F, WS_RWY) + ui * 4096 + (tb * 2 + vb) * 1024 + lane * 16);
    const u32x4* qt = (const u32x4*)(wsp<bf16>(F, WS_RWQ) + ui * 4096) + lane; const u32x4* s0 = (const u32x4*)(wsp<bf16>(F, WS_RWS) + ui * 4096) + lane;
    p.yl[0] = yl[0]; p.yl[1] = yl[1];
#pragma unroll
    for (int kb = 0; kb < 2; ++kb)
#pragma unroll
        for (int s = 0; s < 2; ++s) { p.qa[kb * 2 + s] = qt[((tb * 2 + kb) * 2 + s) * 64]; p.sb[kb * 2 + s] = s0[((kb * 2 + vb) * 2 + s) * 64]; }
}
__device__ __forceinline__ void rw_out_fetch_b(Frame& F, int unit, int tid, RwOutB& p) {
    const int jF = unit % RW_NCH, hh = (unit / RW_NCH) & 15, b = unit / (RW_NCH * 16);
    const int row = rw_row0(b, jF) + (tid >> 3), c0 = hh * 64 + (tid & 7) * 8;
    const bf16* XS = wsp<bf16>(F, WS_XS) + (size_t)row * 3072 + c0; const bf16* LR = wsp<bf16>(F, WS_LR) + (size_t)row * NLR + c0;
    p.px[0] = *(const u32x4*)XS; p.px[1] = *(const u32x4*)(XS + 1024); p.px[2] = *(const u32x4*)(XS + 2048);
    p.pl[0] = *(const u32x4*)(LR + 2048); p.pl[1] = *(const u32x4*)(LR + 3072); p.pl[2] = *(const u32x4*)(LR + 4096);
}
__device__ __forceinline__ void rw_out_unit(Frame& F, int layer, int unit, int unit_next, RwOutA& a, const RwOutB& bc, RwOutB& bn, const LAS float* VL) {
    const int jF = unit % RW_NCH, hh = (unit / RW_NCH) & 15, b = unit / (RW_NCH * 16);
    const int row0 = rw_row0(b, jF);
    const int lane = F.lane, h = lane >> 5, w = F.wave, dir = w >> 2, tb = (w >> 1) & 1, vb = w & 1;
    LAS float* YS = (LAS float*)F.lds;
    {
        f32x16 acc;
#pragma unroll
        for (int g = 0; g < 2; ++g)
#pragma unroll
            for (int e = 0; e < 4; ++e) { acc[8 * g + 2 * e] = bf_lo(a.yl[g][e]); acc[8 * g + 2 * e + 1] = bf_hi(a.yl[g][e]); }
#pragma unroll
        for (int i = 0; i < 4; ++i) acc = MFMA32(__builtin_bit_cast(bf16x8, a.qa[i]), __builtin_bit_cast(bf16x8, a.sb[i]), acc);
        if (unit_next >= 0) { rw_out_fetch_a(F, unit_next, w, lane, a); int tl_ = F.tid; asm volatile("" : "+v"(tl_)); rw_out_fetch_b(F, unit_next, tl_, bn); }
        LB();
        LAS float* yd = YS + dir * 64 * 68 + (32 * tb) * 68 + 32 * vb + (lane & 31);
#pragma unroll
        for (int r = 0; r < 16; ++r) yd[crow(r, h) * 68] = acc[r];
    }
    LB();
    {
        int tl_ = F.tid; asm volatile("" : "+v"(tl_));
        const int t = tl_ >> 3, j0 = (tl_ & 7) * 8, c0 = hh * 64 + j0; const int row = row0 + t;
        float y[8], s = 0.f;
#pragma unroll
        for (int e = 0; e < 2; ++e) { const f32x4 ya = *(const LAS f32x4*)(YS + t * 68 + j0 + 4 * e), yb = *(const LAS f32x4*)(YS + 64 * 68 + t * 68 + j0 + 4 * e);
#pragma unroll
            for (int q = 0; q < 4; ++q) { y[4 * e + q] = ya[q] + yb[q]; s += y[4 * e + q]; } }
        const float mean = red8(s) * (1.0f / 64.0f); float q2 = 0.f;
#pragma unroll
        for (int e = 0; e < 8; ++e) { y[e] -= mean; q2 += y[e] * y[e]; }
        const float rs = __builtin_amdgcn_rsqf(red8(q2) * (1.0f / 64.0f) + 64e-5f);
        float dp = 0.f; float ov[8];
#pragma unroll
        for (int e = 0; e < 2; ++e) {
            const f32x4 r = unpk4(bc.px[0], e), k = unpk4(bc.px[1], e);
            const f32x4 ka = *(const LAS f32x4*)(VL + 2 * 1024 + c0 + 4 * e), rk = *(const LAS f32x4*)(VL + 3 * 1024 + c0 + 4 * e);
            const f32x4 a0p = *(const LAS f32x4*)(VL + c0 + 4 * e) + unpk4(bc.pl[0], e);
            const f32x4 a1p = *(const LAS f32x4*)(VL + 1024 + c0 + 4 * e) + unpk4(bc.pl[1], e);
#pragma unroll
            for (int q = 0; q < 4; ++q) dp += r[q] * (k[q] * (2.0f + (sigm(a0p[q]) + sigm(a1p[q]) - 2.0f) * ka[q])) * rk[q]; }
        const float dot = red8(dp);
#pragma unroll
        for (int e = 0; e < 2; ++e) { const f32x4 v = unpk4(bc.px[2], e), g = unpk4(bc.pl[2], e), lng = *(const LAS f32x4*)(VL + 4 * 1024 + c0 + 4 * e);
#pragma unroll
            for (int q = 0; q < 4; ++q) ov[4 * e + q] = (y[4 * e + q] * rs * lng[q] + dot * v[q]) * g[q]; }
        u32x4 o; o.x = cvtpk(ov[0], ov[1]); o.y = cvtpk(ov[2], ov[3]); o.z = cvtpk(ov[4], ov[5]); o.w = cvtpk(ov[6], ov[7]);
        *(u32x4*)(wsp<bf16>(F, WS_Y) + (size_t)row * 3072 + 2048 + c0) = o;
    }
}

constexpr int CW_FOLD = 28672;
__device__ __forceinline__ void branch_fold(Frame& F, int layer) {
    if (F.wg >= 96) return;
    volatile LAS int* qslot = (volatile LAS int*)(F.lds + LDSCTL_OFF);
    asm volatile("s_waitcnt vmcnt(0)" ::: "memory");
    __syncthreads();
    for (int q = F.wg; q < 96; q += F.G) { const int t = q & 31;
        if (F.tid == 0) {
            __builtin_amdgcn_fence(__ATOMIC_RELEASE, "agent");
            asm volatile("s_waitcnt vmcnt(0)" ::: "memory");
            const int old = (int)__hip_atomic_fetch_add(F.ctl + CW_FOLD + 64 * layer + t, 1u, __ATOMIC_RELAXED, __HIP_MEMORY_SCOPE_AGENT);
            if (old == 2) { __builtin_amdgcn_fence(__ATOMIC_ACQUIRE, "agent"); asm volatile("s_waitcnt vmcnt(0)" ::: "memory"); }
            qslot[0] = old;
        }
        __syncthreads();
        const int old = qslot[0];
        __syncthreads();
        if (old != 2) continue;
        const bf16* P = wsp<bf16>(F, WS_YDR); bf16* mg = wsp<bf16>(F, WS_MG) + (size_t)ML * DM;
        const int r0 = (t >> 3) * 256, c0 = (t & 7) * 256;
#pragma unroll 1
        for (int it = 0; it < 16; it += 4) {
            u32x4 p[4][3];
#pragma unroll
            for (int k = 0; k < 4; ++k) { const int idx = (it + k) * NTHR + F.tid; const size_t off = (size_t)(r0 + (idx >> 5)) * DM + c0 + (idx & 31) * 8;
#pragma unroll
                for (int b = 0; b < 3; ++b) p[k][b] = *(const u32x4*)(P + (size_t)b * MC * DM + off); }
#pragma unroll
            for (int k = 0; k < 4; ++k) { const int idx = (it + k) * NTHR + F.tid; const size_t off = (size_t)(r0 + (idx >> 5)) * DM + c0 + (idx & 31) * 8;
                u32x4 w;
                w.x = cvtpk(pg8::bf_lo(p[k][0].x) + pg8::bf_lo(p[k][1].x) + pg8::bf_lo(p[k][2].x), pg8::bf_hi(p[k][0].x) + pg8::bf_hi(p[k][1].x) + pg8::bf_hi(p[k][2].x));
                w.y = cvtpk(pg8::bf_lo(p[k][0].y) + pg8::bf_lo(p[k][1].y) + pg8::bf_lo(p[k][2].y), pg8::bf_hi(p[k][0].y) + pg8::bf_hi(p[k][1].y) + pg8::bf_hi(p[k][2].y));
                w.z = cvtpk(pg8::bf_lo(p[k][0].z) + pg8::bf_lo(p[k][1].z) + pg8::bf_lo(p[k][2].z), pg8::bf_hi(p[k][0].z) + pg8::bf_hi(p[k][1].z) + pg8::bf_hi(p[k][2].z));
                w.w = cvtpk(pg8::bf_lo(p[k][0].w) + pg8::bf_lo(p[k][1].w) + pg8::bf_lo(p[k][2].w), pg8::bf_hi(p[k][0].w) + pg8::bf_hi(p[k][1].w) + pg8::bf_hi(p[k][2].w));
                *(u32x4*)(mg + off) = w; }
        }
    }
}

__device__ __forceinline__ void mixa_phase(Frame& F, int layer) {
    constexpr int NU = NB * 16 * RW_NCH;
    if (F.wg < NU) { RwIn in; rw_fetch_x(F, F.wg, F.tid, in); rw_fetch_l(F, F.wg, 0, F.tid, in); rw_fetch_v(F, layer, F.wg, F.tid, in);
        for (int u = F.wg; u < NU; u += F.G) rw_local_unit(F, layer, u, u + F.G < NU ? u + F.G : -1, in); }
    __syncthreads();
    for (int u = F.wg; u < 256; u += F.G) ret_state_unit(F, layer, u);
    __syncthreads();
}
__device__ __forceinline__ void mix_phase(Frame& F, int layer, int qidx, int mode = 3) {
#ifdef RW_DEBUG
    for (int u = F.wg; u < 256; u += F.G) rwkv_scan_unit(F, layer, u);
    __syncthreads();
#endif
    if (mode & 1) { if (F.wave < 3) for (int tk = F.wg * 3 + F.wave; tk < 256; tk += F.G * 3) rw_seq_task(F, tk, F.lane, F.lds + F.wave * RWQ_WAVE); }
    if (!(mode & 2)) return;
    const bool lastl = layer == NL - 1;
    const int nswa = lastl ? 512 : 576;
    volatile LAS int* qslot = (volatile LAS int*)(F.lds + LDSCTL_OFF);
    __syncthreads();
    for (;;) {
        LB();
        if (F.tid == 0) qslot[0] = (int)__hip_atomic_fetch_add(F.ctl + CW_SWAQ + 64 * qidx, 1u, __ATOMIC_RELAXED, __HIP_MEMORY_SCOPE_AGENT);
        LB();
        const int item = qslot[0];
        if (item >= nswa) break;
        swa_unit(F, layer, item);
    }
    for (;;) {
        LB();
        if (F.tid == 0) qslot[0] = (int)__hip_atomic_fetch_add(F.ctl + CW_SWAQ + 64 * qidx + 32, 1u, __ATOMIC_RELAXED, __HIP_MEMORY_SCOPE_AGENT);
        LB();
        const int r = qslot[0];
        if (r >= nswa) break;
        ret_out_unit(F, layer, lastl ? (r >> 4) * 18 + 2 + (r & 15) : r);
    }
}
__device__ __forceinline__ void mixfin_phase(Frame& F, int layer, int nrows) {
    { TS_BEGIN(1);
      LAS float* VL = (LAS float*)(F.lds + 40960);
      for (int e = F.tid; e < 5 * 256; e += NTHR) { const int v = e >> 8, c4 = (e & 255) * 4; const int src = v == 0 ? 2 : (v == 1 ? 3 : (v == 2 ? 5 : (v == 3 ? 6 : 7)));
          *(LAS f32x4*)(VL + v * 1024 + c4) = *(const f32x4*)(vecp(F, layer, src) + c4); }
      constexpr int NU = NB * 16 * RW_NCH; const bool lastl = layer == NL - 1;
      auto nextu = [&](int u) { u += F.G; while (u < NU && lastl && (u % RW_NCH) < 4) u += F.G; return u < NU ? u : -1; };
      int u = F.wg - F.G; u = nextu(u);
      if (u >= 0) { RwOutA a; RwOutB b0, b1; rw_out_fetch_a(F, u, F.wave, F.lane, a); rw_out_fetch_b(F, u, F.tid, b0);
          __syncthreads();
          while (u >= 0) { int un = nextu(u); rw_out_unit(F, layer, u, un, a, b0, b1, VL); u = un;
              if (u < 0) break;
              un = nextu(u); rw_out_unit(F, layer, u, un, a, b1, b0, VL); u = un; } }
    TS_END(1); }
    __syncthreads();
}

constexpr int CONVQ_IN = 21, CONVQ_BR = 2, CONVQ_F1 = 10;
constexpr int NPH = 12;
constexpr int NSTEPS = 2 + NL * NPH + 1;
__global__ void __launch_bounds__(NTHR, 2) hyb_fwd(Args args) {
    extern __shared__ __attribute__((aligned(16))) unsigned char lds[];
    Frame F;
    F.lds = (LAS unsigned char*)lds;
    F.tid = threadIdx.x; F.lane = F.tid & 63; F.wave = __builtin_amdgcn_readfirstlane(F.tid >> 6);
    const int wv0 = F.wave;
    F.G = gridDim.x; F.wg = blockIdx.x; F.ws = args.ws; F.ctl = (unsigned*)(args.ws + WS_CTL);
    for (int u = F.tid; u < (LDS_BYTES - LDSCTL_OFF) / 4; u += NTHR) ((LAS unsigned*)(F.lds + LDSCTL_OFF))[u] = 0u;
    __syncthreads();
    if (F.tid < 26) { const __attribute__((address_space(4))) unsigned long long* kp = (const __attribute__((address_space(4))) unsigned long long*)__builtin_amdgcn_kernarg_segment_ptr();
        ((LAS unsigned long long*)(F.lds + PTAB_OFF))[F.tid] = kp[F.tid]; }
    __syncthreads();
    XcdBarrier bar = xcd_barrier_post(F.ctl + CW_BAR, (volatile LAS unsigned*)(F.lds + MISC_OFF) + 8);
    int lo = args.s_lo, hi = args.s_hi;
#define IN(k) (lo <= (k) && (k) < hi)
#define SL() do { size_t z_ = 0; asm volatile("" : "+s"(lo), "+s"(hi), "+s"(z_), "+s"(F.wg), "+s"(F.G)); F.ws = args.ws + z_; } while (0)
#define LAUNDER() do { int t_ = wv0 * 64 + lane_now(); asm volatile("" : "+v"(t_)); F.tid = t_; F.lane = t_ & 63; F.wave = __builtin_amdgcn_readfirstlane(t_ >> 6); } while (0)
#define SEAM(k) do { SL(); if (IN(k) && IN((k) + 1)) xcd_barrier(bar, wv0 == 0 && lane_now() == 0); } while (0)
    SL(); if (IN(0)) { LAUNDER(); p0_prologue(F); }
#ifdef PROBE_P0
    SL(); if (IN(0)) { xcd_barrier(bar, wv0 == 0 && lane_now() == 0); LAUNDER(); p0_prologue(F); }
#endif
    SEAM(0);
    SL(); if (IN(1)) { LAUNDER(); p1_modreduce(F); }
    SEAM(1);
    for (int layer_ = 0; layer_ < NL; ++layer_) {
        int layer = layer_; asm volatile("" : "+s"(layer));
        const int s0 = 2 + layer * NPH;
        const int mrows = (layer == NL - 1) ? ML : MT;
        const float* modl = wsp<float>(F, WS_MOD) + (size_t)layer * 5 * 12288;
        SL(); if (IN(s0 + 0)) { LAUNDER(); if (layer > 0) conv_pull(F, -1, conv_deadline(layer)); norm_phase(F, layer, 0, MT, layer > 0); }
#if defined(PROBE_PHASE) && PROBE_PHASE == 0
        SL(); if (IN(s0 + 0)) { xcd_barrier(bar, wv0 == 0 && lane_now() == 0); LAUNDER(); norm_phase(F, layer, 0, MT, false); }
#endif
        SEAM(s0 + 0);
        SL(); if (IN(s0 + 1)) {
            const int gg = (layer < NL - 1 && F.G == 256) ? 240 : F.G;
            if (layer == NL - 1) {
            pg8::Gemm g{wsp<bf16>(F, WS_U), wsp<bf16>(F, WS_WIN + layer * SZ_WIN), MT, LDP, DM, DM, DM}; pg8::LastInOrder S; S.init(F.G, F.wg);
            pg8::EpiBf16<0> E{wsp<bf16>(F, WS_P), LDP};
            pg8::gemm_phase<pg8::EpiBf16<0>, pg8::LastInOrder, true, true>(F.lds, g, S, E, wv0);
            } else if (F.wg < gg) {
            pg8::Gemm g{wsp<bf16>(F, WS_U), wsp<bf16>(F, WS_WIN + layer * SZ_WIN), MT, LDP, DM, DM, DM}; pg8::StaticOrder S; S.init(MT, LDP, gg, F.wg);
            pg8::EpiBf16<0> E{wsp<bf16>(F, WS_P), LDP};
            pg8::gemm_phase<pg8::EpiBf16<0>, pg8::StaticOrder, true, true>(F.lds, g, S, E, wv0);
            } else { LAUNDER(); conv_pull(F, CONVQ_IN, CONV_QTOT); }
#ifdef PROBE_GEMM2
            pg8::gemm_phase<pg8::EpiBf16<0>, pg8::StaticOrder, true, true>(F.lds, g, S, E, wv0);
#endif
        }
        SEAM(s0 + 1);
        SL(); if (IN(s0 + 2)) { LAUNDER(); if (layer == 0) conv_pull(F, -1, CONV_Q0); prep_phase(F, layer); }
#if defined(PROBE_PHASE) && PROBE_PHASE == 2
        SL(); if (IN(s0 + 2)) { xcd_barrier(bar, wv0 == 0 && lane_now() == 0); LAUNDER(); prep_phase(F, layer); }
#endif
        SEAM(s0 + 2);
        SL(); if (IN(s0 + 3)) {
            const int gg = (layer == 0 && F.G == 256) ? 240 : F.G;
            if (F.wg < gg) {
            pg8::Gemm g{wsp<bf16>(F, WS_ALR), wsp<bf16>(F, WS_WLR + layer * SZ_WLR), MT, NLR, 128, KLR, KLR}; pg8::LrOrder S; S.init(MT, NLR, gg, F.wg);
            pg8::EpiBf16<0> E{wsp<bf16>(F, WS_LR), NLR};
            pg8::gemm_phase<pg8::EpiBf16<0>, pg8::LrOrder, true, true>(F.lds, g, S, E, wv0);
            } else { LAUNDER(); conv_pull(F, 1, CONV_QTOT); }
        }
        SEAM(s0 + 3);
        SL(); if (IN(s0 + 4)) { LAUNDER(); mixa_phase(F, layer); }
#if defined(PROBE_PHASE) && PROBE_PHASE == 4
        SL(); if (IN(s0 + 4)) { xcd_barrier(bar, wv0 == 0 && lane_now() == 0); LAUNDER(); mixa_phase(F, layer); }
#endif
        SEAM(s0 + 4);
        SL(); if (IN(s0 + 5)) { LAUNDER(); mix_phase(F, layer, layer); }
#ifdef PROBE_MIX
        SL(); if (IN(s0 + 5)) { xcd_barrier(bar, wv0 == 0 && lane_now() == 0); LAUNDER(); mix_phase(F, layer, layer + 4, PROBE_MIX); }
#endif
        SEAM(s0 + 5);
        SL(); if (IN(s0 + 6)) { LAUNDER(); mixfin_phase(F, layer, mrows); }
#if defined(PROBE_PHASE) && PROBE_PHASE == 6
        SL(); if (IN(s0 + 6)) { xcd_barrier(bar, wv0 == 0 && lane_now() == 0); LAUNDER(); mixfin_phase(F, layer, mrows); }
#endif
        SEAM(s0 + 6);
        SL(); if (IN(s0 + 7)) {
            pg8::Gemm g{wsp<bf16>(F, WS_Y), wsp<bf16>(F, WS_WBR + layer * SZ_WBR), mrows, DM, BW, 3072, BW}; pg8::BranchOrder S; S.init(F.G, F.wg, mrows > ML);
            pg8::EpiBranch E{wsp<bf16>(F, WS_P) + C_GATE, LDP, wsp<bf16>(F, WS_MG), wsp<bf16>(F, WS_YDR)};
            pg8::gemm_phase<pg8::EpiBranch, pg8::BranchOrder, true, true>(F.lds, g, S, E, wv0);
#if defined(PROBE_PHASE) && PROBE_PHASE == 7
            pg8::gemm_phase<pg8::EpiBranch, pg8::BranchOrder, true, true>(F.lds, g, S, E, wv0);
#endif
            if (mrows > ML) { LAUNDER(); branch_fold(F, layer);
                if (layer < NL - 1 && F.G == 256 && F.wg >= 96) conv_pull(F, CONVQ_BR, CONV_QTOT); }
        }
        SEAM(s0 + 7);
        SL(); if (IN(s0 + 8)) {
            pg8::Gemm g{wsp<bf16>(F, WS_MG), wsp<bf16>(F, WS_WOUT + layer * SZ_WOUT), MT, DM, DM, DM, DM}; pg8::OutOrder S; S.init(F.G, F.wg, mrows > ML, DM);
            pg8::EpiOut E{wsp<bf16>(F, WS_MGF), wsp<bf16>(F, WS_YDR), modl, 2 * DM, (int)(F.wg & 7)};
            pg8::gemm_phase<pg8::EpiOut, pg8::OutOrder, true, true>(F.lds, g, S, E, wv0);
        }
        SEAM(s0 + 8);
        SL(); if (IN(s0 + 9)) { LAUNDER(); norm_phase(F, layer, 1, mrows, true); }
#if defined(PROBE_PHASE) && PROBE_PHASE == 9
        SL(); if (IN(s0 + 9)) { xcd_barrier(bar, wv0 == 0 && lane_now() == 0); LAUNDER(); norm_phase(F, layer, 1, mrows, false); }
#endif
        SEAM(s0 + 9);
        SL(); if (IN(s0 + 10)) {
            const int gg = (layer < NL - 1 && mrows > ML && F.G == 256) ? 232 : F.G;
            if (F.wg < gg) {
            pg8::Gemm g{wsp<bf16>(F, WS_U), wsp<bf16>(F, WS_WFF1 + layer * SZ_WFF), mrows, DFF, DM, DM, DM}; pg8::StaticOrder S; S.init(mrows, DFF, gg, F.wg);
            pg8::EpiBf16<2> E{wsp<bf16>(F, WS_F), DFF};
            pg8::gemm_phase<pg8::EpiBf16<2>, pg8::StaticOrder, true, true>(F.lds, g, S, E, wv0);
            } else { LAUNDER(); conv_pull(F, CONVQ_F1, CONV_QTOT); }
#ifdef PROBE_GEMM2
            pg8::gemm_phase<pg8::EpiBf16<2>, pg8::StaticOrder, true, true>(F.lds, g, S, E, wv0);
#endif
        }
        SEAM(s0 + 10);
        SL(); if (IN(s0 + 11)) {
            pg8::Gemm g{wsp<bf16>(F, WS_F), wsp<bf16>(F, WS_WFF2 + layer * SZ_WFF), MT, DM, DFF, DFF, DFF}; pg8::OutOrder S; S.init(F.G, F.wg, mrows > ML, DFF);
            pg8::EpiOut E{wsp<bf16>(F, WS_MGF) + (size_t)ML * DM, wsp<bf16>(F, WS_YDR), modl, 5 * DM, (int)(F.wg & 7)};
            pg8::gemm_phase<pg8::EpiOut, pg8::OutOrder, true, true>(F.lds, g, S, E, wv0);
        }
        SEAM(s0 + 11);
    }
    SL(); if (IN(NSTEPS - 1)) { LAUNDER(); final_norm(F, args.out); }
#undef IN
#undef SL
#undef LAUNDER
#undef SEAM
}

#ifndef MK_ONE_LAUNCH
#define MK_ONE_LAUNCH 1
#endif
extern "C" void kernel_launch(void* const* d_in, const int* in_sizes, int n_in, void* d_out, int out_size, void* d_ws, size_t ws_size, hipStream_t stream) {
    static int grid = 0;
    if (grid == 0) {
        if (n_in != 26 || out_size != ML * DM || ws_size < WS_END2) { fprintf(stderr, "kernel_launch: unexpected shapes (n_in %d, out %d, ws %zu < %zu)\n", n_in, out_size, ws_size, (size_t)WS_END2); grid = -1; return; }
        int dev = 0, cus = 0, per_cu = 0;
        if (hipGetDevice(&dev) != hipSuccess || hipDeviceGetAttribute(&cus, hipDeviceAttributeMultiprocessorCount, dev) != hipSuccess) { grid = -1; return; }
        if (hipFuncSetAttribute((const void*)hyb_fwd, hipFuncAttributeMaxDynamicSharedMemorySize, LDS_BYTES) != hipSuccess) { fprintf(stderr, "kernel_launch: hipFuncSetAttribute failed\n"); grid = -1; return; }
        if (hipOccupancyMaxActiveBlocksPerMultiprocessor(&per_cu, (const void*)hyb_fwd, NTHR, LDS_BYTES) != hipSuccess || per_cu < 1) fprintf(stderr, "kernel_launch: occupancy query reports %d\n", per_cu);
        (void)hipGetLastError();
        grid = cus;
    }
    if (grid < 0) return;
    if (hipMemsetAsync((char*)d_ws + WS_CTL, 0, CTL_ZERO_BYTES, stream) != hipSuccess) return;
    Args a{};
    for (int i = 0; i < 26; ++i) a.in[i] = (const float*)d_in[i];
    a.out = (float*)d_out; a.ws = (unsigned char*)d_ws;
#if MK_ONE_LAUNCH
    a.s_lo = 0; a.s_hi = NSTEPS;
    hipLaunchKernelGGL(hyb_fwd, dim3(grid), dim3(NTHR), LDS_BYTES, stream, a);
#else
    for (int s = 0; s < NSTEPS; ++s) { a.s_lo = s; a.s_hi = s + 1; hipLaunchKernelGGL(hyb_fwd, dim3(grid), dim3(NTHR), LDS_BYTES, stream, a); }
#endif
}
```

```cpp
#include <hip/hip_runtime.h>
#include <cstdio>
#include <cstdint>
__device__ __forceinline__ int lane_now() { int l; asm volatile("v_mbcnt_lo_u32_b32 %0, -1, 0\n\tv_mbcnt_hi_u32_b32 %0, -1, %0" : "=v"(l)); return l; }
namespace pg8 {
#define PG8_LAS __attribute__((address_space(3)))
typedef unsigned short bf16_t;
typedef short bf16x8 __attribute__((ext_vector_type(8)));
typedef float f32x4 __attribute__((ext_vector_type(4)));
typedef unsigned u32x4 __attribute__((ext_vector_type(4)));
constexpr int BM = 256, BK = 64, HALF = 128, HTB = HALF * BK * 2  , STAGE_BYTES = 8 * HTB, NXCD = 8, WGM = 8;

__host__ __device__ __forceinline__ int lds_byte(int r, int c) { const int st = (r >> 4) * 2 + (c >> 5), rr = r & 15, cc = c & 31, ob = rr * 64 + cc * 2; return st * 1024 + (ob ^ (((ob >> 9) & 1) << 5)); }
__host__ __device__ __forceinline__ void stage_rc(int b, int& R, int& C) { const int st = b / 1024, sb = b % 1024, swz = sb ^ (((sb >> 9) & 1) << 5); R = (st >> 1) * 16 + swz / 64; C = (st & 1) * 32 + (swz % 64) / 2; }
__host__ __device__ __forceinline__ int perm32(int rho) { const int n = rho >> 4, i = rho & 15; return 8 * (i >> 2) + 4 * n + (i & 3); }

struct Unit { int pm, pn; };
struct Gemm { const bf16_t* A; const bf16_t* Bt; int M, N, K, lda, ldb; };

struct StaticOrder {
    int nM, nN, nwg, G, c;
    __host__ __device__ void init(int M, int N, int G_, int c_) { nM = M / BM; nN = N / BM; nwg = nM * nN; G = G_; c = c_; }
    __host__ __device__ bool next(int i, Unit& u) const {
        const long L = (long)i * G + c; if (L >= nwg) return false;
        int wgid = (int)L; { const int q = nwg / NXCD, r = nwg % NXCD, xcd = wgid % NXCD, off = wgid / NXCD; wgid = (xcd < r ? xcd * (q + 1) : r * (q + 1) + (xcd - r) * q) + off; }
        const int nig = WGM * nN, gid = wgid / nig, fm = gid * WGM, gsz = (nM - fm) < WGM ? (nM - fm) : WGM;
        u.pm = fm + ((wgid % nig) % gsz); u.pn = (wgid % nig) / gsz; return true;
    }
    __device__ __forceinline__ void a_ready(const Unit&) const {}
    __device__ __forceinline__ void done(const Unit&) const {}
    __device__ __forceinline__ size_t a_off(const Unit&) const { return 0; }
    __device__ __forceinline__ size_t b_off(const Unit&) const { return 0; }
    __device__ __forceinline__ int nt(const Unit&, int d) const { return d; }
};

__device__ __forceinline__ unsigned cvt_pk_bf16(float lo, float hi) { unsigned r; asm volatile("v_cvt_pk_bf16_f32 %0, %1, %2" : "=v"(r) : "v"(lo), "v"(hi)); return r; }
typedef float f32x2 __attribute__((ext_vector_type(2)));
__device__ __forceinline__ float sigmoidf_(float x) { return __builtin_amdgcn_rcpf(1.0f + __builtin_amdgcn_exp2f(x * -1.4426950408889634f)); }
__device__ __forceinline__ float bf_lo(unsigned w) { return __uint_as_float(w << 16); }
__device__ __forceinline__ float bf_hi(unsigned w) { return __uint_as_float(w & 0xffff0000u); }

template <int ACT> struct EpiBf16 {
    static constexpr bool PERM = true, AFTER_DRAIN = false;
    bf16_t* O; int ldc;
    __device__ __forceinline__ void operator()(const f32x4 (&acc)[2][2][4][2], const Unit& u, int wr, int wc, int fr, int fq) const {
        const int row0 = u.pm * BM + wr * 64 + fr; const int col0 = u.pn * BM + wc * 32 + 8 * fq;
#pragma unroll
        for (int ai = 0; ai < 2; ++ai)
#pragma unroll
            for (int m = 0; m < 4; ++m) { bf16_t* rowp = O + (size_t)(row0 + ai * HALF + m * 16) * ldc + col0;
#pragma unroll
                for (int bj = 0; bj < 2; ++bj) { f32x4 v0 = acc[ai][bj][m][0], v1 = acc[ai][bj][m][1];
                    if (ACT == 2) {
#pragma unroll
                        for (int e = 0; e < 4; ++e) { const float a = fmaxf(v0[e], 0.f), b = fmaxf(v1[e], 0.f); v0[e] = a * a; v1[e] = b * b; } }
                    u32x4 w; w.x = cvt_pk_bf16(v0[0], v0[1]); w.y = cvt_pk_bf16(v0[2], v0[3]); w.z = cvt_pk_bf16(v1[0], v1[1]); w.w = cvt_pk_bf16(v1[2], v1[3]);
                    *(u32x4*)(rowp + bj * HALF) = w; } }
    }
};
struct OutOrder {
    StaticOrder S0; int G, c, nsub, ksl;
    __device__ void init(int G_, int c_, bool ctx, int K) { S0.init(8192, 2048, G_, c_); G = G_; c = c_; nsub = ctx ? 256 : 0; ksl = K / 8 * 2; }
    __device__ bool next(int i, Unit& u) const {
        const int T = c < 256 ? (256 - c + G - 1) / G : 0;
        if (i < T) { S0.next(i, u); return true; }
        const int q = (i - T) * G + c; if (q >= nsub) return false;
        const int lt = q >> 3; u.pm = 32 + (lt >> 3); u.pn = lt & 7; return true;
    }
    __device__ __forceinline__ void a_ready(const Unit&) const {}
    __device__ __forceinline__ void done(const Unit&) const {}
    __device__ __forceinline__ size_t a_off(const Unit& u) const { return u.pm < 32 ? 0 : (size_t)(c & 7) * ksl; }
    __device__ __forceinline__ size_t b_off(const Unit& u) const { return a_off(u); }
    __device__ __forceinline__ int nt(const Unit& u, int d) const { return u.pm < 32 ? d : d >> 3; }
};
struct EpiOut {
    static constexpr bool PERM = true, AFTER_DRAIN = false;
    bf16_t* D; bf16_t* part; const float* modl; int goff, slice;
    __device__ __forceinline__ void operator()(const f32x4 (&acc)[2][2][4][2], const Unit& u, int wr, int wc, int fr, int fq) const {
        const bool lat = u.pm < 32; const int mr = lat ? (u.pm >> 3) : 4;
        const int row0 = u.pm * BM + wr * 64 + fr, col0 = u.pn * BM + wc * 32 + 8 * fq;
        const float* gv = modl + (size_t)mr * 12288 + goff + col0;
        bf16_t* dst = lat ? D + (size_t)row0 * 2048 + col0 : part + ((size_t)slice * 1024 + (row0 - 8192)) * 2048 + col0;
        f32x4 gg[2][2];
#pragma unroll
        for (int bj = 0; bj < 2; ++bj)
#pragma unroll
            for (int n = 0; n < 2; ++n) gg[bj][n] = *(const f32x4*)(gv + bj * HALF + n * 4);
#pragma unroll
        for (int ai = 0; ai < 2; ++ai)
#pragma unroll
            for (int m = 0; m < 4; ++m) { bf16_t* rowp = dst + (size_t)(ai * HALF + m * 16) * 2048;
#pragma unroll
                for (int bj = 0; bj < 2; ++bj) { const f32x4 v0 = acc[ai][bj][m][0] * gg[bj][0], v1 = acc[ai][bj][m][1] * gg[bj][1];
                    u32x4 w; w.x = cvt_pk_bf16(v0[0], v0[1]); w.y = cvt_pk_bf16(v0[2], v0[3]); w.z = cvt_pk_bf16(v1[0], v1[1]); w.w = cvt_pk_bf16(v1[2], v1[3]);
                    *(u32x4*)(rowp + bj * HALF) = w; } }
    }
};

struct BranchOrder {
    StaticOrder S0; int G, c, nctx;
    __device__ void init(int G_, int c_, bool ctx) { S0.init(8192, 2048, G_, c_); G = G_; c = c_; nctx = ctx ? 96 : 0; }
    __device__ bool next(int i, Unit& u) const {
        const int T = c < 256 ? (256 - c + G - 1) / G : 0;
        if (i < 3 * T) { const int ti = i / 3, b = i - 3 * ti; S0.next(ti, u); u.pn += 8 * b; return true; }
        const int q = (i - 3 * T) * G + c; if (q >= nctx) return false;
        u.pm = 32 + ((q & 31) >> 3); u.pn = (q & 7) + 8 * (q >> 5); return true;
    }
    __device__ __forceinline__ void a_ready(const Unit&) const {}
    __device__ __forceinline__ void done(const Unit&) const {}
    __device__ __forceinline__ size_t a_off(const Unit& u) const { return (size_t)(u.pn >> 3) * 2048; }
    __device__ __forceinline__ size_t b_off(const Unit&) const { return 0; }
    __device__ __forceinline__ int nt(const Unit&, int d) const { return d; }
};
struct EpiBranch {
    static constexpr bool PERM = true, AFTER_DRAIN = false;
    const bf16_t* G; int ldg;
    bf16_t* out;
    bf16_t* part;
    __device__ __forceinline__ void operator()(const f32x4 (&acc)[2][2][4][2], const Unit& u, int wr, int wc, int fr, int fq) const {
        const int b = u.pn >> 3; const bool ctx = u.pm >= 32, old = !ctx && b > 0;
        const int row0 = u.pm * BM + wr * 64 + fr; const int col0 = (u.pn & 7) * BM + wc * 32 + 8 * fq;
        const bf16_t* gp = G + (size_t)row0 * ldg + b * 2048 + col0;
        bf16_t* op = ctx ? part + ((size_t)b * 1024 + (row0 - 8192)) * 2048 + col0 : out + (size_t)row0 * 2048 + col0;
        u32x4 gw[2][4], ow[2][4];
#pragma unroll
        for (int g = -1; g < 4; ++g) {
            if (g + 1 < 4) {
#pragma unroll
                for (int q = 0; q < 4; ++q) { const int it = (g + 1) * 4 + q, ai = it >> 3, m = (it >> 1) & 3, bj = it & 1; const int ro = ai * HALF + m * 16;
                    gw[(g + 1) & 1][q] = *(const u32x4*)(gp + (size_t)ro * ldg + bj * HALF);
                    ow[(g + 1) & 1][q] = *(const u32x4*)(op + (size_t)ro * 2048 + bj * HALF); }
            }
            asm volatile("" ::: "memory");
            if (g >= 0) {
#pragma unroll
                for (int q = 0; q < 4; ++q) { const int it = g * 4 + q, ai = it >> 3, m = (it >> 1) & 3, bj = it & 1; const int ro = ai * HALF + m * 16;
                    const u32x4 gq = gw[g & 1][q];
                    f32x4 g0, g1; g0[0] = sigmoidf_(bf_lo(gq.x)); g0[1] = sigmoidf_(bf_hi(gq.x)); g0[2] = sigmoidf_(bf_lo(gq.y)); g0[3] = sigmoidf_(bf_hi(gq.y));
                    g1[0] = sigmoidf_(bf_lo(gq.z)); g1[1] = sigmoidf_(bf_hi(gq.z)); g1[2] = sigmoidf_(bf_lo(gq.w)); g1[3] = sigmoidf_(bf_hi(gq.w));
                    f32x4 v0 = acc[ai][bj][m][0] * g0, v1 = acc[ai][bj][m][1] * g1;
                    u32x4 o = ow[g & 1][q]; if (!old) o = (u32x4){0u, 0u, 0u, 0u};
                    v0[0] += bf_lo(o.x); v0[1] += bf_hi(o.x); v0[2] += bf_lo(o.y); v0[3] += bf_hi(o.y); v1[0] += bf_lo(o.z); v1[1] += bf_hi(o.z); v1[2] += bf_lo(o.w); v1[3] += bf_hi(o.w);
                    u32x4 w; w.x = cvt_pk_bf16(v0[0], v0[1]); w.y = cvt_pk_bf16(v0[2], v0[3]); w.z = cvt_pk_bf16(v1[0], v1[1]); w.w = cvt_pk_bf16(v1[2], v1[3]);
                    *(u32x4*)(op + (size_t)ro * 2048 + bj * HALF) = w; }
                asm volatile("" ::: "memory");
            }
        }
    }
};

struct LastInOrder {
    StaticOrder S0; int G, c;
    __device__ void init(int G_, int c_) { S0.init(8192, 15360, G_, c_); G = G_; c = c_; }
    __device__ bool next(int i, Unit& u) const {
        const long L = (long)i * G + c;
        if (L < 1920) { S0.next(i, u); return true; }
        const int j = (int)(L - 1920); if (j >= 112) return false;
        const int q = j % 28; u.pm = 32 + j / 28; u.pn = q < 12 ? 4 + q : 8 + q; return true;
    }
    __device__ __forceinline__ void a_ready(const Unit&) const {}
    __device__ __forceinline__ void done(const Unit&) const {}
    __device__ __forceinline__ size_t a_off(const Unit&) const { return 0; }
    __device__ __forceinline__ size_t b_off(const Unit&) const { return 0; }
    __device__ __forceinline__ int nt(const Unit&, int d) const { return d; }
};

struct LrOrder {
    StaticOrder S0;
    __device__ void init(int M, int N, int G_, int c_) { S0.init(M, N, G_, c_); }
    __device__ bool next(int i, Unit& u) const { return S0.next(i, u); }
    __device__ __forceinline__ void a_ready(const Unit&) const {}
    __device__ __forceinline__ void done(const Unit&) const {}
    __device__ __forceinline__ size_t a_off(const Unit& u) const { return (size_t)(u.pn < 8 ? 0 : (u.pn < 16 ? 256 : 512)); }
    __device__ __forceinline__ size_t b_off(const Unit& u) const { return a_off(u); }
    __device__ __forceinline__ int nt(const Unit&, int d) const { return d; }
};

template <class Epi, class Sched, bool ALIGN_EPI = false, bool SP2 = false>
__device__ __forceinline__ void gemm_phase(PG8_LAS unsigned char* lds, const Gemm g, const Sched& S, const Epi& E, const int wv  ) {
    int tid_ = wv * 64 + lane_now(); asm volatile("" : "+v"(tid_));
    const int tid = tid_, wid = __builtin_amdgcn_readfirstlane(tid >> 6), lane = tid & 63, wr = wid >> 2, wc = wid & 3, fr = lane & 15, fq = lane >> 4;
    const int ntd = g.K / BK;
    unsigned voffA[2], voffB[2];
#pragma unroll
    for (int i = 0; i < 2; ++i) { int R, C; stage_rc(tid * 16 + i * 8192, R, C); const int Rb = Epi::PERM ? ((R & ~31) + perm32(R & 31)) : R;
        voffA[i] = (unsigned)(R * g.lda + C) * 2u; voffB[i] = (unsigned)(Rb * g.ldb + C) * 2u; }
    const size_t kstep = (size_t)(BK * 2);
    const size_t hstepA = (size_t)HALF * g.lda * 2, hstepB = (size_t)HALF * g.ldb * 2;
    const size_t tstepA = 2 * hstepA, tstepB = 2 * hstepB;
    const unsigned ldsw = (unsigned)wid * 1024u;
    const int aoff = lds_byte(wr * 64 + fr, fq * 8), boff = lds_byte(wc * 32 + fr, fq * 8);
#define PG8_SA(b, h) (((b) * 2 + (h)) * HTB)
#define PG8_SB(b, h) ((4 + (b) * 2 + (h)) * HTB)
#define PG8_STAGE(bufoff, gbase, voff) do { _Pragma("unroll") for (int _i = 0; _i < 2; ++_i) \
        __builtin_amdgcn_global_load_lds((const unsigned*)((const char*)(gbase) + (voff)[_i]), (PG8_LAS unsigned*)(lds + (bufoff) + ldsw + _i * 8192), 16, 0, 0); } while (0)
#define PG8_LDA(dst, b, h) do { _Pragma("unroll") for (int m = 0; m < 4; ++m) _Pragma("unroll") for (int k = 0; k < 2; ++k) dst[m][k] = *(const PG8_LAS bf16x8*)(lds + PG8_SA(b, h) + aoff + m * 2048 + k * 1024); } while (0)
#define PG8_LDB(dst, b, h) do { _Pragma("unroll") for (int n = 0; n < 2; ++n) _Pragma("unroll") for (int k = 0; k < 2; ++k) dst[n][k] = *(const PG8_LAS bf16x8*)(lds + PG8_SB(b, h) + boff + n * 2048 + k * 1024); } while (0)
#define PG8_MMA(ai, bj, At, Bt) do { __builtin_amdgcn_s_setprio(1); _Pragma("unroll") for (int m = 0; m < 4; ++m) _Pragma("unroll") for (int n = 0; n < 2; ++n) _Pragma("unroll") for (int k = 0; k < 2; ++k) \
        acc[ai][bj][m][n] = __builtin_amdgcn_mfma_f32_16x16x32_bf16(Bt[n][k], At[m][k], acc[ai][bj][m][n], 0, 0, 0); __builtin_amdgcn_s_setprio(0); } while (0)
#define PG8_WAIT_V(n) asm volatile("s_waitcnt vmcnt(" #n ")" ::: "memory")
#define PG8_WAIT_L(n) asm volatile("s_waitcnt lgkmcnt(" #n ")" ::: "memory")
#define PG8_BAR __builtin_amdgcn_s_barrier()
#define PG8_SCHED __builtin_amdgcn_sched_barrier(0)
    Unit cur, nxt; int ui = 0;
    if (!S.next(0, cur)) return;
    f32x4 acc[2][2][4][2];
#pragma unroll
    for (int a = 0; a < 2; ++a)
#pragma unroll
        for (int b = 0; b < 2; ++b)
#pragma unroll
            for (int m = 0; m < 4; ++m)
#pragma unroll
                for (int n = 0; n < 2; ++n) acc[a][b][m][n] = (f32x4){0.f, 0.f, 0.f, 0.f};
    bf16x8 At[4][2], B0[2][2], B1[2][2];
    const char* cA = (const char*)g.A + (size_t)cur.pm * tstepA + S.a_off(cur); const char* cB = (const char*)g.Bt + (size_t)cur.pn * tstepB + S.b_off(cur);
    S.a_ready(cur);
    if constexpr (SP2) {
        PG8_STAGE(PG8_SB(0, 0), cB, voffB); PG8_STAGE(PG8_SB(0, 1), cB + hstepB, voffB); PG8_STAGE(PG8_SA(0, 0), cA, voffA); PG8_STAGE(PG8_SA(0, 1), cA + hstepA, voffA);
        if (wr == 1) PG8_BAR;
        PG8_WAIT_V(2); PG8_BAR;
        PG8_STAGE(PG8_SB(1, 0), cB + kstep, voffB); PG8_STAGE(PG8_SA(1, 0), cA + kstep, voffA); PG8_STAGE(PG8_SB(1, 1), cB + hstepB + kstep, voffB);
        PG8_WAIT_V(6); PG8_BAR;
    } else {
        PG8_STAGE(PG8_SB(0, 0), cB, voffB); PG8_STAGE(PG8_SA(0, 0), cA, voffA); PG8_STAGE(PG8_SB(0, 1), cB + hstepB, voffB); PG8_STAGE(PG8_SA(0, 1), cA + hstepA, voffA);
        if (wr == 1) PG8_BAR;
        PG8_WAIT_V(4); PG8_BAR;
        PG8_STAGE(PG8_SB(1, 0), cB + kstep, voffB); PG8_STAGE(PG8_SA(1, 0), cA + kstep, voffA); PG8_STAGE(PG8_SB(1, 1), cB + hstepB + kstep, voffB);
        PG8_WAIT_V(6); PG8_BAR;
    }
    for (;;) {
        const bool has_next = S.next(ui + 1, nxt);
        const char* nA = has_next ? (const char*)g.A + (size_t)nxt.pm * tstepA + S.a_off(nxt) : cA; const char* nB = has_next ? (const char*)g.Bt + (size_t)nxt.pn * tstepB + S.b_off(nxt) : cB;
        const int nt = S.nt(cur, ntd);
#pragma nounroll
        for (int t = 0; t < nt; t += 2) {
            const bool last = (t == nt - 2);
            const char* a1 = cA + (size_t)(t + 1) * kstep;
            const char* a2 = last ? nA : cA + (size_t)(t + 2) * kstep; const char* b2 = last ? nB : cB + (size_t)(t + 2) * kstep;
            const char* a3 = a2 + kstep; const char* b3 = b2 + kstep;
            if (last && has_next) S.a_ready(nxt);
            if constexpr (SP2) {
            PG8_LDB(B0, 0, 0); PG8_LDB(B1, 0, 1); PG8_SCHED; PG8_LDA(At, 0, 0); PG8_STAGE(PG8_SA(1, 1), a1 + hstepA, voffA);
            PG8_WAIT_V(8); PG8_WAIT_L(0); PG8_BAR; PG8_MMA(0, 0, At, B0); PG8_MMA(0, 1, At, B1); PG8_BAR; PG8_SCHED;
            PG8_LDA(At, 0, 1); PG8_STAGE(PG8_SB(0, 0), b2, voffB); PG8_STAGE(PG8_SB(0, 1), b2 + hstepB, voffB); PG8_STAGE(PG8_SA(0, 0), a2, voffA);
            PG8_WAIT_V(8); PG8_WAIT_L(0); PG8_BAR; PG8_MMA(1, 0, At, B0); PG8_MMA(1, 1, At, B1); PG8_BAR; PG8_SCHED;
            PG8_LDB(B0, 1, 0); PG8_LDB(B1, 1, 1); PG8_SCHED; PG8_LDA(At, 1, 0); PG8_STAGE(PG8_SA(0, 1), a2 + hstepA, voffA);
            PG8_WAIT_V(8); PG8_WAIT_L(0); PG8_BAR; PG8_MMA(0, 0, At, B0); PG8_MMA(0, 1, At, B1); PG8_BAR; PG8_SCHED;
            PG8_LDA(At, 1, 1); PG8_STAGE(PG8_SB(1, 0), b3, voffB); PG8_STAGE(PG8_SB(1, 1), b3 + hstepB, voffB); PG8_STAGE(PG8_SA(1, 0), a3, voffA);
            PG8_WAIT_V(8); PG8_WAIT_L(0); PG8_BAR; PG8_MMA(1, 0, At, B0); PG8_MMA(1, 1, At, B1); PG8_BAR; PG8_SCHED;
            } else {
            PG8_LDB(B0, 0, 0); PG8_SCHED; PG8_LDA(At, 0, 0); PG8_STAGE(PG8_SA(1, 1), a1 + hstepA, voffA);
            PG8_WAIT_L(8); PG8_BAR; PG8_WAIT_L(0); PG8_MMA(0, 0, At, B0); PG8_BAR; PG8_SCHED;
            PG8_LDB(B1, 0, 1); PG8_STAGE(PG8_SB(0, 0), b2, voffB);
            PG8_BAR; PG8_WAIT_L(0); PG8_MMA(0, 1, At, B1); PG8_BAR;
            PG8_LDA(At, 0, 1); PG8_STAGE(PG8_SA(0, 0), a2, voffA);
            PG8_BAR; PG8_WAIT_L(0); PG8_MMA(1, 0, At, B0); PG8_BAR; PG8_SCHED;
            PG8_STAGE(PG8_SB(0, 1), b2 + hstepB, voffB);
            PG8_WAIT_V(6); PG8_BAR; PG8_MMA(1, 1, At, B1); PG8_BAR;
            PG8_LDB(B0, 1, 0); PG8_SCHED; PG8_LDA(At, 1, 0); PG8_STAGE(PG8_SA(0, 1), a2 + hstepA, voffA);
            PG8_WAIT_L(8); PG8_BAR; PG8_WAIT_L(0); PG8_MMA(0, 0, At, B0); PG8_BAR; PG8_SCHED;
            PG8_LDB(B1, 1, 1); PG8_STAGE(PG8_SB(1, 0), b3, voffB);
            PG8_BAR; PG8_WAIT_L(0); PG8_MMA(0, 1, At, B1); PG8_BAR;
            PG8_LDA(At, 1, 1); PG8_STAGE(PG8_SA(1, 0), a3, voffA);
            PG8_BAR; PG8_WAIT_L(0); PG8_MMA(1, 0, At, B0); PG8_BAR; PG8_SCHED;
            PG8_STAGE(PG8_SB(1, 1), b3 + hstepB, voffB);
            PG8_WAIT_V(6); PG8_BAR; PG8_MMA(1, 1, At, B1); PG8_BAR;
            }
        }
        if constexpr (ALIGN_EPI) { if (wr == 0) PG8_BAR; }
        if constexpr (!Epi::AFTER_DRAIN) { int t2_ = lane_now(); asm volatile("" : "+v"(t2_));   E(acc, cur, wr, wc, t2_ & 15, (t2_ >> 4) & 3); S.done(cur); }
        if (!has_next) break;
#pragma unroll
        for (int a = 0; a < 2; ++a)
#pragma unroll
            for (int b = 0; b < 2; ++b)
#pragma unroll
                for (int m = 0; m < 4; ++m)
#pragma unroll
                    for (int n = 0; n < 2; ++n) acc[a][b][m][n] = (f32x4){0.f, 0.f, 0.f, 0.f};
        cur = nxt; cA = nA; cB = nB; ++ui;
        if constexpr (ALIGN_EPI) { if (wr == 1) PG8_BAR; }
    }
    PG8_WAIT_V(0);
    if constexpr (!ALIGN_EPI) { if (wr == 0) PG8_BAR; }
    PG8_BAR;
    if constexpr (Epi::AFTER_DRAIN) { E.fused(acc, cur, wr, wc, fr, fq, lds, wid, lane); S.done(cur); }
#undef PG8_SA
#undef PG8_SB
#undef PG8_STAGE
#undef PG8_LDA
#undef PG8_LDB
#undef PG8_MMA
#undef PG8_WAIT_V
#undef PG8_WAIT_L
#undef PG8_BAR
#undef PG8_SCHED
}
}

constexpr int NB = 4, TL = 2048, TCX = 256, DM = 2048, NL = 4, DFF = 8192, BW = 1024;
constexpr int ML = NB * TL, MC = NB * TCX, MT = ML + MC;
constexpr int NIN = 15232, LDP = 15360;
constexpr int C_RET = 0, C_SWA = 4096, C_RW = 5632, C_GATE = 9088, RWIN = 3456;
constexpr int NLR = 5120, KLR = 384;
constexpr int NQK = 1280;
constexpr int NSTEP = 2304, SCAN_BLK = 32;

constexpr size_t al256(size_t x) { return (x + 255) & ~(size_t)255; }
constexpr size_t WS_CTL = 0, CTL_ZERO_BYTES = 1u << 20;
constexpr size_t SZ_WIN = (size_t)LDP * DM * 2, SZ_WBR = (size_t)3 * DM * BW * 2, SZ_WOUT = (size_t)DM * DM * 2, SZ_WFF = (size_t)DFF * DM * 2, SZ_WLR = (size_t)NLR * KLR * 2;
constexpr size_t WS_WIN = CTL_ZERO_BYTES;
constexpr size_t WS_WBR = WS_WIN + NL * SZ_WIN;
constexpr size_t WS_WOUT = WS_WBR + NL * SZ_WBR;
constexpr size_t WS_WFF1 = WS_WOUT + NL * SZ_WOUT;
constexpr size_t WS_WFF2 = WS_WFF1 + NL * SZ_WFF;
constexpr size_t WS_WLR = WS_WFF2 + NL * SZ_WFF;
constexpr size_t WS_H = WS_WLR + NL * SZ_WLR;
constexpr size_t WS_U = WS_H + (size_t)MT * DM * 4;
constexpr size_t WS_P = WS_U + (size_t)MT * DM * 2;
constexpr size_t WS_Y = WS_P + (size_t)MT * LDP * 2;
constexpr size_t WS_MGF = WS_Y + (size_t)MT * 3072 * 2;
constexpr size_t WS_MG = WS_MGF + (size_t)MT * DM * 4;
constexpr size_t WS_F = WS_MG + (size_t)MT * DM * 2;
constexpr size_t WS_MODP = WS_F + (size_t)MT * DFF * 2;
constexpr size_t WS_MOD = WS_MODP + (size_t)8 * NL * 5 * 12288 * 4;
constexpr size_t WS_ROPE = WS_MOD + (size_t)NL * 5 * 12288 * 4;
constexpr size_t WS_XS = WS_ROPE + 64 * 32 * 2 * 4;
constexpr size_t WS_ALR = WS_XS + (size_t)MT * 3072 * 4;
constexpr size_t WS_LR = WS_ALR + (size_t)MT * KLR * 2;
constexpr size_t WS_QKR = WS_LR + (size_t)MT * NLR * 4;
constexpr size_t WS_ST = WS_QKR + (size_t)MT * NQK * 2;
constexpr size_t WS_YDR = WS_ST + (size_t)NB * 8 * 2 * 18 * 128 * 128 * 2;
constexpr size_t WS_YDW = WS_YDR + (size_t)2 * MT * BW * 4;
constexpr size_t RWU = (size_t)NB * 16 * 2 * 36;
constexpr size_t WS_RWY = WS_F;
constexpr size_t WS_RWH = WS_F + RWU * 16384;
constexpr size_t WS_RWP = WS_YDW;
constexpr size_t WS_RWQ = WS_RWP + RWU * 8192;
constexpr size_t WS_RWG = WS_RWQ + RWU * 8192;
constexpr size_t WS_RWS = WS_RWG + RWU * 256;
constexpr size_t WS_END = WS_RWS + RWU * 8192;
static_assert(RWU * 32768 <= (size_t)MT * DFF * 2, "rwkv tiles overlay F");
constexpr size_t WS_VEC = WS_END;
constexpr size_t WS_END2 = WS_VEC + (size_t)NL * 8 * 1024 * 4;
constexpr int CW_BAR = 4096;
constexpr int CW_DBG = 20480;
constexpr int CW_SWAQ = 16384;

constexpr int RING_BYTES = 131072, LDSCTL_OFF = RING_BYTES, MISC_OFF = LDSCTL_OFF + 320, LDS_BYTES = 147456;
constexpr int NWAVES = 8, NTHR = 512;

#define GAS __attribute__((address_space(1)))
#define LAS __attribute__((address_space(3)))
typedef unsigned short bf16;
typedef float f32x4 __attribute__((ext_vector_type(4)));
typedef float f32x2 __attribute__((ext_vector_type(2)));
typedef unsigned u32x4 __attribute__((ext_vector_type(4)));
typedef unsigned u32x2 __attribute__((ext_vector_type(2)));
#define LDS_WAIT() asm volatile("s_waitcnt lgkmcnt(0)" ::: "memory")
#define LB() do { asm volatile("s_waitcnt lgkmcnt(0)" ::: "memory"); __builtin_amdgcn_s_barrier(); asm volatile("" ::: "memory"); } while (0)
#define VM_WAIT() asm volatile("s_waitcnt vmcnt(0)" ::: "memory")
typedef __bf16 bf16x2_t __attribute__((ext_vector_type(2)));
__device__ __forceinline__ unsigned cvtpk(float lo, float hi) { f32x2 v = {lo, hi}; bf16x2_t b = __builtin_convertvector(v, bf16x2_t); return __builtin_bit_cast(unsigned, b); }
__device__ __forceinline__ unsigned f2bf(float f) { return cvtpk(f, 0.f) & 0xffffu; }
__device__ __forceinline__ unsigned pk2(float lo, float hi) { return cvtpk(lo, hi); }
__device__ __forceinline__ float bf2f(bf16 v) { return __uint_as_float((unsigned)v << 16); }
__device__ __forceinline__ float fexp(float x) { return __builtin_amdgcn_exp2f(x * 1.4426950408889634f); }
__device__ __forceinline__ float sigm(float x) { return __builtin_amdgcn_rcpf(1.0f + __builtin_amdgcn_exp2f(x * -1.4426950408889634f)); }
__device__ __forceinline__ float ftanh(float x) { return 1.0f - 2.0f * __builtin_amdgcn_rcpf(1.0f + __builtin_amdgcn_exp2f(x * 2.8853900817779268f)); }
using pg8::bf_lo; using pg8::bf_hi;
__device__ __forceinline__ float shx(float v, int m, int lane) { return __int_as_float(__builtin_amdgcn_ds_bpermute((lane ^ m) << 2, __float_as_int(v))); }
__device__ __forceinline__ float lanefrom(float v, int src) { return __int_as_float(__builtin_amdgcn_ds_bpermute((src & 63) << 2, __float_as_int(v))); }
__device__ __forceinline__ float wave_sum(float v, int lane) {
#pragma unroll
    for (int o = 1; o < 64; o <<= 1) v += shx(v, o, lane);
    return v;
}
__device__ __forceinline__ float wave_max(float v, int lane) {
#pragma unroll
    for (int o = 1; o < 64; o <<= 1) v = fmaxf(v, shx(v, o, lane));
    return v;
}

#ifdef TS_DEBUG
#define TS_BEGIN(id) unsigned long long ts_##id = __builtin_amdgcn_s_memrealtime()
#define TS_END(id) do { if (F.wg == TS_WG && F.tid == 0) if ((id) == TS_SEL) atomicAdd(F.ctl + CW_DBG + 8, (unsigned)(__builtin_amdgcn_s_memrealtime() - ts_##id)); } while (0)
#else
#define TS_BEGIN(id)
#define TS_END(id)
#endif
#define XB_TMO      128
#define XB_XCNT(j)  (256  + 64 * (j))
#define XB_XSUB(j)  (1280 + 64 * (j))
#define XB_XGEN(j)  (2304 + 64 * (j))
#define XB_TOP      3328
#define XB_TOPGEN   3392
#define XCD_BAR_WORDS 3456
#define XB_SPIN_CAP (1u << 22)
__device__ __forceinline__ unsigned xb_ld(unsigned* p)              { return __hip_atomic_load(p, __ATOMIC_RELAXED, __HIP_MEMORY_SCOPE_AGENT); }
__device__ __forceinline__ unsigned xb_add(unsigned* p, unsigned v) { return __hip_atomic_fetch_add(p, v, __ATOMIC_RELAXED, __HIP_MEMORY_SCOPE_AGENT); }
__device__ __forceinline__ unsigned xb_xcc_id() { return (unsigned)__builtin_amdgcn_s_getreg((3 << 11) | 20) & 0xFu; }
#define XB_SPIN(cond, bar) do { unsigned _sp = 0; while (cond) { __builtin_amdgcn_s_sleep(1); \
    if ((++_sp & 255u) == 0u) { if (xb_ld(&(bar)[XB_TMO])) break; if (_sp > XB_SPIN_CAP) { atomicAdd(&(bar)[XB_TMO], 1u); break; } } } } while (0)
struct XcdBarrier { unsigned* bar; unsigned x; volatile LAS unsigned* st; };
__device__ __forceinline__ XcdBarrier xcd_barrier_post(unsigned* bar, volatile LAS unsigned* st) {
    XcdBarrier b; b.bar = bar; b.x = xb_xcc_id(); b.st = st;
    if (threadIdx.x == 0) (void)xb_add(&bar[XB_XCNT(b.x)], 1u);
    return b;
}
__device__ __forceinline__ void xcd_barrier_complete(unsigned* bar, unsigned x, unsigned& nloc, unsigned& nx) {
    const unsigned G = gridDim.x * gridDim.y * gridDim.z;
    unsigned sum, cnt, mine, sp = 0u;
    for (;;) {
        sum = 0u; cnt = 0u; mine = 0u;
#pragma unroll
        for (unsigned j = 0; j < 16; ++j) { const unsigned c = xb_ld(&bar[XB_XCNT(j)]); sum += c; cnt += (c > 0u) ? 1u : 0u; mine = (j == x) ? c : mine; }
        if (sum == G) break;
        __builtin_amdgcn_s_sleep(1);
        if ((++sp & 255u) == 0u) { if (xb_ld(&bar[XB_TMO])) break; if (sp > XB_SPIN_CAP) { atomicAdd(&bar[XB_TMO], 1u); break; } }
    }
    nloc = mine > 0u ? mine : 1u; nx = cnt > 0u ? cnt : 1u;
}
__device__ __forceinline__ void xcd_barrier(const XcdBarrier& b, const bool thread0  ) {
    asm volatile("s_waitcnt vmcnt(0)" ::: "memory");
    __syncthreads();
    if (thread0) {
        unsigned* bar = b.bar; unsigned bx = b.x;
        asm volatile("" : "+s"(bar), "+s"(bx));
        __builtin_amdgcn_s_waitcnt(0);
        unsigned nloc = b.st[0], nx = b.st[1];
        if (nloc == 0u) { xcd_barrier_complete(bar, bx, nloc, nx); b.st[0] = nloc; b.st[1] = nx; }
        const unsigned old = xb_add(&bar[XB_XSUB(bx)], 1u);
        const unsigned gen = old / nloc;
        if (old + 1u == (gen + 1u) * nloc) {
            __builtin_amdgcn_fence(__ATOMIC_RELEASE, "agent");
            asm volatile("s_waitcnt vmcnt(0)" ::: "memory");
            const unsigned og = xb_add(&bar[XB_TOP], 1u);
            const unsigned tg = og / nx;
            if (og + 1u == (tg + 1u) * nx) xb_add(&bar[XB_TOPGEN], 1u);
            else XB_SPIN(xb_ld(&bar[XB_TOPGEN]) == tg, bar);
            __builtin_amdgcn_fence(__ATOMIC_ACQUIRE, "agent");
            xb_add(&bar[XB_XGEN(bx)], 1u);
            asm volatile("s_waitcnt vmcnt(0)" ::: "memory");
        } else {
            XB_SPIN(xb_ld(&bar[XB_XGEN(bx)]) == gen, bar);
            __builtin_amdgcn_fence(__ATOMIC_ACQUIRE, "agent");
            asm volatile("s_waitcnt vmcnt(0)" ::: "memory");
        }
    }
    __syncthreads();
}

struct Args { const float* in[26]; float* out; unsigned char* ws; int s_lo, s_hi; };
enum { I_X = 0, I_C, I_CTX, I_CCTX, I_N1G, I_N2G, I_WMOD, I_BMOD, I_WIN, I_RETDEC, I_SINK, I_MU, I_W0, I_WUP, I_A0, I_AUP, I_GUP, I_KK, I_KA, I_RK, I_LNG, I_WBR, I_WOUT, I_WFF1, I_WFF2, I_FING };
struct Frame {
    LAS unsigned char* lds;
    unsigned* ctl;
    int tid, lane, wave, G, wg;
    unsigned char* ws;
};
template <class T> __device__ __forceinline__ T* wsp(const Frame& F, size_t off) { return (T*)(F.ws + off); }
constexpr int PTAB_OFF = LDSCTL_OFF + 64;
__device__ __forceinline__ const float* inp(const Frame& F, int i) {
    const LAS unsigned* t = (const LAS unsigned*)(F.lds + PTAB_OFF) + 2 * i;
    const unsigned lo = __builtin_amdgcn_readfirstlane(t[0]), hi = __builtin_amdgcn_readfirstlane(t[1]);
    return (const float*)(GAS const float*)(((unsigned long long)hi << 32) | (unsigned long long)lo);
}

__device__ __forceinline__ int scan_row(int b, int dir, int s) {
    if (s < TCX) return ML + b * TCX + (dir ? (TCX - 1 - s) : s);
    const int t = s - TCX; return b * TL + (dir ? (TL - 1 - t) : t);
}

constexpr int CONV_IT_IN = (DM / 64) * (NIN / 64), CONV_IT_BR = (BW / 64) * (DM / 64), CONV_IT_OUT = (DM / 64) * (DM / 64), CONV_IT_F1 = (DM / 64) * (DFF / 64), CONV_IT_F2 = (DFF / 64) * (DM / 64);
constexpr int CONV_IT_L = CONV_IT_IN + 3 * CONV_IT_BR + CONV_IT_OUT + CONV_IT_F1 + CONV_IT_F2;
constexpr int CONV_WG_ITEMS = CONV_IT_L / 8;
static_assert(CONV_IT_L % 8 == 0, "conversion items per layer");
constexpr int CW_CONVQ = 24576;
struct ConvDesc { const float* W; bf16* WT; int K, N, k0, n0; };
__device__ __forceinline__ ConvDesc conv_desc(Frame& F, int l, int r) {
    ConvDesc d; int item;
    if (r < CONV_IT_IN) { d.W = inp(F, I_WIN) + (size_t)l * DM * NIN; d.K = DM; d.N = NIN; d.WT = wsp<bf16>(F, WS_WIN + l * SZ_WIN); item = r; }
    else if ((r -= CONV_IT_IN) < 3 * CONV_IT_BR) { const int n = r / CONV_IT_BR; d.W = inp(F, I_WBR) + ((size_t)l * 3 + n) * BW * DM; d.K = BW; d.N = DM; d.WT = wsp<bf16>(F, WS_WBR + l * SZ_WBR) + (size_t)n * DM * BW; item = r % CONV_IT_BR; }
    else if ((r -= 3 * CONV_IT_BR) < CONV_IT_OUT) { d.W = inp(F, I_WOUT) + (size_t)l * DM * DM; d.K = DM; d.N = DM; d.WT = wsp<bf16>(F, WS_WOUT + l * SZ_WOUT); item = r; }
    else if ((r -= CONV_IT_OUT) < CONV_IT_F1) { d.W = inp(F, I_WFF1) + (size_t)l * DM * DFF; d.K = DM; d.N = DFF; d.WT = wsp<bf16>(F, WS_WFF1 + l * SZ_WFF); item = r; }
    else { r -= CONV_IT_F1; d.W = inp(F, I_WFF2) + (size_t)l * DFF * DM; d.K = DFF; d.N = DM; d.WT = wsp<bf16>(F, WS_WFF2 + l * SZ_WFF); item = r; }
    const int nblk = d.N / 64; d.k0 = 64 * (item / nblk); d.n0 = 64 * (item % nblk);
    return d;
}
__device__ __forceinline__ void tr_load(const ConvDesc& d, int lane, f32x4 (&v)[16]) {
    const int kr = lane >> 4, nc = (lane & 15) * 4;
#pragma unroll
    for (int i = 0; i < 16; ++i) v[i] = __builtin_nontemporal_load((const f32x4*)(d.W + (size_t)(d.k0 + 8 * (i >> 1) + 2 * kr + (i & 1)) * d.N + d.n0 + nc));
}
__device__ __forceinline__ void tr_store(const ConvDesc& d, int lane, LAS unsigned char* scr, const f32x4 (&v)[16]) {
    const int kr = lane >> 4, nc = (lane & 15) * 4, sw = 4 * ((lane >> 2) & 3);
    LAS unsigned* t = (LAS unsigned*)scr + nc * 36;
#pragma unroll
    for (int m = 0; m < 8; ++m) { const int kp = (4 * m + kr) ^ sw;
        t[kp] = cvtpk(v[2 * m].x, v[2 * m + 1].x); t[36 + kp] = cvtpk(v[2 * m].y, v[2 * m + 1].y); t[72 + kp] = cvtpk(v[2 * m].z, v[2 * m + 1].z); t[108 + kp] = cvtpk(v[2 * m].w, v[2 * m + 1].w); }
    LDS_WAIT(); asm volatile("" ::: "memory");
    const int c = lane & 7;
#pragma unroll
    for (int j = 0; j < 8; ++j) { const int n = (lane >> 3) + 8 * j;
        __builtin_nontemporal_store(*(const LAS u32x4*)(scr + n * 144 + 16 * (c ^ ((n >> 4) & 3))), (u32x4*)(d.WT + (size_t)(d.n0 + n) * d.K + d.k0 + 8 * c)); }
    LDS_WAIT(); asm volatile("" ::: "memory");
}
__device__ __forceinline__ void conv_wave_item(Frame& F, int l, int r, LAS unsigned char* scr) { const ConvDesc d = conv_desc(F, l, r); f32x4 v[16]; tr_load(d, F.lane, v); tr_store(d, F.lane, scr, v); }
constexpr int CONV_Q0 = (CONV_IT_L - CONV_IT_IN) / 8;
constexpr int CONV_QTOT = CONV_Q0 + (NL - 1) * CONV_WG_ITEMS;
static_assert(CONV_WG_ITEMS % 4 == 0 && CONV_Q0 % 4 == 0 && (CONV_IT_L - CONV_IT_IN) % 8 == 0, "conversion ranges");
__device__ __forceinline__ ConvDesc conv_desc_q(Frame& F, int gw) {
    if (gw < CONV_Q0 * 8) return conv_desc(F, 0, CONV_IT_IN + gw);
    gw -= CONV_Q0 * 8; const int l = gw / CONV_IT_L;
    return conv_desc(F, 1 + l, gw - l * CONV_IT_L);
}
__device__ __forceinline__ int conv_deadline(int layer) { return CONV_Q0 + (layer - 1) * CONV_WG_ITEMS + CONV_WG_ITEMS; }
__device__ __forceinline__ void conv_pull(Frame& F, int nr, int limit) {
    volatile LAS int* qslot = (volatile LAS int*)(F.lds + LDSCTL_OFF);
    LAS unsigned char* scr = F.lds + F.wave * 9216;
    for (int n = 0; nr < 0 || n < nr; ++n) {
        __syncthreads();
        if (F.tid == 0) { int it = (int)__hip_atomic_load(F.ctl + CW_CONVQ, __ATOMIC_RELAXED, __HIP_MEMORY_SCOPE_AGENT);
            if (it < limit) it = (int)__hip_atomic_fetch_add(F.ctl + CW_CONVQ, 4u, __ATOMIC_RELAXED, __HIP_MEMORY_SCOPE_AGENT); else it = CONV_QTOT;
            qslot[0] = it; }
        __syncthreads();
        const int item = qslot[0];
        if (item >= CONV_QTOT) break;
        const int r0 = item * 8 + F.wave;
        f32x4 va[16], vb[16];
        const ConvDesc d0 = conv_desc_q(F, r0), d1 = conv_desc_q(F, r0 + 8);
        tr_load(d0, F.lane, va);
        tr_load(d1, F.lane, vb);
        tr_store(d0, F.lane, scr, va);
        const ConvDesc d2 = conv_desc_q(F, r0 + 16);
        tr_load(d2, F.lane, va);
        tr_store(d1, F.lane, scr, vb);
        const ConvDesc d3 = conv_desc_q(F, r0 + 24);
        tr_load(d3, F.lane, vb);
        tr_store(d2, F.lane, scr, va);
        tr_store(d3, F.lane, scr, vb);
    }
    __syncthreads();
}
__device__ __forceinline__ void p0_prologue(Frame& F) {
    const int gw = F.wg * NWAVES + F.wave, NGW = F.G * NWAVES;
    const int gt = F.wg * NTHR + F.tid, NGT = F.G * NTHR;
    LAS float* sil = (LAS float*)(F.lds + 81920);
    for (int e = F.tid; e < 5 * DM; e += NTHR) { const int r = e / DM, k = e % DM; const float v = r < 4 ? inp(F, I_C)[r * DM + k] : inp(F, I_CCTX)[k]; sil[e] = v * sigm(v); }
    { LAS unsigned char* scr = F.lds + F.wave * 9216;
      for (int it = gw; it < CONV_IT_IN; it += NGW) conv_wave_item(F, 0, it, scr); }
    for (int e = gt; e < NL * (LDP - NIN) * DM / 8; e += NGT) { const int l = e / ((LDP - NIN) * DM / 8), r = e % ((LDP - NIN) * DM / 8);
        *(u32x4*)(wsp<bf16>(F, WS_WIN + l * SZ_WIN) + (size_t)NIN * DM + (size_t)r * 8) = (u32x4){0u, 0u, 0u, 0u}; }
    for (int e = gt; e < NL * (KLR / 8) * NLR; e += NGT) {
        const int n = e % NLR, kg = (e / NLR) % (KLR / 8), l = e / (NLR * (KLR / 8)), k0 = 8 * kg;
        const float* src = nullptr;
        if (n < 2048) { const int d = n >> 10; if (kg >= 8 * d && kg < 8 * d + 8) src = inp(F, I_WUP) + (((size_t)l * 2 + d) * 64 + (k0 - 64 * d)) * BW + (n & 1023); }
        else if (n < 4096) { const int d = (n - 2048) >> 10; if (kg >= 16 + 8 * d && kg < 24 + 8 * d) src = inp(F, I_AUP) + (((size_t)l * 2 + d) * 64 + (k0 - 128 - 64 * d)) * BW + (n & 1023); }
        else if (kg >= 32) src = inp(F, I_GUP) + ((size_t)l * 128 + (k0 - 256)) * BW + (n - 4096);
        u32x4 o = {0u, 0u, 0u, 0u};
        if (src) { float v[8];
#pragma unroll
            for (int j = 0; j < 8; ++j) v[j] = src[(size_t)j * BW];
            o.x = pk2(v[0], v[1]); o.y = pk2(v[2], v[3]); o.z = pk2(v[4], v[5]); o.w = pk2(v[6], v[7]); }
        *(u32x4*)(wsp<bf16>(F, WS_WLR + l * SZ_WLR) + (size_t)n * KLR + k0) = o;
    }
    { const f32x4* x4 = (const f32x4*)inp(F, I_X); const f32x4* c4 = (const f32x4*)inp(F, I_CTX); u32x2* h4 = wsp<u32x2>(F, WS_H);
      for (int e = gt; e < ML * DM / 4; e += 4 * NGT) { f32x4 x[4];
#pragma unroll
          for (int k = 0; k < 4; ++k) { const int i = e + k * NGT; x[k] = x4[i < ML * DM / 4 ? i : e]; }
#pragma unroll
          for (int k = 0; k < 4; ++k) { const int i = e + k * NGT; if (i < ML * DM / 4) { u32x2 w; w.x = pk2(x[k].x, x[k].y); w.y = pk2(x[k].z, x[k].w); h4[i] = w; } } }
      for (int e = gt; e < MC * DM / 4; e += 4 * NGT) { f32x4 x[4];
#pragma unroll
          for (int k = 0; k < 4; ++k) { const int i = e + k * NGT; x[k] = c4[i < MC * DM / 4 ? i : e]; }
#pragma unroll
          for (int k = 0; k < 4; ++k) { const int i = e + k * NGT; if (i < MC * DM / 4) { u32x2 w; w.x = pk2(x[k].x, x[k].y); w.y = pk2(x[k].z, x[k].w); h4[ML * DM / 4 + i] = w; } } } }
    for (int e = gt; e < NL * 8 * 1024; e += NGT) { const int l = e >> 13, v = (e >> 10) & 7, c = e & 1023; float x;
        if (v < 2) x = inp(F, I_W0)[(l * 2 + v) * 1024 + c]; else if (v < 4) x = inp(F, I_A0)[(l * 2 + v - 2) * 1024 + c];
        else if (v == 4) x = inp(F, I_KK)[l * 1024 + c]; else if (v == 5) x = inp(F, I_KA)[l * 1024 + c]; else if (v == 6) x = inp(F, I_RK)[l * 1024 + c]; else x = inp(F, I_LNG)[l * 1024 + c];
        wsp<float>(F, WS_VEC)[e] = x; }
    if (gt < 64 * 32) { const int pos = gt >> 5, i = gt & 31; const float inv = powf(10000.0f, -(float)i / 32.0f); const float ang = (float)pos * inv;
        wsp<float>(F, WS_ROPE)[2 * gt] = cosf(ang); wsp<float>(F, WS_ROPE)[2 * gt + 1] = sinf(ang); }
    __syncthreads();
    for (int it = gw; it < NL * 8 * 48; it += NGW) {
        const int l = it / (8 * 48), kc = (it / 48) % 8, cc = it % 48, col = cc * 256 + F.lane * 4, k0 = kc * 256;
        const float* wp = inp(F, I_WMOD) + ((size_t)l * DM + k0) * 12288 + col;
        f32x4 a0 = {0.f, 0.f, 0.f, 0.f}, a1 = a0, a2 = a0, a3 = a0, a4 = a0;
#pragma unroll 16
        for (int k = 0; k < 256; ++k) { const f32x4 w = *(const f32x4*)(wp + (size_t)k * 12288);
            a0 += sil[0 * DM + k0 + k] * w; a1 += sil[1 * DM + k0 + k] * w; a2 += sil[2 * DM + k0 + k] * w; a3 += sil[3 * DM + k0 + k] * w; a4 += sil[4 * DM + k0 + k] * w; }
        float* mp = wsp<float>(F, WS_MODP) + ((size_t)(kc * NL + l) * 5) * 12288 + col;
        *(f32x4*)(mp) = a0; *(f32x4*)(mp + 12288) = a1; *(f32x4*)(mp + 2 * 12288) = a2; *(f32x4*)(mp + 3 * 12288) = a3; *(f32x4*)(mp + 4 * 12288) = a4;
    }
}
__device__ __forceinline__ void p1_modreduce(Frame& F) {
    const int gt = F.wg * NTHR + F.tid, NGT = F.G * NTHR;
    for (int e = gt; e < NL * 5 * 12288; e += NGT) { const int l = e / (5 * 12288), j = e % 12288;
        float s = inp(F, I_BMOD)[l * 12288 + j];
#pragma unroll
        for (int kc = 0; kc < 8; ++kc) s += wsp<float>(F, WS_MODP)[(size_t)kc * NL * 5 * 12288 + e];
        wsp<float>(F, WS_MOD)[e] = s; }
}

struct NormIn { u32x2 h[8]; u32x2 d[8]; u32x2 e[8]; };
__device__ __forceinline__ void norm_fetch(Frame& F, int row, int nd, NormIn& in) {
    const u32x2* xr = (const u32x2*)(wsp<bf16>(F, WS_H) + (size_t)row * DM) + F.lane;
    const u32x2* pp = (const u32x2*)(wsp<bf16>(F, WS_MGF) + (size_t)row * DM) + F.lane;
    const u32x2* pe = nd == 2 ? pp + (size_t)ML * DM / 4 : pp;
#pragma unroll
    for (int j = 0; j < 8; ++j) in.h[j] = xr[64 * j];
#pragma unroll
    for (int j = 0; j < 8; ++j) in.d[j] = pp[64 * j];
#pragma unroll
    for (int j = 0; j < 8; ++j) in.e[j] = pe[64 * j];
}
__device__ __forceinline__ void norm_finish(Frame& F, bool wb, int row, int mr, f32x4 (&v)[8]) {
    const LAS float* LA = (const LAS float*)F.lds + mr * DM; const LAS float* LB = LA + 5 * DM;
    if (wb) { u32x2* xw = (u32x2*)(wsp<bf16>(F, WS_H) + (size_t)row * DM) + F.lane;
#pragma unroll
        for (int j = 0; j < 8; ++j) { u32x2 w; w.x = pk2(v[j].x, v[j].y); w.y = pk2(v[j].z, v[j].w); xw[64 * j] = w; } }
    float ss = 0.f;
#pragma unroll
    for (int j = 0; j < 8; ++j) ss += (v[j].x * v[j].x + v[j].y * v[j].y) + (v[j].z * v[j].z + v[j].w * v[j].w);
    const float rs = __builtin_amdgcn_rsqf(wave_sum(ss, F.lane) * (1.0f / DM) + 1e-6f);
    u32x2* o = (u32x2*)(wsp<bf16>(F, WS_U) + (size_t)row * DM) + F.lane;
    asm volatile("" ::: "memory");
#pragma unroll
    for (int j = 0; j < 8; ++j) { const int c = 4 * F.lane + 256 * j;
        const f32x4 y = (v[j] * rs) * *(const LAS f32x4*)(LA + c) + *(const LAS f32x4*)(LB + c);
        u32x2 w; w.x = pk2(y.x, y.y); w.y = pk2(y.z, y.w); o[64 * j] = w; }
}
__device__ __forceinline__ void norm_row(Frame& F, int nd, int row, const NormIn& in) {
    f32x4 v[8];
#pragma unroll
    for (int j = 0; j < 8; ++j) { const u32x2 w = in.h[j]; v[j] = (f32x4){bf_lo(w.x), bf_hi(w.x), bf_lo(w.y), bf_hi(w.y)}; }
    if (nd >= 1) {
#pragma unroll
        for (int j = 0; j < 8; ++j) { const u32x2 w = in.d[j]; v[j] += (f32x4){bf_lo(w.x), bf_hi(w.x), bf_lo(w.y), bf_hi(w.y)}; } }
    if (nd == 2) {
#pragma unroll
        for (int j = 0; j < 8; ++j) { const u32x2 w = in.e[j]; v[j] += (f32x4){bf_lo(w.x), bf_hi(w.x), bf_lo(w.y), bf_hi(w.y)}; } }
    norm_finish(F, nd == 2, row, row >> 11, v);
}
__device__ __forceinline__ void norm_ctx_row(Frame& F, bool partials, int row) {
    f32x4 v[8];
    { const u32x2* xr = (const u32x2*)(wsp<bf16>(F, WS_H) + (size_t)row * DM) + F.lane; u32x2 h[8];
#pragma unroll
      for (int j = 0; j < 8; ++j) h[j] = xr[64 * j];
#pragma unroll
      for (int j = 0; j < 8; ++j) v[j] = (f32x4){bf_lo(h[j].x), bf_hi(h[j].x), bf_lo(h[j].y), bf_hi(h[j].y)}; }
    if (partials) {
        const u32x2* pp = (const u32x2*)(wsp<bf16>(F, WS_YDR) + (size_t)(row - ML) * DM) + F.lane;
#pragma unroll 1
        for (int s = 0; s < 8; s += 2) { u32x2 pw[2][8];
#pragma unroll
            for (int j = 0; j < 8; ++j) { pw[0][j] = pp[(size_t)s * 1024 * DM / 4 + 64 * j]; pw[1][j] = pp[(size_t)(s + 1) * 1024 * DM / 4 + 64 * j]; }
#pragma unroll
            for (int j = 0; j < 8; ++j) { const u32x2 w = pw[0][j], x = pw[1][j];
                v[j] += (f32x4){bf_lo(w.x), bf_hi(w.x), bf_lo(w.y), bf_hi(w.y)}; v[j] += (f32x4){bf_lo(x.x), bf_hi(x.x), bf_lo(x.y), bf_hi(x.y)}; } }
    }
    norm_finish(F, partials, row, 4, v);
}
__device__ __forceinline__ void norm_phase(Frame& F, int layer, int which, int nrows, bool partials) {
    const int gw = F.wg * NWAVES + F.wave, NGW = F.G * NWAVES;
    { const float* gptr = inp(F, which ? I_N2G : I_N1G) + layer * DM; const float* modb = wsp<float>(F, WS_MOD) + (size_t)layer * 5 * 12288 + (which ? 3 * DM : 0);
      LAS float* LA = (LAS float*)F.lds; LAS float* LB = LA + 5 * DM;
      for (int e = F.tid; e < 5 * (DM / 4); e += NTHR) { const int mr = e / (DM / 4), c = (e % (DM / 4)) * 4;
          const f32x4 g = *(const f32x4*)(gptr + c), sh = *(const f32x4*)(modb + (size_t)mr * 12288 + c), sc = *(const f32x4*)(modb + (size_t)mr * 12288 + DM + c);
          *(LAS f32x4*)(LA + mr * DM + c) = g * (1.0f + sc); *(LAS f32x4*)(LB + mr * DM + c) = sh; }
      __syncthreads(); }
    for (int row = ML + ((gw + NGW / 2) % NGW); row < nrows; row += NGW) norm_ctx_row(F, partials, row);
    int row = gw; if (row >= ML) return;
    const int nd = partials ? (which ? 1 : 2) : 0;
    NormIn a, b; norm_fetch(F, row, nd, a);
    for (;;) {
        const int r1 = row + NGW; const bool h1 = r1 < ML; norm_fetch(F, h1 ? r1 : row, nd, b);
        norm_row(F, nd, row, a);
        if (!h1) break;
        const int r2 = r1 + NGW; const bool h2 = r2 < ML; norm_fetch(F, h2 ? r2 : r1, nd, a);
        norm_row(F, nd, r1, b);
        if (!h2) break;
        row = r2;
    }
}
__device__ __forceinline__ void final_norm(Frame& F, float* out) {
    const int gw = F.wg * NWAVES + F.wave, NGW = F.G * NWAVES;
#ifdef TS_DEBUG
    const float dbg_e0 = (float)F.ctl[CW_DBG + 8] * TS_SCALE, dbg_e1 = 0.f;
#endif
#ifdef RW_DEBUG
    const float* dst_ = (const float*)(F.ctl + CW_DBG); const float er0_ = sqrtf(dst_[0] / fmaxf(dst_[1], 1e-30f)), er1_ = sqrtf(dst_[2] / fmaxf(dst_[3], 1e-30f)); const float dbg_e0 = er0_ > RW_DEBUG_THR ? 0.3f : 0.0f, dbg_e1 = er1_ > RW_DEBUG_THR ? 0.6f : 0.0f;
#endif
    LAS float* LG = (LAS float*)F.lds;
    for (int e = F.tid; e < DM / 4; e += NTHR) *(LAS f32x4*)(LG + 4 * e) = *(const f32x4*)(inp(F, I_FING) + 4 * e);
    __syncthreads();
    for (int row = gw; row < ML; row += NGW) {
        const u32x2* xr = (const u32x2*)(wsp<bf16>(F, WS_H) + (size_t)row * DM) + F.lane;
        const u32x2* pp = (const u32x2*)(wsp<bf16>(F, WS_MGF) + (size_t)row * DM) + F.lane;
        f32x4 v[8]; float ss = 0.f; u32x2 hw[8], d1[8], d2[8];
#pragma unroll
        for (int j = 0; j < 8; ++j) { hw[j] = xr[64 * j]; d1[j] = pp[64 * j]; d2[j] = pp[(size_t)ML * DM / 4 + 64 * j]; }
        asm volatile("" ::: "memory");
#pragma unroll
        for (int j = 0; j < 8; ++j) { const u32x2 h = hw[j], w = d1[j], x = d2[j]; v[j] = (f32x4){bf_lo(h.x), bf_hi(h.x), bf_lo(h.y), bf_hi(h.y)};
            v[j] += (f32x4){bf_lo(w.x), bf_hi(w.x), bf_lo(w.y), bf_hi(w.y)}; v[j] += (f32x4){bf_lo(x.x), bf_hi(x.x), bf_lo(x.y), bf_hi(x.y)}; }
#pragma unroll
        for (int j = 0; j < 8; ++j) ss += (v[j].x * v[j].x + v[j].y * v[j].y) + (v[j].z * v[j].z + v[j].w * v[j].w);
        const float rs = __builtin_amdgcn_rsqf(wave_sum(ss, F.lane) * (1.0f / DM) + 1e-6f);
        f32x4* o = (f32x4*)(out + (size_t)row * DM) + F.lane;
#pragma unroll
        for (int j = 0; j < 8; ++j) { const f32x4 g = *(const LAS f32x4*)(LG + 4 * F.lane + 256 * j); f32x4 ov = (v[j] * rs) * g;
#if defined(RW_DEBUG) || defined(TS_DEBUG)
#ifndef RW_DEBUG_NOSTAT
            ov += dbg_e0; if (row == 0 && j == 0 && F.lane == 0) ov.x += dbg_e1;
#endif
#endif
            o[64 * j] = ov; }
    }
}
__device__ __forceinline__ void prep_phase(Frame& F, int layer) {
    const int gw = F.wg * NWAVES + F.wave, NGW = F.G * NWAVES;
    const bf16* P = wsp<bf16>(F, WS_P);
    LAS float* Lmu0 = (LAS float*)F.lds; LAS float* Lmu1 = Lmu0 + RWIN; LAS float* Lrope = Lmu1 + RWIN;
    { const float* mu0 = inp(F, I_MU) + (size_t)layer * 2 * RWIN; const float* rope = wsp<float>(F, WS_ROPE);
      for (int e = F.tid; e < 2 * RWIN / 4; e += NTHR) *(LAS f32x4*)(Lmu0 + 4 * e) = *(const f32x4*)(mu0 + 4 * e);
      for (int e = F.tid; e < 64 * 32 * 2 / 4; e += NTHR) *(LAS f32x4*)(Lrope + 4 * e) = *(const f32x4*)(rope + 4 * e);
      __syncthreads(); }
    for (int row = gw; row < MT; row += NGW) {
        bool first, last; int t = 0;
        if (row < ML) { t = row & (TL - 1); first = t == 0; last = t == TL - 1; } else { const int c = (row - ML) & (TCX - 1); first = c == 0; last = c == TCX - 1; }
        const bf16* pr = P + (size_t)row * LDP + C_RW; const bf16* pv = first ? pr : pr - LDP; const bf16* pn = last ? pr : pr + LDP;
        const bf16* ps = P + (size_t)row * LDP + C_SWA;
        u32x4 pw[7], vw[7], nw[7]; unsigned rx[3][4];
#pragma unroll
        for (int p = 0; p < 7; ++p) { int j8 = F.lane + 64 * p; j8 = j8 < RWIN / 8 ? j8 : RWIN / 8 - 1; const int c = 8 * j8;
            pw[p] = *(const u32x4*)(pr + c); vw[p] = *(const u32x4*)(pv + c); nw[p] = *(const u32x4*)(pn + c); }
#pragma unroll
        for (int q = 0; q < 3; ++q) { int tk = F.lane + 64 * q; tk = tk < 160 ? tk : 159; const bf16* ph = ps + (tk >> 4) * 128 + (tk & 15) * 2;
            rx[q][0] = *(const unsigned*)(ph); rx[q][1] = *(const unsigned*)(ph + 32); rx[q][2] = *(const unsigned*)(ph + 64); rx[q][3] = *(const unsigned*)(ph + 96); }
        asm volatile("" ::: "memory");
        bf16* xs = wsp<bf16>(F, WS_XS) + (size_t)row * 3072; bf16* alr = wsp<bf16>(F, WS_ALR) + (size_t)row * KLR;
#pragma unroll
        for (int p = 0; p < 7; ++p) { const int j8 = F.lane + 64 * p;
            if (j8 < RWIN / 8) { const int c = 8 * j8;
                const u32x4 cw = pw[p]; const u32x4 vv = first ? (u32x4){0u, 0u, 0u, 0u} : vw[p]; const u32x4 nn = last ? (u32x4){0u, 0u, 0u, 0u} : nw[p];
                const f32x4 ma = *(const LAS f32x4*)(Lmu0 + c), mb = *(const LAS f32x4*)(Lmu0 + c + 4), na = *(const LAS f32x4*)(Lmu1 + c), nb = *(const LAS f32x4*)(Lmu1 + c + 4);
                float s[8];
#pragma unroll
                for (int e = 0; e < 4; ++e) { const float p0 = bf_lo(cw[e]), p1 = bf_hi(cw[e]), v0 = bf_lo(vv[e]), v1 = bf_hi(vv[e]), n0 = bf_lo(nn[e]), n1 = bf_hi(nn[e]);
                    const float m0 = e < 2 ? ma[2 * e] : mb[2 * e - 4], m1 = e < 2 ? ma[2 * e + 1] : mb[2 * e - 3], q0 = e < 2 ? na[2 * e] : nb[2 * e - 4], q1 = e < 2 ? na[2 * e + 1] : nb[2 * e - 3];
                    s[2 * e] = p0 + m0 * (v0 - p0) + q0 * (n0 - p0); s[2 * e + 1] = p1 + m1 * (v1 - p1) + q1 * (n1 - p1); }
                if (c < 3072) { u32x4 o; o.x = pk2(s[0], s[1]); o.y = pk2(s[2], s[3]); o.z = pk2(s[4], s[5]); o.w = pk2(s[6], s[7]); *(u32x4*)(xs + c) = o; }
                else { u32x4 o; int dst;
                    if (c < 3200) { dst = c - 3072; o.x = pk2(ftanh(s[0]), ftanh(s[1])); o.y = pk2(ftanh(s[2]), ftanh(s[3])); o.z = pk2(ftanh(s[4]), ftanh(s[5])); o.w = pk2(ftanh(s[6]), ftanh(s[7])); }
                    else if (c < 3328) { dst = 128 + c - 3200; o.x = pk2(s[0], s[1]); o.y = pk2(s[2], s[3]); o.z = pk2(s[4], s[5]); o.w = pk2(s[6], s[7]); }
                    else { dst = 256 + c - 3328; o.x = pk2(sigm(s[0]), sigm(s[1])); o.y = pk2(sigm(s[2]), sigm(s[3])); o.z = pk2(sigm(s[4]), sigm(s[5])); o.w = pk2(sigm(s[6]), sigm(s[7])); }
                    *(u32x4*)(alr + dst) = o; } } }
        bf16* qk = wsp<bf16>(F, WS_QKR) + (size_t)row * NQK;
        const bool lat = row < ML; const int rr = t >> 6, cc = t & 63;
#pragma unroll
        for (int q = 0; q < 3; ++q) { const int tk = F.lane + 64 * q;
            if (tk < 160) { const int hd = tk >> 4, i2 = (tk & 15) * 2;
                f32x4 tr = {1.f, 0.f, 1.f, 0.f}, tc = tr;
                if (lat) { tr = *(const LAS f32x4*)(Lrope + (rr * 32 + i2) * 2); tc = *(const LAS f32x4*)(Lrope + (cc * 32 + i2) * 2); }
                const float a0 = bf_lo(rx[q][0]), a1 = bf_hi(rx[q][0]), b0 = bf_lo(rx[q][1]), b1 = bf_hi(rx[q][1]), c0 = bf_lo(rx[q][2]), c1 = bf_hi(rx[q][2]), d0 = bf_lo(rx[q][3]), d1 = bf_hi(rx[q][3]);
                unsigned* o = (unsigned*)(qk + hd * 128 + i2);
                o[0] = pk2(a0 * tr.x - b0 * tr.y, a1 * tr.z - b1 * tr.w); o[16] = pk2(b0 * tr.x + a0 * tr.y, b1 * tr.z + a1 * tr.w);
                o[32] = pk2(c0 * tc.x - d0 * tc.y, c1 * tc.z - d1 * tc.w); o[48] = pk2(d0 * tc.x + c0 * tc.y, d1 * tc.z + c1 * tc.w); } }
    }
}

__device__ __forceinline__ float red8(float v) {
    v += __int_as_float(__builtin_amdgcn_update_dpp(0, __float_as_int(v), 0xB1, 0xF, 0xF, true));
    v += __int_as_float(__builtin_amdgcn_update_dpp(0, __float_as_int(v), 0x4E, 0xF, 0xF, true));
    v += __int_as_float(__builtin_amdgcn_update_dpp(0, __float_as_int(v), 0x141, 0xF, 0xF, true));
    return v;
}
__device__ __forceinline__ float red16(float v) {
    v += __int_as_float(__builtin_amdgcn_update_dpp(0, __float_as_int(v), 0xB1, 0xF, 0xF, true));
    v += __int_as_float(__builtin_amdgcn_update_dpp(0, __float_as_int(v), 0x4E, 0xF, 0xF, true));
    v += __int_as_float(__builtin_amdgcn_update_dpp(0, __float_as_int(v), 0x141, 0xF, 0xF, true));
    v += __int_as_float(__builtin_amdgcn_update_dpp(0, __float_as_int(v), 0x140, 0xF, 0xF, true));
    return v;
}
typedef short bf16x8 __attribute__((ext_vector_type(8)));
typedef short s16x4 __attribute__((ext_vector_type(4)));
typedef float f32x16 __attribute__((ext_vector_type(16)));
#define MFMA32(a, b, c) __builtin_amdgcn_mfma_f32_32x32x16_bf16((a), (b), (c), 0, 0, 0)
__device__ __forceinline__ int crow(int reg, int h) { return (reg & 3) + 8 * (reg >> 2) + 4 * h; }
__device__ __forceinline__ s16x4 tr16(const LAS unsigned char* p) { return __builtin_bit_cast(s16x4, __builtin_amdgcn_ds_read_tr16_b64_v4i16((LAS s16x4*)p)); }
__device__ __forceinline__ bf16x8 frag_rm(const LAS unsigned char* base, int pitch, int r0, int k0, int lane) {
    return *(const LAS bf16x8*)(base + (r0 + (lane & 31)) * pitch + (k0 + 8 * (lane >> 5)) * 2);
}
template <bool PERM> __device__ __forceinline__ bf16x8 frag_tr(const LAS unsigned char* base, int pitch, int k0, int r0, int lane) {
    const int g = lane >> 4, i = lane & 15, q = i >> 2, p = i & 3, h = g >> 1;
    const LAS unsigned char* a = base + (k0 + (PERM ? 4 : 8) * h + q) * pitch + (r0 + 16 * (g & 1) + 4 * p) * 2;
    const s16x4 lo = tr16(a), hi = tr16(a + (PERM ? 8 : 4) * pitch);
    return __builtin_shufflevector(lo, hi, 0, 1, 2, 3, 4, 5, 6, 7);
}
__device__ __forceinline__ bf16x8 pack_step(const f32x16& x, int s) {
    u32x4 p; p.x = cvtpk(x[8 * s + 0], x[8 * s + 1]); p.y = cvtpk(x[8 * s + 2], x[8 * s + 3]); p.z = cvtpk(x[8 * s + 4], x[8 * s + 5]); p.w = cvtpk(x[8 * s + 6], x[8 * s + 7]);
    return __builtin_bit_cast(bf16x8, p);
}
__device__ __forceinline__ f32x16 zero16() { f32x16 z; for (int i = 0; i < 16; ++i) z[i] = 0.f; return z; }
constexpr int TP = 272;
constexpr int TILE_B = 128 * TP;
__device__ __forceinline__ void load_tile128(LAS unsigned char* dst, const bf16* src, size_t ld, int tid) {
    u32x4 t[4];
#pragma unroll
    for (int it = 0; it < 4; ++it) { const int idx = tid + NTHR * it, row = idx >> 4, ch = idx & 15; t[it] = *(const u32x4*)(src + (size_t)row * ld + ch * 8); }
    asm volatile("" ::: "memory");
#pragma unroll
    for (int it = 0; it < 4; ++it) { const int idx = tid + NTHR * it, row = idx >> 4, ch = idx & 15; *(LAS u32x4*)(dst + row * TP + ch * 16) = t[it]; }
}
__device__ __forceinline__ void tile3_fetch(u32x4 (&t)[3][4], const bf16* s0, const bf16* s1, const bf16* s2, size_t ld, int tid) {
#pragma unroll
    for (int it = 0; it < 4; ++it) { const int idx = tid + NTHR * it, row = idx >> 4, ch = idx & 15; const size_t o = (size_t)row * ld + ch * 8;
        t[0][it] = *(const u32x4*)(s0 + o); t[1][it] = *(const u32x4*)(s1 + o); t[2][it] = *(const u32x4*)(s2 + o); }
}
__device__ __forceinline__ void tile3_store(const u32x4 (&t)[3][4], LAS unsigned char* d0, LAS unsigned char* d1, LAS unsigned char* d2, int tid) {
#pragma unroll
    for (int it = 0; it < 4; ++it) { const int idx = tid + NTHR * it, row = idx >> 4, ch = idx & 15; const int o = row * TP + ch * 16;
        *(LAS u32x4*)(d0 + o) = t[0][it]; *(LAS u32x4*)(d1 + o) = t[1][it]; *(LAS u32x4*)(d2 + o) = t[2][it]; }
}

__device__ __forceinline__ void swa_unit(Frame& F, int layer, int unit) {
    const bf16* QK = wsp<bf16>(F, WS_QKR); const bf16* P = wsp<bf16>(F, WS_P);
    LAS unsigned char* Qt = F.lds; LAS unsigned char* Kt = F.lds + TILE_B; LAS unsigned char* Vt = F.lds + 2 * TILE_B;
    LAS float* stat = (LAS float*)(F.lds + 3 * TILE_B) + F.wave * 32;
    const int lane = F.lane, h = lane >> 5, wi = F.wave & 3, wh = F.wave >> 2;
    int b, qh, n, qrow0; bool isctx;
    if (unit < 512) { b = unit >> 7; qh = (unit >> 4) & 7; n = unit & 15; qrow0 = b * TL + n * 128; isctx = false; }
    else { const int u = unit - 512; b = u >> 4; qh = (u >> 1) & 7; n = u & 1; qrow0 = ML + b * TCX + n * 128; isctx = true; }
    const int kvh = qh >> 2;
    LB();
    load_tile128(Qt, QK + (size_t)qrow0 * NQK + qh * 128, NQK, F.tid);
    LB();
    bf16x8 qf[8];
#pragma unroll
    for (int ks = 0; ks < 8; ++ks) qf[ks] = frag_rm(Qt, TP, 32 * wi, 16 * ks, lane);
    const float L2E = 1.4426950408889634f, SC = 0.08838834764831845f * L2E;
    float m = inp(F, I_SINK)[layer * 8 + qh] * L2E, l = h == 0 ? 1.0f : 0.0f;
    f32x16 O0 = zero16(), O1 = zero16();
    const int iq = 32 * wi + (lane & 31);
    const int nch = isctx ? 2 : 5;
    auto chunk_info = [&](int c, int& krow0, int& mtype) -> bool {
        mtype = 0;
        if (isctx) { krow0 = ML + b * TCX + c * 128; return true; }
        if (c < 3) { const int kb = n - 1 + c; if (kb < 0 || kb > 15) return false; krow0 = b * TL + kb * 128; mtype = c == 0 ? 1 : (c == 2 ? 2 : 0); return true; }
        krow0 = ML + b * TCX + (c - 3) * 128; return true;
    };
    u32x4 pk[4], pv[4];
    auto fetch = [&](int krow0) {
#pragma unroll
        for (int it = 0; it < 4; ++it) { const int idx = F.tid + NTHR * it, row = idx >> 4, ch = idx & 15;
            pk[it] = *(const u32x4*)(QK + (size_t)(krow0 + row) * NQK + 1024 + kvh * 128 + ch * 8); pv[it] = *(const u32x4*)(P + (size_t)(krow0 + row) * LDP + C_SWA + 1280 + kvh * 128 + ch * 8); }
    };
    int c = 0, krow0 = 0, mtype = 0;
    while (!chunk_info(c, krow0, mtype)) ++c;
    fetch(krow0);
    while (c < nch) {
        const int mt = mtype;
        LB();
#pragma unroll
        for (int it = 0; it < 4; ++it) { const int idx = F.tid + NTHR * it, row = idx >> 4, ch = idx & 15; *(LAS u32x4*)(Kt + row * TP + ch * 16) = pk[it]; *(LAS u32x4*)(Vt + row * TP + ch * 16) = pv[it]; }
        LB();
        ++c; while (c < nch && !chunk_info(c, krow0, mtype)) ++c;
        if (c < nch) fetch(krow0);
        for (int kb = 0; kb < 4; kb += 2) {
            f32x16 Xa = zero16(), Xb = zero16();
#pragma unroll
            for (int ks = 0; ks < 8; ++ks) { Xa = MFMA32(frag_rm(Kt, TP, 32 * kb, 16 * ks, lane), qf[ks], Xa); Xb = MFMA32(frag_rm(Kt, TP, 32 * kb + 32, 16 * ks, lane), qf[ks], Xb); }
            float bm = -INFINITY;
            int iql = iq - 32 * kb; asm volatile("" : "+v"(iql));
#pragma unroll
            for (int r = 0; r < 16; ++r) { const int d = iql - crow(r, h), d2 = d - 32; float s = Xa[r] * SC, s2 = Xb[r] * SC;
                const bool ok = mt == 0 || (mt == 1 ? d <= 0 : d >= 0), ok2 = mt == 0 || (mt == 1 ? d2 <= 0 : d2 >= 0);
                s = ok ? s : -INFINITY; s2 = ok2 ? s2 : -INFINITY; Xa[r] = s; Xb[r] = s2; bm = fmaxf(bm, fmaxf(s, s2)); }
            bm = fmaxf(bm, shx(bm, 32, lane));
            const float mn = fmaxf(m, bm), sc = __builtin_amdgcn_exp2f(m - mn); m = mn;
            float ps = 0.f;
#pragma unroll
            for (int r = 0; r < 16; ++r) { const float p = __builtin_amdgcn_exp2f(Xa[r] - mn), p2 = __builtin_amdgcn_exp2f(Xb[r] - mn); Xa[r] = p; Xb[r] = p2; ps += p + p2; }
            l = l * sc + ps;
            const bf16x8 pa0 = pack_step(Xa, 0), pa1 = pack_step(Xa, 1), pb0 = pack_step(Xb, 0), pb1 = pack_step(Xb, 1);
            if (h == 0) stat[lane] = sc;
            LDS_WAIT();
#pragma unroll
            for (int g = 0; g < 4; ++g) { const f32x4 sv = *(const LAS f32x4*)(stat + 8 * g + 4 * h);
#pragma unroll
                for (int e = 0; e < 4; ++e) { O0[4 * g + e] *= sv[e]; O1[4 * g + e] *= sv[e]; } }
            O0 = MFMA32(pa0, frag_tr<true>(Vt, TP, 32 * kb, 64 * wh, lane), O0);
            O1 = MFMA32(pa0, frag_tr<true>(Vt, TP, 32 * kb, 64 * wh + 32, lane), O1);
            O0 = MFMA32(pa1, frag_tr<true>(Vt, TP, 32 * kb + 16, 64 * wh, lane), O0);
            O1 = MFMA32(pa1, frag_tr<true>(Vt, TP, 32 * kb + 16, 64 * wh + 32, lane), O1);
            O0 = MFMA32(pb0, frag_tr<true>(Vt, TP, 32 * kb + 32, 64 * wh, lane), O0);
            O1 = MFMA32(pb0, frag_tr<true>(Vt, TP, 32 * kb + 32, 64 * wh + 32, lane), O1);
            O0 = MFMA32(pb1, frag_tr<true>(Vt, TP, 32 * kb + 48, 64 * wh, lane), O0);
            O1 = MFMA32(pb1, frag_tr<true>(Vt, TP, 32 * kb + 48, 64 * wh + 32, lane), O1);
        }
    }
    l += shx(l, 32, lane);
    if (h == 0) stat[lane] = 1.0f / l;
    LDS_WAIT();
    bf16* yo = wsp<bf16>(F, WS_Y) + (size_t)(qrow0 + 32 * wi) * 3072 + 1024 + qh * 128 + 64 * wh + (lane & 31);
#pragma unroll
    for (int g = 0; g < 4; ++g) { const f32x4 sv = *(const LAS f32x4*)(stat + 8 * g + 4 * h);
#pragma unroll
        for (int e = 0; e < 4; ++e) { const int r = 8 * g + 4 * h + e; yo[(size_t)r * 3072] = (bf16)f2bf(O0[4 * g + e] * sv[e]); yo[(size_t)r * 3072 + 32] = (bf16)f2bf(O1[4 * g + e] * sv[e]); } }
}

constexpr size_t ST_CHUNK = (size_t)128 * 128;
__device__ __forceinline__ int ret_chunk_row0(int b, int jF) { return jF < 2 ? ML + b * TCX + jF * 128 : b * TL + (jF - 2) * 128; }
__device__ __forceinline__ void ret_state_unit(Frame& F, int layer, int unit) {
    const int dvq = unit & 3, dir = (unit >> 2) & 1, hh = (unit >> 3) & 7, b = unit >> 6;
    const bf16* P = wsp<bf16>(F, WS_P);
    bf16* ST = wsp<bf16>(F, WS_ST) + ((size_t)((b * 8 + hh) * 2 + dir) * 18) * ST_CHUNK;
    const float gam = sigm(inp(F, I_RETDEC)[(layer * 2 + dir) * 8 + hh]); const float lg2 = __builtin_amdgcn_logf(gam);
    const float gC = __builtin_amdgcn_exp2f(lg2 * 128.0f);
    LAS unsigned char* Kt = F.lds; LAS unsigned char* Vt = F.lds + TILE_B;
    constexpr int VP = 80;
    const int lane = F.lane, h = lane >> 5, w = F.wave;
    f32x16 acc = zero16(), acb = zero16();
    const float vfac = __builtin_amdgcn_exp2f(lg2 * (float)(127 - (F.tid >> 2))) * 0.08838834764831845f;
    u32x4 pkA[4], pvA, pkB[4], pvB;
#define RS_FETCH(c_, pk_, pv_) do { const int jf_ = dir == 0 ? (c_) : ((c_) < 2 ? 1 - (c_) : 19 - (c_)); const int r0_ = ret_chunk_row0(b, jf_); \
        _Pragma("unroll") for (int it = 0; it < 4; ++it) { const int idx = F.tid + NTHR * it, tp = idx >> 4, ch = idx & 15; const int row = r0_ + (dir ? 127 - tp : tp); \
            pk_[it] = *(const u32x4*)(P + (size_t)row * LDP + C_RET + 1024 + hh * 128 + ch * 8); } \
        { const int tp = F.tid >> 2, ch = F.tid & 3; const int row = r0_ + (dir ? 127 - tp : tp); \
          pv_ = *(const u32x4*)(P + (size_t)row * LDP + C_RET + 2048 + hh * 128 + dvq * 32 + ch * 8); } } while (0)
#define RS_STEP(c_, pk_, pv_) do { const int jF = dir == 0 ? (c_) : ((c_) < 2 ? 1 - (c_) : 19 - (c_)); \
        LB(); \
        _Pragma("unroll") for (int it = 0; it < 4; ++it) { const int idx = F.tid + NTHR * it, tp = idx >> 4, ch = idx & 15; *(LAS u32x4*)(Kt + tp * TP + ch * 16) = pk_[it]; } \
        { const int tp = F.tid >> 2, ch = F.tid & 3; u32x4 q_; \
          _Pragma("unroll") for (int e = 0; e < 4; ++e) q_[e] = cvtpk(bf_lo(pv_[e]) * vfac, bf_hi(pv_[e]) * vfac); \
          *(LAS u32x4*)(Vt + tp * VP + ch * 16) = q_; } \
        LB(); \
        if (w < 4) { \
            bf16* so = ST + (size_t)jF * ST_CHUNK + (size_t)(dvq * 32) * 128 + 32 * w + (lane & 31); \
            _Pragma("unroll") for (int r = 0; r < 16; ++r) so[(size_t)crow(r, h) * 128] = (bf16)f2bf(acc[r] + acb[r]); } \
          \
        { const int cn_ = (c_) + 2 < 18 ? (c_) + 2 : 17; RS_FETCH(cn_, pk_, pv_); } \
        if (w < 4) { \
            _Pragma("unroll") for (int r = 0; r < 16; ++r) { acc[r] *= gC; acb[r] *= gC; } \
            _Pragma("unroll") for (int ks = 0; ks < 8; ks += 2) { acc = MFMA32(frag_tr<false>(Vt, VP, 16 * ks, 0, lane), frag_tr<false>(Kt, TP, 16 * ks, 32 * w, lane), acc); \
                acb = MFMA32(frag_tr<false>(Vt, VP, 16 * ks + 16, 0, lane), frag_tr<false>(Kt, TP, 16 * ks + 16, 32 * w, lane), acb); } \
        } } while (0)
    RS_FETCH(0, pkA, pvA); RS_FETCH(1, pkB, pvB);
#pragma unroll 1
    for (int c = 0; c < 18; c += 2) { RS_STEP(c, pkA, pvA); RS_STEP(c + 1, pkB, pvB); }
#undef RS_FETCH
#undef RS_STEP
    LB();
}
__device__ __forceinline__ void ret_out_unit(Frame& F, int layer, int unit) {
    const int jF = unit % 18, hh = (unit / 18) & 7, b = unit / 144;
    const bf16* P = wsp<bf16>(F, WS_P);
    const int row0 = ret_chunk_row0(b, jF);
    LAS unsigned char* Qt = F.lds; LAS unsigned char* Kt = F.lds + TILE_B; LAS unsigned char* Vt = F.lds + 2 * TILE_B;
    const int lane = F.lane, h = lane >> 5, wi = F.wave & 3, wh = F.wave >> 2;
    const float* rdp = inp(F, I_RETDEC) + layer * 16 + hh; const float rdf = rdp[0], rdb = rdp[8];
    LB();
    u32x4 tq[3][4];
    tile3_fetch(tq, P + (size_t)row0 * LDP + C_RET + hh * 128, P + (size_t)row0 * LDP + C_RET + 1024 + hh * 128, P + (size_t)row0 * LDP + C_RET + 2048 + hh * 128, LDP, F.tid);
    u32x4 psf[4], psb[4];
    { const bf16* Sf = wsp<bf16>(F, WS_ST) + ((size_t)((b * 8 + hh) * 2 + 0) * 18 + jF) * ST_CHUNK; const bf16* Sb = wsp<bf16>(F, WS_ST) + ((size_t)((b * 8 + hh) * 2 + 1) * 18 + jF) * ST_CHUNK;
#pragma unroll
      for (int it = 0; it < 4; ++it) { const int idx = F.tid + NTHR * it, row = idx >> 4, ch = idx & 15; psf[it] = *(const u32x4*)(Sf + (size_t)row * 128 + ch * 8); psb[it] = *(const u32x4*)(Sb + (size_t)row * 128 + ch * 8); } }
    asm volatile("" ::: "memory");
    const float lgf = __builtin_amdgcn_logf(sigm(rdf)), lgb = __builtin_amdgcn_logf(sigm(rdb));
    tile3_store(tq, Qt, Kt, Vt, F.tid);
    LB();
    f32x16 Y0 = zero16(), Y1 = zero16();
    const int iq = 32 * wi + (lane & 31);
    for (int jb = 0; jb < 4; ++jb) {
        f32x16 X = zero16();
#pragma unroll
        for (int ks = 0; ks < 8; ++ks) X = MFMA32(frag_rm(Kt, TP, 32 * jb, 16 * ks, lane), frag_rm(Qt, TP, 32 * wi, 16 * ks, lane), X);
        int iql = iq - 32 * jb; asm volatile("" : "+v"(iql));
#pragma unroll
        for (int r = 0; r < 16; ++r) { const int d = iql - crow(r, h); const int ad = d < 0 ? -d : d;
            const float wgt = __builtin_amdgcn_exp2f((d > 0 ? lgf : lgb) * (float)ad) * (d == 0 ? 2.0f : 1.0f);
            X[r] *= wgt * 0.08838834764831845f; }
        const bf16x8 pa0 = pack_step(X, 0), pa1 = pack_step(X, 1);
        Y0 = MFMA32(pa0, frag_tr<true>(Vt, TP, 32 * jb, 64 * wh, lane), Y0);
        Y0 = MFMA32(pa1, frag_tr<true>(Vt, TP, 32 * jb + 16, 64 * wh, lane), Y0);
        Y1 = MFMA32(pa0, frag_tr<true>(Vt, TP, 32 * jb, 64 * wh + 32, lane), Y1);
        Y1 = MFMA32(pa1, frag_tr<true>(Vt, TP, 32 * jb + 16, 64 * wh + 32, lane), Y1);
    }
    LB();
#pragma unroll
    for (int it = 0; it < 4; ++it) { const int idx = F.tid + NTHR * it, row = idx >> 4, ch = idx & 15; *(LAS u32x4*)(Kt + row * TP + ch * 16) = psf[it]; *(LAS u32x4*)(Vt + row * TP + ch * 16) = psb[it]; }
    LB();
    {
        f32x16 T0 = zero16(), T1 = zero16(), U0 = zero16(), U1 = zero16();
#pragma unroll
        for (int ks = 0; ks < 8; ++ks) { const bf16x8 a = frag_rm(Qt, TP, 32 * wi, 16 * ks, lane);
            T0 = MFMA32(a, frag_rm(Kt, TP, 64 * wh, 16 * ks, lane), T0); T1 = MFMA32(a, frag_rm(Kt, TP, 64 * wh + 32, 16 * ks, lane), T1);
            U0 = MFMA32(a, frag_rm(Vt, TP, 64 * wh, 16 * ks, lane), U0); U1 = MFMA32(a, frag_rm(Vt, TP, 64 * wh + 32, 16 * ks, lane), U1); }
#pragma unroll
        for (int r = 0; r < 16; ++r) { const int i = 32 * wi + crow(r, h);
            const float ff = __builtin_amdgcn_exp2f(lgf * (float)(i + 1)), fb = __builtin_amdgcn_exp2f(lgb * (float)(128 - i));
            Y0[r] += ff * T0[r] + fb * U0[r]; Y1[r] += ff * T1[r] + fb * U1[r]; }
    }
    LB();
    LAS float* yl = (LAS float*)F.lds;
#pragma unroll
    for (int r = 0; r < 16; ++r) { const int i = 32 * wi + crow(r, h); yl[i * 132 + 64 * wh + (lane & 31)] = Y0[r]; yl[i * 132 + 64 * wh + 32 + (lane & 31)] = Y1[r]; }
    LB();
    { const int i = F.tid >> 2, part = F.tid & 3; const LAS float* yr = yl + i * 132 + 32 * part;
      f32x4 v[8]; float s = 0.f;
#pragma unroll
      for (int e = 0; e < 8; ++e) { v[e] = *(const LAS f32x4*)(yr + 4 * e); s += (v[e].x + v[e].y) + (v[e].z + v[e].w); }
      s += shx(s, 1, lane); s += shx(s, 2, lane); const float mean = s * (1.0f / 128.0f); float q = 0.f;
#pragma unroll
      for (int e = 0; e < 8; ++e) { v[e] = v[e] - mean; q += (v[e].x * v[e].x + v[e].y * v[e].y) + (v[e].z * v[e].z + v[e].w * v[e].w); }
      q += shx(q, 1, lane); q += shx(q, 2, lane); const float rs = __builtin_amdgcn_rsqf(q * (1.0f / 128.0f) + 1e-5f);
      const bf16* gp = P + (size_t)(row0 + i) * LDP + C_RET + 3072 + hh * 128 + 32 * part; bf16* yo = wsp<bf16>(F, WS_Y) + (size_t)(row0 + i) * 3072 + hh * 128 + 32 * part;
#pragma unroll
      for (int e2 = 0; e2 < 4; ++e2) { const u32x4 gw = *(const u32x4*)(gp + 8 * e2); u32x4 ow;
#pragma unroll
          for (int e = 0; e < 4; ++e) { const float g0 = bf_lo(gw[e]), g1 = bf_hi(gw[e]); const int vi = 2 * e2 + (e >> 1), vo = 2 * (e & 1);
              ow[e] = cvtpk(g0 * sigm(g0) * v[vi][vo] * rs, g1 * sigm(g1) * v[vi][vo + 1] * rs); }
          *(u32x4*)(yo + 8 * e2) = ow; } }
}

#ifdef RW_DEBUG
constexpr size_t WS_DBGY = WS_END2;
struct RwPre { f32x4 r4, k4, v4, lw, la; };
__device__ __forceinline__ void rwkv_scan_unit(Frame& F, int layer, int unit) {
    const int rh = unit & 1, dir = (unit >> 1) & 1, h = (unit >> 2) & 15, b = unit >> 6;
    constexpr int BUF = 6 * 2048 + 1024;
    LAS float* const base = (LAS float*)F.lds;
    const float* XS = wsp<float>(F, WS_XS); const float* LR = wsp<float>(F, WS_LR); float* YD = wsp<float>(F, WS_DBGY) + (size_t)dir * MT * BW;
    const int vrow = F.tid >> 4, kq = F.tid & 15;
    const int ptok = F.tid >> 4, pj = (F.tid & 15) * 4, pc = h * 64 + pj;
    const f32x4 w0v = *(const f32x4*)(inp(F, I_W0) + ((size_t)layer * 2 + dir) * BW + pc), a0v = *(const f32x4*)(inp(F, I_A0) + ((size_t)layer * 2 + dir) * BW + pc);
    const f32x4 kkv = *(const f32x4*)(inp(F, I_KK) + (size_t)layer * BW + pc), kav = *(const f32x4*)(inp(F, I_KA) + (size_t)layer * BW + pc);
    auto fetch = [&](int blk, RwPre& p) {
        const int row = scan_row(b, dir, blk * SCAN_BLK + ptok);
        p.r4 = *(const f32x4*)(XS + (size_t)row * 3072 + pc); p.k4 = *(const f32x4*)(XS + (size_t)row * 3072 + 1024 + pc); p.v4 = *(const f32x4*)(XS + (size_t)row * 3072 + 2048 + pc);
        p.lw = *(const f32x4*)(LR + (size_t)row * NLR + dir * 1024 + pc); p.la = *(const f32x4*)(LR + (size_t)row * NLR + 2048 + dir * 1024 + pc);
    };
    auto derive = [&](const RwPre& p, LAS float* buf) {
        f32x4 dec, av, kk, kd; float ssq = 0.f;
#pragma unroll
        for (int e = 0; e < 4; ++e) { dec[e] = fexp(-0.6065306597126334f * sigm(w0v[e] + p.lw[e])); av[e] = sigm(a0v[e] + p.la[e]); kk[e] = p.k4[e] * kkv[e]; ssq += kk[e] * kk[e];
            kd[e] = p.k4[e] * (1.0f + (av[e] - 1.0f) * kav[e]); }
        ssq += __int_as_float(__builtin_amdgcn_update_dpp(0, __float_as_int(ssq), 0xB1, 0xF, 0xF, true));
        ssq += __int_as_float(__builtin_amdgcn_update_dpp(0, __float_as_int(ssq), 0x4E, 0xF, 0xF, true));
        ssq += __int_as_float(__builtin_amdgcn_update_dpp(0, __float_as_int(ssq), 0x141, 0xF, 0xF, true));
        ssq += __int_as_float(__builtin_amdgcn_update_dpp(0, __float_as_int(ssq), 0x140, 0xF, 0xF, true));
        const float inv = __builtin_amdgcn_rsqf(fmaxf(ssq, 1e-24f));
        f32x4 an, bn;
#pragma unroll
        for (int e = 0; e < 4; ++e) { const float kn = kk[e] * inv; an[e] = -kn; bn[e] = kn * av[e]; }
        const int o = ptok * 64 + pj;
        *(LAS f32x4*)(buf + o) = p.r4; *(LAS f32x4*)(buf + 2048 + o) = dec; *(LAS f32x4*)(buf + 4096 + o) = kd; *(LAS f32x4*)(buf + 6144 + o) = p.v4; *(LAS f32x4*)(buf + 8192 + o) = an; *(LAS f32x4*)(buf + 10240 + o) = bn;
    };
    f32x2 S0 = {0.f, 0.f}, S1 = S0;
    RwPre pre;
    __syncthreads();
    fetch(0, pre); derive(pre, base);
    __syncthreads();
    constexpr int NBLK = NSTEP / SCAN_BLK;
    for (int blk = 0; blk < NBLK; ++blk) {
        LAS float* cur = base + (blk & 1) * BUF; LAS float* nxt = base + ((blk + 1) & 1) * BUF;
        if (blk + 1 < NBLK) fetch(blk + 1, pre);
        const LAS float* Rl = cur; const LAS float* Wl = cur + 2048; const LAS float* Kl = cur + 4096; const LAS float* Vl = cur + 6144; const LAS float* Al = cur + 8192; const LAS float* Bl = cur + 10240; LAS float* Yl = cur + 12288;
        const int ob = 4 * kq, vb = 32 * rh + vrow;
        f32x4 a0 = *(const LAS f32x4*)(Al + ob), w0 = *(const LAS f32x4*)(Wl + ob), b0 = *(const LAS f32x4*)(Bl + ob), k0 = *(const LAS f32x4*)(Kl + ob), r0 = *(const LAS f32x4*)(Rl + ob);
        float vv = Vl[vb];
#pragma unroll 8
        for (int tok = 0; tok < SCAN_BLK; ++tok) {
            const int on = ((tok + 1) & (SCAN_BLK - 1)) * 64;
            const f32x4 a1 = *(const LAS f32x4*)(Al + on + ob), w1 = *(const LAS f32x4*)(Wl + on + ob), b1 = *(const LAS f32x4*)(Bl + on + ob), k1 = *(const LAS f32x4*)(Kl + on + ob), r1 = *(const LAS f32x4*)(Rl + on + ob);
            const float vn = Vl[on + vb];
            f32x2 t = S0 * a0.xy; t += S1 * a0.zw;
            const float sa = red16(t.x + t.y);
            const f32x2 sa2 = {sa, sa}, vv2 = {vv, vv};
            S0 = S0 * w0.xy + (sa2 * b0.xy + vv2 * k0.xy); S1 = S1 * w0.zw + (sa2 * b0.zw + vv2 * k0.zw);
            f32x2 u = S0 * r0.xy; u += S1 * r0.zw;
            const float y = red16(u.x + u.y);
            Yl[tok * 32 + vrow] = y;
            a0 = a1; w0 = w1; b0 = b1; k0 = k1; r0 = r1; vv = vn;
        }
        if (blk + 1 < NBLK) derive(pre, nxt);
        __syncthreads();
        if (F.tid < 256) { const int e = F.tid * 4, tok = e >> 5, j = e & 31; const int row = scan_row(b, dir, blk * SCAN_BLK + tok);
          *(f32x4*)(YD + (size_t)row * BW + h * 64 + 32 * rh + j) = *(const LAS f32x4*)(Yl + e); }
    }
    __syncthreads();
}
#endif
__device__ __forceinline__ const float* vecp(const Frame& F, int layer, int v) { return wsp<float>(F, WS_VEC) + ((size_t)layer * 8 + v) * 1024; }
constexpr int RW_NCH = 36, RW_NU = NB * 16 * 2 * RW_NCH;
constexpr int RWP = 144;
constexpr int RWS = 64 * RWP;
__device__ __forceinline__ int rw_row0(int b, int jF) { return jF < 4 ? ML + b * TCX + 64 * jF : b * TL + 64 * (jF - 4); }
enum { RM = 0, TR = 1 };
template <int AM, int BM_> __device__ __forceinline__ f32x16 mm64(const LAS unsigned char* A, const LAS unsigned char* B, int tb, int sb, int lane, f32x16 acc) {
#pragma unroll
    for (int ks = 0; ks < 4; ++ks) {
        const bf16x8 a = AM == RM ? frag_rm(A, RWP, 32 * tb, 16 * ks, lane) : frag_tr<false>(A, RWP, 16 * ks, 32 * tb, lane);
        const bf16x8 b = BM_ == RM ? frag_rm(B, RWP, 32 * sb, 16 * ks, lane) : frag_tr<false>(B, RWP, 16 * ks, 32 * sb, lane);
        acc = MFMA32(a, b, acc); }
    return acc;
}
__device__ __forceinline__ void store_tile_bf16(LAS unsigned char* T, const f32x16& x, int tb, int sb, int lane) {
    const int h = lane >> 5; LAS unsigned short* p = (LAS unsigned short*)(T + (32 * tb) * RWP) + 32 * sb + (lane & 31);
#pragma unroll
    for (int r = 0; r < 16; ++r) p[crow(r, h) * (RWP / 2)] = (unsigned short)(cvtpk(x[r], 0.f) & 0xffffu);
}
__device__ __forceinline__ bf16x8 gfrag_perm(const bf16* X, int ld, int m0, int k0, int lane) {
    const bf16* p = X + (size_t)(m0 + (lane & 31)) * ld + k0 + 4 * (lane >> 5);
    const u32x2 lo = *(const u32x2*)p, hi = *(const u32x2*)(p + 8);
    u32x4 w; w.x = lo.x; w.y = lo.y; w.z = hi.x; w.w = hi.y; return __builtin_bit_cast(bf16x8, w);
}
template <bool REV> __device__ __forceinline__ void tri_inv16(const LAS float* AD, LAS unsigned char* T, int lane_) {
    int lane = lane_; asm volatile("" : "+v"(lane));
    const int blk = lane >> 4, j = lane & 15; const LAS float* A = AD + blk * 16 * 20;
    float x[16];
#pragma unroll
    for (int i = 0; i < 16; ++i) { const int t = REV ? 15 - i : i; float a0 = (j == t) ? 1.0f : 0.0f, a1 = 0.0f;
#pragma unroll
        for (int s4 = 0; s4 < 16; s4 += 4) { if (REV ? (s4 + 3 > t) : (s4 < t)) { const f32x4 a = *(const LAS f32x4*)(A + t * 20 + s4);
#pragma unroll
                for (int e = 0; e < 4; ++e) { const int s = s4 + e; if (REV ? (s > t) : (s < t)) { if (e & 1) a1 = fmaf(a[e], x[s], a1); else a0 = fmaf(a[e], x[s], a0); } } } }
        x[t] = a0 + a1; asm volatile("" ::: "memory"); }
    LAS unsigned short* tp = (LAS unsigned short*)T + (16 * blk) * (RWP / 2) + 16 * blk + j;
#pragma unroll
    for (int s = 0; s < 16; ++s) tp[s * (RWP / 2)] = (unsigned short)(cvtpk(x[s], 0.f) & 0xffffu);
}
struct RwIn { u32x4 x[3]; u32x4 l[2]; float vn; };
__device__ __forceinline__ void rw_fetch_x(Frame& F, int unit, int tid, RwIn& p) {
    const int jF = unit % RW_NCH, hh = (unit / RW_NCH) & 15, b = unit / (RW_NCH * 16);
    const bf16* xr = wsp<bf16>(F, WS_XS) + (size_t)(rw_row0(b, jF) + (tid >> 3)) * 3072 + hh * 64 + (tid & 7) * 8;
    p.x[0] = *(const u32x4*)xr; p.x[1] = *(const u32x4*)(xr + 1024); p.x[2] = *(const u32x4*)(xr + 2048);
}
__device__ __forceinline__ void rw_fetch_l(Frame& F, int unit, int dir, int tid, RwIn& p) {
    const int jF = unit % RW_NCH, hh = (unit / RW_NCH) & 15, b = unit / (RW_NCH * 16);
    const bf16* lr = wsp<bf16>(F, WS_LR) + (size_t)(rw_row0(b, jF) + (tid >> 3)) * NLR + dir * 1024 + hh * 64 + (tid & 7) * 8;
    p.l[0] = *(const u32x4*)lr; p.l[1] = *(const u32x4*)(lr + 2048);
}
__device__ __forceinline__ void rw_fetch_v(Frame& F, int layer, int unit, int tid, RwIn& p) {
    const int hh = (unit / RW_NCH) & 15; const int v = tid >> 6; p.vn = vecp(F, layer, v < 6 ? v : 5)[hh * 64 + (tid & 63)];
}
__device__ __forceinline__ void rw_local_unit(Frame& F, int layer, int unit, int unit_next, RwIn& in) {
    const int jF = unit % RW_NCH, hh = (unit / RW_NCH) & 15, b = unit / (RW_NCH * 16);
    const int row0 = rw_row0(b, jF);
    LAS unsigned char* const L = F.lds;
    LAS unsigned char* sAh = L; LAS unsigned char* sRh = L + RWS; LAS unsigned char* sBh = L + 2 * RWS; LAS unsigned char* sKh = L + 3 * RWS; LAS unsigned char* sBt = L + 4 * RWS; LAS unsigned char* sKt = L + 5 * RWS;
    LAS unsigned char* sV = L + 6 * RWS; LAS unsigned char* sAAK = L + 7 * RWS; LAS unsigned char* sARB = L + 8 * RWS; LAS unsigned char* sARK = L + 9 * RWS; LAS unsigned char* sPm = L + 10 * RWS; LAS unsigned char* sTm = L + 11 * RWS;
    LAS unsigned char* sM1 = sAAK; LAS unsigned char* sVT = sKh; LAS unsigned char* sWW = sPm;
    LAS unsigned char* sTm2 = L + 12 * RWS;
    LAS float* VLh = (LAS float*)(L + 13 * RWS + 9216);
    LAS float* CL = (LAS float*)(L + 13 * RWS);
    const int w = F.wave, grp = w >> 2, tb = (w >> 1) & 1, sb = w & 1;
    float r8[8], k8[8], kn8[8];
    { int tl_ = F.tid; asm volatile("" : "+v"(tl_)); const int t = tl_ >> 3, j0 = (tl_ & 7) * 8;
      if (tl_ < 384) VLh[tl_] = in.vn;
      LB();
      const u32x4 rw_ = in.x[0], kw_ = in.x[1]; f32x4 ra, rb, ka, kb;
#pragma unroll
      for (int e = 0; e < 2; ++e) { ra[2 * e] = bf_lo(rw_[e]); ra[2 * e + 1] = bf_hi(rw_[e]); rb[2 * e] = bf_lo(rw_[2 + e]); rb[2 * e + 1] = bf_hi(rw_[2 + e]); ka[2 * e] = bf_lo(kw_[e]); ka[2 * e + 1] = bf_hi(kw_[e]); kb[2 * e] = bf_lo(kw_[2 + e]); kb[2 * e + 1] = bf_hi(kw_[2 + e]); }
      const f32x4 kka = *(const LAS f32x4*)(VLh + 4 * 64 + j0), kkb = *(const LAS f32x4*)(VLh + 4 * 64 + j0 + 4);
      float ssq = 0.f;
#pragma unroll
      for (int e = 0; e < 4; ++e) { r8[e] = ra[e]; r8[4 + e] = rb[e]; k8[e] = ka[e]; k8[4 + e] = kb[e]; kn8[e] = ka[e] * kka[e]; kn8[4 + e] = kb[e] * kkb[e]; }
#pragma unroll
      for (int e = 0; e < 8; ++e) ssq += kn8[e] * kn8[e];
      ssq = red8(ssq); const float inv = __builtin_amdgcn_rsqf(fmaxf(ssq, 1e-24f));
#pragma unroll
      for (int e = 0; e < 8; ++e) kn8[e] *= inv;
      *(LAS u32x4*)(sV + t * RWP + j0 * 2) = in.x[2]; }
    for (int dir = 0; dir < 2; ++dir) {
        const int ui = ((b * 16 + hh) * 2 + dir) * RW_NCH + jF;
        int tl_ = F.tid; asm volatile("" : "+v"(tl_)); const int t = tl_ >> 3, j0 = (tl_ & 7) * 8, c0 = hh * 64 + j0;
        float lw8[8], as8[8];
        { f32x4 wa, wb, aa, ab; { const u32x4 lw_ = in.l[0], la_ = in.l[1];
#pragma unroll
            for (int e = 0; e < 2; ++e) { wa[2 * e] = bf_lo(lw_[e]); wa[2 * e + 1] = bf_hi(lw_[e]); wb[2 * e] = bf_lo(lw_[2 + e]); wb[2 * e + 1] = bf_hi(lw_[2 + e]); aa[2 * e] = bf_lo(la_[e]); aa[2 * e + 1] = bf_hi(la_[e]); ab[2 * e] = bf_lo(la_[2 + e]); ab[2 * e + 1] = bf_hi(la_[2 + e]); } }
          const LAS float* w0p = VLh + dir * 64 + j0; const LAS float* a0p = VLh + (2 + dir) * 64 + j0;
          const f32x4 w0a = *(const LAS f32x4*)w0p, w0b = *(const LAS f32x4*)(w0p + 4), a0a = *(const LAS f32x4*)a0p, a0b = *(const LAS f32x4*)(a0p + 4);
#pragma unroll
          for (int e = 0; e < 4; ++e) { lw8[e] = -0.6065306597126334f * sigm(w0a[e] + wa[e]); lw8[4 + e] = -0.6065306597126334f * sigm(w0b[e] + wb[e]); as8[e] = sigm(a0a[e] + aa[e]); as8[4 + e] = sigm(a0b[e] + ab[e]); } }
        float cl8[8], ce8[8];
        { const int ln = F.lane;
#pragma unroll
          for (int e = 0; e < 8; ++e) cl8[e] = lw8[e];
#pragma unroll
          for (int d = 8; d < 64; d <<= 1) { const int src = dir ? ln + d : ln - d; const float msk = (src >= 0 && src < 64) ? 1.0f : 0.0f;
              float tp8[8];
#pragma unroll
              for (int e = 0; e < 8; ++e) tp8[e] = lanefrom(cl8[e], src);
              asm volatile("" ::: "memory");
#pragma unroll
              for (int e = 0; e < 8; ++e) cl8[e] = fmaf(tp8[e], msk, cl8[e]); }
          LAS float* WT = CL;
          if ((ln >> 3) == (dir ? 0 : 7)) { *(LAS f32x4*)(WT + w * 64 + j0) = (f32x4){cl8[0], cl8[1], cl8[2], cl8[3]}; *(LAS f32x4*)(WT + w * 64 + j0 + 4) = (f32x4){cl8[4], cl8[5], cl8[6], cl8[7]}; }
          LB();
#pragma unroll
          for (int e = 0; e < 8; ++e) ce8[e] = 0.f;
#pragma unroll
          for (int ww = 0; ww < 8; ++ww) { const f32x4 a = *(const LAS f32x4*)(WT + ww * 64 + j0), b2 = *(const LAS f32x4*)(WT + ww * 64 + j0 + 4); const float bm = (dir ? ww > w : ww < w) ? 1.0f : 0.0f;
#pragma unroll
              for (int e = 0; e < 4; ++e) { ce8[e] += a[e]; ce8[4 + e] += b2[e]; cl8[e] = fmaf(a[e], bm, cl8[e]); cl8[4 + e] = fmaf(b2[e], bm, cl8[4 + e]); } }
        }
        { const LAS float* kap = VLh + 5 * 64 + j0; const f32x4 kaa = *(const LAS f32x4*)kap, kab = *(const LAS f32x4*)(kap + 4);
          float oA[8], oR[8], oB[8], oK[8], oBt[8], oKt[8];
#pragma unroll
          for (int e = 0; e < 8; ++e) { const float cl = cl8[e], ce = ce8[e], kav = e < 4 ? kaa[e] : kab[e - 4];
              const float ex = fexp(cl), exm = fexp(-cl), exx = fexp(cl - lw8[e]), ext = fexp(ce - cl);
              const float kd = k8[e] * (1.0f + (as8[e] - 1.0f) * kav), bb = kn8[e] * as8[e];
              oA[e] = -kn8[e] * exx; oR[e] = r8[e] * ex; oB[e] = bb * exm; oK[e] = kd * exm; oBt[e] = bb * ext; oKt[e] = kd * ext; }
          const int o = t * RWP + j0 * 2;
#define RW_ST8(slot, a) do { u32x4 q_; q_.x = cvtpk(a[0], a[1]); q_.y = cvtpk(a[2], a[3]); q_.z = cvtpk(a[4], a[5]); q_.w = cvtpk(a[6], a[7]); *(LAS u32x4*)((slot) + o) = q_; } while (0)
          RW_ST8(sAh, oA); RW_ST8(sRh, oR); RW_ST8(sBh, oB); RW_ST8(sKh, oK); RW_ST8(sBt, oBt); RW_ST8(sKt, oKt);
#undef RW_ST8
        }
        if (t == 0) { float* gm = wsp<float>(F, WS_RWG) + (size_t)ui * 64 + j0;
            *(f32x4*)gm = (f32x4){fexp(ce8[0]), fexp(ce8[1]), fexp(ce8[2]), fexp(ce8[3])}; *(f32x4*)(gm + 4) = (f32x4){fexp(ce8[4]), fexp(ce8[5]), fexp(ce8[6]), fexp(ce8[7])}; }
        { const int un = unit_next >= 0 ? unit_next : unit; rw_fetch_x(F, un, tl_, in); rw_fetch_v(F, layer, un, tl_, in); rw_fetch_l(F, dir == 0 ? unit : un, dir == 0 ? 1 : 0, tl_, in); }
        LB();
#if defined(TS_DEBUG) && TS_SEL == 0
#endif
        int lane = F.lane; asm volatile("" : "+v"(lane)); const int h = lane >> 5;
        const int tq = 32 * tb + 4 * h, sq = 32 * sb + (lane & 31);
        LAS float* AD16 = CL + 1024;
        const int pB = dir ? 0 : 1, qB = 1 - pB;
        if (grp == 0) {
            f32x16 X1 = mm64<RM, RM>(sAh, sBh, tb, sb, lane, zero16()), X2 = mm64<RM, RM>(sAh, sKh, tb, sb, lane, zero16());
#pragma unroll
            for (int r = 0; r < 16; ++r) { const int d = (tq + (r & 3) + 8 * (r >> 2)) - sq; const bool keep = (dir ? -d : d) > 0; X1[r] = keep ? X1[r] : 0.f; X2[r] = keep ? X2[r] : 0.f; }
            store_tile_bf16(sAAK, X2, tb, sb, lane);
            { f32x16 AF; const int sl = lane & 31;
#pragma unroll
              for (int r = 0; r < 16; ++r) { const int tl = (r & 3) + 8 * (r >> 2) + 4 * h; const bool same16 = tb == sb && (tl >> 4) == (sl >> 4);
                  AF[r] = same16 ? 0.f : X1[r];
                  if (same16) AD16[((2 * tb + (tl >> 4)) * 16 + (tl & 15)) * 20 + (sl & 15)] = X1[r]; }
              store_tile_bf16(sPm, AF, tb, sb, lane); store_tile_bf16(sTm, zero16(), tb, sb, lane); }
            LB();
            if (w == 0) { if (dir == 0) tri_inv16<false>(AD16, sTm, lane); else tri_inv16<true>(AD16, sTm, lane); }
            LB();
            { f32x16 Mx = (tb == pB && sb == qB) ? zero16() : mm64<RM, TR>(sPm, sTm, tb, sb, lane, zero16());
#pragma unroll
              for (int r = 0; r < 16; ++r) { const int d = (tq + (r & 3) + 8 * (r >> 2)) - sq; Mx[r] += d == 0 ? 1.0f : 0.f; }
              store_tile_bf16(sBh, Mx, tb, sb, lane); }
            LB();
            { const f32x16 Tn = mm64<RM, TR>(sTm, sBh, tb, sb, lane, zero16()); store_tile_bf16(sTm2, Tn, tb, sb, lane); }
            LB();
            { f32x16 Mx = zero16();
              if (tb == pB && sb == qB) {
#pragma unroll
                  for (int ks = 0; ks < 2; ++ks) Mx = MFMA32(frag_rm(sPm, RWP, 32 * pB, 32 * qB + 16 * ks, lane), frag_tr<false>(sTm2, RWP, 32 * qB + 16 * ks, 32 * qB, lane), Mx); }
#pragma unroll
              for (int r = 0; r < 16; ++r) { const int d = (tq + (r & 3) + 8 * (r >> 2)) - sq; Mx[r] += d == 0 ? 1.0f : 0.f; }
              store_tile_bf16(sBh, Mx, tb, sb, lane); }
            LB();
            { const f32x16 Tn = mm64<RM, TR>(sTm2, sBh, tb, sb, lane, zero16()); store_tile_bf16(sTm, Tn, tb, sb, lane); }
            LB();
            { const f32x16 Wt = mm64<RM, TR>(sTm, sAh, tb, sb, lane, zero16()); store_tile_bf16(sWW, Wt, tb, sb, lane); }
            LB();
            asm volatile("" : "+v"(in.x[0]), "+v"(in.x[1]), "+v"(in.x[2]), "+v"(in.l[0]), "+v"(in.l[1]), "+v"(in.vn));
            { f32x16 QtT = mm64<TR, RM>(sWW, sARB, tb, sb, lane, zero16());
#pragma unroll
              for (int r = 0; r < 16; ++r) QtT[r] += bf2f(((const LAS unsigned short*)(sRh + sq * RWP))[32 * tb + crow(r, h)]);
              int l4 = lane; asm volatile("" : "+v"(l4));
              u32x4* qo = (u32x4*)(wsp<bf16>(F, WS_RWQ) + (size_t)ui * 4096) + ((sb * 2 + tb) * 2) * 64 + l4;
              qo[0] = __builtin_bit_cast(u32x4, pack_step(QtT, 0)); qo[64] = __builtin_bit_cast(u32x4, pack_step(QtT, 1));
              const f32x16 PpT = mm64<TR, TR>(sWW, sBt, tb, sb, lane, zero16());
              u32x4* po = (u32x4*)(wsp<bf16>(F, WS_RWP) + (size_t)ui * 4096) + ((sb * 2 + tb) * 2) * 64 + l4;
              po[0] = __builtin_bit_cast(u32x4, pack_step(PpT, 0)); po[64] = __builtin_bit_cast(u32x4, pack_step(PpT, 1)); }
            LB();
#if defined(TS_DEBUG) && TS_SEL == 1
#endif
        } else {
            f32x16 X1 = mm64<RM, RM>(sRh, sBh, tb, sb, lane, zero16()), X2 = mm64<RM, RM>(sRh, sKh, tb, sb, lane, zero16());
#pragma unroll
            for (int r = 0; r < 16; ++r) { const int d = (tq + (r & 3) + 8 * (r >> 2)) - sq; const bool keep = (dir ? -d : d) >= 0; X1[r] = keep ? X1[r] : 0.f; X2[r] = keep ? X2[r] : 0.f; }
            store_tile_bf16(sARB, X1, tb, sb, lane); store_tile_bf16(sARK, X2, tb, sb, lane);
            LB();
            X1 = mm64<RM, TR>(sAAK, sV, tb, sb, lane, zero16());
            f32x16 accY = mm64<RM, TR>(sARK, sV, tb, sb, lane, zero16()), accH = mm64<TR, TR>(sKt, sV, tb, sb, lane, zero16());
            LB();
            store_tile_bf16(sM1, X1, tb, sb, lane);
#pragma unroll 1
            for (int i = 0; i < 4; ++i) LB();
            { const f32x16 Vx = mm64<RM, TR>(sTm, sM1, tb, sb, lane, zero16()); store_tile_bf16(sVT, Vx, tb, sb, lane); }
            LB();
            asm volatile("" : "+v"(in.x[0]), "+v"(in.x[1]), "+v"(in.x[2]), "+v"(in.l[0]), "+v"(in.l[1]), "+v"(in.vn));
            accY = mm64<RM, TR>(sARB, sVT, tb, sb, lane, accY); accH = mm64<TR, TR>(sBt, sVT, tb, sb, lane, accH);
            int l4 = lane; asm volatile("" : "+v"(l4));
            u32x4* yo = (u32x4*)(wsp<bf16>(F, WS_RWY) + (size_t)ui * 4096 + (tb * 2 + sb) * 1024 + l4 * 16);
            u32x4* ho = (u32x4*)(wsp<bf16>(F, WS_RWH) + (size_t)ui * 4096 + (tb * 2 + sb) * 1024 + l4 * 16);
#pragma unroll
            for (int g = 0; g < 2; ++g) { u32x4 a, b2;
#pragma unroll
                for (int e = 0; e < 4; ++e) { a[e] = cvtpk(accY[8 * g + 2 * e], accY[8 * g + 2 * e + 1]); b2[e] = cvtpk(accH[8 * g + 2 * e], accH[8 * g + 2 * e + 1]); }
                yo[g] = a; ho[g] = b2; }
            LB();
        }
    }
}
constexpr int RWQ_SLOT = 13 * 1024, RWQ_WAVE = 3 * RWQ_SLOT;
__device__ __forceinline__ void rw_seq_task(Frame& F, int task, int lane, LAS unsigned char* ring) {
    const int vb = task & 1, dir = (task >> 1) & 1, bh = task >> 2, h = lane >> 5;
    auto issue = [&](int c) {
        const int jF = dir == 0 ? c : (c < 4 ? 3 - c : 39 - c); const size_t ui = (size_t)(bh * 2 + dir) * RW_NCH + jF;
        const char* pp = (const char*)(wsp<bf16>(F, WS_RWP) + ui * 4096) + lane * 16; const char* hp = (const char*)(wsp<bf16>(F, WS_RWH) + ui * 4096) + lane * 16; const char* gp = (const char*)(wsp<float>(F, WS_RWG) + ui * 64) + lane * 16;
        LAS unsigned char* sl = ring + (c % 3) * RWQ_SLOT;
#pragma unroll
        for (int i = 0; i < 8; ++i) __builtin_amdgcn_global_load_lds((const unsigned*)(pp + i * 1024), (LAS unsigned*)(sl + i * 1024), 16, 0, 0);
#pragma unroll
        for (int ko = 0; ko < 2; ++ko)
#pragma unroll
            for (int i = 0; i < 2; ++i) __builtin_amdgcn_global_load_lds((const unsigned*)(hp + (ko * 2 + vb) * 2048 + i * 1024), (LAS unsigned*)(sl + 8192 + ko * 2048 + i * 1024), 16, 0, 0);
        __builtin_amdgcn_global_load_lds((const unsigned*)gp, (LAS unsigned*)(sl + 12288), 16, 0, 0);
    };
    f32x16 S0 = zero16(), S1 = zero16();
    issue(0); issue(1);
#pragma unroll 1
    for (int c = 0; c < RW_NCH; ++c) {
        asm volatile("s_waitcnt lgkmcnt(0)" ::: "memory");
        if (c + 2 < RW_NCH) { issue(c + 2); asm volatile("s_waitcnt vmcnt(26)" ::: "memory"); }
        else if (c + 1 < RW_NCH) asm volatile("s_waitcnt vmcnt(13)" ::: "memory");
        else asm volatile("s_waitcnt vmcnt(0)" ::: "memory");
        const LAS unsigned char* sl = ring + (c % 3) * RWQ_SLOT;
        const int jF = dir == 0 ? c : (c < 4 ? 3 - c : 39 - c); const size_t ui = (size_t)(bh * 2 + dir) * RW_NCH + jF;
        const bf16x8 b00 = pack_step(S0, 0), b01 = pack_step(S0, 1), b10 = pack_step(S1, 0), b11 = pack_step(S1, 1);
        f32x16 n0, n1;
#pragma unroll
        for (int g = 0; g < 4; ++g) {
            const u32x2 h0 = *(const LAS u32x2*)(sl + 8192 + lane * 32 + 8 * g), h1 = *(const LAS u32x2*)(sl + 8192 + 2048 + lane * 32 + 8 * g);
            const f32x4 g0 = *(const LAS f32x4*)(sl + 12288 + (8 * g + 4 * h) * 4), g1 = *(const LAS f32x4*)(sl + 12288 + (32 + 8 * g + 4 * h) * 4);
            n0[4 * g] = bf_lo(h0.x) + g0[0] * S0[4 * g]; n0[4 * g + 1] = bf_hi(h0.x) + g0[1] * S0[4 * g + 1]; n0[4 * g + 2] = bf_lo(h0.y) + g0[2] * S0[4 * g + 2]; n0[4 * g + 3] = bf_hi(h0.y) + g0[3] * S0[4 * g + 3];
            n1[4 * g] = bf_lo(h1.x) + g1[0] * S1[4 * g]; n1[4 * g + 1] = bf_hi(h1.x) + g1[1] * S1[4 * g + 1]; n1[4 * g + 2] = bf_lo(h1.y) + g1[2] * S1[4 * g + 2]; n1[4 * g + 3] = bf_hi(h1.y) + g1[3] * S1[4 * g + 3]; }
#define RWQ_PF(ko, ki, s) (*(const LAS bf16x8*)(sl + (((ko) * 2 + (ki)) * 2 + (s)) * 1024 + lane * 16))
        n0 = MFMA32(RWQ_PF(0, 0, 0), b00, n0); n1 = MFMA32(RWQ_PF(1, 0, 0), b00, n1);
        n0 = MFMA32(RWQ_PF(0, 0, 1), b01, n0); n1 = MFMA32(RWQ_PF(1, 0, 1), b01, n1);
        n0 = MFMA32(RWQ_PF(0, 1, 0), b10, n0); n1 = MFMA32(RWQ_PF(1, 1, 0), b10, n1);
        n0 = MFMA32(RWQ_PF(0, 1, 1), b11, n0); n1 = MFMA32(RWQ_PF(1, 1, 1), b11, n1);
#undef RWQ_PF
        u32x4* so = (u32x4*)(wsp<bf16>(F, WS_RWS) + ui * 4096) + lane;
        so[((0 * 2 + vb) * 2 + 0) * 64] = __builtin_bit_cast(u32x4, b00); so[((0 * 2 + vb) * 2 + 1) * 64] = __builtin_bit_cast(u32x4, b01);
        so[((1 * 2 + vb) * 2 + 0) * 64] = __builtin_bit_cast(u32x4, b10); so[((1 * 2 + vb) * 2 + 1) * 64] = __builtin_bit_cast(u32x4, b11);
        S0 = n0; S1 = n1;
    }
}
__device__ __forceinline__ f32x4 unpk4(const u32x4& w, int half) { return (f32x4){bf_lo(w[2 * half]), bf_hi(w[2 * half]), bf_lo(w[2 * half + 1]), bf_hi(w[2 * half + 1])}; }
struct RwOutA { u32x4 yl[2]; u32x4 qa[4], sb[4]; };
struct RwOutB { u32x4 px[3], pl[3]; };
__device__ __forceinline__ void rw_out_fetch_a(Frame& F, int unit, int w, int lane, RwOutA& p) {
    const int jF = unit % RW_NCH, hh = (unit / RW_NCH) & 15, b = unit / (RW_NCH * 16); const int dir = w >> 2, tb = (w >> 1) & 1, vb = w & 1;
    const size_t ui = (size_t)((b * 16 + hh) * 2 + dir) * RW_NCH + jF;
    const u32x4* yl = (const u32x4*)(wsp<bf16>(F, WS_RWY) + ui * 4096 + (tb * 2 + vb) * 1024 + lane * 16);
    const u32x4* qt = (const u32x4*)(wsp<bf16>(F, WS_RWQ) + ui * 4096) + lane; const u32x4* s0 = (const u32x4*)(wsp<bf16>(F, WS_RWS) + ui * 4096) + lane;
    p.yl[0] = yl[0]; p.yl[1] = yl[1];
#pragma unroll
    for (int kb = 0; kb < 2; ++kb)
#pragma unroll
        for (int s = 0; s < 2; ++s) { p.qa[kb * 2 + s] = qt[((tb * 2 + kb) * 2 + s) * 64]; p.sb[kb * 2 + s] = s0[((kb * 2 + vb) * 2 + s) * 64]; }
}
__device__ __forceinline__ void rw_out_fetch_b(Frame& F, int unit, int tid, RwOutB& p) {
    const int jF = unit % RW_NCH, hh = (unit / RW_NCH) & 15, b = unit / (RW_NCH * 16);
    const int row = rw_row0(b, jF) + (tid >> 3), c0 = hh * 64 + (tid & 7) * 8;
    const bf16* XS = wsp<bf16>(F, WS_XS) + (size_t)row * 3072 + c0; const bf16* LR = wsp<bf16>(F, WS_LR) + (size_t)row * NLR + c0;
    p.px[0] = *(const u32x4*)XS; p.px[1] = *(const u32x4*)(XS + 1024); p.px[2] = *(const u32x4*)(XS + 2048);
    p.pl[0] = *(const u32x4*)(LR + 2048); p.pl[1] = *(const u32x4*)(LR + 3072); p.pl[2] = *(const u32x4*)(LR + 4096);
}
__device__ __forceinline__ void rw_out_unit(Frame& F, int layer, int unit, int unit_next, RwOutA& a, const RwOutB& bc, RwOutB& bn, const LAS float* VL) {
    const int jF = unit % RW_NCH, hh = (unit / RW_NCH) & 15, b = unit / (RW_NCH * 16);
    const int row0 = rw_row0(b, jF);
    const int lane = F.lane, h = lane >> 5, w = F.wave, dir = w >> 2, tb = (w >> 1) & 1, vb = w & 1;
    LAS float* YS = (LAS float*)F.lds;
    {
        f32x16 acc;
#pragma unroll
        for (int g = 0; g < 2; ++g)
#pragma unroll
            for (int e = 0; e < 4; ++e) { acc[8 * g + 2 * e] = bf_lo(a.yl[g][e]); acc[8 * g + 2 * e + 1] = bf_hi(a.yl[g][e]); }
#pragma unroll
        for (int i = 0; i < 4; ++i) acc = MFMA32(__builtin_bit_cast(bf16x8, a.qa[i]), __builtin_bit_cast(bf16x8, a.sb[i]), acc);
        if (unit_next >= 0) { rw_out_fetch_a(F, unit_next, w, lane, a); int tl_ = F.tid; asm volatile("" : "+v"(tl_)); rw_out_fetch_b(F, unit_next, tl_, bn); }
        LB();
        LAS float* yd = YS + dir * 64 * 68 + (32 * tb) * 68 + 32 * vb + (lane & 31);
#pragma unroll
        for (int r = 0; r < 16; ++r) yd[crow(r, h) * 68] = acc[r];
    }
    LB();
    {
        int tl_ = F.tid; asm volatile("" : "+v"(tl_));
        const int t = tl_ >> 3, j0 = (tl_ & 7) * 8, c0 = hh * 64 + j0; const int row = row0 + t;
        float y[8], s = 0.f;
#pragma unroll
        for (int e = 0; e < 2; ++e) { const f32x4 ya = *(const LAS f32x4*)(YS + t * 68 + j0 + 4 * e), yb = *(const LAS f32x4*)(YS + 64 * 68 + t * 68 + j0 + 4 * e);
#pragma unroll
            for (int q = 0; q < 4; ++q) { y[4 * e + q] = ya[q] + yb[q]; s += y[4 * e + q]; } }
        const float mean = red8(s) * (1.0f / 64.0f); float q2 = 0.f;
#pragma unroll
        for (int e = 0; e < 8; ++e) { y[e] -= mean; q2 += y[e] * y[e]; }
        const float rs = __builtin_amdgcn_rsqf(red8(q2) * (1.0f / 64.0f) + 64e-5f);
        float dp = 0.f; float ov[8];
#pragma unroll
        for (int e = 0; e < 2; ++e) {
            const f32x4 r = unpk4(bc.px[0], e), k = unpk4(bc.px[1], e);
            const f32x4 ka = *(const LAS f32x4*)(VL + 2 * 1024 + c0 + 4 * e), rk = *(const LAS f32x4*)(VL + 3 * 1024 + c0 + 4 * e);
            const f32x4 a0p = *(const LAS f32x4*)(VL + c0 + 4 * e) + unpk4(bc.pl[0], e);
            const f32x4 a1p = *(const LAS f32x4*)(VL + 1024 + c0 + 4 * e) + unpk4(bc.pl[1], e);
#pragma unroll
            for (int q = 0; q < 4; ++q) dp += r[q] * (k[q] * (2.0f + (sigm(a0p[q]) + sigm(a1p[q]) - 2.0f) * ka[q])) * rk[q]; }
        const float dot = red8(dp);
#pragma unroll
        for (int e = 0; e < 2; ++e) { const f32x4 v = unpk4(bc.px[2], e), g = unpk4(bc.pl[2], e), lng = *(const LAS f32x4*)(VL + 4 * 1024 + c0 + 4 * e);
#pragma unroll
            for (int q = 0; q < 4; ++q) ov[4 * e + q] = (y[4 * e + q] * rs * lng[q] + dot * v[q]) * g[q]; }
        u32x4 o; o.x = cvtpk(ov[0], ov[1]); o.y = cvtpk(ov[2], ov[3]); o.z = cvtpk(ov[4], ov[5]); o.w = cvtpk(ov[6], ov[7]);
        *(u32x4*)(wsp<bf16>(F, WS_Y) + (size_t)row * 3072 + 2048 + c0) = o;
    }
}

constexpr int CW_FOLD = 28672;
__device__ __forceinline__ void branch_fold(Frame& F, int layer) {
    if (F.wg >= 96) return;
    volatile LAS int* qslot = (volatile LAS int*)(F.lds + LDSCTL_OFF);
    asm volatile("s_waitcnt vmcnt(0)" ::: "memory");
    __syncthreads();
    for (int q = F.wg; q < 96; q += F.G) { const int t = q & 31;
        if (F.tid == 0) {
            __builtin_amdgcn_fence(__ATOMIC_RELEASE, "agent");
            asm volatile("s_waitcnt vmcnt(0)" ::: "memory");
            const int old = (int)__hip_atomic_fetch_add(F.ctl + CW_FOLD + 64 * layer + t, 1u, __ATOMIC_RELAXED, __HIP_MEMORY_SCOPE_AGENT);
            if (old == 2) { __builtin_amdgcn_fence(__ATOMIC_ACQUIRE, "agent"); asm volatile("s_waitcnt vmcnt(0)" ::: "memory"); }
            qslot[0] = old;
        }
        __syncthreads();
        const int old = qslot[0];
        __syncthreads();
        if (old != 2) continue;
        const bf16* P = wsp<bf16>(F, WS_YDR); bf16* mg = wsp<bf16>(F, WS_MG) + (size_t)ML * DM;
        const int r0 = (t >> 3) * 256, c0 = (t & 7) * 256;
#pragma unroll 1
        for (int it = 0; it < 16; it += 4) {
            u32x4 p[4][3];
#pragma unroll
            for (int k = 0; k < 4; ++k) { const int idx = (it + k) * NTHR + F.tid; const size_t off = (size_t)(r0 + (idx >> 5)) * DM + c0 + (idx & 31) * 8;
#pragma unroll
                for (int b = 0; b < 3; ++b) p[k][b] = *(const u32x4*)(P + (size_t)b * MC * DM + off); }
#pragma unroll
            for (int k = 0; k < 4; ++k) { const int idx = (it + k) * NTHR + F.tid; const size_t off = (size_t)(r0 + (idx >> 5)) * DM + c0 + (idx & 31) * 8;
                u32x4 w;
                w.x = cvtpk(pg8::bf_lo(p[k][0].x) + pg8::bf_lo(p[k][1].x) + pg8::bf_lo(p[k][2].x), pg8::bf_hi(p[k][0].x) + pg8::bf_hi(p[k][1].x) + pg8::bf_hi(p[k][2].x));
                w.y = cvtpk(pg8::bf_lo(p[k][0].y) + pg8::bf_lo(p[k][1].y) + pg8::bf_lo(p[k][2].y), pg8::bf_hi(p[k][0].y) + pg8::bf_hi(p[k][1].y) + pg8::bf_hi(p[k][2].y));
                w.z = cvtpk(pg8::bf_lo(p[k][0].z) + pg8::bf_lo(p[k][1].z) + pg8::bf_lo(p[k][2].z), pg8::bf_hi(p[k][0].z) + pg8::bf_hi(p[k][1].z) + pg8::bf_hi(p[k][2].z));
                w.w = cvtpk(pg8::bf_lo(p[k][0].w) + pg8::bf_lo(p[k][1].w) + pg8::bf_lo(p[k][2].w), pg8::bf_hi(p[k][0].w) + pg8::bf_hi(p[k][1].w) + pg8::bf_hi(p[k][2].w));
                *(u32x4*)(mg + off) = w; }
        }
    }
}

__device__ __forceinline__ void mixa_phase(Frame& F, int layer) {
    constexpr int NU = NB * 16 * RW_NCH;
    if (F.wg < NU) { RwIn in; rw_fetch_x(F, F.wg, F.tid, in); rw_fetch_l(F, F.wg, 0, F.tid, in); rw_fetch_v(F, layer, F.wg, F.tid, in);
        for (int u = F.wg; u < NU; u += F.G) rw_local_unit(F, layer, u, u + F.G < NU ? u + F.G : -1, in); }
    __syncthreads();
    for (int u = F.wg; u < 256; u += F.G) ret_state_unit(F, layer, u);
    __syncthreads();
}
__device__ __forceinline__ void mix_phase(Frame& F, int layer, int qidx, int mode = 3) {
#ifdef RW_DEBUG
    for (int u = F.wg; u < 256; u += F.G) rwkv_scan_unit(F, layer, u);
    __syncthreads();
#endif
    if (mode & 1) { if (F.wave < 3) for (int tk = F.wg * 3 + F.wave; tk < 256; tk += F.G * 3) rw_seq_task(F, tk, F.lane, F.lds + F.wave * RWQ_WAVE); }
    if (!(mode & 2)) return;
    const bool lastl = layer == NL - 1;
    const int nswa = lastl ? 512 : 576;
    volatile LAS int* qslot = (volatile LAS int*)(F.lds + LDSCTL_OFF);
    for (;;) {
        __syncthreads();
        if (F.tid == 0) qslot[0] = (int)__hip_atomic_fetch_add(F.ctl + CW_SWAQ + 64 * qidx, 1u, __ATOMIC_RELAXED, __HIP_MEMORY_SCOPE_AGENT);
        __syncthreads();
        const int item = qslot[0];
        if (item >= nswa) break;
        swa_unit(F, layer, item);
    }
    for (;;) {
        __syncthreads();
        if (F.tid == 0) qslot[0] = (int)__hip_atomic_fetch_add(F.ctl + CW_SWAQ + 64 * qidx + 32, 1u, __ATOMIC_RELAXED, __HIP_MEMORY_SCOPE_AGENT);
        __syncthreads();
        const int r = qslot[0];
        if (r >= nswa) break;
        ret_out_unit(F, layer, lastl ? (r >> 4) * 18 + 2 + (r & 15) : r);
    }
}
__device__ __forceinline__ void mixfin_phase(Frame& F, int layer, int nrows) {
    { TS_BEGIN(1);
      LAS float* VL = (LAS float*)(F.lds + 40960);
      for (int e = F.tid; e < 5 * 256; e += NTHR) { const int v = e >> 8, c4 = (e & 255) * 4; const int src = v == 0 ? 2 : (v == 1 ? 3 : (v == 2 ? 5 : (v == 3 ? 6 : 7)));
          *(LAS f32x4*)(VL + v * 1024 + c4) = *(const f32x4*)(vecp(F, layer, src) + c4); }
      constexpr int NU = NB * 16 * RW_NCH; const bool lastl = layer == NL - 1;
      auto nextu = [&](int u) { u += F.G; while (u < NU && lastl && (u % RW_NCH) < 4) u += F.G; return u < NU ? u : -1; };
      int u = F.wg - F.G; u = nextu(u);
      if (u >= 0) { RwOutA a; RwOutB b0, b1; rw_out_fetch_a(F, u, F.wave, F.lane, a); rw_out_fetch_b(F, u, F.tid, b0);
          __syncthreads();
          while (u >= 0) { int un = nextu(u); rw_out_unit(F, layer, u, un, a, b0, b1, VL); u = un;
              if (u < 0) break;
              un = nextu(u); rw_out_unit(F, layer, u, un, a, b1, b0, VL); u = un; } }
    TS_END(1); }
    __syncthreads();
}

constexpr int CONVQ_IN = 21, CONVQ_BR = 2, CONVQ_F1 = 10;
constexpr int NPH = 12;
constexpr int NSTEPS = 2 + NL * NPH + 1;
__global__ void __launch_bounds__(NTHR, 2) hyb_fwd(Args args) {
    extern __shared__ __attribute__((aligned(16))) unsigned char lds[];
    Frame F;
    F.lds = (LAS unsigned char*)lds;
    F.tid = threadIdx.x; F.lane = F.tid & 63; F.wave = __builtin_amdgcn_readfirstlane(F.tid >> 6);
    const int wv0 = F.wave;
    F.G = gridDim.x; F.wg = blockIdx.x; F.ws = args.ws; F.ctl = (unsigned*)(args.ws + WS_CTL);
    for (int u = F.tid; u < (LDS_BYTES - LDSCTL_OFF) / 4; u += NTHR) ((LAS unsigned*)(F.lds + LDSCTL_OFF))[u] = 0u;
    __syncthreads();
    if (F.tid < 26) { const __attribute__((address_space(4))) unsigned long long* kp = (const __attribute__((address_space(4))) unsigned long long*)__builtin_amdgcn_kernarg_segment_ptr();
        ((LAS unsigned long long*)(F.lds + PTAB_OFF))[F.tid] = kp[F.tid]; }
    __syncthreads();
    XcdBarrier bar = xcd_barrier_post(F.ctl + CW_BAR, (volatile LAS unsigned*)(F.lds + MISC_OFF) + 8);
    int lo = args.s_lo, hi = args.s_hi;
#define IN(k) (lo <= (k) && (k) < hi)
#define SL() do { size_t z_ = 0; asm volatile("" : "+s"(lo), "+s"(hi), "+s"(z_), "+s"(F.wg), "+s"(F.G)); F.ws = args.ws + z_; } while (0)
#define LAUNDER() do { int t_ = wv0 * 64 + lane_now(); asm volatile("" : "+v"(t_)); F.tid = t_; F.lane = t_ & 63; F.wave = __builtin_amdgcn_readfirstlane(t_ >> 6); } while (0)
#define SEAM(k) do { SL(); if (IN(k) && IN((k) + 1)) xcd_barrier(bar, wv0 == 0 && lane_now() == 0); } while (0)
    SL(); if (IN(0)) { LAUNDER(); p0_prologue(F); }
#ifdef PROBE_P0
    SL(); if (IN(0)) { xcd_barrier(bar, wv0 == 0 && lane_now() == 0); LAUNDER(); p0_prologue(F); }
#endif
    SEAM(0);
    SL(); if (IN(1)) { LAUNDER(); p1_modreduce(F); }
    SEAM(1);
    for (int layer_ = 0; layer_ < NL; ++layer_) {
        int layer = layer_; asm volatile("" : "+s"(layer));
        const int s0 = 2 + layer * NPH;
        const int mrows = (layer == NL - 1) ? ML : MT;
        const float* modl = wsp<float>(F, WS_MOD) + (size_t)layer * 5 * 12288;
        SL(); if (IN(s0 + 0)) { LAUNDER(); if (layer > 0) conv_pull(F, -1, conv_deadline(layer)); norm_phase(F, layer, 0, MT, layer > 0); }
#if defined(PROBE_PHASE) && PROBE_PHASE == 0
        SL(); if (IN(s0 + 0)) { xcd_barrier(bar, wv0 == 0 && lane_now() == 0); LAUNDER(); norm_phase(F, layer, 0, MT, false); }
#endif
        SEAM(s0 + 0);
        SL(); if (IN(s0 + 1)) {
            const int gg = (layer < NL - 1 && F.G == 256) ? 240 : F.G;
            if (layer == NL - 1) {
            pg8::Gemm g{wsp<bf16>(F, WS_U), wsp<bf16>(F, WS_WIN + layer * SZ_WIN), MT, LDP, DM, DM, DM}; pg8::LastInOrder S; S.init(F.G, F.wg);
            pg8::EpiBf16<0> E{wsp<bf16>(F, WS_P), LDP};
            pg8::gemm_phase<pg8::EpiBf16<0>, pg8::LastInOrder, true, true>(F.lds, g, S, E, wv0);
            } else if (F.wg < gg) {
            pg8::Gemm g{wsp<bf16>(F, WS_U), wsp<bf16>(F, WS_WIN + layer * SZ_WIN), MT, LDP, DM, DM, DM}; pg8::StaticOrder S; S.init(MT, LDP, gg, F.wg);
            pg8::EpiBf16<0> E{wsp<bf16>(F, WS_P), LDP};
            pg8::gemm_phase<pg8::EpiBf16<0>, pg8::StaticOrder, true, true>(F.lds, g, S, E, wv0);
            } else { LAUNDER(); conv_pull(F, CONVQ_IN, CONV_QTOT); }
#ifdef PROBE_GEMM2
            pg8::gemm_phase<pg8::EpiBf16<0>, pg8::StaticOrder, true, true>(F.lds, g, S, E, wv0);
#endif
        }
        SEAM(s0 + 1);
        SL(); if (IN(s0 + 2)) { LAUNDER(); if (layer == 0) conv_pull(F, -1, CONV_Q0); prep_phase(F, layer); }
#if defined(PROBE_PHASE) && PROBE_PHASE == 2
        SL(); if (IN(s0 + 2)) { xcd_barrier(bar, wv0 == 0 && lane_now() == 0); LAUNDER(); prep_phase(F, layer); }
#endif
        SEAM(s0 + 2);
        SL(); if (IN(s0 + 3)) {
            pg8::Gemm g{wsp<bf16>(F, WS_ALR), wsp<bf16>(F, WS_WLR + layer * SZ_WLR), MT, NLR, 128, KLR, KLR}; pg8::LrOrder S; S.init(MT, NLR, F.G, F.wg);
            pg8::EpiBf16<0> E{wsp<bf16>(F, WS_LR), NLR};
            pg8::gemm_phase<pg8::EpiBf16<0>, pg8::LrOrder, true, true>(F.lds, g, S, E, wv0);
#if defined(PROBE_PHASE) && PROBE_PHASE == 3
            pg8::gemm_phase<pg8::EpiBf16<0>, pg8::LrOrder, true, true>(F.lds, g, S, E, wv0);
#endif
        }
        SEAM(s0 + 3);
        SL(); if (IN(s0 + 4)) { LAUNDER(); mixa_phase(F, layer); }
#if defined(PROBE_PHASE) && PROBE_PHASE == 4
        SL(); if (IN(s0 + 4)) { xcd_barrier(bar, wv0 == 0 && lane_now() == 0); LAUNDER(); mixa_phase(F, layer); }
#endif
        SEAM(s0 + 4);
        SL(); if (IN(s0 + 5)) { LAUNDER(); mix_phase(F, layer, layer); }
#ifdef PROBE_MIX
        SL(); if (IN(s0 + 5)) { xcd_barrier(bar, wv0 == 0 && lane_now() == 0); LAUNDER(); mix_phase(F, layer, layer + 4, PROBE_MIX); }
#endif
        SEAM(s0 + 5);
        SL(); if (IN(s0 + 6)) { LAUNDER(); mixfin_phase(F, layer, mrows); }
#if defined(PROBE_PHASE) && PROBE_PHASE == 6
        SL(); if (IN(s0 + 6)) { xcd_barrier(bar, wv0 == 0 && lane_now() == 0); LAUNDER(); mixfin_phase(F, layer, mrows); }
#endif
        SEAM(s0 + 6);
        SL(); if (IN(s0 + 7)) {
            pg8::Gemm g{wsp<bf16>(F, WS_Y), wsp<bf16>(F, WS_WBR + layer * SZ_WBR), mrows, DM, BW, 3072, BW}; pg8::BranchOrder S; S.init(F.G, F.wg, mrows > ML);
            pg8::EpiBranch E{wsp<bf16>(F, WS_P) + C_GATE, LDP, wsp<bf16>(F, WS_MG), wsp<bf16>(F, WS_YDR)};
            pg8::gemm_phase<pg8::EpiBranch, pg8::BranchOrder, true, true>(F.lds, g, S, E, wv0);
#if defined(PROBE_PHASE) && PROBE_PHASE == 7
            pg8::gemm_phase<pg8::EpiBranch, pg8::BranchOrder, true, true>(F.lds, g, S, E, wv0);
#endif
            if (mrows > ML) { LAUNDER(); branch_fold(F, layer);
                if (layer < NL - 1 && F.G == 256 && F.wg >= 96) conv_pull(F, CONVQ_BR, CONV_QTOT); }
        }
        SEAM(s0 + 7);
        SL(); if (IN(s0 + 8)) {
            pg8::Gemm g{wsp<bf16>(F, WS_MG), wsp<bf16>(F, WS_WOUT + layer * SZ_WOUT), MT, DM, DM, DM, DM}; pg8::OutOrder S; S.init(F.G, F.wg, mrows > ML, DM);
            pg8::EpiOut E{wsp<bf16>(F, WS_MGF), wsp<bf16>(F, WS_YDR), modl, 2 * DM, (int)(F.wg & 7)};
            pg8::gemm_phase<pg8::EpiOut, pg8::OutOrder, true, true>(F.lds, g, S, E, wv0);
        }
        SEAM(s0 + 8);
        SL(); if (IN(s0 + 9)) { LAUNDER(); norm_phase(F, layer, 1, mrows, true); }
#if defined(PROBE_PHASE) && PROBE_PHASE == 9
        SL(); if (IN(s0 + 9)) { xcd_barrier(bar, wv0 == 0 && lane_now() == 0); LAUNDER(); norm_phase(F, layer, 1, mrows, false); }
#endif
        SEAM(s0 + 9);
        SL(); if (IN(s0 + 10)) {
            const int gg = (layer < NL - 1 && mrows > ML && F.G == 256) ? 232 : F.G;
            if (F.wg < gg) {
            pg8::Gemm g{wsp<bf16>(F, WS_U), wsp<bf16>(F, WS_WFF1 + layer * SZ_WFF), mrows, DFF, DM, DM, DM}; pg8::StaticOrder S; S.init(mrows, DFF, gg, F.wg);
            pg8::EpiBf16<2> E{wsp<bf16>(F, WS_F), DFF};
            pg8::gemm_phase<pg8::EpiBf16<2>, pg8::StaticOrder, true, true>(F.lds, g, S, E, wv0);
            } else { LAUNDER(); conv_pull(F, CONVQ_F1, CONV_QTOT); }
#ifdef PROBE_GEMM2
            pg8::gemm_phase<pg8::EpiBf16<2>, pg8::StaticOrder, true, true>(F.lds, g, S, E, wv0);
#endif
        }
        SEAM(s0 + 10);
        SL(); if (IN(s0 + 11)) {
            pg8::Gemm g{wsp<bf16>(F, WS_F), wsp<bf16>(F, WS_WFF2 + layer * SZ_WFF), MT, DM, DFF, DFF, DFF}; pg8::OutOrder S; S.init(F.G, F.wg, mrows > ML, DFF);
            pg8::EpiOut E{wsp<bf16>(F, WS_MGF) + (size_t)ML * DM, wsp<bf16>(F, WS_YDR), modl, 5 * DM, (int)(F.wg & 7)};
            pg8::gemm_phase<pg8::EpiOut, pg8::OutOrder, true, true>(F.lds, g, S, E, wv0);
        }
        SEAM(s0 + 11);
    }
    SL(); if (IN(NSTEPS - 1)) { LAUNDER(); final_norm(F, args.out); }
#undef IN
#undef SL
#undef LAUNDER
#undef SEAM
}

#ifndef MK_ONE_LAUNCH
#define MK_ONE_LAUNCH 1
#endif
extern "C" void kernel_launch(void* const* d_in, const int* in_sizes, int n_in, void* d_out, int out_size, void* d_ws, size_t ws_size, hipStream_t stream) {
    static int grid = 0;
    if (grid == 0) {
        if (n_in != 26 || out_size != ML * DM || ws_size < WS_END2) { fprintf(stderr, "kernel_launch: unexpected shapes (n_in %d, out %d, ws %zu < %zu)\n", n_in, out_size, ws_size, (size_t)WS_END2); grid = -1; return; }
        int dev = 0, cus = 0, per_cu = 0;
        if (hipGetDevice(&dev) != hipSuccess || hipDeviceGetAttribute(&cus, hipDeviceAttributeMultiprocessorCount, dev) != hipSuccess) { grid = -1; return; }
        if (hipFuncSetAttribute((const void*)hyb_fwd, hipFuncAttributeMaxDynamicSharedMemorySize, LDS_BYTES) != hipSuccess) { fprintf(stderr, "kernel_launch: hipFuncSetAttribute failed\n"); grid = -1; return; }
        if (hipOccupancyMaxActiveBlocksPerMultiprocessor(&per_cu, (const void*)hyb_fwd, NTHR, LDS_BYTES) != hipSuccess || per_cu < 1) fprintf(stderr, "kernel_launch: occupancy query reports %d\n", per_cu);
        (void)hipGetLastError();
        grid = cus;
    }
    if (grid < 0) return;
    if (hipMemsetAsync((char*)d_ws + WS_CTL, 0, CTL_ZERO_BYTES, stream) != hipSuccess) return;
    Args a{};
    for (int i = 0; i < 26; ++i) a.in[i] = (const float*)d_in[i];
    a.out = (float*)d_out; a.ws = (unsigned char*)d_ws;
#if MK_ONE_LAUNCH
    a.s_lo = 0; a.s_hi = NSTEPS;
    hipLaunchKernelGGL(hyb_fwd, dim3(grid), dim3(NTHR), LDS_BYTES, stream, a);
#else
    for (int s = 0; s < NSTEPS; ++s) { a.s_lo = s; a.s_hi = s + 1; hipLaunchKernelGGL(hyb_fwd, dim3(grid), dim3(NTHR), LDS_BYTES, stream, a); }
#endif
}
```
